# Optimizing an MI355X kernel written in HIP

```python
import math
import jax, jax.numpy as jnp
from jax import lax
import numpy as np

D_MODEL = 1024
BATCH = 2
SEQ = 8192
DEPTH = 2

CHUNK = 64
D_HEAD = 64
QBLOCK = 128
ROPE_THETA = 10000.0
EPS = 1e-6

A_HEADS = 4
A_DV = 2 * D_HEAD
B_HEADS = 8
B_LOOKBACK = 8
B_BAND = (B_LOOKBACK + 1) * CHUNK
B_MAX_REL = 256
B_REL_SIZE = CHUNK + B_MAX_REL
C_HEADS = 4
C_DV = 2 * D_HEAD

N_BRANCH = 3
D_FF = 2816

A_QK = A_HEADS * 2 * D_HEAD
A_V = A_HEADS * A_DV
B_QKV = B_HEADS * D_HEAD
C_QK = C_HEADS * D_HEAD
C_V = C_HEADS * C_DV
SPLITS = (A_QK, A_QK, A_V, B_QKV, B_QKV, B_QKV, C_QK, C_QK, C_V, C_V, N_BRANCH * D_MODEL)
IN_COLS = sum(SPLITS)

kernel_name = "hybrid_gated_diffattn_chunkattn_retention_macaron"


def _rms_f32(x, gain):
    xf = x.astype(jnp.float32)
    y = xf * lax.rsqrt(jnp.mean(xf * xf, axis=-1, keepdims=True) + EPS)
    return y * gain.astype(jnp.float32)


def rms_norm(x, gain):
    return _rms_f32(x, gain).astype(x.dtype)


def rope(x):
    S, d = x.shape[1], x.shape[-1]
    half = d // 2
    inv = ROPE_THETA ** (-jnp.arange(half, dtype=jnp.float32) / half)
    ang = jnp.arange(S, dtype=jnp.float32)[:, None] * inv[None, :]
    shape = (1, S) + (1,) * (x.ndim - 3) + (half,)
    cos, sin = jnp.cos(ang).reshape(shape), jnp.sin(ang).reshape(shape)
    x1, x2 = x[..., :half], x[..., half:]
    return jnp.concatenate([x1 * cos - x2 * sin, x2 * cos + x1 * sin], axis=-1)


def swiglu_ffn(x, norm, w_gate, w_up, w_down):
    h = rms_norm(x, norm)
    return (jax.nn.silu(h @ w_gate) * (h @ w_up)) @ w_down


def diff_attention(q, k, v, lam, lam_init, subln):
    bsz, S = q.shape[0], q.shape[1]
    nb = S // QBLOCK
    scale = D_HEAD ** -0.5
    qb = jnp.moveaxis(q.reshape(bsz, nb, QBLOCK, A_HEADS, 2, D_HEAD), 1, 0)
    key_chunk = jnp.arange(S) // CHUNK

    def block(args):
        i, qi = args
        q_chunk = (i * QBLOCK + jnp.arange(QBLOCK)) // CHUNK
        visible = key_chunk[None, :] <= q_chunk[:, None]
        s = jnp.einsum('bqhcd,bkhcd->bhcqk', qi, k) * scale
        p = jax.nn.softmax(jnp.where(visible, s, -jnp.inf), axis=-1)
        w = p[:, :, 0] - lam * p[:, :, 1]
        return jnp.einsum('bhqk,bkhe->bqhe', w, v)

    o = lax.map(block, (jnp.arange(nb), qb))
    o = jnp.moveaxis(o, 0, 1).reshape(bsz, S, A_HEADS, A_DV)
    o = _rms_f32(o, subln) * (1.0 - lam_init)
    return o.reshape(bsz, S, A_HEADS * A_DV)


def chunk_attention(q, k, v, rel_bias):
    bsz, S = q.shape[0], q.shape[1]
    nc = S // CHUNK
    scale = D_HEAD ** -0.5
    qc = q.reshape(bsz, nc, CHUNK, B_HEADS, D_HEAD)

    def band(t):
        tc = t.reshape(bsz, nc, CHUNK, B_HEADS, D_HEAD)
        tp = jnp.pad(tc, ((0, 0), (B_LOOKBACK, 0), (0, 0), (0, 0), (0, 0)))
        return jnp.concatenate([tp[:, j:j + nc] for j in range(B_LOOKBACK + 1)], axis=2)

    kb, vb = band(k), band(v)
    qi = jnp.arange(CHUNK)
    kj = jnp.arange(B_BAND)
    rel = qi[:, None] + B_LOOKBACK * CHUNK - kj[None, :]
    idx = jnp.clip(rel, -(CHUNK - 1), B_MAX_REL) + (CHUNK - 1)
    bias = rel_bias.astype(jnp.float32)[:, idx]
    valid = (jnp.arange(nc)[:, None] - B_LOOKBACK + (kj // CHUNK)[None, :]) >= 0
    s = jnp.einsum('bnqhd,bnkhd->bnhqk', qc, kb) * scale + bias
    s = jnp.where(valid[None, :, None, None, :], s, -jnp.inf)
    p = jax.nn.softmax(s, axis=-1)
    o = jnp.einsum('bnhqk,bnkhd->bnqhd', p, vb)
    return o.reshape(bsz, S, B_HEADS * D_HEAD)


def retention(q, k, v, g, out_norm):
    bsz, S = q.shape[0], q.shape[1]
    nc = S // CHUNK
    log_gamma = jnp.log(1.0 - 2.0 ** (-5.0 - jnp.arange(C_HEADS, dtype=jnp.float32)))
    pos = jnp.arange(CHUNK, dtype=jnp.float32)
    diff = pos[:, None] - pos[None, :]
    decay = jnp.where(diff >= 0, jnp.exp(log_gamma[:, None, None] * jnp.maximum(diff, 0.0)), 0.0)
    zeta = jnp.exp(log_gamma[:, None] * (CHUNK - 1 - pos)[None, :])
    xi = jnp.exp(log_gamma[:, None] * (pos + 1.0)[None, :])
    chunk_decay = jnp.exp(log_gamma * CHUNK)

    qc = q.reshape(bsz, nc, CHUNK, C_HEADS, D_HEAD)
    kc = k.reshape(bsz, nc, CHUNK, C_HEADS, D_HEAD)
    vc = v.reshape(bsz, nc, CHUNK, C_HEADS, C_DV)
    inner = jnp.einsum('bnqhd,bnkhd->bnhqk', qc, kc) * decay
    inner = jnp.einsum('bnhqk,bnkhe->bnqhe', inner, vc)
    kv = jnp.einsum('bnkhd,bnkhe,hk->bnhde', kc, vc, zeta)

    def step(state, kv_n):
        return state * chunk_decay[None, :, None, None] + kv_n, state

    init = jnp.zeros((bsz, C_HEADS, D_HEAD, C_DV), jnp.float32)
    _, prev = lax.scan(step, init, jnp.moveaxis(kv, 1, 0))
    prev = jnp.moveaxis(prev, 0, 1)
    cross = jnp.einsum('bnqhd,bnhde->bnqhe', qc, prev) * xi.T[None, None, :, :, None]
    o = (inner + cross).reshape(bsz, S, C_HEADS, C_DV)
    o = _rms_f32(o, out_norm).reshape(bsz, S, C_HEADS * C_DV)
    return jax.nn.silu(g) * o


def setup_inputs(seed: int = 0) -> dict:
    key = jax.random.key(seed)
    ks = iter(jax.random.split(key, 32))
    f32 = jnp.float32

    def nrm(shape, scale):
        return jax.random.normal(next(ks), shape, f32) * scale

    def gain(shape):
        return 1.0 + 0.02 * jax.random.normal(next(ks), shape, f32)

    L = DEPTH
    return {
        "x": jax.random.normal(next(ks), (BATCH, SEQ, D_MODEL), f32),
        "ffn1_norm": gain((L, D_MODEL)),
        "ffn1_w_gate": nrm((L, D_MODEL, D_FF), D_MODEL ** -0.5),
        "ffn1_w_up": nrm((L, D_MODEL, D_FF), D_MODEL ** -0.5),
        "ffn1_w_down": nrm((L, D_FF, D_MODEL), D_FF ** -0.5),
        "mix_norm": gain((L, D_MODEL)),
        "w_in": nrm((L, D_MODEL, IN_COLS), D_MODEL ** -0.5),
        "a_q_norm": gain((L, D_HEAD)),
        "a_k_norm": gain((L, D_HEAD)),
        "a_lambda_q1": nrm((L, D_HEAD), 0.1),
        "a_lambda_k1": nrm((L, D_HEAD), 0.1),
        "a_lambda_q2": nrm((L, D_HEAD), 0.1),
        "a_lambda_k2": nrm((L, D_HEAD), 0.1),
        "a_subln": gain((L, A_DV)),
        "b_q_norm": gain((L, D_HEAD)),
        "b_k_norm": gain((L, D_HEAD)),
        "b_rel_bias": nrm((L, B_HEADS, B_REL_SIZE), 0.5),
        "c_out_norm": gain((L, C_HEADS, C_DV)),
        "w_branch_a": nrm((L, A_V, D_MODEL), A_V ** -0.5),
        "w_branch_b": nrm((L, B_QKV, D_MODEL), B_QKV ** -0.5),
        "w_branch_c": nrm((L, C_V, D_MODEL), C_V ** -0.5),
        "w_out": nrm((L, D_MODEL, D_MODEL), D_MODEL ** -0.5),
        "ffn2_norm": gain((L, D_MODEL)),
        "ffn2_w_gate": nrm((L, D_MODEL, D_FF), D_MODEL ** -0.5),
        "ffn2_w_up": nrm((L, D_MODEL, D_FF), D_MODEL ** -0.5),
        "ffn2_w_down": nrm((L, D_FF, D_MODEL), D_FF ** -0.5),
    }


def reference(x, ffn1_norm, ffn1_w_gate, ffn1_w_up, ffn1_w_down, mix_norm, w_in,
              a_q_norm, a_k_norm, a_lambda_q1, a_lambda_k1, a_lambda_q2, a_lambda_k2, a_subln,
              b_q_norm, b_k_norm, b_rel_bias, c_out_norm,
              w_branch_a, w_branch_b, w_branch_c, w_out,
              ffn2_norm, ffn2_w_gate, ffn2_w_up, ffn2_w_down):
    f32 = jnp.float32
    bsz, S = x.shape[0], x.shape[1]
    split_points = [int(p) for p in np.cumsum(SPLITS)[:-1]]
    for l in range(DEPTH):
        x = x + 0.5 * swiglu_ffn(x, ffn1_norm[l], ffn1_w_gate[l], ffn1_w_up[l], ffn1_w_down[l])

        h = rms_norm(x, mix_norm[l])
        aq, ak, av, bq, bk, bv, cq, ck, cv, cg, gates = jnp.split(h @ w_in[l], split_points, axis=-1)

        lam_init = 0.8 - 0.6 * math.exp(-0.3 * l)
        lam = (jnp.exp(jnp.sum(a_lambda_q1[l].astype(f32) * a_lambda_k1[l].astype(f32)))
               - jnp.exp(jnp.sum(a_lambda_q2[l].astype(f32) * a_lambda_k2[l].astype(f32))) + lam_init)
        qa = rope(_rms_f32(aq.reshape(bsz, S, A_HEADS, 2, D_HEAD), a_q_norm[l]))
        ka = rope(_rms_f32(ak.reshape(bsz, S, A_HEADS, 2, D_HEAD), a_k_norm[l]))
        va = av.reshape(bsz, S, A_HEADS, A_DV).astype(f32)
        y_a = diff_attention(qa, ka, va, lam, lam_init, a_subln[l])

        qb = _rms_f32(bq.reshape(bsz, S, B_HEADS, D_HEAD), b_q_norm[l])
        kb = _rms_f32(bk.reshape(bsz, S, B_HEADS, D_HEAD), b_k_norm[l])
        vb = bv.reshape(bsz, S, B_HEADS, D_HEAD).astype(f32)
        y_b = chunk_attention(qb, kb, vb, b_rel_bias[l])

        qc = rope(cq.reshape(bsz, S, C_HEADS, D_HEAD).astype(f32))
        kc = rope(ck.reshape(bsz, S, C_HEADS, D_HEAD).astype(f32)) * (D_HEAD ** -0.5)
        vc = cv.reshape(bsz, S, C_HEADS, C_DV).astype(f32)
        y_c = retention(qc, kc, vc, cg.astype(f32), c_out_norm[l])

        g = jax.nn.sigmoid(gates.astype(f32)).reshape(bsz, S, N_BRANCH, D_MODEL)
        merged = (g[:, :, 0] * (y_a.astype(x.dtype) @ w_branch_a[l]).astype(f32)
                  + g[:, :, 1] * (y_b.astype(x.dtype) @ w_branch_b[l]).astype(f32)
                  + g[:, :, 2] * (y_c.astype(x.dtype) @ w_branch_c[l]).astype(f32))
        x = x + merged.astype(x.dtype) @ w_out[l]

        x = x + 0.5 * swiglu_ffn(x, ffn2_norm[l], ffn2_w_gate[l], ffn2_w_up[l], ffn2_w_down[l])
    return x
```

```cpp
#define MK_PER_PHASE_LAUNCH 0
#include <hip/hip_runtime.h>
#include <hip/hip_bf16.h>
#include <cstdio>
#include <cstdint>
#include <cmath>

#ifndef MK_PER_PHASE_LAUNCH
#define MK_PER_PHASE_LAUNCH 0
#endif
#ifndef NAIVE_GEMM
#define NAIVE_GEMM 0
#endif
#ifndef NAIVE_UP
#define NAIVE_UP NAIVE_GEMM
#endif
#ifndef NAIVE_DOWN
#define NAIVE_DOWN NAIVE_GEMM
#endif
#ifndef NAIVE_WIN
#define NAIVE_WIN NAIVE_GEMM
#endif
#ifndef NAIVE_GATE
#define NAIVE_GATE NAIVE_GEMM
#endif
#ifndef NAIVE_MERGE
#define NAIVE_MERGE NAIVE_GEMM
#endif
#ifndef NAIVE_WOUT
#define NAIVE_WOUT NAIVE_GEMM
#endif
#ifndef PROBE_MASK
#define PROBE_MASK 0
#endif
#ifndef PROBE_NULL
#define PROBE_NULL 0
#endif
#ifndef FA_V2
#define FA_V2 1
#endif
#ifndef PROBE_A
#define PROBE_A 0
#endif
#ifndef PROBE_B
#define PROBE_B 0
#endif
#ifndef NAIVE_A
#define NAIVE_A 0
#endif
#ifndef NAIVE_B
#define NAIVE_B 0
#endif
#ifndef NAIVE_C
#define NAIVE_C 0
#endif

constexpr int BATCH = 2, SEQ = 8192, DM = 1024, DEPTH = 2, M = BATCH * SEQ;
constexpr int DFF = 2816, NIN1 = 4608, NGATE = 3072, NIN = 7680;
constexpr float EPS = 1e-6f;
constexpr float LOG2E = 1.4426950408889634f;
constexpr float C2 = 0.125f * LOG2E;

enum { I_X = 0, I_F1N, I_F1G, I_F1U, I_F1D, I_MIXN, I_WIN, I_AQN, I_AKN, I_LQ1, I_LK1, I_LQ2, I_LK2, I_ASUB, I_BQN, I_BKN, I_BREL, I_CON, I_WBA, I_WBB, I_WBC, I_WOUT, I_F2N, I_F2G, I_F2U, I_F2D, N_IN };

constexpr size_t MiB = 1u << 20;
constexpr size_t WS_CTL = 0, CTL_ZERO_BYTES = 1 * MiB;
constexpr size_t WS_ONES = 512 * 1024;
constexpr size_t WS_COS = 1 * MiB, WS_SIN = 2 * MiB;
constexpr size_t WS_SSQ = 3 * MiB;
constexpr size_t WS_W = 4 * MiB;
constexpr size_t W_GU1 = 0, W_D1 = W_GU1 + (size_t)2 * DFF * DM * 2, W_IN = W_D1 + (size_t)DM * DFF * 2, W_BR = W_IN + (size_t)NIN * DM * 2,
                 W_OUT = W_BR + (size_t)3 * DM * 512 * 2, W_GU2 = W_OUT + (size_t)DM * DM * 2, W_D2 = W_GU2 + (size_t)2 * DFF * DM * 2, W_END = W_D2 + (size_t)DM * DFF * 2;
static_assert(W_END == 53 * MiB, "weights");
constexpr size_t WS_XB = 57 * MiB;
constexpr size_t WS_R4 = 89 * MiB;
constexpr size_t WS_R3 = 121 * MiB;
constexpr size_t P16 = 16 * MiB;
constexpr size_t WS_AQ = WS_R3, WS_BQ = WS_R3 + P16, WS_CG = WS_R3 + 2 * P16;
constexpr size_t WS_AK = WS_R3 + 3 * P16, WS_AV = WS_AK + P16, WS_BK = WS_AV + P16, WS_BV = WS_BK + P16, WS_CQ = WS_BV + P16, WS_CK = WS_CQ + P16 / 2, WS_CV = WS_CK + P16 / 2;
constexpr size_t WS_GT = WS_AK;
constexpr size_t WS_HB = WS_R3;
constexpr size_t WS_MG = WS_R4;
constexpr size_t WS_END = WS_R3 + 144 * MiB;
static_assert(WS_CV + P16 == WS_END && WS_GT + (size_t)M * NGATE * 2 == WS_END && WS_HB + (size_t)M * DFF * 2 <= WS_END, "ws map");

#define GAS __attribute__((address_space(1)))
#define LAS __attribute__((address_space(3)))
typedef unsigned short bf16_t;
typedef short bf16x8 __attribute__((ext_vector_type(8)));
typedef float f32x4 __attribute__((ext_vector_type(4)));
typedef float f32x2 __attribute__((ext_vector_type(2)));
typedef float f32x16 __attribute__((ext_vector_type(16)));
typedef unsigned u32x4 __attribute__((ext_vector_type(4)));
typedef unsigned u32x2 __attribute__((ext_vector_type(2)));
typedef GAS unsigned gu32;
#define RLX_AGENT __ATOMIC_RELAXED, __HIP_MEMORY_SCOPE_AGENT
#define LDS_WAIT() asm volatile("s_waitcnt lgkmcnt(0)" ::: "memory")
#define VM_WAIT() asm volatile("s_waitcnt vmcnt(0)" ::: "memory")

__device__ __forceinline__ unsigned f2bf(float f) { unsigned u = __builtin_bit_cast(unsigned, f); return (u + 0x7fffu + ((u >> 16) & 1u)) >> 16; }
__device__ __forceinline__ unsigned pk2(float lo, float hi) { return f2bf(lo) | (f2bf(hi) << 16); }
__device__ __forceinline__ float bf2f(unsigned short b) { return __builtin_bit_cast(float, (unsigned)b << 16); }
__device__ __forceinline__ float bflo(unsigned w) { return __builtin_bit_cast(float, w << 16); }
__device__ __forceinline__ float bfhi(unsigned w) { return __builtin_bit_cast(float, w & 0xffff0000u); }
__device__ __forceinline__ unsigned cvt_pk_bf16(float lo, float hi) { unsigned r; asm volatile("v_cvt_pk_bf16_f32 %0, %1, %2" : "=v"(r) : "v"(lo), "v"(hi)); return r; }
__device__ __forceinline__ float fast_rcp(float x) { return __builtin_amdgcn_rcpf(x); }
__device__ __forceinline__ float fast_exp2(float x) { return __builtin_amdgcn_exp2f(x); }
__device__ __forceinline__ float silu_f(float x) { return x * fast_rcp(1.0f + fast_exp2(-x * LOG2E)); }
__device__ __forceinline__ float sigmoid_f(float x) { return fast_rcp(1.0f + fast_exp2(-x * LOG2E)); }
__device__ __forceinline__ float wave_sum(float v) {
#pragma unroll
    for (int o = 1; o < 64; o <<= 1) v += __shfl_xor(v, o);
    return v;
}
__device__ __forceinline__ float wave_max(float v) {
#pragma unroll
    for (int o = 1; o < 64; o <<= 1) v = fmaxf(v, __shfl_xor(v, o));
    return v;
}

namespace pg8 {
#define PG8_LAS __attribute__((address_space(3)))
constexpr int BM = 256, BK = 64, HALF = 128, HTB = HALF * BK * 2  , STAGE_BYTES = 8 * HTB, NXCD = 8, WGM = 8;

__host__ __device__ __forceinline__ int lds_byte(int r, int c) { const int st = (r >> 4) * 2 + (c >> 5), rr = r & 15, cc = c & 31, ob = rr * 64 + cc * 2; return st * 1024 + (ob ^ (((ob >> 9) & 1) << 5)); }
__host__ __device__ __forceinline__ void stage_rc(int b, int& R, int& C) { const int st = b / 1024, sb = b % 1024, swz = sb ^ (((sb >> 9) & 1) << 5); R = (st >> 1) * 16 + swz / 64; C = (st & 1) * 32 + (swz % 64) / 2; }
__host__ __device__ __forceinline__ int perm32(int rho) { const int n = rho >> 4, i = rho & 15; return 8 * (i >> 2) + 4 * n + (i & 3); }

struct Unit { int pm, pn, sub, ui; };
struct Gemm { const bf16_t* A; const bf16_t* Bt; int K; size_t subA, subB; };
__device__ __forceinline__ const char* pickA(const Gemm& g, int s) { return (const char*)g.A + (size_t)s * g.subA; }
__device__ __forceinline__ const char* pickB(const Gemm& g, int s) { return (const char*)g.Bt + (size_t)s * g.subB; }

struct StaticOrder {
    int nM, nN, nwg, G, c;
    __host__ __device__ void init(int Mr, int N, int G_, int c_) { nM = Mr / BM; nN = N / BM; nwg = nM * nN; G = G_; c = c_; }
    template <int NSUB = 1> __host__ __device__ bool next(int i, Unit& u) const {
        const int it = i / NSUB; u.sub = i - it * NSUB; u.ui = it;
        const long L = (long)it * G + c; if (L >= nwg) return false;
        int wgid = (int)L; { const int q = nwg / NXCD, r = nwg % NXCD, xcd = wgid % NXCD, off = wgid / NXCD; wgid = (xcd < r ? xcd * (q + 1) : r * (q + 1) + (xcd - r) * q) + off; }
        const int nig = WGM * nN, gid = wgid / nig, fm = gid * WGM, gsz = (nM - fm) < WGM ? (nM - fm) : WGM;
        u.pm = fm + ((wgid % nig) % gsz); u.pn = (wgid % nig) / gsz; return true;
    }
};

template <int NSUB = 1, class Epi>
__device__ __forceinline__ void gemm_phase(PG8_LAS unsigned char* lds, const int tid, const Gemm g, const StaticOrder& S, const Epi& E) {
    const int wid = __builtin_amdgcn_readfirstlane(tid >> 6), lane = tid & 63, wr = wid >> 2, wc = wid & 3, fr = lane & 15, fq = lane >> 4;
    const int K = g.K, nt = K / BK;
    unsigned voffA[2], voffB[2];
#pragma unroll
    for (int i = 0; i < 2; ++i) { int R, C; stage_rc(tid * 16 + i * 8192, R, C); const int Rb = ((R & ~31) + perm32(R & 31));
        voffA[i] = (unsigned)(R * K + C) * 2u; voffB[i] = (unsigned)(Rb * K + C) * 2u; }
    const size_t kstep = (size_t)(BK * 2);
    const size_t hstep = (size_t)HALF * K * 2;
    const size_t tstep = 2 * hstep;
    const unsigned ldsw = (unsigned)wid * 1024u;
    const int aoff = lds_byte(wr * 64 + fr, fq * 8), boff = lds_byte(wc * 32 + fr, fq * 8);
#define PG8_SA(b, h) (((b) * 2 + (h)) * HTB)
#define PG8_SB(b, h) ((4 + (b) * 2 + (h)) * HTB)
#define PG8_STAGE(bufoff, gbase, voff) do { _Pragma("unroll") for (int _i = 0; _i < 2; ++_i) \
        __builtin_amdgcn_global_load_lds((const unsigned*)((const char*)(gbase) + (voff)[_i]), (PG8_LAS unsigned*)(lds + (bufoff) + ldsw + _i * 8192), 16, 0, 0); } while (0)
#define PG8_LDA(dst, b, h) do { _Pragma("unroll") for (int m = 0; m < 4; ++m) _Pragma("unroll") for (int k = 0; k < 2; ++k) dst[m][k] = *(const PG8_LAS bf16x8*)(lds + PG8_SA(b, h) + aoff + m * 2048 + k * 1024); } while (0)
#define PG8_LDB(dst, b, h) do { _Pragma("unroll") for (int n = 0; n < 2; ++n) _Pragma("unroll") for (int k = 0; k < 2; ++k) dst[n][k] = *(const PG8_LAS bf16x8*)(lds + PG8_SB(b, h) + boff + n * 2048 + k * 1024); } while (0)
#define PG8_MMA(ai, bj, At, Bt) do { __builtin_amdgcn_s_setprio(1); _Pragma("unroll") for (int m = 0; m < 4; ++m) _Pragma("unroll") for (int n = 0; n < 2; ++n) _Pragma("unroll") for (int k = 0; k < 2; ++k) \
        acc[ai][bj][m][n] = __builtin_amdgcn_mfma_f32_16x16x32_bf16(Bt[n][k], At[m][k], acc[ai][bj][m][n], 0, 0, 0); __builtin_amdgcn_s_setprio(0); } while (0)
#define PG8_WAIT_V(n) asm volatile("s_waitcnt vmcnt(" #n ")" ::: "memory")
#define PG8_WAIT_L(n) asm volatile("s_waitcnt lgkmcnt(" #n ")" ::: "memory")
#define PG8_BAR __builtin_amdgcn_s_barrier()
#define PG8_SCHED __builtin_amdgcn_sched_barrier(0)
    Unit cur, nxt; int ui = 0;
    if (!S.template next<NSUB>(0, cur)) return;
    f32x4 acc[2][2][4][2];
#pragma unroll
    for (int a = 0; a < 2; ++a)
#pragma unroll
        for (int b = 0; b < 2; ++b)
#pragma unroll
            for (int m = 0; m < 4; ++m)
#pragma unroll
                for (int n = 0; n < 2; ++n) acc[a][b][m][n] = (f32x4){0.f, 0.f, 0.f, 0.f};
    bf16x8 At[4][2], B0[2][2], B1[2][2];
    const char* cA = pickA(g, cur.sub) + (size_t)cur.pm * tstep; const char* cB = pickB(g, cur.sub) + (size_t)cur.pn * tstep;
    PG8_STAGE(PG8_SB(0, 0), cB, voffB); PG8_STAGE(PG8_SB(0, 1), cB + hstep, voffB); PG8_STAGE(PG8_SA(0, 0), cA, voffA); PG8_STAGE(PG8_SA(0, 1), cA + hstep, voffA);
    if (wr == 1) PG8_BAR;
    PG8_WAIT_V(2); PG8_BAR;
    PG8_STAGE(PG8_SB(1, 0), cB + kstep, voffB); PG8_STAGE(PG8_SA(1, 0), cA + kstep, voffA); PG8_STAGE(PG8_SB(1, 1), cB + hstep + kstep, voffB);
    PG8_WAIT_V(6); PG8_BAR;
    for (;;) {
        const bool has_next = S.template next<NSUB>(ui + 1, nxt);
        const char* nA = has_next ? pickA(g, nxt.sub) + (size_t)nxt.pm * tstep : cA; const char* nB = has_next ? pickB(g, nxt.sub) + (size_t)nxt.pn * tstep : cB;
        for (int t = 0; t < nt; t += 2) {
            const bool last = (t == nt - 2);
            const char* a1 = cA + (size_t)(t + 1) * kstep;
            const char* a2 = last ? nA : cA + (size_t)(t + 2) * kstep; const char* b2 = last ? nB : cB + (size_t)(t + 2) * kstep;
            const char* a3 = a2 + kstep; const char* b3 = b2 + kstep;
            PG8_LDB(B0, 0, 0); PG8_LDB(B1, 0, 1); PG8_SCHED; PG8_LDA(At, 0, 0); PG8_STAGE(PG8_SA(1, 1), a1 + hstep, voffA);
            PG8_WAIT_V(8); PG8_WAIT_L(0); PG8_BAR; PG8_MMA(0, 0, At, B0); PG8_MMA(0, 1, At, B1); PG8_BAR; PG8_SCHED;
            PG8_LDA(At, 0, 1); PG8_STAGE(PG8_SB(0, 0), b2, voffB); PG8_STAGE(PG8_SB(0, 1), b2 + hstep, voffB); PG8_STAGE(PG8_SA(0, 0), a2, voffA);
            PG8_WAIT_V(8); PG8_WAIT_L(0); PG8_BAR; PG8_MMA(1, 0, At, B0); PG8_MMA(1, 1, At, B1); PG8_BAR; PG8_SCHED;
            PG8_LDB(B0, 1, 0); PG8_LDB(B1, 1, 1); PG8_SCHED; PG8_LDA(At, 1, 0); PG8_STAGE(PG8_SA(0, 1), a2 + hstep, voffA);
            PG8_WAIT_V(8); PG8_WAIT_L(0); PG8_BAR; PG8_MMA(0, 0, At, B0); PG8_MMA(0, 1, At, B1); PG8_BAR; PG8_SCHED;
            PG8_LDA(At, 1, 1); PG8_STAGE(PG8_SB(1, 0), b3, voffB); PG8_STAGE(PG8_SB(1, 1), b3 + hstep, voffB); PG8_STAGE(PG8_SA(1, 0), a3, voffA);
            PG8_WAIT_V(8); PG8_WAIT_L(0); PG8_BAR; PG8_MMA(1, 0, At, B0); PG8_MMA(1, 1, At, B1); PG8_BAR; PG8_SCHED;
        }
        if (wr == 0) PG8_BAR;
        { int l_ = tid; asm volatile("" : "+v"(l_)); const int fr_ = l_ & 15, fq_ = (l_ >> 4) & 3;
          E(acc, cur, wr, wc, fr_, fq_); }
        if (!has_next) break;
        cur = nxt; cA = nA; cB = nB; ++ui;
        if (wr == 1) PG8_BAR;
    }
    PG8_WAIT_V(0);
    PG8_BAR;
#undef PG8_SA
#undef PG8_SB
#undef PG8_STAGE
#undef PG8_LDA
#undef PG8_LDB
#undef PG8_MMA
#undef PG8_WAIT_V
#undef PG8_WAIT_L
#undef PG8_BAR
#undef PG8_SCHED
}
}

namespace epi {
using pg8::Unit;
typedef f32x4 Acc[2][2][4][2];
#define ACC_ZERO(acc) do { _Pragma("unroll") for (int a_ = 0; a_ < 2; ++a_) _Pragma("unroll") for (int b_ = 0; b_ < 2; ++b_) _Pragma("unroll") for (int m_ = 0; m_ < 4; ++m_) \
    _Pragma("unroll") for (int n_ = 0; n_ < 2; ++n_) acc[a_][b_][m_][n_] = (f32x4){0.f, 0.f, 0.f, 0.f}; } while (0)

__device__ __forceinline__ float dot4(const f32x4 a) { return (a[0] * a[0] + a[1] * a[1]) + (a[2] * a[2] + a[3] * a[3]); }
__device__ __forceinline__ u32x4 pack8(const f32x4 a, const f32x4 b) { u32x4 w; w.x = cvt_pk_bf16(a[0], a[1]); w.y = cvt_pk_bf16(a[2], a[3]); w.z = cvt_pk_bf16(b[0], b[1]); w.w = cvt_pk_bf16(b[2], b[3]); return w; }
constexpr int EPI_RSTD_OFF = 132096, EPI_GAIN_OFF = EPI_RSTD_OFF + 8 * 256 * 4, EPI_ROPE_OFF = EPI_GAIN_OFF + 4 * 64 * 4, EPI_END = EPI_ROPE_OFF + 128;
__device__ __forceinline__ void fill_rstd_table(LAS unsigned char* lds0, const int tid, const float* ssq, const pg8::StaticOrder& S) {
    LAS float* tab = (LAS float*)(lds0 + EPI_RSTD_OFF);
    Unit u;
#pragma unroll 1
    for (int i = 0; i < 8 && S.next(i, u); ++i) {
        const int row = tid >> 1, half = tid & 1;
        const float* p = ssq + ((size_t)u.pm * 256 + row) * 16 + half * 8;
        const f32x4 a = *(const f32x4*)p, b = *(const f32x4*)(p + 4);
        float s = ((a[0] + a[1]) + (a[2] + a[3])) + ((b[0] + b[1]) + (b[2] + b[3])); s += __shfl_xor(s, 1);
        if (half == 0) tab[i * 256 + row] = __builtin_amdgcn_rsqf(s * (1.0f / DM) + EPS);
    }
}
__device__ __forceinline__ float row_rstd(const LAS float* tab, int ui, int lrow) { return tab[ui * 256 + lrow]; }

struct EpiNull {
    __device__ __forceinline__ void operator()(Acc& acc, const Unit& u, int wr, int wc, int fr, int fq) const {
#pragma unroll
        for (int ai = 0; ai < 2; ++ai)
#pragma unroll
            for (int bj = 0; bj < 2; ++bj)
#pragma unroll
                for (int m = 0; m < 4; ++m) { asm volatile("" : "+v"(acc[ai][bj][m][0]), "+v"(acc[ai][bj][m][1])); }
        ACC_ZERO(acc);
    }
};
struct EpiUp {
    bf16_t* H; const LAS float* rst;
    __device__ __forceinline__ void operator()(Acc& acc, const Unit& u, int wr, int wc, int fr, int fq) const {
#pragma unroll
        for (int ai = 0; ai < 2; ++ai)
#pragma unroll
            for (int m = 0; m < 4; ++m) {
                const int lrow = ai * 128 + wr * 64 + m * 16 + fr, row = u.pm * 256 + lrow;
                const float rs = row_rstd(rst, u.ui, lrow);
                f32x4 h0, h1;
#pragma unroll
                for (int j = 0; j < 4; ++j) { h0[j] = silu_f(acc[ai][0][m][0][j] * rs) * (acc[ai][1][m][0][j] * rs); h1[j] = silu_f(acc[ai][0][m][1][j] * rs) * (acc[ai][1][m][1][j] * rs); }
                *(u32x4*)(H + (size_t)row * DFF + u.pn * 128 + wc * 32 + 8 * fq) = pack8(h0, h1);
            }
        ACC_ZERO(acc);
    }
};

struct EpiRes {
    const float* xold; float* xnew; bf16_t* xb; float* ssq; float s;
    __device__ __forceinline__ void operator()(Acc& acc, const Unit& u, int wr, int wc, int fr, int fq) const {
#pragma unroll
        for (int ai = 0; ai < 2; ++ai) {
            f32x4 ov[4][2][2];
#pragma unroll
            for (int m = 0; m < 4; ++m)
#pragma unroll
                for (int bj = 0; bj < 2; ++bj) { const size_t off = (size_t)(u.pm * 256 + ai * 128 + wr * 64 + m * 16 + fr) * DM + u.pn * 256 + bj * 128 + wc * 32 + 8 * fq;
                    ov[m][bj][0] = *(const f32x4*)(xold + off); ov[m][bj][1] = *(const f32x4*)(xold + off + 4); }
            asm volatile("" ::: "memory");
#pragma unroll
            for (int m = 0; m < 4; ++m) {
                const int row = u.pm * 256 + ai * 128 + wr * 64 + m * 16 + fr; float ss = 0.f;
#pragma unroll
                for (int bj = 0; bj < 2; ++bj) {
                    const size_t off = (size_t)row * DM + u.pn * 256 + bj * 128 + wc * 32 + 8 * fq;
                    const f32x4 v0 = ov[m][bj][0] + acc[ai][bj][m][0] * s, v1 = ov[m][bj][1] + acc[ai][bj][m][1] * s;
                    *(f32x4*)(xnew + off) = v0; *(f32x4*)(xnew + off + 4) = v1;
                    *(u32x4*)(xb + off) = pack8(v0, v1);
                    ss += dot4(v0) + dot4(v1);
                }
                ss += __shfl_xor(ss, 16); ss += __shfl_xor(ss, 32);
                if (fq == 0) ssq[(size_t)row * 16 + u.pn * 4 + wc] = ss;
            }
            asm volatile("" ::: "memory");
        }
        ACC_ZERO(acc);
    }
};

struct EpiGate {
    bf16_t* G; const LAS float* rst;
    __device__ __forceinline__ void operator()(Acc& acc, const Unit& u, int wr, int wc, int fr, int fq) const {
#pragma unroll
        for (int ai = 0; ai < 2; ++ai)
#pragma unroll
            for (int m = 0; m < 4; ++m) {
                const int lrow = ai * 128 + wr * 64 + m * 16 + fr, row = u.pm * 256 + lrow;
                const float rs = row_rstd(rst, u.ui, lrow);
#pragma unroll
                for (int bj = 0; bj < 2; ++bj) { f32x4 g0, g1;
#pragma unroll
                    for (int j = 0; j < 4; ++j) { g0[j] = fmaxf(sigmoid_f(acc[ai][bj][m][0][j] * rs), 9.5367431640625e-07f); g1[j] = fmaxf(sigmoid_f(acc[ai][bj][m][1][j] * rs), 9.5367431640625e-07f); }
                    *(u32x4*)(G + (size_t)row * NGATE + u.pn * 256 + bj * 128 + wc * 32 + 8 * fq) = pack8(g0, g1); }
            }
        ACC_ZERO(acc);
    }
};

struct EpiMerge {
    const bf16_t* G; bf16_t* MG; const unsigned* ones;
    __device__ __forceinline__ void operator()(Acc& acc, const Unit& u, int wr, int wc, int fr, int fq) const {
        const int sub = u.sub; const bool chain = sub < 2;
        const char* gb = (const char*)(G + (size_t)u.pm * 256 * NGATE + sub * 1024 + u.pn * 256);
        const char* nb = chain ? gb + 2048 : (const char*)ones; const unsigned nmask = chain ? 0xffffffffu : 0u;
        const unsigned go = (unsigned)((wr * 64 + fr) * NGATE + wc * 32 + 8 * fq) * 2u;
#pragma unroll
        for (int ai = 0; ai < 2; ++ai)
#pragma unroll
            for (int mh = 0; mh < 2; ++mh) {
                u32x4 gc[2][2], gn[2][2];
#pragma unroll
                for (int m2 = 0; m2 < 2; ++m2)
#pragma unroll
                    for (int bj = 0; bj < 2; ++bj) { const unsigned o = go + (unsigned)(((ai * 128 + (2 * mh + m2) * 16) * NGATE + bj * 128) * 2);
                        gc[m2][bj] = *(const u32x4*)(gb + o); gn[m2][bj] = *(const u32x4*)(nb + (o & nmask)); }
                asm volatile("" ::: "memory");
#pragma unroll
                for (int m2 = 0; m2 < 2; ++m2)
#pragma unroll
                    for (int bj = 0; bj < 2; ++bj) { const u32x4 c = gc[m2][bj], n = gn[m2][bj]; const int m = 2 * mh + m2;
                        const f32x4 c0 = {bflo(c.x), bfhi(c.x), bflo(c.y), bfhi(c.y)}, c1 = {bflo(c.z), bfhi(c.z), bflo(c.w), bfhi(c.w)};
                        const f32x4 n0 = {bflo(n.x), bfhi(n.x), bflo(n.y), bfhi(n.y)}, n1 = {bflo(n.z), bfhi(n.z), bflo(n.w), bfhi(n.w)};
#pragma unroll
                        for (int j = 0; j < 4; ++j) { acc[ai][bj][m][0][j] *= c0[j] * fast_rcp(n0[j]); acc[ai][bj][m][1][j] *= c1[j] * fast_rcp(n1[j]); } }
                asm volatile("" ::: "memory");
            }
        if (!chain) {
            char* mb = (char*)(MG + (size_t)u.pm * 256 * DM + u.pn * 256);
            const unsigned mo = (unsigned)((wr * 64 + fr) * DM + wc * 32 + 8 * fq) * 2u;
#pragma unroll
            for (int ai = 0; ai < 2; ++ai)
#pragma unroll
                for (int m = 0; m < 4; ++m)
#pragma unroll
                    for (int bj = 0; bj < 2; ++bj)
                        *(u32x4*)(mb + mo + (unsigned)(((ai * 128 + m * 16) * DM + bj * 128) * 2)) = pack8(acc[ai][bj][m][0], acc[ai][bj][m][1]);
            ACC_ZERO(acc);
        }
    }
};

enum { F_NORM = 1, F_ROPE = 2, F_C2 = 4, F_CKD = 8, F_SILU = 16 };
struct EpiWin {
    unsigned char* ws; const LAS float* rst; const LAS float* gtab; const LAS float* rtab;
    __device__ __forceinline__ void operator()(Acc& acc, const Unit& u, int wr, int wc, int fr, int fq) const {
        const int pn = u.pn;
        size_t obase; int pitch, colbase, flags, gk = 0;
        if (pn < 2)       { obase = WS_AQ; pitch = 512; colbase = 256 * pn;        flags = F_NORM | F_ROPE | F_C2; gk = 0; }
        else if (pn < 4)  { obase = WS_AK; pitch = 512; colbase = 256 * (pn - 2);  flags = F_NORM | F_ROPE; gk = 1; }
        else if (pn < 6)  { obase = WS_AV; pitch = 512; colbase = 256 * (pn - 4);  flags = 0; }
        else if (pn < 8)  { obase = WS_BQ; pitch = 512; colbase = 256 * (pn - 6);  flags = F_NORM | F_C2; gk = 2; }
        else if (pn < 10) { obase = WS_BK; pitch = 512; colbase = 256 * (pn - 8);  flags = F_NORM; gk = 3; }
        else if (pn < 12) { obase = WS_BV; pitch = 512; colbase = 256 * (pn - 10); flags = 0; }
        else if (pn == 12) { obase = WS_CQ; pitch = 256; colbase = 0; flags = F_ROPE; }
        else if (pn == 13) { obase = WS_CK; pitch = 256; colbase = 0; flags = F_ROPE | F_CKD; }
        else if (pn < 16) { obase = WS_CV; pitch = 512; colbase = 256 * (pn - 14); flags = 0; }
        else              { obase = WS_CG; pitch = 512; colbase = 256 * (pn - 16); flags = F_SILU; }
        bf16_t* out = (bf16_t*)(ws + obase);
        f32x4 gA0 = {1.f, 1.f, 1.f, 1.f}, gA1 = gA0, gB0 = gA0, gB1 = gA0;
        if (flags & F_NORM) { const LAS float* gain = gtab + gk * 64; gA0 = *(const LAS f32x4*)(gain + 8 * fq); gA1 = *(const LAS f32x4*)(gain + 8 * fq + 4); gB0 = *(const LAS f32x4*)(gain + 32 + 8 * fq); gB1 = *(const LAS f32x4*)(gain + 36 + 8 * fq); }
        const f32x4 rc0 = *(const LAS f32x4*)(rtab + 8 * fq), rc1 = *(const LAS f32x4*)(rtab + 8 * fq + 4);
        const float l2g = __builtin_log2f(1.0f - __builtin_exp2f(-5.0f - (float)wc));
#pragma unroll
        for (int ai = 0; ai < 2; ++ai)
#pragma unroll
            for (int m = 0; m < 4; ++m) {
                const int lrow = ai * 128 + wr * 64 + m * 16 + fr, row = u.pm * 256 + lrow, t = row & (SEQ - 1);
                const float rs = row_rstd(rst, u.ui, lrow);
                f32x4 a0 = acc[ai][0][m][0] * rs, a1 = acc[ai][0][m][1] * rs, b0 = acc[ai][1][m][0] * rs, b1 = acc[ai][1][m][1] * rs;
                if (flags & F_NORM) {
                    float ss = (dot4(a0) + dot4(a1)) + (dot4(b0) + dot4(b1)); ss += __shfl_xor(ss, 16); ss += __shfl_xor(ss, 32);
                    const float r = __builtin_amdgcn_rsqf(ss * (1.0f / 64.0f) + EPS);
                    a0 = a0 * gA0 * r; a1 = a1 * gA1 * r; b0 = b0 * gB0 * r; b1 = b1 * gB1 * r;
                }
                if (flags & F_ROPE) {
                    const float tf = (float)t; f32x4 c0, c1, s0, s1;
#pragma unroll
                    for (int j = 0; j < 4; ++j) { const float r0 = __builtin_amdgcn_fractf(tf * rc0[j]), r1 = __builtin_amdgcn_fractf(tf * rc1[j]);
                        c0[j] = __builtin_amdgcn_cosf(r0); s0[j] = __builtin_amdgcn_sinf(r0); c1[j] = __builtin_amdgcn_cosf(r1); s1[j] = __builtin_amdgcn_sinf(r1); }
                    const f32x4 na0 = a0 * c0 - b0 * s0, nb0 = b0 * c0 + a0 * s0, na1 = a1 * c1 - b1 * s1, nb1 = b1 * c1 + a1 * s1;
                    a0 = na0; b0 = nb0; a1 = na1; b1 = nb1;
                }
                float sc = 1.0f;
                if (flags & F_C2) sc = C2;
                if (flags & F_CKD) sc = 0.125f * fast_exp2(-(float)(t & 63) * l2g);
                a0 = a0 * sc; a1 = a1 * sc; b0 = b0 * sc; b1 = b1 * sc;
                if (flags & F_SILU) {
#pragma unroll
                    for (int j = 0; j < 4; ++j) { a0[j] = silu_f(a0[j]); a1[j] = silu_f(a1[j]); b0[j] = silu_f(b0[j]); b1[j] = silu_f(b1[j]); }
                }
                bf16_t* o = out + (size_t)row * pitch + colbase + 64 * wc + 8 * fq;
                *(u32x4*)o = pack8(a0, a1); *(u32x4*)(o + 32) = pack8(b0, b1);
            }
        ACC_ZERO(acc);
    }
};
}

__device__ __forceinline__ float log2_gamma(int h) { return __builtin_amdgcn_logf(1.0f - __builtin_amdgcn_exp2f(-5.0f - (float)h)); }

namespace naive {
struct ANorm {
    const float* x; const float* gain; const LAS float* rs; int m0;
    __device__ __forceinline__ float get(int m, int k) const { return x[(size_t)m * DM + k] * rs[m - m0] * gain[k]; }
};
struct ABf {
    const bf16_t* a; int pitch;
    __device__ __forceinline__ float get(int m, int k) const { return bf2f(a[(size_t)m * pitch + k]); }
};
template <int NB, bool SHARED_A, bool NORM, int RT, class Epi>
__device__ __forceinline__ void gemm(LAS unsigned char* lds, const int tid, int vcu, int G, int N, int K,
                                     const float* x, const float* gain, const bf16_t* a0, const bf16_t* a1, const bf16_t* a2, int apitch,
                                     const float* w0, const float* w1, const float* w2, int ldb, const Epi& E) {
    constexpr int NA = SHARED_A ? 1 : NB;
    LAS float* As = (LAS float*)lds;
    LAS float* Bs = As + NA * 16 * 132;
    LAS float* rs = Bs + NB * 16 * 128;
    const int tx = tid & 15, ty = tid >> 4, lane = tid & 63, wave = tid >> 6;
    constexpr int TM = 32 * RT;
    const int ntn = N / 128, ntiles = (M / TM) * ntn;
    for (int tile = vcu; tile < ntiles; tile += G) {
        const int m0 = (tile / ntn) * TM, n0 = (tile % ntn) * 128;
        __syncthreads();
        if (NORM) {
            for (int r = wave * (TM / 8); r < wave * (TM / 8) + TM / 8; ++r) {
                const float* xr = x + (size_t)(m0 + r) * DM; float s = 0.f;
                for (int k = lane; k < DM; k += 64) { const float v = xr[k]; s += v * v; }
                s = wave_sum(s);
                if (lane == 0) rs[r] = 1.0f / sqrtf(s * (1.0f / DM) + EPS);
            }
            __syncthreads();
        }
        float acc[NB][RT][8];
#pragma unroll
        for (int b = 0; b < NB; ++b)
#pragma unroll
            for (int i = 0; i < RT; ++i)
#pragma unroll
                for (int j = 0; j < 8; ++j) acc[b][i][j] = 0.f;
        for (int k0 = 0; k0 < K; k0 += 16) {
            {
                const int r = tid >> 2, kq = (tid & 3) * 4;
                if (r < TM)
#pragma unroll
                for (int b = 0; b < NA; ++b)
#pragma unroll
                    for (int i = 0; i < 4; ++i) {
                        float v;
                        if (NORM) v = x[(size_t)(m0 + r) * DM + k0 + kq + i] * rs[r] * gain[k0 + kq + i];
                        else { const bf16_t* ap = (b == 0 ? a0 : (b == 1 ? a1 : a2)); v = bf2f(ap[(size_t)(m0 + r) * apitch + k0 + kq + i]); }
                        As[(b * 16 + kq + i) * 132 + r] = v;
                    }
                const int kb = tid >> 5, n4 = (tid & 31) * 4;
#pragma unroll
                for (int b = 0; b < NB; ++b) { const float* wp = (b == 0 ? w0 : (b == 1 ? w1 : w2));
                    const f32x4 v = *(const f32x4*)(wp + (size_t)(k0 + kb) * ldb + n0 + n4);
                    *(LAS f32x4*)(Bs + (b * 16 + kb) * 128 + n4) = v; }
            }
            __syncthreads();
#pragma unroll
            for (int kk = 0; kk < 16; ++kk) {
#pragma unroll
                for (int b = 0; b < NB; ++b) {
                    const int ab = SHARED_A ? 0 : b;
                    float av[RT];
#pragma unroll
                    for (int i = 0; i < RT; ++i) av[i] = As[(ab * 16 + kk) * 132 + ty * RT + i];
                    const f32x4 b0 = *(const LAS f32x4*)(Bs + (b * 16 + kk) * 128 + tx * 8), b1 = *(const LAS f32x4*)(Bs + (b * 16 + kk) * 128 + tx * 8 + 4);
#pragma unroll
                    for (int i = 0; i < RT; ++i)
#pragma unroll
                        for (int j = 0; j < 4; ++j) { acc[b][i][j] += av[i] * b0[j]; acc[b][i][4 + j] += av[i] * b1[j]; }
                }
            }
            __syncthreads();
        }
#pragma unroll
        for (int i = 0; i < RT; ++i) E(m0 + ty * RT + i, n0 + tx * 8, acc, i, tx);
    }
}

__device__ __forceinline__ void xb_ssq_pass(const float* x, bf16_t* xb, float* ssq, int gw, int ngw, int lane) {
    for (int m = gw; m < M; m += ngw) {
        const f32x4* xr = (const f32x4*)(x + (size_t)m * DM) + lane; float s = 0.f;
        u32x2* o = (u32x2*)(xb + (size_t)m * DM) + lane;
#pragma unroll
        for (int j = 0; j < 4; ++j) { const f32x4 v = xr[64 * j]; s += (v[0] * v[0] + v[1] * v[1]) + (v[2] * v[2] + v[3] * v[3]); u32x2 w; w.x = pk2(v[0], v[1]); w.y = pk2(v[2], v[3]); o[64 * j] = w; }
        s = wave_sum(s);
        if (lane < 16) ssq[(size_t)m * 16 + lane] = (lane == 0) ? s : 0.f;
    }
}

struct NEpiUp { bf16_t* H;
    __device__ __forceinline__ void operator()(int m, int n, const float (&acc)[2][4][8], int i, int tx) const {
#pragma unroll
        for (int j = 0; j < 8; ++j) { const float g = acc[0][i][j], u = acc[1][i][j]; H[(size_t)m * DFF + n + j] = (bf16_t)f2bf(g / (1.0f + expf(-g)) * u); } } };
struct NEpiRes { const float* xold; float* xnew; bf16_t* xb; float* ssq; float s;
    __device__ __forceinline__ void operator()(int m, int n, const float (&acc)[1][4][8], int i, int tx) const {
        float ss = 0.f;
#pragma unroll
        for (int j = 0; j < 8; ++j) { const float v = xold[(size_t)m * DM + n + j] + s * acc[0][i][j]; xnew[(size_t)m * DM + n + j] = v; xb[(size_t)m * DM + n + j] = (bf16_t)f2bf(v); ss += v * v; }
        ss += __shfl_xor(ss, 1); ss += __shfl_xor(ss, 2); ss += __shfl_xor(ss, 4); ss += __shfl_xor(ss, 8);
        if (tx == 0) { ssq[(size_t)m * 16 + (n >> 7)] = ss; ssq[(size_t)m * 16 + 8 + (n >> 7)] = 0.f; }
    } };
struct NEpiGate { bf16_t* G;
    __device__ __forceinline__ void operator()(int m, int n, const float (&acc)[1][4][8], int i, int tx) const {
#pragma unroll
        for (int j = 0; j < 8; ++j) G[(size_t)m * NGATE + n + j] = (bf16_t)f2bf(fmaxf(1.0f / (1.0f + expf(-acc[0][i][j])), 9.5367431640625e-07f)); } };
struct NEpiMerge { const bf16_t* G; bf16_t* MG;
    __device__ __forceinline__ void operator()(int m, int n, const float (&acc)[3][2][8], int i, int tx) const {
#pragma unroll
        for (int j = 0; j < 8; ++j) { const size_t go = (size_t)m * NGATE + n + j;
            const float v = bf2f(G[go]) * acc[0][i][j] + bf2f(G[go + 1024]) * acc[1][i][j] + bf2f(G[go + 2048]) * acc[2][i][j];
            MG[(size_t)m * DM + n + j] = (bf16_t)f2bf(v); } } };
struct NEpiWin { unsigned char* ws; const float* cosT; const float* sinT; const float *aqn, *akn, *bqn, *bkn;
    __device__ __forceinline__ void operator()(int m, int n, const float (&acc)[1][4][8], int i, int tx) const {
        size_t obase; int pitch, c0, flags; const float* gain = nullptr;
        if (n < 512)       { obase = WS_AQ; pitch = 512; c0 = 0;    flags = epi::F_NORM | epi::F_ROPE | epi::F_C2; gain = aqn; }
        else if (n < 1024) { obase = WS_AK; pitch = 512; c0 = 512;  flags = epi::F_NORM | epi::F_ROPE; gain = akn; }
        else if (n < 1536) { obase = WS_AV; pitch = 512; c0 = 1024; flags = 0; }
        else if (n < 2048) { obase = WS_BQ; pitch = 512; c0 = 1536; flags = epi::F_NORM | epi::F_C2; gain = bqn; }
        else if (n < 2560) { obase = WS_BK; pitch = 512; c0 = 2048; flags = epi::F_NORM; gain = bkn; }
        else if (n < 3072) { obase = WS_BV; pitch = 512; c0 = 2560; flags = 0; }
        else if (n < 3328) { obase = WS_CQ; pitch = 256; c0 = 3072; flags = epi::F_ROPE; }
        else if (n < 3584) { obase = WS_CK; pitch = 256; c0 = 3328; flags = epi::F_ROPE | epi::F_CKD; }
        else if (n < 4096) { obase = WS_CV; pitch = 512; c0 = 3584; flags = 0; }
        else               { obase = WS_CG; pitch = 512; c0 = 4096; flags = epi::F_SILU; }
        const int t = m & (SEQ - 1), d0 = n & 63; float v[8];
#pragma unroll
        for (int j = 0; j < 8; ++j) v[j] = acc[0][i][j];
        if (flags & epi::F_NORM) { float ss = 0.f;
#pragma unroll
            for (int j = 0; j < 8; ++j) ss += v[j] * v[j];
            ss += __shfl_xor(ss, 1); ss += __shfl_xor(ss, 2); ss += __shfl_xor(ss, 4);
            const float r = 1.0f / sqrtf(ss * (1.0f / 64.0f) + EPS);
#pragma unroll
            for (int j = 0; j < 8; ++j) v[j] = v[j] * r * gain[d0 + j]; }
        if (flags & epi::F_ROPE) {
#pragma unroll
            for (int j = 0; j < 8; ++j) { const float p = __shfl_xor(v[j], 4); const int d = d0 + j, ii = d & 31; const float c = cosT[t * 32 + ii], s = sinT[t * 32 + ii];
                v[j] = (d < 32) ? (v[j] * c - p * s) : (v[j] * c + p * s); } }
        float sc = 1.0f;
        if (flags & epi::F_C2) sc = C2;
        if (flags & epi::F_CKD) sc = 0.125f * exp2f(-(float)(t & 63) * log2_gamma((n - 3328) >> 6));
        bf16_t* o = (bf16_t*)(ws + obase) + (size_t)m * pitch + (n - c0);
#pragma unroll
        for (int j = 0; j < 8; ++j) { float y = v[j] * sc; if (flags & epi::F_SILU) y = y / (1.0f + expf(-y)); o[j] = (bf16_t)f2bf(y); }
    } };

__device__ __forceinline__ void attn_a(unsigned char* ws, const float* lq1, const float* lk1, const float* lq2, const float* lk2, const float* subln, float lam_init,
                                       LAS unsigned char* lds, int gw, int ngw, int wave, int lane) {
    const bf16_t* AQ = (const bf16_t*)(ws + WS_AQ); const bf16_t* AK = (const bf16_t*)(ws + WS_AK); const bf16_t* AV = (const bf16_t*)(ws + WS_AV); bf16_t* YA = (bf16_t*)(ws + WS_AQ);
    const float lam = expf(wave_sum(lq1[lane] * lk1[lane])) - expf(wave_sum(lq2[lane] * lk2[lane])) + lam_init;
    LAS float* qs = (LAS float*)lds + wave * 128;
    for (int task = gw; task < M * 4; task += ngw) {
        const int h = task & 3, m = task >> 2, b = m >> 13, t = m & (SEQ - 1), nch = (t >> 6) + 1;
        qs[lane] = bf2f(AQ[(size_t)m * 512 + h * 128 + lane]); qs[64 + lane] = bf2f(AQ[(size_t)m * 512 + h * 128 + 64 + lane]);
        LDS_WAIT(); asm volatile("" ::: "memory");
        float mx[2] = {-1e30f, -1e30f}, l[2] = {0.f, 0.f}, o[2][2] = {{0.f, 0.f}, {0.f, 0.f}};
        for (int c = 0; c < nch; ++c) {
            const size_t krow = (size_t)(b * SEQ + c * 64 + lane);
            float s[2] = {0.f, 0.f};
            for (int cc = 0; cc < 2; ++cc) { const u32x4* kp = (const u32x4*)(AK + krow * 512 + h * 128 + cc * 64);
                for (int q = 0; q < 8; ++q) { const u32x4 w = kp[q]; const LAS float* qq = qs + cc * 64 + q * 8;
                    s[cc] += bflo(w.x) * qq[0] + bfhi(w.x) * qq[1] + bflo(w.y) * qq[2] + bfhi(w.y) * qq[3] + bflo(w.z) * qq[4] + bfhi(w.z) * qq[5] + bflo(w.w) * qq[6] + bfhi(w.w) * qq[7]; } }
            float p[2];
            for (int cc = 0; cc < 2; ++cc) { const float mn = fmaxf(mx[cc], wave_max(s[cc])), f = exp2f(mx[cc] - mn); mx[cc] = mn; p[cc] = exp2f(s[cc] - mn);
                l[cc] = l[cc] * f + wave_sum(p[cc]); o[cc][0] *= f; o[cc][1] *= f; }
            for (int j = 0; j < 64; ++j) { const float p0 = __shfl(p[0], j), p1 = __shfl(p[1], j); const size_t vrow = (size_t)(b * SEQ + c * 64 + j) * 512 + h * 128;
                const float v0 = bf2f(AV[vrow + lane]), v1 = bf2f(AV[vrow + 64 + lane]);
                o[0][0] += p0 * v0; o[0][1] += p0 * v1; o[1][0] += p1 * v0; o[1][1] += p1 * v1; }
        }
        const float y0 = o[0][0] / l[0] - lam * o[1][0] / l[1], y1 = o[0][1] / l[0] - lam * o[1][1] / l[1];
        const float r = 1.0f / sqrtf(wave_sum(y0 * y0 + y1 * y1) * (1.0f / 128.0f) + EPS) * (1.0f - lam_init);
        YA[(size_t)m * 512 + h * 128 + lane] = (bf16_t)f2bf(y0 * r * subln[lane]); YA[(size_t)m * 512 + h * 128 + 64 + lane] = (bf16_t)f2bf(y1 * r * subln[64 + lane]);
        asm volatile("" ::: "memory");
    }
}
__device__ __forceinline__ void attn_b(unsigned char* ws, const float* relb, LAS unsigned char* lds, int gw, int ngw, int wave, int lane) {
    const bf16_t* BQ = (const bf16_t*)(ws + WS_BQ); const bf16_t* BK = (const bf16_t*)(ws + WS_BK); const bf16_t* BV = (const bf16_t*)(ws + WS_BV); bf16_t* YB = (bf16_t*)(ws + WS_BQ);
    LAS float* qs = (LAS float*)lds + wave * 128;
    for (int task = gw; task < M * 8; task += ngw) {
        const int h = task & 7, m = task >> 3, b = m >> 13, t = m & (SEQ - 1), n = t >> 6;
        qs[lane] = bf2f(BQ[(size_t)m * 512 + h * 64 + lane]);
        LDS_WAIT(); asm volatile("" ::: "memory");
        float mx = -1e30f, l = 0.f, o = 0.f;
        for (int c = (n >= 8 ? n - 8 : 0); c <= n; ++c) {
            const int kpos = c * 64 + lane; const size_t krow = (size_t)(b * SEQ + kpos);
            float s = 0.f; const u32x4* kp = (const u32x4*)(BK + krow * 512 + h * 64);
            for (int q = 0; q < 8; ++q) { const u32x4 w = kp[q]; const LAS float* qq = qs + q * 8;
                s += bflo(w.x) * qq[0] + bfhi(w.x) * qq[1] + bflo(w.y) * qq[2] + bfhi(w.y) * qq[3] + bflo(w.z) * qq[4] + bfhi(w.z) * qq[5] + bflo(w.w) * qq[6] + bfhi(w.w) * qq[7]; }
            int rel = t - kpos; rel = rel < -63 ? -63 : (rel > 256 ? 256 : rel);
            s += relb[h * 320 + rel + 63] * LOG2E;
            const float mn = fmaxf(mx, wave_max(s)), f = exp2f(mx - mn); mx = mn; const float p = exp2f(s - mn);
            l = l * f + wave_sum(p); o *= f;
            for (int j = 0; j < 64; ++j) o += __shfl(p, j) * bf2f(BV[(size_t)(b * SEQ + c * 64 + j) * 512 + h * 64 + lane]);
        }
        YB[(size_t)m * 512 + h * 64 + lane] = (bf16_t)f2bf(o / l);
        asm volatile("" ::: "memory");
    }
}
__device__ __forceinline__ void retention(unsigned char* ws, const float* onorm, LAS unsigned char* lds, int vcu, int G, int tid) {
    const bf16_t* CQ = (const bf16_t*)(ws + WS_CQ); const bf16_t* CK = (const bf16_t*)(ws + WS_CK); const bf16_t* CV = (const bf16_t*)(ws + WS_CV); bf16_t* CG = (bf16_t*)(ws + WS_CG);
    LAS float* qs = (LAS float*)lds; LAS float* ks = qs + 64 * 64; LAS float* vs = ks + 64 * 64; LAS float* os = vs + 64 * 128;
    for (int bh = vcu; bh < 8; bh += G) {
        const int b = bh >> 2, h = bh & 3; const float l2g = log2_gamma(h), gam = exp2f(l2g);
        float S[64];
#pragma unroll
        for (int d = 0; d < 64; ++d) S[d] = 0.f;
        for (int n = 0; n < SEQ / 64; ++n) {
            __syncthreads();
            for (int i = tid; i < 64 * 64; i += 512) { const int r = i >> 6, d = i & 63; const size_t row = (size_t)(b * SEQ + n * 64 + r);
                qs[i] = bf2f(CQ[row * 256 + h * 64 + d]); ks[i] = bf2f(CK[row * 256 + h * 64 + d]) * exp2f((float)r * l2g); }
            for (int i = tid; i < 64 * 128; i += 512) { const int r = i >> 7, e = i & 127; vs[i] = bf2f(CV[(size_t)(b * SEQ + n * 64 + r) * 512 + h * 128 + e]); }
            __syncthreads();
            if (tid < 128) {
                for (int r = 0; r < 64; ++r) { const float v = vs[r * 128 + tid]; float o = 0.f;
#pragma unroll
                    for (int d = 0; d < 64; ++d) { S[d] = gam * S[d] + ks[r * 64 + d] * v; o += qs[r * 64 + d] * S[d]; }
                    os[r * 128 + tid] = o; }
            }
            __syncthreads();
            { const int r = tid >> 3, e0 = (tid & 7) * 16; float ss = 0.f;
#pragma unroll
              for (int j = 0; j < 16; ++j) { const float v = os[r * 128 + e0 + j]; ss += v * v; }
              ss += __shfl_xor(ss, 1); ss += __shfl_xor(ss, 2); ss += __shfl_xor(ss, 4);
              const float rr = 1.0f / sqrtf(ss * (1.0f / 128.0f) + EPS); bf16_t* g = CG + (size_t)(b * SEQ + n * 64 + r) * 512 + h * 128 + e0;
#pragma unroll
              for (int j = 0; j < 16; ++j) g[j] = (bf16_t)f2bf(bf2f(g[j]) * os[r * 128 + e0 + j] * rr * onorm[h * 128 + e0 + j]); }
        }
    }
}
}

namespace fa {
typedef short s16x4 __attribute__((ext_vector_type(4)));
typedef short v4i16_t __attribute__((ext_vector_type(4)));
typedef LAS const unsigned char* lds_cptr;
constexpr int SLOTB = 32768, NSLOT = 3, KOFF = 0, VOFF = 16384;
constexpr int LDS_WS = NSLOT * SLOTB, LDS_BIAS = LDS_WS + 2048, LDS_END = LDS_BIAS + 2560;
constexpr float THR = 8.0f;
__device__ __forceinline__ int crow(int r, int hi) { return (r & 3) + 8 * (r >> 2) + 4 * hi; }
__device__ __forceinline__ void glds16(const void* gsrc, unsigned lds_dst) { unsigned keep;
    asm volatile("s_mov_b32 %0, m0\n\ts_mov_b32 m0, %2\n\ts_nop 0\n\tglobal_load_lds_dwordx4 %1, off\n\ts_mov_b32 m0, %0" : "=&s"(keep) : "v"(gsrc), "s"(lds_dst) : "memory"); }
#define FA_WAIT_BAR(N) asm volatile("s_waitcnt vmcnt(" #N ") lgkmcnt(0)\n\ts_barrier" ::: "memory")
#define FA_BAR() asm volatile("s_waitcnt lgkmcnt(0)\n\ts_barrier" ::: "memory")
__device__ __forceinline__ s16x4 vtr(lds_cptr p) { return __builtin_bit_cast(s16x4, __builtin_amdgcn_ds_read_tr16_b64_v4i16((LAS v4i16_t*)p)); }
__device__ __forceinline__ bf16x8 cat8(const s16x4 lo, const s16x4 hi) { return (bf16x8){lo[0], lo[1], lo[2], lo[3], hi[0], hi[1], hi[2], hi[3]}; }
__device__ __forceinline__ float swapmax(float m) { auto rr = __builtin_amdgcn_permlane32_swap(__float_as_uint(m), __float_as_uint(m), false, false); return fmaxf(__uint_as_float(rr[0]), __uint_as_float(rr[1])); }
__device__ __forceinline__ float swapsum(float m) { auto rr = __builtin_amdgcn_permlane32_swap(__float_as_uint(m), __float_as_uint(m), false, false); return __uint_as_float(rr[0]) + __uint_as_float(rr[1]); }
__device__ __forceinline__ bf16x8 pack_p(const f32x16& p, int base) { u32x4 w; w.x = cvt_pk_bf16(p[base], p[base + 1]); w.y = cvt_pk_bf16(p[base + 2], p[base + 3]); w.z = cvt_pk_bf16(p[base + 4], p[base + 5]); w.w = cvt_pk_bf16(p[base + 6], p[base + 7]); return __builtin_bit_cast(bf16x8, w); }
__device__ __forceinline__ float half_sum32(float v) {
#pragma unroll
    for (int o = 1; o < 32; o <<= 1) v += __shfl_xor(v, o);
    return v;
}

template <int MODE>
__device__ __forceinline__ void attn_unit(LAS unsigned char* lds, const int tid, const bf16_t* Qg, const bf16_t* Kg, const bf16_t* Vg, bf16_t* Yg, const int b, const int hq, const int u,
                                          const float lam, const float osc, const float* subln) {
    constexpr int PITCH = 512, NDB = (MODE == 0) ? 4 : 2;
    const int lane = tid & 63, r32 = lane & 31, hi = lane >> 5, wid = __builtin_amdgcn_readfirstlane(tid >> 6), ch = wid >> 2, wq = wid & 3;
    const int cw = 2 * u + (wq >> 1);
    const int t0 = (MODE == 0) ? 0 : ((2 * u - 8) > 0 ? (2 * u - 8) : 0), t1 = 2 * u + 1, NT = t1 - t0 + 1;
    const size_t rowbase = (size_t)b * SEQ;
    const bf16_t* Kb = Kg + rowbase * PITCH + hq * 128; const bf16_t* Vb = Vg + rowbase * PITCH + hq * 128;
    const unsigned lds0 = (unsigned)(uintptr_t)lds;
    LAS float* wsf = (LAS float*)(lds + LDS_WS) + wid * 64;
    const bf16_t* ksrc = Kb + (size_t)lane * PITCH + (2 * wid) * 8;
    const bf16_t* vsrc0 = Vb + (size_t)(16 * ((2 * wid) & 3) + (lane >> 2)) * PITCH + 32 * ((2 * wid) >> 2) + (lane & 3) * 8;
    const bf16_t* vsrc1 = Vb + (size_t)(16 * ((2 * wid + 1) & 3) + (lane >> 2)) * PITCH + 32 * ((2 * wid + 1) >> 2) + (lane & 3) * 8;
#define FA_DMA(t, slot) do { const size_t to_ = (size_t)(t) * 64 * PITCH; const unsigned sb_ = lds0 + (unsigned)(slot) * SLOTB; \
        glds16(ksrc + to_, (unsigned)__builtin_amdgcn_readfirstlane(sb_ + KOFF + (2 * wid) * 1024)); glds16(ksrc + to_ + 8, (unsigned)__builtin_amdgcn_readfirstlane(sb_ + KOFF + (2 * wid + 1) * 1024)); \
        glds16(vsrc0 + to_, (unsigned)__builtin_amdgcn_readfirstlane(sb_ + VOFF + (2 * wid) * 1024)); glds16(vsrc1 + to_, (unsigned)__builtin_amdgcn_readfirstlane(sb_ + VOFF + (2 * wid + 1) * 1024)); } while (0)
    FA_DMA(t0, 0);
    if (NT > 1) FA_DMA(t0 + 1, 1);
    const size_t qrow = rowbase + (size_t)u * 128 + wq * 32;
    bf16x8 qr[4];
#pragma unroll
    for (int i = 0; i < 4; ++i) qr[i] = *(const bf16x8*)(Qg + (qrow + r32) * PITCH + hq * 128 + ch * 64 + i * 16 + hi * 8);
    f32x16 o[NDB];
#pragma unroll
    for (int d = 0; d < NDB; ++d)
#pragma unroll
        for (int r = 0; r < 16; ++r) o[d][r] = 0.f;
    float mref = 0.f, lsum = 0.f; bool first = true;
    const lds_cptr kp0 = (lds_cptr)lds + KOFF + ch * 8192 + hi * 1024 + r32 * 16;
    const lds_cptr vp0 = (lds_cptr)lds + VOFF + ((MODE == 0) ? 0 : ch * 8192) + ((lane >> 4) & 1) * 32 + (lane & 3) * 8 + (4 * hi + ((lane & 15) >> 2)) * 64;
    int slot = 0;
    for (int i = 0; i < NT; ++i) {
        if (i + 1 < NT) FA_WAIT_BAR(4); else FA_WAIT_BAR(0);
        if (i + 2 < NT) { const int s2 = (slot == 0) ? 2 : slot - 1; FA_DMA(t0 + i + 2, s2); }
        const int t = t0 + i;
        const bool vis = (MODE == 0) ? (t <= cw) : (t <= cw && t + 8 >= cw);
        if (vis) {
            const lds_cptr kp = kp0 + slot * SLOTB; const lds_cptr vp = vp0 + slot * SLOTB;
            f32x16 p0, p1;
#pragma unroll
            for (int r = 0; r < 16; ++r) { p0[r] = 0.f; p1[r] = 0.f; }
#pragma unroll
            for (int k = 0; k < 4; ++k) {
                const bf16x8 ka = *(const LAS bf16x8*)(kp + k * 2048), kb = *(const LAS bf16x8*)(kp + k * 2048 + 512);
                p0 = __builtin_amdgcn_mfma_f32_32x32x16_bf16(ka, qr[k], p0, 0, 0, 0);
                p1 = __builtin_amdgcn_mfma_f32_32x32x16_bf16(kb, qr[k], p1, 0, 0, 0);
            }
            if (MODE == 1) {
                const LAS float* bt = (const LAS float*)(lds + LDS_BIAS) + ch * 320;
                const int relb = 64 * (cw - t) + 32 * (wq & 1) + r32 + 63;
                if (cw - t >= 5) { const float c = bt[319];
#pragma unroll
                    for (int r = 0; r < 16; ++r) { p0[r] += c; p1[r] += c; }
                } else {
#pragma unroll
                    for (int r = 0; r < 16; ++r) { const int i0 = relb - crow(r, hi), i1 = i0 - 32; p0[r] += bt[i0 > 319 ? 319 : i0]; p1[r] += bt[i1 > 319 ? 319 : i1]; }
                }
            }
            float rm = fmaxf(p0[0], p1[0]);
#pragma unroll
            for (int r = 1; r < 16; ++r) rm = fmaxf(rm, fmaxf(p0[r], p1[r]));
            rm = swapmax(rm);
            if (first) { mref = rm; first = false; }
            else if (__any(rm - mref > THR)) {
                const float dl = fmaxf(rm - mref, 0.f); mref += dl; const float f = fast_exp2(-dl); lsum *= f;
                if (hi == 0) wsf[r32] = f;
                LDS_WAIT();
#pragma unroll
                for (int r = 0; r < 16; ++r) { const float fr = wsf[crow(r, hi)];
#pragma unroll
                    for (int d = 0; d < NDB; ++d) o[d][r] *= fr; }
            }
            float sacc = 0.f;
#pragma unroll
            for (int r = 0; r < 16; ++r) { p0[r] = fast_exp2(p0[r] - mref); p1[r] = fast_exp2(p1[r] - mref); sacc += p0[r] + p1[r]; }
            lsum += sacc;
            const bf16x8 pa0 = pack_p(p0, 0), pa1 = pack_p(p0, 8), pa2 = pack_p(p1, 0), pa3 = pack_p(p1, 8);
#pragma unroll
            for (int d = 0; d < NDB; ++d) {
                const lds_cptr vd = vp + d * 4096;
                const bf16x8 v0 = cat8(vtr(vd), vtr(vd + 512)), v1 = cat8(vtr(vd + 1024), vtr(vd + 1024 + 512)), v2 = cat8(vtr(vd + 2048), vtr(vd + 2048 + 512)), v3 = cat8(vtr(vd + 3072), vtr(vd + 3072 + 512));
                o[d] = __builtin_amdgcn_mfma_f32_32x32x16_bf16(pa0, v0, o[d], 0, 0, 0);
                o[d] = __builtin_amdgcn_mfma_f32_32x32x16_bf16(pa1, v1, o[d], 0, 0, 0);
                o[d] = __builtin_amdgcn_mfma_f32_32x32x16_bf16(pa2, v2, o[d], 0, 0, 0);
                o[d] = __builtin_amdgcn_mfma_f32_32x32x16_bf16(pa3, v3, o[d], 0, 0, 0);
            }
        }
        slot = (slot == NSLOT - 1) ? 0 : slot + 1;
    }
    lsum = swapsum(lsum);
    if (hi == 0) wsf[32 + r32] = lsum;
    LDS_WAIT();
#pragma unroll
    for (int r = 0; r < 16; ++r) { const float il = fast_rcp(wsf[32 + crow(r, hi)]);
#pragma unroll
        for (int d = 0; d < NDB; ++d) o[d][r] *= il; }
    FA_BAR();
    if (MODE == 0) {
        LAS float* xf = (LAS float*)lds + (wid & 3) * 4096;
        if (ch == 1) {
#pragma unroll
            for (int d = 0; d < 4; ++d)
#pragma unroll
                for (int r = 0; r < 16; ++r) xf[(d * 16 + r) * 64 + lane] = o[d][r];
        }
        FA_BAR();
        if (ch == 0) {
            float ss[16];
#pragma unroll
            for (int r = 0; r < 16; ++r) ss[r] = 0.f;
#pragma unroll
            for (int d = 0; d < 4; ++d)
#pragma unroll
                for (int r = 0; r < 16; ++r) { const float y = o[d][r] - lam * xf[(d * 16 + r) * 64 + lane]; o[d][r] = y; ss[r] += y * y; }
            LAS bf16_t* stg = (LAS bf16_t*)(lds + 65536) + wid * 4096;
            float g[4];
#pragma unroll
            for (int d = 0; d < 4; ++d) g[d] = subln[32 * d + r32] * osc;
#pragma unroll
            for (int r = 0; r < 16; ++r) { const float rs = __builtin_amdgcn_rsqf(half_sum32(ss[r]) * (1.0f / 128.0f) + EPS); const int orow = crow(r, hi);
#pragma unroll
                for (int d = 0; d < 4; ++d) stg[orow * 128 + d * 32 + r32] = (bf16_t)f2bf(o[d][r] * rs * g[d]); }
            LDS_WAIT();
#pragma unroll
            for (int i = 0; i < 8; ++i) { const int idx = i * 64 + lane, row = idx >> 4, c8 = idx & 15;
                const u32x4 v = *(const LAS u32x4*)(stg + row * 128 + c8 * 8);
                *(u32x4*)(Yg + (qrow + row) * PITCH + hq * 128 + c8 * 8) = v; }
        }
    } else {
        LAS bf16_t* stg = (LAS bf16_t*)lds + wid * 2048;
#pragma unroll
        for (int r = 0; r < 16; ++r) { const int orow = crow(r, hi);
#pragma unroll
            for (int d = 0; d < 2; ++d) stg[orow * 64 + d * 32 + r32] = (bf16_t)f2bf(o[d][r]); }
        LDS_WAIT();
#pragma unroll
        for (int i = 0; i < 4; ++i) { const int idx = i * 64 + lane, row = idx >> 3, c8 = idx & 7;
            const u32x4 v = *(const LAS u32x4*)(stg + row * 64 + c8 * 8);
            *(u32x4*)(Yg + (qrow + row) * PITCH + hq * 128 + ch * 64 + c8 * 8) = v; }
    }
    FA_BAR();
#undef FA_DMA
}

constexpr int NSLOT2 = 4, LDS_WS2 = 132096, LDS_BIAS2 = LDS_WS2 + 2048;
template <int MODE>
__device__ __forceinline__ void attn_unit2(LAS unsigned char* lds, const int tid_, const bf16_t* Qg, const bf16_t* Kg, const bf16_t* Vg, bf16_t* Yg, const int b, const int hq, const int u,
                                           const float lam, const float osc, const float* subln) {
    constexpr int PITCH = 512, NDB = (MODE == 0) ? 4 : 2;
    int tid = tid_; asm volatile("" : "+v"(tid));
    const int lane = tid & 63, r32 = lane & 31, hi = lane >> 5, wid = __builtin_amdgcn_readfirstlane(tid >> 6), ch = wid >> 2, wq = wid & 3;
    const int cw = 2 * u + (wq >> 1);
    const int t0 = (MODE == 0) ? 0 : ((2 * u - 8) > 0 ? (2 * u - 8) : 0), t1 = 2 * u + 1, NT = t1 - t0 + 1;
    const int iv1 = cw - t0, iv0 = (MODE == 0) ? 0 : ((cw - 8 - t0) > 0 ? (cw - 8 - t0) : 0);
    const size_t rowbase = (size_t)b * SEQ;
    const bf16_t* Kb = Kg + rowbase * PITCH + hq * 128; const bf16_t* Vb = Vg + rowbase * PITCH + hq * 128;
    const unsigned lds0 = (unsigned)(uintptr_t)lds;
    LAS float* wsf = (LAS float*)(lds + LDS_WS2) + wid * 64;
    const bf16_t* ksrc = Kb + (size_t)lane * PITCH + (2 * wid) * 8;
    const bf16_t* vsrc0 = Vb + (size_t)(16 * ((2 * wid) & 3) + (lane >> 2)) * PITCH + 32 * ((2 * wid) >> 2) + (lane & 3) * 8;
    const bf16_t* vsrc1 = Vb + (size_t)(16 * ((2 * wid + 1) & 3) + (lane >> 2)) * PITCH + 32 * ((2 * wid + 1) >> 2) + (lane & 3) * 8;
#define FA_DMA(t, slot) do { const size_t to_ = (size_t)(t) * 64 * PITCH; const unsigned sb_ = lds0 + (unsigned)(slot) * SLOTB; \
        glds16(ksrc + to_, (unsigned)__builtin_amdgcn_readfirstlane(sb_ + KOFF + (2 * wid) * 1024)); glds16(ksrc + to_ + 8, (unsigned)__builtin_amdgcn_readfirstlane(sb_ + KOFF + (2 * wid + 1) * 1024)); \
        glds16(vsrc0 + to_, (unsigned)__builtin_amdgcn_readfirstlane(sb_ + VOFF + (2 * wid) * 1024)); glds16(vsrc1 + to_, (unsigned)__builtin_amdgcn_readfirstlane(sb_ + VOFF + (2 * wid + 1) * 1024)); } while (0)
    FA_DMA(t0, 0);
    FA_DMA(t0 + 1, 1);
    const size_t qrow = rowbase + (size_t)u * 128 + wq * 32;
    bf16x8 qr[4];
#pragma unroll
    for (int i = 0; i < 4; ++i) qr[i] = *(const bf16x8*)(Qg + (qrow + r32) * PITCH + hq * 128 + ch * 64 + i * 16 + hi * 8);
    f32x16 o[NDB];
#pragma unroll
    for (int d = 0; d < NDB; ++d)
#pragma unroll
        for (int r = 0; r < 16; ++r) o[d][r] = 0.f;
    float mref = 0.f, lsum = 0.f; bool first = true;
    const lds_cptr kp0 = (lds_cptr)lds + KOFF + ch * 8192 + hi * 1024 + r32 * 16;
    const lds_cptr vp0 = (lds_cptr)lds + VOFF + ((MODE == 0) ? 0 : ch * 8192) + ((lane >> 4) & 1) * 32 + (lane & 3) * 8 + (4 * hi + ((lane & 15) >> 2)) * 64;
    f32x16 p0, p1; bf16x8 pa0, pa1, pa2, pa3;
#pragma unroll
    for (int r = 0; r < 16; ++r) { p0[r] = 0.f; p1[r] = 0.f; }
    pa0 = pa1 = pa2 = pa3 = (bf16x8){0, 0, 0, 0, 0, 0, 0, 0};
#define FA_QK(i_) do { const lds_cptr kp = kp0 + ((i_) & 3) * SLOTB; bf16x8 kf[8]; \
        _Pragma("unroll") for (int k = 0; k < 4; ++k) { kf[2 * k] = *(const LAS bf16x8*)(kp + k * 2048); kf[2 * k + 1] = *(const LAS bf16x8*)(kp + k * 2048 + 512); } \
        _Pragma("unroll") for (int r = 0; r < 16; ++r) { p0[r] = 0.f; p1[r] = 0.f; } \
        _Pragma("unroll") for (int k = 0; k < 4; ++k) { p0 = __builtin_amdgcn_mfma_f32_32x32x16_bf16(kf[2 * k], qr[k], p0, 0, 0, 0); p1 = __builtin_amdgcn_mfma_f32_32x32x16_bf16(kf[2 * k + 1], qr[k], p1, 0, 0, 0); } \
        if (MODE == 1) { const int t = t0 + (i_); const LAS float* bt = (const LAS float*)(lds + LDS_BIAS2) + ch * 320; const int relb = 64 * (cw - t) + 32 * (wq & 1) + r32 + 63; \
            if (cw - t >= 5) { const float c = bt[319]; _Pragma("unroll") for (int r = 0; r < 16; ++r) { p0[r] += c; p1[r] += c; } } \
            else { _Pragma("unroll") for (int r = 0; r < 16; ++r) { const int i0 = relb - crow(r, hi), i1 = i0 - 32; p0[r] += bt[i0 > 319 ? 319 : i0]; p1[r] += bt[i1 > 319 ? 319 : i1]; } } } } while (0)
#define FA_SM() do { float rm = fmaxf(p0[0], p1[0]); _Pragma("unroll") for (int r = 1; r < 16; ++r) rm = fmaxf(rm, fmaxf(p0[r], p1[r])); rm = swapmax(rm); \
        if (first) { mref = rm; first = false; } \
        else if (__any(rm - mref > THR)) { const float dl = fmaxf(rm - mref, 0.f); mref += dl; const float f = fast_exp2(-dl); lsum *= f; if (hi == 0) wsf[r32] = f; LDS_WAIT(); \
            _Pragma("unroll") for (int r = 0; r < 16; ++r) { const float fr = wsf[crow(r, hi)]; _Pragma("unroll") for (int d = 0; d < NDB; ++d) o[d][r] *= fr; } } \
        float sacc = 0.f; _Pragma("unroll") for (int r = 0; r < 16; ++r) { p0[r] = fast_exp2(p0[r] - mref); p1[r] = fast_exp2(p1[r] - mref); sacc += p0[r] + p1[r]; } lsum += sacc; \
        pa0 = pack_p(p0, 0); pa1 = pack_p(p0, 8); pa2 = pack_p(p1, 0); pa3 = pack_p(p1, 8); } while (0)
#define FA_VLD(dst, vd) do { dst[0] = cat8(vtr(vd), vtr((vd) + 512)); dst[1] = cat8(vtr((vd) + 1024), vtr((vd) + 1024 + 512)); dst[2] = cat8(vtr((vd) + 2048), vtr((vd) + 2048 + 512)); dst[3] = cat8(vtr((vd) + 3072), vtr((vd) + 3072 + 512)); } while (0)
#define FA_PV(i_) do { const lds_cptr vp = vp0 + ((i_) & 3) * SLOTB; \
        _Pragma("unroll") for (int d = 0; d < NDB; ++d) { bf16x8 va[4]; FA_VLD(va, vp + d * 4096); \
            o[d] = __builtin_amdgcn_mfma_f32_32x32x16_bf16(pa0, va[0], o[d], 0, 0, 0); o[d] = __builtin_amdgcn_mfma_f32_32x32x16_bf16(pa1, va[1], o[d], 0, 0, 0); \
            o[d] = __builtin_amdgcn_mfma_f32_32x32x16_bf16(pa2, va[2], o[d], 0, 0, 0); o[d] = __builtin_amdgcn_mfma_f32_32x32x16_bf16(pa3, va[3], o[d], 0, 0, 0); } } while (0)
    if (ch == 0) {
        FA_WAIT_BAR(4);
        if (NT > 2) FA_DMA(t0 + 2, 2);
        if (iv0 == 0) { FA_QK(0); FA_SM(); }
        for (int i = 1; i < NT; ++i) {
            if (i + 1 < NT) FA_WAIT_BAR(4); else FA_WAIT_BAR(0);
            if (i + 2 < NT) FA_DMA(t0 + i + 2, (i + 2) & 3);
            if ((i - 1 >= iv0) && (i - 1 <= iv1)) FA_PV(i - 1);
            if ((i >= iv0) && (i <= iv1)) { FA_QK(i); FA_SM(); }
        }
        if (NT - 1 <= iv1) FA_PV(NT - 1);
    } else {
        FA_WAIT_BAR(4);
        if (NT > 2) FA_DMA(t0 + 2, 2);
        if (iv0 == 0) FA_QK(0);
        for (int i = 1; i < NT; ++i) {
            if (i + 1 < NT) FA_WAIT_BAR(4); else FA_WAIT_BAR(0);
            if (i + 2 < NT) FA_DMA(t0 + i + 2, (i + 2) & 3);
            if ((i - 1 >= iv0) && (i - 1 <= iv1)) { FA_SM(); FA_PV(i - 1); }
            if ((i >= iv0) && (i <= iv1)) FA_QK(i);
        }
        if (NT - 1 <= iv1) { FA_SM(); FA_PV(NT - 1); }
    }
#undef FA_QK
#undef FA_SM
#undef FA_VLD
#undef FA_PV
    lsum = swapsum(lsum);
    if (hi == 0) wsf[32 + r32] = lsum;
    LDS_WAIT();
#pragma unroll
    for (int r = 0; r < 16; ++r) { const float il = fast_rcp(wsf[32 + crow(r, hi)]);
#pragma unroll
        for (int d = 0; d < NDB; ++d) o[d][r] *= il; }
    FA_BAR();
    if (MODE == 0) {
        LAS float* xf = (LAS float*)lds + (wid & 3) * 4096;
        if (ch == 1) {
#pragma unroll
            for (int d = 0; d < 4; ++d)
#pragma unroll
                for (int r = 0; r < 16; ++r) xf[(d * 16 + r) * 64 + lane] = o[d][r];
        }
        FA_BAR();
        if (ch == 0) {
            float ss[16];
#pragma unroll
            for (int r = 0; r < 16; ++r) ss[r] = 0.f;
#pragma unroll
            for (int d = 0; d < 4; ++d)
#pragma unroll
                for (int r = 0; r < 16; ++r) { const float y = o[d][r] - lam * xf[(d * 16 + r) * 64 + lane]; o[d][r] = y; ss[r] += y * y; }
            LAS bf16_t* stg = (LAS bf16_t*)(lds + 65536) + wid * 4096;
            float g[4];
#pragma unroll
            for (int d = 0; d < 4; ++d) g[d] = subln[32 * d + r32] * osc;
#pragma unroll
            for (int r = 0; r < 16; ++r) { const float rs = __builtin_amdgcn_rsqf(half_sum32(ss[r]) * (1.0f / 128.0f) + EPS); const int orow = crow(r, hi);
#pragma unroll
                for (int d = 0; d < 4; ++d) stg[orow * 128 + d * 32 + r32] = (bf16_t)f2bf(o[d][r] * rs * g[d]); }
            LDS_WAIT();
#pragma unroll
            for (int i = 0; i < 8; ++i) { const int idx = i * 64 + lane, row = idx >> 4, c8 = idx & 15;
                const u32x4 v = *(const LAS u32x4*)(stg + row * 128 + c8 * 8);
                *(u32x4*)(Yg + (qrow + row) * PITCH + hq * 128 + c8 * 8) = v; }
        }
    } else {
        LAS bf16_t* stg = (LAS bf16_t*)lds + wid * 2048;
#pragma unroll
        for (int r = 0; r < 16; ++r) { const int orow = crow(r, hi);
#pragma unroll
            for (int d = 0; d < 2; ++d) stg[orow * 64 + d * 32 + r32] = (bf16_t)f2bf(o[d][r]); }
        LDS_WAIT();
#pragma unroll
        for (int i = 0; i < 4; ++i) { const int idx = i * 64 + lane, row = idx >> 3, c8 = idx & 7;
            const u32x4 v = *(const LAS u32x4*)(stg + row * 64 + c8 * 8);
            *(u32x4*)(Yg + (qrow + row) * PITCH + hq * 128 + ch * 64 + c8 * 8) = v; }
    }
    FA_BAR();
#undef FA_DMA
}

#if FA_V2
#define FA_UNIT attn_unit2
#else
#define FA_UNIT attn_unit
#endif
__device__ __forceinline__ void attn_a_phase(LAS unsigned char* lds, const int tid, unsigned char* ws, bf16_t* yout, const int vcu, const int G, const float* lq1, const float* lk1, const float* lq2, const float* lk2,
                                             const float* subln, const float lam_init) {
    const int lane = tid & 63;
    const float lam = expf(wave_sum(lq1[lane] * lk1[lane])) - expf(wave_sum(lq2[lane] * lk2[lane])) + lam_init;
    for (int v = vcu; v < 256; v += G) {
        const int bh = v >> 5, p = v & 31;
        FA_UNIT<0>(lds, tid, (const bf16_t*)(ws + WS_AQ), (const bf16_t*)(ws + WS_AK), (const bf16_t*)(ws + WS_AV), yout, bh >> 2, bh & 3, p, lam, 1.0f - lam_init, subln);
        FA_UNIT<0>(lds, tid, (const bf16_t*)(ws + WS_AQ), (const bf16_t*)(ws + WS_AK), (const bf16_t*)(ws + WS_AV), yout, bh >> 2, bh & 3, 63 - p, lam, 1.0f - lam_init, subln);
    }
}
__device__ __forceinline__ void attn_b_phase(LAS unsigned char* lds, const int tid, unsigned char* ws, bf16_t* yout, const int vcu, const int G, const float* relb) {
    for (int v = vcu; v < 256; v += G) {
        const int bp = v >> 5, b = bp >> 2, hp = bp & 3;
        LAS float* bt = (LAS float*)(lds + (FA_V2 ? LDS_BIAS2 : LDS_BIAS));
        for (int i = tid; i < 640; i += 512) bt[i] = relb[(2 * hp) * 320 + i] * LOG2E;
        FA_BAR();
        FA_UNIT<1>(lds, tid, (const bf16_t*)(ws + WS_BQ), (const bf16_t*)(ws + WS_BK), (const bf16_t*)(ws + WS_BV), yout, b, hp, 2 * (v & 31), 0.f, 0.f, nullptr);
        FA_UNIT<1>(lds, tid, (const bf16_t*)(ws + WS_BQ), (const bf16_t*)(ws + WS_BK), (const bf16_t*)(ws + WS_BV), yout, b, hp, 2 * (v & 31) + 1, 0.f, 0.f, nullptr);
    }
}

__device__ __forceinline__ void ret_kv_phase(LAS unsigned char* lds, const int tid_, unsigned char* ws, const int gw, const int ngw) {
    int tid = tid_; asm volatile("" : "+v"(tid));
    const int lane = tid & 63, r32 = lane & 31, hi = lane >> 5, wid = __builtin_amdgcn_readfirstlane(tid >> 6);
    const bf16_t* CK = (const bf16_t*)(ws + WS_CK); const bf16_t* CV = (const bf16_t*)(ws + WS_CV); float* KVT = (float*)(ws + WS_R4);
    LAS unsigned char* wl = lds + wid * 16384; const unsigned wl0 = (unsigned)(uintptr_t)wl;
    const lds_cptr tp0 = (lds_cptr)wl + ((lane >> 4) & 1) * 32 + (lane & 3) * 8 + (4 * hi + ((lane & 15) >> 2)) * 64;
    for (int task = gw; task < 2048; task += ngw) {
        const int eh = task & 1, n = (task >> 1) & 127, bh = task >> 8, b = bh >> 2, h = bh & 3;
        const size_t row0 = (size_t)b * SEQ + n * 64;
#pragma unroll
        for (int p = 0; p < 8; ++p) {
            glds16(CK + (row0 + 16 * (p & 3) + (lane >> 2)) * 256 + h * 64 + 32 * (p >> 2) + (lane & 3) * 8, (unsigned)__builtin_amdgcn_readfirstlane(wl0 + p * 1024));
            glds16(CV + (row0 + 16 * (p & 3) + (lane >> 2)) * 512 + h * 128 + eh * 64 + 32 * (p >> 2) + (lane & 3) * 8, (unsigned)__builtin_amdgcn_readfirstlane(wl0 + 8192 + p * 1024));
        }
        asm volatile("s_waitcnt vmcnt(0)" ::: "memory");
#pragma unroll
        for (int eb = 0; eb < 2; ++eb)
#pragma unroll
            for (int db = 0; db < 2; ++db) {
                f32x16 acc;
#pragma unroll
                for (int r = 0; r < 16; ++r) acc[r] = 0.f;
#pragma unroll
                for (int s = 0; s < 4; ++s) {
                    const lds_cptr va = tp0 + 8192 + (eb * 4 + s) * 1024, ka = tp0 + (db * 4 + s) * 1024;
                    acc = __builtin_amdgcn_mfma_f32_32x32x16_bf16(cat8(vtr(va), vtr(va + 512)), cat8(vtr(ka), vtr(ka + 512)), acc, 0, 0, 0);
                }
                float* dst = KVT + ((size_t)(bh * 128 + n) * 128 + eh * 64 + eb * 32) * 64 + db * 32 + r32;
#pragma unroll
                for (int r = 0; r < 16; ++r) dst[(size_t)crow(r, hi) * 64] = acc[r];
            }
        LDS_WAIT(); asm volatile("" ::: "memory");
    }
}
__device__ __forceinline__ void ret_scan_phase(const int tid, unsigned char* ws, const int vcu, const int G) {
    float* KVT = (float*)(ws + WS_R4);
    for (int gt = vcu * 512 + tid; gt < 65536; gt += G * 512) {
        const int bh = gt >> 13, idx = gt & 8191, h = bh & 3;
        const float l2g = log2_gamma(h), gam = fast_exp2(l2g), g63 = fast_exp2(63.f * l2g), g64 = fast_exp2(64.f * l2g);
        float* p = KVT + (size_t)bh * 128 * 8192 + idx; float s = 0.f;
        for (int n0 = 0; n0 < 128; n0 += 16) {
            float kv[16];
#pragma unroll
            for (int j = 0; j < 16; ++j) kv[j] = p[(size_t)(n0 + j) * 8192];
#pragma unroll
            for (int j = 0; j < 16; ++j) { p[(size_t)(n0 + j) * 8192] = gam * s; s = g64 * s + g63 * kv[j]; }
        }
    }
}
__device__ __forceinline__ void ret_out_phase(LAS unsigned char* lds, const int tid_, unsigned char* ws, const int gw, const int ngw, const float* onorm) {
    int tid = tid_; asm volatile("" : "+v"(tid));
    const int lane = tid & 63, r32 = lane & 31, hi = lane >> 5, wid = __builtin_amdgcn_readfirstlane(tid >> 6);
    const bf16_t* CQ = (const bf16_t*)(ws + WS_CQ); const bf16_t* CK = (const bf16_t*)(ws + WS_CK); const bf16_t* CV = (const bf16_t*)(ws + WS_CV); bf16_t* CG = (bf16_t*)(ws + WS_CG);
    const float* KVT = (const float*)(ws + WS_R4);
    LAS unsigned char* wl = lds + wid * 16384; const unsigned wl0 = (unsigned)(uintptr_t)wl;
    const lds_cptr tp0 = (lds_cptr)wl + ((lane >> 4) & 1) * 32 + (lane & 3) * 8 + (4 * hi + ((lane & 15) >> 2)) * 64;
    for (int task = gw; task < 2048; task += ngw) {
        const int rh = task & 1, n = (task >> 1) & 127, bh = task >> 8, b = bh >> 2, h = bh & 3;
        const size_t row0 = (size_t)b * SEQ + n * 64;
        const float l2g = log2_gamma(h);
#pragma unroll
        for (int p = 0; p < 16; ++p)
            glds16(CV + (row0 + 16 * (p & 3) + (lane >> 2)) * 512 + h * 128 + 32 * (p >> 2) + (lane & 3) * 8, (unsigned)__builtin_amdgcn_readfirstlane(wl0 + p * 1024));
        bf16x8 qr[4], kf[8];
#pragma unroll
        for (int i = 0; i < 4; ++i) {
            qr[i] = *(const bf16x8*)(CQ + (row0 + 32 * rh + r32) * 256 + h * 64 + i * 16 + hi * 8);
            kf[2 * i] = *(const bf16x8*)(CK + (row0 + r32) * 256 + h * 64 + i * 16 + hi * 8);
            kf[2 * i + 1] = *(const bf16x8*)(CK + (row0 + 32 + r32) * 256 + h * 64 + i * 16 + hi * 8);
        }
        f32x16 p0, p1;
#pragma unroll
        for (int r = 0; r < 16; ++r) { p0[r] = 0.f; p1[r] = 0.f; }
#pragma unroll
        for (int i = 0; i < 4; ++i) { p0 = __builtin_amdgcn_mfma_f32_32x32x16_bf16(kf[2 * i], qr[i], p0, 0, 0, 0); p1 = __builtin_amdgcn_mfma_f32_32x32x16_bf16(kf[2 * i + 1], qr[i], p1, 0, 0, 0); }
        const int qi = 32 * rh + r32;
#pragma unroll
        for (int r = 0; r < 16; ++r) { const int key = crow(r, hi); if (key > qi) p0[r] = 0.f; if (key + 32 > qi) p1[r] = 0.f; }
        const bf16x8 pa0 = pack_p(p0, 0), pa1 = pack_p(p0, 8), pa2 = pack_p(p1, 0), pa3 = pack_p(p1, 8);
        asm volatile("s_waitcnt vmcnt(0)" ::: "memory");
        const float* st = KVT + (size_t)(bh * 128 + n) * 8192;
        f32x16 o[4];
#pragma unroll
        for (int d = 0; d < 4; ++d) {
            const lds_cptr vd = tp0 + d * 4096;
            f32x16 a;
#pragma unroll
            for (int r = 0; r < 16; ++r) a[r] = 0.f;
            a = __builtin_amdgcn_mfma_f32_32x32x16_bf16(pa0, cat8(vtr(vd), vtr(vd + 512)), a, 0, 0, 0);
            a = __builtin_amdgcn_mfma_f32_32x32x16_bf16(pa1, cat8(vtr(vd + 1024), vtr(vd + 1024 + 512)), a, 0, 0, 0);
            a = __builtin_amdgcn_mfma_f32_32x32x16_bf16(pa2, cat8(vtr(vd + 2048), vtr(vd + 2048 + 512)), a, 0, 0, 0);
            a = __builtin_amdgcn_mfma_f32_32x32x16_bf16(pa3, cat8(vtr(vd + 3072), vtr(vd + 3072 + 512)), a, 0, 0, 0);
#pragma unroll
            for (int i = 0; i < 4; ++i) {
                const f32x4 s0 = *(const f32x4*)(st + (size_t)(32 * d + r32) * 64 + i * 16 + hi * 8), s1 = *(const f32x4*)(st + (size_t)(32 * d + r32) * 64 + i * 16 + hi * 8 + 4);
                a = __builtin_amdgcn_mfma_f32_32x32x16_bf16(qr[i], __builtin_bit_cast(bf16x8, epi::pack8(s0, s1)), a, 0, 0, 0);
            }
            o[d] = a;
        }
        LDS_WAIT(); asm volatile("" ::: "memory");
        LAS float* stg = (LAS float*)wl;
        float gn[4];
#pragma unroll
        for (int d = 0; d < 4; ++d) gn[d] = onorm[h * 128 + 32 * d + r32];
#pragma unroll
        for (int r = 0; r < 16; ++r) {
            const float dec = fast_exp2((float)(32 * rh + crow(r, hi)) * l2g);
            float ss = 0.f;
#pragma unroll
            for (int d = 0; d < 4; ++d) { o[d][r] *= dec; ss += o[d][r] * o[d][r]; }
            const float rs = __builtin_amdgcn_rsqf(half_sum32(ss) * (1.0f / 128.0f) + EPS);
#pragma unroll
            for (int d = 0; d < 4; ++d) stg[crow(r, hi) * 128 + d * 32 + r32] = o[d][r] * rs * gn[d];
        }
        LDS_WAIT(); asm volatile("" ::: "memory");
#pragma unroll
        for (int i = 0; i < 8; ++i) { const int idx = i * 64 + lane, row = idx >> 4, c8 = idx & 15;
            const f32x4 y0 = *(const LAS f32x4*)(stg + row * 128 + c8 * 8), y1 = *(const LAS f32x4*)(stg + row * 128 + c8 * 8 + 4);
            bf16_t* gp = CG + (row0 + 32 * rh + row) * 512 + h * 128 + c8 * 8;
            const u32x4 gv = *(const u32x4*)gp;
            const f32x4 g0 = {bflo(gv.x), bfhi(gv.x), bflo(gv.y), bfhi(gv.y)}, g1 = {bflo(gv.z), bfhi(gv.z), bflo(gv.w), bfhi(gv.w)};
            *(u32x4*)gp = epi::pack8(y0 * g0, y1 * g1); }
        LDS_WAIT(); asm volatile("" ::: "memory");
    }
}
}
#define XB_TMO      128
#define XB_XCNT(j)  (256  + 64 * (j))
#define XB_XSUB(j)  (1280 + 64 * (j))
#define XB_XGEN(j)  (2304 + 64 * (j))
#define XB_TOP      3328
#define XB_TOPGEN   3392
#define XCD_BAR_WORDS 3456
#define XB_SPIN_CAP (1u << 18)

__device__ __forceinline__ unsigned xb_ld(unsigned* p)              { return __hip_atomic_load(p, __ATOMIC_RELAXED, __HIP_MEMORY_SCOPE_AGENT); }
__device__ __forceinline__ unsigned xb_add(unsigned* p, unsigned v) { return __hip_atomic_fetch_add(p, v, __ATOMIC_RELAXED, __HIP_MEMORY_SCOPE_AGENT); }
__device__ __forceinline__ unsigned xb_xcc_id() { return (unsigned)__builtin_amdgcn_s_getreg((3 << 11) | 20) & 0xFu; }
#define XB_SPIN(cond, bar) do { unsigned _sp = 0; while (cond) { __builtin_amdgcn_s_sleep(1); \
    if ((++_sp & 255u) == 0u) { if (xb_ld(&(bar)[XB_TMO])) break; if (_sp > XB_SPIN_CAP) { atomicAdd(&(bar)[XB_TMO], 1u); break; } } } } while (0)

struct XcdBarrier {
    unsigned* bar; unsigned x;
    volatile LAS unsigned* st;
};

__device__ __forceinline__ XcdBarrier xcd_barrier_post(unsigned* bar, volatile LAS unsigned* st) {
    XcdBarrier b; b.bar = bar; b.x = xb_xcc_id(); b.st = st;
    if (threadIdx.x == 0) (void)xb_add(&bar[XB_XCNT(b.x)], 1u);
    return b;
}
__device__ __forceinline__ void xcd_barrier_complete(unsigned* bar, unsigned x, unsigned& nloc, unsigned& nx) {
    const unsigned G = gridDim.x * gridDim.y * gridDim.z;
    unsigned sum, cnt, mine, sp = 0u;
    for (;;) {
        sum = 0u; cnt = 0u; mine = 0u;
#pragma unroll
        for (unsigned j = 0; j < 16; ++j) { const unsigned c = xb_ld(&bar[XB_XCNT(j)]); sum += c; cnt += (c > 0u) ? 1u : 0u; mine = (j == x) ? c : mine; }
        if (sum == G) break;
        __builtin_amdgcn_s_sleep(1);
        if ((++sp & 255u) == 0u) { if (xb_ld(&bar[XB_TMO])) break; if (sp > XB_SPIN_CAP) { atomicAdd(&bar[XB_TMO], 1u); break; } }
    }
    nloc = mine > 0u ? mine : 1u; nx = cnt > 0u ? cnt : 1u;
}

__device__ __forceinline__ void xcd_barrier(const XcdBarrier& b) {
    asm volatile("s_waitcnt vmcnt(0)" ::: "memory");
    __syncthreads();
    if (threadIdx.x == 0) {
        unsigned* bar = b.bar;
        __builtin_amdgcn_s_waitcnt(0);
        unsigned nloc = b.st[0], nx = b.st[1];
        if (nloc == 0u) { xcd_barrier_complete(bar, b.x, nloc, nx); b.st[0] = nloc; b.st[1] = nx; }
        const unsigned old = xb_add(&bar[XB_XSUB(b.x)], 1u);
        const unsigned gen = old / nloc;
        if (old + 1u == (gen + 1u) * nloc) {
            __builtin_amdgcn_fence(__ATOMIC_RELEASE, "agent");
            asm volatile("s_waitcnt vmcnt(0)" ::: "memory");
            const unsigned og = xb_add(&bar[XB_TOP], 1u);
            const unsigned tg = og / nx;
            if (og + 1u == (tg + 1u) * nx) xb_add(&bar[XB_TOPGEN], 1u);
            else XB_SPIN(xb_ld(&bar[XB_TOPGEN]) == tg, bar);
            __builtin_amdgcn_fence(__ATOMIC_ACQUIRE, "agent");
            xb_add(&bar[XB_XGEN(b.x)], 1u);
            asm volatile("s_waitcnt vmcnt(0)" ::: "memory");
        } else {
            XB_SPIN(xb_ld(&bar[XB_XGEN(b.x)]) == gen, bar);
            __builtin_amdgcn_fence(__ATOMIC_ACQUIRE, "agent");
            asm volatile("s_waitcnt vmcnt(0)" ::: "memory");
        }
    }
    __syncthreads();
}

constexpr int NWAVES = 8;
constexpr int RING_OFF = 0, RING_BYTES = 131072;
constexpr int LDSCTL_OFF = RING_BYTES, MISC_OFF = LDSCTL_OFF + 320;
constexpr int LDS_BYTES = 147456;
constexpr int CW_TMO = 0, CW_CODE = 1, CW_BAR = 4096;
constexpr int N_PHASES = 1 + 12 * DEPTH;

#define CAS __attribute__((address_space(4)))
struct Args { const GAS float* in[N_IN]; GAS float* out; GAS unsigned char* ws; double ropec[32]; float lam_init[2]; };

template <class T> __device__ __forceinline__ T* as_global(GAS T* p) { return (T*)p; }
__device__ __forceinline__ int conv_dst_row(int mode, int row_off, int n0) {
    if (mode == 0) return row_off + n0;
    if (mode == 1) return 256 * (n0 >> 7) + (n0 & 127) + row_off;
    return (n0 < NIN1) ? ((n0 & ~255) + 128 * ((n0 >> 5) & 1) + 32 * ((n0 >> 6) & 3)) : n0;
}
__device__ __forceinline__ void conv_item(const float* W, const float* gain, int K, int N, bf16_t* WT, int mode, int row_off, LAS float* scr, int item, int lane) {
    const int nblk = N / 32, kb = item / nblk, nb = item % nblk, k0 = 64 * kb, n0 = 32 * nb;
#pragma unroll 8
    for (int i = 0; i < 32; ++i) { const int kk = 2 * i + (lane >> 5); float v = W[(size_t)(k0 + kk) * N + n0 + (lane & 31)]; if (gain) v *= gain[k0 + kk]; scr[kk * 33 + (lane & 31)] = v; }
    LDS_WAIT(); asm volatile("" ::: "memory");
    const int c = lane & 7, drow = conv_dst_row(mode, row_off, n0);
#pragma unroll
    for (int j = 0; j < 4; ++j) { const int n = (lane >> 3) + 8 * j; const LAS float* s = scr + (8 * c) * 33 + n;
        u32x4 o; o.x = pk2(s[0 * 33], s[1 * 33]); o.y = pk2(s[2 * 33], s[3 * 33]); o.z = pk2(s[4 * 33], s[5 * 33]); o.w = pk2(s[6 * 33], s[7 * 33]);
        *(GAS u32x4*)(WT + (size_t)(drow + n) * K + k0 + 8 * c) = o; }
    LDS_WAIT(); asm volatile("" ::: "memory");
}
__device__ __forceinline__ void convert_layer(const CAS Args& a, unsigned char* ws, int l, LAS unsigned char* lds, int gw, int ngw, int wave, int lane) {
    LAS float* scr = (LAS float*)(lds + wave * 16384);
    unsigned char* wb = ws + WS_W;
    constexpr int I_GU = (DM / 64) * (DFF / 32), I_D = (DFF / 64) * (DM / 32), I_IN = (DM / 64) * (NIN / 32), I_BR = (512 / 64) * (DM / 32), I_O = (DM / 64) * (DM / 32);
    constexpr int NITEMS = 4 * I_GU + 2 * I_D + I_IN + 3 * I_BR + I_O;
    const size_t oGU = (size_t)l * DM * DFF, oD = (size_t)l * DFF * DM, oIN = (size_t)l * DM * NIN, oBR = (size_t)l * 512 * DM, oO = (size_t)l * DM * DM;
    for (int it = gw; it < NITEMS; it += ngw) {
        int r = it;
        if (r < I_GU) { conv_item(as_global(a.in[I_F1G]) + oGU, as_global(a.in[I_F1N]) + l * DM, DM, DFF, (bf16_t*)(wb + W_GU1), 1, 0, scr, r, lane); continue; } r -= I_GU;
        if (r < I_GU) { conv_item(as_global(a.in[I_F1U]) + oGU, as_global(a.in[I_F1N]) + l * DM, DM, DFF, (bf16_t*)(wb + W_GU1), 1, 128, scr, r, lane); continue; } r -= I_GU;
        if (r < I_D)  { conv_item(as_global(a.in[I_F1D]) + oD, nullptr, DFF, DM, (bf16_t*)(wb + W_D1), 0, 0, scr, r, lane); continue; } r -= I_D;
        if (r < I_IN) { conv_item(as_global(a.in[I_WIN]) + oIN, as_global(a.in[I_MIXN]) + l * DM, DM, NIN, (bf16_t*)(wb + W_IN), 2, 0, scr, r, lane); continue; } r -= I_IN;
        if (r < I_BR) { conv_item(as_global(a.in[I_WBA]) + oBR, nullptr, 512, DM, (bf16_t*)(wb + W_BR), 0, 0, scr, r, lane); continue; } r -= I_BR;
        if (r < I_BR) { conv_item(as_global(a.in[I_WBB]) + oBR, nullptr, 512, DM, (bf16_t*)(wb + W_BR), 0, DM, scr, r, lane); continue; } r -= I_BR;
        if (r < I_BR) { conv_item(as_global(a.in[I_WBC]) + oBR, nullptr, 512, DM, (bf16_t*)(wb + W_BR), 0, 2 * DM, scr, r, lane); continue; } r -= I_BR;
        if (r < I_O)  { conv_item(as_global(a.in[I_WOUT]) + oO, nullptr, DM, DM, (bf16_t*)(wb + W_OUT), 0, 0, scr, r, lane); continue; } r -= I_O;
        if (r < I_GU) { conv_item(as_global(a.in[I_F2G]) + oGU, as_global(a.in[I_F2N]) + l * DM, DM, DFF, (bf16_t*)(wb + W_GU2), 1, 0, scr, r, lane); continue; } r -= I_GU;
        if (r < I_GU) { conv_item(as_global(a.in[I_F2U]) + oGU, as_global(a.in[I_F2N]) + l * DM, DM, DFF, (bf16_t*)(wb + W_GU2), 1, 128, scr, r, lane); continue; } r -= I_GU;
        conv_item(as_global(a.in[I_F2D]) + oD, nullptr, DFF, DM, (bf16_t*)(wb + W_D2), 0, 0, scr, r, lane);
    }
}
__device__ __forceinline__ void rope_tables(const CAS Args& a, unsigned char* ws, int gtid, int ngt) {
    float* cosT = (float*)(ws + WS_COS); float* sinT = (float*)(ws + WS_SIN);
    for (int i = gtid; i < SEQ * 32; i += ngt) { const int t = i >> 5, k = i & 31;
        const double rev = (double)t * a.ropec[k]; const float fr = (float)(rev - floor(rev));
        cosT[i] = __builtin_amdgcn_cosf(fr); sinT[i] = __builtin_amdgcn_sinf(fr); }
}

struct Ctx { LAS unsigned char* lds; int tid, lane, wave, vcu, G, bx, gw, ngw; unsigned char* ws; float* X; const CAS Args* ap; };
enum { K_PRO = 0, K_CONV, K_UP, K_DOWN, K_WIN, K_KV, K_SCAN, K_MIX, K_GATE, K_MERGE, K_WOUT, N_KINDS };
__host__ __device__ __forceinline__ void phase_decode(int ph, int& kind, int& l, int& ffn2) {
    if (ph == 0) { kind = K_PRO; l = 0; ffn2 = 0; return; }
    const int k = (ph - 1) % 12; l = (ph - 1) / 12; ffn2 = (k >= 10);
    const int tab[12] = {K_CONV, K_UP, K_DOWN, K_WIN, K_KV, K_SCAN, K_MIX, K_GATE, K_MERGE, K_WOUT, K_UP, K_DOWN};
    kind = (k == 0) ? K_CONV : (k == 1 || k == 10) ? K_UP : (k == 2 || k == 11) ? K_DOWN : (k == 3) ? K_WIN : (k == 4) ? K_KV : (k == 5) ? K_SCAN : (k == 6) ? K_MIX : (k == 7) ? K_GATE : (k == 8) ? K_MERGE : K_WOUT;
    (void)tab;
}
template <int KIND>
__device__ __forceinline__ void phase_body(const Ctx& c, const int l, const int ffn2) {
    const CAS Args& args = *c.ap; unsigned char* ws = c.ws; float* X = c.X; LAS unsigned char* lds = c.lds;
    const int tid = c.tid, lane = c.lane, wave = c.wave, vcu = c.vcu, G = c.G, bx = c.bx, gw = c.gw, ngw = c.ngw;
    bf16_t* XB = (bf16_t*)(ws + WS_XB); float* SSQ = (float*)(ws + WS_SSQ);
    const float* cosT = (const float*)(ws + WS_COS); const float* sinT = (const float*)(ws + WS_SIN);
    unsigned char* wb = ws + WS_W;
    (void)tid; (void)lane; (void)wave; (void)vcu; (void)G; (void)bx; (void)gw; (void)ngw; (void)XB; (void)SSQ; (void)cosT; (void)sinT; (void)wb; (void)X; (void)lds;
    if constexpr (KIND == K_PRO) {
        rope_tables(args, ws, (vcu * NWAVES * 64) + tid, G * NWAVES * 64);
        if (bx == 0 && tid < 4) ((unsigned*)(ws + WS_ONES))[tid] = 0x3f803f80u;
        naive::xb_ssq_pass(as_global(args.in[I_X]), XB, SSQ, gw, ngw, lane);
        convert_layer(args, ws, 0, lds, gw, ngw, wave, lane);
    } else if constexpr (KIND == K_CONV) {
        if (l > 0) convert_layer(args, ws, l, lds, gw, ngw, wave, lane);
    } else if constexpr (KIND == K_UP) {
#if NAIVE_UP
        const float* xin = (l == 0 && !ffn2) ? as_global(args.in[I_X]) : X;
        naive::gemm<2, true, true, 4>(lds, tid, vcu, G, DFF, DM, xin, (ffn2 ? as_global(args.in[I_F2N]) : as_global(args.in[I_F1N])) + l * DM, nullptr, nullptr, nullptr, 0,
                                   (ffn2 ? as_global(args.in[I_F2G]) : as_global(args.in[I_F1G])) + (size_t)l * DM * DFF, (ffn2 ? as_global(args.in[I_F2U]) : as_global(args.in[I_F1U])) + (size_t)l * DM * DFF, nullptr, DFF, naive::NEpiUp{(bf16_t*)(ws + WS_HB)});
#else
        pg8::Gemm g{XB, (const bf16_t*)(wb + (ffn2 ? W_GU2 : W_GU1)), DM, 0, 0};
        pg8::StaticOrder S; S.init(M, 2 * DFF, G, bx);
        epi::fill_rstd_table(lds, tid, SSQ, S); __syncthreads();
        pg8::gemm_phase(lds + RING_OFF, tid, g, S, epi::EpiUp{(bf16_t*)(ws + WS_HB), (const LAS float*)(lds + epi::EPI_RSTD_OFF)});
#endif
    } else if constexpr (KIND == K_DOWN) {
        const float* xold = (l == 0 && !ffn2) ? as_global(args.in[I_X]) : X;
#if NAIVE_DOWN
        naive::gemm<1, true, false, 4>(lds, tid, vcu, G, DM, DFF, nullptr, nullptr, (const bf16_t*)(ws + WS_HB), nullptr, nullptr, DFF,
                                    (ffn2 ? as_global(args.in[I_F2D]) : as_global(args.in[I_F1D])) + (size_t)l * DFF * DM, nullptr, nullptr, DM, naive::NEpiRes{xold, X, XB, SSQ, 0.5f});
#else
        pg8::Gemm g{(const bf16_t*)(ws + WS_HB), (const bf16_t*)(wb + (ffn2 ? W_D2 : W_D1)), DFF, 0, 0};
        pg8::StaticOrder S; S.init(M, DM, G, bx);
        pg8::gemm_phase(lds + RING_OFF, tid, g, S, epi::EpiRes{xold, X, XB, SSQ, 0.5f});
#endif
    } else if constexpr (KIND == K_WIN) {
#if NAIVE_WIN
        naive::gemm<1, true, true, 4>(lds, tid, vcu, G, NIN1, DM, X, as_global(args.in[I_MIXN]) + l * DM, nullptr, nullptr, nullptr, 0,
                                   as_global(args.in[I_WIN]) + (size_t)l * DM * NIN, nullptr, nullptr, NIN,
                                   naive::NEpiWin{ws, cosT, sinT, as_global(args.in[I_AQN]) + l * 64, as_global(args.in[I_AKN]) + l * 64, as_global(args.in[I_BQN]) + l * 64, as_global(args.in[I_BKN]) + l * 64});
#else
        pg8::Gemm g{XB, (const bf16_t*)(wb + W_IN), DM, 0, 0};
        pg8::StaticOrder S; S.init(M, NIN1, G, bx);
        epi::fill_rstd_table(lds, tid, SSQ, S);
        { LAS float* gt = (LAS float*)(lds + epi::EPI_GAIN_OFF); LAS float* rt = (LAS float*)(lds + epi::EPI_ROPE_OFF);
          if (tid < 256) { const int kq = tid >> 6; const float* gp = (kq == 0) ? as_global(args.in[I_AQN]) : (kq == 1) ? as_global(args.in[I_AKN]) : (kq == 2) ? as_global(args.in[I_BQN]) : as_global(args.in[I_BKN]); gt[tid] = gp[l * 64 + (tid & 63)]; }
          else if (tid < 288) rt[tid - 256] = (float)args.ropec[tid - 256]; }
        __syncthreads();
        pg8::gemm_phase(lds + RING_OFF, tid, g, S, epi::EpiWin{ws, (const LAS float*)(lds + epi::EPI_RSTD_OFF), (const LAS float*)(lds + epi::EPI_GAIN_OFF), (const LAS float*)(lds + epi::EPI_ROPE_OFF)});
#endif
    } else if constexpr (KIND == K_KV) {
#if !NAIVE_C
        fa::ret_kv_phase(lds, tid, ws, gw, ngw);
#endif
    } else if constexpr (KIND == K_SCAN) {
#if !NAIVE_C
        fa::ret_scan_phase(tid, ws, vcu, G);
#endif
    } else if constexpr (KIND == K_MIX) {
#if NAIVE_C
        naive::retention(ws, as_global(args.in[I_CON]) + l * 512, lds, vcu, G, tid);
#else
        fa::ret_out_phase(lds, tid, ws, gw, ngw, as_global(args.in[I_CON]) + l * 512);
#endif
        __syncthreads();
#if NAIVE_B
        naive::attn_b(ws, as_global(args.in[I_BREL]) + l * 8 * 320, lds, gw, ngw, wave, lane);
#else
#if PROBE_B
        for (int rep = 0; rep < PROBE_B; ++rep) { fa::attn_b_phase(lds, tid, ws, (bf16_t*)(ws + WS_W), vcu, G, as_global(args.in[I_BREL]) + l * 8 * 320); __syncthreads(); }
#endif
        fa::attn_b_phase(lds, tid, ws, (bf16_t*)(ws + WS_BQ), vcu, G, as_global(args.in[I_BREL]) + l * 8 * 320);
#endif
        __syncthreads();
#if NAIVE_A
        naive::attn_a(ws, as_global(args.in[I_LQ1]) + l * 64, as_global(args.in[I_LK1]) + l * 64, as_global(args.in[I_LQ2]) + l * 64, as_global(args.in[I_LK2]) + l * 64, as_global(args.in[I_ASUB]) + l * 128, (l == 0 ? args.lam_init[0] : args.lam_init[1]), lds, gw, ngw, wave, lane);
#else
#if PROBE_A
        for (int rep = 0; rep < PROBE_A; ++rep) { fa::attn_a_phase(lds, tid, ws, (bf16_t*)(ws + WS_W), vcu, G, as_global(args.in[I_LQ1]) + l * 64, as_global(args.in[I_LK1]) + l * 64, as_global(args.in[I_LQ2]) + l * 64, as_global(args.in[I_LK2]) + l * 64, as_global(args.in[I_ASUB]) + l * 128, (l == 0 ? args.lam_init[0] : args.lam_init[1])); __syncthreads(); }
#endif
        fa::attn_a_phase(lds, tid, ws, (bf16_t*)(ws + WS_AQ), vcu, G, as_global(args.in[I_LQ1]) + l * 64, as_global(args.in[I_LK1]) + l * 64, as_global(args.in[I_LQ2]) + l * 64, as_global(args.in[I_LK2]) + l * 64, as_global(args.in[I_ASUB]) + l * 128, (l == 0 ? args.lam_init[0] : args.lam_init[1]));
#endif
    } else if constexpr (KIND == K_GATE) {
#if NAIVE_GATE
        naive::gemm<1, true, true, 4>(lds, tid, vcu, G, NGATE, DM, X, as_global(args.in[I_MIXN]) + l * DM, nullptr, nullptr, nullptr, 0,
                                   as_global(args.in[I_WIN]) + (size_t)l * DM * NIN + NIN1, nullptr, nullptr, NIN, naive::NEpiGate{(bf16_t*)(ws + WS_GT)});
#else
        pg8::Gemm g{XB, (const bf16_t*)(wb + W_IN) + (size_t)NIN1 * DM, DM, 0, 0};
        pg8::StaticOrder S; S.init(M, NGATE, G, bx);
        epi::fill_rstd_table(lds, tid, SSQ, S); __syncthreads();
        pg8::gemm_phase(lds + RING_OFF, tid, g, S, epi::EpiGate{(bf16_t*)(ws + WS_GT), (const LAS float*)(lds + epi::EPI_RSTD_OFF)});
#endif
    } else if constexpr (KIND == K_MERGE) {
#if NAIVE_MERGE
        naive::gemm<3, false, false, 2>(lds, tid, vcu, G, DM, 512, nullptr, nullptr, (const bf16_t*)(ws + WS_AQ), (const bf16_t*)(ws + WS_BQ), (const bf16_t*)(ws + WS_CG), 512,
                                     as_global(args.in[I_WBA]) + (size_t)l * 512 * DM, as_global(args.in[I_WBB]) + (size_t)l * 512 * DM, as_global(args.in[I_WBC]) + (size_t)l * 512 * DM, DM,
                                     naive::NEpiMerge{(const bf16_t*)(ws + WS_GT), (bf16_t*)(ws + WS_MG)});
#else
        static_assert(WS_BQ - WS_AQ == P16 && WS_CG - WS_BQ == P16, "y_a, y_b, y_c equally spaced");
        pg8::Gemm g{(const bf16_t*)(ws + WS_AQ), (const bf16_t*)(wb + W_BR), 512, P16, (size_t)DM * 512 * 2};
        pg8::StaticOrder S; S.init(M, DM, G, bx);
        pg8::gemm_phase<3>(lds + RING_OFF, tid, g, S, epi::EpiMerge{(const bf16_t*)(ws + WS_GT), (bf16_t*)(ws + WS_MG), (const unsigned*)(ws + WS_ONES)});
#endif
    } else if constexpr (KIND == K_WOUT) {
#if NAIVE_WOUT
        naive::gemm<1, true, false, 4>(lds, tid, vcu, G, DM, DM, nullptr, nullptr, (const bf16_t*)(ws + WS_MG), nullptr, nullptr, DM,
                                    as_global(args.in[I_WOUT]) + (size_t)l * DM * DM, nullptr, nullptr, DM, naive::NEpiRes{X, X, XB, SSQ, 1.0f});
#else
        pg8::Gemm g{(const bf16_t*)(ws + WS_MG), (const bf16_t*)(wb + W_OUT), DM, 0, 0};
        pg8::StaticOrder S; S.init(M, DM, G, bx);
        pg8::gemm_phase(lds + RING_OFF, tid, g, S, epi::EpiRes{X, X, XB, SSQ, 1.0f});
#endif
    }
}
__device__ __forceinline__ Ctx make_ctx(LAS unsigned char* lds, const int wave_s) {
    Ctx c; c.lds = lds;
    int tid = wave_s * 64 + (int)__builtin_amdgcn_mbcnt_hi(~0u, __builtin_amdgcn_mbcnt_lo(~0u, 0u)); asm volatile("" : "+v"(tid));
    const CAS Args* argp = (const CAS Args*)__builtin_amdgcn_kernarg_segment_ptr(); asm volatile("" : "+s"(argp));
    c.ap = argp; c.tid = tid; c.lane = tid & 63; c.wave = __builtin_amdgcn_readfirstlane(tid >> 6);
    c.G = gridDim.x; c.bx = blockIdx.x; c.vcu = (c.G % 8 == 0) ? (c.bx % 8) * (c.G / 8) + c.bx / 8 : c.bx;
    c.gw = c.vcu * NWAVES + c.wave; c.ngw = c.G * NWAVES;
    GAS unsigned char* ws = argp->ws; asm volatile("" : "+s"(ws)); c.ws = as_global(ws);
    GAS float* X = argp->out; asm volatile("" : "+s"(X)); c.X = as_global(X);
    return c;
}
#if MK_PER_PHASE_LAUNCH
template <int KIND>
__global__ void __launch_bounds__(NWAVES * 64, 2) phase_kernel(Args args_, int l, int ffn2) {
    extern __shared__ __attribute__((aligned(16))) unsigned char lds_raw[];
    const Ctx c = make_ctx((LAS unsigned char*)lds_raw, __builtin_amdgcn_readfirstlane(threadIdx.x >> 6));
    phase_body<KIND>(c, l, ffn2);
}
#endif
#if !MK_PER_PHASE_LAUNCH
__global__ void __launch_bounds__(NWAVES * 64, 2) trunk_fwd(Args args_) {
    extern __shared__ __attribute__((aligned(16))) unsigned char lds_raw[];
    LAS unsigned char* lds = (LAS unsigned char*)lds_raw;
    volatile LAS unsigned* MISC = (volatile LAS unsigned*)(lds + MISC_OFF);
    gu32* ctl = (gu32*)(args_.ws + WS_CTL);
    for (int u = threadIdx.x; u < (LDS_BYTES - LDSCTL_OFF) / 4; u += NWAVES * 64) ((LAS unsigned*)(lds + LDSCTL_OFF))[u] = 0u;
    __syncthreads();
    XcdBarrier bar = xcd_barrier_post((unsigned*)(ctl + CW_BAR), MISC + 8);
    const int wave_s = __builtin_amdgcn_readfirstlane(threadIdx.x >> 6);
    for (int ph = 0; ph < N_PHASES; ++ph) {
        const Ctx c = make_ctx(lds, wave_s);
        int kind_, l_, ffn2_; phase_decode(ph, kind_, l_, ffn2_);
        const int kind = __builtin_amdgcn_readfirstlane(kind_), l = __builtin_amdgcn_readfirstlane(l_), ffn2 = __builtin_amdgcn_readfirstlane(ffn2_);
#if PROBE_MASK
        if ((PROBE_MASK >> kind) & 1) {
            switch (kind) {
            case K_CONV: phase_body<K_CONV>(c, l, ffn2); break;
#if PROBE_NULL
            case K_UP: { pg8::Gemm g{(const bf16_t*)(c.ws + WS_XB), (const bf16_t*)(c.ws + WS_W + (ffn2 ? W_GU2 : W_GU1)), DM, 0, 0}; pg8::StaticOrder S; S.init(M, 2 * DFF, c.G, c.bx); pg8::gemm_phase(c.lds + RING_OFF, c.tid, g, S, epi::EpiNull{}); } break;
#else
            case K_UP: phase_body<K_UP>(c, l, ffn2); break;
#endif
            case K_WIN: phase_body<K_WIN>(c, l, ffn2); break;
            case K_KV: phase_body<K_KV>(c, l, ffn2); break;
            case K_GATE: phase_body<K_GATE>(c, l, ffn2); break;
            case K_MERGE: phase_body<K_MERGE>(c, l, ffn2); break;
            default: break;
            }
            xcd_barrier(bar);
        }
#endif
        switch (kind) {
        case K_PRO: phase_body<K_PRO>(c, l, ffn2); break;
        case K_CONV: phase_body<K_CONV>(c, l, ffn2); break;
        case K_UP: phase_body<K_UP>(c, l, ffn2); break;
        case K_DOWN: phase_body<K_DOWN>(c, l, ffn2); break;
        case K_WIN: phase_body<K_WIN>(c, l, ffn2); break;
        case K_KV: phase_body<K_KV>(c, l, ffn2); break;
        case K_SCAN: phase_body<K_SCAN>(c, l, ffn2); break;
        case K_MIX: phase_body<K_MIX>(c, l, ffn2); break;
        case K_GATE: phase_body<K_GATE>(c, l, ffn2); break;
        case K_MERGE: phase_body<K_MERGE>(c, l, ffn2); break;
        default: phase_body<K_WOUT>(c, l, ffn2); break;
        }
        if (ph + 1 < N_PHASES) xcd_barrier(bar);
    }
}
#endif

#if MK_PER_PHASE_LAUNCH
template <int KIND> static void launch_phase(int grid, hipStream_t stream, const Args& a, int l, int ffn2) {
    static bool attr = false;
    if (!attr) { (void)hipFuncSetAttribute((const void*)phase_kernel<KIND>, hipFuncAttributeMaxDynamicSharedMemorySize, LDS_BYTES); attr = true; }
    hipLaunchKernelGGL(phase_kernel<KIND>, dim3(grid), dim3(NWAVES * 64), LDS_BYTES, stream, a, l, ffn2);
}
#endif
extern "C" void kernel_launch(void* const* d_in, const int* in_sizes, int n_in, void* d_out, int out_size, void* d_ws, size_t ws_size, hipStream_t stream) {
    static int grid = 0;
    if (grid == 0) {
        if (n_in != N_IN || in_sizes[0] != M * DM || out_size != M * DM || ws_size < WS_END) { fprintf(stderr, "kernel_launch: unexpected shapes (n_in %d, in0 %d, out %d, ws %zu < %zu); nothing launched\n", n_in, n_in > 0 ? in_sizes[0] : -1, out_size, ws_size, (size_t)WS_END); grid = -1; return; }
        int dev = 0, cus = 0, per_cu = 0;
        if (hipGetDevice(&dev) != hipSuccess || hipDeviceGetAttribute(&cus, hipDeviceAttributeMultiprocessorCount, dev) != hipSuccess) { grid = -1; return; }
#if !MK_PER_PHASE_LAUNCH
        if (hipFuncSetAttribute((const void*)trunk_fwd, hipFuncAttributeMaxDynamicSharedMemorySize, LDS_BYTES) != hipSuccess) { fprintf(stderr, "kernel_launch: hipFuncSetAttribute failed\n"); grid = -1; return; }
        if (hipOccupancyMaxActiveBlocksPerMultiprocessor(&per_cu, (const void*)trunk_fwd, NWAVES * 64, LDS_BYTES) != hipSuccess || per_cu < 1)
            fprintf(stderr, "kernel_launch: note: occupancy query reports %d workgroups per CU\n", per_cu);
        (void)hipGetLastError();
#endif
        (void)per_cu;
        grid = cus;
    }
    if (grid < 0) return;
    (void)hipMemsetAsync((char*)d_ws + WS_CTL, 0, CTL_ZERO_BYTES, stream);
    Args a{};
    for (int i = 0; i < N_IN; ++i) a.in[i] = (const GAS float*)d_in[i];
    a.out = (GAS float*)d_out; a.ws = (GAS unsigned char*)d_ws;
    for (int i = 0; i < 32; ++i) a.ropec[i] = std::pow(10000.0, -(double)i / 32.0) / (2.0 * 3.14159265358979323846);
    for (int l = 0; l < 2; ++l) a.lam_init[l] = (float)(0.8 - 0.6 * std::exp(-0.3 * (double)l));
#if MK_PER_PHASE_LAUNCH
    for (int ph = 0; ph < N_PHASES; ++ph) {
        int kind, l, ffn2; phase_decode(ph, kind, l, ffn2);
        switch (kind) {
        case K_PRO: launch_phase<K_PRO>(grid, stream, a, l, ffn2); break;
        case K_CONV: if (l > 0) launch_phase<K_CONV>(grid, stream, a, l, ffn2); break;
        case K_UP: launch_phase<K_UP>(grid, stream, a, l, ffn2); break;
        case K_DOWN: launch_phase<K_DOWN>(grid, stream, a, l, ffn2); break;
        case K_WIN: launch_phase<K_WIN>(grid, stream, a, l, ffn2); break;
#if NAIVE_C
        case K_KV: case K_SCAN: break;
#else
        case K_KV: launch_phase<K_KV>(grid, stream, a, l, ffn2); break;
        case K_SCAN: launch_phase<K_SCAN>(grid, stream, a, l, ffn2); break;
#endif
        case K_MIX: launch_phase<K_MIX>(grid, stream, a, l, ffn2); break;
        case K_GATE: launch_phase<K_GATE>(grid, stream, a, l, ffn2); break;
        case K_MERGE: launch_phase<K_MERGE>(grid, stream, a, l, ffn2); break;
        default: launch_phase<K_WOUT>(grid, stream, a, l, ffn2); break;
        }
    }
#else
    hipLaunchKernelGGL(trunk_fwd, dim3(grid), dim3(NWAVES * 64), LDS_BYTES, stream, a);
#endif
    const hipError_t le = hipPeekAtLastError();
    if (le != hipSuccess) fprintf(stderr, "kernel_launch: launch failed: %s\n", hipGetErrorName(le));
}
```

```cpp
#define MK_PER_PHASE_LAUNCH 0
#include <hip/hip_runtime.h>
#include <hip/hip_bf16.h>
#include <cstdio>
#include <cstdint>
#include <cmath>

#ifndef MK_PER_PHASE_LAUNCH
#define MK_PER_PHASE_LAUNCH 0
#endif
#ifndef NAIVE_GEMM
#define NAIVE_GEMM 0
#endif
#ifndef NAIVE_UP
#define NAIVE_UP NAIVE_GEMM
#endif
#ifndef NAIVE_DOWN
#define NAIVE_DOWN NAIVE_GEMM
#endif
#ifndef NAIVE_WIN
#define NAIVE_WIN NAIVE_GEMM
#endif
#ifndef NAIVE_GATE
#define NAIVE_GATE NAIVE_GEMM
#endif
#ifndef NAIVE_MERGE
#define NAIVE_MERGE NAIVE_GEMM
#endif
#ifndef NAIVE_WOUT
#define NAIVE_WOUT NAIVE_GEMM
#endif
#ifndef PROBE_MASK
#define PROBE_MASK 0
#endif
#ifndef PROBE_NULL
#define PROBE_NULL 0
#endif
#ifndef FA_V2
#define FA_V2 1
#endif
#ifndef PROBE_PM
#define PROBE_PM 0
#endif
#ifndef PROBE_A
#define PROBE_A 0
#endif
#ifndef PROBE_B
#define PROBE_B 0
#endif
#ifndef NAIVE_A
#define NAIVE_A 0
#endif
#ifndef NAIVE_B
#define NAIVE_B 0
#endif
#ifndef NAIVE_C
#define NAIVE_C 0
#endif

constexpr int BATCH = 2, SEQ = 8192, DM = 1024, DEPTH = 2, M = BATCH * SEQ;
constexpr int DFF = 2816, NIN1 = 4608, NGATE = 3072, NIN = 7680;
constexpr float EPS = 1e-6f;
constexpr float LOG2E = 1.4426950408889634f;
constexpr float C2 = 0.125f * LOG2E;

enum { I_X = 0, I_F1N, I_F1G, I_F1U, I_F1D, I_MIXN, I_WIN, I_AQN, I_AKN, I_LQ1, I_LK1, I_LQ2, I_LK2, I_ASUB, I_BQN, I_BKN, I_BREL, I_CON, I_WBA, I_WBB, I_WBC, I_WOUT, I_F2N, I_F2G, I_F2U, I_F2D, N_IN };

constexpr size_t MiB = 1u << 20;
constexpr size_t WS_CTL = 0, CTL_ZERO_BYTES = 1 * MiB;
constexpr size_t WS_ONES = 512 * 1024;
constexpr size_t WS_COS = 1 * MiB, WS_SIN = 2 * MiB;
constexpr size_t WS_SSQ = 3 * MiB;
constexpr size_t WS_W = 4 * MiB;
constexpr size_t W_GU1 = 0, W_D1 = W_GU1 + (size_t)2 * DFF * DM * 2, W_IN = W_D1 + (size_t)DM * DFF * 2, W_BR = W_IN + (size_t)NIN * DM * 2,
                 W_OUT = W_BR + (size_t)3 * DM * 512 * 2, W_GU2 = W_OUT + (size_t)DM * DM * 2, W_D2 = W_GU2 + (size_t)2 * DFF * DM * 2, W_END = W_D2 + (size_t)DM * DFF * 2;
static_assert(W_END == 53 * MiB, "weights");
constexpr size_t WS_XB = 57 * MiB;
constexpr size_t WS_R4 = 89 * MiB;
constexpr size_t WS_R3 = 121 * MiB;
constexpr size_t P16 = 16 * MiB;
constexpr size_t WS_AQ = WS_R3, WS_BQ = WS_R3 + P16, WS_CG = WS_R3 + 2 * P16;
constexpr size_t WS_AK = WS_R3 + 3 * P16, WS_AV = WS_AK + P16, WS_BK = WS_AV + P16, WS_BV = WS_BK + P16, WS_CQ = WS_BV + P16, WS_CK = WS_CQ + P16 / 2, WS_CV = WS_CK + P16 / 2;
constexpr size_t WS_GT = WS_AK;
constexpr size_t WS_HB = WS_R3;
constexpr size_t WS_MG = WS_R4;
constexpr size_t WS_END = WS_R3 + 144 * MiB;
static_assert(WS_CV + P16 == WS_END && WS_GT + (size_t)M * NGATE * 2 == WS_END && WS_HB + (size_t)M * DFF * 2 <= WS_END, "ws map");

#define GAS __attribute__((address_space(1)))
#define LAS __attribute__((address_space(3)))
typedef unsigned short bf16_t;
typedef short bf16x8 __attribute__((ext_vector_type(8)));
typedef float f32x4 __attribute__((ext_vector_type(4)));
typedef float f32x2 __attribute__((ext_vector_type(2)));
typedef float f32x16 __attribute__((ext_vector_type(16)));
typedef unsigned u32x4 __attribute__((ext_vector_type(4)));
typedef unsigned u32x2 __attribute__((ext_vector_type(2)));
typedef GAS unsigned gu32;
#define RLX_AGENT __ATOMIC_RELAXED, __HIP_MEMORY_SCOPE_AGENT
#define LDS_WAIT() asm volatile("s_waitcnt lgkmcnt(0)" ::: "memory")
#define VM_WAIT() asm volatile("s_waitcnt vmcnt(0)" ::: "memory")

__device__ __forceinline__ unsigned f2bf(float f) { unsigned u = __builtin_bit_cast(unsigned, f); return (u + 0x7fffu + ((u >> 16) & 1u)) >> 16; }
__device__ __forceinline__ unsigned pk2(float lo, float hi) { return f2bf(lo) | (f2bf(hi) << 16); }
__device__ __forceinline__ float bf2f(unsigned short b) { return __builtin_bit_cast(float, (unsigned)b << 16); }
__device__ __forceinline__ float bflo(unsigned w) { return __builtin_bit_cast(float, w << 16); }
__device__ __forceinline__ float bfhi(unsigned w) { return __builtin_bit_cast(float, w & 0xffff0000u); }
__device__ __forceinline__ unsigned cvt_pk_bf16(float lo, float hi) { unsigned r; asm volatile("v_cvt_pk_bf16_f32 %0, %1, %2" : "=v"(r) : "v"(lo), "v"(hi)); return r; }
__device__ __forceinline__ float fast_rcp(float x) { return __builtin_amdgcn_rcpf(x); }
__device__ __forceinline__ float fast_exp2(float x) { return __builtin_amdgcn_exp2f(x); }
__device__ __forceinline__ float silu_f(float x) { return x * fast_rcp(1.0f + fast_exp2(-x * LOG2E)); }
__device__ __forceinline__ float sigmoid_f(float x) { return fast_rcp(1.0f + fast_exp2(-x * LOG2E)); }
__device__ __forceinline__ float wave_sum(float v) {
#pragma unroll
    for (int o = 1; o < 64; o <<= 1) v += __shfl_xor(v, o);
    return v;
}
__device__ __forceinline__ float wave_max(float v) {
#pragma unroll
    for (int o = 1; o < 64; o <<= 1) v = fmaxf(v, __shfl_xor(v, o));
    return v;
}

namespace pg8 {
#define PG8_LAS __attribute__((address_space(3)))
constexpr int BM = 256, BK = 64, HALF = 128, HTB = HALF * BK * 2  , STAGE_BYTES = 8 * HTB, NXCD = 8, WGM = 8;

__host__ __device__ __forceinline__ int lds_byte(int r, int c) { const int st = (r >> 4) * 2 + (c >> 5), rr = r & 15, cc = c & 31, ob = rr * 64 + cc * 2; return st * 1024 + (ob ^ (((ob >> 9) & 1) << 5)); }
__host__ __device__ __forceinline__ void stage_rc(int b, int& R, int& C) { const int st = b / 1024, sb = b % 1024, swz = sb ^ (((sb >> 9) & 1) << 5); R = (st >> 1) * 16 + swz / 64; C = (st & 1) * 32 + (swz % 64) / 2; }
__host__ __device__ __forceinline__ int perm32(int rho) { const int n = rho >> 4, i = rho & 15; return 8 * (i >> 2) + 4 * n + (i & 3); }

struct Unit { int pm, pn, sub, ui; };
struct Gemm { const bf16_t* A; const bf16_t* Bt; int K; size_t subA, subB; };
__device__ __forceinline__ const char* pickA(const Gemm& g, int s) { return (const char*)g.A + (size_t)s * g.subA; }
__device__ __forceinline__ const char* pickB(const Gemm& g, int s) { return (const char*)g.Bt + (size_t)s * g.subB; }

struct StaticOrder {
    int nM, nN, nwg, G, c;
    __host__ __device__ void init(int Mr, int N, int G_, int c_) { nM = Mr / BM; nN = N / BM; nwg = nM * nN; G = G_; c = c_; }
    template <int NSUB = 1> __host__ __device__ bool next(int i, Unit& u) const {
        const int it = i / NSUB; u.sub = i - it * NSUB; u.ui = it;
        const long L = (long)it * G + c; if (L >= nwg) return false;
        int wgid = (int)L; { const int q = nwg / NXCD, r = nwg % NXCD, xcd = wgid % NXCD, off = wgid / NXCD; wgid = (xcd < r ? xcd * (q + 1) : r * (q + 1) + (xcd - r) * q) + off; }
        const int nig = WGM * nN, gid = wgid / nig, fm = gid * WGM, gsz = (nM - fm) < WGM ? (nM - fm) : WGM;
        u.pm = fm + ((wgid % nig) % gsz); u.pn = (wgid % nig) / gsz; return true;
    }
};

template <int NSUB = 1, class Epi>
__device__ __forceinline__ void gemm_phase(PG8_LAS unsigned char* lds, const int tid, const Gemm g, const StaticOrder& S, const Epi& E) {
    const int wid = __builtin_amdgcn_readfirstlane(tid >> 6), lane = tid & 63, wr = wid >> 2, wc = wid & 3, fr = lane & 15, fq = lane >> 4;
    const int K = g.K, nt = K / BK;
    unsigned voffA[2], voffB[2];
#pragma unroll
    for (int i = 0; i < 2; ++i) { int R, C; stage_rc(tid * 16 + i * 8192, R, C); const int Rb = ((R & ~31) + perm32(R & 31));
        voffA[i] = (unsigned)(R * K + C) * 2u; voffB[i] = (unsigned)(Rb * K + C) * 2u; }
    const size_t kstep = (size_t)(BK * 2);
    const size_t hstep = (size_t)HALF * K * 2;
    const size_t tstep = 2 * hstep;
    const unsigned ldsw = (unsigned)wid * 1024u;
    const int aoff = lds_byte(wr * 64 + fr, fq * 8), boff = lds_byte(wc * 32 + fr, fq * 8);
#define PG8_SA(b, h) (((b) * 2 + (h)) * HTB)
#define PG8_SB(b, h) ((4 + (b) * 2 + (h)) * HTB)
#define PG8_STAGE(bufoff, gbase, voff) do { _Pragma("unroll") for (int _i = 0; _i < 2; ++_i) \
        __builtin_amdgcn_global_load_lds((const unsigned*)((const char*)(gbase) + (voff)[_i]), (PG8_LAS unsigned*)(lds + (bufoff) + ldsw + _i * 8192), 16, 0, 0); } while (0)
#define PG8_LDA(dst, b, h) do { _Pragma("unroll") for (int m = 0; m < 4; ++m) _Pragma("unroll") for (int k = 0; k < 2; ++k) dst[m][k] = *(const PG8_LAS bf16x8*)(lds + PG8_SA(b, h) + aoff + m * 2048 + k * 1024); } while (0)
#define PG8_LDB(dst, b, h) do { _Pragma("unroll") for (int n = 0; n < 2; ++n) _Pragma("unroll") for (int k = 0; k < 2; ++k) dst[n][k] = *(const PG8_LAS bf16x8*)(lds + PG8_SB(b, h) + boff + n * 2048 + k * 1024); } while (0)
#define PG8_MMA(ai, bj, At, Bt) do { __builtin_amdgcn_s_setprio(1); _Pragma("unroll") for (int m = 0; m < 4; ++m) _Pragma("unroll") for (int n = 0; n < 2; ++n) _Pragma("unroll") for (int k = 0; k < 2; ++k) \
        acc[ai][bj][m][n] = __builtin_amdgcn_mfma_f32_16x16x32_bf16(Bt[n][k], At[m][k], acc[ai][bj][m][n], 0, 0, 0); __builtin_amdgcn_s_setprio(0); } while (0)
#define PG8_WAIT_V(n) asm volatile("s_waitcnt vmcnt(" #n ")" ::: "memory")
#define PG8_WAIT_L(n) asm volatile("s_waitcnt lgkmcnt(" #n ")" ::: "memory")
#define PG8_BAR __builtin_amdgcn_s_barrier()
#define PG8_SCHED __builtin_amdgcn_sched_barrier(0)
    Unit cur, nxt; int ui = 0;
    if (!S.template next<NSUB>(0, cur)) return;
    f32x4 acc[2][2][4][2];
#pragma unroll
    for (int a = 0; a < 2; ++a)
#pragma unroll
        for (int b = 0; b < 2; ++b)
#pragma unroll
            for (int m = 0; m < 4; ++m)
#pragma unroll
                for (int n = 0; n < 2; ++n) acc[a][b][m][n] = (f32x4){0.f, 0.f, 0.f, 0.f};
    bf16x8 At[4][2], B0[2][2], B1[2][2];
    const char* cA = pickA(g, cur.sub) + (size_t)cur.pm * tstep; const char* cB = pickB(g, cur.sub) + (size_t)cur.pn * tstep;
    PG8_STAGE(PG8_SB(0, 0), cB, voffB); PG8_STAGE(PG8_SB(0, 1), cB + hstep, voffB); PG8_STAGE(PG8_SA(0, 0), cA, voffA); PG8_STAGE(PG8_SA(0, 1), cA + hstep, voffA);
    if (wr == 1) PG8_BAR;
    PG8_WAIT_V(2); PG8_BAR;
    PG8_STAGE(PG8_SB(1, 0), cB + kstep, voffB); PG8_STAGE(PG8_SA(1, 0), cA + kstep, voffA); PG8_STAGE(PG8_SB(1, 1), cB + hstep + kstep, voffB);
    PG8_WAIT_V(6); PG8_BAR;
    for (;;) {
        const bool has_next = S.template next<NSUB>(ui + 1, nxt);
        const char* nA = has_next ? pickA(g, nxt.sub) + (size_t)nxt.pm * tstep : cA; const char* nB = has_next ? pickB(g, nxt.sub) + (size_t)nxt.pn * tstep : cB;
        for (int t = 0; t < nt; t += 2) {
            const bool last = (t == nt - 2);
            const char* a1 = cA + (size_t)(t + 1) * kstep;
            const char* a2 = last ? nA : cA + (size_t)(t + 2) * kstep; const char* b2 = last ? nB : cB + (size_t)(t + 2) * kstep;
            const char* a3 = a2 + kstep; const char* b3 = b2 + kstep;
            PG8_LDB(B0, 0, 0); PG8_LDB(B1, 0, 1); PG8_SCHED; PG8_LDA(At, 0, 0); PG8_STAGE(PG8_SA(1, 1), a1 + hstep, voffA);
            PG8_WAIT_V(8); PG8_WAIT_L(0); PG8_BAR; PG8_MMA(0, 0, At, B0); PG8_MMA(0, 1, At, B1); PG8_BAR; PG8_SCHED;
            PG8_LDA(At, 0, 1); PG8_STAGE(PG8_SB(0, 0), b2, voffB); PG8_STAGE(PG8_SB(0, 1), b2 + hstep, voffB); PG8_STAGE(PG8_SA(0, 0), a2, voffA);
            PG8_WAIT_V(8); PG8_WAIT_L(0); PG8_BAR; PG8_MMA(1, 0, At, B0); PG8_MMA(1, 1, At, B1); PG8_BAR; PG8_SCHED;
            PG8_LDB(B0, 1, 0); PG8_LDB(B1, 1, 1); PG8_SCHED; PG8_LDA(At, 1, 0); PG8_STAGE(PG8_SA(0, 1), a2 + hstep, voffA);
            PG8_WAIT_V(8); PG8_WAIT_L(0); PG8_BAR; PG8_MMA(0, 0, At, B0); PG8_MMA(0, 1, At, B1); PG8_BAR; PG8_SCHED;
            PG8_LDA(At, 1, 1); PG8_STAGE(PG8_SB(1, 0), b3, voffB); PG8_STAGE(PG8_SB(1, 1), b3 + hstep, voffB); PG8_STAGE(PG8_SA(1, 0), a3, voffA);
            PG8_WAIT_V(8); PG8_WAIT_L(0); PG8_BAR; PG8_MMA(1, 0, At, B0); PG8_MMA(1, 1, At, B1); PG8_BAR; PG8_SCHED;
        }
        if (wr == 0) PG8_BAR;
        { int l_ = tid; asm volatile("" : "+v"(l_)); const int fr_ = l_ & 15, fq_ = (l_ >> 4) & 3;
          E(acc, cur, wr, wc, fr_, fq_); }
        if (!has_next) break;
        cur = nxt; cA = nA; cB = nB; ++ui;
        if (wr == 1) PG8_BAR;
    }
    PG8_WAIT_V(0);
    PG8_BAR;
#undef PG8_SA
#undef PG8_SB
#undef PG8_STAGE
#undef PG8_LDA
#undef PG8_LDB
#undef PG8_MMA
#undef PG8_WAIT_V
#undef PG8_WAIT_L
#undef PG8_BAR
#undef PG8_SCHED
}
}

namespace epi {
using pg8::Unit;
typedef f32x4 Acc[2][2][4][2];
#define ACC_ZERO(acc) do { _Pragma("unroll") for (int a_ = 0; a_ < 2; ++a_) _Pragma("unroll") for (int b_ = 0; b_ < 2; ++b_) _Pragma("unroll") for (int m_ = 0; m_ < 4; ++m_) \
    _Pragma("unroll") for (int n_ = 0; n_ < 2; ++n_) acc[a_][b_][m_][n_] = (f32x4){0.f, 0.f, 0.f, 0.f}; } while (0)

__device__ __forceinline__ float dot4(const f32x4 a) { return (a[0] * a[0] + a[1] * a[1]) + (a[2] * a[2] + a[3] * a[3]); }
__device__ __forceinline__ u32x4 pack8(const f32x4 a, const f32x4 b) { u32x4 w; w.x = cvt_pk_bf16(a[0], a[1]); w.y = cvt_pk_bf16(a[2], a[3]); w.z = cvt_pk_bf16(b[0], b[1]); w.w = cvt_pk_bf16(b[2], b[3]); return w; }
constexpr int EPI_RSTD_OFF = 132096, EPI_GAIN_OFF = EPI_RSTD_OFF + 8 * 256 * 4, EPI_ROPE_OFF = EPI_GAIN_OFF + 4 * 64 * 4, EPI_END = EPI_ROPE_OFF + 128;
__device__ __forceinline__ void fill_rstd_table(LAS unsigned char* lds0, const int tid, const float* ssq, const pg8::StaticOrder& S) {
    LAS float* tab = (LAS float*)(lds0 + EPI_RSTD_OFF);
    Unit u;
#pragma unroll 1
    for (int i = 0; i < 8 && S.next(i, u); ++i) {
        const int row = tid >> 1, half = tid & 1;
        const float* p = ssq + ((size_t)u.pm * 256 + row) * 16 + half * 8;
        const f32x4 a = *(const f32x4*)p, b = *(const f32x4*)(p + 4);
        float s = ((a[0] + a[1]) + (a[2] + a[3])) + ((b[0] + b[1]) + (b[2] + b[3])); s += __shfl_xor(s, 1);
        if (half == 0) tab[i * 256 + row] = __builtin_amdgcn_rsqf(s * (1.0f / DM) + EPS);
    }
}
__device__ __forceinline__ float row_rstd(const LAS float* tab, int ui, int lrow) { return tab[ui * 256 + lrow]; }

struct EpiNull {
    __device__ __forceinline__ void operator()(Acc& acc, const Unit& u, int wr, int wc, int fr, int fq) const {
#pragma unroll
        for (int ai = 0; ai < 2; ++ai)
#pragma unroll
            for (int bj = 0; bj < 2; ++bj)
#pragma unroll
                for (int m = 0; m < 4; ++m) { asm volatile("" : "+v"(acc[ai][bj][m][0]), "+v"(acc[ai][bj][m][1])); }
        ACC_ZERO(acc);
    }
};
struct EpiUp {
    bf16_t* H; const LAS float* rst;
    __device__ __forceinline__ void operator()(Acc& acc, const Unit& u, int wr, int wc, int fr, int fq) const {
#pragma unroll
        for (int ai = 0; ai < 2; ++ai)
#pragma unroll
            for (int m = 0; m < 4; ++m) {
                const int lrow = ai * 128 + wr * 64 + m * 16 + fr, row = u.pm * 256 + lrow;
                const float rs = row_rstd(rst, u.ui, lrow);
                f32x4 h0, h1;
#pragma unroll
                for (int j = 0; j < 4; ++j) { h0[j] = silu_f(acc[ai][0][m][0][j] * rs) * (acc[ai][1][m][0][j] * rs); h1[j] = silu_f(acc[ai][0][m][1][j] * rs) * (acc[ai][1][m][1][j] * rs); }
                *(u32x4*)(H + (size_t)row * DFF + u.pn * 128 + wc * 32 + 8 * fq) = pack8(h0, h1);
            }
        ACC_ZERO(acc);
    }
};

struct EpiRes {
    const float* xold; float* xnew; bf16_t* xb; float* ssq; float s;
    __device__ __forceinline__ void operator()(Acc& acc, const Unit& u, int wr, int wc, int fr, int fq) const {
#pragma unroll
        for (int ai = 0; ai < 2; ++ai) {
            f32x4 ov[4][2][2];
#pragma unroll
            for (int m = 0; m < 4; ++m)
#pragma unroll
                for (int bj = 0; bj < 2; ++bj) { const size_t off = (size_t)(u.pm * 256 + ai * 128 + wr * 64 + m * 16 + fr) * DM + u.pn * 256 + bj * 128 + wc * 32 + 8 * fq;
                    ov[m][bj][0] = *(const f32x4*)(xold + off); ov[m][bj][1] = *(const f32x4*)(xold + off + 4); }
            asm volatile("" ::: "memory");
#pragma unroll
            for (int m = 0; m < 4; ++m) {
                const int row = u.pm * 256 + ai * 128 + wr * 64 + m * 16 + fr; float ss = 0.f;
#pragma unroll
                for (int bj = 0; bj < 2; ++bj) {
                    const size_t off = (size_t)row * DM + u.pn * 256 + bj * 128 + wc * 32 + 8 * fq;
                    const f32x4 v0 = ov[m][bj][0] + acc[ai][bj][m][0] * s, v1 = ov[m][bj][1] + acc[ai][bj][m][1] * s;
                    *(f32x4*)(xnew + off) = v0; *(f32x4*)(xnew + off + 4) = v1;
                    *(u32x4*)(xb + off) = pack8(v0, v1);
                    ss += dot4(v0) + dot4(v1);
                }
                ss += __shfl_xor(ss, 16); ss += __shfl_xor(ss, 32);
                if (fq == 0) ssq[(size_t)row * 16 + u.pn * 4 + wc] = ss;
            }
            asm volatile("" ::: "memory");
        }
        ACC_ZERO(acc);
    }
};

struct EpiGate {
    bf16_t* G; const LAS float* rst;
    __device__ __forceinline__ void operator()(Acc& acc, const Unit& u, int wr, int wc, int fr, int fq) const {
#pragma unroll
        for (int ai = 0; ai < 2; ++ai)
#pragma unroll
            for (int m = 0; m < 4; ++m) {
                const int lrow = ai * 128 + wr * 64 + m * 16 + fr, row = u.pm * 256 + lrow;
                const float rs = row_rstd(rst, u.ui, lrow);
#pragma unroll
                for (int bj = 0; bj < 2; ++bj) { f32x4 g0, g1;
#pragma unroll
                    for (int j = 0; j < 4; ++j) { g0[j] = fmaxf(sigmoid_f(acc[ai][bj][m][0][j] * rs), 9.5367431640625e-07f); g1[j] = fmaxf(sigmoid_f(acc[ai][bj][m][1][j] * rs), 9.5367431640625e-07f); }
                    *(u32x4*)(G + (size_t)row * NGATE + u.pn * 256 + bj * 128 + wc * 32 + 8 * fq) = pack8(g0, g1); }
            }
        ACC_ZERO(acc);
    }
};

struct EpiMerge {
    const bf16_t* G; bf16_t* MG; const unsigned* ones;
    __device__ __forceinline__ void operator()(Acc& acc, const Unit& u, int wr, int wc, int fr, int fq) const {
        const int sub = u.sub; const bool chain = sub < 2;
        const char* gb = (const char*)(G + (size_t)u.pm * 256 * NGATE + sub * 1024 + u.pn * 256);
        const char* nb = chain ? gb + 2048 : (const char*)ones; const unsigned nmask = chain ? 0xffffffffu : 0u;
        const unsigned go = (unsigned)((wr * 64 + fr) * NGATE + wc * 32 + 8 * fq) * 2u;
#pragma unroll
        for (int ai = 0; ai < 2; ++ai)
#pragma unroll
            for (int mh = 0; mh < 2; ++mh) {
                u32x4 gc[2][2], gn[2][2];
#pragma unroll
                for (int m2 = 0; m2 < 2; ++m2)
#pragma unroll
                    for (int bj = 0; bj < 2; ++bj) { const unsigned o = go + (unsigned)(((ai * 128 + (2 * mh + m2) * 16) * NGATE + bj * 128) * 2);
                        gc[m2][bj] = *(const u32x4*)(gb + o); gn[m2][bj] = *(const u32x4*)(nb + (o & nmask)); }
                asm volatile("" ::: "memory");
#pragma unroll
                for (int m2 = 0; m2 < 2; ++m2)
#pragma unroll
                    for (int bj = 0; bj < 2; ++bj) { const u32x4 c = gc[m2][bj], n = gn[m2][bj]; const int m = 2 * mh + m2;
                        const f32x4 c0 = {bflo(c.x), bfhi(c.x), bflo(c.y), bfhi(c.y)}, c1 = {bflo(c.z), bfhi(c.z), bflo(c.w), bfhi(c.w)};
                        const f32x4 n0 = {bflo(n.x), bfhi(n.x), bflo(n.y), bfhi(n.y)}, n1 = {bflo(n.z), bfhi(n.z), bflo(n.w), bfhi(n.w)};
#pragma unroll
                        for (int j = 0; j < 4; ++j) { acc[ai][bj][m][0][j] *= c0[j] * fast_rcp(n0[j]); acc[ai][bj][m][1][j] *= c1[j] * fast_rcp(n1[j]); } }
                asm volatile("" ::: "memory");
            }
        if (!chain) {
            char* mb = (char*)(MG + (size_t)u.pm * 256 * DM + u.pn * 256);
            const unsigned mo = (unsigned)((wr * 64 + fr) * DM + wc * 32 + 8 * fq) * 2u;
#pragma unroll
            for (int ai = 0; ai < 2; ++ai)
#pragma unroll
                for (int m = 0; m < 4; ++m)
#pragma unroll
                    for (int bj = 0; bj < 2; ++bj)
                        *(u32x4*)(mb + mo + (unsigned)(((ai * 128 + m * 16) * DM + bj * 128) * 2)) = pack8(acc[ai][bj][m][0], acc[ai][bj][m][1]);
            ACC_ZERO(acc);
        }
    }
};

enum { F_NORM = 1, F_ROPE = 2, F_C2 = 4, F_CKD = 8, F_SILU = 16 };
struct EpiWin {
    unsigned char* ws; const LAS float* rst; const LAS float* gtab; const LAS float* rtab;
    __device__ __forceinline__ void operator()(Acc& acc, const Unit& u, int wr, int wc, int fr, int fq) const {
        const int pn = u.pn;
        size_t obase; int pitch, colbase, flags, gk = 0;
        if (pn < 2)       { obase = WS_AQ; pitch = 512; colbase = 256 * pn;        flags = F_NORM | F_ROPE | F_C2; gk = 0; }
        else if (pn < 4)  { obase = WS_AK; pitch = 512; colbase = 256 * (pn - 2);  flags = F_NORM | F_ROPE; gk = 1; }
        else if (pn < 6)  { obase = WS_AV; pitch = 512; colbase = 256 * (pn - 4);  flags = 0; }
        else if (pn < 8)  { obase = WS_BQ; pitch = 512; colbase = 256 * (pn - 6);  flags = F_NORM | F_C2; gk = 2; }
        else if (pn < 10) { obase = WS_BK; pitch = 512; colbase = 256 * (pn - 8);  flags = F_NORM; gk = 3; }
        else if (pn < 12) { obase = WS_BV; pitch = 512; colbase = 256 * (pn - 10); flags = 0; }
        else if (pn == 12) { obase = WS_CQ; pitch = 256; colbase = 0; flags = F_ROPE; }
        else if (pn == 13) { obase = WS_CK; pitch = 256; colbase = 0; flags = F_ROPE | F_CKD; }
        else if (pn < 16) { obase = WS_CV; pitch = 512; colbase = 256 * (pn - 14); flags = 0; }
        else              { obase = WS_CG; pitch = 512; colbase = 256 * (pn - 16); flags = F_SILU; }
        bf16_t* out = (bf16_t*)(ws + obase);
        f32x4 gA0 = {1.f, 1.f, 1.f, 1.f}, gA1 = gA0, gB0 = gA0, gB1 = gA0;
        if (flags & F_NORM) { const LAS float* gain = gtab + gk * 64; gA0 = *(const LAS f32x4*)(gain + 8 * fq); gA1 = *(const LAS f32x4*)(gain + 8 * fq + 4); gB0 = *(const LAS f32x4*)(gain + 32 + 8 * fq); gB1 = *(const LAS f32x4*)(gain + 36 + 8 * fq); }
        const f32x4 rc0 = *(const LAS f32x4*)(rtab + 8 * fq), rc1 = *(const LAS f32x4*)(rtab + 8 * fq + 4);
        const float l2g = __builtin_log2f(1.0f - __builtin_exp2f(-5.0f - (float)wc));
#pragma unroll
        for (int ai = 0; ai < 2; ++ai)
#pragma unroll
            for (int m = 0; m < 4; ++m) {
                const int lrow = ai * 128 + wr * 64 + m * 16 + fr, row = u.pm * 256 + lrow, t = row & (SEQ - 1);
                const float rs = row_rstd(rst, u.ui, lrow);
                f32x4 a0 = acc[ai][0][m][0] * rs, a1 = acc[ai][0][m][1] * rs, b0 = acc[ai][1][m][0] * rs, b1 = acc[ai][1][m][1] * rs;
                if (flags & F_NORM) {
                    float ss = (dot4(a0) + dot4(a1)) + (dot4(b0) + dot4(b1)); ss += __shfl_xor(ss, 16); ss += __shfl_xor(ss, 32);
                    const float r = __builtin_amdgcn_rsqf(ss * (1.0f / 64.0f) + EPS);
                    a0 = a0 * gA0 * r; a1 = a1 * gA1 * r; b0 = b0 * gB0 * r; b1 = b1 * gB1 * r;
                }
                if (flags & F_ROPE) {
                    const float tf = (float)t; f32x4 c0, c1, s0, s1;
#pragma unroll
                    for (int j = 0; j < 4; ++j) { const float r0 = __builtin_amdgcn_fractf(tf * rc0[j]), r1 = __builtin_amdgcn_fractf(tf * rc1[j]);
                        c0[j] = __builtin_amdgcn_cosf(r0); s0[j] = __builtin_amdgcn_sinf(r0); c1[j] = __builtin_amdgcn_cosf(r1); s1[j] = __builtin_amdgcn_sinf(r1); }
                    const f32x4 na0 = a0 * c0 - b0 * s0, nb0 = b0 * c0 + a0 * s0, na1 = a1 * c1 - b1 * s1, nb1 = b1 * c1 + a1 * s1;
                    a0 = na0; b0 = nb0; a1 = na1; b1 = nb1;
                }
                float sc = 1.0f;
                if (flags & F_C2) sc = C2;
                if (flags & F_CKD) sc = 0.125f * fast_exp2(-(float)(t & 63) * l2g);
                a0 = a0 * sc; a1 = a1 * sc; b0 = b0 * sc; b1 = b1 * sc;
                if (flags & F_SILU) {
#pragma unroll
                    for (int j = 0; j < 4; ++j) { a0[j] = silu_f(a0[j]); a1[j] = silu_f(a1[j]); b0[j] = silu_f(b0[j]); b1[j] = silu_f(b1[j]); }
                }
                bf16_t* o = out + (size_t)row * pitch + colbase + 64 * wc + 8 * fq;
                *(u32x4*)o = pack8(a0, a1); *(u32x4*)(o + 32) = pack8(b0, b1);
            }
        ACC_ZERO(acc);
    }
};
}

__device__ __forceinline__ float log2_gamma(int h) { return __builtin_amdgcn_logf(1.0f - __builtin_amdgcn_exp2f(-5.0f - (float)h)); }

namespace naive {
struct ANorm {
    const float* x; const float* gain; const LAS float* rs; int m0;
    __device__ __forceinline__ float get(int m, int k) const { return x[(size_t)m * DM + k] * rs[m - m0] * gain[k]; }
};
struct ABf {
    const bf16_t* a; int pitch;
    __device__ __forceinline__ float get(int m, int k) const { return bf2f(a[(size_t)m * pitch + k]); }
};
template <int NB, bool SHARED_A, bool NORM, int RT, class Epi>
__device__ __forceinline__ void gemm(LAS unsigned char* lds, const int tid, int vcu, int G, int N, int K,
                                     const float* x, const float* gain, const bf16_t* a0, const bf16_t* a1, const bf16_t* a2, int apitch,
                                     const float* w0, const float* w1, const float* w2, int ldb, const Epi& E) {
    constexpr int NA = SHARED_A ? 1 : NB;
    LAS float* As = (LAS float*)lds;
    LAS float* Bs = As + NA * 16 * 132;
    LAS float* rs = Bs + NB * 16 * 128;
    const int tx = tid & 15, ty = tid >> 4, lane = tid & 63, wave = tid >> 6;
    constexpr int TM = 32 * RT;
    const int ntn = N / 128, ntiles = (M / TM) * ntn;
    for (int tile = vcu; tile < ntiles; tile += G) {
        const int m0 = (tile / ntn) * TM, n0 = (tile % ntn) * 128;
        __syncthreads();
        if (NORM) {
            for (int r = wave * (TM / 8); r < wave * (TM / 8) + TM / 8; ++r) {
                const float* xr = x + (size_t)(m0 + r) * DM; float s = 0.f;
                for (int k = lane; k < DM; k += 64) { const float v = xr[k]; s += v * v; }
                s = wave_sum(s);
                if (lane == 0) rs[r] = 1.0f / sqrtf(s * (1.0f / DM) + EPS);
            }
            __syncthreads();
        }
        float acc[NB][RT][8];
#pragma unroll
        for (int b = 0; b < NB; ++b)
#pragma unroll
            for (int i = 0; i < RT; ++i)
#pragma unroll
                for (int j = 0; j < 8; ++j) acc[b][i][j] = 0.f;
        for (int k0 = 0; k0 < K; k0 += 16) {
            {
                const int r = tid >> 2, kq = (tid & 3) * 4;
                if (r < TM)
#pragma unroll
                for (int b = 0; b < NA; ++b)
#pragma unroll
                    for (int i = 0; i < 4; ++i) {
                        float v;
                        if (NORM) v = x[(size_t)(m0 + r) * DM + k0 + kq + i] * rs[r] * gain[k0 + kq + i];
                        else { const bf16_t* ap = (b == 0 ? a0 : (b == 1 ? a1 : a2)); v = bf2f(ap[(size_t)(m0 + r) * apitch + k0 + kq + i]); }
                        As[(b * 16 + kq + i) * 132 + r] = v;
                    }
                const int kb = tid >> 5, n4 = (tid & 31) * 4;
#pragma unroll
                for (int b = 0; b < NB; ++b) { const float* wp = (b == 0 ? w0 : (b == 1 ? w1 : w2));
                    const f32x4 v = *(const f32x4*)(wp + (size_t)(k0 + kb) * ldb + n0 + n4);
                    *(LAS f32x4*)(Bs + (b * 16 + kb) * 128 + n4) = v; }
            }
            __syncthreads();
#pragma unroll
            for (int kk = 0; kk < 16; ++kk) {
#pragma unroll
                for (int b = 0; b < NB; ++b) {
                    const int ab = SHARED_A ? 0 : b;
                    float av[RT];
#pragma unroll
                    for (int i = 0; i < RT; ++i) av[i] = As[(ab * 16 + kk) * 132 + ty * RT + i];
                    const f32x4 b0 = *(const LAS f32x4*)(Bs + (b * 16 + kk) * 128 + tx * 8), b1 = *(const LAS f32x4*)(Bs + (b * 16 + kk) * 128 + tx * 8 + 4);
#pragma unroll
                    for (int i = 0; i < RT; ++i)
#pragma unroll
                        for (int j = 0; j < 4; ++j) { acc[b][i][j] += av[i] * b0[j]; acc[b][i][4 + j] += av[i] * b1[j]; }
                }
            }
            __syncthreads();
        }
#pragma unroll
        for (int i = 0; i < RT; ++i) E(m0 + ty * RT + i, n0 + tx * 8, acc, i, tx);
    }
}

__device__ __forceinline__ void xb_ssq_pass(const float* x, bf16_t* xb, float* ssq, int gw, int ngw, int lane) {
    for (int m = gw; m < M; m += ngw) {
        const f32x4* xr = (const f32x4*)(x + (size_t)m * DM) + lane; float s = 0.f;
        u32x2* o = (u32x2*)(xb + (size_t)m * DM) + lane;
#pragma unroll
        for (int j = 0; j < 4; ++j) { const f32x4 v = xr[64 * j]; s += (v[0] * v[0] + v[1] * v[1]) + (v[2] * v[2] + v[3] * v[3]); u32x2 w; w.x = pk2(v[0], v[1]); w.y = pk2(v[2], v[3]); o[64 * j] = w; }
        s = wave_sum(s);
        if (lane < 16) ssq[(size_t)m * 16 + lane] = (lane == 0) ? s : 0.f;
    }
}

struct NEpiUp { bf16_t* H;
    __device__ __forceinline__ void operator()(int m, int n, const float (&acc)[2][4][8], int i, int tx) const {
#pragma unroll
        for (int j = 0; j < 8; ++j) { const float g = acc[0][i][j], u = acc[1][i][j]; H[(size_t)m * DFF + n + j] = (bf16_t)f2bf(g / (1.0f + expf(-g)) * u); } } };
struct NEpiRes { const float* xold; float* xnew; bf16_t* xb; float* ssq; float s;
    __device__ __forceinline__ void operator()(int m, int n, const float (&acc)[1][4][8], int i, int tx) const {
        float ss = 0.f;
#pragma unroll
        for (int j = 0; j < 8; ++j) { const float v = xold[(size_t)m * DM + n + j] + s * acc[0][i][j]; xnew[(size_t)m * DM + n + j] = v; xb[(size_t)m * DM + n + j] = (bf16_t)f2bf(v); ss += v * v; }
        ss += __shfl_xor(ss, 1); ss += __shfl_xor(ss, 2); ss += __shfl_xor(ss, 4); ss += __shfl_xor(ss, 8);
        if (tx == 0) { ssq[(size_t)m * 16 + (n >> 7)] = ss; ssq[(size_t)m * 16 + 8 + (n >> 7)] = 0.f; }
    } };
struct NEpiGate { bf16_t* G;
    __device__ __forceinline__ void operator()(int m, int n, const float (&acc)[1][4][8], int i, int tx) const {
#pragma unroll
        for (int j = 0; j < 8; ++j) G[(size_t)m * NGATE + n + j] = (bf16_t)f2bf(fmaxf(1.0f / (1.0f + expf(-acc[0][i][j])), 9.5367431640625e-07f)); } };
struct NEpiMerge { const bf16_t* G; bf16_t* MG;
    __device__ __forceinline__ void operator()(int m, int n, const float (&acc)[3][2][8], int i, int tx) const {
#pragma unroll
        for (int j = 0; j < 8; ++j) { const size_t go = (size_t)m * NGATE + n + j;
            const float v = bf2f(G[go]) * acc[0][i][j] + bf2f(G[go + 1024]) * acc[1][i][j] + bf2f(G[go + 2048]) * acc[2][i][j];
            MG[(size_t)m * DM + n + j] = (bf16_t)f2bf(v); } } };
struct NEpiWin { unsigned char* ws; const float* cosT; const float* sinT; const float *aqn, *akn, *bqn, *bkn;
    __device__ __forceinline__ void operator()(int m, int n, const float (&acc)[1][4][8], int i, int tx) const {
        size_t obase; int pitch, c0, flags; const float* gain = nullptr;
        if (n < 512)       { obase = WS_AQ; pitch = 512; c0 = 0;    flags = epi::F_NORM | epi::F_ROPE | epi::F_C2; gain = aqn; }
        else if (n < 1024) { obase = WS_AK; pitch = 512; c0 = 512;  flags = epi::F_NORM | epi::F_ROPE; gain = akn; }
        else if (n < 1536) { obase = WS_AV; pitch = 512; c0 = 1024; flags = 0; }
        else if (n < 2048) { obase = WS_BQ; pitch = 512; c0 = 1536; flags = epi::F_NORM | epi::F_C2; gain = bqn; }
        else if (n < 2560) { obase = WS_BK; pitch = 512; c0 = 2048; flags = epi::F_NORM; gain = bkn; }
        else if (n < 3072) { obase = WS_BV; pitch = 512; c0 = 2560; flags = 0; }
        else if (n < 3328) { obase = WS_CQ; pitch = 256; c0 = 3072; flags = epi::F_ROPE; }
        else if (n < 3584) { obase = WS_CK; pitch = 256; c0 = 3328; flags = epi::F_ROPE | epi::F_CKD; }
        else if (n < 4096) { obase = WS_CV; pitch = 512; c0 = 3584; flags = 0; }
        else               { obase = WS_CG; pitch = 512; c0 = 4096; flags = epi::F_SILU; }
        const int t = m & (SEQ - 1), d0 = n & 63; float v[8];
#pragma unroll
        for (int j = 0; j < 8; ++j) v[j] = acc[0][i][j];
        if (flags & epi::F_NORM) { float ss = 0.f;
#pragma unroll
            for (int j = 0; j < 8; ++j) ss += v[j] * v[j];
            ss += __shfl_xor(ss, 1); ss += __shfl_xor(ss, 2); ss += __shfl_xor(ss, 4);
            const float r = 1.0f / sqrtf(ss * (1.0f / 64.0f) + EPS);
#pragma unroll
            for (int j = 0; j < 8; ++j) v[j] = v[j] * r * gain[d0 + j]; }
        if (flags & epi::F_ROPE) {
#pragma unroll
            for (int j = 0; j < 8; ++j) { const float p = __shfl_xor(v[j], 4); const int d = d0 + j, ii = d & 31; const float c = cosT[t * 32 + ii], s = sinT[t * 32 + ii];
                v[j] = (d < 32) ? (v[j] * c - p * s) : (v[j] * c + p * s); } }
        float sc = 1.0f;
        if (flags & epi::F_C2) sc = C2;
        if (flags & epi::F_CKD) sc = 0.125f * exp2f(-(float)(t & 63) * log2_gamma((n - 3328) >> 6));
        bf16_t* o = (bf16_t*)(ws + obase) + (size_t)m * pitch + (n - c0);
#pragma unroll
        for (int j = 0; j < 8; ++j) { float y = v[j] * sc; if (flags & epi::F_SILU) y = y / (1.0f + expf(-y)); o[j] = (bf16_t)f2bf(y); }
    } };

__device__ __forceinline__ void attn_a(unsigned char* ws, const float* lq1, const float* lk1, const float* lq2, const float* lk2, const float* subln, float lam_init,
                                       LAS unsigned char* lds, int gw, int ngw, int wave, int lane) {
    const bf16_t* AQ = (const bf16_t*)(ws + WS_AQ); const bf16_t* AK = (const bf16_t*)(ws + WS_AK); const bf16_t* AV = (const bf16_t*)(ws + WS_AV); bf16_t* YA = (bf16_t*)(ws + WS_AQ);
    const float lam = expf(wave_sum(lq1[lane] * lk1[lane])) - expf(wave_sum(lq2[lane] * lk2[lane])) + lam_init;
    LAS float* qs = (LAS float*)lds + wave * 128;
    for (int task = gw; task < M * 4; task += ngw) {
        const int h = task & 3, m = task >> 2, b = m >> 13, t = m & (SEQ - 1), nch = (t >> 6) + 1;
        qs[lane] = bf2f(AQ[(size_t)m * 512 + h * 128 + lane]); qs[64 + lane] = bf2f(AQ[(size_t)m * 512 + h * 128 + 64 + lane]);
        LDS_WAIT(); asm volatile("" ::: "memory");
        float mx[2] = {-1e30f, -1e30f}, l[2] = {0.f, 0.f}, o[2][2] = {{0.f, 0.f}, {0.f, 0.f}};
        for (int c = 0; c < nch; ++c) {
            const size_t krow = (size_t)(b * SEQ + c * 64 + lane);
            float s[2] = {0.f, 0.f};
            for (int cc = 0; cc < 2; ++cc) { const u32x4* kp = (const u32x4*)(AK + krow * 512 + h * 128 + cc * 64);
                for (int q = 0; q < 8; ++q) { const u32x4 w = kp[q]; const LAS float* qq = qs + cc * 64 + q * 8;
                    s[cc] += bflo(w.x) * qq[0] + bfhi(w.x) * qq[1] + bflo(w.y) * qq[2] + bfhi(w.y) * qq[3] + bflo(w.z) * qq[4] + bfhi(w.z) * qq[5] + bflo(w.w) * qq[6] + bfhi(w.w) * qq[7]; } }
            float p[2];
            for (int cc = 0; cc < 2; ++cc) { const float mn = fmaxf(mx[cc], wave_max(s[cc])), f = exp2f(mx[cc] - mn); mx[cc] = mn; p[cc] = exp2f(s[cc] - mn);
                l[cc] = l[cc] * f + wave_sum(p[cc]); o[cc][0] *= f; o[cc][1] *= f; }
            for (int j = 0; j < 64; ++j) { const float p0 = __shfl(p[0], j), p1 = __shfl(p[1], j); const size_t vrow = (size_t)(b * SEQ + c * 64 + j) * 512 + h * 128;
                const float v0 = bf2f(AV[vrow + lane]), v1 = bf2f(AV[vrow + 64 + lane]);
                o[0][0] += p0 * v0; o[0][1] += p0 * v1; o[1][0] += p1 * v0; o[1][1] += p1 * v1; }
        }
        const float y0 = o[0][0] / l[0] - lam * o[1][0] / l[1], y1 = o[0][1] / l[0] - lam * o[1][1] / l[1];
        const float r = 1.0f / sqrtf(wave_sum(y0 * y0 + y1 * y1) * (1.0f / 128.0f) + EPS) * (1.0f - lam_init);
        YA[(size_t)m * 512 + h * 128 + lane] = (bf16_t)f2bf(y0 * r * subln[lane]); YA[(size_t)m * 512 + h * 128 + 64 + lane] = (bf16_t)f2bf(y1 * r * subln[64 + lane]);
        asm volatile("" ::: "memory");
    }
}
__device__ __forceinline__ void attn_b(unsigned char* ws, const float* relb, LAS unsigned char* lds, int gw, int ngw, int wave, int lane) {
    const bf16_t* BQ = (const bf16_t*)(ws + WS_BQ); const bf16_t* BK = (const bf16_t*)(ws + WS_BK); const bf16_t* BV = (const bf16_t*)(ws + WS_BV); bf16_t* YB = (bf16_t*)(ws + WS_BQ);
    LAS float* qs = (LAS float*)lds + wave * 128;
    for (int task = gw; task < M * 8; task += ngw) {
        const int h = task & 7, m = task >> 3, b = m >> 13, t = m & (SEQ - 1), n = t >> 6;
        qs[lane] = bf2f(BQ[(size_t)m * 512 + h * 64 + lane]);
        LDS_WAIT(); asm volatile("" ::: "memory");
        float mx = -1e30f, l = 0.f, o = 0.f;
        for (int c = (n >= 8 ? n - 8 : 0); c <= n; ++c) {
            const int kpos = c * 64 + lane; const size_t krow = (size_t)(b * SEQ + kpos);
            float s = 0.f; const u32x4* kp = (const u32x4*)(BK + krow * 512 + h * 64);
            for (int q = 0; q < 8; ++q) { const u32x4 w = kp[q]; const LAS float* qq = qs + q * 8;
                s += bflo(w.x) * qq[0] + bfhi(w.x) * qq[1] + bflo(w.y) * qq[2] + bfhi(w.y) * qq[3] + bflo(w.z) * qq[4] + bfhi(w.z) * qq[5] + bflo(w.w) * qq[6] + bfhi(w.w) * qq[7]; }
            int rel = t - kpos; rel = rel < -63 ? -63 : (rel > 256 ? 256 : rel);
            s += relb[h * 320 + rel + 63] * LOG2E;
            const float mn = fmaxf(mx, wave_max(s)), f = exp2f(mx - mn); mx = mn; const float p = exp2f(s - mn);
            l = l * f + wave_sum(p); o *= f;
            for (int j = 0; j < 64; ++j) o += __shfl(p, j) * bf2f(BV[(size_t)(b * SEQ + c * 64 + j) * 512 + h * 64 + lane]);
        }
        YB[(size_t)m * 512 + h * 64 + lane] = (bf16_t)f2bf(o / l);
        asm volatile("" ::: "memory");
    }
}
__device__ __forceinline__ void retention(unsigned char* ws, const float* onorm, LAS unsigned char* lds, int vcu, int G, int tid) {
    const bf16_t* CQ = (const bf16_t*)(ws + WS_CQ); const bf16_t* CK = (const bf16_t*)(ws + WS_CK); const bf16_t* CV = (const bf16_t*)(ws + WS_CV); bf16_t* CG = (bf16_t*)(ws + WS_CG);
    LAS float* qs = (LAS float*)lds; LAS float* ks = qs + 64 * 64; LAS float* vs = ks + 64 * 64; LAS float* os = vs + 64 * 128;
    for (int bh = vcu; bh < 8; bh += G) {
        const int b = bh >> 2, h = bh & 3; const float l2g = log2_gamma(h), gam = exp2f(l2g);
        float S[64];
#pragma unroll
        for (int d = 0; d < 64; ++d) S[d] = 0.f;
        for (int n = 0; n < SEQ / 64; ++n) {
            __syncthreads();
            for (int i = tid; i < 64 * 64; i += 512) { const int r = i >> 6, d = i & 63; const size_t row = (size_t)(b * SEQ + n * 64 + r);
                qs[i] = bf2f(CQ[row * 256 + h * 64 + d]); ks[i] = bf2f(CK[row * 256 + h * 64 + d]) * exp2f((float)r * l2g); }
            for (int i = tid; i < 64 * 128; i += 512) { const int r = i >> 7, e = i & 127; vs[i] = bf2f(CV[(size_t)(b * SEQ + n * 64 + r) * 512 + h * 128 + e]); }
            __syncthreads();
            if (tid < 128) {
                for (int r = 0; r < 64; ++r) { const float v = vs[r * 128 + tid]; float o = 0.f;
#pragma unroll
                    for (int d = 0; d < 64; ++d) { S[d] = gam * S[d] + ks[r * 64 + d] * v; o += qs[r * 64 + d] * S[d]; }
                    os[r * 128 + tid] = o; }
            }
            __syncthreads();
            { const int r = tid >> 3, e0 = (tid & 7) * 16; float ss = 0.f;
#pragma unroll
              for (int j = 0; j < 16; ++j) { const float v = os[r * 128 + e0 + j]; ss += v * v; }
              ss += __shfl_xor(ss, 1); ss += __shfl_xor(ss, 2); ss += __shfl_xor(ss, 4);
              const float rr = 1.0f / sqrtf(ss * (1.0f / 128.0f) + EPS); bf16_t* g = CG + (size_t)(b * SEQ + n * 64 + r) * 512 + h * 128 + e0;
#pragma unroll
              for (int j = 0; j < 16; ++j) g[j] = (bf16_t)f2bf(bf2f(g[j]) * os[r * 128 + e0 + j] * rr * onorm[h * 128 + e0 + j]); }
        }
    }
}
}

namespace fa {
typedef short s16x4 __attribute__((ext_vector_type(4)));
typedef short v4i16_t __attribute__((ext_vector_type(4)));
typedef LAS const unsigned char* lds_cptr;
constexpr int SLOTB = 32768, NSLOT = 3, KOFF = 0, VOFF = 16384;
constexpr int LDS_WS = NSLOT * SLOTB, LDS_BIAS = LDS_WS + 2048, LDS_END = LDS_BIAS + 2560;
constexpr float THR = 8.0f;
__device__ __forceinline__ int crow(int r, int hi) { return (r & 3) + 8 * (r >> 2) + 4 * hi; }
__device__ __forceinline__ void glds16(const void* gsrc, unsigned lds_dst) { unsigned keep;
    asm volatile("s_mov_b32 %0, m0\n\ts_mov_b32 m0, %2\n\ts_nop 0\n\tglobal_load_lds_dwordx4 %1, off\n\ts_mov_b32 m0, %0" : "=&s"(keep) : "v"(gsrc), "s"(lds_dst) : "memory"); }
#define FA_WAIT_BAR(N) asm volatile("s_waitcnt vmcnt(" #N ") lgkmcnt(0)\n\ts_barrier" ::: "memory")
#define FA_BAR() asm volatile("s_waitcnt lgkmcnt(0)\n\ts_barrier" ::: "memory")
__device__ __forceinline__ s16x4 vtr(lds_cptr p) { return __builtin_bit_cast(s16x4, __builtin_amdgcn_ds_read_tr16_b64_v4i16((LAS v4i16_t*)p)); }
__device__ __forceinline__ bf16x8 cat8(const s16x4 lo, const s16x4 hi) { return (bf16x8){lo[0], lo[1], lo[2], lo[3], hi[0], hi[1], hi[2], hi[3]}; }
__device__ __forceinline__ float swapmax(float m) { auto rr = __builtin_amdgcn_permlane32_swap(__float_as_uint(m), __float_as_uint(m), false, false); return fmaxf(__uint_as_float(rr[0]), __uint_as_float(rr[1])); }
__device__ __forceinline__ float swapsum(float m) { auto rr = __builtin_amdgcn_permlane32_swap(__float_as_uint(m), __float_as_uint(m), false, false); return __uint_as_float(rr[0]) + __uint_as_float(rr[1]); }
__device__ __forceinline__ bf16x8 pack_p(const f32x16& p, int base) { u32x4 w; w.x = cvt_pk_bf16(p[base], p[base + 1]); w.y = cvt_pk_bf16(p[base + 2], p[base + 3]); w.z = cvt_pk_bf16(p[base + 4], p[base + 5]); w.w = cvt_pk_bf16(p[base + 6], p[base + 7]); return __builtin_bit_cast(bf16x8, w); }
__device__ __forceinline__ float half_sum32(float v) {
#pragma unroll
    for (int o = 1; o < 32; o <<= 1) v += __shfl_xor(v, o);
    return v;
}

template <int MODE>
__device__ __forceinline__ void attn_unit(LAS unsigned char* lds, const int tid, const bf16_t* Qg, const bf16_t* Kg, const bf16_t* Vg, bf16_t* Yg, const int b, const int hq, const int u,
                                          const float lam, const float osc, const float* subln) {
    constexpr int PITCH = 512, NDB = (MODE == 0) ? 4 : 2;
    const int lane = tid & 63, r32 = lane & 31, hi = lane >> 5, wid = __builtin_amdgcn_readfirstlane(tid >> 6), ch = wid >> 2, wq = wid & 3;
    const int cw = 2 * u + (wq >> 1);
    const int t0 = (MODE == 0) ? 0 : ((2 * u - 8) > 0 ? (2 * u - 8) : 0), t1 = 2 * u + 1, NT = t1 - t0 + 1;
    const size_t rowbase = (size_t)b * SEQ;
    const bf16_t* Kb = Kg + rowbase * PITCH + hq * 128; const bf16_t* Vb = Vg + rowbase * PITCH + hq * 128;
    const unsigned lds0 = (unsigned)(uintptr_t)lds;
    LAS float* wsf = (LAS float*)(lds + LDS_WS) + wid * 64;
    const bf16_t* ksrc = Kb + (size_t)lane * PITCH + (2 * wid) * 8;
    const bf16_t* vsrc0 = Vb + (size_t)(16 * ((2 * wid) & 3) + (lane >> 2)) * PITCH + 32 * ((2 * wid) >> 2) + (lane & 3) * 8;
    const bf16_t* vsrc1 = Vb + (size_t)(16 * ((2 * wid + 1) & 3) + (lane >> 2)) * PITCH + 32 * ((2 * wid + 1) >> 2) + (lane & 3) * 8;
#define FA_DMA(t, slot) do { const size_t to_ = (size_t)(t) * 64 * PITCH; const unsigned sb_ = lds0 + (unsigned)(slot) * SLOTB; \
        glds16(ksrc + to_, (unsigned)__builtin_amdgcn_readfirstlane(sb_ + KOFF + (2 * wid) * 1024)); glds16(ksrc + to_ + 8, (unsigned)__builtin_amdgcn_readfirstlane(sb_ + KOFF + (2 * wid + 1) * 1024)); \
        glds16(vsrc0 + to_, (unsigned)__builtin_amdgcn_readfirstlane(sb_ + VOFF + (2 * wid) * 1024)); glds16(vsrc1 + to_, (unsigned)__builtin_amdgcn_readfirstlane(sb_ + VOFF + (2 * wid + 1) * 1024)); } while (0)
    FA_DMA(t0, 0);
    if (NT > 1) FA_DMA(t0 + 1, 1);
    const size_t qrow = rowbase + (size_t)u * 128 + wq * 32;
    bf16x8 qr[4];
#pragma unroll
    for (int i = 0; i < 4; ++i) qr[i] = *(const bf16x8*)(Qg + (qrow + r32) * PITCH + hq * 128 + ch * 64 + i * 16 + hi * 8);
    f32x16 o[NDB];
#pragma unroll
    for (int d = 0; d < NDB; ++d)
#pragma unroll
        for (int r = 0; r < 16; ++r) o[d][r] = 0.f;
    float mref = 0.f, lsum = 0.f; bool first = true;
    const lds_cptr kp0 = (lds_cptr)lds + KOFF + ch * 8192 + hi * 1024 + r32 * 16;
    const lds_cptr vp0 = (lds_cptr)lds + VOFF + ((MODE == 0) ? 0 : ch * 8192) + ((lane >> 4) & 1) * 32 + (lane & 3) * 8 + (4 * hi + ((lane & 15) >> 2)) * 64;
    int slot = 0;
    for (int i = 0; i < NT; ++i) {
        if (i + 1 < NT) FA_WAIT_BAR(4); else FA_WAIT_BAR(0);
        if (i + 2 < NT) { const int s2 = (slot == 0) ? 2 : slot - 1; FA_DMA(t0 + i + 2, s2); }
        const int t = t0 + i;
        const bool vis = (MODE == 0) ? (t <= cw) : (t <= cw && t + 8 >= cw);
        if (vis) {
            const lds_cptr kp = kp0 + slot * SLOTB; const lds_cptr vp = vp0 + slot * SLOTB;
            f32x16 p0, p1;
#pragma unroll
            for (int r = 0; r < 16; ++r) { p0[r] = 0.f; p1[r] = 0.f; }
#pragma unroll
            for (int k = 0; k < 4; ++k) {
                const bf16x8 ka = *(const LAS bf16x8*)(kp + k * 2048), kb = *(const LAS bf16x8*)(kp + k * 2048 + 512);
                p0 = __builtin_amdgcn_mfma_f32_32x32x16_bf16(ka, qr[k], p0, 0, 0, 0);
                p1 = __builtin_amdgcn_mfma_f32_32x32x16_bf16(kb, qr[k], p1, 0, 0, 0);
            }
            if (MODE == 1) {
                const LAS float* bt = (const LAS float*)(lds + LDS_BIAS) + ch * 320;
                const int relb = 64 * (cw - t) + 32 * (wq & 1) + r32 + 63;
                if (cw - t >= 5) { const float c = bt[319];
#pragma unroll
                    for (int r = 0; r < 16; ++r) { p0[r] += c; p1[r] += c; }
                } else {
#pragma unroll
                    for (int r = 0; r < 16; ++r) { const int i0 = relb - crow(r, hi), i1 = i0 - 32; p0[r] += bt[i0 > 319 ? 319 : i0]; p1[r] += bt[i1 > 319 ? 319 : i1]; }
                }
            }
            float rm = fmaxf(p0[0], p1[0]);
#pragma unroll
            for (int r = 1; r < 16; ++r) rm = fmaxf(rm, fmaxf(p0[r], p1[r]));
            rm = swapmax(rm);
            if (first) { mref = rm; first = false; }
            else if (__any(rm - mref > THR)) {
                const float dl = fmaxf(rm - mref, 0.f); mref += dl; const float f = fast_exp2(-dl); lsum *= f;
                if (hi == 0) wsf[r32] = f;
                LDS_WAIT();
#pragma unroll
                for (int r = 0; r < 16; ++r) { const float fr = wsf[crow(r, hi)];
#pragma unroll
                    for (int d = 0; d < NDB; ++d) o[d][r] *= fr; }
            }
            float sacc = 0.f;
#pragma unroll
            for (int r = 0; r < 16; ++r) { p0[r] = fast_exp2(p0[r] - mref); p1[r] = fast_exp2(p1[r] - mref); sacc += p0[r] + p1[r]; }
            lsum += sacc;
            const bf16x8 pa0 = pack_p(p0, 0), pa1 = pack_p(p0, 8), pa2 = pack_p(p1, 0), pa3 = pack_p(p1, 8);
#pragma unroll
            for (int d = 0; d < NDB; ++d) {
                const lds_cptr vd = vp + d * 4096;
                const bf16x8 v0 = cat8(vtr(vd), vtr(vd + 512)), v1 = cat8(vtr(vd + 1024), vtr(vd + 1024 + 512)), v2 = cat8(vtr(vd + 2048), vtr(vd + 2048 + 512)), v3 = cat8(vtr(vd + 3072), vtr(vd + 3072 + 512));
                o[d] = __builtin_amdgcn_mfma_f32_32x32x16_bf16(pa0, v0, o[d], 0, 0, 0);
                o[d] = __builtin_amdgcn_mfma_f32_32x32x16_bf16(pa1, v1, o[d], 0, 0, 0);
                o[d] = __builtin_amdgcn_mfma_f32_32x32x16_bf16(pa2, v2, o[d], 0, 0, 0);
                o[d] = __builtin_amdgcn_mfma_f32_32x32x16_bf16(pa3, v3, o[d], 0, 0, 0);
            }
        }
        slot = (slot == NSLOT - 1) ? 0 : slot + 1;
    }
    lsum = swapsum(lsum);
    if (hi == 0) wsf[32 + r32] = lsum;
    LDS_WAIT();
#pragma unroll
    for (int r = 0; r < 16; ++r) { const float il = fast_rcp(wsf[32 + crow(r, hi)]);
#pragma unroll
        for (int d = 0; d < NDB; ++d) o[d][r] *= il; }
    FA_BAR();
    if (MODE == 0) {
        LAS float* xf = (LAS float*)lds + (wid & 3) * 4096;
        if (ch == 1) {
#pragma unroll
            for (int d = 0; d < 4; ++d)
#pragma unroll
                for (int r = 0; r < 16; ++r) xf[(d * 16 + r) * 64 + lane] = o[d][r];
        }
        FA_BAR();
        if (ch == 0) {
            float ss[16];
#pragma unroll
            for (int r = 0; r < 16; ++r) ss[r] = 0.f;
#pragma unroll
            for (int d = 0; d < 4; ++d)
#pragma unroll
                for (int r = 0; r < 16; ++r) { const float y = o[d][r] - lam * xf[(d * 16 + r) * 64 + lane]; o[d][r] = y; ss[r] += y * y; }
            LAS bf16_t* stg = (LAS bf16_t*)(lds + 65536) + wid * 4096;
            float g[4];
#pragma unroll
            for (int d = 0; d < 4; ++d) g[d] = subln[32 * d + r32] * osc;
#pragma unroll
            for (int r = 0; r < 16; ++r) { const float rs = __builtin_amdgcn_rsqf(half_sum32(ss[r]) * (1.0f / 128.0f) + EPS); const int orow = crow(r, hi);
#pragma unroll
                for (int d = 0; d < 4; ++d) stg[orow * 128 + d * 32 + r32] = (bf16_t)f2bf(o[d][r] * rs * g[d]); }
            LDS_WAIT();
#pragma unroll
            for (int i = 0; i < 8; ++i) { const int idx = i * 64 + lane, row = idx >> 4, c8 = idx & 15;
                const u32x4 v = *(const LAS u32x4*)(stg + row * 128 + c8 * 8);
                *(u32x4*)(Yg + (qrow + row) * PITCH + hq * 128 + c8 * 8) = v; }
        }
    } else {
        LAS bf16_t* stg = (LAS bf16_t*)lds + wid * 2048;
#pragma unroll
        for (int r = 0; r < 16; ++r) { const int orow = crow(r, hi);
#pragma unroll
            for (int d = 0; d < 2; ++d) stg[orow * 64 + d * 32 + r32] = (bf16_t)f2bf(o[d][r]); }
        LDS_WAIT();
#pragma unroll
        for (int i = 0; i < 4; ++i) { const int idx = i * 64 + lane, row = idx >> 3, c8 = idx & 7;
            const u32x4 v = *(const LAS u32x4*)(stg + row * 64 + c8 * 8);
            *(u32x4*)(Yg + (qrow + row) * PITCH + hq * 128 + ch * 64 + c8 * 8) = v; }
    }
    FA_BAR();
#undef FA_DMA
}

constexpr int NSLOT2 = 4, LDS_WS2 = 132096, LDS_BIAS2 = LDS_WS2 + 2048;
template <int MODE>
__device__ __forceinline__ void attn_unit2(LAS unsigned char* lds, const int tid_, const bf16_t* Qg, const bf16_t* Kg, const bf16_t* Vg, bf16_t* Yg, const int b, const int hq, const int u,
                                           const float lam, const float osc, const float* subln, const int pm = 0) {
    constexpr int PITCH = 512, NDB = (MODE == 0) ? 4 : 2;
    int tid = tid_; asm volatile("" : "+v"(tid));
    const int lane = tid & 63, r32 = lane & 31, hi = lane >> 5, wid = __builtin_amdgcn_readfirstlane(tid >> 6), ch = wid >> 2, wq = wid & 3;
    const int cw = 2 * u + (wq >> 1);
    const int t0 = (MODE == 0) ? 0 : ((2 * u - 8) > 0 ? (2 * u - 8) : 0), t1 = 2 * u + 1, NT = t1 - t0 + 1;
    const int iv1 = cw - t0, iv0 = (MODE == 0) ? 0 : ((cw - 8 - t0) > 0 ? (cw - 8 - t0) : 0);
    const size_t rowbase = (size_t)b * SEQ;
    const bf16_t* Kb = Kg + rowbase * PITCH + hq * 128; const bf16_t* Vb = Vg + rowbase * PITCH + hq * 128;
    const unsigned lds0 = (unsigned)(uintptr_t)lds;
    LAS float* wsf = (LAS float*)(lds + LDS_WS2) + wid * 64;
    const bf16_t* ksrc = Kb + (size_t)lane * PITCH + (2 * wid) * 8;
    const bf16_t* vsrc0 = Vb + (size_t)(16 * ((2 * wid) & 3) + (lane >> 2)) * PITCH + 32 * ((2 * wid) >> 2) + (lane & 3) * 8;
    const bf16_t* vsrc1 = Vb + (size_t)(16 * ((2 * wid + 1) & 3) + (lane >> 2)) * PITCH + 32 * ((2 * wid + 1) >> 2) + (lane & 3) * 8;
#define FA_DMA(t, slot) do { if (pm == 1) break; const size_t to_ = (size_t)(t) * 64 * PITCH; const unsigned sb_ = lds0 + (unsigned)(slot) * SLOTB; \
        glds16(ksrc + to_, (unsigned)__builtin_amdgcn_readfirstlane(sb_ + KOFF + (2 * wid) * 1024)); glds16(ksrc + to_ + 8, (unsigned)__builtin_amdgcn_readfirstlane(sb_ + KOFF + (2 * wid + 1) * 1024)); \
        glds16(vsrc0 + to_, (unsigned)__builtin_amdgcn_readfirstlane(sb_ + VOFF + (2 * wid) * 1024)); glds16(vsrc1 + to_, (unsigned)__builtin_amdgcn_readfirstlane(sb_ + VOFF + (2 * wid + 1) * 1024)); } while (0)
    FA_DMA(t0, 0);
    FA_DMA(t0 + 1, 1);
    const size_t qrow = rowbase + (size_t)u * 128 + wq * 32;
    bf16x8 qr[4];
#pragma unroll
    for (int i = 0; i < 4; ++i) qr[i] = *(const bf16x8*)(Qg + (qrow + r32) * PITCH + hq * 128 + ch * 64 + i * 16 + hi * 8);
    f32x16 o[NDB];
#pragma unroll
    for (int d = 0; d < NDB; ++d)
#pragma unroll
        for (int r = 0; r < 16; ++r) o[d][r] = 0.f;
    float mref = 0.f, lsum = 0.f; bool first = true;
    const lds_cptr kp0 = (lds_cptr)lds + KOFF + ch * 8192 + hi * 1024 + r32 * 16;
    const lds_cptr vp0 = (lds_cptr)lds + VOFF + ((MODE == 0) ? 0 : ch * 8192) + ((lane >> 4) & 1) * 32 + (lane & 3) * 8 + (4 * hi + ((lane & 15) >> 2)) * 64;
    f32x16 p0, p1; bf16x8 pa0, pa1, pa2, pa3, kf[8], va[4], vb[4];
#pragma unroll
    for (int r = 0; r < 16; ++r) { p0[r] = 0.f; p1[r] = 0.f; }
    pa0 = pa1 = pa2 = pa3 = (bf16x8){0, 0, 0, 0, 0, 0, 0, 0};
#pragma unroll
    for (int k = 0; k < 4; ++k) va[k] = vb[k] = pa0;
#define FA_SB() __builtin_amdgcn_sched_barrier(0)
#define FA_KLD(i_) do { const lds_cptr kp = kp0 + ((i_) & 3) * SLOTB; \
        _Pragma("unroll") for (int k = 0; k < 4; ++k) { kf[2 * k] = *(const LAS bf16x8*)(kp + k * 2048); kf[2 * k + 1] = *(const LAS bf16x8*)(kp + k * 2048 + 512); } } while (0)
#define FA_QK(i_) do { \
        _Pragma("unroll") for (int r = 0; r < 16; ++r) { p0[r] = 0.f; p1[r] = 0.f; } \
        _Pragma("unroll") for (int k = 0; k < 4; ++k) { p0 = __builtin_amdgcn_mfma_f32_32x32x16_bf16(kf[2 * k], qr[k], p0, 0, 0, 0); p1 = __builtin_amdgcn_mfma_f32_32x32x16_bf16(kf[2 * k + 1], qr[k], p1, 0, 0, 0); } \
        if (MODE == 1) { const int t = t0 + (i_); const LAS float* bt = (const LAS float*)(lds + LDS_BIAS2) + ch * 320; const int relb = 64 * (cw - t) + 32 * (wq & 1) + r32 + 63; \
            if (cw - t >= 5) { const float c = bt[319]; _Pragma("unroll") for (int r = 0; r < 16; ++r) { p0[r] += c; p1[r] += c; } } \
            else { _Pragma("unroll") for (int r = 0; r < 16; ++r) { const int i0 = relb - crow(r, hi), i1 = i0 - 32; p0[r] += bt[i0 > 319 ? 319 : i0]; p1[r] += bt[i1 > 319 ? 319 : i1]; } } } } while (0)
#define FA_SM() do { float rm = fmaxf(p0[0], p1[0]); _Pragma("unroll") for (int r = 1; r < 16; ++r) rm = fmaxf(rm, fmaxf(p0[r], p1[r])); rm = swapmax(rm); \
        if (first) { mref = rm; first = false; } \
        else if (__any(rm - mref > THR)) { const float dl = fmaxf(rm - mref, 0.f); mref += dl; const float f = fast_exp2(-dl); lsum *= f; if (hi == 0) wsf[r32] = f; LDS_WAIT(); \
            _Pragma("unroll") for (int r = 0; r < 16; ++r) { const float fr = wsf[crow(r, hi)]; _Pragma("unroll") for (int d = 0; d < NDB; ++d) o[d][r] *= fr; } } \
        float sacc = 0.f; _Pragma("unroll") for (int r = 0; r < 16; ++r) { p0[r] = fast_exp2(p0[r] - mref); p1[r] = fast_exp2(p1[r] - mref); sacc += p0[r] + p1[r]; } lsum += sacc; \
        pa0 = pack_p(p0, 0); pa1 = pack_p(p0, 8); pa2 = pack_p(p1, 0); pa3 = pack_p(p1, 8); } while (0)
#define FA_VLD(dst, i_, d_) do { const lds_cptr vd = vp0 + ((i_) & 3) * SLOTB + (d_) * 4096; dst[0] = cat8(vtr(vd), vtr(vd + 512)); dst[1] = cat8(vtr(vd + 1024), vtr(vd + 1024 + 512)); \
        dst[2] = cat8(vtr(vd + 2048), vtr(vd + 2048 + 512)); dst[3] = cat8(vtr(vd + 3072), vtr(vd + 3072 + 512)); } while (0)
#define FA_MMA4(d_, vv) do { o[d_] = __builtin_amdgcn_mfma_f32_32x32x16_bf16(pa0, vv[0], o[d_], 0, 0, 0); o[d_] = __builtin_amdgcn_mfma_f32_32x32x16_bf16(pa1, vv[1], o[d_], 0, 0, 0); \
        o[d_] = __builtin_amdgcn_mfma_f32_32x32x16_bf16(pa2, vv[2], o[d_], 0, 0, 0); o[d_] = __builtin_amdgcn_mfma_f32_32x32x16_bf16(pa3, vv[3], o[d_], 0, 0, 0); } while (0)
#define FA_PV(i_) do { FA_VLD(vb, i_, 1); FA_SB(); FA_MMA4(0, va); FA_SB(); \
        if (NDB == 4) { FA_VLD(va, i_, 2); FA_SB(); } FA_MMA4(1, vb); FA_SB(); \
        if (NDB == 4) { FA_VLD(vb, i_, 3); FA_SB(); FA_MMA4(2, va); FA_SB(); FA_MMA4(3, vb); FA_SB(); } } while (0)
    if (ch == 0) {
#pragma unroll 1
        for (int i = 0; i < NT; ++i) {
            if (i + 1 < NT) FA_WAIT_BAR(4); else FA_WAIT_BAR(0);
            if (i + 2 < NT) FA_DMA(t0 + i + 2, (i + 2) & 3);
            if (pm != 2) {
                const bool prev = (i - 1 >= iv0) && (i - 1 <= iv1), cur = (i >= iv0) && (i <= iv1);
                if (cur) FA_KLD(i);
                FA_SB();
                if (prev) FA_PV(i - 1);
                if (cur) { FA_QK(i); FA_SB(); FA_VLD(va, i, 0); FA_SM(); FA_SB(); }
            }
        }
        if (NT - 1 <= iv1 && pm != 2) FA_PV(NT - 1);
    } else {
#pragma unroll 1
        for (int i = 0; i < NT; ++i) {
            if (i + 1 < NT) FA_WAIT_BAR(4); else FA_WAIT_BAR(0);
            if (i + 2 < NT) FA_DMA(t0 + i + 2, (i + 2) & 3);
            if (pm != 2) {
                const bool prev = (i - 1 >= iv0) && (i - 1 <= iv1), cur = (i >= iv0) && (i <= iv1);
                if (cur) FA_KLD(i);
                if (prev) FA_VLD(va, i - 1, 0);
                FA_SB();
                if (prev) { FA_SM(); FA_SB(); FA_PV(i - 1); }
                if (cur) { FA_QK(i); FA_SB(); }
            }
        }
        if (NT - 1 <= iv1 && pm != 2) { FA_VLD(va, NT - 1, 0); FA_SB(); FA_SM(); FA_SB(); FA_PV(NT - 1); }
    }
#undef FA_KLD
#undef FA_MMA4
#undef FA_SB
#undef FA_QK
#undef FA_SM
#undef FA_VLD
#undef FA_PV
    lsum = swapsum(lsum);
    if (hi == 0) wsf[32 + r32] = lsum;
    LDS_WAIT();
#pragma unroll
    for (int r = 0; r < 16; ++r) { const float il = fast_rcp(wsf[32 + crow(r, hi)]);
#pragma unroll
        for (int d = 0; d < NDB; ++d) o[d][r] *= il; }
    FA_BAR();
    if (MODE == 0) {
        LAS float* xf = (LAS float*)lds + (wid & 3) * 4096;
        if (ch == 1) {
#pragma unroll
            for (int d = 0; d < 4; ++d)
#pragma unroll
                for (int r = 0; r < 16; ++r) xf[(d * 16 + r) * 64 + lane] = o[d][r];
        }
        FA_BAR();
        if (ch == 0) {
            float ss[16];
#pragma unroll
            for (int r = 0; r < 16; ++r) ss[r] = 0.f;
#pragma unroll
            for (int d = 0; d < 4; ++d)
#pragma unroll
                for (int r = 0; r < 16; ++r) { const float y = o[d][r] - lam * xf[(d * 16 + r) * 64 + lane]; o[d][r] = y; ss[r] += y * y; }
            LAS bf16_t* stg = (LAS bf16_t*)(lds + 65536) + wid * 4096;
            float g[4];
#pragma unroll
            for (int d = 0; d < 4; ++d) g[d] = subln[32 * d + r32] * osc;
#pragma unroll
            for (int r = 0; r < 16; ++r) { const float rs = __builtin_amdgcn_rsqf(half_sum32(ss[r]) * (1.0f / 128.0f) + EPS); const int orow = crow(r, hi);
#pragma unroll
                for (int d = 0; d < 4; ++d) stg[orow * 128 + d * 32 + r32] = (bf16_t)f2bf(o[d][r] * rs * g[d]); }
            LDS_WAIT();
#pragma unroll
            for (int i = 0; i < 8; ++i) { const int idx = i * 64 + lane, row = idx >> 4, c8 = idx & 15;
                const u32x4 v = *(const LAS u32x4*)(stg + row * 128 + c8 * 8);
                *(u32x4*)(Yg + (qrow + row) * PITCH + hq * 128 + c8 * 8) = v; }
        }
    } else {
        LAS bf16_t* stg = (LAS bf16_t*)lds + wid * 2048;
#pragma unroll
        for (int r = 0; r < 16; ++r) { const int orow = crow(r, hi);
#pragma unroll
            for (int d = 0; d < 2; ++d) stg[orow * 64 + d * 32 + r32] = (bf16_t)f2bf(o[d][r]); }
        LDS_WAIT();
#pragma unroll
        for (int i = 0; i < 4; ++i) { const int idx = i * 64 + lane, row = idx >> 3, c8 = idx & 7;
            const u32x4 v = *(const LAS u32x4*)(stg + row * 64 + c8 * 8);
            *(u32x4*)(Yg + (qrow + row) * PITCH + hq * 128 + ch * 64 + c8 * 8) = v; }
    }
    FA_BAR();
#undef FA_DMA
}

#if FA_V2
#define FA_UNIT attn_unit2
#else
#define FA_UNIT attn_unit
#endif
__device__ __forceinline__ void attn_a_phase(LAS unsigned char* lds, const int tid, unsigned char* ws, bf16_t* yout, const int vcu, const int G, const float* lq1, const float* lk1, const float* lq2, const float* lk2,
                                             const float* subln, const float lam_init, const int pm = 0) {
    const int lane = tid & 63;
    const float lamv = expf(wave_sum(lq1[lane] * lk1[lane])) - expf(wave_sum(lq2[lane] * lk2[lane])) + lam_init;
    const float lam = __uint_as_float(__builtin_amdgcn_readfirstlane(__float_as_uint(lamv)));
    for (int v = vcu; v < 256; v += G) {
        const int bh = v >> 5, p = v & 31;
#pragma unroll 1
        for (int k = 0; k < 2; ++k)
            FA_UNIT<0>(lds, tid, (const bf16_t*)(ws + WS_AQ), (const bf16_t*)(ws + WS_AK), (const bf16_t*)(ws + WS_AV), yout, bh >> 2, bh & 3, k ? 63 - p : p, lam, 1.0f - lam_init, subln, pm);
    }
}
__device__ __forceinline__ void attn_b_phase(LAS unsigned char* lds, const int tid, unsigned char* ws, bf16_t* yout, const int vcu, const int G, const float* relb) {
    for (int v = vcu; v < 256; v += G) {
        const int bp = v >> 5, b = bp >> 2, hp = bp & 3;
        LAS float* bt = (LAS float*)(lds + (FA_V2 ? LDS_BIAS2 : LDS_BIAS));
        for (int i = tid; i < 640; i += 512) bt[i] = relb[(2 * hp) * 320 + i] * LOG2E;
        FA_BAR();
#pragma unroll 1
        for (int k = 0; k < 2; ++k)
            FA_UNIT<1>(lds, tid, (const bf16_t*)(ws + WS_BQ), (const bf16_t*)(ws + WS_BK), (const bf16_t*)(ws + WS_BV), yout, b, hp, 2 * (v & 31) + k, 0.f, 0.f, nullptr);
    }
}

__device__ __forceinline__ void ret_kv_phase(LAS unsigned char* lds, const int tid_, unsigned char* ws, const int gw, const int ngw) {
    int tid = tid_; asm volatile("" : "+v"(tid));
    const int lane = tid & 63, r32 = lane & 31, hi = lane >> 5, wid = __builtin_amdgcn_readfirstlane(tid >> 6);
    const bf16_t* CK = (const bf16_t*)(ws + WS_CK); const bf16_t* CV = (const bf16_t*)(ws + WS_CV); float* KVT = (float*)(ws + WS_R4);
    LAS unsigned char* wl = lds + wid * 16384; const unsigned wl0 = (unsigned)(uintptr_t)wl;
    const lds_cptr tp0 = (lds_cptr)wl + ((lane >> 4) & 1) * 32 + (lane & 3) * 8 + (4 * hi + ((lane & 15) >> 2)) * 64;
    for (int task = gw; task < 2048; task += ngw) {
        const int eh = task & 1, n = (task >> 1) & 127, bh = task >> 8, b = bh >> 2, h = bh & 3;
        const size_t row0 = (size_t)b * SEQ + n * 64;
#pragma unroll
        for (int p = 0; p < 8; ++p) {
            glds16(CK + (row0 + 16 * (p & 3) + (lane >> 2)) * 256 + h * 64 + 32 * (p >> 2) + (lane & 3) * 8, (unsigned)__builtin_amdgcn_readfirstlane(wl0 + p * 1024));
            glds16(CV + (row0 + 16 * (p & 3) + (lane >> 2)) * 512 + h * 128 + eh * 64 + 32 * (p >> 2) + (lane & 3) * 8, (unsigned)__builtin_amdgcn_readfirstlane(wl0 + 8192 + p * 1024));
        }
        asm volatile("s_waitcnt vmcnt(0)" ::: "memory");
#pragma unroll
        for (int eb = 0; eb < 2; ++eb)
#pragma unroll
            for (int db = 0; db < 2; ++db) {
                f32x16 acc;
#pragma unroll
                for (int r = 0; r < 16; ++r) acc[r] = 0.f;
#pragma unroll
                for (int s = 0; s < 4; ++s) {
                    const lds_cptr va = tp0 + 8192 + (eb * 4 + s) * 1024, ka = tp0 + (db * 4 + s) * 1024;
                    acc = __builtin_amdgcn_mfma_f32_32x32x16_bf16(cat8(vtr(va), vtr(va + 512)), cat8(vtr(ka), vtr(ka + 512)), acc, 0, 0, 0);
                }
                float* dst = KVT + ((size_t)(bh * 128 + n) * 128 + eh * 64 + eb * 32) * 64 + db * 32 + r32;
#pragma unroll
                for (int r = 0; r < 16; ++r) dst[(size_t)crow(r, hi) * 64] = acc[r];
            }
        LDS_WAIT(); asm volatile("" ::: "memory");
    }
}
__device__ __forceinline__ void ret_scan_phase(const int tid, unsigned char* ws, const int vcu, const int G) {
    float* KVT = (float*)(ws + WS_R4);
    for (int gt = vcu * 512 + tid; gt < 65536; gt += G * 512) {
        const int bh = gt >> 13, idx = gt & 8191, h = bh & 3;
        const float l2g = log2_gamma(h), gam = fast_exp2(l2g), g63 = fast_exp2(63.f * l2g), g64 = fast_exp2(64.f * l2g);
        float* p = KVT + (size_t)bh * 128 * 8192 + idx; float s = 0.f;
        for (int n0 = 0; n0 < 128; n0 += 16) {
            float kv[16];
#pragma unroll
            for (int j = 0; j < 16; ++j) kv[j] = p[(size_t)(n0 + j) * 8192];
#pragma unroll
            for (int j = 0; j < 16; ++j) { p[(size_t)(n0 + j) * 8192] = gam * s; s = g64 * s + g63 * kv[j]; }
        }
    }
}
__device__ __forceinline__ void ret_out_phase(LAS unsigned char* lds, const int tid_, unsigned char* ws, const int gw, const int ngw, const float* onorm) {
    int tid = tid_; asm volatile("" : "+v"(tid));
    const int lane = tid & 63, r32 = lane & 31, hi = lane >> 5, wid = __builtin_amdgcn_readfirstlane(tid >> 6);
    const bf16_t* CQ = (const bf16_t*)(ws + WS_CQ); const bf16_t* CK = (const bf16_t*)(ws + WS_CK); const bf16_t* CV = (const bf16_t*)(ws + WS_CV); bf16_t* CG = (bf16_t*)(ws + WS_CG);
    const float* KVT = (const float*)(ws + WS_R4);
    LAS unsigned char* wl = lds + wid * 16384; const unsigned wl0 = (unsigned)(uintptr_t)wl;
    const lds_cptr tp0 = (lds_cptr)wl + ((lane >> 4) & 1) * 32 + (lane & 3) * 8 + (4 * hi + ((lane & 15) >> 2)) * 64;
    for (int task = gw; task < 2048; task += ngw) {
        const int rh = task & 1, n = (task >> 1) & 127, bh = task >> 8, b = bh >> 2, h = bh & 3;
        const size_t row0 = (size_t)b * SEQ + n * 64;
        const float l2g = log2_gamma(h);
#pragma unroll
        for (int p = 0; p < 16; ++p)
            glds16(CV + (row0 + 16 * (p & 3) + (lane >> 2)) * 512 + h * 128 + 32 * (p >> 2) + (lane & 3) * 8, (unsigned)__builtin_amdgcn_readfirstlane(wl0 + p * 1024));
        bf16x8 qr[4], kf[8];
#pragma unroll
        for (int i = 0; i < 4; ++i) {
            qr[i] = *(const bf16x8*)(CQ + (row0 + 32 * rh + r32) * 256 + h * 64 + i * 16 + hi * 8);
            kf[2 * i] = *(const bf16x8*)(CK + (row0 + r32) * 256 + h * 64 + i * 16 + hi * 8);
            kf[2 * i + 1] = *(const bf16x8*)(CK + (row0 + 32 + r32) * 256 + h * 64 + i * 16 + hi * 8);
        }
        f32x16 p0, p1;
#pragma unroll
        for (int r = 0; r < 16; ++r) { p0[r] = 0.f; p1[r] = 0.f; }
#pragma unroll
        for (int i = 0; i < 4; ++i) { p0 = __builtin_amdgcn_mfma_f32_32x32x16_bf16(kf[2 * i], qr[i], p0, 0, 0, 0); p1 = __builtin_amdgcn_mfma_f32_32x32x16_bf16(kf[2 * i + 1], qr[i], p1, 0, 0, 0); }
        const int qi = 32 * rh + r32;
#pragma unroll
        for (int r = 0; r < 16; ++r) { const int key = crow(r, hi); if (key > qi) p0[r] = 0.f; if (key + 32 > qi) p1[r] = 0.f; }
        const bf16x8 pa0 = pack_p(p0, 0), pa1 = pack_p(p0, 8), pa2 = pack_p(p1, 0), pa3 = pack_p(p1, 8);
        asm volatile("s_waitcnt vmcnt(0)" ::: "memory");
        const float* st = KVT + (size_t)(bh * 128 + n) * 8192;
        f32x16 o[4];
#pragma unroll
        for (int d = 0; d < 4; ++d) {
            const lds_cptr vd = tp0 + d * 4096;
            f32x16 a;
#pragma unroll
            for (int r = 0; r < 16; ++r) a[r] = 0.f;
            a = __builtin_amdgcn_mfma_f32_32x32x16_bf16(pa0, cat8(vtr(vd), vtr(vd + 512)), a, 0, 0, 0);
            a = __builtin_amdgcn_mfma_f32_32x32x16_bf16(pa1, cat8(vtr(vd + 1024), vtr(vd + 1024 + 512)), a, 0, 0, 0);
            a = __builtin_amdgcn_mfma_f32_32x32x16_bf16(pa2, cat8(vtr(vd + 2048), vtr(vd + 2048 + 512)), a, 0, 0, 0);
            a = __builtin_amdgcn_mfma_f32_32x32x16_bf16(pa3, cat8(vtr(vd + 3072), vtr(vd + 3072 + 512)), a, 0, 0, 0);
#pragma unroll
            for (int i = 0; i < 4; ++i) {
                const f32x4 s0 = *(const f32x4*)(st + (size_t)(32 * d + r32) * 64 + i * 16 + hi * 8), s1 = *(const f32x4*)(st + (size_t)(32 * d + r32) * 64 + i * 16 + hi * 8 + 4);
                a = __builtin_amdgcn_mfma_f32_32x32x16_bf16(qr[i], __builtin_bit_cast(bf16x8, epi::pack8(s0, s1)), a, 0, 0, 0);
            }
            o[d] = a;
        }
        LDS_WAIT(); asm volatile("" ::: "memory");
        LAS float* stg = (LAS float*)wl;
        float gn[4];
#pragma unroll
        for (int d = 0; d < 4; ++d) gn[d] = onorm[h * 128 + 32 * d + r32];
#pragma unroll
        for (int r = 0; r < 16; ++r) {
            const float dec = fast_exp2((float)(32 * rh + crow(r, hi)) * l2g);
            float ss = 0.f;
#pragma unroll
            for (int d = 0; d < 4; ++d) { o[d][r] *= dec; ss += o[d][r] * o[d][r]; }
            const float rs = __builtin_amdgcn_rsqf(half_sum32(ss) * (1.0f / 128.0f) + EPS);
#pragma unroll
            for (int d = 0; d < 4; ++d) stg[crow(r, hi) * 128 + d * 32 + r32] = o[d][r] * rs * gn[d];
        }
        LDS_WAIT(); asm volatile("" ::: "memory");
#pragma unroll
        for (int i = 0; i < 8; ++i) { const int idx = i * 64 + lane, row = idx >> 4, c8 = idx & 15;
            const f32x4 y0 = *(const LAS f32x4*)(stg + row * 128 + c8 * 8), y1 = *(const LAS f32x4*)(stg + row * 128 + c8 * 8 + 4);
            bf16_t* gp = CG + (row0 + 32 * rh + row) * 512 + h * 128 + c8 * 8;
            const u32x4 gv = *(const u32x4*)gp;
            const f32x4 g0 = {bflo(gv.x), bfhi(gv.x), bflo(gv.y), bfhi(gv.y)}, g1 = {bflo(gv.z), bfhi(gv.z), bflo(gv.w), bfhi(gv.w)};
            *(u32x4*)gp = epi::pack8(y0 * g0, y1 * g1); }
        LDS_WAIT(); asm volatile("" ::: "memory");
    }
}
}
#define XB_TMO      128
#define XB_XCNT(j)  (256  + 64 * (j))
#define XB_XSUB(j)  (1280 + 64 * (j))
#define XB_XGEN(j)  (2304 + 64 * (j))
#define XB_TOP      3328
#define XB_TOPGEN   3392
#define XCD_BAR_WORDS 3456
#define XB_SPIN_CAP (1u << 18)

__device__ __forceinline__ unsigned xb_ld(unsigned* p)              { return __hip_atomic_load(p, __ATOMIC_RELAXED, __HIP_MEMORY_SCOPE_AGENT); }
__device__ __forceinline__ unsigned xb_add(unsigned* p, unsigned v) { return __hip_atomic_fetch_add(p, v, __ATOMIC_RELAXED, __HIP_MEMORY_SCOPE_AGENT); }
__device__ __forceinline__ unsigned xb_xcc_id() { return (unsigned)__builtin_amdgcn_s_getreg((3 << 11) | 20) & 0xFu; }
#define XB_SPIN(cond, bar) do { unsigned _sp = 0; while (cond) { __builtin_amdgcn_s_sleep(1); \
    if ((++_sp & 255u) == 0u) { if (xb_ld(&(bar)[XB_TMO])) break; if (_sp > XB_SPIN_CAP) { atomicAdd(&(bar)[XB_TMO], 1u); break; } } } } while (0)

struct XcdBarrier {
    unsigned* bar; unsigned x;
    volatile LAS unsigned* st;
};

__device__ __forceinline__ XcdBarrier xcd_barrier_post(unsigned* bar, volatile LAS unsigned* st) {
    XcdBarrier b; b.bar = bar; b.x = xb_xcc_id(); b.st = st;
    if (threadIdx.x == 0) (void)xb_add(&bar[XB_XCNT(b.x)], 1u);
    return b;
}
__device__ __forceinline__ void xcd_barrier_complete(unsigned* bar, unsigned x, unsigned& nloc, unsigned& nx) {
    const unsigned G = gridDim.x * gridDim.y * gridDim.z;
    unsigned sum, cnt, mine, sp = 0u;
    for (;;) {
        sum = 0u; cnt = 0u; mine = 0u;
#pragma unroll
        for (unsigned j = 0; j < 16; ++j) { const unsigned c = xb_ld(&bar[XB_XCNT(j)]); sum += c; cnt += (c > 0u) ? 1u : 0u; mine = (j == x) ? c : mine; }
        if (sum == G) break;
        __builtin_amdgcn_s_sleep(1);
        if ((++sp & 255u) == 0u) { if (xb_ld(&bar[XB_TMO])) break; if (sp > XB_SPIN_CAP) { atomicAdd(&bar[XB_TMO], 1u); break; } }
    }
    nloc = mine > 0u ? mine : 1u; nx = cnt > 0u ? cnt : 1u;
}

__device__ __forceinline__ void xcd_barrier(const XcdBarrier& b) {
    asm volatile("s_waitcnt vmcnt(0)" ::: "memory");
    __syncthreads();
    if (threadIdx.x == 0) {
        unsigned* bar = b.bar;
        __builtin_amdgcn_s_waitcnt(0);
        unsigned nloc = b.st[0], nx = b.st[1];
        if (nloc == 0u) { xcd_barrier_complete(bar, b.x, nloc, nx); b.st[0] = nloc; b.st[1] = nx; }
        const unsigned old = xb_add(&bar[XB_XSUB(b.x)], 1u);
        const unsigned gen = old / nloc;
        if (old + 1u == (gen + 1u) * nloc) {
            __builtin_amdgcn_fence(__ATOMIC_RELEASE, "agent");
            asm volatile("s_waitcnt vmcnt(0)" ::: "memory");
            const unsigned og = xb_add(&bar[XB_TOP], 1u);
            const unsigned tg = og / nx;
            if (og + 1u == (tg + 1u) * nx) xb_add(&bar[XB_TOPGEN], 1u);
            else XB_SPIN(xb_ld(&bar[XB_TOPGEN]) == tg, bar);
            __builtin_amdgcn_fence(__ATOMIC_ACQUIRE, "agent");
            xb_add(&bar[XB_XGEN(b.x)], 1u);
            asm volatile("s_waitcnt vmcnt(0)" ::: "memory");
        } else {
            XB_SPIN(xb_ld(&bar[XB_XGEN(b.x)]) == gen, bar);
            __builtin_amdgcn_fence(__ATOMIC_ACQUIRE, "agent");
            asm volatile("s_waitcnt vmcnt(0)" ::: "memory");
        }
    }
    __syncthreads();
}

constexpr int NWAVES = 8;
constexpr int RING_OFF = 0, RING_BYTES = 131072;
constexpr int LDSCTL_OFF = RING_BYTES, MISC_OFF = LDSCTL_OFF + 320;
constexpr int LDS_BYTES = 147456;
constexpr int CW_TMO = 0, CW_CODE = 1, CW_BAR = 4096;
constexpr int N_PHASES = 1 + 12 * DEPTH;

#define CAS __attribute__((address_space(4)))
struct Args { const GAS float* in[N_IN]; GAS float* out; GAS unsigned char* ws; double ropec[32]; float lam_init[2]; };

template <class T> __device__ __forceinline__ T* as_global(GAS T* p) { return (T*)p; }
__device__ __forceinline__ int conv_dst_row(int mode, int row_off, int n0) {
    if (mode == 0) return row_off + n0;
    if (mode == 1) return 256 * (n0 >> 7) + (n0 & 127) + row_off;
    return (n0 < NIN1) ? ((n0 & ~255) + 128 * ((n0 >> 5) & 1) + 32 * ((n0 >> 6) & 3)) : n0;
}
__device__ __forceinline__ void conv_item(const float* W, const float* gain, int K, int N, bf16_t* WT, int mode, int row_off, LAS float* scr, int item, int lane) {
    const int nblk = N / 32, kb = item / nblk, nb = item % nblk, k0 = 64 * kb, n0 = 32 * nb;
#pragma unroll 8
    for (int i = 0; i < 32; ++i) { const int kk = 2 * i + (lane >> 5); float v = W[(size_t)(k0 + kk) * N + n0 + (lane & 31)]; if (gain) v *= gain[k0 + kk]; scr[kk * 33 + (lane & 31)] = v; }
    LDS_WAIT(); asm volatile("" ::: "memory");
    const int c = lane & 7, drow = conv_dst_row(mode, row_off, n0);
#pragma unroll
    for (int j = 0; j < 4; ++j) { const int n = (lane >> 3) + 8 * j; const LAS float* s = scr + (8 * c) * 33 + n;
        u32x4 o; o.x = pk2(s[0 * 33], s[1 * 33]); o.y = pk2(s[2 * 33], s[3 * 33]); o.z = pk2(s[4 * 33], s[5 * 33]); o.w = pk2(s[6 * 33], s[7 * 33]);
        *(GAS u32x4*)(WT + (size_t)(drow + n) * K + k0 + 8 * c) = o; }
    LDS_WAIT(); asm volatile("" ::: "memory");
}
__device__ __forceinline__ void convert_layer(const CAS Args& a, unsigned char* ws, int l, LAS unsigned char* lds, int gw, int ngw, int wave, int lane) {
    LAS float* scr = (LAS float*)(lds + wave * 16384);
    unsigned char* wb = ws + WS_W;
    constexpr int I_GU = (DM / 64) * (DFF / 32), I_D = (DFF / 64) * (DM / 32), I_IN = (DM / 64) * (NIN / 32), I_BR = (512 / 64) * (DM / 32), I_O = (DM / 64) * (DM / 32);
    constexpr int NITEMS = 4 * I_GU + 2 * I_D + I_IN + 3 * I_BR + I_O;
    const size_t oGU = (size_t)l * DM * DFF, oD = (size_t)l * DFF * DM, oIN = (size_t)l * DM * NIN, oBR = (size_t)l * 512 * DM, oO = (size_t)l * DM * DM;
    for (int it = gw; it < NITEMS; it += ngw) {
        int r = it;
        if (r < I_GU) { conv_item(as_global(a.in[I_F1G]) + oGU, as_global(a.in[I_F1N]) + l * DM, DM, DFF, (bf16_t*)(wb + W_GU1), 1, 0, scr, r, lane); continue; } r -= I_GU;
        if (r < I_GU) { conv_item(as_global(a.in[I_F1U]) + oGU, as_global(a.in[I_F1N]) + l * DM, DM, DFF, (bf16_t*)(wb + W_GU1), 1, 128, scr, r, lane); continue; } r -= I_GU;
        if (r < I_D)  { conv_item(as_global(a.in[I_F1D]) + oD, nullptr, DFF, DM, (bf16_t*)(wb + W_D1), 0, 0, scr, r, lane); continue; } r -= I_D;
        if (r < I_IN) { conv_item(as_global(a.in[I_WIN]) + oIN, as_global(a.in[I_MIXN]) + l * DM, DM, NIN, (bf16_t*)(wb + W_IN), 2, 0, scr, r, lane); continue; } r -= I_IN;
        if (r < I_BR) { conv_item(as_global(a.in[I_WBA]) + oBR, nullptr, 512, DM, (bf16_t*)(wb + W_BR), 0, 0, scr, r, lane); continue; } r -= I_BR;
        if (r < I_BR) { conv_item(as_global(a.in[I_WBB]) + oBR, nullptr, 512, DM, (bf16_t*)(wb + W_BR), 0, DM, scr, r, lane); continue; } r -= I_BR;
        if (r < I_BR) { conv_item(as_global(a.in[I_WBC]) + oBR, nullptr, 512, DM, (bf16_t*)(wb + W_BR), 0, 2 * DM, scr, r, lane); continue; } r -= I_BR;
        if (r < I_O)  { conv_item(as_global(a.in[I_WOUT]) + oO, nullptr, DM, DM, (bf16_t*)(wb + W_OUT), 0, 0, scr, r, lane); continue; } r -= I_O;
        if (r < I_GU) { conv_item(as_global(a.in[I_F2G]) + oGU, as_global(a.in[I_F2N]) + l * DM, DM, DFF, (bf16_t*)(wb + W_GU2), 1, 0, scr, r, lane); continue; } r -= I_GU;
        if (r < I_GU) { conv_item(as_global(a.in[I_F2U]) + oGU, as_global(a.in[I_F2N]) + l * DM, DM, DFF, (bf16_t*)(wb + W_GU2), 1, 128, scr, r, lane); continue; } r -= I_GU;
        conv_item(as_global(a.in[I_F2D]) + oD, nullptr, DFF, DM, (bf16_t*)(wb + W_D2), 0, 0, scr, r, lane);
    }
}
__device__ __forceinline__ void rope_tables(const CAS Args& a, unsigned char* ws, int gtid, int ngt) {
    float* cosT = (float*)(ws + WS_COS); float* sinT = (float*)(ws + WS_SIN);
    for (int i = gtid; i < SEQ * 32; i += ngt) { const int t = i >> 5, k = i & 31;
        const double rev = (double)t * a.ropec[k]; const float fr = (float)(rev - floor(rev));
        cosT[i] = __builtin_amdgcn_cosf(fr); sinT[i] = __builtin_amdgcn_sinf(fr); }
}

struct Ctx { LAS unsigned char* lds; int tid, lane, wave, vcu, G, bx, gw, ngw; unsigned char* ws; float* X; const CAS Args* ap; };
enum { K_PRO = 0, K_CONV, K_UP, K_DOWN, K_WIN, K_KV, K_SCAN, K_MIX, K_GATE, K_MERGE, K_WOUT, N_KINDS };
__host__ __device__ __forceinline__ void phase_decode(int ph, int& kind, int& l, int& ffn2) {
    if (ph == 0) { kind = K_PRO; l = 0; ffn2 = 0; return; }
    const int k = (ph - 1) % 12; l = (ph - 1) / 12; ffn2 = (k >= 10);
    const int tab[12] = {K_CONV, K_UP, K_DOWN, K_WIN, K_KV, K_SCAN, K_MIX, K_GATE, K_MERGE, K_WOUT, K_UP, K_DOWN};
    kind = (k == 0) ? K_CONV : (k == 1 || k == 10) ? K_UP : (k == 2 || k == 11) ? K_DOWN : (k == 3) ? K_WIN : (k == 4) ? K_KV : (k == 5) ? K_SCAN : (k == 6) ? K_MIX : (k == 7) ? K_GATE : (k == 8) ? K_MERGE : K_WOUT;
    (void)tab;
}
template <int KIND>
__device__ __forceinline__ void phase_body(const Ctx& c, const int l, const int ffn2) {
    const CAS Args& args = *c.ap; unsigned char* ws = c.ws; float* X = c.X; LAS unsigned char* lds = c.lds;
    const int tid = c.tid, lane = c.lane, wave = c.wave, vcu = c.vcu, G = c.G, bx = c.bx, gw = c.gw, ngw = c.ngw;
    bf16_t* XB = (bf16_t*)(ws + WS_XB); float* SSQ = (float*)(ws + WS_SSQ);
    const float* cosT = (const float*)(ws + WS_COS); const float* sinT = (const float*)(ws + WS_SIN);
    unsigned char* wb = ws + WS_W;
    (void)tid; (void)lane; (void)wave; (void)vcu; (void)G; (void)bx; (void)gw; (void)ngw; (void)XB; (void)SSQ; (void)cosT; (void)sinT; (void)wb; (void)X; (void)lds;
    if constexpr (KIND == K_PRO) {
        rope_tables(args, ws, (vcu * NWAVES * 64) + tid, G * NWAVES * 64);
        if (bx == 0 && tid < 4) ((unsigned*)(ws + WS_ONES))[tid] = 0x3f803f80u;
        naive::xb_ssq_pass(as_global(args.in[I_X]), XB, SSQ, gw, ngw, lane);
        convert_layer(args, ws, 0, lds, gw, ngw, wave, lane);
    } else if constexpr (KIND == K_CONV) {
        if (l > 0) convert_layer(args, ws, l, lds, gw, ngw, wave, lane);
    } else if constexpr (KIND == K_UP) {
#if NAIVE_UP
        const float* xin = (l == 0 && !ffn2) ? as_global(args.in[I_X]) : X;
        naive::gemm<2, true, true, 4>(lds, tid, vcu, G, DFF, DM, xin, (ffn2 ? as_global(args.in[I_F2N]) : as_global(args.in[I_F1N])) + l * DM, nullptr, nullptr, nullptr, 0,
                                   (ffn2 ? as_global(args.in[I_F2G]) : as_global(args.in[I_F1G])) + (size_t)l * DM * DFF, (ffn2 ? as_global(args.in[I_F2U]) : as_global(args.in[I_F1U])) + (size_t)l * DM * DFF, nullptr, DFF, naive::NEpiUp{(bf16_t*)(ws + WS_HB)});
#else
        pg8::Gemm g{XB, (const bf16_t*)(wb + (ffn2 ? W_GU2 : W_GU1)), DM, 0, 0};
        pg8::StaticOrder S; S.init(M, 2 * DFF, G, bx);
        epi::fill_rstd_table(lds, tid, SSQ, S); __syncthreads();
        pg8::gemm_phase(lds + RING_OFF, tid, g, S, epi::EpiUp{(bf16_t*)(ws + WS_HB), (const LAS float*)(lds + epi::EPI_RSTD_OFF)});
#endif
    } else if constexpr (KIND == K_DOWN) {
        const float* xold = (l == 0 && !ffn2) ? as_global(args.in[I_X]) : X;
#if NAIVE_DOWN
        naive::gemm<1, true, false, 4>(lds, tid, vcu, G, DM, DFF, nullptr, nullptr, (const bf16_t*)(ws + WS_HB), nullptr, nullptr, DFF,
                                    (ffn2 ? as_global(args.in[I_F2D]) : as_global(args.in[I_F1D])) + (size_t)l * DFF * DM, nullptr, nullptr, DM, naive::NEpiRes{xold, X, XB, SSQ, 0.5f});
#else
        pg8::Gemm g{(const bf16_t*)(ws + WS_HB), (const bf16_t*)(wb + (ffn2 ? W_D2 : W_D1)), DFF, 0, 0};
        pg8::StaticOrder S; S.init(M, DM, G, bx);
        pg8::gemm_phase(lds + RING_OFF, tid, g, S, epi::EpiRes{xold, X, XB, SSQ, 0.5f});
#endif
    } else if constexpr (KIND == K_WIN) {
#if NAIVE_WIN
        naive::gemm<1, true, true, 4>(lds, tid, vcu, G, NIN1, DM, X, as_global(args.in[I_MIXN]) + l * DM, nullptr, nullptr, nullptr, 0,
                                   as_global(args.in[I_WIN]) + (size_t)l * DM * NIN, nullptr, nullptr, NIN,
                                   naive::NEpiWin{ws, cosT, sinT, as_global(args.in[I_AQN]) + l * 64, as_global(args.in[I_AKN]) + l * 64, as_global(args.in[I_BQN]) + l * 64, as_global(args.in[I_BKN]) + l * 64});
#else
        pg8::Gemm g{XB, (const bf16_t*)(wb + W_IN), DM, 0, 0};
        pg8::StaticOrder S; S.init(M, NIN1, G, bx);
        epi::fill_rstd_table(lds, tid, SSQ, S);
        { LAS float* gt = (LAS float*)(lds + epi::EPI_GAIN_OFF); LAS float* rt = (LAS float*)(lds + epi::EPI_ROPE_OFF);
          if (tid < 256) { const int kq = tid >> 6; const float* gp = (kq == 0) ? as_global(args.in[I_AQN]) : (kq == 1) ? as_global(args.in[I_AKN]) : (kq == 2) ? as_global(args.in[I_BQN]) : as_global(args.in[I_BKN]); gt[tid] = gp[l * 64 + (tid & 63)]; }
          else if (tid < 288) rt[tid - 256] = (float)args.ropec[tid - 256]; }
        __syncthreads();
        pg8::gemm_phase(lds + RING_OFF, tid, g, S, epi::EpiWin{ws, (const LAS float*)(lds + epi::EPI_RSTD_OFF), (const LAS float*)(lds + epi::EPI_GAIN_OFF), (const LAS float*)(lds + epi::EPI_ROPE_OFF)});
#endif
    } else if constexpr (KIND == K_KV) {
#if !NAIVE_C
        fa::ret_kv_phase(lds, tid, ws, gw, ngw);
#endif
    } else if constexpr (KIND == K_SCAN) {
#if !NAIVE_C
        fa::ret_scan_phase(tid, ws, vcu, G);
#endif
    } else if constexpr (KIND == K_MIX) {
#if NAIVE_C
        naive::retention(ws, as_global(args.in[I_CON]) + l * 512, lds, vcu, G, tid);
#else
        fa::ret_out_phase(lds, tid, ws, gw, ngw, as_global(args.in[I_CON]) + l * 512);
#endif
        __syncthreads();
#if NAIVE_B
        naive::attn_b(ws, as_global(args.in[I_BREL]) + l * 8 * 320, lds, gw, ngw, wave, lane);
#else
#if PROBE_B
        for (int rep = 0; rep < PROBE_B; ++rep) { fa::attn_b_phase(lds, tid, ws, (bf16_t*)(ws + WS_W), vcu, G, as_global(args.in[I_BREL]) + l * 8 * 320); __syncthreads(); }
#endif
        fa::attn_b_phase(lds, tid, ws, (bf16_t*)(ws + WS_BQ), vcu, G, as_global(args.in[I_BREL]) + l * 8 * 320);
#endif
        __syncthreads();
#if NAIVE_A
        naive::attn_a(ws, as_global(args.in[I_LQ1]) + l * 64, as_global(args.in[I_LK1]) + l * 64, as_global(args.in[I_LQ2]) + l * 64, as_global(args.in[I_LK2]) + l * 64, as_global(args.in[I_ASUB]) + l * 128, (l == 0 ? args.lam_init[0] : args.lam_init[1]), lds, gw, ngw, wave, lane);
#else
#if PROBE_A
        for (int rep = 0; rep < PROBE_A; ++rep) { fa::attn_a_phase(lds, tid, ws, (bf16_t*)(ws + WS_W), vcu, G, as_global(args.in[I_LQ1]) + l * 64, as_global(args.in[I_LK1]) + l * 64, as_global(args.in[I_LQ2]) + l * 64, as_global(args.in[I_LK2]) + l * 64, as_global(args.in[I_ASUB]) + l * 128, (l == 0 ? args.lam_init[0] : args.lam_init[1]), PROBE_PM); __syncthreads(); }
#endif
        fa::attn_a_phase(lds, tid, ws, (bf16_t*)(ws + WS_AQ), vcu, G, as_global(args.in[I_LQ1]) + l * 64, as_global(args.in[I_LK1]) + l * 64, as_global(args.in[I_LQ2]) + l * 64, as_global(args.in[I_LK2]) + l * 64, as_global(args.in[I_ASUB]) + l * 128, (l == 0 ? args.lam_init[0] : args.lam_init[1]));
#endif
    } else if constexpr (KIND == K_GATE) {
#if NAIVE_GATE
        naive::gemm<1, true, true, 4>(lds, tid, vcu, G, NGATE, DM, X, as_global(args.in[I_MIXN]) + l * DM, nullptr, nullptr, nullptr, 0,
                                   as_global(args.in[I_WIN]) + (size_t)l * DM * NIN + NIN1, nullptr, nullptr, NIN, naive::NEpiGate{(bf16_t*)(ws + WS_GT)});
#else
        pg8::Gemm g{XB, (const bf16_t*)(wb + W_IN) + (size_t)NIN1 * DM, DM, 0, 0};
        pg8::StaticOrder S; S.init(M, NGATE, G, bx);
        epi::fill_rstd_table(lds, tid, SSQ, S); __syncthreads();
        pg8::gemm_phase(lds + RING_OFF, tid, g, S, epi::EpiGate{(bf16_t*)(ws + WS_GT), (const LAS float*)(lds + epi::EPI_RSTD_OFF)});
#endif
    } else if constexpr (KIND == K_MERGE) {
#if NAIVE_MERGE
        naive::gemm<3, false, false, 2>(lds, tid, vcu, G, DM, 512, nullptr, nullptr, (const bf16_t*)(ws + WS_AQ), (const bf16_t*)(ws + WS_BQ), (const bf16_t*)(ws + WS_CG), 512,
                                     as_global(args.in[I_WBA]) + (size_t)l * 512 * DM, as_global(args.in[I_WBB]) + (size_t)l * 512 * DM, as_global(args.in[I_WBC]) + (size_t)l * 512 * DM, DM,
                                     naive::NEpiMerge{(const bf16_t*)(ws + WS_GT), (bf16_t*)(ws + WS_MG)});
#else
        static_assert(WS_BQ - WS_AQ == P16 && WS_CG - WS_BQ == P16, "y_a, y_b, y_c equally spaced");
        pg8::Gemm g{(const bf16_t*)(ws + WS_AQ), (const bf16_t*)(wb + W_BR), 512, P16, (size_t)DM * 512 * 2};
        pg8::StaticOrder S; S.init(M, DM, G, bx);
        pg8::gemm_phase<3>(lds + RING_OFF, tid, g, S, epi::EpiMerge{(const bf16_t*)(ws + WS_GT), (bf16_t*)(ws + WS_MG), (const unsigned*)(ws + WS_ONES)});
#endif
    } else if constexpr (KIND == K_WOUT) {
#if NAIVE_WOUT
        naive::gemm<1, true, false, 4>(lds, tid, vcu, G, DM, DM, nullptr, nullptr, (const bf16_t*)(ws + WS_MG), nullptr, nullptr, DM,
                                    as_global(args.in[I_WOUT]) + (size_t)l * DM * DM, nullptr, nullptr, DM, naive::NEpiRes{X, X, XB, SSQ, 1.0f});
#else
        pg8::Gemm g{(const bf16_t*)(ws + WS_MG), (const bf16_t*)(wb + W_OUT), DM, 0, 0};
        pg8::StaticOrder S; S.init(M, DM, G, bx);
        pg8::gemm_phase(lds + RING_OFF, tid, g, S, epi::EpiRes{X, X, XB, SSQ, 1.0f});
#endif
    }
}
__device__ __forceinline__ Ctx make_ctx(LAS unsigned char* lds, const int wave_s) {
    Ctx c; c.lds = lds;
    int tid = wave_s * 64 + (int)__builtin_amdgcn_mbcnt_hi(~0u, __builtin_amdgcn_mbcnt_lo(~0u, 0u)); asm volatile("" : "+v"(tid));
    const CAS Args* argp = (const CAS Args*)__builtin_amdgcn_kernarg_segment_ptr(); asm volatile("" : "+s"(argp));
    c.ap = argp; c.tid = tid; c.lane = tid & 63; c.wave = __builtin_amdgcn_readfirstlane(tid >> 6);
    c.G = gridDim.x; c.bx = blockIdx.x; c.vcu = (c.G % 8 == 0) ? (c.bx % 8) * (c.G / 8) + c.bx / 8 : c.bx;
    c.gw = c.vcu * NWAVES + c.wave; c.ngw = c.G * NWAVES;
    GAS unsigned char* ws = argp->ws; asm volatile("" : "+s"(ws)); c.ws = as_global(ws);
    GAS float* X = argp->out; asm volatile("" : "+s"(X)); c.X = as_global(X);
    return c;
}
#if MK_PER_PHASE_LAUNCH
template <int KIND>
__global__ void __launch_bounds__(NWAVES * 64, 2) phase_kernel(Args args_, int l, int ffn2) {
    extern __shared__ __attribute__((aligned(16))) unsigned char lds_raw[];
    const Ctx c = make_ctx((LAS unsigned char*)lds_raw, __builtin_amdgcn_readfirstlane(threadIdx.x >> 6));
    phase_body<KIND>(c, l, ffn2);
}
#endif
#if !MK_PER_PHASE_LAUNCH
__global__ void __launch_bounds__(NWAVES * 64, 2) trunk_fwd(Args args_) {
    extern __shared__ __attribute__((aligned(16))) unsigned char lds_raw[];
    LAS unsigned char* lds = (LAS unsigned char*)lds_raw;
    volatile LAS unsigned* MISC = (volatile LAS unsigned*)(lds + MISC_OFF);
    gu32* ctl = (gu32*)(args_.ws + WS_CTL);
    for (int u = threadIdx.x; u < (LDS_BYTES - LDSCTL_OFF) / 4; u += NWAVES * 64) ((LAS unsigned*)(lds + LDSCTL_OFF))[u] = 0u;
    __syncthreads();
    XcdBarrier bar = xcd_barrier_post((unsigned*)(ctl + CW_BAR), MISC + 8);
    const int wave_s = __builtin_amdgcn_readfirstlane(threadIdx.x >> 6);
    for (int ph = 0; ph < N_PHASES; ++ph) {
        const Ctx c = make_ctx(lds, wave_s);
        int kind_, l_, ffn2_; phase_decode(ph, kind_, l_, ffn2_);
        const int kind = __builtin_amdgcn_readfirstlane(kind_), l = __builtin_amdgcn_readfirstlane(l_), ffn2 = __builtin_amdgcn_readfirstlane(ffn2_);
#if PROBE_MASK
        if ((PROBE_MASK >> kind) & 1) {
            switch (kind) {
            case K_CONV: phase_body<K_CONV>(c, l, ffn2); break;
#if PROBE_NULL
            case K_UP: { pg8::Gemm g{(const bf16_t*)(c.ws + WS_XB), (const bf16_t*)(c.ws + WS_W + (ffn2 ? W_GU2 : W_GU1)), DM, 0, 0}; pg8::StaticOrder S; S.init(M, 2 * DFF, c.G, c.bx); pg8::gemm_phase(c.lds + RING_OFF, c.tid, g, S, epi::EpiNull{}); } break;
#else
            case K_UP: phase_body<K_UP>(c, l, ffn2); break;
#endif
            case K_WIN: phase_body<K_WIN>(c, l, ffn2); break;
            case K_KV: phase_body<K_KV>(c, l, ffn2); break;
            case K_GATE: phase_body<K_GATE>(c, l, ffn2); break;
            case K_MERGE: phase_body<K_MERGE>(c, l, ffn2); break;
            default: break;
            }
            xcd_barrier(bar);
        }
#endif
        switch (kind) {
        case K_PRO: phase_body<K_PRO>(c, l, ffn2); break;
        case K_CONV: phase_body<K_CONV>(c, l, ffn2); break;
        case K_UP: phase_body<K_UP>(c, l, ffn2); break;
        case K_DOWN: phase_body<K_DOWN>(c, l, ffn2); break;
        case K_WIN: phase_body<K_WIN>(c, l, ffn2); break;
        case K_KV: phase_body<K_KV>(c, l, ffn2); break;
        case K_SCAN: phase_body<K_SCAN>(c, l, ffn2); break;
        case K_MIX: phase_body<K_MIX>(c, l, ffn2); break;
        case K_GATE: phase_body<K_GATE>(c, l, ffn2); break;
        case K_MERGE: phase_body<K_MERGE>(c, l, ffn2); break;
        default: phase_body<K_WOUT>(c, l, ffn2); break;
        }
        if (ph + 1 < N_PHASES) xcd_barrier(bar);
    }
}
#endif

#if MK_PER_PHASE_LAUNCH
template <int KIND> static void launch_phase(int grid, hipStream_t stream, const Args& a, int l, int ffn2) {
    static bool attr = false;
    if (!attr) { (void)hipFuncSetAttribute((const void*)phase_kernel<KIND>, hipFuncAttributeMaxDynamicSharedMemorySize, LDS_BYTES); attr = true; }
    hipLaunchKernelGGL(phase_kernel<KIND>, dim3(grid), dim3(NWAVES * 64), LDS_BYTES, stream, a, l, ffn2);
}
#endif
extern "C" void kernel_launch(void* const* d_in, const int* in_sizes, int n_in, void* d_out, int out_size, void* d_ws, size_t ws_size, hipStream_t stream) {
    static int grid = 0;
    if (grid == 0) {
        if (n_in != N_IN || in_sizes[0] != M * DM || out_size != M * DM || ws_size < WS_END) { fprintf(stderr, "kernel_launch: unexpected shapes (n_in %d, in0 %d, out %d, ws %zu < %zu); nothing launched\n", n_in, n_in > 0 ? in_sizes[0] : -1, out_size, ws_size, (size_t)WS_END); grid = -1; return; }
        int dev = 0, cus = 0, per_cu = 0;
        if (hipGetDevice(&dev) != hipSuccess || hipDeviceGetAttribute(&cus, hipDeviceAttributeMultiprocessorCount, dev) != hipSuccess) { grid = -1; return; }
#if !MK_PER_PHASE_LAUNCH
        if (hipFuncSetAttribute((const void*)trunk_fwd, hipFuncAttributeMaxDynamicSharedMemorySize, LDS_BYTES) != hipSuccess) { fprintf(stderr, "kernel_launch: hipFuncSetAttribute failed\n"); grid = -1; return; }
        if (hipOccupancyMaxActiveBlocksPerMultiprocessor(&per_cu, (const void*)trunk_fwd, NWAVES * 64, LDS_BYTES) != hipSuccess || per_cu < 1)
            fprintf(stderr, "kernel_launch: note: occupancy query reports %d workgroups per CU\n", per_cu);
        (void)hipGetLastError();
#endif
        (void)per_cu;
        grid = cus;
    }
    if (grid < 0) return;
    (void)hipMemsetAsync((char*)d_ws + WS_CTL, 0, CTL_ZERO_BYTES, stream);
    Args a{};
    for (int i = 0; i < N_IN; ++i) a.in[i] = (const GAS float*)d_in[i];
    a.out = (GAS float*)d_out; a.ws = (GAS unsigned char*)d_ws;
    for (int i = 0; i < 32; ++i) a.ropec[i] = std::pow(10000.0, -(double)i / 32.0) / (2.0 * 3.14159265358979323846);
    for (int l = 0; l < 2; ++l) a.lam_init[l] = (float)(0.8 - 0.6 * std::exp(-0.3 * (double)l));
#if MK_PER_PHASE_LAUNCH
    for (int ph = 0; ph < N_PHASES; ++ph) {
        int kind, l, ffn2; phase_decode(ph, kind, l, ffn2);
        switch (kind) {
        case K_PRO: launch_phase<K_PRO>(grid, stream, a, l, ffn2); break;
        case K_CONV: if (l > 0) launch_phase<K_CONV>(grid, stream, a, l, ffn2); break;
        case K_UP: launch_phase<K_UP>(grid, stream, a, l, ffn2); break;
        case K_DOWN: launch_phase<K_DOWN>(grid, stream, a, l, ffn2); break;
        case K_WIN: launch_phase<K_WIN>(grid, stream, a, l, ffn2); break;
#if NAIVE_C
        case K_KV: case K_SCAN: break;
#else
        case K_KV: launch_phase<K_KV>(grid, stream, a, l, ffn2); break;
        case K_SCAN: launch_phase<K_SCAN>(grid, stream, a, l, ffn2); break;
#endif
        case K_MIX: launch_phase<K_MIX>(grid, stream, a, l, ffn2); break;
        case K_GATE: launch_phase<K_GATE>(grid, stream, a, l, ffn2); break;
        case K_MERGE: launch_phase<K_MERGE>(grid, stream, a, l, ffn2); break;
        default: launch_phase<K_WOUT>(grid, stream, a, l, ffn2); break;
        }
    }
#else
    hipLaunchKernelGGL(trunk_fwd, dim3(grid), dim3(NWAVES * 64), LDS_BYTES, stream, a);
#endif
    const hipError_t le = hipPeekAtLastError();
    if (le != hipSuccess) fprintf(stderr, "kernel_launch: launch failed: %s\n", hipGetErrorName(le));
}
```

```cpp
#include <hip/hip_runtime.h>
#include <hip/hip_bf16.h>
#include <cstdio>
#include <cstdint>
#include <cmath>

#ifndef MK_PER_PHASE_LAUNCH
#define MK_PER_PHASE_LAUNCH 0
#endif
#ifndef NAIVE_GEMM
#define NAIVE_GEMM 0
#endif
#ifndef NAIVE_UP
#define NAIVE_UP NAIVE_GEMM
#endif
#ifndef NAIVE_DOWN
#define NAIVE_DOWN NAIVE_GEMM
#endif
#ifndef NAIVE_WIN
#define NAIVE_WIN NAIVE_GEMM
#endif
#ifndef NAIVE_GATE
#define NAIVE_GATE NAIVE_GEMM
#endif
#ifndef NAIVE_MERGE
#define NAIVE_MERGE NAIVE_GEMM
#endif
#ifndef NAIVE_WOUT
#define NAIVE_WOUT NAIVE_GEMM
#endif
#ifndef PROBE_MASK
#define PROBE_MASK 0
#endif
#ifndef PROBE_NULL
#define PROBE_NULL 0
#endif
#ifndef FA_V2
#define FA_V2 3
#endif
#ifndef PROBE_PM
#define PROBE_PM 0
#endif
#ifndef PROBE_T
#define PROBE_T 0
#endif
#ifndef PROBE_SEL
#define PROBE_SEL 0
#endif
#ifndef FA_WMAP
#define FA_WMAP 0
#endif
#ifndef HIDE_CONV
#define HIDE_CONV 1
#endif
#ifndef PROBE_PH
#define PROBE_PH 0
#endif
#ifndef PROBE_BLK
#define PROBE_BLK 0
#endif
#ifndef FA_HAND
#define FA_HAND 1
#endif
#ifndef FUSE_RET
#define FUSE_RET 0
#endif
#ifndef FA_HANDB
#define FA_HANDB 1
#endif
#ifndef FA_NOMAX_BOUND_A
#define FA_NOMAX_BOUND_A 100.0f
#endif
#ifndef FA_NOMAX_BOUND_B
#define FA_NOMAX_BOUND_B 100.0f
#endif
#ifndef PROBE_A
#define PROBE_A 0
#endif
#ifndef PROBE_B
#define PROBE_B 0
#endif
#ifndef NAIVE_A
#define NAIVE_A 0
#endif
#ifndef NAIVE_B
#define NAIVE_B 0
#endif
#ifndef NAIVE_C
#define NAIVE_C 0
#endif

constexpr int BATCH = 2, SEQ = 8192, DM = 1024, DEPTH = 2, M = BATCH * SEQ;
constexpr int DFF = 2816, NIN1 = 4608, NGATE = 3072, NIN = 7680;
constexpr float EPS = 1e-6f;
constexpr float LOG2E = 1.4426950408889634f;
constexpr float C2 = 0.125f * LOG2E;

enum { I_X = 0, I_F1N, I_F1G, I_F1U, I_F1D, I_MIXN, I_WIN, I_AQN, I_AKN, I_LQ1, I_LK1, I_LQ2, I_LK2, I_ASUB, I_BQN, I_BKN, I_BREL, I_CON, I_WBA, I_WBB, I_WBC, I_WOUT, I_F2N, I_F2G, I_F2U, I_F2D, N_IN };

constexpr size_t MiB = 1u << 20;
constexpr size_t WS_CTL = 0, CTL_ZERO_BYTES = 1 * MiB;
constexpr size_t WS_PROBE = 576 * 1024;
constexpr size_t WS_ONES = 512 * 1024;
constexpr size_t WS_COS = 1 * MiB, WS_SIN = 2 * MiB;
constexpr size_t WS_SSQ = 3 * MiB;
constexpr size_t WS_W = 4 * MiB;
constexpr size_t W_GU1 = 0, W_D1 = W_GU1 + (size_t)2 * DFF * DM * 2, W_IN = W_D1 + (size_t)DM * DFF * 2, W_BR = W_IN + (size_t)NIN * DM * 2,
                 W_OUT = W_BR + (size_t)3 * DM * 512 * 2, W_GU2 = W_OUT + (size_t)DM * DM * 2, W_D2 = W_GU2 + (size_t)2 * DFF * DM * 2, W_END = W_D2 + (size_t)DM * DFF * 2;
static_assert(W_END == 53 * MiB, "weights");
constexpr size_t WS_XB = 57 * MiB;
constexpr size_t WS_R4 = 89 * MiB;
constexpr size_t WS_R3 = 121 * MiB;
constexpr size_t P16 = 16 * MiB;
constexpr size_t WS_AQ = WS_R3, WS_BQ = WS_R3 + P16, WS_CG = WS_R3 + 2 * P16;
constexpr size_t WS_AK = WS_R3 + 3 * P16, WS_AV = WS_AK + P16, WS_BK = WS_AV + P16, WS_BV = WS_BK + P16, WS_CQ = WS_BV + P16, WS_CK = WS_CQ + P16 / 2, WS_CV = WS_CK + P16 / 2;
constexpr size_t WS_GT = WS_AK;
constexpr size_t WS_HB = WS_R3;
constexpr size_t WS_MG = WS_R4;
constexpr size_t WS_END = WS_R3 + 144 * MiB;
static_assert(WS_CV + P16 == WS_END && WS_GT + (size_t)M * NGATE * 2 == WS_END && WS_HB + (size_t)M * DFF * 2 <= WS_END, "ws map");

#define GAS __attribute__((address_space(1)))
#define LAS __attribute__((address_space(3)))
typedef unsigned short bf16_t;
typedef short bf16x8 __attribute__((ext_vector_type(8)));
typedef float f32x4 __attribute__((ext_vector_type(4)));
typedef float f32x2 __attribute__((ext_vector_type(2)));
typedef float f32x16 __attribute__((ext_vector_type(16)));
typedef unsigned u32x4 __attribute__((ext_vector_type(4)));
typedef unsigned u32x2 __attribute__((ext_vector_type(2)));
typedef GAS unsigned gu32;
#define RLX_AGENT __ATOMIC_RELAXED, __HIP_MEMORY_SCOPE_AGENT
#define LDS_WAIT() asm volatile("s_waitcnt lgkmcnt(0)" ::: "memory")
#define VM_WAIT() asm volatile("s_waitcnt vmcnt(0)" ::: "memory")

__device__ __forceinline__ unsigned f2bf(float f) { unsigned u = __builtin_bit_cast(unsigned, f); return (u + 0x7fffu + ((u >> 16) & 1u)) >> 16; }
__device__ __forceinline__ unsigned pk2(float lo, float hi) { return f2bf(lo) | (f2bf(hi) << 16); }
__device__ __forceinline__ float bf2f(unsigned short b) { return __builtin_bit_cast(float, (unsigned)b << 16); }
__device__ __forceinline__ float bflo(unsigned w) { return __builtin_bit_cast(float, w << 16); }
__device__ __forceinline__ float bfhi(unsigned w) { return __builtin_bit_cast(float, w & 0xffff0000u); }
__device__ __forceinline__ unsigned cvt_pk_bf16(float lo, float hi) { unsigned r; asm volatile("v_cvt_pk_bf16_f32 %0, %1, %2" : "=v"(r) : "v"(lo), "v"(hi)); return r; }
__device__ __forceinline__ float fast_rcp(float x) { return __builtin_amdgcn_rcpf(x); }
__device__ __forceinline__ float fast_exp2(float x) { return __builtin_amdgcn_exp2f(x); }
__device__ __forceinline__ float silu_f(float x) { return x * fast_rcp(1.0f + fast_exp2(-x * LOG2E)); }
__device__ __forceinline__ float sigmoid_f(float x) { return fast_rcp(1.0f + fast_exp2(-x * LOG2E)); }
template <int O> __device__ __forceinline__ float xor_add(float v) {
    if constexpr (O == 32) { auto rr = __builtin_amdgcn_permlane32_swap(__float_as_uint(v), __float_as_uint(v), false, false); return __uint_as_float(rr[0]) + __uint_as_float(rr[1]); }
    else return v + __uint_as_float((unsigned)__builtin_amdgcn_ds_swizzle((int)__float_as_uint(v), (O << 10) | 0x1f));
}
template <int O> __device__ __forceinline__ float xor_max(float v) {
    if constexpr (O == 32) { auto rr = __builtin_amdgcn_permlane32_swap(__float_as_uint(v), __float_as_uint(v), false, false); return fmaxf(__uint_as_float(rr[0]), __uint_as_float(rr[1])); }
    else return fmaxf(v, __uint_as_float((unsigned)__builtin_amdgcn_ds_swizzle((int)__float_as_uint(v), (O << 10) | 0x1f)));
}
__device__ __forceinline__ float wave_sum(float v) { v = xor_add<1>(v); v = xor_add<2>(v); v = xor_add<4>(v); v = xor_add<8>(v); v = xor_add<16>(v); return xor_add<32>(v); }
__device__ __forceinline__ float wave_max(float v) { v = xor_max<1>(v); v = xor_max<2>(v); v = xor_max<4>(v); v = xor_max<8>(v); v = xor_max<16>(v); return xor_max<32>(v); }

namespace pg8 {
#define PG8_LAS __attribute__((address_space(3)))
constexpr int BM = 256, BK = 64, HALF = 128, HTB = HALF * BK * 2  , STAGE_BYTES = 8 * HTB, NXCD = 8, WGM = 8;

__host__ __device__ __forceinline__ int lds_byte(int r, int c) { const int st = (r >> 4) * 2 + (c >> 5), rr = r & 15, cc = c & 31, ob = rr * 64 + cc * 2; return st * 1024 + (ob ^ (((ob >> 9) & 1) << 5)); }
__host__ __device__ __forceinline__ void stage_rc(int b, int& R, int& C) { const int st = b / 1024, sb = b % 1024, swz = sb ^ (((sb >> 9) & 1) << 5); R = (st >> 1) * 16 + swz / 64; C = (st & 1) * 32 + (swz % 64) / 2; }
__host__ __device__ __forceinline__ int perm32(int rho) { const int n = rho >> 4, i = rho & 15; return 8 * (i >> 2) + 4 * n + (i & 3); }

struct Unit { int pm, pn, sub, ui; };
struct Gemm { const bf16_t* A; const bf16_t* Bt; int K; size_t subA, subB; };
__device__ __forceinline__ const char* pickA(const Gemm& g, int s) { return (const char*)g.A + (size_t)s * g.subA; }
__device__ __forceinline__ const char* pickB(const Gemm& g, int s) { return (const char*)g.Bt + (size_t)s * g.subB; }

struct StaticOrder {
    int nM, nN, nwg, G, c;
    __host__ __device__ void init(int Mr, int N, int G_, int c_) { nM = Mr / BM; nN = N / BM; nwg = nM * nN; G = G_; c = c_; }
    template <int NSUB = 1> __host__ __device__ bool next(int i, Unit& u) const {
        const int it = i / NSUB; u.sub = i - it * NSUB; u.ui = it;
        const long L = (long)it * G + c; if (L >= nwg) return false;
        int wgid = (int)L; { const int q = nwg / NXCD, r = nwg % NXCD, xcd = wgid % NXCD, off = wgid / NXCD; wgid = (xcd < r ? xcd * (q + 1) : r * (q + 1) + (xcd - r) * q) + off; }
        const int nig = WGM * nN, gid = wgid / nig, fm = gid * WGM, gsz = (nM - fm) < WGM ? (nM - fm) : WGM;
        u.pm = fm + ((wgid % nig) % gsz); u.pn = (wgid % nig) / gsz; return true;
    }
};

struct NoPre { __device__ __forceinline__ void operator()() const {} };
template <int NSUB = 1, class Epi, class Pre = NoPre>
__device__ __forceinline__ void gemm_phase(PG8_LAS unsigned char* lds, const int tid, const Gemm g, const StaticOrder& S, const Epi& E, const Pre& pre = Pre()) {
    const int wid = __builtin_amdgcn_readfirstlane(tid >> 6), lane = tid & 63, wr = wid >> 2, wc = wid & 3, fr = lane & 15, fq = lane >> 4;
    const int K = g.K, nt = K / BK;
    unsigned voffA[2], voffB[2];
#pragma unroll
    for (int i = 0; i < 2; ++i) { int R, C; stage_rc(tid * 16 + i * 8192, R, C); const int Rb = ((R & ~31) + perm32(R & 31));
        voffA[i] = (unsigned)(R * K + C) * 2u; voffB[i] = (unsigned)(Rb * K + C) * 2u; }
    const size_t kstep = (size_t)(BK * 2);
    const size_t hstep = (size_t)HALF * K * 2;
    const size_t tstep = 2 * hstep;
    const unsigned ldsw = (unsigned)wid * 1024u;
    const int aoff = lds_byte(wr * 64 + fr, fq * 8), boff = lds_byte(wc * 32 + fr, fq * 8);
#define PG8_SA(b, h) (((b) * 2 + (h)) * HTB)
#define PG8_SB(b, h) ((4 + (b) * 2 + (h)) * HTB)
#define PG8_STAGE(bufoff, gbase, voff) do { _Pragma("unroll") for (int _i = 0; _i < 2; ++_i) \
        __builtin_amdgcn_global_load_lds((const unsigned*)((const char*)(gbase) + (voff)[_i]), (PG8_LAS unsigned*)(lds + (bufoff) + ldsw + _i * 8192), 16, 0, 0); } while (0)
#define PG8_LDA(dst, b, h) do { _Pragma("unroll") for (int m = 0; m < 4; ++m) _Pragma("unroll") for (int k = 0; k < 2; ++k) dst[m][k] = *(const PG8_LAS bf16x8*)(lds + PG8_SA(b, h) + aoff + m * 2048 + k * 1024); } while (0)
#define PG8_LDB(dst, b, h) do { _Pragma("unroll") for (int n = 0; n < 2; ++n) _Pragma("unroll") for (int k = 0; k < 2; ++k) dst[n][k] = *(const PG8_LAS bf16x8*)(lds + PG8_SB(b, h) + boff + n * 2048 + k * 1024); } while (0)
#define PG8_MMA(ai, bj, At, Bt) do { __builtin_amdgcn_s_setprio(1); _Pragma("unroll") for (int m = 0; m < 4; ++m) _Pragma("unroll") for (int n = 0; n < 2; ++n) _Pragma("unroll") for (int k = 0; k < 2; ++k) \
        acc[ai][bj][m][n] = __builtin_amdgcn_mfma_f32_16x16x32_bf16(Bt[n][k], At[m][k], acc[ai][bj][m][n], 0, 0, 0); __builtin_amdgcn_s_setprio(0); } while (0)
#define PG8_WAIT_V(n) asm volatile("s_waitcnt vmcnt(" #n ")" ::: "memory")
#define PG8_WAIT_L(n) asm volatile("s_waitcnt lgkmcnt(" #n ")" ::: "memory")
#define PG8_BAR __builtin_amdgcn_s_barrier()
#define PG8_SCHED __builtin_amdgcn_sched_barrier(0)
    Unit cur, nxt; int ui = 0;
    if (!S.template next<NSUB>(0, cur)) return;
    f32x4 acc[2][2][4][2];
#pragma unroll
    for (int a = 0; a < 2; ++a)
#pragma unroll
        for (int b = 0; b < 2; ++b)
#pragma unroll
            for (int m = 0; m < 4; ++m)
#pragma unroll
                for (int n = 0; n < 2; ++n) acc[a][b][m][n] = (f32x4){0.f, 0.f, 0.f, 0.f};
    bf16x8 At[4][2], B0[2][2], B1[2][2];
    const char* cA = pickA(g, cur.sub) + (size_t)cur.pm * tstep; const char* cB = pickB(g, cur.sub) + (size_t)cur.pn * tstep;
    PG8_STAGE(PG8_SB(0, 0), cB, voffB); PG8_STAGE(PG8_SB(0, 1), cB + hstep, voffB); PG8_STAGE(PG8_SA(0, 0), cA, voffA); PG8_STAGE(PG8_SA(0, 1), cA + hstep, voffA);
    pre();
    if (wr == 1) PG8_BAR;
    PG8_WAIT_V(2); PG8_BAR;
    PG8_STAGE(PG8_SB(1, 0), cB + kstep, voffB); PG8_STAGE(PG8_SA(1, 0), cA + kstep, voffA); PG8_STAGE(PG8_SB(1, 1), cB + hstep + kstep, voffB);
    PG8_WAIT_V(6); PG8_BAR;
    for (;;) {
        const bool has_next = S.template next<NSUB>(ui + 1, nxt);
        const char* nA = has_next ? pickA(g, nxt.sub) + (size_t)nxt.pm * tstep : cA; const char* nB = has_next ? pickB(g, nxt.sub) + (size_t)nxt.pn * tstep : cB;
        for (int t = 0; t < nt; t += 2) {
            const bool last = (t == nt - 2);
            const char* a1 = cA + (size_t)(t + 1) * kstep;
            const char* a2 = last ? nA : cA + (size_t)(t + 2) * kstep; const char* b2 = last ? nB : cB + (size_t)(t + 2) * kstep;
            const char* a3 = a2 + kstep; const char* b3 = b2 + kstep;
            PG8_LDB(B0, 0, 0); PG8_LDB(B1, 0, 1); PG8_SCHED; PG8_LDA(At, 0, 0); PG8_STAGE(PG8_SA(1, 1), a1 + hstep, voffA);
            PG8_WAIT_V(8); PG8_WAIT_L(0); PG8_BAR; PG8_MMA(0, 0, At, B0); PG8_MMA(0, 1, At, B1); PG8_BAR; PG8_SCHED;
            PG8_LDA(At, 0, 1); PG8_STAGE(PG8_SB(0, 0), b2, voffB); PG8_STAGE(PG8_SB(0, 1), b2 + hstep, voffB); PG8_STAGE(PG8_SA(0, 0), a2, voffA);
            PG8_WAIT_V(8); PG8_WAIT_L(0); PG8_BAR; PG8_MMA(1, 0, At, B0); PG8_MMA(1, 1, At, B1); PG8_BAR; PG8_SCHED;
            PG8_LDB(B0, 1, 0); PG8_LDB(B1, 1, 1); PG8_SCHED; PG8_LDA(At, 1, 0); PG8_STAGE(PG8_SA(0, 1), a2 + hstep, voffA);
            PG8_WAIT_V(8); PG8_WAIT_L(0); PG8_BAR; PG8_MMA(0, 0, At, B0); PG8_MMA(0, 1, At, B1); PG8_BAR; PG8_SCHED;
            PG8_LDA(At, 1, 1); PG8_STAGE(PG8_SB(1, 0), b3, voffB); PG8_STAGE(PG8_SB(1, 1), b3 + hstep, voffB); PG8_STAGE(PG8_SA(1, 0), a3, voffA);
            PG8_WAIT_V(8); PG8_WAIT_L(0); PG8_BAR; PG8_MMA(1, 0, At, B0); PG8_MMA(1, 1, At, B1); PG8_BAR; PG8_SCHED;
        }
        if (wr == 0) PG8_BAR;
        { int l_ = tid; asm volatile("" : "+v"(l_)); const int fr_ = l_ & 15, fq_ = (l_ >> 4) & 3;
          E(acc, cur, wr, wc, fr_, fq_); }
        if (!has_next) break;
        cur = nxt; cA = nA; cB = nB; ++ui;
        if (wr == 1) PG8_BAR;
    }
    PG8_WAIT_V(0);
    PG8_BAR;
#undef PG8_SA
#undef PG8_SB
#undef PG8_STAGE
#undef PG8_LDA
#undef PG8_LDB
#undef PG8_MMA
#undef PG8_WAIT_V
#undef PG8_WAIT_L
#undef PG8_BAR
#undef PG8_SCHED
}
}

namespace epi {
using pg8::Unit;
__device__ __forceinline__ float log2_gamma_w(int h) { return __builtin_amdgcn_logf(1.0f - __builtin_amdgcn_exp2f(-5.0f - (float)h)); }
typedef f32x4 Acc[2][2][4][2];
#define ACC_ZERO(acc) do { _Pragma("unroll") for (int a_ = 0; a_ < 2; ++a_) _Pragma("unroll") for (int b_ = 0; b_ < 2; ++b_) _Pragma("unroll") for (int m_ = 0; m_ < 4; ++m_) \
    _Pragma("unroll") for (int n_ = 0; n_ < 2; ++n_) acc[a_][b_][m_][n_] = (f32x4){0.f, 0.f, 0.f, 0.f}; } while (0)

__device__ __forceinline__ float dot4(const f32x4 a) { return (a[0] * a[0] + a[1] * a[1]) + (a[2] * a[2] + a[3] * a[3]); }
__device__ __forceinline__ u32x4 pack8(const f32x4 a, const f32x4 b) { u32x4 w; w.x = cvt_pk_bf16(a[0], a[1]); w.y = cvt_pk_bf16(a[2], a[3]); w.z = cvt_pk_bf16(b[0], b[1]); w.w = cvt_pk_bf16(b[2], b[3]); return w; }
constexpr int EPI_RSTD_OFF = 132096, EPI_GAIN_OFF = EPI_RSTD_OFF + 8 * 256 * 4, EPI_ROPE_OFF = EPI_GAIN_OFF + 4 * 64 * 4, EPI_END = EPI_ROPE_OFF + 128;
__device__ __forceinline__ void fill_rstd_table(LAS unsigned char* lds0, const int tid, const float* ssq, const pg8::StaticOrder& S) {
    LAS float* tab = (LAS float*)(lds0 + EPI_RSTD_OFF);
    const int row = tid >> 1, half = tid & 1;
    f32x4 a[8], b[8]; bool ok[8];
#pragma unroll
    for (int i = 0; i < 8; ++i) {
        Unit u; ok[i] = S.next(i, u);
        const float* p = ssq + ((size_t)(ok[i] ? u.pm : 0) * 256 + row) * 16 + half * 8;
        a[i] = *(const f32x4*)p; b[i] = *(const f32x4*)(p + 4);
    }
#pragma unroll
    for (int i = 0; i < 8; ++i) {
        float s = ((a[i][0] + a[i][1]) + (a[i][2] + a[i][3])) + ((b[i][0] + b[i][1]) + (b[i][2] + b[i][3])); s = xor_add<1>(s);
        if (half == 0 && ok[i]) tab[i * 256 + row] = __builtin_amdgcn_rsqf(s * (1.0f / DM) + EPS);
    }
}
__device__ __forceinline__ float row_rstd(const LAS float* tab, int ui, int lrow) { return tab[ui * 256 + lrow]; }

struct EpiNull {
    __device__ __forceinline__ void operator()(Acc& acc, const Unit& u, int wr, int wc, int fr, int fq) const {
#pragma unroll
        for (int ai = 0; ai < 2; ++ai)
#pragma unroll
            for (int bj = 0; bj < 2; ++bj)
#pragma unroll
                for (int m = 0; m < 4; ++m) { asm volatile("" : "+v"(acc[ai][bj][m][0]), "+v"(acc[ai][bj][m][1])); }
        ACC_ZERO(acc);
    }
};
struct EpiUp {
    bf16_t* H; const LAS float* rst;
    __device__ __forceinline__ void operator()(Acc& acc, const Unit& u, int wr, int wc, int fr, int fq) const {
#pragma unroll
        for (int ai = 0; ai < 2; ++ai)
#pragma unroll
            for (int m = 0; m < 4; ++m) {
                const int lrow = ai * 128 + wr * 64 + m * 16 + fr, row = u.pm * 256 + lrow;
                const float rs = row_rstd(rst, u.ui, lrow);
                f32x4 h0, h1;
#pragma unroll
                for (int j = 0; j < 4; ++j) { h0[j] = silu_f(acc[ai][0][m][0][j] * rs) * (acc[ai][1][m][0][j] * rs); h1[j] = silu_f(acc[ai][0][m][1][j] * rs) * (acc[ai][1][m][1][j] * rs); }
                *(u32x4*)(H + (size_t)row * DFF + u.pn * 128 + wc * 32 + 8 * fq) = pack8(h0, h1);
            }
        ACC_ZERO(acc);
    }
};

struct EpiRes {
    const float* xold; float* xnew; bf16_t* xb; float* ssq; float s;
    __device__ __forceinline__ void operator()(Acc& acc, const Unit& u, int wr, int wc, int fr, int fq) const {
#pragma unroll
        for (int ai = 0; ai < 2; ++ai) {
            f32x4 ov[4][2][2];
#pragma unroll
            for (int m = 0; m < 4; ++m)
#pragma unroll
                for (int bj = 0; bj < 2; ++bj) { const size_t off = (size_t)(u.pm * 256 + ai * 128 + wr * 64 + m * 16 + fr) * DM + u.pn * 256 + bj * 128 + wc * 32 + 8 * fq;
                    ov[m][bj][0] = *(const f32x4*)(xold + off); ov[m][bj][1] = *(const f32x4*)(xold + off + 4); }
            asm volatile("" ::: "memory");
#pragma unroll
            for (int m = 0; m < 4; ++m) {
                const int row = u.pm * 256 + ai * 128 + wr * 64 + m * 16 + fr; float ss = 0.f;
#pragma unroll
                for (int bj = 0; bj < 2; ++bj) {
                    const size_t off = (size_t)row * DM + u.pn * 256 + bj * 128 + wc * 32 + 8 * fq;
                    const f32x4 v0 = ov[m][bj][0] + acc[ai][bj][m][0] * s, v1 = ov[m][bj][1] + acc[ai][bj][m][1] * s;
                    *(f32x4*)(xnew + off) = v0; *(f32x4*)(xnew + off + 4) = v1;
                    *(u32x4*)(xb + off) = pack8(v0, v1);
                    ss += dot4(v0) + dot4(v1);
                }
                ss = xor_add<16>(ss); ss = xor_add<32>(ss);
                if (fq == 0) ssq[(size_t)row * 16 + u.pn * 4 + wc] = ss;
            }
            asm volatile("" ::: "memory");
        }
        ACC_ZERO(acc);
    }
};

struct EpiGate {
    bf16_t* G; const LAS float* rst;
    __device__ __forceinline__ void operator()(Acc& acc, const Unit& u, int wr, int wc, int fr, int fq) const {
#pragma unroll
        for (int ai = 0; ai < 2; ++ai)
#pragma unroll
            for (int m = 0; m < 4; ++m) {
                const int lrow = ai * 128 + wr * 64 + m * 16 + fr, row = u.pm * 256 + lrow;
                const float rs = row_rstd(rst, u.ui, lrow);
#pragma unroll
                for (int bj = 0; bj < 2; ++bj) { f32x4 g0, g1;
#pragma unroll
                    for (int j = 0; j < 4; ++j) { g0[j] = fmaxf(sigmoid_f(acc[ai][bj][m][0][j] * rs), 9.5367431640625e-07f); g1[j] = fmaxf(sigmoid_f(acc[ai][bj][m][1][j] * rs), 9.5367431640625e-07f); }
                    *(u32x4*)(G + (size_t)row * NGATE + u.pn * 256 + bj * 128 + wc * 32 + 8 * fq) = pack8(g0, g1); }
            }
        ACC_ZERO(acc);
    }
};

struct EpiMerge {
    const bf16_t* G; bf16_t* MG; const unsigned* ones;
    __device__ __forceinline__ void operator()(Acc& acc, const Unit& u, int wr, int wc, int fr, int fq) const {
        const int sub = u.sub; const bool chain = sub < 2;
        const char* gb = (const char*)(G + (size_t)u.pm * 256 * NGATE + sub * 1024 + u.pn * 256);
        const char* nb = chain ? gb + 2048 : (const char*)ones; const unsigned nmask = chain ? 0xffffffffu : 0u;
        const unsigned go = (unsigned)((wr * 64 + fr) * NGATE + wc * 32 + 8 * fq) * 2u;
#pragma unroll
        for (int ai = 0; ai < 2; ++ai)
#pragma unroll
            for (int mh = 0; mh < 2; ++mh) {
                u32x4 gc[2][2], gn[2][2];
#pragma unroll
                for (int m2 = 0; m2 < 2; ++m2)
#pragma unroll
                    for (int bj = 0; bj < 2; ++bj) { const unsigned o = go + (unsigned)(((ai * 128 + (2 * mh + m2) * 16) * NGATE + bj * 128) * 2);
                        gc[m2][bj] = *(const u32x4*)(gb + o); gn[m2][bj] = *(const u32x4*)(nb + (o & nmask)); }
                asm volatile("" ::: "memory");
#pragma unroll
                for (int m2 = 0; m2 < 2; ++m2)
#pragma unroll
                    for (int bj = 0; bj < 2; ++bj) { const u32x4 c = gc[m2][bj], n = gn[m2][bj]; const int m = 2 * mh + m2;
                        const f32x4 c0 = {bflo(c.x), bfhi(c.x), bflo(c.y), bfhi(c.y)}, c1 = {bflo(c.z), bfhi(c.z), bflo(c.w), bfhi(c.w)};
                        const f32x4 n0 = {bflo(n.x), bfhi(n.x), bflo(n.y), bfhi(n.y)}, n1 = {bflo(n.z), bfhi(n.z), bflo(n.w), bfhi(n.w)};
#pragma unroll
                        for (int j = 0; j < 4; ++j) { acc[ai][bj][m][0][j] *= c0[j] * fast_rcp(n0[j]); acc[ai][bj][m][1][j] *= c1[j] * fast_rcp(n1[j]); } }
                asm volatile("" ::: "memory");
            }
        if (!chain) {
            char* mb = (char*)(MG + (size_t)u.pm * 256 * DM + u.pn * 256);
            const unsigned mo = (unsigned)((wr * 64 + fr) * DM + wc * 32 + 8 * fq) * 2u;
#pragma unroll
            for (int ai = 0; ai < 2; ++ai)
#pragma unroll
                for (int m = 0; m < 4; ++m)
#pragma unroll
                    for (int bj = 0; bj < 2; ++bj)
                        *(u32x4*)(mb + mo + (unsigned)(((ai * 128 + m * 16) * DM + bj * 128) * 2)) = pack8(acc[ai][bj][m][0], acc[ai][bj][m][1]);
            ACC_ZERO(acc);
        }
    }
};

enum { F_NORM = 1, F_ROPE = 2, F_C2 = 4, F_CKD = 8, F_SILU = 16 };
struct EpiWin {
    unsigned char* ws; const LAS float* rst; const LAS float* gtab; const LAS float* rtab;
    template <int FLAGS>
    __device__ __forceinline__ void body(Acc& acc, const Unit& u, int wr, int wc, int fr, int fq, bf16_t* out, int pitch, int colbase, int gk) const {
        f32x4 gA0 = {1.f, 1.f, 1.f, 1.f}, gA1 = gA0, gB0 = gA0, gB1 = gA0;
        if (FLAGS & F_NORM) { const LAS float* gain = gtab + gk * 64; gA0 = *(const LAS f32x4*)(gain + 8 * fq); gA1 = *(const LAS f32x4*)(gain + 8 * fq + 4); gB0 = *(const LAS f32x4*)(gain + 32 + 8 * fq); gB1 = *(const LAS f32x4*)(gain + 36 + 8 * fq); }
        f32x4 rc0 = {0.f, 0.f, 0.f, 0.f}, rc1 = rc0;
        if (FLAGS & F_ROPE) { rc0 = *(const LAS f32x4*)(rtab + 8 * fq); rc1 = *(const LAS f32x4*)(rtab + 8 * fq + 4); }
        const float l2g = (FLAGS & F_CKD) ? log2_gamma_w(wc) : 0.f;
#pragma unroll
        for (int ai = 0; ai < 2; ++ai)
#pragma unroll
            for (int m = 0; m < 4; ++m) {
                const int lrow = ai * 128 + wr * 64 + m * 16 + fr, row = u.pm * 256 + lrow, t = row & (SEQ - 1);
                const float rs = row_rstd(rst, u.ui, lrow);
                f32x4 a0 = acc[ai][0][m][0] * rs, a1 = acc[ai][0][m][1] * rs, b0 = acc[ai][1][m][0] * rs, b1 = acc[ai][1][m][1] * rs;
                if (FLAGS & F_NORM) {
                    float ss = (dot4(a0) + dot4(a1)) + (dot4(b0) + dot4(b1)); ss = xor_add<16>(ss); ss = xor_add<32>(ss);
                    const float r = __builtin_amdgcn_rsqf(ss * (1.0f / 64.0f) + EPS);
                    a0 = a0 * gA0 * r; a1 = a1 * gA1 * r; b0 = b0 * gB0 * r; b1 = b1 * gB1 * r;
                }
                if (FLAGS & F_ROPE) {
                    const float tf = (float)t; f32x4 c0, c1, s0, s1;
#pragma unroll
                    for (int j = 0; j < 4; ++j) { const float r0 = __builtin_amdgcn_fractf(tf * rc0[j]), r1 = __builtin_amdgcn_fractf(tf * rc1[j]);
                        c0[j] = __builtin_amdgcn_cosf(r0); s0[j] = __builtin_amdgcn_sinf(r0); c1[j] = __builtin_amdgcn_cosf(r1); s1[j] = __builtin_amdgcn_sinf(r1); }
                    const f32x4 na0 = a0 * c0 - b0 * s0, nb0 = b0 * c0 + a0 * s0, na1 = a1 * c1 - b1 * s1, nb1 = b1 * c1 + a1 * s1;
                    a0 = na0; b0 = nb0; a1 = na1; b1 = nb1;
                }
                if (FLAGS & (F_C2 | F_CKD)) {
                    const float sc = (FLAGS & F_C2) ? C2 : 0.125f * fast_exp2(-(float)(t & 63) * l2g);
                    a0 = a0 * sc; a1 = a1 * sc; b0 = b0 * sc; b1 = b1 * sc;
                }
                if (FLAGS & F_SILU) {
#pragma unroll
                    for (int j = 0; j < 4; ++j) { a0[j] = silu_f(a0[j]); a1[j] = silu_f(a1[j]); b0[j] = silu_f(b0[j]); b1[j] = silu_f(b1[j]); }
                }
                bf16_t* o = out + (size_t)row * pitch + colbase + 64 * wc + 8 * fq;
                *(u32x4*)o = pack8(a0, a1); *(u32x4*)(o + 32) = pack8(b0, b1);
            }
        ACC_ZERO(acc);
    }
    __device__ __forceinline__ void operator()(Acc& acc, const Unit& u, int wr, int wc, int fr, int fq) const {
        const int pn = u.pn;
        if (pn < 2)        body<F_NORM | F_ROPE | F_C2>(acc, u, wr, wc, fr, fq, (bf16_t*)(ws + WS_AQ), 512, 256 * pn, 0);
        else if (pn < 4)   body<F_NORM | F_ROPE>(acc, u, wr, wc, fr, fq, (bf16_t*)(ws + WS_AK), 512, 256 * (pn - 2), 1);
        else if (pn < 6)   body<0>(acc, u, wr, wc, fr, fq, (bf16_t*)(ws + WS_AV), 512, 256 * (pn - 4), 0);
        else if (pn < 8)   body<F_NORM | F_C2>(acc, u, wr, wc, fr, fq, (bf16_t*)(ws + WS_BQ), 512, 256 * (pn - 6), 2);
        else if (pn < 10)  body<F_NORM>(acc, u, wr, wc, fr, fq, (bf16_t*)(ws + WS_BK), 512, 256 * (pn - 8), 3);
        else if (pn < 12)  body<0>(acc, u, wr, wc, fr, fq, (bf16_t*)(ws + WS_BV), 512, 256 * (pn - 10), 0);
        else if (pn == 12) body<F_ROPE>(acc, u, wr, wc, fr, fq, (bf16_t*)(ws + WS_CQ), 256, 0, 0);
        else if (pn == 13) body<F_ROPE | F_CKD>(acc, u, wr, wc, fr, fq, (bf16_t*)(ws + WS_CK), 256, 0, 0);
        else if (pn < 16)  body<0>(acc, u, wr, wc, fr, fq, (bf16_t*)(ws + WS_CV), 512, 256 * (pn - 14), 0);
        else               body<F_SILU>(acc, u, wr, wc, fr, fq, (bf16_t*)(ws + WS_CG), 512, 256 * (pn - 16), 0);
    }
};
}

__device__ __forceinline__ float log2_gamma(int h) { return __builtin_amdgcn_logf(1.0f - __builtin_amdgcn_exp2f(-5.0f - (float)h)); }

namespace naive {
struct ANorm {
    const float* x; const float* gain; const LAS float* rs; int m0;
    __device__ __forceinline__ float get(int m, int k) const { return x[(size_t)m * DM + k] * rs[m - m0] * gain[k]; }
};
struct ABf {
    const bf16_t* a; int pitch;
    __device__ __forceinline__ float get(int m, int k) const { return bf2f(a[(size_t)m * pitch + k]); }
};
template <int NB, bool SHARED_A, bool NORM, int RT, class Epi>
__device__ __forceinline__ void gemm(LAS unsigned char* lds, const int tid, int vcu, int G, int N, int K,
                                     const float* x, const float* gain, const bf16_t* a0, const bf16_t* a1, const bf16_t* a2, int apitch,
                                     const float* w0, const float* w1, const float* w2, int ldb, const Epi& E) {
    constexpr int NA = SHARED_A ? 1 : NB;
    LAS float* As = (LAS float*)lds;
    LAS float* Bs = As + NA * 16 * 132;
    LAS float* rs = Bs + NB * 16 * 128;
    const int tx = tid & 15, ty = tid >> 4, lane = tid & 63, wave = tid >> 6;
    constexpr int TM = 32 * RT;
    const int ntn = N / 128, ntiles = (M / TM) * ntn;
    for (int tile = vcu; tile < ntiles; tile += G) {
        const int m0 = (tile / ntn) * TM, n0 = (tile % ntn) * 128;
        __syncthreads();
        if (NORM) {
            for (int r = wave * (TM / 8); r < wave * (TM / 8) + TM / 8; ++r) {
                const float* xr = x + (size_t)(m0 + r) * DM; float s = 0.f;
                for (int k = lane; k < DM; k += 64) { const float v = xr[k]; s += v * v; }
                s = wave_sum(s);
                if (lane == 0) rs[r] = 1.0f / sqrtf(s * (1.0f / DM) + EPS);
            }
            __syncthreads();
        }
        float acc[NB][RT][8];
#pragma unroll
        for (int b = 0; b < NB; ++b)
#pragma unroll
            for (int i = 0; i < RT; ++i)
#pragma unroll
                for (int j = 0; j < 8; ++j) acc[b][i][j] = 0.f;
        for (int k0 = 0; k0 < K; k0 += 16) {
            {
                const int r = tid >> 2, kq = (tid & 3) * 4;
                if (r < TM)
#pragma unroll
                for (int b = 0; b < NA; ++b)
#pragma unroll
                    for (int i = 0; i < 4; ++i) {
                        float v;
                        if (NORM) v = x[(size_t)(m0 + r) * DM + k0 + kq + i] * rs[r] * gain[k0 + kq + i];
                        else { const bf16_t* ap = (b == 0 ? a0 : (b == 1 ? a1 : a2)); v = bf2f(ap[(size_t)(m0 + r) * apitch + k0 + kq + i]); }
                        As[(b * 16 + kq + i) * 132 + r] = v;
                    }
                const int kb = tid >> 5, n4 = (tid & 31) * 4;
#pragma unroll
                for (int b = 0; b < NB; ++b) { const float* wp = (b == 0 ? w0 : (b == 1 ? w1 : w2));
                    const f32x4 v = *(const f32x4*)(wp + (size_t)(k0 + kb) * ldb + n0 + n4);
                    *(LAS f32x4*)(Bs + (b * 16 + kb) * 128 + n4) = v; }
            }
            __syncthreads();
#pragma unroll
            for (int kk = 0; kk < 16; ++kk) {
#pragma unroll
                for (int b = 0; b < NB; ++b) {
                    const int ab = SHARED_A ? 0 : b;
                    float av[RT];
#pragma unroll
                    for (int i = 0; i < RT; ++i) av[i] = As[(ab * 16 + kk) * 132 + ty * RT + i];
                    const f32x4 b0 = *(const LAS f32x4*)(Bs + (b * 16 + kk) * 128 + tx * 8), b1 = *(const LAS f32x4*)(Bs + (b * 16 + kk) * 128 + tx * 8 + 4);
#pragma unroll
                    for (int i = 0; i < RT; ++i)
#pragma unroll
                        for (int j = 0; j < 4; ++j) { acc[b][i][j] += av[i] * b0[j]; acc[b][i][4 + j] += av[i] * b1[j]; }
                }
            }
            __syncthreads();
        }
#pragma unroll
        for (int i = 0; i < RT; ++i) E(m0 + ty * RT + i, n0 + tx * 8, acc, i, tx);
    }
}

__device__ __forceinline__ void xb_ssq_pass(const float* x, bf16_t* xb, float* ssq, int gw, int ngw, int lane) {
    for (int m0 = gw * 4; m0 < M; m0 += ngw * 4) {
        f32x4 v[4][4];
#pragma unroll
        for (int r = 0; r < 4; ++r)
#pragma unroll
            for (int j = 0; j < 4; ++j) v[r][j] = ((const f32x4*)(x + (size_t)(m0 + r) * DM) + lane)[64 * j];
#pragma unroll
        for (int r = 0; r < 4; ++r) {
            float s = 0.f; u32x2* o = (u32x2*)(xb + (size_t)(m0 + r) * DM) + lane;
#pragma unroll
            for (int j = 0; j < 4; ++j) { const f32x4 w4 = v[r][j]; s += (w4[0] * w4[0] + w4[1] * w4[1]) + (w4[2] * w4[2] + w4[3] * w4[3]); u32x2 w; w.x = pk2(w4[0], w4[1]); w.y = pk2(w4[2], w4[3]); o[64 * j] = w; }
            s = wave_sum(s);
            if (lane < 16) ssq[(size_t)(m0 + r) * 16 + lane] = (lane == 0) ? s : 0.f;
        }
    }
}

struct NEpiUp { bf16_t* H;
    __device__ __forceinline__ void operator()(int m, int n, const float (&acc)[2][4][8], int i, int tx) const {
#pragma unroll
        for (int j = 0; j < 8; ++j) { const float g = acc[0][i][j], u = acc[1][i][j]; H[(size_t)m * DFF + n + j] = (bf16_t)f2bf(g / (1.0f + expf(-g)) * u); } } };
struct NEpiRes { const float* xold; float* xnew; bf16_t* xb; float* ssq; float s;
    __device__ __forceinline__ void operator()(int m, int n, const float (&acc)[1][4][8], int i, int tx) const {
        float ss = 0.f;
#pragma unroll
        for (int j = 0; j < 8; ++j) { const float v = xold[(size_t)m * DM + n + j] + s * acc[0][i][j]; xnew[(size_t)m * DM + n + j] = v; xb[(size_t)m * DM + n + j] = (bf16_t)f2bf(v); ss += v * v; }
        ss += __shfl_xor(ss, 1); ss += __shfl_xor(ss, 2); ss += __shfl_xor(ss, 4); ss += __shfl_xor(ss, 8);
        if (tx == 0) { ssq[(size_t)m * 16 + (n >> 7)] = ss; ssq[(size_t)m * 16 + 8 + (n >> 7)] = 0.f; }
    } };
struct NEpiGate { bf16_t* G;
    __device__ __forceinline__ void operator()(int m, int n, const float (&acc)[1][4][8], int i, int tx) const {
#pragma unroll
        for (int j = 0; j < 8; ++j) G[(size_t)m * NGATE + n + j] = (bf16_t)f2bf(fmaxf(1.0f / (1.0f + expf(-acc[0][i][j])), 9.5367431640625e-07f)); } };
struct NEpiMerge { const bf16_t* G; bf16_t* MG;
    __device__ __forceinline__ void operator()(int m, int n, const float (&acc)[3][2][8], int i, int tx) const {
#pragma unroll
        for (int j = 0; j < 8; ++j) { const size_t go = (size_t)m * NGATE + n + j;
            const float v = bf2f(G[go]) * acc[0][i][j] + bf2f(G[go + 1024]) * acc[1][i][j] + bf2f(G[go + 2048]) * acc[2][i][j];
            MG[(size_t)m * DM + n + j] = (bf16_t)f2bf(v); } } };
struct NEpiWin { unsigned char* ws; const float* cosT; const float* sinT; const float *aqn, *akn, *bqn, *bkn;
    __device__ __forceinline__ void operator()(int m, int n, const float (&acc)[1][4][8], int i, int tx) const {
        size_t obase; int pitch, c0, flags; const float* gain = nullptr;
        if (n < 512)       { obase = WS_AQ; pitch = 512; c0 = 0;    flags = epi::F_NORM | epi::F_ROPE | epi::F_C2; gain = aqn; }
        else if (n < 1024) { obase = WS_AK; pitch = 512; c0 = 512;  flags = epi::F_NORM | epi::F_ROPE; gain = akn; }
        else if (n < 1536) { obase = WS_AV; pitch = 512; c0 = 1024; flags = 0; }
        else if (n < 2048) { obase = WS_BQ; pitch = 512; c0 = 1536; flags = epi::F_NORM | epi::F_C2; gain = bqn; }
        else if (n < 2560) { obase = WS_BK; pitch = 512; c0 = 2048; flags = epi::F_NORM; gain = bkn; }
        else if (n < 3072) { obase = WS_BV; pitch = 512; c0 = 2560; flags = 0; }
        else if (n < 3328) { obase = WS_CQ; pitch = 256; c0 = 3072; flags = epi::F_ROPE; }
        else if (n < 3584) { obase = WS_CK; pitch = 256; c0 = 3328; flags = epi::F_ROPE | epi::F_CKD; }
        else if (n < 4096) { obase = WS_CV; pitch = 512; c0 = 3584; flags = 0; }
        else               { obase = WS_CG; pitch = 512; c0 = 4096; flags = epi::F_SILU; }
        const int t = m & (SEQ - 1), d0 = n & 63; float v[8];
#pragma unroll
        for (int j = 0; j < 8; ++j) v[j] = acc[0][i][j];
        if (flags & epi::F_NORM) { float ss = 0.f;
#pragma unroll
            for (int j = 0; j < 8; ++j) ss += v[j] * v[j];
            ss += __shfl_xor(ss, 1); ss += __shfl_xor(ss, 2); ss += __shfl_xor(ss, 4);
            const float r = 1.0f / sqrtf(ss * (1.0f / 64.0f) + EPS);
#pragma unroll
            for (int j = 0; j < 8; ++j) v[j] = v[j] * r * gain[d0 + j]; }
        if (flags & epi::F_ROPE) {
#pragma unroll
            for (int j = 0; j < 8; ++j) { const float p = __shfl_xor(v[j], 4); const int d = d0 + j, ii = d & 31; const float c = cosT[t * 32 + ii], s = sinT[t * 32 + ii];
                v[j] = (d < 32) ? (v[j] * c - p * s) : (v[j] * c + p * s); } }
        float sc = 1.0f;
        if (flags & epi::F_C2) sc = C2;
        if (flags & epi::F_CKD) sc = 0.125f * exp2f(-(float)(t & 63) * log2_gamma((n - 3328) >> 6));
        bf16_t* o = (bf16_t*)(ws + obase) + (size_t)m * pitch + (n - c0);
#pragma unroll
        for (int j = 0; j < 8; ++j) { float y = v[j] * sc; if (flags & epi::F_SILU) y = y / (1.0f + expf(-y)); o[j] = (bf16_t)f2bf(y); }
    } };

__device__ __forceinline__ void attn_a(unsigned char* ws, const float* lq1, const float* lk1, const float* lq2, const float* lk2, const float* subln, float lam_init,
                                       LAS unsigned char* lds, int gw, int ngw, int wave, int lane) {
    const bf16_t* AQ = (const bf16_t*)(ws + WS_AQ); const bf16_t* AK = (const bf16_t*)(ws + WS_AK); const bf16_t* AV = (const bf16_t*)(ws + WS_AV); bf16_t* YA = (bf16_t*)(ws + WS_AQ);
    const float lam = expf(wave_sum(lq1[lane] * lk1[lane])) - expf(wave_sum(lq2[lane] * lk2[lane])) + lam_init;
    LAS float* qs = (LAS float*)lds + wave * 128;
    for (int task = gw; task < M * 4; task += ngw) {
        const int h = task & 3, m = task >> 2, b = m >> 13, t = m & (SEQ - 1), nch = (t >> 6) + 1;
        qs[lane] = bf2f(AQ[(size_t)m * 512 + h * 128 + lane]); qs[64 + lane] = bf2f(AQ[(size_t)m * 512 + h * 128 + 64 + lane]);
        LDS_WAIT(); asm volatile("" ::: "memory");
        float mx[2] = {-1e30f, -1e30f}, l[2] = {0.f, 0.f}, o[2][2] = {{0.f, 0.f}, {0.f, 0.f}};
        for (int c = 0; c < nch; ++c) {
            const size_t krow = (size_t)(b * SEQ + c * 64 + lane);
            float s[2] = {0.f, 0.f};
            for (int cc = 0; cc < 2; ++cc) { const u32x4* kp = (const u32x4*)(AK + krow * 512 + h * 128 + cc * 64);
                for (int q = 0; q < 8; ++q) { const u32x4 w = kp[q]; const LAS float* qq = qs + cc * 64 + q * 8;
                    s[cc] += bflo(w.x) * qq[0] + bfhi(w.x) * qq[1] + bflo(w.y) * qq[2] + bfhi(w.y) * qq[3] + bflo(w.z) * qq[4] + bfhi(w.z) * qq[5] + bflo(w.w) * qq[6] + bfhi(w.w) * qq[7]; } }
            float p[2];
            for (int cc = 0; cc < 2; ++cc) { const float mn = fmaxf(mx[cc], wave_max(s[cc])), f = exp2f(mx[cc] - mn); mx[cc] = mn; p[cc] = exp2f(s[cc] - mn);
                l[cc] = l[cc] * f + wave_sum(p[cc]); o[cc][0] *= f; o[cc][1] *= f; }
            for (int j = 0; j < 64; ++j) { const float p0 = __shfl(p[0], j), p1 = __shfl(p[1], j); const size_t vrow = (size_t)(b * SEQ + c * 64 + j) * 512 + h * 128;
                const float v0 = bf2f(AV[vrow + lane]), v1 = bf2f(AV[vrow + 64 + lane]);
                o[0][0] += p0 * v0; o[0][1] += p0 * v1; o[1][0] += p1 * v0; o[1][1] += p1 * v1; }
        }
        const float y0 = o[0][0] / l[0] - lam * o[1][0] / l[1], y1 = o[0][1] / l[0] - lam * o[1][1] / l[1];
        const float r = 1.0f / sqrtf(wave_sum(y0 * y0 + y1 * y1) * (1.0f / 128.0f) + EPS) * (1.0f - lam_init);
        YA[(size_t)m * 512 + h * 128 + lane] = (bf16_t)f2bf(y0 * r * subln[lane]); YA[(size_t)m * 512 + h * 128 + 64 + lane] = (bf16_t)f2bf(y1 * r * subln[64 + lane]);
        asm volatile("" ::: "memory");
    }
}
__device__ __forceinline__ void attn_b(unsigned char* ws, const float* relb, LAS unsigned char* lds, int gw, int ngw, int wave, int lane) {
    const bf16_t* BQ = (const bf16_t*)(ws + WS_BQ); const bf16_t* BK = (const bf16_t*)(ws + WS_BK); const bf16_t* BV = (const bf16_t*)(ws + WS_BV); bf16_t* YB = (bf16_t*)(ws + WS_BQ);
    LAS float* qs = (LAS float*)lds + wave * 128;
    for (int task = gw; task < M * 8; task += ngw) {
        const int h = task & 7, m = task >> 3, b = m >> 13, t = m & (SEQ - 1), n = t >> 6;
        qs[lane] = bf2f(BQ[(size_t)m * 512 + h * 64 + lane]);
        LDS_WAIT(); asm volatile("" ::: "memory");
        float mx = -1e30f, l = 0.f, o = 0.f;
        for (int c = (n >= 8 ? n - 8 : 0); c <= n; ++c) {
            const int kpos = c * 64 + lane; const size_t krow = (size_t)(b * SEQ + kpos);
            float s = 0.f; const u32x4* kp = (const u32x4*)(BK + krow * 512 + h * 64);
            for (int q = 0; q < 8; ++q) { const u32x4 w = kp[q]; const LAS float* qq = qs + q * 8;
                s += bflo(w.x) * qq[0] + bfhi(w.x) * qq[1] + bflo(w.y) * qq[2] + bfhi(w.y) * qq[3] + bflo(w.z) * qq[4] + bfhi(w.z) * qq[5] + bflo(w.w) * qq[6] + bfhi(w.w) * qq[7]; }
            int rel = t - kpos; rel = rel < -63 ? -63 : (rel > 256 ? 256 : rel);
            s += relb[h * 320 + rel + 63] * LOG2E;
            const float mn = fmaxf(mx, wave_max(s)), f = exp2f(mx - mn); mx = mn; const float p = exp2f(s - mn);
            l = l * f + wave_sum(p); o *= f;
            for (int j = 0; j < 64; ++j) o += __shfl(p, j) * bf2f(BV[(size_t)(b * SEQ + c * 64 + j) * 512 + h * 64 + lane]);
        }
        YB[(size_t)m * 512 + h * 64 + lane] = (bf16_t)f2bf(o / l);
        asm volatile("" ::: "memory");
    }
}
__device__ __forceinline__ void retention(unsigned char* ws, const float* onorm, LAS unsigned char* lds, int vcu, int G, int tid) {
    const bf16_t* CQ = (const bf16_t*)(ws + WS_CQ); const bf16_t* CK = (const bf16_t*)(ws + WS_CK); const bf16_t* CV = (const bf16_t*)(ws + WS_CV); bf16_t* CG = (bf16_t*)(ws + WS_CG);
    LAS float* qs = (LAS float*)lds; LAS float* ks = qs + 64 * 64; LAS float* vs = ks + 64 * 64; LAS float* os = vs + 64 * 128;
    for (int bh = vcu; bh < 8; bh += G) {
        const int b = bh >> 2, h = bh & 3; const float l2g = log2_gamma(h), gam = exp2f(l2g);
        float S[64];
#pragma unroll
        for (int d = 0; d < 64; ++d) S[d] = 0.f;
        for (int n = 0; n < SEQ / 64; ++n) {
            __syncthreads();
            for (int i = tid; i < 64 * 64; i += 512) { const int r = i >> 6, d = i & 63; const size_t row = (size_t)(b * SEQ + n * 64 + r);
                qs[i] = bf2f(CQ[row * 256 + h * 64 + d]); ks[i] = bf2f(CK[row * 256 + h * 64 + d]) * exp2f((float)r * l2g); }
            for (int i = tid; i < 64 * 128; i += 512) { const int r = i >> 7, e = i & 127; vs[i] = bf2f(CV[(size_t)(b * SEQ + n * 64 + r) * 512 + h * 128 + e]); }
            __syncthreads();
            if (tid < 128) {
                for (int r = 0; r < 64; ++r) { const float v = vs[r * 128 + tid]; float o = 0.f;
#pragma unroll
                    for (int d = 0; d < 64; ++d) { S[d] = gam * S[d] + ks[r * 64 + d] * v; o += qs[r * 64 + d] * S[d]; }
                    os[r * 128 + tid] = o; }
            }
            __syncthreads();
            { const int r = tid >> 3, e0 = (tid & 7) * 16; float ss = 0.f;
#pragma unroll
              for (int j = 0; j < 16; ++j) { const float v = os[r * 128 + e0 + j]; ss += v * v; }
              ss += __shfl_xor(ss, 1); ss += __shfl_xor(ss, 2); ss += __shfl_xor(ss, 4);
              const float rr = 1.0f / sqrtf(ss * (1.0f / 128.0f) + EPS); bf16_t* g = CG + (size_t)(b * SEQ + n * 64 + r) * 512 + h * 128 + e0;
#pragma unroll
              for (int j = 0; j < 16; ++j) g[j] = (bf16_t)f2bf(bf2f(g[j]) * os[r * 128 + e0 + j] * rr * onorm[h * 128 + e0 + j]); }
        }
    }
}
}

namespace fa {
typedef short s16x4 __attribute__((ext_vector_type(4)));
typedef short v4i16_t __attribute__((ext_vector_type(4)));
typedef LAS const unsigned char* lds_cptr;
constexpr int SLOTB = 32768, NSLOT = 3, KOFF = 0, VOFF = 16384;
constexpr int LDS_WS = NSLOT * SLOTB, LDS_BIAS = LDS_WS + 2048, LDS_END = LDS_BIAS + 2560;
constexpr float THR = 8.0f;
__device__ __forceinline__ int crow(int r, int hi) { return (r & 3) + 8 * (r >> 2) + 4 * hi; }
__device__ __forceinline__ void glds16(const void* gsrc, unsigned lds_dst) { unsigned keep;
    asm volatile("s_mov_b32 %0, m0\n\ts_mov_b32 m0, %2\n\ts_nop 0\n\tglobal_load_lds_dwordx4 %1, off\n\ts_mov_b32 m0, %0" : "=&s"(keep) : "v"(gsrc), "s"(lds_dst) : "memory"); }
__device__ __forceinline__ void glds16s(const void* sbase, unsigned voff, unsigned lds_dst) { unsigned keep;
    asm volatile("s_mov_b32 %0, m0\n\ts_mov_b32 m0, %3\n\ts_nop 0\n\tglobal_load_lds_dwordx4 %1, %2\n\ts_mov_b32 m0, %0" : "=&s"(keep) : "v"(voff), "s"(sbase), "s"(lds_dst) : "memory"); }
#define FA_WAIT_BAR(N) asm volatile("s_waitcnt vmcnt(" #N ") lgkmcnt(0)\n\ts_barrier" ::: "memory")
#define FA_BAR() asm volatile("s_waitcnt lgkmcnt(0)\n\ts_barrier" ::: "memory")
__device__ __forceinline__ s16x4 vtr(lds_cptr p) { return __builtin_bit_cast(s16x4, __builtin_amdgcn_ds_read_tr16_b64_v4i16((LAS v4i16_t*)p)); }
__device__ __forceinline__ bf16x8 cat8(const s16x4 lo, const s16x4 hi) { return (bf16x8){lo[0], lo[1], lo[2], lo[3], hi[0], hi[1], hi[2], hi[3]}; }
__device__ __forceinline__ float swapmax(float m) { auto rr = __builtin_amdgcn_permlane32_swap(__float_as_uint(m), __float_as_uint(m), false, false); return fmaxf(__uint_as_float(rr[0]), __uint_as_float(rr[1])); }
__device__ __forceinline__ float swapsum(float m) { auto rr = __builtin_amdgcn_permlane32_swap(__float_as_uint(m), __float_as_uint(m), false, false); return __uint_as_float(rr[0]) + __uint_as_float(rr[1]); }
__device__ __forceinline__ bf16x8 pack_p(const f32x16& p, int base) { u32x4 w; w.x = cvt_pk_bf16(p[base], p[base + 1]); w.y = cvt_pk_bf16(p[base + 2], p[base + 3]); w.z = cvt_pk_bf16(p[base + 4], p[base + 5]); w.w = cvt_pk_bf16(p[base + 6], p[base + 7]); return __builtin_bit_cast(bf16x8, w); }
__device__ __forceinline__ float half_sum32(float v) {
    v = xor_add<1>(v); v = xor_add<2>(v); v = xor_add<4>(v); v = xor_add<8>(v); return xor_add<16>(v);
}

template <int MODE>
__device__ __forceinline__ void attn_unit(LAS unsigned char* lds, const int tid, const bf16_t* Qg, const bf16_t* Kg, const bf16_t* Vg, bf16_t* Yg, const int b, const int hq, const int u,
                                          const float lam, const float osc, const float* subln) {
    constexpr int PITCH = 512, NDB = (MODE == 0) ? 4 : 2;
    const int lane = tid & 63, r32 = lane & 31, hi = lane >> 5, wid = __builtin_amdgcn_readfirstlane(tid >> 6), ch = wid >> 2, wq = wid & 3;
    const int cw = 2 * u + (wq >> 1);
    const int t0 = (MODE == 0) ? 0 : ((2 * u - 8) > 0 ? (2 * u - 8) : 0), t1 = 2 * u + 1, NT = t1 - t0 + 1;
    const size_t rowbase = (size_t)b * SEQ;
    const bf16_t* Kb = Kg + rowbase * PITCH + hq * 128; const bf16_t* Vb = Vg + rowbase * PITCH + hq * 128;
    const unsigned lds0 = (unsigned)(uintptr_t)lds;
    LAS float* wsf = (LAS float*)(lds + LDS_WS) + wid * 64;
    const bf16_t* ksrc = Kb + (size_t)lane * PITCH + (2 * wid) * 8;
    const bf16_t* vsrc0 = Vb + (size_t)(16 * ((2 * wid) & 3) + (lane >> 2)) * PITCH + 32 * ((2 * wid) >> 2) + (lane & 3) * 8;
    const bf16_t* vsrc1 = Vb + (size_t)(16 * ((2 * wid + 1) & 3) + (lane >> 2)) * PITCH + 32 * ((2 * wid + 1) >> 2) + (lane & 3) * 8;
#define FA_DMA(t, slot) do { const size_t to_ = (size_t)(t) * 64 * PITCH; const unsigned sb_ = lds0 + (unsigned)(slot) * SLOTB; \
        glds16(ksrc + to_, (unsigned)__builtin_amdgcn_readfirstlane(sb_ + KOFF + (2 * wid) * 1024)); glds16(ksrc + to_ + 8, (unsigned)__builtin_amdgcn_readfirstlane(sb_ + KOFF + (2 * wid + 1) * 1024)); \
        glds16(vsrc0 + to_, (unsigned)__builtin_amdgcn_readfirstlane(sb_ + VOFF + (2 * wid) * 1024)); glds16(vsrc1 + to_, (unsigned)__builtin_amdgcn_readfirstlane(sb_ + VOFF + (2 * wid + 1) * 1024)); } while (0)
    FA_DMA(t0, 0);
    if (NT > 1) FA_DMA(t0 + 1, 1);
    const size_t qrow = rowbase + (size_t)u * 128 + wq * 32;
    bf16x8 qr[4];
#pragma unroll
    for (int i = 0; i < 4; ++i) qr[i] = *(const bf16x8*)(Qg + (qrow + r32) * PITCH + hq * 128 + ch * 64 + i * 16 + hi * 8);
    f32x16 o[NDB];
#pragma unroll
    for (int d = 0; d < NDB; ++d)
#pragma unroll
        for (int r = 0; r < 16; ++r) o[d][r] = 0.f;
    float mref = 0.f, lsum = 0.f; bool first = true;
    const lds_cptr kp0 = (lds_cptr)lds + KOFF + ch * 8192 + hi * 1024 + r32 * 16;
    const lds_cptr vp0 = (lds_cptr)lds + VOFF + ((MODE == 0) ? 0 : ch * 8192) + ((lane >> 4) & 1) * 32 + (lane & 3) * 8 + (4 * hi + ((lane & 15) >> 2)) * 64;
    int slot = 0;
    for (int i = 0; i < NT; ++i) {
        if (i + 1 < NT) FA_WAIT_BAR(4); else FA_WAIT_BAR(0);
        if (i + 2 < NT) { const int s2 = (slot == 0) ? 2 : slot - 1; FA_DMA(t0 + i + 2, s2); }
        const int t = t0 + i;
        const bool vis = (MODE == 0) ? (t <= cw) : (t <= cw && t + 8 >= cw);
        if (vis) {
            const lds_cptr kp = kp0 + slot * SLOTB; const lds_cptr vp = vp0 + slot * SLOTB;
            f32x16 p0, p1;
#pragma unroll
            for (int r = 0; r < 16; ++r) { p0[r] = 0.f; p1[r] = 0.f; }
#pragma unroll
            for (int k = 0; k < 4; ++k) {
                const bf16x8 ka = *(const LAS bf16x8*)(kp + k * 2048), kb = *(const LAS bf16x8*)(kp + k * 2048 + 512);
                p0 = __builtin_amdgcn_mfma_f32_32x32x16_bf16(ka, qr[k], p0, 0, 0, 0);
                p1 = __builtin_amdgcn_mfma_f32_32x32x16_bf16(kb, qr[k], p1, 0, 0, 0);
            }
            if (MODE == 1) {
                const LAS float* bt = (const LAS float*)(lds + LDS_BIAS) + ch * 320;
                const int relb = 64 * (cw - t) + 32 * (wq & 1) + r32 + 63;
                if (cw - t >= 5) { const float c = bt[319];
#pragma unroll
                    for (int r = 0; r < 16; ++r) { p0[r] += c; p1[r] += c; }
                } else {
#pragma unroll
                    for (int r = 0; r < 16; ++r) { const int i0 = relb - crow(r, hi), i1 = i0 - 32; p0[r] += bt[i0 > 319 ? 319 : i0]; p1[r] += bt[i1 > 319 ? 319 : i1]; }
                }
            }
            float rm = fmaxf(p0[0], p1[0]);
#pragma unroll
            for (int r = 1; r < 16; ++r) rm = fmaxf(rm, fmaxf(p0[r], p1[r]));
            rm = swapmax(rm);
            if (first) { mref = rm; first = false; }
            else if (__any(rm - mref > THR)) {
                const float dl = fmaxf(rm - mref, 0.f); mref += dl; const float f = fast_exp2(-dl); lsum *= f;
                if (hi == 0) wsf[r32] = f;
                LDS_WAIT();
#pragma unroll
                for (int r = 0; r < 16; ++r) { const float fr = wsf[crow(r, hi)];
#pragma unroll
                    for (int d = 0; d < NDB; ++d) o[d][r] *= fr; }
            }
            float sacc = 0.f;
#pragma unroll
            for (int r = 0; r < 16; ++r) { p0[r] = fast_exp2(p0[r] - mref); p1[r] = fast_exp2(p1[r] - mref); sacc += p0[r] + p1[r]; }
            lsum += sacc;
            const bf16x8 pa0 = pack_p(p0, 0), pa1 = pack_p(p0, 8), pa2 = pack_p(p1, 0), pa3 = pack_p(p1, 8);
#pragma unroll
            for (int d = 0; d < NDB; ++d) {
                const lds_cptr vd = vp + d * 4096;
                const bf16x8 v0 = cat8(vtr(vd), vtr(vd + 512)), v1 = cat8(vtr(vd + 1024), vtr(vd + 1024 + 512)), v2 = cat8(vtr(vd + 2048), vtr(vd + 2048 + 512)), v3 = cat8(vtr(vd + 3072), vtr(vd + 3072 + 512));
                o[d] = __builtin_amdgcn_mfma_f32_32x32x16_bf16(pa0, v0, o[d], 0, 0, 0);
                o[d] = __builtin_amdgcn_mfma_f32_32x32x16_bf16(pa1, v1, o[d], 0, 0, 0);
                o[d] = __builtin_amdgcn_mfma_f32_32x32x16_bf16(pa2, v2, o[d], 0, 0, 0);
                o[d] = __builtin_amdgcn_mfma_f32_32x32x16_bf16(pa3, v3, o[d], 0, 0, 0);
            }
        }
        slot = (slot == NSLOT - 1) ? 0 : slot + 1;
    }
    lsum = swapsum(lsum);
    if (hi == 0) wsf[32 + r32] = lsum;
    LDS_WAIT();
#pragma unroll
    for (int r = 0; r < 16; ++r) { const float il = fast_rcp(wsf[32 + crow(r, hi)]);
#pragma unroll
        for (int d = 0; d < NDB; ++d) o[d][r] *= il; }
    FA_BAR();
    if (MODE == 0) {
        LAS float* xf = (LAS float*)lds + (wid & 3) * 4096;
        if (ch == 1) {
#pragma unroll
            for (int d = 0; d < 4; ++d)
#pragma unroll
                for (int r = 0; r < 16; ++r) xf[(d * 16 + r) * 64 + lane] = o[d][r];
        }
        FA_BAR();
        if (ch == 0) {
            float ss[16];
#pragma unroll
            for (int r = 0; r < 16; ++r) ss[r] = 0.f;
#pragma unroll
            for (int d = 0; d < 4; ++d)
#pragma unroll
                for (int r = 0; r < 16; ++r) { const float y = o[d][r] - lam * xf[(d * 16 + r) * 64 + lane]; o[d][r] = y; ss[r] += y * y; }
            LAS bf16_t* stg = (LAS bf16_t*)(lds + 65536) + wid * 4096;
            float g[4];
#pragma unroll
            for (int d = 0; d < 4; ++d) g[d] = subln[32 * d + r32] * osc;
#pragma unroll
            for (int r = 0; r < 16; ++r) { const float rs = __builtin_amdgcn_rsqf(half_sum32(ss[r]) * (1.0f / 128.0f) + EPS); const int orow = crow(r, hi);
#pragma unroll
                for (int d = 0; d < 4; ++d) stg[orow * 128 + d * 32 + r32] = (bf16_t)f2bf(o[d][r] * rs * g[d]); }
            LDS_WAIT();
#pragma unroll
            for (int i = 0; i < 8; ++i) { const int idx = i * 64 + lane, row = idx >> 4, c8 = idx & 15;
                const u32x4 v = *(const LAS u32x4*)(stg + row * 128 + c8 * 8);
                *(u32x4*)(Yg + (qrow + row) * PITCH + hq * 128 + c8 * 8) = v; }
        }
    } else {
        LAS bf16_t* stg = (LAS bf16_t*)lds + wid * 2048;
#pragma unroll
        for (int r = 0; r < 16; ++r) { const int orow = crow(r, hi);
#pragma unroll
            for (int d = 0; d < 2; ++d) stg[orow * 64 + d * 32 + r32] = (bf16_t)f2bf(o[d][r]); }
        LDS_WAIT();
#pragma unroll
        for (int i = 0; i < 4; ++i) { const int idx = i * 64 + lane, row = idx >> 3, c8 = idx & 7;
            const u32x4 v = *(const LAS u32x4*)(stg + row * 64 + c8 * 8);
            *(u32x4*)(Yg + (qrow + row) * PITCH + hq * 128 + ch * 64 + c8 * 8) = v; }
    }
    FA_BAR();
#undef FA_DMA
}

constexpr int NSLOT2 = 4, LDS_WS2 = 132096, LDS_BIAS2 = LDS_WS2 + 2048;
template <int MODE>
__device__ __forceinline__ void attn_unit2(LAS unsigned char* lds, const int tid_, const bf16_t* Qg, const bf16_t* Kg, const bf16_t* Vg, bf16_t* Yg, const int b, const int hq, const int u,
                                           const float lam, const float osc, const float* subln, const int pm = 0) {
    constexpr int PITCH = 512, NDB = (MODE == 0) ? 4 : 2;
    int tid = tid_; asm volatile("" : "+v"(tid));
    const int lane = tid & 63, r32 = lane & 31, hi = lane >> 5, hwid = __builtin_amdgcn_readfirstlane(tid >> 6);
#if FA_WMAP == 1
    const int wid = (hwid >> 1) | ((hwid & 1) << 2);
#elif FA_WMAP == 2
    const int wid = (hwid & 1) | ((hwid >> 2) << 1) | (((hwid >> 1) & 1) << 2);
#else
    const int wid = hwid;
#endif
    const int ch = wid >> 2, wq = wid & 3;
    const int cw = 2 * u + (wq >> 1);
    const int t0 = (MODE == 0) ? 0 : ((2 * u - 8) > 0 ? (2 * u - 8) : 0), t1 = 2 * u + 1, NT = t1 - t0 + 1;
    const int iv1 = cw - t0, iv0 = (MODE == 0) ? 0 : ((cw - 8 - t0) > 0 ? (cw - 8 - t0) : 0);
    const size_t rowbase = (size_t)b * SEQ;
    const bf16_t* Kb = Kg + rowbase * PITCH + hq * 128; const bf16_t* Vb = Vg + rowbase * PITCH + hq * 128;
    const unsigned lds0 = (unsigned)(uintptr_t)lds;
    LAS float* wsf = (LAS float*)(lds + LDS_WS2) + wid * 64;
    const bf16_t* kbase = Kb + (2 * wid) * 8;
    const bf16_t* vbase = Vb + (size_t)(16 * ((2 * wid) & 3)) * PITCH + 32 * ((2 * wid) >> 2);
    const unsigned kvo = (unsigned)lane * PITCH * 2u, vvo = (unsigned)((lane >> 2) * PITCH + (lane & 3) * 8) * 2u;
#define FA_DMA(t, slot) do { if (pm == 1) break; const size_t to_ = (size_t)(t) * 64 * PITCH; const unsigned sb_ = lds0 + (unsigned)(slot) * SLOTB; \
        glds16s(kbase + to_, kvo, (unsigned)__builtin_amdgcn_readfirstlane(sb_ + KOFF + (2 * wid) * 1024)); glds16s(kbase + to_ + 8, kvo, (unsigned)__builtin_amdgcn_readfirstlane(sb_ + KOFF + (2 * wid + 1) * 1024)); \
        glds16s(vbase + to_, vvo, (unsigned)__builtin_amdgcn_readfirstlane(sb_ + VOFF + (2 * wid) * 1024)); glds16s(vbase + to_ + 16 * PITCH, vvo, (unsigned)__builtin_amdgcn_readfirstlane(sb_ + VOFF + (2 * wid + 1) * 1024)); } while (0)
    FA_DMA(t0, 0);
    FA_DMA(t0 + 1, 1);
    const size_t qrow = rowbase + (size_t)u * 128 + wq * 32;
    bf16x8 qr[4];
#pragma unroll
    for (int i = 0; i < 4; ++i) qr[i] = *(const bf16x8*)(Qg + (qrow + r32) * PITCH + hq * 128 + ch * 64 + i * 16 + hi * 8);
    f32x16 o[NDB];
#pragma unroll
    for (int d = 0; d < NDB; ++d)
#pragma unroll
        for (int r = 0; r < 16; ++r) o[d][r] = 0.f;
    float mref = 0.f, lsum = 0.f; bool first = true;
    const lds_cptr kp0 = (lds_cptr)lds + KOFF + ch * 8192 + hi * 1024 + r32 * 16;
    const lds_cptr vp0 = (lds_cptr)lds + VOFF + ((MODE == 0) ? 0 : ch * 8192) + ((lane >> 4) & 1) * 32 + (lane & 3) * 8 + (4 * hi + ((lane & 15) >> 2)) * 64;
    f32x16 p0, p1; bf16x8 pa0, pa1, pa2, pa3, kf[8], vf[NDB * 4];
#pragma unroll
    for (int r = 0; r < 16; ++r) { p0[r] = 0.f; p1[r] = 0.f; }
    pa0 = pa1 = pa2 = pa3 = (bf16x8){0, 0, 0, 0, 0, 0, 0, 0};
#pragma unroll
    for (int k = 0; k < NDB * 4; ++k) vf[k] = pa0;
#define FA_SB() __builtin_amdgcn_sched_barrier(0)
#define FA_KLD(i_) do { if (pm == 7) break; const lds_cptr kp = kp0 + ((i_) & 3) * SLOTB; \
        _Pragma("unroll") for (int k = 0; k < 4; ++k) { kf[2 * k] = *(const LAS bf16x8*)(kp + k * 2048); kf[2 * k + 1] = *(const LAS bf16x8*)(kp + k * 2048 + 512); } } while (0)
#define FA_QK(i_) do { \
        _Pragma("unroll") for (int r = 0; r < 16; ++r) { p0[r] = 0.f; p1[r] = 0.f; } \
        _Pragma("unroll") for (int k = 0; k < 4; ++k) { p0 = __builtin_amdgcn_mfma_f32_32x32x16_bf16(kf[2 * k], qr[k], p0, 0, 0, 0); p1 = __builtin_amdgcn_mfma_f32_32x32x16_bf16(kf[2 * k + 1], qr[k], p1, 0, 0, 0); } \
        if (MODE == 1) { const int t = t0 + (i_); const LAS float* bt = (const LAS float*)(lds + LDS_BIAS2) + ch * 320; const int relb = 64 * (cw - t) + 32 * (wq & 1) + r32 + 63; \
            if (cw - t >= 5) { const float c = bt[319]; _Pragma("unroll") for (int r = 0; r < 16; ++r) { p0[r] += c; p1[r] += c; } } \
            else { _Pragma("unroll") for (int r = 0; r < 16; ++r) { const int i0 = relb - crow(r, hi), i1 = i0 - 32; p0[r] += bt[i0 > 319 ? 319 : i0]; p1[r] += bt[i1 > 319 ? 319 : i1]; } } } } while (0)
#define FA_MX3(a, b, c) __builtin_fmaxf(__builtin_fmaxf((a), (b)), (c))
#define FA_SM() do { if (pm == 3) { asm volatile("" : "+v"(p0), "+v"(p1)); break; } \
        float ma = FA_MX3(p0[0], p0[1], p1[0]), mb = FA_MX3(p0[2], p0[3], p1[1]), mc = FA_MX3(p0[4], p0[5], p1[2]), md = FA_MX3(p0[6], p0[7], p1[3]); \
        ma = FA_MX3(ma, p0[8], p0[9]); mb = FA_MX3(mb, p0[10], p0[11]); mc = FA_MX3(mc, p0[12], p0[13]); md = FA_MX3(md, p0[14], p0[15]); \
        ma = FA_MX3(ma, p1[4], p1[5]); mb = FA_MX3(mb, p1[6], p1[7]); mc = FA_MX3(mc, p1[8], p1[9]); md = FA_MX3(md, p1[10], p1[11]); \
        ma = FA_MX3(ma, p1[12], p1[13]); mb = FA_MX3(mb, p1[14], p1[15]); float rm = __builtin_fmaxf(__builtin_fmaxf(ma, mb), __builtin_fmaxf(mc, md)); rm = swapmax(rm); \
        if (first) { mref = rm; first = false; } \
        else if (__any(rm - mref > THR)) { const float dl = fmaxf(rm - mref, 0.f); mref += dl; const float f = fast_exp2(-dl); lsum *= f; if (hi == 0) wsf[r32] = f; LDS_WAIT(); \
            _Pragma("unroll") for (int r = 0; r < 16; ++r) { const float fr = wsf[crow(r, hi)]; _Pragma("unroll") for (int d = 0; d < NDB; ++d) o[d][r] *= fr; } } \
        float sa = 0.f, sb = 0.f, sc = 0.f, sd = 0.f; \
        _Pragma("unroll") for (int r = 0; r < 16; r += 4) { p0[r] = fast_exp2(p0[r] - mref); p0[r + 1] = fast_exp2(p0[r + 1] - mref); p0[r + 2] = fast_exp2(p0[r + 2] - mref); p0[r + 3] = fast_exp2(p0[r + 3] - mref); \
            p1[r] = fast_exp2(p1[r] - mref); p1[r + 1] = fast_exp2(p1[r + 1] - mref); p1[r + 2] = fast_exp2(p1[r + 2] - mref); p1[r + 3] = fast_exp2(p1[r + 3] - mref); \
            sa += p0[r] + p1[r]; sb += p0[r + 1] + p1[r + 1]; sc += p0[r + 2] + p1[r + 2]; sd += p0[r + 3] + p1[r + 3]; } \
        lsum += (sa + sb) + (sc + sd); \
        pa0 = pack_p(p0, 0); pa1 = pack_p(p0, 8); pa2 = pack_p(p1, 0); pa3 = pack_p(p1, 8); } while (0)
#define FA_VLDALL(i_) do { if (pm == 4) break; const lds_cptr vt = vp0 + ((i_) & 3) * SLOTB; \
        _Pragma("unroll") for (int d = 0; d < NDB; ++d) _Pragma("unroll") for (int k = 0; k < 4; ++k) vf[4 * d + k] = cat8(vtr(vt + d * 4096 + k * 1024), vtr(vt + d * 4096 + k * 1024 + 512)); } while (0)
#define FA_PV() do { if (pm == 5) break; _Pragma("unroll") for (int d = 0; d < NDB; ++d) { \
        o[d] = __builtin_amdgcn_mfma_f32_32x32x16_bf16(pa0, vf[4 * d], o[d], 0, 0, 0); o[d] = __builtin_amdgcn_mfma_f32_32x32x16_bf16(pa1, vf[4 * d + 1], o[d], 0, 0, 0); \
        o[d] = __builtin_amdgcn_mfma_f32_32x32x16_bf16(pa2, vf[4 * d + 2], o[d], 0, 0, 0); o[d] = __builtin_amdgcn_mfma_f32_32x32x16_bf16(pa3, vf[4 * d + 3], o[d], 0, 0, 0); } } while (0)
#if PROBE_T
    unsigned tacc0 = 0, tacc1 = 0, tacc2 = 0, tacc3 = 0; unsigned long long s0 = 0, s1 = 0, s2 = 0, s3 = 0; const unsigned long long rt0 = __builtin_amdgcn_s_memrealtime();
#define FA_TS(v) do { FA_SB(); asm volatile("s_memtime %0\n\ts_waitcnt lgkmcnt(0)" : "=s"(v) :: "memory"); FA_SB(); } while (0)
#define FA_TSV(v, a, b) do { FA_SB(); asm volatile("s_nop 15\n\ts_nop 15" : "+v"(a), "+v"(b)); asm volatile("s_memtime %0\n\ts_waitcnt lgkmcnt(0)" : "=s"(v) :: "memory"); FA_SB(); } while (0)
#define FA_TACC() do { tacc0 += (unsigned)(s3 - s0); tacc1 += (unsigned)(s1 - s0); tacc2 += (unsigned)(s2 - s1); tacc3 += (unsigned)(s3 - s2); } while (0)
#define FA_TOUT(base) do { if (blockIdx.x == 0 && (hwid & 3) == 0 && u >= 32) { const unsigned long long rt1 = __builtin_amdgcn_s_memrealtime(); \
        unsigned long long* pv = (unsigned long long*)((char*)Yg - WS_AQ + WS_PROBE) + (base); if (lane == 0) { pv[0] = tacc0 / NT; pv[1] = tacc1 / NT; pv[2] = tacc2 / NT; pv[3] = tacc3 / NT; pv[4] = ((unsigned long long)tacc0 * 100) / (rt1 - rt0); pv[5] = NT; } } } while (0)
#else
#define FA_TS(v) do { } while (0)
#define FA_TSV(v, a, b) do { } while (0)
#define FA_TACC() do { } while (0)
#define FA_TOUT(base) do { } while (0)
#endif
    if (ch == 0) {
#pragma unroll 1
        for (int i = 0; i < NT; ++i) {
            FA_TS(s0);
            if (i + 1 < NT) FA_WAIT_BAR(4); else FA_WAIT_BAR(0);
            FA_TS(s1);
            if (i + 2 < NT) FA_DMA(t0 + i + 2, (i + 2) & 3);
            if (pm != 2) {
                const bool prev = (i - 1 >= iv0) && (i - 1 <= iv1), cur = (i >= iv0) && (i <= iv1);
                if (cur) FA_KLD(i);
                FA_SB();
                if (prev) { FA_PV(); FA_SB(); }
                if (cur) { FA_QK(i); FA_SB(); FA_TSV(s2, p0, p1); FA_VLDALL(i); FA_SB(); FA_SM(); FA_SB(); FA_TSV(s3, pa0, pa3); FA_TACC(); }
            }
        }
        FA_TOUT(0);
        if (NT - 1 <= iv1 && pm != 2) FA_PV();
    } else {
#pragma unroll 1
        for (int i = 0; i < NT; ++i) {
            FA_TS(s0);
            if (i + 1 < NT) FA_WAIT_BAR(4); else FA_WAIT_BAR(0);
            FA_TS(s1);
            if (i + 2 < NT) FA_DMA(t0 + i + 2, (i + 2) & 3);
            if (pm != 2) {
                const bool prev = (i - 1 >= iv0) && (i - 1 <= iv1), cur = (i >= iv0) && (i <= iv1);
                if (prev) { FA_VLDALL(i - 1); FA_SB(); FA_SM(); FA_SB(); FA_TSV(s2, pa0, pa3); }
                if (cur) { FA_KLD(i); FA_SB(); }
                if (prev) { FA_PV(); FA_SB(); }
                if (cur) { FA_QK(i); FA_SB(); FA_TSV(s3, p0, p1); if (prev) FA_TACC(); }
            }
        }
        FA_TOUT(8);
        if (NT - 1 <= iv1 && pm != 2) { FA_VLDALL(NT - 1); FA_SB(); FA_SM(); FA_SB(); FA_PV(); }
    }
#undef FA_VLDALL
#undef FA_MX3
#undef FA_TS
#undef FA_TSV
#undef FA_TACC
#undef FA_TOUT
#undef FA_KLD
#undef FA_SB
#undef FA_QK
#undef FA_SM
#undef FA_PV
    lsum = swapsum(lsum);
    if (hi == 0) wsf[32 + r32] = lsum;
    LDS_WAIT();
#pragma unroll
    for (int r = 0; r < 16; ++r) { const float il = fast_rcp(wsf[32 + crow(r, hi)]);
#pragma unroll
        for (int d = 0; d < NDB; ++d) o[d][r] *= il; }
    FA_BAR();
    if (MODE == 0) {
        LAS float* xf = (LAS float*)lds + (wid & 3) * 4096;
        if (ch == 1) {
#pragma unroll
            for (int d = 0; d < 4; ++d)
#pragma unroll
                for (int r = 0; r < 16; ++r) xf[(d * 16 + r) * 64 + lane] = o[d][r];
        }
        FA_BAR();
        if (ch == 0) {
            float ss[16];
#pragma unroll
            for (int r = 0; r < 16; ++r) ss[r] = 0.f;
#pragma unroll
            for (int d = 0; d < 4; ++d)
#pragma unroll
                for (int r = 0; r < 16; ++r) { const float y = o[d][r] - lam * xf[(d * 16 + r) * 64 + lane]; o[d][r] = y; ss[r] += y * y; }
            LAS bf16_t* stg = (LAS bf16_t*)(lds + 65536) + wid * 4096;
            float g[4];
#pragma unroll
            for (int d = 0; d < 4; ++d) g[d] = subln[32 * d + r32] * osc;
#pragma unroll
            for (int r = 0; r < 16; ++r) { const float rs = __builtin_amdgcn_rsqf(half_sum32(ss[r]) * (1.0f / 128.0f) + EPS); const int orow = crow(r, hi);
#pragma unroll
                for (int d = 0; d < 4; ++d) stg[orow * 128 + d * 32 + r32] = (bf16_t)f2bf(o[d][r] * rs * g[d]); }
            LDS_WAIT();
#pragma unroll
            for (int i = 0; i < 8; ++i) { const int idx = i * 64 + lane, row = idx >> 4, c8 = idx & 15;
                const u32x4 v = *(const LAS u32x4*)(stg + row * 128 + c8 * 8);
                *(u32x4*)(Yg + (qrow + row) * PITCH + hq * 128 + c8 * 8) = v; }
        }
    } else {
        LAS bf16_t* stg = (LAS bf16_t*)lds + wid * 2048;
#pragma unroll
        for (int r = 0; r < 16; ++r) { const int orow = crow(r, hi);
#pragma unroll
            for (int d = 0; d < 2; ++d) stg[orow * 64 + d * 32 + r32] = (bf16_t)f2bf(o[d][r]); }
        LDS_WAIT();
#pragma unroll
        for (int i = 0; i < 4; ++i) { const int idx = i * 64 + lane, row = idx >> 3, c8 = idx & 7;
            const u32x4 v = *(const LAS u32x4*)(stg + row * 64 + c8 * 8);
            *(u32x4*)(Yg + (qrow + row) * PITCH + hq * 128 + ch * 64 + c8 * 8) = v; }
    }
    FA_BAR();
#undef FA_DMA
}

constexpr int K3OFF = 0, V3OFF = 49152, NK3 = 3;
template <int MODE, bool NOMAX>
__device__ __forceinline__ void attn_unit3(LAS unsigned char* lds, const int tid_, const bf16_t* Qg, const bf16_t* Kg, const bf16_t* Vg, bf16_t* Yg, const int b, const int hq, const int u,
                                           const float lam, const float osc, const float* subln, const int pm = 0) {
    constexpr int PITCH = 512, NDB = (MODE == 0) ? 4 : 2;
    int tid = tid_; asm volatile("" : "+v"(tid));
#if PROBE_T
    const unsigned long long tu0_ = __builtin_amdgcn_s_memtime();
#endif
    const int lane = tid & 63, r32 = lane & 31, hi = lane >> 5, wid = __builtin_amdgcn_readfirstlane(tid >> 6), ch = wid >> 2, wq = wid & 3;
    const int cw = 2 * u + (wq >> 1);
    const int t0 = (MODE == 0) ? 0 : ((2 * u - 8) > 0 ? (2 * u - 8) : 0), t1 = 2 * u + 1, NT = t1 - t0 + 1;
    const int iv1 = cw - t0, iv0 = (MODE == 0) ? 0 : ((cw - 8 - t0) > 0 ? (cw - 8 - t0) : 0);
    const size_t rowbase = (size_t)b * SEQ;
    const bf16_t* Kb = Kg + rowbase * PITCH + hq * 128; const bf16_t* Vb = Vg + rowbase * PITCH + hq * 128;
    const unsigned lds0 = (unsigned)(uintptr_t)lds;
    LAS float* wsf = (LAS float*)(lds + LDS_WS2) + wid * 64;
    const bf16_t* kbase = Kb + (2 * wid) * 8;
    const bf16_t* vbase = Vb + (size_t)(16 * ((2 * wid) & 3)) * PITCH + 32 * ((2 * wid) >> 2);
    const unsigned kvo = (unsigned)lane * PITCH * 2u, vvo = (unsigned)((lane >> 2) * PITCH + (lane & 3) * 8) * 2u;
#define F3_DMAK(j) do { if ((j) < NT) { const size_t to_ = (size_t)(t0 + (j)) * 64 * PITCH; const unsigned sb_ = lds0 + K3OFF + (unsigned)((j) % NK3) * 16384u; \
        glds16s(kbase + to_, kvo, (unsigned)__builtin_amdgcn_readfirstlane(sb_ + (2 * wid) * 1024)); glds16s(kbase + to_ + 8, kvo, (unsigned)__builtin_amdgcn_readfirstlane(sb_ + (2 * wid + 1) * 1024)); } } while (0)
#define F3_DMAV(j) do { if ((j) < NT) { const size_t to_ = (size_t)(t0 + (j)) * 64 * PITCH; const unsigned sb_ = lds0 + V3OFF + (unsigned)((j) & 3) * 16384u; \
        glds16s(vbase + to_, vvo, (unsigned)__builtin_amdgcn_readfirstlane(sb_ + (2 * wid) * 1024)); glds16s(vbase + to_ + 16 * PITCH, vvo, (unsigned)__builtin_amdgcn_readfirstlane(sb_ + (2 * wid + 1) * 1024)); } } while (0)
    F3_DMAK(0); F3_DMAK(1); F3_DMAV(0); F3_DMAK(2); F3_DMAV(1);
    const size_t qrow = rowbase + (size_t)u * 128 + wq * 32;
    bf16x8 qr[4];
#pragma unroll
    for (int i = 0; i < 4; ++i) qr[i] = *(const bf16x8*)(Qg + (qrow + r32) * PITCH + hq * 128 + ch * 64 + i * 16 + hi * 8);
    f32x16 o[NDB];
#pragma unroll
    for (int d = 0; d < NDB; ++d)
#pragma unroll
        for (int r = 0; r < 16; ++r) o[d][r] = 0.f;
    float mref = -1e30f, lsum = 0.f;
    const lds_cptr kp0 = (lds_cptr)lds + K3OFF + ch * 8192 + hi * 1024 + r32 * 16;
    const lds_cptr vp0 = (lds_cptr)lds + V3OFF + ((MODE == 0) ? 0 : ch * 8192) + ((lane >> 4) & 1) * 32 + (lane & 3) * 8 + (4 * hi + ((lane & 15) >> 2)) * 64;
    const LAS float* btab = (const LAS float*)(lds + LDS_BIAS2) + ch * 640;
    f32x16 cA0, cA1, cB0, cB1; u32x4 pA[4], pB[4];
#pragma unroll
    for (int r = 0; r < 16; ++r) { cA0[r] = 0.f; cA1[r] = 0.f; cB0[r] = 0.f; cB1[r] = 0.f; }
#pragma unroll
    for (int k = 0; k < 4; ++k) { pA[k] = (u32x4){0u, 0u, 0u, 0u}; pB[k] = (u32x4){0u, 0u, 0u, 0u}; }
#define F3_SB() __builtin_amdgcn_sched_barrier(0)
#define F3_MX3(a, b, c) __builtin_fmaxf(__builtin_fmaxf((a), (b)), (c))
#define F3_QK(j, d0, d1) do { const lds_cptr kp = kp0 + ((j) % NK3) * 16384; \
        _Pragma("unroll") for (int k = 0; k < 4; ++k) { const bf16x8 ka = *(const LAS bf16x8*)(kp + k * 2048), kb = *(const LAS bf16x8*)(kp + k * 2048 + 512); \
            if (k == 0) { d0 = __builtin_amdgcn_mfma_f32_32x32x16_bf16(ka, qr[0], (f32x16){0.f, 0.f, 0.f, 0.f, 0.f, 0.f, 0.f, 0.f, 0.f, 0.f, 0.f, 0.f, 0.f, 0.f, 0.f, 0.f}, 0, 0, 0); d1 = __builtin_amdgcn_mfma_f32_32x32x16_bf16(kb, qr[0], (f32x16){0.f, 0.f, 0.f, 0.f, 0.f, 0.f, 0.f, 0.f, 0.f, 0.f, 0.f, 0.f, 0.f, 0.f, 0.f, 0.f}, 0, 0, 0); } \
            else { d0 = __builtin_amdgcn_mfma_f32_32x32x16_bf16(ka, qr[k], d0, 0, 0, 0); d1 = __builtin_amdgcn_mfma_f32_32x32x16_bf16(kb, qr[k], d1, 0, 0, 0); } } } while (0)
#define F3_BIAS(j, d0, d1) do { if (MODE == 1) { const int t = t0 + (j); const LAS float* bt = btab; const int relb = 64 * (cw - t) + 32 * (wq & 1) + r32 + 63; \
            if (cw - t >= 5) { const float c = bt[319]; _Pragma("unroll") for (int r = 0; r < 16; ++r) { d0[r] += c; d1[r] += c; } } \
            else { _Pragma("unroll") for (int r = 0; r < 16; ++r) { const int i0 = relb - crow(r, hi), i1 = i0 - 32; d0[r] += bt[i0 > 319 ? 319 : i0]; d1[r] += bt[i1 > 319 ? 319 : i1]; } } } } while (0)
#define F3_PV(j, P) do { const lds_cptr vt = vp0 + ((j) & 3) * 16384; \
        _Pragma("unroll") for (int d = 0; d < NDB; ++d) { const lds_cptr vd = vt + d * 4096; \
            o[d] = __builtin_amdgcn_mfma_f32_32x32x16_bf16(__builtin_bit_cast(bf16x8, P[0]), cat8(vtr(vd), vtr(vd + 512)), o[d], 0, 0, 0); o[d] = __builtin_amdgcn_mfma_f32_32x32x16_bf16(__builtin_bit_cast(bf16x8, P[1]), cat8(vtr(vd + 1024), vtr(vd + 1536)), o[d], 0, 0, 0); \
            o[d] = __builtin_amdgcn_mfma_f32_32x32x16_bf16(__builtin_bit_cast(bf16x8, P[2]), cat8(vtr(vd + 2048), vtr(vd + 2560)), o[d], 0, 0, 0); o[d] = __builtin_amdgcn_mfma_f32_32x32x16_bf16(__builtin_bit_cast(bf16x8, P[3]), cat8(vtr(vd + 3072), vtr(vd + 3584)), o[d], 0, 0, 0); } } while (0)
#define F3_SM(c0, c1, P) do { \
        if (NOMAX) { upd = false; } else { \
        float ma = F3_MX3(c0[0], c0[1], c1[0]), mb = F3_MX3(c0[2], c0[3], c1[1]), mc = F3_MX3(c0[4], c0[5], c1[2]), md = F3_MX3(c0[6], c0[7], c1[3]); \
        ma = F3_MX3(ma, c0[8], c0[9]); mb = F3_MX3(mb, c0[10], c0[11]); mc = F3_MX3(mc, c0[12], c0[13]); md = F3_MX3(md, c0[14], c0[15]); \
        ma = F3_MX3(ma, c1[4], c1[5]); mb = F3_MX3(mb, c1[6], c1[7]); mc = F3_MX3(mc, c1[8], c1[9]); md = F3_MX3(md, c1[10], c1[11]); \
        ma = F3_MX3(ma, c1[12], c1[13]); mb = F3_MX3(mb, c1[14], c1[15]); float rm = __builtin_fmaxf(__builtin_fmaxf(ma, mb), __builtin_fmaxf(mc, md)); rm = swapmax(rm); \
        upd = __any(rm - mref > THR); const float mnew = upd ? __builtin_fmaxf(mref, rm) : mref; fsc = fast_exp2(mref - mnew); mref = mnew; lsum *= fsc; } \
        float sa = 0.f, sb = 0.f, sc = 0.f, sd = 0.f; \
        _Pragma("unroll") for (int r = 0; r < 16; r += 4) { \
            if (NOMAX) { c0[r] = fast_exp2(c0[r]); c0[r + 1] = fast_exp2(c0[r + 1]); c0[r + 2] = fast_exp2(c0[r + 2]); c0[r + 3] = fast_exp2(c0[r + 3]); \
                         c1[r] = fast_exp2(c1[r]); c1[r + 1] = fast_exp2(c1[r + 1]); c1[r + 2] = fast_exp2(c1[r + 2]); c1[r + 3] = fast_exp2(c1[r + 3]); } \
            else { c0[r] = fast_exp2(c0[r] - mref); c0[r + 1] = fast_exp2(c0[r + 1] - mref); c0[r + 2] = fast_exp2(c0[r + 2] - mref); c0[r + 3] = fast_exp2(c0[r + 3] - mref); \
                   c1[r] = fast_exp2(c1[r] - mref); c1[r + 1] = fast_exp2(c1[r + 1] - mref); c1[r + 2] = fast_exp2(c1[r + 2] - mref); c1[r + 3] = fast_exp2(c1[r + 3] - mref); } \
            sa += c0[r] + c1[r]; sb += c0[r + 1] + c1[r + 1]; sc += c0[r + 2] + c1[r + 2]; sd += c0[r + 3] + c1[r + 3]; } \
        lsum += (sa + sb) + (sc + sd); \
        P[0] = __builtin_bit_cast(u32x4, pack_p(c0, 0)); P[1] = __builtin_bit_cast(u32x4, pack_p(c0, 8)); P[2] = __builtin_bit_cast(u32x4, pack_p(c1, 0)); P[3] = __builtin_bit_cast(u32x4, pack_p(c1, 8)); } while (0)
#define F3_RESC() do { if (!NOMAX && upd) { if (hi == 0) wsf[r32] = fsc; LDS_WAIT(); \
            _Pragma("unroll") for (int r = 0; r < 16; ++r) { const float fr = wsf[crow(r, hi)]; _Pragma("unroll") for (int d = 0; d < NDB; ++d) o[d][r] *= fr; } } } while (0)
#define F3_HEAD(i) do { if ((i) + 3 < NT) { asm volatile("s_waitcnt vmcnt(6) lgkmcnt(0)\n\ts_barrier" ::: "memory"); } else FA_WAIT_BAR(0); \
        F3_DMAK((i) + 3); F3_DMAV((i) + 2); F3_SB(); } while (0)
#if PROBE_T
    unsigned tq0 = 0, tq1 = 0, tqn = 0; unsigned long long ts0_ = 0, ts1_ = 0, ts2_ = 0;
#define F3_TS(v) do { F3_SB(); asm volatile("s_memtime %0\n\ts_waitcnt lgkmcnt(0)" : "=s"(v) :: "memory"); F3_SB(); } while (0)
#define F3_TSE(a, b) do { F3_SB(); asm volatile("s_nop 15\n\ts_nop 15" : "+v"(a), "+v"(b)); asm volatile("s_memtime %0\n\ts_waitcnt lgkmcnt(0)" : "=s"(ts2_) :: "memory"); F3_SB(); tq0 += (unsigned)(ts1_ - ts0_); tq1 += (unsigned)(ts2_ - ts1_); ++tqn; } while (0)
#else
#define F3_TS(v) do { } while (0)
#define F3_TSE(a, b) do { } while (0)
#endif
#define F3_HAND(i, C0, C1, N0, N1, PP, PW) do { \
        const lds_cptr vt_ = vp0 + (((i) - 1) & 3) * 16384; const lds_cptr kq_ = kp0 + (((i) + 1) % NK3) * 16384; \
        bf16x8 fq0, fq1, fq2, fq3, fq4; float sa_ = 0.f, sb_ = 0.f; \
        fq0 = cat8(vtr(vt_ + 0), vtr(vt_ + 512)); fq1 = cat8(vtr(vt_ + 1024), vtr(vt_ + 1536)); fq2 = cat8(vtr(vt_ + 2048), vtr(vt_ + 2560)); F3_SB(); \
        F3_TS(ts0_); if ((i) + 3 < NT) { asm volatile("s_waitcnt vmcnt(6) lgkmcnt(0)\n\ts_barrier" ::: "memory"); } else FA_WAIT_BAR(0); F3_TS(ts1_); \
        F3_DMAK((i) + 3); F3_DMAV((i) + 2); F3_SB(); \
        o[0] = __builtin_amdgcn_mfma_f32_32x32x16_bf16(__builtin_bit_cast(bf16x8, PP[0]), fq0, o[0], 0, 0, 0); fq3 = cat8(vtr(vt_ + 3072), vtr(vt_ + 3584)); C0[0] = fast_exp2(C0[0]); C0[1] = fast_exp2(C0[1]); asm volatile("" : "+v"(C0)); F3_SB(); \
        o[0] = __builtin_amdgcn_mfma_f32_32x32x16_bf16(__builtin_bit_cast(bf16x8, PP[1]), fq1, o[0], 0, 0, 0); fq0 = cat8(vtr(vt_ + 4096), vtr(vt_ + 4608)); C0[2] = fast_exp2(C0[2]); C0[3] = fast_exp2(C0[3]); asm volatile("" : "+v"(C0)); F3_SB(); \
        o[0] = __builtin_amdgcn_mfma_f32_32x32x16_bf16(__builtin_bit_cast(bf16x8, PP[2]), fq2, o[0], 0, 0, 0); fq1 = cat8(vtr(vt_ + 5120), vtr(vt_ + 5632)); C0[4] = fast_exp2(C0[4]); C0[5] = fast_exp2(C0[5]); asm volatile("" : "+v"(C0)); F3_SB(); \
        o[0] = __builtin_amdgcn_mfma_f32_32x32x16_bf16(__builtin_bit_cast(bf16x8, PP[3]), fq3, o[0], 0, 0, 0); fq2 = cat8(vtr(vt_ + 6144), vtr(vt_ + 6656)); C0[6] = fast_exp2(C0[6]); C0[7] = fast_exp2(C0[7]); asm volatile("" : "+v"(C0)); F3_SB(); \
        o[1] = __builtin_amdgcn_mfma_f32_32x32x16_bf16(__builtin_bit_cast(bf16x8, PP[0]), fq0, o[1], 0, 0, 0); fq3 = cat8(vtr(vt_ + 7168), vtr(vt_ + 7680)); C0[8] = fast_exp2(C0[8]); C0[9] = fast_exp2(C0[9]); asm volatile("" : "+v"(C0)); F3_SB(); \
        o[1] = __builtin_amdgcn_mfma_f32_32x32x16_bf16(__builtin_bit_cast(bf16x8, PP[1]), fq1, o[1], 0, 0, 0); fq0 = cat8(vtr(vt_ + 8192), vtr(vt_ + 8704)); C0[10] = fast_exp2(C0[10]); C0[11] = fast_exp2(C0[11]); asm volatile("" : "+v"(C0)); F3_SB(); \
        o[1] = __builtin_amdgcn_mfma_f32_32x32x16_bf16(__builtin_bit_cast(bf16x8, PP[2]), fq2, o[1], 0, 0, 0); fq1 = cat8(vtr(vt_ + 9216), vtr(vt_ + 9728)); C0[12] = fast_exp2(C0[12]); C0[13] = fast_exp2(C0[13]); asm volatile("" : "+v"(C0)); F3_SB(); \
        o[1] = __builtin_amdgcn_mfma_f32_32x32x16_bf16(__builtin_bit_cast(bf16x8, PP[3]), fq3, o[1], 0, 0, 0); fq2 = cat8(vtr(vt_ + 10240), vtr(vt_ + 10752)); C0[14] = fast_exp2(C0[14]); C0[15] = fast_exp2(C0[15]); asm volatile("" : "+v"(C0)); F3_SB(); \
        o[2] = __builtin_amdgcn_mfma_f32_32x32x16_bf16(__builtin_bit_cast(bf16x8, PP[0]), fq0, o[2], 0, 0, 0); fq3 = cat8(vtr(vt_ + 11264), vtr(vt_ + 11776)); C1[0] = fast_exp2(C1[0]); C1[1] = fast_exp2(C1[1]); sa_ += C0[0]; sb_ += C0[1]; asm volatile("" : "+v"(C1), "+v"(sa_), "+v"(sb_)); F3_SB(); \
        o[2] = __builtin_amdgcn_mfma_f32_32x32x16_bf16(__builtin_bit_cast(bf16x8, PP[1]), fq1, o[2], 0, 0, 0); fq0 = cat8(vtr(vt_ + 12288), vtr(vt_ + 12800)); C1[2] = fast_exp2(C1[2]); C1[3] = fast_exp2(C1[3]); sa_ += C0[2]; sb_ += C0[3]; asm volatile("" : "+v"(C1), "+v"(sa_), "+v"(sb_)); F3_SB(); \
        o[2] = __builtin_amdgcn_mfma_f32_32x32x16_bf16(__builtin_bit_cast(bf16x8, PP[2]), fq2, o[2], 0, 0, 0); fq1 = cat8(vtr(vt_ + 13312), vtr(vt_ + 13824)); C1[4] = fast_exp2(C1[4]); C1[5] = fast_exp2(C1[5]); sa_ += C0[4]; sb_ += C0[5]; asm volatile("" : "+v"(C1), "+v"(sa_), "+v"(sb_)); F3_SB(); \
        o[2] = __builtin_amdgcn_mfma_f32_32x32x16_bf16(__builtin_bit_cast(bf16x8, PP[3]), fq3, o[2], 0, 0, 0); fq2 = cat8(vtr(vt_ + 14336), vtr(vt_ + 14848)); C1[6] = fast_exp2(C1[6]); C1[7] = fast_exp2(C1[7]); sa_ += C0[6]; sb_ += C0[7]; asm volatile("" : "+v"(C1), "+v"(sa_), "+v"(sb_)); F3_SB(); \
        o[3] = __builtin_amdgcn_mfma_f32_32x32x16_bf16(__builtin_bit_cast(bf16x8, PP[0]), fq0, o[3], 0, 0, 0); fq3 = cat8(vtr(vt_ + 15360), vtr(vt_ + 15872)); C1[8] = fast_exp2(C1[8]); C1[9] = fast_exp2(C1[9]); sa_ += C0[8]; sb_ += C0[9]; asm volatile("" : "+v"(C1), "+v"(sa_), "+v"(sb_)); F3_SB(); \
        o[3] = __builtin_amdgcn_mfma_f32_32x32x16_bf16(__builtin_bit_cast(bf16x8, PP[1]), fq1, o[3], 0, 0, 0); fq0 = *(const LAS bf16x8*)(kq_ + 0); C1[10] = fast_exp2(C1[10]); C1[11] = fast_exp2(C1[11]); sa_ += C0[10]; sb_ += C0[11]; asm volatile("" : "+v"(C1), "+v"(sa_), "+v"(sb_)); F3_SB(); \
        o[3] = __builtin_amdgcn_mfma_f32_32x32x16_bf16(__builtin_bit_cast(bf16x8, PP[2]), fq2, o[3], 0, 0, 0); fq1 = *(const LAS bf16x8*)(kq_ + 512); C1[12] = fast_exp2(C1[12]); C1[13] = fast_exp2(C1[13]); sa_ += C0[12]; sb_ += C0[13]; asm volatile("" : "+v"(C1), "+v"(sa_), "+v"(sb_)); F3_SB(); \
        o[3] = __builtin_amdgcn_mfma_f32_32x32x16_bf16(__builtin_bit_cast(bf16x8, PP[3]), fq3, o[3], 0, 0, 0); fq2 = *(const LAS bf16x8*)(kq_ + 2048); C1[14] = fast_exp2(C1[14]); C1[15] = fast_exp2(C1[15]); sa_ += C0[14]; sb_ += C0[15]; asm volatile("" : "+v"(C1), "+v"(sa_), "+v"(sb_)); F3_SB(); \
        N0 = __builtin_amdgcn_mfma_f32_32x32x16_bf16(fq0, qr[0], (f32x16){0.f,0.f,0.f,0.f,0.f,0.f,0.f,0.f,0.f,0.f,0.f,0.f,0.f,0.f,0.f,0.f}, 0, 0, 0); fq3 = *(const LAS bf16x8*)(kq_ + 2560); sa_ += C1[0]; sb_ += C1[1]; PW[0][0] = cvt_pk_bf16(C0[0], C0[1]); PW[0][1] = cvt_pk_bf16(C0[2], C0[3]); asm volatile("" : "+v"(sa_), "+v"(sb_), "+v"(PW[0])); F3_SB(); \
        N1 = __builtin_amdgcn_mfma_f32_32x32x16_bf16(fq1, qr[0], (f32x16){0.f,0.f,0.f,0.f,0.f,0.f,0.f,0.f,0.f,0.f,0.f,0.f,0.f,0.f,0.f,0.f}, 0, 0, 0); fq0 = *(const LAS bf16x8*)(kq_ + 4096); sa_ += C1[2]; sb_ += C1[3]; PW[0][2] = cvt_pk_bf16(C0[4], C0[5]); PW[0][3] = cvt_pk_bf16(C0[6], C0[7]); asm volatile("" : "+v"(sa_), "+v"(sb_), "+v"(PW[0])); F3_SB(); \
        N0 = __builtin_amdgcn_mfma_f32_32x32x16_bf16(fq2, qr[1], N0, 0, 0, 0); fq1 = *(const LAS bf16x8*)(kq_ + 4608); sa_ += C1[4]; sb_ += C1[5]; PW[1][0] = cvt_pk_bf16(C0[8], C0[9]); PW[1][1] = cvt_pk_bf16(C0[10], C0[11]); asm volatile("" : "+v"(sa_), "+v"(sb_), "+v"(PW[1])); F3_SB(); \
        N1 = __builtin_amdgcn_mfma_f32_32x32x16_bf16(fq3, qr[1], N1, 0, 0, 0); fq2 = *(const LAS bf16x8*)(kq_ + 6144); sa_ += C1[6]; sb_ += C1[7]; PW[1][2] = cvt_pk_bf16(C0[12], C0[13]); PW[1][3] = cvt_pk_bf16(C0[14], C0[15]); asm volatile("" : "+v"(sa_), "+v"(sb_), "+v"(PW[1])); F3_SB(); \
        N0 = __builtin_amdgcn_mfma_f32_32x32x16_bf16(fq0, qr[2], N0, 0, 0, 0); fq3 = *(const LAS bf16x8*)(kq_ + 6656); sa_ += C1[8]; sb_ += C1[9]; PW[2][0] = cvt_pk_bf16(C1[0], C1[1]); PW[2][1] = cvt_pk_bf16(C1[2], C1[3]); asm volatile("" : "+v"(sa_), "+v"(sb_), "+v"(PW[2])); F3_SB(); \
        N1 = __builtin_amdgcn_mfma_f32_32x32x16_bf16(fq1, qr[2], N1, 0, 0, 0); sa_ += C1[10]; sb_ += C1[11]; PW[2][2] = cvt_pk_bf16(C1[4], C1[5]); PW[2][3] = cvt_pk_bf16(C1[6], C1[7]); asm volatile("" : "+v"(sa_), "+v"(sb_), "+v"(PW[2])); F3_SB(); \
        N0 = __builtin_amdgcn_mfma_f32_32x32x16_bf16(fq2, qr[3], N0, 0, 0, 0); sa_ += C1[12]; sb_ += C1[13]; PW[3][0] = cvt_pk_bf16(C1[8], C1[9]); PW[3][1] = cvt_pk_bf16(C1[10], C1[11]); asm volatile("" : "+v"(sa_), "+v"(sb_), "+v"(PW[3])); F3_SB(); \
        N1 = __builtin_amdgcn_mfma_f32_32x32x16_bf16(fq3, qr[3], N1, 0, 0, 0); sa_ += C1[14]; sb_ += C1[15]; PW[3][2] = cvt_pk_bf16(C1[12], C1[13]); PW[3][3] = cvt_pk_bf16(C1[14], C1[15]); asm volatile("" : "+v"(sa_), "+v"(sb_), "+v"(PW[3])); F3_SB(); \
        lsum += sa_ + sb_; F3_TSE(N0, N1); } while (0)
#define F3_HANDB(i, C0, C1, N0, N1, PP, PW) do { \
        const lds_cptr vt_ = vp0 + (((i) - 1) & 3) * 16384; const lds_cptr kq_ = kp0 + (((i) + 1) % NK3) * 16384; \
        const LAS float* bb_ = btab + (64 * (cw - (t0 + (i))) + 32 * (wq & 1) + r32 + 63 - 4 * hi - 59);     \
        bf16x8 fq0, fq1, fq2, fq3; float sa_ = 0.f, sb_ = 0.f, b0_, b1_, b2_, b3_; \
        fq0 = cat8(vtr(vt_ + 0), vtr(vt_ + 512)); fq1 = cat8(vtr(vt_ + 1024), vtr(vt_ + 1536)); fq2 = cat8(vtr(vt_ + 2048), vtr(vt_ + 2560)); b0_ = bb_[59]; b1_ = bb_[58]; b2_ = bb_[57]; b3_ = bb_[56]; F3_SB(); \
        if ((i) + 3 < NT) { asm volatile("s_waitcnt vmcnt(6) lgkmcnt(0)\n\ts_barrier" ::: "memory"); } else FA_WAIT_BAR(0); \
        F3_DMAK((i) + 3); F3_DMAV((i) + 2); F3_SB(); \
        o[0] = __builtin_amdgcn_mfma_f32_32x32x16_bf16(__builtin_bit_cast(bf16x8, PP[0]), fq0, o[0], 0, 0, 0); fq3 = cat8(vtr(vt_ + 3072), vtr(vt_ + 3584)); C0[0] = fast_exp2(C0[0] + b0_); C0[1] = fast_exp2(C0[1] + b1_); b0_ = bb_[51]; b1_ = bb_[50]; asm volatile("" : "+v"(C0)); F3_SB(); \
        o[0] = __builtin_amdgcn_mfma_f32_32x32x16_bf16(__builtin_bit_cast(bf16x8, PP[1]), fq1, o[0], 0, 0, 0); fq0 = cat8(vtr(vt_ + 4096), vtr(vt_ + 4608)); C0[2] = fast_exp2(C0[2] + b2_); C0[3] = fast_exp2(C0[3] + b3_); b2_ = bb_[49]; b3_ = bb_[48]; asm volatile("" : "+v"(C0)); F3_SB(); \
        o[0] = __builtin_amdgcn_mfma_f32_32x32x16_bf16(__builtin_bit_cast(bf16x8, PP[2]), fq2, o[0], 0, 0, 0); fq1 = cat8(vtr(vt_ + 5120), vtr(vt_ + 5632)); C0[4] = fast_exp2(C0[4] + b0_); C0[5] = fast_exp2(C0[5] + b1_); b0_ = bb_[43]; b1_ = bb_[42]; asm volatile("" : "+v"(C0)); F3_SB(); \
        o[0] = __builtin_amdgcn_mfma_f32_32x32x16_bf16(__builtin_bit_cast(bf16x8, PP[3]), fq3, o[0], 0, 0, 0); fq2 = cat8(vtr(vt_ + 6144), vtr(vt_ + 6656)); C0[6] = fast_exp2(C0[6] + b2_); C0[7] = fast_exp2(C0[7] + b3_); b2_ = bb_[41]; b3_ = bb_[40]; asm volatile("" : "+v"(C0)); F3_SB(); \
        o[1] = __builtin_amdgcn_mfma_f32_32x32x16_bf16(__builtin_bit_cast(bf16x8, PP[0]), fq0, o[1], 0, 0, 0); fq3 = cat8(vtr(vt_ + 7168), vtr(vt_ + 7680)); C0[8] = fast_exp2(C0[8] + b0_); C0[9] = fast_exp2(C0[9] + b1_); b0_ = bb_[35]; b1_ = bb_[34]; sa_ += C0[0]; sb_ += C0[1]; asm volatile("" : "+v"(C0), "+v"(sa_), "+v"(sb_)); F3_SB(); \
        o[1] = __builtin_amdgcn_mfma_f32_32x32x16_bf16(__builtin_bit_cast(bf16x8, PP[1]), fq1, o[1], 0, 0, 0); fq0 = *(const LAS bf16x8*)(kq_ + 0); C0[10] = fast_exp2(C0[10] + b2_); C0[11] = fast_exp2(C0[11] + b3_); b2_ = bb_[33]; b3_ = bb_[32]; sa_ += C0[2]; sb_ += C0[3]; sa_ += C0[4]; asm volatile("" : "+v"(C0), "+v"(sa_), "+v"(sb_)); F3_SB(); \
        o[1] = __builtin_amdgcn_mfma_f32_32x32x16_bf16(__builtin_bit_cast(bf16x8, PP[2]), fq2, o[1], 0, 0, 0); fq1 = *(const LAS bf16x8*)(kq_ + 512); C0[12] = fast_exp2(C0[12] + b0_); C0[13] = fast_exp2(C0[13] + b1_); b0_ = bb_[27]; b1_ = bb_[26]; sb_ += C0[5]; sa_ += C0[6]; sb_ += C0[7]; asm volatile("" : "+v"(C0), "+v"(sa_), "+v"(sb_)); F3_SB(); \
        o[1] = __builtin_amdgcn_mfma_f32_32x32x16_bf16(__builtin_bit_cast(bf16x8, PP[3]), fq3, o[1], 0, 0, 0); fq2 = *(const LAS bf16x8*)(kq_ + 2048); C0[14] = fast_exp2(C0[14] + b2_); C0[15] = fast_exp2(C0[15] + b3_); b2_ = bb_[25]; b3_ = bb_[24]; sa_ += C0[8]; sb_ += C0[9]; asm volatile("" : "+v"(C0), "+v"(sa_), "+v"(sb_)); F3_SB(); \
        N0 = __builtin_amdgcn_mfma_f32_32x32x16_bf16(fq0, qr[0], (f32x16){0.f,0.f,0.f,0.f,0.f,0.f,0.f,0.f,0.f,0.f,0.f,0.f,0.f,0.f,0.f,0.f}, 0, 0, 0); fq3 = *(const LAS bf16x8*)(kq_ + 2560); C1[0] = fast_exp2(C1[0] + b0_); C1[1] = fast_exp2(C1[1] + b1_); b0_ = bb_[19]; b1_ = bb_[18]; sa_ += C0[10]; sb_ += C0[11]; sa_ += C0[12]; PW[0][0] = cvt_pk_bf16(C0[0], C0[1]); PW[0][1] = cvt_pk_bf16(C0[2], C0[3]); asm volatile("" : "+v"(C1), "+v"(sa_), "+v"(sb_), "+v"(PW[0])); F3_SB(); \
        N1 = __builtin_amdgcn_mfma_f32_32x32x16_bf16(fq1, qr[0], (f32x16){0.f,0.f,0.f,0.f,0.f,0.f,0.f,0.f,0.f,0.f,0.f,0.f,0.f,0.f,0.f,0.f}, 0, 0, 0); fq0 = *(const LAS bf16x8*)(kq_ + 4096); C1[2] = fast_exp2(C1[2] + b2_); C1[3] = fast_exp2(C1[3] + b3_); b2_ = bb_[17]; b3_ = bb_[16]; sb_ += C0[13]; sa_ += C0[14]; sb_ += C0[15]; PW[0][2] = cvt_pk_bf16(C0[4], C0[5]); PW[0][3] = cvt_pk_bf16(C0[6], C0[7]); asm volatile("" : "+v"(C1), "+v"(sa_), "+v"(sb_), "+v"(PW[0])); F3_SB(); \
        N0 = __builtin_amdgcn_mfma_f32_32x32x16_bf16(fq2, qr[1], N0, 0, 0, 0); fq1 = *(const LAS bf16x8*)(kq_ + 4608); C1[4] = fast_exp2(C1[4] + b0_); C1[5] = fast_exp2(C1[5] + b1_); b0_ = bb_[11]; b1_ = bb_[10]; sa_ += C1[0]; sb_ += C1[1]; PW[1][0] = cvt_pk_bf16(C0[8], C0[9]); PW[1][1] = cvt_pk_bf16(C0[10], C0[11]); asm volatile("" : "+v"(C1), "+v"(sa_), "+v"(sb_), "+v"(PW[1])); F3_SB(); \
        N1 = __builtin_amdgcn_mfma_f32_32x32x16_bf16(fq3, qr[1], N1, 0, 0, 0); fq2 = *(const LAS bf16x8*)(kq_ + 6144); C1[6] = fast_exp2(C1[6] + b2_); C1[7] = fast_exp2(C1[7] + b3_); b2_ = bb_[9]; b3_ = bb_[8]; sa_ += C1[2]; sb_ += C1[3]; sa_ += C1[4]; PW[1][2] = cvt_pk_bf16(C0[12], C0[13]); PW[1][3] = cvt_pk_bf16(C0[14], C0[15]); asm volatile("" : "+v"(C1), "+v"(sa_), "+v"(sb_), "+v"(PW[1])); F3_SB(); \
        N0 = __builtin_amdgcn_mfma_f32_32x32x16_bf16(fq0, qr[2], N0, 0, 0, 0); fq3 = *(const LAS bf16x8*)(kq_ + 6656); C1[8] = fast_exp2(C1[8] + b0_); C1[9] = fast_exp2(C1[9] + b1_); b0_ = bb_[3]; b1_ = bb_[2]; sb_ += C1[5]; sa_ += C1[6]; sb_ += C1[7]; PW[2][0] = cvt_pk_bf16(C1[0], C1[1]); PW[2][1] = cvt_pk_bf16(C1[2], C1[3]); asm volatile("" : "+v"(C1), "+v"(sa_), "+v"(sb_), "+v"(PW[2])); F3_SB(); \
        N1 = __builtin_amdgcn_mfma_f32_32x32x16_bf16(fq1, qr[2], N1, 0, 0, 0); C1[10] = fast_exp2(C1[10] + b2_); C1[11] = fast_exp2(C1[11] + b3_); b2_ = bb_[1]; b3_ = bb_[0]; sa_ += C1[8]; sb_ += C1[9]; PW[2][2] = cvt_pk_bf16(C1[4], C1[5]); PW[2][3] = cvt_pk_bf16(C1[6], C1[7]); asm volatile("" : "+v"(C1), "+v"(sa_), "+v"(sb_), "+v"(PW[2])); F3_SB(); \
        N0 = __builtin_amdgcn_mfma_f32_32x32x16_bf16(fq2, qr[3], N0, 0, 0, 0); C1[12] = fast_exp2(C1[12] + b0_); C1[13] = fast_exp2(C1[13] + b1_); sa_ += C1[10]; sb_ += C1[11]; sa_ += C1[12]; PW[3][0] = cvt_pk_bf16(C1[8], C1[9]); PW[3][1] = cvt_pk_bf16(C1[10], C1[11]); asm volatile("" : "+v"(C1), "+v"(sa_), "+v"(sb_), "+v"(PW[3])); F3_SB(); \
        N1 = __builtin_amdgcn_mfma_f32_32x32x16_bf16(fq3, qr[3], N1, 0, 0, 0); C1[14] = fast_exp2(C1[14] + b2_); C1[15] = fast_exp2(C1[15] + b3_); sb_ += C1[13]; sa_ += C1[14]; sb_ += C1[15]; PW[3][2] = cvt_pk_bf16(C1[12], C1[13]); PW[3][3] = cvt_pk_bf16(C1[14], C1[15]); asm volatile("" : "+v"(C1), "+v"(sa_), "+v"(sb_), "+v"(PW[3])); F3_SB(); \
        lsum += sa_ + sb_; } while (0)
#define F3_SLOW(i, C0, C1, N0, N1, PP, PW) do { F3_HEAD(i); \
        const bool vc = ((i) >= iv0) && ((i) <= iv1), vp = ((i) - 1 >= iv0) && ((i) - 1 <= iv1), vn = ((i) + 1 >= iv0) && ((i) + 1 <= iv1) && ((i) + 1 < NT); \
        if (vp) F3_PV((i) - 1, PP); \
        F3_SB(); \
        if (vn) { F3_QK((i) + 1, N0, N1); } \
        F3_SB(); \
        if (vc) { F3_BIAS((i), C0, C1); F3_SM(C0, C1, PW); } else { upd = false; }     \
        F3_SB(); F3_RESC(); } while (0)
    bool upd = false; float fsc = 1.f;
    asm volatile("s_waitcnt vmcnt(8) lgkmcnt(0)\n\ts_barrier" ::: "memory");
    if (iv0 == 0) { F3_QK(0, cA0, cA1); }
    F3_SB();
    if (MODE == 0) {
        F3_SLOW(0, cA0, cA1, cB0, cB1, pB, pA);
        if (NOMAX && FA_HAND) {
#pragma unroll 1
            for (int i = 1; i + 3 < NT; i += 2) { F3_HAND(i, cB0, cB1, cA0, cA1, pA, pB); F3_HAND(i + 1, cA0, cA1, cB0, cB1, pB, pA); }
            if (NT >= 4) { F3_HAND(NT - 3, cB0, cB1, cA0, cA1, pA, pB); }
        } else {
#pragma unroll 1
            for (int i = 1; i + 3 < NT; i += 2) { F3_SLOW(i, cB0, cB1, cA0, cA1, pA, pB); F3_SLOW(i + 1, cA0, cA1, cB0, cB1, pB, pA); }
            if (NT >= 4) { F3_SLOW(NT - 3, cB0, cB1, cA0, cA1, pA, pB); }
        }
        if (NT >= 4) { F3_SLOW(NT - 2, cA0, cA1, cB0, cB1, pB, pA); }
        F3_SLOW(NT - 1, cB0, cB1, cA0, cA1, pA, pB);
    } else {
        F3_SLOW(0, cA0, cA1, cB0, cB1, pB, pA); F3_SLOW(1, cB0, cB1, cA0, cA1, pA, pB);
        if (NOMAX && FA_HANDB) {
#pragma unroll 1
            for (int i = 2; i + 3 < NT; i += 2) { F3_HANDB(i, cA0, cA1, cB0, cB1, pB, pA); F3_HANDB(i + 1, cB0, cB1, cA0, cA1, pA, pB); }
        } else {
#pragma unroll 1
            for (int i = 2; i + 3 < NT; i += 2) { F3_SLOW(i, cA0, cA1, cB0, cB1, pB, pA); F3_SLOW(i + 1, cB0, cB1, cA0, cA1, pA, pB); }
        }
        if (NT >= 4) { F3_SLOW(NT - 2, cA0, cA1, cB0, cB1, pB, pA); F3_SLOW(NT - 1, cB0, cB1, cA0, cA1, pA, pB); }
    }
#if PROBE_T
    if (MODE == 0 && blockIdx.x == 0 && (wid & 3) == 0 && u >= 32 && lane == 0 && tqn) { unsigned long long* pv = (unsigned long long*)((char*)Yg - WS_AQ + WS_PROBE) + (ch ? 8 : 0); pv[0] = tq0 / tqn; pv[1] = tq1 / tqn; pv[2] = tqn; }
#endif
    if (NT - 1 <= iv1) F3_PV(NT - 1, pB);
#undef F3_TS
#undef F3_TSE
#undef F3_HEAD
#undef F3_SLOW
#undef F3_HAND
#undef F3_HANDB
#undef F3_DMAK
#undef F3_DMAV
#undef F3_SB
#undef F3_MX3
#undef F3_QK
#undef F3_BIAS
#undef F3_PV
#undef F3_SM
#undef F3_RESC
    lsum = swapsum(lsum);
    if (hi == 0) wsf[32 + r32] = lsum;
    LDS_WAIT();
#pragma unroll
    for (int r = 0; r < 16; ++r) { const float il = fast_rcp(wsf[32 + crow(r, hi)]);
#pragma unroll
        for (int d = 0; d < NDB; ++d) o[d][r] *= il; }
    FA_BAR();
    if (MODE == 0) {
        LAS float* xf = (LAS float*)lds + (wid & 3) * 4096;
        if (ch == 1) {
#pragma unroll
            for (int d = 0; d < 4; ++d)
#pragma unroll
                for (int r = 0; r < 16; ++r) xf[(d * 16 + r) * 64 + lane] = o[d][r];
        }
        FA_BAR();
        if (ch == 0) {
            float ss[16];
#pragma unroll
            for (int r = 0; r < 16; ++r) ss[r] = 0.f;
#pragma unroll
            for (int d = 0; d < 4; ++d)
#pragma unroll
                for (int r = 0; r < 16; ++r) { const float y = o[d][r] - lam * xf[(d * 16 + r) * 64 + lane]; o[d][r] = y; ss[r] += y * y; }
            LAS bf16_t* stg = (LAS bf16_t*)(lds + 65536) + wid * 4096;
            float g[4];
#pragma unroll
            for (int d = 0; d < 4; ++d) g[d] = subln[32 * d + r32] * osc;
#pragma unroll
            for (int r = 0; r < 16; ++r) { const float rs = __builtin_amdgcn_rsqf(half_sum32(ss[r]) * (1.0f / 128.0f) + EPS); const int orow = crow(r, hi);
#pragma unroll
                for (int d = 0; d < 4; ++d) stg[orow * 128 + d * 32 + r32] = (bf16_t)f2bf(o[d][r] * rs * g[d]); }
            LDS_WAIT();
#pragma unroll
            for (int i = 0; i < 8; ++i) { const int idx = i * 64 + lane, row = idx >> 4, c8 = idx & 15;
                const u32x4 v = *(const LAS u32x4*)(stg + row * 128 + c8 * 8);
                *(u32x4*)(Yg + (qrow + row) * PITCH + hq * 128 + c8 * 8) = v; }
        }
    } else {
        LAS bf16_t* stg = (LAS bf16_t*)lds + wid * 2048;
#pragma unroll
        for (int r = 0; r < 16; ++r) { const int orow = crow(r, hi);
#pragma unroll
            for (int d = 0; d < 2; ++d) stg[orow * 64 + d * 32 + r32] = (bf16_t)f2bf(o[d][r]); }
        LDS_WAIT();
#pragma unroll
        for (int i = 0; i < 4; ++i) { const int idx = i * 64 + lane, row = idx >> 3, c8 = idx & 7;
            const u32x4 v = *(const LAS u32x4*)(stg + row * 64 + c8 * 8);
            *(u32x4*)(Yg + (qrow + row) * PITCH + hq * 128 + ch * 64 + c8 * 8) = v; }
    }
    FA_BAR();
#if PROBE_T
    if (MODE == 0 && blockIdx.x == 0 && wid == 0 && u >= 32 && lane == 0) { unsigned long long* pv = (unsigned long long*)((char*)Yg - WS_AQ + WS_PROBE); pv[3] = (__builtin_amdgcn_s_memtime() - tu0_) / 10; }
#endif
}

#if FA_V2 == 3
#define FA_UNIT attn_unit2
#elif FA_V2
#define FA_UNIT attn_unit2
#else
#define FA_UNIT attn_unit
#endif
__device__ __forceinline__ void attn_a_phase(LAS unsigned char* lds, const int tid, unsigned char* ws, bf16_t* yout, const int vcu, const int G, const float* lq1, const float* lk1, const float* lq2, const float* lk2,
                                             const float* subln, const float lam_init, const float* gq, const float* gk, const int pm = 0) {
    const int lane = tid & 63;
    const float lamv = expf(wave_sum(lq1[lane] * lk1[lane])) - expf(wave_sum(lq2[lane] * lk2[lane])) + lam_init;
    const float lam = __uint_as_float(__builtin_amdgcn_readfirstlane(__float_as_uint(lamv)));
    const float bound = wave_max(fabsf(gq[lane])) * wave_max(fabsf(gk[lane])) * 64.0f * C2;
    const bool nomax = __uint_as_float(__builtin_amdgcn_readfirstlane(__float_as_uint(bound))) < FA_NOMAX_BOUND_A;
    for (int v = vcu; v < 256; v += G) {
        const int bh = v >> 5, p = v & 31;
#pragma unroll 1
        for (int k = 0; k < 2; ++k) {
#if FA_V2 == 3
            if (nomax) attn_unit3<0, true>(lds, tid, (const bf16_t*)(ws + WS_AQ), (const bf16_t*)(ws + WS_AK), (const bf16_t*)(ws + WS_AV), yout, bh >> 2, bh & 3, k ? 63 - p : p, lam, 1.0f - lam_init, subln, pm);
            else       attn_unit3<0, false>(lds, tid, (const bf16_t*)(ws + WS_AQ), (const bf16_t*)(ws + WS_AK), (const bf16_t*)(ws + WS_AV), yout, bh >> 2, bh & 3, k ? 63 - p : p, lam, 1.0f - lam_init, subln, pm);
#else
            FA_UNIT<0>(lds, tid, (const bf16_t*)(ws + WS_AQ), (const bf16_t*)(ws + WS_AK), (const bf16_t*)(ws + WS_AV), yout, bh >> 2, bh & 3, k ? 63 - p : p, lam, 1.0f - lam_init, subln, pm);
#endif
        }
    }
}
__device__ __forceinline__ void attn_b_phase(LAS unsigned char* lds, const int tid, unsigned char* ws, bf16_t* yout, const int vcu, const int G, const float* relb, const float* gq, const float* gk) {
    for (int v = vcu; v < 256; v += G) {
        const int bp = v >> 5, b = bp >> 2, hp = bp & 3;
        LAS float* bt = (LAS float*)(lds + (FA_V2 ? LDS_BIAS2 : LDS_BIAS));
        for (int i = tid; i < 1280; i += 512) { const int c = i / 640, j = i - c * 640; bt[i] = relb[(2 * hp + c) * 320 + (j < 320 ? j : 319)] * LOG2E; }
        FA_BAR();
        float bm = 0.f;
        for (int i = tid & 63; i < 1280; i += 64) bm = fmaxf(bm, fabsf(bt[i]));
        const float bound = wave_max(fabsf(gq[tid & 63])) * wave_max(fabsf(gk[tid & 63])) * 64.0f * C2 + wave_max(bm);
        const bool nomax = __uint_as_float(__builtin_amdgcn_readfirstlane(__float_as_uint(bound))) < FA_NOMAX_BOUND_B;
#pragma unroll 1
        for (int k = 0; k < 2; ++k) {
#if FA_V2 == 3
            if (nomax) attn_unit3<1, true>(lds, tid, (const bf16_t*)(ws + WS_BQ), (const bf16_t*)(ws + WS_BK), (const bf16_t*)(ws + WS_BV), yout, b, hp, 2 * (v & 31) + k, 0.f, 0.f, nullptr);
            else       attn_unit3<1, false>(lds, tid, (const bf16_t*)(ws + WS_BQ), (const bf16_t*)(ws + WS_BK), (const bf16_t*)(ws + WS_BV), yout, b, hp, 2 * (v & 31) + k, 0.f, 0.f, nullptr);
#else
            FA_UNIT<1>(lds, tid, (const bf16_t*)(ws + WS_BQ), (const bf16_t*)(ws + WS_BK), (const bf16_t*)(ws + WS_BV), yout, b, hp, 2 * (v & 31) + k, 0.f, 0.f, nullptr);
#endif
        }
    }
}

__device__ __forceinline__ void ret_kv_phase(LAS unsigned char* lds, const int tid_, unsigned char* ws, const int gw, const int ngw) {
    int tid = tid_; asm volatile("" : "+v"(tid));
    const int lane = tid & 63, r32 = lane & 31, hi = lane >> 5, wid = __builtin_amdgcn_readfirstlane(tid >> 6);
    const bf16_t* CK = (const bf16_t*)(ws + WS_CK); const bf16_t* CV = (const bf16_t*)(ws + WS_CV); float* KVT = (float*)(ws + WS_R4);
    LAS unsigned char* wl = lds + wid * 16384; const unsigned wl0 = (unsigned)(uintptr_t)wl;
    const lds_cptr tp0 = (lds_cptr)wl + ((lane >> 4) & 1) * 32 + (lane & 3) * 8 + (4 * hi + ((lane & 15) >> 2)) * 64;
    for (int task = gw; task < 2048; task += ngw) {
        const int eh = task & 1, n = (task >> 1) & 127, bh = task >> 8, b = bh >> 2, h = bh & 3;
        const size_t row0 = (size_t)b * SEQ + n * 64;
#pragma unroll
        for (int p = 0; p < 8; ++p) {
            glds16(CK + (row0 + 16 * (p & 3) + (lane >> 2)) * 256 + h * 64 + 32 * (p >> 2) + (lane & 3) * 8, (unsigned)__builtin_amdgcn_readfirstlane(wl0 + p * 1024));
            glds16(CV + (row0 + 16 * (p & 3) + (lane >> 2)) * 512 + h * 128 + eh * 64 + 32 * (p >> 2) + (lane & 3) * 8, (unsigned)__builtin_amdgcn_readfirstlane(wl0 + 8192 + p * 1024));
        }
        asm volatile("s_waitcnt vmcnt(0)" ::: "memory");
#pragma unroll
        for (int eb = 0; eb < 2; ++eb)
#pragma unroll
            for (int db = 0; db < 2; ++db) {
                f32x16 acc;
#pragma unroll
                for (int r = 0; r < 16; ++r) acc[r] = 0.f;
#pragma unroll
                for (int s = 0; s < 4; ++s) {
                    const lds_cptr va = tp0 + 8192 + (eb * 4 + s) * 1024, ka = tp0 + (db * 4 + s) * 1024;
                    acc = __builtin_amdgcn_mfma_f32_32x32x16_bf16(cat8(vtr(va), vtr(va + 512)), cat8(vtr(ka), vtr(ka + 512)), acc, 0, 0, 0);
                }
                float* dst = KVT + ((size_t)(bh * 128 + n) * 128 + eh * 64 + eb * 32) * 64 + db * 32 + r32;
#pragma unroll
                for (int r = 0; r < 16; ++r) dst[(size_t)crow(r, hi) * 64] = acc[r];
            }
        LDS_WAIT(); asm volatile("" ::: "memory");
    }
}
__device__ __forceinline__ void ret_scan_phase(const int tid, unsigned char* ws, const int vcu, const int G) {
    float* KVT = (float*)(ws + WS_R4);
    for (int gt = vcu * 512 + tid; gt < 65536; gt += G * 512) {
        const int bh = gt >> 13, idx = gt & 8191, h = bh & 3;
        const float l2g = log2_gamma(h), gam = fast_exp2(l2g), g63 = fast_exp2(63.f * l2g), g64 = fast_exp2(64.f * l2g);
        float* p = KVT + (size_t)bh * 128 * 8192 + idx; float s = 0.f;
        for (int n0 = 0; n0 < 128; n0 += 32) {
            float kv[32];
#pragma unroll
            for (int j = 0; j < 32; ++j) kv[j] = p[(size_t)(n0 + j) * 8192];
#pragma unroll
            for (int j = 0; j < 32; ++j) { p[(size_t)(n0 + j) * 8192] = gam * s; s = g64 * s + g63 * kv[j]; }
        }
    }
}
__device__ __forceinline__ void ret_out_phase(LAS unsigned char* lds, const int tid_, unsigned char* ws, const int gw, const int ngw, const float* onorm) {
    int tid = tid_; asm volatile("" : "+v"(tid));
    const int lane = tid & 63, r32 = lane & 31, hi = lane >> 5, wid = __builtin_amdgcn_readfirstlane(tid >> 6);
    const bf16_t* CQ = (const bf16_t*)(ws + WS_CQ); const bf16_t* CK = (const bf16_t*)(ws + WS_CK); const bf16_t* CV = (const bf16_t*)(ws + WS_CV); bf16_t* CG = (bf16_t*)(ws + WS_CG);
    const float* KVT = (const float*)(ws + WS_R4);
    LAS unsigned char* wl = lds + wid * 16384; const unsigned wl0 = (unsigned)(uintptr_t)wl;
    const lds_cptr tp0 = (lds_cptr)wl + ((lane >> 4) & 1) * 32 + (lane & 3) * 8 + (4 * hi + ((lane & 15) >> 2)) * 64;
    for (int task = gw; task < 2048; task += ngw) {
        const int rh = task & 1, n = (task >> 1) & 127, bh = task >> 8, b = bh >> 2, h = bh & 3;
        const size_t row0 = (size_t)b * SEQ + n * 64;
        const float l2g = log2_gamma(h);
#pragma unroll
        for (int p = 0; p < 16; ++p)
            glds16(CV + (row0 + 16 * (p & 3) + (lane >> 2)) * 512 + h * 128 + 32 * (p >> 2) + (lane & 3) * 8, (unsigned)__builtin_amdgcn_readfirstlane(wl0 + p * 1024));
        bf16x8 qr[4], kf[8];
#pragma unroll
        for (int i = 0; i < 4; ++i) {
            qr[i] = *(const bf16x8*)(CQ + (row0 + 32 * rh + r32) * 256 + h * 64 + i * 16 + hi * 8);
            kf[2 * i] = *(const bf16x8*)(CK + (row0 + r32) * 256 + h * 64 + i * 16 + hi * 8);
            kf[2 * i + 1] = *(const bf16x8*)(CK + (row0 + 32 + r32) * 256 + h * 64 + i * 16 + hi * 8);
        }
        f32x16 p0, p1;
#pragma unroll
        for (int r = 0; r < 16; ++r) { p0[r] = 0.f; p1[r] = 0.f; }
#pragma unroll
        for (int i = 0; i < 4; ++i) { p0 = __builtin_amdgcn_mfma_f32_32x32x16_bf16(kf[2 * i], qr[i], p0, 0, 0, 0); p1 = __builtin_amdgcn_mfma_f32_32x32x16_bf16(kf[2 * i + 1], qr[i], p1, 0, 0, 0); }
        const int qi = 32 * rh + r32;
#pragma unroll
        for (int r = 0; r < 16; ++r) { const int key = crow(r, hi); if (key > qi) p0[r] = 0.f; if (key + 32 > qi) p1[r] = 0.f; }
        const bf16x8 pa0 = pack_p(p0, 0), pa1 = pack_p(p0, 8), pa2 = pack_p(p1, 0), pa3 = pack_p(p1, 8);
        asm volatile("s_waitcnt vmcnt(0)" ::: "memory");
        const float* st = KVT + (size_t)(bh * 128 + n) * 8192;
        f32x16 o[4];
#pragma unroll
        for (int d = 0; d < 4; ++d) {
            const lds_cptr vd = tp0 + d * 4096;
            f32x16 a;
#pragma unroll
            for (int r = 0; r < 16; ++r) a[r] = 0.f;
            a = __builtin_amdgcn_mfma_f32_32x32x16_bf16(pa0, cat8(vtr(vd), vtr(vd + 512)), a, 0, 0, 0);
            a = __builtin_amdgcn_mfma_f32_32x32x16_bf16(pa1, cat8(vtr(vd + 1024), vtr(vd + 1024 + 512)), a, 0, 0, 0);
            a = __builtin_amdgcn_mfma_f32_32x32x16_bf16(pa2, cat8(vtr(vd + 2048), vtr(vd + 2048 + 512)), a, 0, 0, 0);
            a = __builtin_amdgcn_mfma_f32_32x32x16_bf16(pa3, cat8(vtr(vd + 3072), vtr(vd + 3072 + 512)), a, 0, 0, 0);
#pragma unroll
            for (int i = 0; i < 4; ++i) {
                const f32x4 s0 = *(const f32x4*)(st + (size_t)(32 * d + r32) * 64 + i * 16 + hi * 8), s1 = *(const f32x4*)(st + (size_t)(32 * d + r32) * 64 + i * 16 + hi * 8 + 4);
                a = __builtin_amdgcn_mfma_f32_32x32x16_bf16(qr[i], __builtin_bit_cast(bf16x8, epi::pack8(s0, s1)), a, 0, 0, 0);
            }
            o[d] = a;
        }
        LDS_WAIT(); asm volatile("" ::: "memory");
        LAS float* stg = (LAS float*)wl;
        float gn[4];
#pragma unroll
        for (int d = 0; d < 4; ++d) gn[d] = onorm[h * 128 + 32 * d + r32];
#pragma unroll
        for (int r = 0; r < 16; ++r) {
            const float dec = fast_exp2((float)(32 * rh + crow(r, hi)) * l2g);
            float ss = 0.f;
#pragma unroll
            for (int d = 0; d < 4; ++d) { o[d][r] *= dec; ss += o[d][r] * o[d][r]; }
            const float rs = __builtin_amdgcn_rsqf(half_sum32(ss) * (1.0f / 128.0f) + EPS);
#pragma unroll
            for (int d = 0; d < 4; ++d) stg[crow(r, hi) * 128 + d * 32 + r32] = o[d][r] * rs * gn[d];
        }
        LDS_WAIT(); asm volatile("" ::: "memory");
#pragma unroll
        for (int i = 0; i < 8; ++i) { const int idx = i * 64 + lane, row = idx >> 4, c8 = idx & 15;
            const f32x4 y0 = *(const LAS f32x4*)(stg + row * 128 + c8 * 8), y1 = *(const LAS f32x4*)(stg + row * 128 + c8 * 8 + 4);
            bf16_t* gp = CG + (row0 + 32 * rh + row) * 512 + h * 128 + c8 * 8;
            const u32x4 gv = *(const u32x4*)gp;
            const f32x4 g0 = {bflo(gv.x), bfhi(gv.x), bflo(gv.y), bfhi(gv.y)}, g1 = {bflo(gv.z), bfhi(gv.z), bflo(gv.w), bfhi(gv.w)};
            *(u32x4*)gp = epi::pack8(y0 * g0, y1 * g1); }
        LDS_WAIT(); asm volatile("" ::: "memory");
    }
}
}
#define XB_TMO      128
#define XB_XCNT(j)  (256  + 64 * (j))
#define XB_XSUB(j)  (1280 + 64 * (j))
#define XB_XGEN(j)  (2304 + 64 * (j))
#define XB_TOP      3328
#define XB_TOPGEN   3392
#define XCD_BAR_WORDS 3456
#define XB_SPIN_CAP (1u << 18)

__device__ __forceinline__ unsigned xb_ld(unsigned* p)              { return __hip_atomic_load(p, __ATOMIC_RELAXED, __HIP_MEMORY_SCOPE_AGENT); }
__device__ __forceinline__ unsigned xb_add(unsigned* p, unsigned v) { return __hip_atomic_fetch_add(p, v, __ATOMIC_RELAXED, __HIP_MEMORY_SCOPE_AGENT); }
__device__ __forceinline__ unsigned xb_xcc_id() { return (unsigned)__builtin_amdgcn_s_getreg((3 << 11) | 20) & 0xFu; }
#define XB_SPIN(cond, bar) do { unsigned _sp = 0; while (cond) { __builtin_amdgcn_s_sleep(1); \
    if ((++_sp & 255u) == 0u) { if (xb_ld(&(bar)[XB_TMO])) break; if (_sp > XB_SPIN_CAP) { atomicAdd(&(bar)[XB_TMO], 1u); break; } } } } while (0)

struct XcdBarrier {
    unsigned* bar; unsigned x;
    volatile LAS unsigned* st;
};

__device__ __forceinline__ XcdBarrier xcd_barrier_post(unsigned* bar, volatile LAS unsigned* st) {
    XcdBarrier b; b.bar = bar; b.x = xb_xcc_id(); b.st = st;
    if (threadIdx.x == 0) (void)xb_add(&bar[XB_XCNT(b.x)], 1u);
    return b;
}
__device__ __forceinline__ void xcd_barrier_complete(unsigned* bar, unsigned x, unsigned& nloc, unsigned& nx) {
    const unsigned G = gridDim.x * gridDim.y * gridDim.z;
    unsigned sum, cnt, mine, sp = 0u;
    for (;;) {
        sum = 0u; cnt = 0u; mine = 0u;
#pragma unroll
        for (unsigned j = 0; j < 16; ++j) { const unsigned c = xb_ld(&bar[XB_XCNT(j)]); sum += c; cnt += (c > 0u) ? 1u : 0u; mine = (j == x) ? c : mine; }
        if (sum == G) break;
        __builtin_amdgcn_s_sleep(1);
        if ((++sp & 255u) == 0u) { if (xb_ld(&bar[XB_TMO])) break; if (sp > XB_SPIN_CAP) { atomicAdd(&bar[XB_TMO], 1u); break; } }
    }
    nloc = mine > 0u ? mine : 1u; nx = cnt > 0u ? cnt : 1u;
}

__device__ __forceinline__ void xcd_barrier(const XcdBarrier& b) {
    asm volatile("s_waitcnt vmcnt(0)" ::: "memory");
    __syncthreads();
    if (threadIdx.x == 0) {
        unsigned* bar = b.bar;
        __builtin_amdgcn_s_waitcnt(0);
        unsigned nloc = b.st[0], nx = b.st[1];
        if (nloc == 0u) { xcd_barrier_complete(bar, b.x, nloc, nx); b.st[0] = nloc; b.st[1] = nx; }
        const unsigned old = xb_add(&bar[XB_XSUB(b.x)], 1u);
        const unsigned gen = old / nloc;
        if (old + 1u == (gen + 1u) * nloc) {
            __builtin_amdgcn_fence(__ATOMIC_RELEASE, "agent");
            asm volatile("s_waitcnt vmcnt(0)" ::: "memory");
            const unsigned og = xb_add(&bar[XB_TOP], 1u);
            const unsigned tg = og / nx;
            if (og + 1u == (tg + 1u) * nx) xb_add(&bar[XB_TOPGEN], 1u);
            else XB_SPIN(xb_ld(&bar[XB_TOPGEN]) == tg, bar);
            __builtin_amdgcn_fence(__ATOMIC_ACQUIRE, "agent");
            xb_add(&bar[XB_XGEN(b.x)], 1u);
            asm volatile("s_waitcnt vmcnt(0)" ::: "memory");
        } else {
            XB_SPIN(xb_ld(&bar[XB_XGEN(b.x)]) == gen, bar);
            __builtin_amdgcn_fence(__ATOMIC_ACQUIRE, "agent");
            asm volatile("s_waitcnt vmcnt(0)" ::: "memory");
        }
    }
    __syncthreads();
}

constexpr int NWAVES = 8;
constexpr int RING_OFF = 0, RING_BYTES = 131072;
constexpr int LDSCTL_OFF = RING_BYTES, MISC_OFF = LDSCTL_OFF + 320;
constexpr int LDS_BYTES = 147456;
constexpr int CW_TMO = 0, CW_CODE = 1, CW_BAR = 4096;
constexpr int PH_PER_LAYER = 12 - (HIDE_CONV ? 1 : 0) - (FUSE_RET ? 2 : 0);
constexpr int N_PHASES = 1 + PH_PER_LAYER * DEPTH;

#define CAS __attribute__((address_space(4)))
struct Args { const GAS float* in[N_IN]; GAS float* out; GAS unsigned char* ws; double ropec[32]; float lam_init[2]; };

template <class T> __device__ __forceinline__ T* as_global(GAS T* p) { return (T*)p; }
__device__ __forceinline__ int conv_dst_row(int mode, int row_off, int n0) {
    if (mode == 0) return row_off + n0;
    if (mode == 1) return 256 * (n0 >> 7) + (n0 & 127) + row_off;
    return (n0 < NIN1) ? ((n0 & ~255) + 128 * ((n0 >> 5) & 1) + 32 * ((n0 >> 6) & 3)) : n0;
}
__device__ __forceinline__ void conv_item(const float* W, const float* gain, int K, int N, bf16_t* WT, int mode, int row_off, LAS float* scr, int item, int lane) {
    const int nblk = N / 32, kb = item / nblk, nb = item % nblk, k0 = 64 * kb, n0 = 32 * nb;
    float wv[32], gv[32];
#pragma unroll
    for (int i = 0; i < 32; ++i) { const int kk = 2 * i + (lane >> 5); wv[i] = W[(size_t)(k0 + kk) * N + n0 + (lane & 31)]; gv[i] = gain ? gain[k0 + kk] : 1.0f; }
#pragma unroll
    for (int i = 0; i < 32; ++i) { const int kk = 2 * i + (lane >> 5); scr[kk * 33 + (lane & 31)] = wv[i] * gv[i]; }
    LDS_WAIT(); asm volatile("" ::: "memory");
    const int c = lane & 7, drow = conv_dst_row(mode, row_off, n0);
#pragma unroll
    for (int j = 0; j < 4; ++j) { const int n = (lane >> 3) + 8 * j; const LAS float* s = scr + (8 * c) * 33 + n;
        u32x4 o; o.x = pk2(s[0 * 33], s[1 * 33]); o.y = pk2(s[2 * 33], s[3 * 33]); o.z = pk2(s[4 * 33], s[5 * 33]); o.w = pk2(s[6 * 33], s[7 * 33]);
        *(GAS u32x4*)(WT + (size_t)(drow + n) * K + k0 + 8 * c) = o; }
    LDS_WAIT(); asm volatile("" ::: "memory");
}
__device__ __forceinline__ void convert_layer(const CAS Args& a, unsigned char* ws, int l, int part, LAS unsigned char* lds, int gw, int ngw, int wave, int lane) {
    LAS float* scr = (LAS float*)(lds + wave * 16384);
    unsigned char* wb = ws + WS_W;
    constexpr int I_GU = (DM / 64) * (DFF / 32), I_D = (DFF / 64) * (DM / 32), I_IN = (DM / 64) * (NIN / 32), I_BR = (512 / 64) * (DM / 32), I_O = (DM / 64) * (DM / 32);
    constexpr int NITEMS = 4 * I_GU + 2 * I_D + I_IN + 3 * I_BR + I_O;
    const size_t oGU = (size_t)l * DM * DFF, oD = (size_t)l * DFF * DM, oIN = (size_t)l * DM * NIN, oBR = (size_t)l * 512 * DM, oO = (size_t)l * DM * DM;
    constexpr int P1 = 2 * I_GU + I_D, P2 = P1 + I_IN + 3 * I_BR + I_O;
    const int it_lo = (part <= 1) ? 0 : (part == 2 ? P1 : P2), it_hi = (part == 0 || part == 3) ? NITEMS : (part == 1 ? P1 : P2);
    for (int it = it_lo + gw; it < it_hi; it += ngw) {
        int r = it;
        if (r < I_GU) { conv_item(as_global(a.in[I_F1G]) + oGU, as_global(a.in[I_F1N]) + l * DM, DM, DFF, (bf16_t*)(wb + W_GU1), 1, 0, scr, r, lane); continue; } r -= I_GU;
        if (r < I_GU) { conv_item(as_global(a.in[I_F1U]) + oGU, as_global(a.in[I_F1N]) + l * DM, DM, DFF, (bf16_t*)(wb + W_GU1), 1, 128, scr, r, lane); continue; } r -= I_GU;
        if (r < I_D)  { conv_item(as_global(a.in[I_F1D]) + oD, nullptr, DFF, DM, (bf16_t*)(wb + W_D1), 0, 0, scr, r, lane); continue; } r -= I_D;
        if (r < I_IN) { conv_item(as_global(a.in[I_WIN]) + oIN, as_global(a.in[I_MIXN]) + l * DM, DM, NIN, (bf16_t*)(wb + W_IN), 2, 0, scr, r, lane); continue; } r -= I_IN;
        if (r < I_BR) { conv_item(as_global(a.in[I_WBA]) + oBR, nullptr, 512, DM, (bf16_t*)(wb + W_BR), 0, 0, scr, r, lane); continue; } r -= I_BR;
        if (r < I_BR) { conv_item(as_global(a.in[I_WBB]) + oBR, nullptr, 512, DM, (bf16_t*)(wb + W_BR), 0, DM, scr, r, lane); continue; } r -= I_BR;
        if (r < I_BR) { conv_item(as_global(a.in[I_WBC]) + oBR, nullptr, 512, DM, (bf16_t*)(wb + W_BR), 0, 2 * DM, scr, r, lane); continue; } r -= I_BR;
        if (r < I_O)  { conv_item(as_global(a.in[I_WOUT]) + oO, nullptr, DM, DM, (bf16_t*)(wb + W_OUT), 0, 0, scr, r, lane); continue; } r -= I_O;
        if (r < I_GU) { conv_item(as_global(a.in[I_F2G]) + oGU, as_global(a.in[I_F2N]) + l * DM, DM, DFF, (bf16_t*)(wb + W_GU2), 1, 0, scr, r, lane); continue; } r -= I_GU;
        if (r < I_GU) { conv_item(as_global(a.in[I_F2U]) + oGU, as_global(a.in[I_F2N]) + l * DM, DM, DFF, (bf16_t*)(wb + W_GU2), 1, 128, scr, r, lane); continue; } r -= I_GU;
        conv_item(as_global(a.in[I_F2D]) + oD, nullptr, DFF, DM, (bf16_t*)(wb + W_D2), 0, 0, scr, r, lane);
    }
}
__device__ __forceinline__ void rope_tables(const CAS Args& a, unsigned char* ws, int gtid, int ngt) {
    float* cosT = (float*)(ws + WS_COS); float* sinT = (float*)(ws + WS_SIN);
    for (int i = gtid; i < SEQ * 32; i += ngt) { const int t = i >> 5, k = i & 31;
        const double rev = (double)t * a.ropec[k]; const float fr = (float)(rev - floor(rev));
        cosT[i] = __builtin_amdgcn_cosf(fr); sinT[i] = __builtin_amdgcn_sinf(fr); }
}


constexpr int CW_CNT = 32768;
__device__ __forceinline__ void cnt_signal(gu32* ctl, int idx) {
    asm volatile("s_waitcnt vmcnt(0)" ::: "memory");
    __syncthreads();
    if (threadIdx.x == 0) {
        __builtin_amdgcn_fence(__ATOMIC_RELEASE, "agent");
        asm volatile("s_waitcnt vmcnt(0)" ::: "memory");
        (void)__hip_atomic_fetch_add((unsigned*)(ctl + CW_CNT + 64 * idx), 1u, __ATOMIC_RELAXED, __HIP_MEMORY_SCOPE_AGENT);
    }
}
__device__ __forceinline__ void cnt_wait(gu32* ctl, int idx, unsigned want) {
    if (threadIdx.x == 0) {
        unsigned sp = 0;
        while (__hip_atomic_load((unsigned*)(ctl + CW_CNT + 64 * idx), __ATOMIC_RELAXED, __HIP_MEMORY_SCOPE_AGENT) < want) {
            __builtin_amdgcn_s_sleep(2);
            if (++sp > (1u << 22)) { __hip_atomic_store((unsigned*)(ctl + CW_TMO), 1u, __ATOMIC_RELAXED, __HIP_MEMORY_SCOPE_AGENT); break; }
        }
        __builtin_amdgcn_fence(__ATOMIC_ACQUIRE, "agent");
        asm volatile("s_waitcnt vmcnt(0)" ::: "memory");
    }
    __syncthreads();
}
struct Ctx { LAS unsigned char* lds; int tid, lane, wave, vcu, G, bx, gw, ngw; unsigned char* ws; float* X; const CAS Args* ap; };
enum { K_PRO = 0, K_CONV, K_UP, K_DOWN, K_WIN, K_KV, K_SCAN, K_MIX, K_GATE, K_MERGE, K_WOUT, N_KINDS };
__host__ __device__ __forceinline__ void phase_decode(int ph, int& kind, int& l, int& ffn2) {
    if (ph == 0) { kind = K_PRO; l = 0; ffn2 = 0; return; }
    int k = (ph - 1) % PH_PER_LAYER + (HIDE_CONV ? 1 : 0); l = (ph - 1) / PH_PER_LAYER;
    if (FUSE_RET && k >= 4) k += 2;
    ffn2 = (k >= 10);
    const int tab[12] = {K_CONV, K_UP, K_DOWN, K_WIN, K_KV, K_SCAN, K_MIX, K_GATE, K_MERGE, K_WOUT, K_UP, K_DOWN};
    kind = (k == 0) ? K_CONV : (k == 1 || k == 10) ? K_UP : (k == 2 || k == 11) ? K_DOWN : (k == 3) ? K_WIN : (k == 4) ? K_KV : (k == 5) ? K_SCAN : (k == 6) ? K_MIX : (k == 7) ? K_GATE : (k == 8) ? K_MERGE : K_WOUT;
    (void)tab;
}
__device__ __forceinline__ int vcu_idle(int bx) { return bx - 128; }
template <int KIND>
__device__ __forceinline__ void phase_body(const Ctx& c, const int l, const int ffn2) {
    const CAS Args& args = *c.ap; unsigned char* ws = c.ws; float* X = c.X; LAS unsigned char* lds = c.lds;
    const int tid = c.tid, lane = c.lane, wave = c.wave, vcu = c.vcu, G = c.G, bx = c.bx, gw = c.gw, ngw = c.ngw;
    bf16_t* XB = (bf16_t*)(ws + WS_XB); float* SSQ = (float*)(ws + WS_SSQ);
    const float* cosT = (const float*)(ws + WS_COS); const float* sinT = (const float*)(ws + WS_SIN);
    unsigned char* wb = ws + WS_W;
    (void)tid; (void)lane; (void)wave; (void)vcu; (void)G; (void)bx; (void)gw; (void)ngw; (void)XB; (void)SSQ; (void)cosT; (void)sinT; (void)wb; (void)X; (void)lds;
    if constexpr (KIND == K_PRO) {
#if NAIVE_WIN
        rope_tables(args, ws, (vcu * NWAVES * 64) + tid, G * NWAVES * 64);
#endif
        if (bx == 0 && tid < 4) ((unsigned*)(ws + WS_ONES))[tid] = 0x3f803f80u;
        naive::xb_ssq_pass(as_global(args.in[I_X]), XB, SSQ, gw, ngw, lane);
        convert_layer(args, ws, 0, (HIDE_CONV && G == 256) ? 1 : 0, lds, gw, ngw, wave, lane);
    } else if constexpr (KIND == K_CONV) {
        if (l > 0) convert_layer(args, ws, l, 0, lds, gw, ngw, wave, lane);
    } else if constexpr (KIND == K_UP) {
#if NAIVE_UP
        const float* xin = (l == 0 && !ffn2) ? as_global(args.in[I_X]) : X;
        naive::gemm<2, true, true, 4>(lds, tid, vcu, G, DFF, DM, xin, (ffn2 ? as_global(args.in[I_F2N]) : as_global(args.in[I_F1N])) + l * DM, nullptr, nullptr, nullptr, 0,
                                   (ffn2 ? as_global(args.in[I_F2G]) : as_global(args.in[I_F1G])) + (size_t)l * DM * DFF, (ffn2 ? as_global(args.in[I_F2U]) : as_global(args.in[I_F1U])) + (size_t)l * DM * DFF, nullptr, DFF, naive::NEpiUp{(bf16_t*)(ws + WS_HB)});
#else
        pg8::Gemm g{XB, (const bf16_t*)(wb + (ffn2 ? W_GU2 : W_GU1)), DM, 0, 0};
        pg8::StaticOrder S; S.init(M, 2 * DFF, G, bx);
        pg8::gemm_phase(lds + RING_OFF, tid, g, S, epi::EpiUp{(bf16_t*)(ws + WS_HB), (const LAS float*)(lds + epi::EPI_RSTD_OFF)}, [&]() { epi::fill_rstd_table(lds, tid, SSQ, S); });
#if HIDE_CONV
        if (G == 256 && bx >= 128) { if (l == 0 && !ffn2) convert_layer(args, ws, 0, 2, lds, (vcu_idle(bx)) * NWAVES + wave, 128 * NWAVES, wave, lane);
                                     if (l == 0 && ffn2)  convert_layer(args, ws, 1, 1, lds, (vcu_idle(bx)) * NWAVES + wave, 128 * NWAVES, wave, lane);
                                     if (l == 1 && !ffn2) convert_layer(args, ws, 1, 2, lds, (vcu_idle(bx)) * NWAVES + wave, 128 * NWAVES, wave, lane); }
#endif
#endif
    } else if constexpr (KIND == K_DOWN) {
        const float* xold = (l == 0 && !ffn2) ? as_global(args.in[I_X]) : X;
#if NAIVE_DOWN
        naive::gemm<1, true, false, 4>(lds, tid, vcu, G, DM, DFF, nullptr, nullptr, (const bf16_t*)(ws + WS_HB), nullptr, nullptr, DFF,
                                    (ffn2 ? as_global(args.in[I_F2D]) : as_global(args.in[I_F1D])) + (size_t)l * DFF * DM, nullptr, nullptr, DM, naive::NEpiRes{xold, X, XB, SSQ, 0.5f});
#else
        pg8::Gemm g{(const bf16_t*)(ws + WS_HB), (const bf16_t*)(wb + (ffn2 ? W_D2 : W_D1)), DFF, 0, 0};
        pg8::StaticOrder S; S.init(M, DM, G, bx);
        pg8::gemm_phase(lds + RING_OFF, tid, g, S, epi::EpiRes{xold, X, XB, SSQ, 0.5f});
#endif
    } else if constexpr (KIND == K_WIN) {
#if NAIVE_WIN
        naive::gemm<1, true, true, 4>(lds, tid, vcu, G, NIN1, DM, X, as_global(args.in[I_MIXN]) + l * DM, nullptr, nullptr, nullptr, 0,
                                   as_global(args.in[I_WIN]) + (size_t)l * DM * NIN, nullptr, nullptr, NIN,
                                   naive::NEpiWin{ws, cosT, sinT, as_global(args.in[I_AQN]) + l * 64, as_global(args.in[I_AKN]) + l * 64, as_global(args.in[I_BQN]) + l * 64, as_global(args.in[I_BKN]) + l * 64});
#else
        pg8::Gemm g{XB, (const bf16_t*)(wb + W_IN), DM, 0, 0};
        pg8::StaticOrder S; S.init(M, NIN1, G, bx);
        epi::fill_rstd_table(lds, tid, SSQ, S);
        { LAS float* gt = (LAS float*)(lds + epi::EPI_GAIN_OFF); LAS float* rt = (LAS float*)(lds + epi::EPI_ROPE_OFF);
          if (tid < 256) { const int kq = tid >> 6; const float* gp = (kq == 0) ? as_global(args.in[I_AQN]) : (kq == 1) ? as_global(args.in[I_AKN]) : (kq == 2) ? as_global(args.in[I_BQN]) : as_global(args.in[I_BKN]); gt[tid] = gp[l * 64 + (tid & 63)]; }
          else if (tid < 288) rt[tid - 256] = (float)args.ropec[tid - 256]; }
        __syncthreads();
        pg8::gemm_phase(lds + RING_OFF, tid, g, S, epi::EpiWin{ws, (const LAS float*)(lds + epi::EPI_RSTD_OFF), (const LAS float*)(lds + epi::EPI_GAIN_OFF), (const LAS float*)(lds + epi::EPI_ROPE_OFF)});
#if HIDE_CONV
        if (G == 256 && bx >= 128) convert_layer(args, ws, l, 3, lds, (vcu_idle(bx)) * NWAVES + wave, 128 * NWAVES, wave, lane);
#endif
#endif
    } else if constexpr (KIND == K_KV) {
#if !NAIVE_C
        fa::ret_kv_phase(lds, tid, ws, gw, ngw);
#endif
    } else if constexpr (KIND == K_SCAN) {
#if !NAIVE_C
        fa::ret_scan_phase(tid, ws, vcu, G);
#endif
    } else if constexpr (KIND == K_MIX) {
#if FUSE_RET && !NAIVE_C && !NAIVE_B && !NAIVE_A
        {
            gu32* ctl = (gu32*)(ws + WS_CTL);
            fa::ret_kv_phase(lds, tid, ws, gw, ngw);
            cnt_signal(ctl, l * 16 + (vcu >> 5));
            fa::attn_b_phase(lds, tid, ws, (bf16_t*)(ws + WS_BQ), vcu, G, as_global(args.in[I_BREL]) + l * 8 * 320, as_global(args.in[I_BQN]) + l * 64, as_global(args.in[I_BKN]) + l * 64);
            if (vcu < 128) { cnt_wait(ctl, l * 16 + (vcu >> 4), 32u); fa::ret_scan_phase(tid, ws, vcu, G); cnt_signal(ctl, l * 16 + 8 + (vcu >> 4)); }
            __syncthreads();
            fa::attn_a_phase(lds, tid, ws, (bf16_t*)(ws + WS_AQ), vcu, G, as_global(args.in[I_LQ1]) + l * 64, as_global(args.in[I_LK1]) + l * 64, as_global(args.in[I_LQ2]) + l * 64, as_global(args.in[I_LK2]) + l * 64, as_global(args.in[I_ASUB]) + l * 128, (l == 0 ? args.lam_init[0] : args.lam_init[1]), as_global(args.in[I_AQN]) + l * 64, as_global(args.in[I_AKN]) + l * 64);
            cnt_wait(ctl, l * 16 + 8 + (vcu >> 5), 16u);
            fa::ret_out_phase(lds, tid, ws, gw, ngw, as_global(args.in[I_CON]) + l * 512);
        }
#else
#if NAIVE_C
        naive::retention(ws, as_global(args.in[I_CON]) + l * 512, lds, vcu, G, tid);
#else
        fa::ret_out_phase(lds, tid, ws, gw, ngw, as_global(args.in[I_CON]) + l * 512);
#endif
        __syncthreads();
#if NAIVE_B
        naive::attn_b(ws, as_global(args.in[I_BREL]) + l * 8 * 320, lds, gw, ngw, wave, lane);
#else
#if PROBE_B
        for (int rep = 0; rep < PROBE_B; ++rep) { fa::attn_b_phase(lds, tid, ws, (bf16_t*)(ws + WS_W), vcu, G, as_global(args.in[I_BREL]) + l * 8 * 320, as_global(args.in[I_BQN]) + l * 64, as_global(args.in[I_BKN]) + l * 64); __syncthreads(); }
#endif
        fa::attn_b_phase(lds, tid, ws, (bf16_t*)(ws + WS_BQ), vcu, G, as_global(args.in[I_BREL]) + l * 8 * 320, as_global(args.in[I_BQN]) + l * 64, as_global(args.in[I_BKN]) + l * 64);
#endif
        __syncthreads();
#if NAIVE_A
        naive::attn_a(ws, as_global(args.in[I_LQ1]) + l * 64, as_global(args.in[I_LK1]) + l * 64, as_global(args.in[I_LQ2]) + l * 64, as_global(args.in[I_LK2]) + l * 64, as_global(args.in[I_ASUB]) + l * 128, (l == 0 ? args.lam_init[0] : args.lam_init[1]), lds, gw, ngw, wave, lane);
#else
#if PROBE_A
        for (int rep = 0; rep < PROBE_A; ++rep) { fa::attn_a_phase(lds, tid, ws, (bf16_t*)(ws + WS_W), vcu, G, as_global(args.in[I_LQ1]) + l * 64, as_global(args.in[I_LK1]) + l * 64, as_global(args.in[I_LQ2]) + l * 64, as_global(args.in[I_LK2]) + l * 64, as_global(args.in[I_ASUB]) + l * 128, (l == 0 ? args.lam_init[0] : args.lam_init[1]), as_global(args.in[I_AQN]) + l * 64, as_global(args.in[I_AKN]) + l * 64, PROBE_PM); __syncthreads(); }
#endif
#define MK_PROBE_STRETCH 1
        fa::attn_a_phase(lds, tid, ws, (bf16_t*)(ws + WS_AQ), vcu, G, as_global(args.in[I_LQ1]) + l * 64, as_global(args.in[I_LK1]) + l * 64, as_global(args.in[I_LQ2]) + l * 64, as_global(args.in[I_LK2]) + l * 64, as_global(args.in[I_ASUB]) + l * 128, (l == 0 ? args.lam_init[0] : args.lam_init[1]), as_global(args.in[I_AQN]) + l * 64, as_global(args.in[I_AKN]) + l * 64);
#endif
#endif
#if PROBE_T
        __syncthreads();
        if (bx == 0 && tid == 0 && l == 1) {
            const unsigned long long* pr = (const unsigned long long*)(ws + WS_PROBE);
            const unsigned long long v = pr[PROBE_SEL]; const unsigned long long t0 = __builtin_amdgcn_s_memrealtime();
            while (__builtin_amdgcn_s_memrealtime() - t0 < v * 100ull) __builtin_amdgcn_s_sleep(32);
        }
#endif
    } else if constexpr (KIND == K_GATE) {
#if NAIVE_GATE
        naive::gemm<1, true, true, 4>(lds, tid, vcu, G, NGATE, DM, X, as_global(args.in[I_MIXN]) + l * DM, nullptr, nullptr, nullptr, 0,
                                   as_global(args.in[I_WIN]) + (size_t)l * DM * NIN + NIN1, nullptr, nullptr, NIN, naive::NEpiGate{(bf16_t*)(ws + WS_GT)});
#else
        pg8::Gemm g{XB, (const bf16_t*)(wb + W_IN) + (size_t)NIN1 * DM, DM, 0, 0};
        pg8::StaticOrder S; S.init(M, NGATE, G, bx);
        pg8::gemm_phase(lds + RING_OFF, tid, g, S, epi::EpiGate{(bf16_t*)(ws + WS_GT), (const LAS float*)(lds + epi::EPI_RSTD_OFF)}, [&]() { epi::fill_rstd_table(lds, tid, SSQ, S); });
#endif
    } else if constexpr (KIND == K_MERGE) {
#if NAIVE_MERGE
        naive::gemm<3, false, false, 2>(lds, tid, vcu, G, DM, 512, nullptr, nullptr, (const bf16_t*)(ws + WS_AQ), (const bf16_t*)(ws + WS_BQ), (const bf16_t*)(ws + WS_CG), 512,
                                     as_global(args.in[I_WBA]) + (size_t)l * 512 * DM, as_global(args.in[I_WBB]) + (size_t)l * 512 * DM, as_global(args.in[I_WBC]) + (size_t)l * 512 * DM, DM,
                                     naive::NEpiMerge{(const bf16_t*)(ws + WS_GT), (bf16_t*)(ws + WS_MG)});
#else
        static_assert(WS_BQ - WS_AQ == P16 && WS_CG - WS_BQ == P16, "y_a, y_b, y_c equally spaced");
        pg8::Gemm g{(const bf16_t*)(ws + WS_AQ), (const bf16_t*)(wb + W_BR), 512, P16, (size_t)DM * 512 * 2};
        pg8::StaticOrder S; S.init(M, DM, G, bx);
        pg8::gemm_phase<3>(lds + RING_OFF, tid, g, S, epi::EpiMerge{(const bf16_t*)(ws + WS_GT), (bf16_t*)(ws + WS_MG), (const unsigned*)(ws + WS_ONES)});
#endif
    } else if constexpr (KIND == K_WOUT) {
#if NAIVE_WOUT
        naive::gemm<1, true, false, 4>(lds, tid, vcu, G, DM, DM, nullptr, nullptr, (const bf16_t*)(ws + WS_MG), nullptr, nullptr, DM,
                                    as_global(args.in[I_WOUT]) + (size_t)l * DM * DM, nullptr, nullptr, DM, naive::NEpiRes{X, X, XB, SSQ, 1.0f});
#else
        pg8::Gemm g{(const bf16_t*)(ws + WS_MG), (const bf16_t*)(wb + W_OUT), DM, 0, 0};
        pg8::StaticOrder S; S.init(M, DM, G, bx);
        pg8::gemm_phase(lds + RING_OFF, tid, g, S, epi::EpiRes{X, X, XB, SSQ, 1.0f});
#endif
    }
}
__device__ __forceinline__ Ctx make_ctx(LAS unsigned char* lds, const int wave_s) {
    Ctx c; c.lds = lds;
    int lane_; asm volatile("v_mbcnt_lo_u32_b32 %0, -1, 0\n\tv_mbcnt_hi_u32_b32 %0, -1, %0" : "=&v"(lane_));
    int tid = wave_s * 64 + lane_; asm volatile("" : "+v"(tid));
    const CAS Args* argp = (const CAS Args*)__builtin_amdgcn_kernarg_segment_ptr(); asm volatile("" : "+s"(argp));
    c.ap = argp; c.tid = tid; c.lane = tid & 63; c.wave = __builtin_amdgcn_readfirstlane(tid >> 6);
    c.G = gridDim.x; c.bx = blockIdx.x; c.vcu = (c.G % 8 == 0) ? (c.bx % 8) * (c.G / 8) + c.bx / 8 : c.bx;
    c.gw = c.vcu * NWAVES + c.wave; c.ngw = c.G * NWAVES;
    GAS unsigned char* ws = argp->ws; asm volatile("" : "+s"(ws)); c.ws = as_global(ws);
    GAS float* X = argp->out; asm volatile("" : "+s"(X)); c.X = as_global(X);
    return c;
}
#if MK_PER_PHASE_LAUNCH
template <int KIND>
__global__ void __launch_bounds__(NWAVES * 64, 2) phase_kernel(Args args_, int l, int ffn2) {
    extern __shared__ __attribute__((aligned(16))) unsigned char lds_raw[];
    const Ctx c = make_ctx((LAS unsigned char*)lds_raw, __builtin_amdgcn_readfirstlane(threadIdx.x >> 6));
    phase_body<KIND>(c, l, ffn2);
}
#endif
#if !MK_PER_PHASE_LAUNCH
__global__ void __launch_bounds__(NWAVES * 64, 2) trunk_fwd(Args args_) {
    extern __shared__ __attribute__((aligned(16))) unsigned char lds_raw[];
    LAS unsigned char* lds = (LAS unsigned char*)lds_raw;
    volatile LAS unsigned* MISC = (volatile LAS unsigned*)(lds + MISC_OFF);
    gu32* ctl = (gu32*)(args_.ws + WS_CTL);
    for (int u = threadIdx.x; u < (LDS_BYTES - LDSCTL_OFF) / 4; u += NWAVES * 64) ((LAS unsigned*)(lds + LDSCTL_OFF))[u] = 0u;
    __syncthreads();
    XcdBarrier bar = xcd_barrier_post((unsigned*)(ctl + CW_BAR), MISC + 8);
    const int wave_s = __builtin_amdgcn_readfirstlane(threadIdx.x >> 6);
    for (int ph = 0; ph < N_PHASES; ++ph) {
        const Ctx c = make_ctx(lds, wave_s);
        int kind_, l_, ffn2_; phase_decode(ph, kind_, l_, ffn2_);
        const int kind = __builtin_amdgcn_readfirstlane(kind_), l = __builtin_amdgcn_readfirstlane(l_), ffn2 = __builtin_amdgcn_readfirstlane(ffn2_);
#if PROBE_MASK
        if ((PROBE_MASK >> kind) & 1) {
            switch (kind) {
            case K_CONV: phase_body<K_CONV>(c, l, ffn2); break;
#if PROBE_NULL
            case K_UP: { pg8::Gemm g{(const bf16_t*)(c.ws + WS_XB), (const bf16_t*)(c.ws + WS_W + (ffn2 ? W_GU2 : W_GU1)), DM, 0, 0}; pg8::StaticOrder S; S.init(M, 2 * DFF, c.G, c.bx); pg8::gemm_phase(c.lds + RING_OFF, c.tid, g, S, epi::EpiNull{}); } break;
#else
            case K_UP: phase_body<K_UP>(c, l, ffn2); break;
#endif
            case K_WIN: phase_body<K_WIN>(c, l, ffn2); break;
            case K_KV: phase_body<K_KV>(c, l, ffn2); break;
            case K_GATE: phase_body<K_GATE>(c, l, ffn2); break;
            case K_MERGE: phase_body<K_MERGE>(c, l, ffn2); break;
            default: break;
            }
            xcd_barrier(bar);
        }
#endif
#if PROBE_PH
        unsigned long long tp0 = __builtin_amdgcn_s_memrealtime();
#endif
        switch (kind) {
        case K_PRO: phase_body<K_PRO>(c, l, ffn2); break;
        case K_CONV: phase_body<K_CONV>(c, l, ffn2); break;
        case K_UP: phase_body<K_UP>(c, l, ffn2); break;
        case K_DOWN: phase_body<K_DOWN>(c, l, ffn2); break;
        case K_WIN: phase_body<K_WIN>(c, l, ffn2); break;
        case K_KV: phase_body<K_KV>(c, l, ffn2); break;
        case K_SCAN: phase_body<K_SCAN>(c, l, ffn2); break;
        case K_MIX: phase_body<K_MIX>(c, l, ffn2); break;
        case K_GATE: phase_body<K_GATE>(c, l, ffn2); break;
        case K_MERGE: phase_body<K_MERGE>(c, l, ffn2); break;
        default: phase_body<K_WOUT>(c, l, ffn2); break;
        }
#if PROBE_PH
        __syncthreads(); const unsigned long long tp1 = __builtin_amdgcn_s_memrealtime();
#endif
        if (ph + 1 < N_PHASES) xcd_barrier(bar);
#if PROBE_PH
        if (blockIdx.x == PROBE_BLK && threadIdx.x == 0) { const unsigned long long tp2 = __builtin_amdgcn_s_memrealtime(); unsigned long long* pr = (unsigned long long*)(args_.ws + WS_PROBE);
            pr[kind] += tp1 - tp0; pr[16] += tp2 - tp1; pr[17] += tp2 - tp0; pr[20 + kind] += tp2 - tp1; }
#endif
    }
#if PROBE_PH
    if (blockIdx.x == PROBE_BLK && threadIdx.x == 0) {
        const unsigned long long v = ((const unsigned long long*)(args_.ws + WS_PROBE))[PROBE_SEL] / 100; const unsigned long long t0 = __builtin_amdgcn_s_memrealtime();
        while (__builtin_amdgcn_s_memrealtime() - t0 < v * 100ull) __builtin_amdgcn_s_sleep(32);
    }
#endif
}
#endif

#if MK_PER_PHASE_LAUNCH
template <int KIND> static void launch_phase(int grid, hipStream_t stream, const Args& a, int l, int ffn2) {
    static bool attr = false;
    if (!attr) { (void)hipFuncSetAttribute((const void*)phase_kernel<KIND>, hipFuncAttributeMaxDynamicSharedMemorySize, LDS_BYTES); attr = true; }
    hipLaunchKernelGGL(phase_kernel<KIND>, dim3(grid), dim3(NWAVES * 64), LDS_BYTES, stream, a, l, ffn2);
}
#endif
extern "C" void kernel_launch(void* const* d_in, const int* in_sizes, int n_in, void* d_out, int out_size, void* d_ws, size_t ws_size, hipStream_t stream) {
    static int grid = 0;
    if (grid == 0) {
        if (n_in != N_IN || in_sizes[0] != M * DM || out_size != M * DM || ws_size < WS_END) { fprintf(stderr, "kernel_launch: unexpected shapes (n_in %d, in0 %d, out %d, ws %zu < %zu); nothing launched\n", n_in, n_in > 0 ? in_sizes[0] : -1, out_size, ws_size, (size_t)WS_END); grid = -1; return; }
        int dev = 0, cus = 0, per_cu = 0;
        if (hipGetDevice(&dev) != hipSuccess || hipDeviceGetAttribute(&cus, hipDeviceAttributeMultiprocessorCount, dev) != hipSuccess) { grid = -1; return; }
#if !MK_PER_PHASE_LAUNCH
        if (hipFuncSetAttribute((const void*)trunk_fwd, hipFuncAttributeMaxDynamicSharedMemorySize, LDS_BYTES) != hipSuccess) { fprintf(stderr, "kernel_launch: hipFuncSetAttribute failed\n"); grid = -1; return; }
        if (hipOccupancyMaxActiveBlocksPerMultiprocessor(&per_cu, (const void*)trunk_fwd, NWAVES * 64, LDS_BYTES) != hipSuccess || per_cu < 1)
            fprintf(stderr, "kernel_launch: note: occupancy query reports %d workgroups per CU\n", per_cu);
        (void)hipGetLastError();
#endif
        (void)per_cu;
        if (cus < 256) { fprintf(stderr, "kernel_launch: built for a 256-CU device (found %d CUs); nothing launched\n", cus); grid = -1; return; }
        grid = 256;
    }
    if (grid < 0) return;
    (void)hipMemsetAsync((char*)d_ws + WS_CTL, 0, (FUSE_RET || PROBE_T || PROBE_PH) ? CTL_ZERO_BYTES : 32768, stream);
    Args a{};
    for (int i = 0; i < N_IN; ++i) a.in[i] = (const GAS float*)d_in[i];
    a.out = (GAS float*)d_out; a.ws = (GAS unsigned char*)d_ws;
    for (int i = 0; i < 32; ++i) a.ropec[i] = std::pow(10000.0, -(double)i / 32.0) / (2.0 * 3.14159265358979323846);
    for (int l = 0; l < 2; ++l) a.lam_init[l] = (float)(0.8 - 0.6 * std::exp(-0.3 * (double)l));
#if MK_PER_PHASE_LAUNCH
    for (int ph = 0; ph < N_PHASES; ++ph) {
        int kind, l, ffn2; phase_decode(ph, kind, l, ffn2);
        switch (kind) {
        case K_PRO: launch_phase<K_PRO>(grid, stream, a, l, ffn2); break;
        case K_CONV: if (l > 0) launch_phase<K_CONV>(grid, stream, a, l, ffn2); break;
        case K_UP: launch_phase<K_UP>(grid, stream, a, l, ffn2); break;
        case K_DOWN: launch_phase<K_DOWN>(grid, stream, a, l, ffn2); break;
        case K_WIN: launch_phase<K_WIN>(grid, stream, a, l, ffn2); break;
#if NAIVE_C
        case K_KV: case K_SCAN: break;
#else
        case K_KV: launch_phase<K_KV>(grid, stream, a, l, ffn2); break;
        case K_SCAN: launch_phase<K_SCAN>(grid, stream, a, l, ffn2); break;
#endif
        case K_MIX: launch_phase<K_MIX>(grid, stream, a, l, ffn2); break;
        case K_GATE: launch_phase<K_GATE>(grid, stream, a, l, ffn2); break;
        case K_MERGE: launch_phase<K_MERGE>(grid, stream, a, l, ffn2); break;
        default: launch_phase<K_WOUT>(grid, stream, a, l, ffn2); break;
        }
    }
#else
    hipLaunchKernelGGL(trunk_fwd, dim3(grid), dim3(NWAVES * 64), LDS_BYTES, stream, a);
#endif
    const hipError_t le = hipPeekAtLastError();
    if (le != hipSuccess) fprintf(stderr, "kernel_launch: launch failed: %s\n", hipGetErrorName(le));
}
```

```cpp
#include <hip/hip_runtime.h>
#include <hip/hip_bf16.h>
#include <cstdio>
#include <cstdint>
#include <cmath>

#ifndef MK_PER_PHASE_LAUNCH
#define MK_PER_PHASE_LAUNCH 0
#endif
#ifndef NAIVE_GEMM
#define NAIVE_GEMM 0
#endif
#ifndef NAIVE_UP
#define NAIVE_UP NAIVE_GEMM
#endif
#ifndef NAIVE_DOWN
#define NAIVE_DOWN NAIVE_GEMM
#endif
#ifndef NAIVE_WIN
#define NAIVE_WIN NAIVE_GEMM
#endif
#ifndef NAIVE_GATE
#define NAIVE_GATE NAIVE_GEMM
#endif
#ifndef NAIVE_MERGE
#define NAIVE_MERGE NAIVE_GEMM
#endif
#ifndef NAIVE_WOUT
#define NAIVE_WOUT NAIVE_GEMM
#endif
#ifndef PROBE_MASK
#define PROBE_MASK 0
#endif
#ifndef PROBE_NULL
#define PROBE_NULL 0
#endif
#ifndef FA_V2
#define FA_V2 3
#endif
#ifndef PROBE_PM
#define PROBE_PM 0
#endif
#ifndef PROBE_T
#define PROBE_T 0
#endif
#ifndef PROBE_SEL
#define PROBE_SEL 0
#endif
#ifndef FA_WMAP
#define FA_WMAP 0
#endif
#ifndef HIDE_CONV
#define HIDE_CONV 1
#endif
#ifndef PROBE_PH
#define PROBE_PH 0
#endif
#ifndef PROBE_BLK
#define PROBE_BLK 0
#endif
#ifndef FA_HAND
#define FA_HAND 1
#endif
#ifndef FUSE_RET
#define FUSE_RET 0
#endif
#ifndef FA_HANDB
#define FA_HANDB 1
#endif
#ifndef FA_NOMAX_BOUND_A
#define FA_NOMAX_BOUND_A 100.0f
#endif
#ifndef FA_NOMAX_BOUND_B
#define FA_NOMAX_BOUND_B 100.0f
#endif
#ifndef FUSE_GM
#define FUSE_GM 1
#endif
#ifndef PROBE_A
#define PROBE_A 0
#endif
#ifndef PROBE_B
#define PROBE_B 0
#endif
#ifndef NAIVE_A
#define NAIVE_A 0
#endif
#ifndef NAIVE_B
#define NAIVE_B 0
#endif
#ifndef NAIVE_C
#define NAIVE_C 0
#endif

constexpr int BATCH = 2, SEQ = 8192, DM = 1024, DEPTH = 2, M = BATCH * SEQ;
constexpr int DFF = 2816, NIN1 = 4608, NGATE = 3072, NIN = 7680;
constexpr float EPS = 1e-6f;
constexpr float LOG2E = 1.4426950408889634f;
constexpr float C2 = 0.125f * LOG2E;

enum { I_X = 0, I_F1N, I_F1G, I_F1U, I_F1D, I_MIXN, I_WIN, I_AQN, I_AKN, I_LQ1, I_LK1, I_LQ2, I_LK2, I_ASUB, I_BQN, I_BKN, I_BREL, I_CON, I_WBA, I_WBB, I_WBC, I_WOUT, I_F2N, I_F2G, I_F2U, I_F2D, N_IN };

constexpr size_t MiB = 1u << 20;
constexpr size_t WS_CTL = 0, CTL_ZERO_BYTES = 1 * MiB;
constexpr size_t WS_PROBE = 576 * 1024;
constexpr size_t WS_ONES = 512 * 1024;
constexpr size_t WS_COS = 1 * MiB, WS_SIN = 2 * MiB;
constexpr size_t WS_SSQ = 3 * MiB;
constexpr size_t WS_W = 4 * MiB;
constexpr size_t W_GU1 = 0, W_D1 = W_GU1 + (size_t)2 * DFF * DM * 2, W_IN = W_D1 + (size_t)DM * DFF * 2, W_BR = W_IN + (size_t)NIN * DM * 2,
                 W_OUT = W_BR + (size_t)3 * DM * 512 * 2, W_GU2 = W_OUT + (size_t)DM * DM * 2, W_D2 = W_GU2 + (size_t)2 * DFF * DM * 2, W_END = W_D2 + (size_t)DM * DFF * 2;
static_assert(W_END == 53 * MiB, "weights");
constexpr size_t WS_XB = 57 * MiB;
constexpr size_t WS_R4 = 89 * MiB;
constexpr size_t WS_R3 = 121 * MiB;
constexpr size_t P16 = 16 * MiB;
constexpr size_t WS_AQ = WS_R3, WS_BQ = WS_R3 + P16, WS_CG = WS_R3 + 2 * P16;
constexpr size_t WS_AK = WS_R3 + 3 * P16, WS_AV = WS_AK + P16, WS_BK = WS_AV + P16, WS_BV = WS_BK + P16, WS_CQ = WS_BV + P16, WS_CK = WS_CQ + P16 / 2, WS_CV = WS_CK + P16 / 2;
constexpr size_t WS_GT = WS_AK;
constexpr size_t WS_HB = WS_R3;
constexpr size_t WS_MG = WS_R4;
constexpr size_t WS_END = WS_R3 + 144 * MiB;
static_assert(WS_CV + P16 == WS_END && WS_GT + (size_t)M * NGATE * 2 == WS_END && WS_HB + (size_t)M * DFF * 2 <= WS_END, "ws map");

#define GAS __attribute__((address_space(1)))
#define LAS __attribute__((address_space(3)))
typedef unsigned short bf16_t;
typedef short bf16x8 __attribute__((ext_vector_type(8)));
typedef float f32x4 __attribute__((ext_vector_type(4)));
typedef float f32x2 __attribute__((ext_vector_type(2)));
typedef float f32x16 __attribute__((ext_vector_type(16)));
typedef unsigned u32x4 __attribute__((ext_vector_type(4)));
typedef unsigned u32x2 __attribute__((ext_vector_type(2)));
typedef GAS unsigned gu32;
#define RLX_AGENT __ATOMIC_RELAXED, __HIP_MEMORY_SCOPE_AGENT
#define LDS_WAIT() asm volatile("s_waitcnt lgkmcnt(0)" ::: "memory")
#define VM_WAIT() asm volatile("s_waitcnt vmcnt(0)" ::: "memory")

__device__ __forceinline__ unsigned f2bf(float f) { unsigned u = __builtin_bit_cast(unsigned, f); return (u + 0x7fffu + ((u >> 16) & 1u)) >> 16; }
__device__ __forceinline__ unsigned pk2(float lo, float hi) { return f2bf(lo) | (f2bf(hi) << 16); }
__device__ __forceinline__ float bf2f(unsigned short b) { return __builtin_bit_cast(float, (unsigned)b << 16); }
__device__ __forceinline__ float bflo(unsigned w) { return __builtin_bit_cast(float, w << 16); }
__device__ __forceinline__ float bfhi(unsigned w) { return __builtin_bit_cast(float, w & 0xffff0000u); }
__device__ __forceinline__ unsigned cvt_pk_bf16(float lo, float hi) { unsigned r; asm volatile("v_cvt_pk_bf16_f32 %0, %1, %2" : "=v"(r) : "v"(lo), "v"(hi)); return r; }
__device__ __forceinline__ float fast_rcp(float x) { return __builtin_amdgcn_rcpf(x); }
__device__ __forceinline__ float fast_exp2(float x) { return __builtin_amdgcn_exp2f(x); }
__device__ __forceinline__ float silu_f(float x) { return x * fast_rcp(1.0f + fast_exp2(-x * LOG2E)); }
__device__ __forceinline__ float sigmoid_f(float x) { return fast_rcp(1.0f + fast_exp2(-x * LOG2E)); }
template <int O> __device__ __forceinline__ float xor_add(float v) {
    if constexpr (O == 32) { auto rr = __builtin_amdgcn_permlane32_swap(__float_as_uint(v), __float_as_uint(v), false, false); return __uint_as_float(rr[0]) + __uint_as_float(rr[1]); }
    else return v + __uint_as_float((unsigned)__builtin_amdgcn_ds_swizzle((int)__float_as_uint(v), (O << 10) | 0x1f));
}
template <int O> __device__ __forceinline__ float xor_max(float v) {
    if constexpr (O == 32) { auto rr = __builtin_amdgcn_permlane32_swap(__float_as_uint(v), __float_as_uint(v), false, false); return fmaxf(__uint_as_float(rr[0]), __uint_as_float(rr[1])); }
    else return fmaxf(v, __uint_as_float((unsigned)__builtin_amdgcn_ds_swizzle((int)__float_as_uint(v), (O << 10) | 0x1f)));
}
__device__ __forceinline__ float wave_sum(float v) { v = xor_add<1>(v); v = xor_add<2>(v); v = xor_add<4>(v); v = xor_add<8>(v); v = xor_add<16>(v); return xor_add<32>(v); }
__device__ __forceinline__ float wave_max(float v) { v = xor_max<1>(v); v = xor_max<2>(v); v = xor_max<4>(v); v = xor_max<8>(v); v = xor_max<16>(v); return xor_max<32>(v); }

namespace pg8 {
#define PG8_LAS __attribute__((address_space(3)))
constexpr int BM = 256, BK = 64, HALF = 128, HTB = HALF * BK * 2  , STAGE_BYTES = 8 * HTB, NXCD = 8, WGM = 8;

__host__ __device__ __forceinline__ int lds_byte(int r, int c) { const int st = (r >> 4) * 2 + (c >> 5), rr = r & 15, cc = c & 31, ob = rr * 64 + cc * 2; return st * 1024 + (ob ^ (((ob >> 9) & 1) << 5)); }
__host__ __device__ __forceinline__ void stage_rc(int b, int& R, int& C) { const int st = b / 1024, sb = b % 1024, swz = sb ^ (((sb >> 9) & 1) << 5); R = (st >> 1) * 16 + swz / 64; C = (st & 1) * 32 + (swz % 64) / 2; }
__host__ __device__ __forceinline__ int perm32(int rho) { const int n = rho >> 4, i = rho & 15; return 8 * (i >> 2) + 4 * n + (i & 3); }

struct Unit { int pm, pn, sub, ui; };
struct Gemm { const bf16_t* A; const bf16_t* Bt; int K; size_t subA, subB; };
__device__ __forceinline__ const char* pickA(const Gemm& g, int s) { return (const char*)g.A + (size_t)s * g.subA; }
__device__ __forceinline__ const char* pickB(const Gemm& g, int s) { return (const char*)g.Bt + (size_t)s * g.subB; }

struct StaticOrder {
    int nM, nN, nwg, G, c;
    __host__ __device__ void init(int Mr, int N, int G_, int c_) { nM = Mr / BM; nN = N / BM; nwg = nM * nN; G = G_; c = c_; }
    template <int NSUB = 1> __host__ __device__ bool next(int i, Unit& u) const {
        const int it = i / NSUB; u.sub = i - it * NSUB; u.ui = it;
        const long L = (long)it * G + c; if (L >= nwg) return false;
        int wgid = (int)L; { const int q = nwg / NXCD, r = nwg % NXCD, xcd = wgid % NXCD, off = wgid / NXCD; wgid = (xcd < r ? xcd * (q + 1) : r * (q + 1) + (xcd - r) * q) + off; }
        const int nig = WGM * nN, gid = wgid / nig, fm = gid * WGM, gsz = (nM - fm) < WGM ? (nM - fm) : WGM;
        u.pm = fm + ((wgid % nig) % gsz); u.pn = (wgid % nig) / gsz; return true;
    }
};

struct NoPre { __device__ __forceinline__ void operator()() const {} };
template <int NSUB = 1, class Epi, class Pre = NoPre>
__device__ __forceinline__ void gemm_phase(PG8_LAS unsigned char* lds, const int tid, const Gemm g, const StaticOrder& S, const Epi& E, const Pre& pre = Pre()) {
    const int wid = __builtin_amdgcn_readfirstlane(tid >> 6), lane = tid & 63, wr = wid >> 2, wc = wid & 3, fr = lane & 15, fq = lane >> 4;
    const int K = g.K, nt = K / BK;
    unsigned voffA[2], voffB[2];
#pragma unroll
    for (int i = 0; i < 2; ++i) { int R, C; stage_rc(tid * 16 + i * 8192, R, C); const int Rb = ((R & ~31) + perm32(R & 31));
        voffA[i] = (unsigned)(R * K + C) * 2u; voffB[i] = (unsigned)(Rb * K + C) * 2u; }
    const size_t kstep = (size_t)(BK * 2);
    const size_t hstep = (size_t)HALF * K * 2;
    const size_t tstep = 2 * hstep;
    const unsigned ldsw = (unsigned)wid * 1024u;
    const int aoff = lds_byte(wr * 64 + fr, fq * 8), boff = lds_byte(wc * 32 + fr, fq * 8);
#define PG8_SA(b, h) (((b) * 2 + (h)) * HTB)
#define PG8_SB(b, h) ((4 + (b) * 2 + (h)) * HTB)
#define PG8_STAGE(bufoff, gbase, voff) do { _Pragma("unroll") for (int _i = 0; _i < 2; ++_i) \
        __builtin_amdgcn_global_load_lds((const unsigned*)((const char*)(gbase) + (voff)[_i]), (PG8_LAS unsigned*)(lds + (bufoff) + ldsw + _i * 8192), 16, 0, 0); } while (0)
#define PG8_LDA(dst, b, h) do { _Pragma("unroll") for (int m = 0; m < 4; ++m) _Pragma("unroll") for (int k = 0; k < 2; ++k) dst[m][k] = *(const PG8_LAS bf16x8*)(lds + PG8_SA(b, h) + aoff + m * 2048 + k * 1024); } while (0)
#define PG8_LDB(dst, b, h) do { _Pragma("unroll") for (int n = 0; n < 2; ++n) _Pragma("unroll") for (int k = 0; k < 2; ++k) dst[n][k] = *(const PG8_LAS bf16x8*)(lds + PG8_SB(b, h) + boff + n * 2048 + k * 1024); } while (0)
#define PG8_MMA(ai, bj, At, Bt) do { __builtin_amdgcn_s_setprio(1); _Pragma("unroll") for (int m = 0; m < 4; ++m) _Pragma("unroll") for (int n = 0; n < 2; ++n) _Pragma("unroll") for (int k = 0; k < 2; ++k) \
        acc[ai][bj][m][n] = __builtin_amdgcn_mfma_f32_16x16x32_bf16(Bt[n][k], At[m][k], acc[ai][bj][m][n], 0, 0, 0); __builtin_amdgcn_s_setprio(0); } while (0)
#define PG8_WAIT_V(n) asm volatile("s_waitcnt vmcnt(" #n ")" ::: "memory")
#define PG8_WAIT_L(n) asm volatile("s_waitcnt lgkmcnt(" #n ")" ::: "memory")
#define PG8_BAR __builtin_amdgcn_s_barrier()
#define PG8_SCHED __builtin_amdgcn_sched_barrier(0)
    Unit cur, nxt; int ui = 0;
    if (!S.template next<NSUB>(0, cur)) return;
    f32x4 acc[2][2][4][2];
#pragma unroll
    for (int a = 0; a < 2; ++a)
#pragma unroll
        for (int b = 0; b < 2; ++b)
#pragma unroll
            for (int m = 0; m < 4; ++m)
#pragma unroll
                for (int n = 0; n < 2; ++n) acc[a][b][m][n] = (f32x4){0.f, 0.f, 0.f, 0.f};
    bf16x8 At[4][2], B0[2][2], B1[2][2];
    const char* cA = pickA(g, cur.sub) + (size_t)cur.pm * tstep; const char* cB = pickB(g, cur.sub) + (size_t)cur.pn * tstep;
    PG8_STAGE(PG8_SB(0, 0), cB, voffB); PG8_STAGE(PG8_SB(0, 1), cB + hstep, voffB); PG8_STAGE(PG8_SA(0, 0), cA, voffA); PG8_STAGE(PG8_SA(0, 1), cA + hstep, voffA);
    pre();
    if (wr == 1) PG8_BAR;
    PG8_WAIT_V(2); PG8_BAR;
    PG8_STAGE(PG8_SB(1, 0), cB + kstep, voffB); PG8_STAGE(PG8_SA(1, 0), cA + kstep, voffA); PG8_STAGE(PG8_SB(1, 1), cB + hstep + kstep, voffB);
    PG8_WAIT_V(6); PG8_BAR;
    for (;;) {
        const bool has_next = S.template next<NSUB>(ui + 1, nxt);
        const char* nA = has_next ? pickA(g, nxt.sub) + (size_t)nxt.pm * tstep : cA; const char* nB = has_next ? pickB(g, nxt.sub) + (size_t)nxt.pn * tstep : cB;
        for (int t = 0; t < nt; t += 2) {
            const bool last = (t == nt - 2);
            const char* a1 = cA + (size_t)(t + 1) * kstep;
            const char* a2 = last ? nA : cA + (size_t)(t + 2) * kstep; const char* b2 = last ? nB : cB + (size_t)(t + 2) * kstep;
            const char* a3 = a2 + kstep; const char* b3 = b2 + kstep;
            PG8_LDB(B0, 0, 0); PG8_LDB(B1, 0, 1); PG8_SCHED; PG8_LDA(At, 0, 0); PG8_STAGE(PG8_SA(1, 1), a1 + hstep, voffA);
            PG8_WAIT_V(8); PG8_WAIT_L(0); PG8_BAR; PG8_MMA(0, 0, At, B0); PG8_MMA(0, 1, At, B1); PG8_BAR; PG8_SCHED;
            PG8_LDA(At, 0, 1); PG8_STAGE(PG8_SB(0, 0), b2, voffB); PG8_STAGE(PG8_SB(0, 1), b2 + hstep, voffB); PG8_STAGE(PG8_SA(0, 0), a2, voffA);
            PG8_WAIT_V(8); PG8_WAIT_L(0); PG8_BAR; PG8_MMA(1, 0, At, B0); PG8_MMA(1, 1, At, B1); PG8_BAR; PG8_SCHED;
            PG8_LDB(B0, 1, 0); PG8_LDB(B1, 1, 1); PG8_SCHED; PG8_LDA(At, 1, 0); PG8_STAGE(PG8_SA(0, 1), a2 + hstep, voffA);
            PG8_WAIT_V(8); PG8_WAIT_L(0); PG8_BAR; PG8_MMA(0, 0, At, B0); PG8_MMA(0, 1, At, B1); PG8_BAR; PG8_SCHED;
            PG8_LDA(At, 1, 1); PG8_STAGE(PG8_SB(1, 0), b3, voffB); PG8_STAGE(PG8_SB(1, 1), b3 + hstep, voffB); PG8_STAGE(PG8_SA(1, 0), a3, voffA);
            PG8_WAIT_V(8); PG8_WAIT_L(0); PG8_BAR; PG8_MMA(1, 0, At, B0); PG8_MMA(1, 1, At, B1); PG8_BAR; PG8_SCHED;
        }
        if (wr == 0) PG8_BAR;
        { int l_ = tid; asm volatile("" : "+v"(l_)); const int fr_ = l_ & 15, fq_ = (l_ >> 4) & 3;
          E(acc, cur, wr, wc, fr_, fq_); }
        if (!has_next) break;
        cur = nxt; cA = nA; cB = nB; ++ui;
        if (wr == 1) PG8_BAR;
    }
    PG8_WAIT_V(0);
    PG8_BAR;
#undef PG8_SA
#undef PG8_SB
#undef PG8_STAGE
#undef PG8_LDA
#undef PG8_LDB
#undef PG8_MMA
#undef PG8_WAIT_V
#undef PG8_WAIT_L
#undef PG8_BAR
#undef PG8_SCHED
}
}

namespace epi {
using pg8::Unit;
__device__ __forceinline__ float log2_gamma_w(int h) { return __builtin_amdgcn_logf(1.0f - __builtin_amdgcn_exp2f(-5.0f - (float)h)); }
typedef f32x4 Acc[2][2][4][2];
#define ACC_ZERO(acc) do { _Pragma("unroll") for (int a_ = 0; a_ < 2; ++a_) _Pragma("unroll") for (int b_ = 0; b_ < 2; ++b_) _Pragma("unroll") for (int m_ = 0; m_ < 4; ++m_) \
    _Pragma("unroll") for (int n_ = 0; n_ < 2; ++n_) acc[a_][b_][m_][n_] = (f32x4){0.f, 0.f, 0.f, 0.f}; } while (0)

__device__ __forceinline__ float dot4(const f32x4 a) { return (a[0] * a[0] + a[1] * a[1]) + (a[2] * a[2] + a[3] * a[3]); }
__device__ __forceinline__ u32x4 pack8(const f32x4 a, const f32x4 b) { u32x4 w; w.x = cvt_pk_bf16(a[0], a[1]); w.y = cvt_pk_bf16(a[2], a[3]); w.z = cvt_pk_bf16(b[0], b[1]); w.w = cvt_pk_bf16(b[2], b[3]); return w; }
constexpr int EPI_RSTD_OFF = 132096, EPI_GAIN_OFF = EPI_RSTD_OFF + 8 * 256 * 4, EPI_ROPE_OFF = EPI_GAIN_OFF + 4 * 64 * 4, EPI_END = EPI_ROPE_OFF + 128;
__device__ __forceinline__ void fill_rstd_table(LAS unsigned char* lds0, const int tid, const float* ssq, const pg8::StaticOrder& S) {
    LAS float* tab = (LAS float*)(lds0 + EPI_RSTD_OFF);
    const int row = tid >> 1, half = tid & 1;
    f32x4 a[8], b[8]; bool ok[8];
#pragma unroll
    for (int i = 0; i < 8; ++i) {
        Unit u; ok[i] = S.next(i, u);
        const float* p = ssq + ((size_t)(ok[i] ? u.pm : 0) * 256 + row) * 16 + half * 8;
        a[i] = *(const f32x4*)p; b[i] = *(const f32x4*)(p + 4);
    }
#pragma unroll
    for (int i = 0; i < 8; ++i) {
        float s = ((a[i][0] + a[i][1]) + (a[i][2] + a[i][3])) + ((b[i][0] + b[i][1]) + (b[i][2] + b[i][3])); s = xor_add<1>(s);
        if (half == 0 && ok[i]) tab[i * 256 + row] = __builtin_amdgcn_rsqf(s * (1.0f / DM) + EPS);
    }
}
__device__ __forceinline__ float row_rstd(const LAS float* tab, int ui, int lrow) { return tab[ui * 256 + lrow]; }

struct EpiNull {
    __device__ __forceinline__ void operator()(Acc& acc, const Unit& u, int wr, int wc, int fr, int fq) const {
#pragma unroll
        for (int ai = 0; ai < 2; ++ai)
#pragma unroll
            for (int bj = 0; bj < 2; ++bj)
#pragma unroll
                for (int m = 0; m < 4; ++m) { asm volatile("" : "+v"(acc[ai][bj][m][0]), "+v"(acc[ai][bj][m][1])); }
        ACC_ZERO(acc);
    }
};
struct EpiUp {
    bf16_t* H; const LAS float* rst;
    __device__ __forceinline__ void operator()(Acc& acc, const Unit& u, int wr, int wc, int fr, int fq) const {
#pragma unroll
        for (int ai = 0; ai < 2; ++ai)
#pragma unroll
            for (int m = 0; m < 4; ++m) {
                const int lrow = ai * 128 + wr * 64 + m * 16 + fr, row = u.pm * 256 + lrow;
                const float rs = row_rstd(rst, u.ui, lrow);
                f32x4 h0, h1;
#pragma unroll
                for (int j = 0; j < 4; ++j) { h0[j] = silu_f(acc[ai][0][m][0][j] * rs) * (acc[ai][1][m][0][j] * rs); h1[j] = silu_f(acc[ai][0][m][1][j] * rs) * (acc[ai][1][m][1][j] * rs); }
                *(u32x4*)(H + (size_t)row * DFF + u.pn * 128 + wc * 32 + 8 * fq) = pack8(h0, h1);
            }
        ACC_ZERO(acc);
    }
};

struct EpiRes {
    const float* xold; float* xnew; bf16_t* xb; float* ssq; float s;
    __device__ __forceinline__ void operator()(Acc& acc, const Unit& u, int wr, int wc, int fr, int fq) const {
#pragma unroll
        for (int ai = 0; ai < 2; ++ai) {
            f32x4 ov[4][2][2];
#pragma unroll
            for (int m = 0; m < 4; ++m)
#pragma unroll
                for (int bj = 0; bj < 2; ++bj) { const size_t off = (size_t)(u.pm * 256 + ai * 128 + wr * 64 + m * 16 + fr) * DM + u.pn * 256 + bj * 128 + wc * 32 + 8 * fq;
                    ov[m][bj][0] = *(const f32x4*)(xold + off); ov[m][bj][1] = *(const f32x4*)(xold + off + 4); }
            asm volatile("" ::: "memory");
#pragma unroll
            for (int m = 0; m < 4; ++m) {
                const int row = u.pm * 256 + ai * 128 + wr * 64 + m * 16 + fr; float ss = 0.f;
#pragma unroll
                for (int bj = 0; bj < 2; ++bj) {
                    const size_t off = (size_t)row * DM + u.pn * 256 + bj * 128 + wc * 32 + 8 * fq;
                    const f32x4 v0 = ov[m][bj][0] + acc[ai][bj][m][0] * s, v1 = ov[m][bj][1] + acc[ai][bj][m][1] * s;
                    *(f32x4*)(xnew + off) = v0; *(f32x4*)(xnew + off + 4) = v1;
                    *(u32x4*)(xb + off) = pack8(v0, v1);
                    ss += dot4(v0) + dot4(v1);
                }
                ss = xor_add<16>(ss); ss = xor_add<32>(ss);
                if (fq == 0) ssq[(size_t)row * 16 + u.pn * 4 + wc] = ss;
            }
            asm volatile("" ::: "memory");
        }
        ACC_ZERO(acc);
    }
};

struct EpiGate {
    bf16_t* G; const LAS float* rst;
    __device__ __forceinline__ void operator()(Acc& acc, const Unit& u, int wr, int wc, int fr, int fq) const {
#pragma unroll
        for (int ai = 0; ai < 2; ++ai)
#pragma unroll
            for (int m = 0; m < 4; ++m) {
                const int lrow = ai * 128 + wr * 64 + m * 16 + fr, row = u.pm * 256 + lrow;
                const float rs = row_rstd(rst, u.ui, lrow);
#pragma unroll
                for (int bj = 0; bj < 2; ++bj) { f32x4 g0, g1;
#pragma unroll
                    for (int j = 0; j < 4; ++j) { g0[j] = fmaxf(sigmoid_f(acc[ai][bj][m][0][j] * rs), 9.5367431640625e-07f); g1[j] = fmaxf(sigmoid_f(acc[ai][bj][m][1][j] * rs), 9.5367431640625e-07f); }
                    *(u32x4*)(G + (size_t)row * NGATE + u.sub * 1024 + u.pn * 256 + bj * 128 + wc * 32 + 8 * fq) = pack8(g0, g1); }
            }
        ACC_ZERO(acc);
    }
};

struct EpiMerge {
    const bf16_t* G; bf16_t* MG; const unsigned* ones;
    __device__ __forceinline__ void operator()(Acc& acc, const Unit& u, int wr, int wc, int fr, int fq) const {
        const int sub = u.sub; const bool chain = sub < 2;
        const char* gb = (const char*)(G + (size_t)u.pm * 256 * NGATE + sub * 1024 + u.pn * 256);
        const char* nb = chain ? gb + 2048 : (const char*)ones; const unsigned nmask = chain ? 0xffffffffu : 0u;
        const unsigned go = (unsigned)((wr * 64 + fr) * NGATE + wc * 32 + 8 * fq) * 2u;
#pragma unroll
        for (int ai = 0; ai < 2; ++ai)
#pragma unroll
            for (int mh = 0; mh < 2; ++mh) {
                u32x4 gc[2][2], gn[2][2];
#pragma unroll
                for (int m2 = 0; m2 < 2; ++m2)
#pragma unroll
                    for (int bj = 0; bj < 2; ++bj) { const unsigned o = go + (unsigned)(((ai * 128 + (2 * mh + m2) * 16) * NGATE + bj * 128) * 2);
                        gc[m2][bj] = *(const u32x4*)(gb + o); gn[m2][bj] = *(const u32x4*)(nb + (o & nmask)); }
                asm volatile("" ::: "memory");
#pragma unroll
                for (int m2 = 0; m2 < 2; ++m2)
#pragma unroll
                    for (int bj = 0; bj < 2; ++bj) { const u32x4 c = gc[m2][bj], n = gn[m2][bj]; const int m = 2 * mh + m2;
                        const f32x4 c0 = {bflo(c.x), bfhi(c.x), bflo(c.y), bfhi(c.y)}, c1 = {bflo(c.z), bfhi(c.z), bflo(c.w), bfhi(c.w)};
                        const f32x4 n0 = {bflo(n.x), bfhi(n.x), bflo(n.y), bfhi(n.y)}, n1 = {bflo(n.z), bfhi(n.z), bflo(n.w), bfhi(n.w)};
#pragma unroll
                        for (int j = 0; j < 4; ++j) { acc[ai][bj][m][0][j] *= c0[j] * fast_rcp(n0[j]); acc[ai][bj][m][1][j] *= c1[j] * fast_rcp(n1[j]); } }
                asm volatile("" ::: "memory");
            }
        if (!chain) {
            char* mb = (char*)(MG + (size_t)u.pm * 256 * DM + u.pn * 256);
            const unsigned mo = (unsigned)((wr * 64 + fr) * DM + wc * 32 + 8 * fq) * 2u;
#pragma unroll
            for (int ai = 0; ai < 2; ++ai)
#pragma unroll
                for (int m = 0; m < 4; ++m)
#pragma unroll
                    for (int bj = 0; bj < 2; ++bj)
                        *(u32x4*)(mb + mo + (unsigned)(((ai * 128 + m * 16) * DM + bj * 128) * 2)) = pack8(acc[ai][bj][m][0], acc[ai][bj][m][1]);
            ACC_ZERO(acc);
        }
    }
};

enum { F_NORM = 1, F_ROPE = 2, F_C2 = 4, F_CKD = 8, F_SILU = 16 };
struct EpiWin {
    unsigned char* ws; const LAS float* rst; const LAS float* gtab; const LAS float* rtab;
    template <int FLAGS>
    __device__ __forceinline__ void body(Acc& acc, const Unit& u, int wr, int wc, int fr, int fq, bf16_t* out, int pitch, int colbase, int gk) const {
        f32x4 gA0 = {1.f, 1.f, 1.f, 1.f}, gA1 = gA0, gB0 = gA0, gB1 = gA0;
        if (FLAGS & F_NORM) { const LAS float* gain = gtab + gk * 64; gA0 = *(const LAS f32x4*)(gain + 8 * fq); gA1 = *(const LAS f32x4*)(gain + 8 * fq + 4); gB0 = *(const LAS f32x4*)(gain + 32 + 8 * fq); gB1 = *(const LAS f32x4*)(gain + 36 + 8 * fq); }
        f32x4 rc0 = {0.f, 0.f, 0.f, 0.f}, rc1 = rc0;
        if (FLAGS & F_ROPE) { rc0 = *(const LAS f32x4*)(rtab + 8 * fq); rc1 = *(const LAS f32x4*)(rtab + 8 * fq + 4); }
        const float l2g = (FLAGS & F_CKD) ? log2_gamma_w(wc) : 0.f;
#pragma unroll
        for (int ai = 0; ai < 2; ++ai)
#pragma unroll
            for (int m = 0; m < 4; ++m) {
                const int lrow = ai * 128 + wr * 64 + m * 16 + fr, row = u.pm * 256 + lrow, t = row & (SEQ - 1);
                const float rs = row_rstd(rst, u.ui, lrow);
                f32x4 a0 = acc[ai][0][m][0] * rs, a1 = acc[ai][0][m][1] * rs, b0 = acc[ai][1][m][0] * rs, b1 = acc[ai][1][m][1] * rs;
                if (FLAGS & F_NORM) {
                    float ss = (dot4(a0) + dot4(a1)) + (dot4(b0) + dot4(b1)); ss = xor_add<16>(ss); ss = xor_add<32>(ss);
                    const float r = __builtin_amdgcn_rsqf(ss * (1.0f / 64.0f) + EPS);
                    a0 = a0 * gA0 * r; a1 = a1 * gA1 * r; b0 = b0 * gB0 * r; b1 = b1 * gB1 * r;
                }
                if (FLAGS & F_ROPE) {
                    const float tf = (float)t; f32x4 c0, c1, s0, s1;
#pragma unroll
                    for (int j = 0; j < 4; ++j) { const float r0 = __builtin_amdgcn_fractf(tf * rc0[j]), r1 = __builtin_amdgcn_fractf(tf * rc1[j]);
                        c0[j] = __builtin_amdgcn_cosf(r0); s0[j] = __builtin_amdgcn_sinf(r0); c1[j] = __builtin_amdgcn_cosf(r1); s1[j] = __builtin_amdgcn_sinf(r1); }
                    const f32x4 na0 = a0 * c0 - b0 * s0, nb0 = b0 * c0 + a0 * s0, na1 = a1 * c1 - b1 * s1, nb1 = b1 * c1 + a1 * s1;
                    a0 = na0; b0 = nb0; a1 = na1; b1 = nb1;
                }
                if (FLAGS & (F_C2 | F_CKD)) {
                    const float sc = (FLAGS & F_C2) ? C2 : 0.125f * fast_exp2(-(float)(t & 63) * l2g);
                    a0 = a0 * sc; a1 = a1 * sc; b0 = b0 * sc; b1 = b1 * sc;
                }
                if (FLAGS & F_SILU) {
#pragma unroll
                    for (int j = 0; j < 4; ++j) { a0[j] = silu_f(a0[j]); a1[j] = silu_f(a1[j]); b0[j] = silu_f(b0[j]); b1[j] = silu_f(b1[j]); }
                }
                bf16_t* o = out + (size_t)row * pitch + colbase + 64 * wc + 8 * fq;
                *(u32x4*)o = pack8(a0, a1); *(u32x4*)(o + 32) = pack8(b0, b1);
            }
        ACC_ZERO(acc);
    }
    __device__ __forceinline__ void operator()(Acc& acc, const Unit& u, int wr, int wc, int fr, int fq) const {
        const int pn = u.pn;
        if (pn < 2)        body<F_NORM | F_ROPE | F_C2>(acc, u, wr, wc, fr, fq, (bf16_t*)(ws + WS_AQ), 512, 256 * pn, 0);
        else if (pn < 4)   body<F_NORM | F_ROPE>(acc, u, wr, wc, fr, fq, (bf16_t*)(ws + WS_AK), 512, 256 * (pn - 2), 1);
        else if (pn < 6)   body<0>(acc, u, wr, wc, fr, fq, (bf16_t*)(ws + WS_AV), 512, 256 * (pn - 4), 0);
        else if (pn < 8)   body<F_NORM | F_C2>(acc, u, wr, wc, fr, fq, (bf16_t*)(ws + WS_BQ), 512, 256 * (pn - 6), 2);
        else if (pn < 10)  body<F_NORM>(acc, u, wr, wc, fr, fq, (bf16_t*)(ws + WS_BK), 512, 256 * (pn - 8), 3);
        else if (pn < 12)  body<0>(acc, u, wr, wc, fr, fq, (bf16_t*)(ws + WS_BV), 512, 256 * (pn - 10), 0);
        else if (pn == 12) body<F_ROPE>(acc, u, wr, wc, fr, fq, (bf16_t*)(ws + WS_CQ), 256, 0, 0);
        else if (pn == 13) body<F_ROPE | F_CKD>(acc, u, wr, wc, fr, fq, (bf16_t*)(ws + WS_CK), 256, 0, 0);
        else if (pn < 16)  body<0>(acc, u, wr, wc, fr, fq, (bf16_t*)(ws + WS_CV), 512, 256 * (pn - 14), 0);
        else               body<F_SILU>(acc, u, wr, wc, fr, fq, (bf16_t*)(ws + WS_CG), 512, 256 * (pn - 16), 0);
    }
};
}

__device__ __forceinline__ float log2_gamma(int h) { return __builtin_amdgcn_logf(1.0f - __builtin_amdgcn_exp2f(-5.0f - (float)h)); }

namespace naive {
struct ANorm {
    const float* x; const float* gain; const LAS float* rs; int m0;
    __device__ __forceinline__ float get(int m, int k) const { return x[(size_t)m * DM + k] * rs[m - m0] * gain[k]; }
};
struct ABf {
    const bf16_t* a; int pitch;
    __device__ __forceinline__ float get(int m, int k) const { return bf2f(a[(size_t)m * pitch + k]); }
};
template <int NB, bool SHARED_A, bool NORM, int RT, class Epi>
__device__ __forceinline__ void gemm(LAS unsigned char* lds, const int tid, int vcu, int G, int N, int K,
                                     const float* x, const float* gain, const bf16_t* a0, const bf16_t* a1, const bf16_t* a2, int apitch,
                                     const float* w0, const float* w1, const float* w2, int ldb, const Epi& E) {
    constexpr int NA = SHARED_A ? 1 : NB;
    LAS float* As = (LAS float*)lds;
    LAS float* Bs = As + NA * 16 * 132;
    LAS float* rs = Bs + NB * 16 * 128;
    const int tx = tid & 15, ty = tid >> 4, lane = tid & 63, wave = tid >> 6;
    constexpr int TM = 32 * RT;
    const int ntn = N / 128, ntiles = (M / TM) * ntn;
    for (int tile = vcu; tile < ntiles; tile += G) {
        const int m0 = (tile / ntn) * TM, n0 = (tile % ntn) * 128;
        __syncthreads();
        if (NORM) {
            for (int r = wave * (TM / 8); r < wave * (TM / 8) + TM / 8; ++r) {
                const float* xr = x + (size_t)(m0 + r) * DM; float s = 0.f;
                for (int k = lane; k < DM; k += 64) { const float v = xr[k]; s += v * v; }
                s = wave_sum(s);
                if (lane == 0) rs[r] = 1.0f / sqrtf(s * (1.0f / DM) + EPS);
            }
            __syncthreads();
        }
        float acc[NB][RT][8];
#pragma unroll
        for (int b = 0; b < NB; ++b)
#pragma unroll
            for (int i = 0; i < RT; ++i)
#pragma unroll
                for (int j = 0; j < 8; ++j) acc[b][i][j] = 0.f;
        for (int k0 = 0; k0 < K; k0 += 16) {
            {
                const int r = tid >> 2, kq = (tid & 3) * 4;
                if (r < TM)
#pragma unroll
                for (int b = 0; b < NA; ++b)
#pragma unroll
                    for (int i = 0; i < 4; ++i) {
                        float v;
                        if (NORM) v = x[(size_t)(m0 + r) * DM + k0 + kq + i] * rs[r] * gain[k0 + kq + i];
                        else { const bf16_t* ap = (b == 0 ? a0 : (b == 1 ? a1 : a2)); v = bf2f(ap[(size_t)(m0 + r) * apitch + k0 + kq + i]); }
                        As[(b * 16 + kq + i) * 132 + r] = v;
                    }
                const int kb = tid >> 5, n4 = (tid & 31) * 4;
#pragma unroll
                for (int b = 0; b < NB; ++b) { const float* wp = (b == 0 ? w0 : (b == 1 ? w1 : w2));
                    const f32x4 v = *(const f32x4*)(wp + (size_t)(k0 + kb) * ldb + n0 + n4);
                    *(LAS f32x4*)(Bs + (b * 16 + kb) * 128 + n4) = v; }
            }
            __syncthreads();
#pragma unroll
            for (int kk = 0; kk < 16; ++kk) {
#pragma unroll
                for (int b = 0; b < NB; ++b) {
                    const int ab = SHARED_A ? 0 : b;
                    float av[RT];
#pragma unroll
                    for (int i = 0; i < RT; ++i) av[i] = As[(ab * 16 + kk) * 132 + ty * RT + i];
                    const f32x4 b0 = *(const LAS f32x4*)(Bs + (b * 16 + kk) * 128 + tx * 8), b1 = *(const LAS f32x4*)(Bs + (b * 16 + kk) * 128 + tx * 8 + 4);
#pragma unroll
                    for (int i = 0; i < RT; ++i)
#pragma unroll
                        for (int j = 0; j < 4; ++j) { acc[b][i][j] += av[i] * b0[j]; acc[b][i][4 + j] += av[i] * b1[j]; }
                }
            }
            __syncthreads();
        }
#pragma unroll
        for (int i = 0; i < RT; ++i) E(m0 + ty * RT + i, n0 + tx * 8, acc, i, tx);
    }
}

__device__ __forceinline__ void xb_ssq_pass(const float* x, bf16_t* xb, float* ssq, int gw, int ngw, int lane) {
    for (int m0 = gw * 4; m0 < M; m0 += ngw * 4) {
        f32x4 v[4][4];
#pragma unroll
        for (int r = 0; r < 4; ++r)
#pragma unroll
            for (int j = 0; j < 4; ++j) v[r][j] = ((const f32x4*)(x + (size_t)(m0 + r) * DM) + lane)[64 * j];
#pragma unroll
        for (int r = 0; r < 4; ++r) {
            float s = 0.f; u32x2* o = (u32x2*)(xb + (size_t)(m0 + r) * DM) + lane;
#pragma unroll
            for (int j = 0; j < 4; ++j) { const f32x4 w4 = v[r][j]; s += (w4[0] * w4[0] + w4[1] * w4[1]) + (w4[2] * w4[2] + w4[3] * w4[3]); u32x2 w; w.x = pk2(w4[0], w4[1]); w.y = pk2(w4[2], w4[3]); o[64 * j] = w; }
            s = wave_sum(s);
            if (lane < 16) ssq[(size_t)(m0 + r) * 16 + lane] = (lane == 0) ? s : 0.f;
        }
    }
}

struct NEpiUp { bf16_t* H;
    __device__ __forceinline__ void operator()(int m, int n, const float (&acc)[2][4][8], int i, int tx) const {
#pragma unroll
        for (int j = 0; j < 8; ++j) { const float g = acc[0][i][j], u = acc[1][i][j]; H[(size_t)m * DFF + n + j] = (bf16_t)f2bf(g / (1.0f + expf(-g)) * u); } } };
struct NEpiRes { const float* xold; float* xnew; bf16_t* xb; float* ssq; float s;
    __device__ __forceinline__ void operator()(int m, int n, const float (&acc)[1][4][8], int i, int tx) const {
        float ss = 0.f;
#pragma unroll
        for (int j = 0; j < 8; ++j) { const float v = xold[(size_t)m * DM + n + j] + s * acc[0][i][j]; xnew[(size_t)m * DM + n + j] = v; xb[(size_t)m * DM + n + j] = (bf16_t)f2bf(v); ss += v * v; }
        ss += __shfl_xor(ss, 1); ss += __shfl_xor(ss, 2); ss += __shfl_xor(ss, 4); ss += __shfl_xor(ss, 8);
        if (tx == 0) { ssq[(size_t)m * 16 + (n >> 7)] = ss; ssq[(size_t)m * 16 + 8 + (n >> 7)] = 0.f; }
    } };
struct NEpiGate { bf16_t* G;
    __device__ __forceinline__ void operator()(int m, int n, const float (&acc)[1][4][8], int i, int tx) const {
#pragma unroll
        for (int j = 0; j < 8; ++j) G[(size_t)m * NGATE + n + j] = (bf16_t)f2bf(fmaxf(1.0f / (1.0f + expf(-acc[0][i][j])), 9.5367431640625e-07f)); } };
struct NEpiMerge { const bf16_t* G; bf16_t* MG;
    __device__ __forceinline__ void operator()(int m, int n, const float (&acc)[3][2][8], int i, int tx) const {
#pragma unroll
        for (int j = 0; j < 8; ++j) { const size_t go = (size_t)m * NGATE + n + j;
            const float v = bf2f(G[go]) * acc[0][i][j] + bf2f(G[go + 1024]) * acc[1][i][j] + bf2f(G[go + 2048]) * acc[2][i][j];
            MG[(size_t)m * DM + n + j] = (bf16_t)f2bf(v); } } };
struct NEpiWin { unsigned char* ws; const float* cosT; const float* sinT; const float *aqn, *akn, *bqn, *bkn;
    __device__ __forceinline__ void operator()(int m, int n, const float (&acc)[1][4][8], int i, int tx) const {
        size_t obase; int pitch, c0, flags; const float* gain = nullptr;
        if (n < 512)       { obase = WS_AQ; pitch = 512; c0 = 0;    flags = epi::F_NORM | epi::F_ROPE | epi::F_C2; gain = aqn; }
        else if (n < 1024) { obase = WS_AK; pitch = 512; c0 = 512;  flags = epi::F_NORM | epi::F_ROPE; gain = akn; }
        else if (n < 1536) { obase = WS_AV; pitch = 512; c0 = 1024; flags = 0; }
        else if (n < 2048) { obase = WS_BQ; pitch = 512; c0 = 1536; flags = epi::F_NORM | epi::F_C2; gain = bqn; }
        else if (n < 2560) { obase = WS_BK; pitch = 512; c0 = 2048; flags = epi::F_NORM; gain = bkn; }
        else if (n < 3072) { obase = WS_BV; pitch = 512; c0 = 2560; flags = 0; }
        else if (n < 3328) { obase = WS_CQ; pitch = 256; c0 = 3072; flags = epi::F_ROPE; }
        else if (n < 3584) { obase = WS_CK; pitch = 256; c0 = 3328; flags = epi::F_ROPE | epi::F_CKD; }
        else if (n < 4096) { obase = WS_CV; pitch = 512; c0 = 3584; flags = 0; }
        else               { obase = WS_CG; pitch = 512; c0 = 4096; flags = epi::F_SILU; }
        const int t = m & (SEQ - 1), d0 = n & 63; float v[8];
#pragma unroll
        for (int j = 0; j < 8; ++j) v[j] = acc[0][i][j];
        if (flags & epi::F_NORM) { float ss = 0.f;
#pragma unroll
            for (int j = 0; j < 8; ++j) ss += v[j] * v[j];
            ss += __shfl_xor(ss, 1); ss += __shfl_xor(ss, 2); ss += __shfl_xor(ss, 4);
            const float r = 1.0f / sqrtf(ss * (1.0f / 64.0f) + EPS);
#pragma unroll
            for (int j = 0; j < 8; ++j) v[j] = v[j] * r * gain[d0 + j]; }
        if (flags & epi::F_ROPE) {
#pragma unroll
            for (int j = 0; j < 8; ++j) { const float p = __shfl_xor(v[j], 4); const int d = d0 + j, ii = d & 31; const float c = cosT[t * 32 + ii], s = sinT[t * 32 + ii];
                v[j] = (d < 32) ? (v[j] * c - p * s) : (v[j] * c + p * s); } }
        float sc = 1.0f;
        if (flags & epi::F_C2) sc = C2;
        if (flags & epi::F_CKD) sc = 0.125f * exp2f(-(float)(t & 63) * log2_gamma((n - 3328) >> 6));
        bf16_t* o = (bf16_t*)(ws + obase) + (size_t)m * pitch + (n - c0);
#pragma unroll
        for (int j = 0; j < 8; ++j) { float y = v[j] * sc; if (flags & epi::F_SILU) y = y / (1.0f + expf(-y)); o[j] = (bf16_t)f2bf(y); }
    } };

__device__ __forceinline__ void attn_a(unsigned char* ws, const float* lq1, const float* lk1, const float* lq2, const float* lk2, const float* subln, float lam_init,
                                       LAS unsigned char* lds, int gw, int ngw, int wave, int lane) {
    const bf16_t* AQ = (const bf16_t*)(ws + WS_AQ); const bf16_t* AK = (const bf16_t*)(ws + WS_AK); const bf16_t* AV = (const bf16_t*)(ws + WS_AV); bf16_t* YA = (bf16_t*)(ws + WS_AQ);
    const float lam = expf(wave_sum(lq1[lane] * lk1[lane])) - expf(wave_sum(lq2[lane] * lk2[lane])) + lam_init;
    LAS float* qs = (LAS float*)lds + wave * 128;
    for (int task = gw; task < M * 4; task += ngw) {
        const int h = task & 3, m = task >> 2, b = m >> 13, t = m & (SEQ - 1), nch = (t >> 6) + 1;
        qs[lane] = bf2f(AQ[(size_t)m * 512 + h * 128 + lane]); qs[64 + lane] = bf2f(AQ[(size_t)m * 512 + h * 128 + 64 + lane]);
        LDS_WAIT(); asm volatile("" ::: "memory");
        float mx[2] = {-1e30f, -1e30f}, l[2] = {0.f, 0.f}, o[2][2] = {{0.f, 0.f}, {0.f, 0.f}};
        for (int c = 0; c < nch; ++c) {
            const size_t krow = (size_t)(b * SEQ + c * 64 + lane);
            float s[2] = {0.f, 0.f};
            for (int cc = 0; cc < 2; ++cc) { const u32x4* kp = (const u32x4*)(AK + krow * 512 + h * 128 + cc * 64);
                for (int q = 0; q < 8; ++q) { const u32x4 w = kp[q]; const LAS float* qq = qs + cc * 64 + q * 8;
                    s[cc] += bflo(w.x) * qq[0] + bfhi(w.x) * qq[1] + bflo(w.y) * qq[2] + bfhi(w.y) * qq[3] + bflo(w.z) * qq[4] + bfhi(w.z) * qq[5] + bflo(w.w) * qq[6] + bfhi(w.w) * qq[7]; } }
            float p[2];
            for (int cc = 0; cc < 2; ++cc) { const float mn = fmaxf(mx[cc], wave_max(s[cc])), f = exp2f(mx[cc] - mn); mx[cc] = mn; p[cc] = exp2f(s[cc] - mn);
                l[cc] = l[cc] * f + wave_sum(p[cc]); o[cc][0] *= f; o[cc][1] *= f; }
            for (int j = 0; j < 64; ++j) { const float p0 = __shfl(p[0], j), p1 = __shfl(p[1], j); const size_t vrow = (size_t)(b * SEQ + c * 64 + j) * 512 + h * 128;
                const float v0 = bf2f(AV[vrow + lane]), v1 = bf2f(AV[vrow + 64 + lane]);
                o[0][0] += p0 * v0; o[0][1] += p0 * v1; o[1][0] += p1 * v0; o[1][1] += p1 * v1; }
        }
        const float y0 = o[0][0] / l[0] - lam * o[1][0] / l[1], y1 = o[0][1] / l[0] - lam * o[1][1] / l[1];
        const float r = 1.0f / sqrtf(wave_sum(y0 * y0 + y1 * y1) * (1.0f / 128.0f) + EPS) * (1.0f - lam_init);
        YA[(size_t)m * 512 + h * 128 + lane] = (bf16_t)f2bf(y0 * r * subln[lane]); YA[(size_t)m * 512 + h * 128 + 64 + lane] = (bf16_t)f2bf(y1 * r * subln[64 + lane]);
        asm volatile("" ::: "memory");
    }
}
__device__ __forceinline__ void attn_b(unsigned char* ws, const float* relb, LAS unsigned char* lds, int gw, int ngw, int wave, int lane) {
    const bf16_t* BQ = (const bf16_t*)(ws + WS_BQ); const bf16_t* BK = (const bf16_t*)(ws + WS_BK); const bf16_t* BV = (const bf16_t*)(ws + WS_BV); bf16_t* YB = (bf16_t*)(ws + WS_BQ);
    LAS float* qs = (LAS float*)lds + wave * 128;
    for (int task = gw; task < M * 8; task += ngw) {
        const int h = task & 7, m = task >> 3, b = m >> 13, t = m & (SEQ - 1), n = t >> 6;
        qs[lane] = bf2f(BQ[(size_t)m * 512 + h * 64 + lane]);
        LDS_WAIT(); asm volatile("" ::: "memory");
        float mx = -1e30f, l = 0.f, o = 0.f;
        for (int c = (n >= 8 ? n - 8 : 0); c <= n; ++c) {
            const int kpos = c * 64 + lane; const size_t krow = (size_t)(b * SEQ + kpos);
            float s = 0.f; const u32x4* kp = (const u32x4*)(BK + krow * 512 + h * 64);
            for (int q = 0; q < 8; ++q) { const u32x4 w = kp[q]; const LAS float* qq = qs + q * 8;
                s += bflo(w.x) * qq[0] + bfhi(w.x) * qq[1] + bflo(w.y) * qq[2] + bfhi(w.y) * qq[3] + bflo(w.z) * qq[4] + bfhi(w.z) * qq[5] + bflo(w.w) * qq[6] + bfhi(w.w) * qq[7]; }
            int rel = t - kpos; rel = rel < -63 ? -63 : (rel > 256 ? 256 : rel);
            s += relb[h * 320 + rel + 63] * LOG2E;
            const float mn = fmaxf(mx, wave_max(s)), f = exp2f(mx - mn); mx = mn; const float p = exp2f(s - mn);
            l = l * f + wave_sum(p); o *= f;
            for (int j = 0; j < 64; ++j) o += __shfl(p, j) * bf2f(BV[(size_t)(b * SEQ + c * 64 + j) * 512 + h * 64 + lane]);
        }
        YB[(size_t)m * 512 + h * 64 + lane] = (bf16_t)f2bf(o / l);
        asm volatile("" ::: "memory");
    }
}
__device__ __forceinline__ void retention(unsigned char* ws, const float* onorm, LAS unsigned char* lds, int vcu, int G, int tid) {
    const bf16_t* CQ = (const bf16_t*)(ws + WS_CQ); const bf16_t* CK = (const bf16_t*)(ws + WS_CK); const bf16_t* CV = (const bf16_t*)(ws + WS_CV); bf16_t* CG = (bf16_t*)(ws + WS_CG);
    LAS float* qs = (LAS float*)lds; LAS float* ks = qs + 64 * 64; LAS float* vs = ks + 64 * 64; LAS float* os = vs + 64 * 128;
    for (int bh = vcu; bh < 8; bh += G) {
        const int b = bh >> 2, h = bh & 3; const float l2g = log2_gamma(h), gam = exp2f(l2g);
        float S[64];
#pragma unroll
        for (int d = 0; d < 64; ++d) S[d] = 0.f;
        for (int n = 0; n < SEQ / 64; ++n) {
            __syncthreads();
            for (int i = tid; i < 64 * 64; i += 512) { const int r = i >> 6, d = i & 63; const size_t row = (size_t)(b * SEQ + n * 64 + r);
                qs[i] = bf2f(CQ[row * 256 + h * 64 + d]); ks[i] = bf2f(CK[row * 256 + h * 64 + d]) * exp2f((float)r * l2g); }
            for (int i = tid; i < 64 * 128; i += 512) { const int r = i >> 7, e = i & 127; vs[i] = bf2f(CV[(size_t)(b * SEQ + n * 64 + r) * 512 + h * 128 + e]); }
            __syncthreads();
            if (tid < 128) {
                for (int r = 0; r < 64; ++r) { const float v = vs[r * 128 + tid]; float o = 0.f;
#pragma unroll
                    for (int d = 0; d < 64; ++d) { S[d] = gam * S[d] + ks[r * 64 + d] * v; o += qs[r * 64 + d] * S[d]; }
                    os[r * 128 + tid] = o; }
            }
            __syncthreads();
            { const int r = tid >> 3, e0 = (tid & 7) * 16; float ss = 0.f;
#pragma unroll
              for (int j = 0; j < 16; ++j) { const float v = os[r * 128 + e0 + j]; ss += v * v; }
              ss += __shfl_xor(ss, 1); ss += __shfl_xor(ss, 2); ss += __shfl_xor(ss, 4);
              const float rr = 1.0f / sqrtf(ss * (1.0f / 128.0f) + EPS); bf16_t* g = CG + (size_t)(b * SEQ + n * 64 + r) * 512 + h * 128 + e0;
#pragma unroll
              for (int j = 0; j < 16; ++j) g[j] = (bf16_t)f2bf(bf2f(g[j]) * os[r * 128 + e0 + j] * rr * onorm[h * 128 + e0 + j]); }
        }
    }
}
}

namespace fa {
typedef short s16x4 __attribute__((ext_vector_type(4)));
typedef short v4i16_t __attribute__((ext_vector_type(4)));
typedef LAS const unsigned char* lds_cptr;
constexpr int SLOTB = 32768, NSLOT = 3, KOFF = 0, VOFF = 16384;
constexpr int LDS_WS = NSLOT * SLOTB, LDS_BIAS = LDS_WS + 2048, LDS_END = LDS_BIAS + 2560;
constexpr float THR = 8.0f;
__device__ __forceinline__ int crow(int r, int hi) { return (r & 3) + 8 * (r >> 2) + 4 * hi; }
__device__ __forceinline__ void glds16(const void* gsrc, unsigned lds_dst) { unsigned keep;
    asm volatile("s_mov_b32 %0, m0\n\ts_mov_b32 m0, %2\n\ts_nop 0\n\tglobal_load_lds_dwordx4 %1, off\n\ts_mov_b32 m0, %0" : "=&s"(keep) : "v"(gsrc), "s"(lds_dst) : "memory"); }
__device__ __forceinline__ void glds16s(const void* sbase, unsigned voff, unsigned lds_dst) { unsigned keep;
    asm volatile("s_mov_b32 %0, m0\n\ts_mov_b32 m0, %3\n\ts_nop 0\n\tglobal_load_lds_dwordx4 %1, %2\n\ts_mov_b32 m0, %0" : "=&s"(keep) : "v"(voff), "s"(sbase), "s"(lds_dst) : "memory"); }
#define FA_WAIT_BAR(N) asm volatile("s_waitcnt vmcnt(" #N ") lgkmcnt(0)\n\ts_barrier" ::: "memory")
#define FA_BAR() asm volatile("s_waitcnt lgkmcnt(0)\n\ts_barrier" ::: "memory")
__device__ __forceinline__ s16x4 vtr(lds_cptr p) { return __builtin_bit_cast(s16x4, __builtin_amdgcn_ds_read_tr16_b64_v4i16((LAS v4i16_t*)p)); }
__device__ __forceinline__ bf16x8 cat8(const s16x4 lo, const s16x4 hi) { return (bf16x8){lo[0], lo[1], lo[2], lo[3], hi[0], hi[1], hi[2], hi[3]}; }
__device__ __forceinline__ float swapmax(float m) { auto rr = __builtin_amdgcn_permlane32_swap(__float_as_uint(m), __float_as_uint(m), false, false); return fmaxf(__uint_as_float(rr[0]), __uint_as_float(rr[1])); }
__device__ __forceinline__ float swapsum(float m) { auto rr = __builtin_amdgcn_permlane32_swap(__float_as_uint(m), __float_as_uint(m), false, false); return __uint_as_float(rr[0]) + __uint_as_float(rr[1]); }
__device__ __forceinline__ bf16x8 pack_p(const f32x16& p, int base) { u32x4 w; w.x = cvt_pk_bf16(p[base], p[base + 1]); w.y = cvt_pk_bf16(p[base + 2], p[base + 3]); w.z = cvt_pk_bf16(p[base + 4], p[base + 5]); w.w = cvt_pk_bf16(p[base + 6], p[base + 7]); return __builtin_bit_cast(bf16x8, w); }
__device__ __forceinline__ float half_sum32(float v) {
    v = xor_add<1>(v); v = xor_add<2>(v); v = xor_add<4>(v); v = xor_add<8>(v); return xor_add<16>(v);
}

template <int MODE>
__device__ __forceinline__ void attn_unit(LAS unsigned char* lds, const int tid, const bf16_t* Qg, const bf16_t* Kg, const bf16_t* Vg, bf16_t* Yg, const int b, const int hq, const int u,
                                          const float lam, const float osc, const float* subln) {
    constexpr int PITCH = 512, NDB = (MODE == 0) ? 4 : 2;
    const int lane = tid & 63, r32 = lane & 31, hi = lane >> 5, wid = __builtin_amdgcn_readfirstlane(tid >> 6), ch = wid >> 2, wq = wid & 3;
    const int cw = 2 * u + (wq >> 1);
    const int t0 = (MODE == 0) ? 0 : ((2 * u - 8) > 0 ? (2 * u - 8) : 0), t1 = 2 * u + 1, NT = t1 - t0 + 1;
    const size_t rowbase = (size_t)b * SEQ;
    const bf16_t* Kb = Kg + rowbase * PITCH + hq * 128; const bf16_t* Vb = Vg + rowbase * PITCH + hq * 128;
    const unsigned lds0 = (unsigned)(uintptr_t)lds;
    LAS float* wsf = (LAS float*)(lds + LDS_WS) + wid * 64;
    const bf16_t* ksrc = Kb + (size_t)lane * PITCH + (2 * wid) * 8;
    const bf16_t* vsrc0 = Vb + (size_t)(16 * ((2 * wid) & 3) + (lane >> 2)) * PITCH + 32 * ((2 * wid) >> 2) + (lane & 3) * 8;
    const bf16_t* vsrc1 = Vb + (size_t)(16 * ((2 * wid + 1) & 3) + (lane >> 2)) * PITCH + 32 * ((2 * wid + 1) >> 2) + (lane & 3) * 8;
#define FA_DMA(t, slot) do { const size_t to_ = (size_t)(t) * 64 * PITCH; const unsigned sb_ = lds0 + (unsigned)(slot) * SLOTB; \
        glds16(ksrc + to_, (unsigned)__builtin_amdgcn_readfirstlane(sb_ + KOFF + (2 * wid) * 1024)); glds16(ksrc + to_ + 8, (unsigned)__builtin_amdgcn_readfirstlane(sb_ + KOFF + (2 * wid + 1) * 1024)); \
        glds16(vsrc0 + to_, (unsigned)__builtin_amdgcn_readfirstlane(sb_ + VOFF + (2 * wid) * 1024)); glds16(vsrc1 + to_, (unsigned)__builtin_amdgcn_readfirstlane(sb_ + VOFF + (2 * wid + 1) * 1024)); } while (0)
    FA_DMA(t0, 0);
    if (NT > 1) FA_DMA(t0 + 1, 1);
    const size_t qrow = rowbase + (size_t)u * 128 + wq * 32;
    bf16x8 qr[4];
#pragma unroll
    for (int i = 0; i < 4; ++i) qr[i] = *(const bf16x8*)(Qg + (qrow + r32) * PITCH + hq * 128 + ch * 64 + i * 16 + hi * 8);
    f32x16 o[NDB];
#pragma unroll
    for (int d = 0; d < NDB; ++d)
#pragma unroll
        for (int r = 0; r < 16; ++r) o[d][r] = 0.f;
    float mref = 0.f, lsum = 0.f; bool first = true;
    const lds_cptr kp0 = (lds_cptr)lds + KOFF + ch * 8192 + hi * 1024 + r32 * 16;
    const lds_cptr vp0 = (lds_cptr)lds + VOFF + ((MODE == 0) ? 0 : ch * 8192) + ((lane >> 4) & 1) * 32 + (lane & 3) * 8 + (4 * hi + ((lane & 15) >> 2)) * 64;
    int slot = 0;
    for (int i = 0; i < NT; ++i) {
        if (i + 1 < NT) FA_WAIT_BAR(4); else FA_WAIT_BAR(0);
        if (i + 2 < NT) { const int s2 = (slot == 0) ? 2 : slot - 1; FA_DMA(t0 + i + 2, s2); }
        const int t = t0 + i;
        const bool vis = (MODE == 0) ? (t <= cw) : (t <= cw && t + 8 >= cw);
        if (vis) {
            const lds_cptr kp = kp0 + slot * SLOTB; const lds_cptr vp = vp0 + slot * SLOTB;
            f32x16 p0, p1;
#pragma unroll
            for (int r = 0; r < 16; ++r) { p0[r] = 0.f; p1[r] = 0.f; }
#pragma unroll
            for (int k = 0; k < 4; ++k) {
                const bf16x8 ka = *(const LAS bf16x8*)(kp + k * 2048), kb = *(const LAS bf16x8*)(kp + k * 2048 + 512);
                p0 = __builtin_amdgcn_mfma_f32_32x32x16_bf16(ka, qr[k], p0, 0, 0, 0);
                p1 = __builtin_amdgcn_mfma_f32_32x32x16_bf16(kb, qr[k], p1, 0, 0, 0);
            }
            if (MODE == 1) {
                const LAS float* bt = (const LAS float*)(lds + LDS_BIAS) + ch * 320;
                const int relb = 64 * (cw - t) + 32 * (wq & 1) + r32 + 63;
                if (cw - t >= 5) { const float c = bt[319];
#pragma unroll
                    for (int r = 0; r < 16; ++r) { p0[r] += c; p1[r] += c; }
                } else {
#pragma unroll
                    for (int r = 0; r < 16; ++r) { const int i0 = relb - crow(r, hi), i1 = i0 - 32; p0[r] += bt[i0 > 319 ? 319 : i0]; p1[r] += bt[i1 > 319 ? 319 : i1]; }
                }
            }
            float rm = fmaxf(p0[0], p1[0]);
#pragma unroll
            for (int r = 1; r < 16; ++r) rm = fmaxf(rm, fmaxf(p0[r], p1[r]));
            rm = swapmax(rm);
            if (first) { mref = rm; first = false; }
            else if (__any(rm - mref > THR)) {
                const float dl = fmaxf(rm - mref, 0.f); mref += dl; const float f = fast_exp2(-dl); lsum *= f;
                if (hi == 0) wsf[r32] = f;
                LDS_WAIT();
#pragma unroll
                for (int r = 0; r < 16; ++r) { const float fr = wsf[crow(r, hi)];
#pragma unroll
                    for (int d = 0; d < NDB; ++d) o[d][r] *= fr; }
            }
            float sacc = 0.f;
#pragma unroll
            for (int r = 0; r < 16; ++r) { p0[r] = fast_exp2(p0[r] - mref); p1[r] = fast_exp2(p1[r] - mref); sacc += p0[r] + p1[r]; }
            lsum += sacc;
            const bf16x8 pa0 = pack_p(p0, 0), pa1 = pack_p(p0, 8), pa2 = pack_p(p1, 0), pa3 = pack_p(p1, 8);
#pragma unroll
            for (int d = 0; d < NDB; ++d) {
                const lds_cptr vd = vp + d * 4096;
                const bf16x8 v0 = cat8(vtr(vd), vtr(vd + 512)), v1 = cat8(vtr(vd + 1024), vtr(vd + 1024 + 512)), v2 = cat8(vtr(vd + 2048), vtr(vd + 2048 + 512)), v3 = cat8(vtr(vd + 3072), vtr(vd + 3072 + 512));
                o[d] = __builtin_amdgcn_mfma_f32_32x32x16_bf16(pa0, v0, o[d], 0, 0, 0);
                o[d] = __builtin_amdgcn_mfma_f32_32x32x16_bf16(pa1, v1, o[d], 0, 0, 0);
                o[d] = __builtin_amdgcn_mfma_f32_32x32x16_bf16(pa2, v2, o[d], 0, 0, 0);
                o[d] = __builtin_amdgcn_mfma_f32_32x32x16_bf16(pa3, v3, o[d], 0, 0, 0);
            }
        }
        slot = (slot == NSLOT - 1) ? 0 : slot + 1;
    }
    lsum = swapsum(lsum);
    if (hi == 0) wsf[32 + r32] = lsum;
    LDS_WAIT();
#pragma unroll
    for (int r = 0; r < 16; ++r) { const float il = fast_rcp(wsf[32 + crow(r, hi)]);
#pragma unroll
        for (int d = 0; d < NDB; ++d) o[d][r] *= il; }
    FA_BAR();
    if (MODE == 0) {
        LAS float* xf = (LAS float*)lds + (wid & 3) * 4096;
        if (ch == 1) {
#pragma unroll
            for (int d = 0; d < 4; ++d)
#pragma unroll
                for (int r = 0; r < 16; ++r) xf[(d * 16 + r) * 64 + lane] = o[d][r];
        }
        FA_BAR();
        if (ch == 0) {
            float ss[16];
#pragma unroll
            for (int r = 0; r < 16; ++r) ss[r] = 0.f;
#pragma unroll
            for (int d = 0; d < 4; ++d)
#pragma unroll
                for (int r = 0; r < 16; ++r) { const float y = o[d][r] - lam * xf[(d * 16 + r) * 64 + lane]; o[d][r] = y; ss[r] += y * y; }
            LAS bf16_t* stg = (LAS bf16_t*)(lds + 65536) + wid * 4096;
            float g[4];
#pragma unroll
            for (int d = 0; d < 4; ++d) g[d] = subln[32 * d + r32] * osc;
#pragma unroll
            for (int r = 0; r < 16; ++r) { const float rs = __builtin_amdgcn_rsqf(half_sum32(ss[r]) * (1.0f / 128.0f) + EPS); const int orow = crow(r, hi);
#pragma unroll
                for (int d = 0; d < 4; ++d) stg[orow * 128 + d * 32 + r32] = (bf16_t)f2bf(o[d][r] * rs * g[d]); }
            LDS_WAIT();
#pragma unroll
            for (int i = 0; i < 8; ++i) { const int idx = i * 64 + lane, row = idx >> 4, c8 = idx & 15;
                const u32x4 v = *(const LAS u32x4*)(stg + row * 128 + c8 * 8);
                *(u32x4*)(Yg + (qrow + row) * PITCH + hq * 128 + c8 * 8) = v; }
        }
    } else {
        LAS bf16_t* stg = (LAS bf16_t*)lds + wid * 2048;
#pragma unroll
        for (int r = 0; r < 16; ++r) { const int orow = crow(r, hi);
#pragma unroll
            for (int d = 0; d < 2; ++d) stg[orow * 64 + d * 32 + r32] = (bf16_t)f2bf(o[d][r]); }
        LDS_WAIT();
#pragma unroll
        for (int i = 0; i < 4; ++i) { const int idx = i * 64 + lane, row = idx >> 3, c8 = idx & 7;
            const u32x4 v = *(const LAS u32x4*)(stg + row * 64 + c8 * 8);
            *(u32x4*)(Yg + (qrow + row) * PITCH + hq * 128 + ch * 64 + c8 * 8) = v; }
    }
    FA_BAR();
#undef FA_DMA
}

constexpr int NSLOT2 = 4, LDS_WS2 = 132096, LDS_BIAS2 = LDS_WS2 + 2048;
template <int MODE>
__device__ __forceinline__ void attn_unit2(LAS unsigned char* lds, const int tid_, const bf16_t* Qg, const bf16_t* Kg, const bf16_t* Vg, bf16_t* Yg, const int b, const int hq, const int u,
                                           const float lam, const float osc, const float* subln, const int pm = 0) {
    constexpr int PITCH = 512, NDB = (MODE == 0) ? 4 : 2;
    int tid = tid_; asm volatile("" : "+v"(tid));
    const int lane = tid & 63, r32 = lane & 31, hi = lane >> 5, hwid = __builtin_amdgcn_readfirstlane(tid >> 6);
#if FA_WMAP == 1
    const int wid = (hwid >> 1) | ((hwid & 1) << 2);
#elif FA_WMAP == 2
    const int wid = (hwid & 1) | ((hwid >> 2) << 1) | (((hwid >> 1) & 1) << 2);
#else
    const int wid = hwid;
#endif
    const int ch = wid >> 2, wq = wid & 3;
    const int cw = 2 * u + (wq >> 1);
    const int t0 = (MODE == 0) ? 0 : ((2 * u - 8) > 0 ? (2 * u - 8) : 0), t1 = 2 * u + 1, NT = t1 - t0 + 1;
    const int iv1 = cw - t0, iv0 = (MODE == 0) ? 0 : ((cw - 8 - t0) > 0 ? (cw - 8 - t0) : 0);
    const size_t rowbase = (size_t)b * SEQ;
    const bf16_t* Kb = Kg + rowbase * PITCH + hq * 128; const bf16_t* Vb = Vg + rowbase * PITCH + hq * 128;
    const unsigned lds0 = (unsigned)(uintptr_t)lds;
    LAS float* wsf = (LAS float*)(lds + LDS_WS2) + wid * 64;
    const bf16_t* kbase = Kb + (2 * wid) * 8;
    const bf16_t* vbase = Vb + (size_t)(16 * ((2 * wid) & 3)) * PITCH + 32 * ((2 * wid) >> 2);
    const unsigned kvo = (unsigned)lane * PITCH * 2u, vvo = (unsigned)((lane >> 2) * PITCH + (lane & 3) * 8) * 2u;
#define FA_DMA(t, slot) do { if (pm == 1) break; const size_t to_ = (size_t)(t) * 64 * PITCH; const unsigned sb_ = lds0 + (unsigned)(slot) * SLOTB; \
        glds16s(kbase + to_, kvo, (unsigned)__builtin_amdgcn_readfirstlane(sb_ + KOFF + (2 * wid) * 1024)); glds16s(kbase + to_ + 8, kvo, (unsigned)__builtin_amdgcn_readfirstlane(sb_ + KOFF + (2 * wid + 1) * 1024)); \
        glds16s(vbase + to_, vvo, (unsigned)__builtin_amdgcn_readfirstlane(sb_ + VOFF + (2 * wid) * 1024)); glds16s(vbase + to_ + 16 * PITCH, vvo, (unsigned)__builtin_amdgcn_readfirstlane(sb_ + VOFF + (2 * wid + 1) * 1024)); } while (0)
    FA_DMA(t0, 0);
    FA_DMA(t0 + 1, 1);
    const size_t qrow = rowbase + (size_t)u * 128 + wq * 32;
    bf16x8 qr[4];
#pragma unroll
    for (int i = 0; i < 4; ++i) qr[i] = *(const bf16x8*)(Qg + (qrow + r32) * PITCH + hq * 128 + ch * 64 + i * 16 + hi * 8);
    f32x16 o[NDB];
#pragma unroll
    for (int d = 0; d < NDB; ++d)
#pragma unroll
        for (int r = 0; r < 16; ++r) o[d][r] = 0.f;
    float mref = 0.f, lsum = 0.f; bool first = true;
    const lds_cptr kp0 = (lds_cptr)lds + KOFF + ch * 8192 + hi * 1024 + r32 * 16;
    const lds_cptr vp0 = (lds_cptr)lds + VOFF + ((MODE == 0) ? 0 : ch * 8192) + ((lane >> 4) & 1) * 32 + (lane & 3) * 8 + (4 * hi + ((lane & 15) >> 2)) * 64;
    f32x16 p0, p1; bf16x8 pa0, pa1, pa2, pa3, kf[8], vf[NDB * 4];
#pragma unroll
    for (int r = 0; r < 16; ++r) { p0[r] = 0.f; p1[r] = 0.f; }
    pa0 = pa1 = pa2 = pa3 = (bf16x8){0, 0, 0, 0, 0, 0, 0, 0};
#pragma unroll
    for (int k = 0; k < NDB * 4; ++k) vf[k] = pa0;
#define FA_SB() __builtin_amdgcn_sched_barrier(0)
#define FA_KLD(i_) do { if (pm == 7) break; const lds_cptr kp = kp0 + ((i_) & 3) * SLOTB; \
        _Pragma("unroll") for (int k = 0; k < 4; ++k) { kf[2 * k] = *(const LAS bf16x8*)(kp + k * 2048); kf[2 * k + 1] = *(const LAS bf16x8*)(kp + k * 2048 + 512); } } while (0)
#define FA_QK(i_) do { \
        _Pragma("unroll") for (int r = 0; r < 16; ++r) { p0[r] = 0.f; p1[r] = 0.f; } \
        _Pragma("unroll") for (int k = 0; k < 4; ++k) { p0 = __builtin_amdgcn_mfma_f32_32x32x16_bf16(kf[2 * k], qr[k], p0, 0, 0, 0); p1 = __builtin_amdgcn_mfma_f32_32x32x16_bf16(kf[2 * k + 1], qr[k], p1, 0, 0, 0); } \
        if (MODE == 1) { const int t = t0 + (i_); const LAS float* bt = (const LAS float*)(lds + LDS_BIAS2) + ch * 320; const int relb = 64 * (cw - t) + 32 * (wq & 1) + r32 + 63; \
            if (cw - t >= 5) { const float c = bt[319]; _Pragma("unroll") for (int r = 0; r < 16; ++r) { p0[r] += c; p1[r] += c; } } \
            else { _Pragma("unroll") for (int r = 0; r < 16; ++r) { const int i0 = relb - crow(r, hi), i1 = i0 - 32; p0[r] += bt[i0 > 319 ? 319 : i0]; p1[r] += bt[i1 > 319 ? 319 : i1]; } } } } while (0)
#define FA_MX3(a, b, c) __builtin_fmaxf(__builtin_fmaxf((a), (b)), (c))
#define FA_SM() do { if (pm == 3) { asm volatile("" : "+v"(p0), "+v"(p1)); break; } \
        float ma = FA_MX3(p0[0], p0[1], p1[0]), mb = FA_MX3(p0[2], p0[3], p1[1]), mc = FA_MX3(p0[4], p0[5], p1[2]), md = FA_MX3(p0[6], p0[7], p1[3]); \
        ma = FA_MX3(ma, p0[8], p0[9]); mb = FA_MX3(mb, p0[10], p0[11]); mc = FA_MX3(mc, p0[12], p0[13]); md = FA_MX3(md, p0[14], p0[15]); \
        ma = FA_MX3(ma, p1[4], p1[5]); mb = FA_MX3(mb, p1[6], p1[7]); mc = FA_MX3(mc, p1[8], p1[9]); md = FA_MX3(md, p1[10], p1[11]); \
        ma = FA_MX3(ma, p1[12], p1[13]); mb = FA_MX3(mb, p1[14], p1[15]); float rm = __builtin_fmaxf(__builtin_fmaxf(ma, mb), __builtin_fmaxf(mc, md)); rm = swapmax(rm); \
        if (first) { mref = rm; first = false; } \
        else if (__any(rm - mref > THR)) { const float dl = fmaxf(rm - mref, 0.f); mref += dl; const float f = fast_exp2(-dl); lsum *= f; if (hi == 0) wsf[r32] = f; LDS_WAIT(); \
            _Pragma("unroll") for (int r = 0; r < 16; ++r) { const float fr = wsf[crow(r, hi)]; _Pragma("unroll") for (int d = 0; d < NDB; ++d) o[d][r] *= fr; } } \
        float sa = 0.f, sb = 0.f, sc = 0.f, sd = 0.f; \
        _Pragma("unroll") for (int r = 0; r < 16; r += 4) { p0[r] = fast_exp2(p0[r] - mref); p0[r + 1] = fast_exp2(p0[r + 1] - mref); p0[r + 2] = fast_exp2(p0[r + 2] - mref); p0[r + 3] = fast_exp2(p0[r + 3] - mref); \
            p1[r] = fast_exp2(p1[r] - mref); p1[r + 1] = fast_exp2(p1[r + 1] - mref); p1[r + 2] = fast_exp2(p1[r + 2] - mref); p1[r + 3] = fast_exp2(p1[r + 3] - mref); \
            sa += p0[r] + p1[r]; sb += p0[r + 1] + p1[r + 1]; sc += p0[r + 2] + p1[r + 2]; sd += p0[r + 3] + p1[r + 3]; } \
        lsum += (sa + sb) + (sc + sd); \
        pa0 = pack_p(p0, 0); pa1 = pack_p(p0, 8); pa2 = pack_p(p1, 0); pa3 = pack_p(p1, 8); } while (0)
#define FA_VLDALL(i_) do { if (pm == 4) break; const lds_cptr vt = vp0 + ((i_) & 3) * SLOTB; \
        _Pragma("unroll") for (int d = 0; d < NDB; ++d) _Pragma("unroll") for (int k = 0; k < 4; ++k) vf[4 * d + k] = cat8(vtr(vt + d * 4096 + k * 1024), vtr(vt + d * 4096 + k * 1024 + 512)); } while (0)
#define FA_PV() do { if (pm == 5) break; _Pragma("unroll") for (int d = 0; d < NDB; ++d) { \
        o[d] = __builtin_amdgcn_mfma_f32_32x32x16_bf16(pa0, vf[4 * d], o[d], 0, 0, 0); o[d] = __builtin_amdgcn_mfma_f32_32x32x16_bf16(pa1, vf[4 * d + 1], o[d], 0, 0, 0); \
        o[d] = __builtin_amdgcn_mfma_f32_32x32x16_bf16(pa2, vf[4 * d + 2], o[d], 0, 0, 0); o[d] = __builtin_amdgcn_mfma_f32_32x32x16_bf16(pa3, vf[4 * d + 3], o[d], 0, 0, 0); } } while (0)
#if PROBE_T
    unsigned tacc0 = 0, tacc1 = 0, tacc2 = 0, tacc3 = 0; unsigned long long s0 = 0, s1 = 0, s2 = 0, s3 = 0; const unsigned long long rt0 = __builtin_amdgcn_s_memrealtime();
#define FA_TS(v) do { FA_SB(); asm volatile("s_memtime %0\n\ts_waitcnt lgkmcnt(0)" : "=s"(v) :: "memory"); FA_SB(); } while (0)
#define FA_TSV(v, a, b) do { FA_SB(); asm volatile("s_nop 15\n\ts_nop 15" : "+v"(a), "+v"(b)); asm volatile("s_memtime %0\n\ts_waitcnt lgkmcnt(0)" : "=s"(v) :: "memory"); FA_SB(); } while (0)
#define FA_TACC() do { tacc0 += (unsigned)(s3 - s0); tacc1 += (unsigned)(s1 - s0); tacc2 += (unsigned)(s2 - s1); tacc3 += (unsigned)(s3 - s2); } while (0)
#define FA_TOUT(base) do { if (blockIdx.x == 0 && (hwid & 3) == 0 && u >= 32) { const unsigned long long rt1 = __builtin_amdgcn_s_memrealtime(); \
        unsigned long long* pv = (unsigned long long*)((char*)Yg - WS_AQ + WS_PROBE) + (base); if (lane == 0) { pv[0] = tacc0 / NT; pv[1] = tacc1 / NT; pv[2] = tacc2 / NT; pv[3] = tacc3 / NT; pv[4] = ((unsigned long long)tacc0 * 100) / (rt1 - rt0); pv[5] = NT; } } } while (0)
#else
#define FA_TS(v) do { } while (0)
#define FA_TSV(v, a, b) do { } while (0)
#define FA_TACC() do { } while (0)
#define FA_TOUT(base) do { } while (0)
#endif
    if (ch == 0) {
#pragma unroll 1
        for (int i = 0; i < NT; ++i) {
            FA_TS(s0);
            if (i + 1 < NT) FA_WAIT_BAR(4); else FA_WAIT_BAR(0);
            FA_TS(s1);
            if (i + 2 < NT) FA_DMA(t0 + i + 2, (i + 2) & 3);
            if (pm != 2) {
                const bool prev = (i - 1 >= iv0) && (i - 1 <= iv1), cur = (i >= iv0) && (i <= iv1);
                if (cur) FA_KLD(i);
                FA_SB();
                if (prev) { FA_PV(); FA_SB(); }
                if (cur) { FA_QK(i); FA_SB(); FA_TSV(s2, p0, p1); FA_VLDALL(i); FA_SB(); FA_SM(); FA_SB(); FA_TSV(s3, pa0, pa3); FA_TACC(); }
            }
        }
        FA_TOUT(0);
        if (NT - 1 <= iv1 && pm != 2) FA_PV();
    } else {
#pragma unroll 1
        for (int i = 0; i < NT; ++i) {
            FA_TS(s0);
            if (i + 1 < NT) FA_WAIT_BAR(4); else FA_WAIT_BAR(0);
            FA_TS(s1);
            if (i + 2 < NT) FA_DMA(t0 + i + 2, (i + 2) & 3);
            if (pm != 2) {
                const bool prev = (i - 1 >= iv0) && (i - 1 <= iv1), cur = (i >= iv0) && (i <= iv1);
                if (prev) { FA_VLDALL(i - 1); FA_SB(); FA_SM(); FA_SB(); FA_TSV(s2, pa0, pa3); }
                if (cur) { FA_KLD(i); FA_SB(); }
                if (prev) { FA_PV(); FA_SB(); }
                if (cur) { FA_QK(i); FA_SB(); FA_TSV(s3, p0, p1); if (prev) FA_TACC(); }
            }
        }
        FA_TOUT(8);
        if (NT - 1 <= iv1 && pm != 2) { FA_VLDALL(NT - 1); FA_SB(); FA_SM(); FA_SB(); FA_PV(); }
    }
#undef FA_VLDALL
#undef FA_MX3
#undef FA_TS
#undef FA_TSV
#undef FA_TACC
#undef FA_TOUT
#undef FA_KLD
#undef FA_SB
#undef FA_QK
#undef FA_SM
#undef FA_PV
    lsum = swapsum(lsum);
    if (hi == 0) wsf[32 + r32] = lsum;
    LDS_WAIT();
#pragma unroll
    for (int r = 0; r < 16; ++r) { const float il = fast_rcp(wsf[32 + crow(r, hi)]);
#pragma unroll
        for (int d = 0; d < NDB; ++d) o[d][r] *= il; }
    FA_BAR();
    if (MODE == 0) {
        LAS float* xf = (LAS float*)lds + (wid & 3) * 4096;
        if (ch == 1) {
#pragma unroll
            for (int d = 0; d < 4; ++d)
#pragma unroll
                for (int r = 0; r < 16; ++r) xf[(d * 16 + r) * 64 + lane] = o[d][r];
        }
        FA_BAR();
        if (ch == 0) {
            float ss[16];
#pragma unroll
            for (int r = 0; r < 16; ++r) ss[r] = 0.f;
#pragma unroll
            for (int d = 0; d < 4; ++d)
#pragma unroll
                for (int r = 0; r < 16; ++r) { const float y = o[d][r] - lam * xf[(d * 16 + r) * 64 + lane]; o[d][r] = y; ss[r] += y * y; }
            LAS bf16_t* stg = (LAS bf16_t*)(lds + 65536) + wid * 4096;
            float g[4];
#pragma unroll
            for (int d = 0; d < 4; ++d) g[d] = subln[32 * d + r32] * osc;
#pragma unroll
            for (int r = 0; r < 16; ++r) { const float rs = __builtin_amdgcn_rsqf(half_sum32(ss[r]) * (1.0f / 128.0f) + EPS); const int orow = crow(r, hi);
#pragma unroll
                for (int d = 0; d < 4; ++d) stg[orow * 128 + d * 32 + r32] = (bf16_t)f2bf(o[d][r] * rs * g[d]); }
            LDS_WAIT();
#pragma unroll
            for (int i = 0; i < 8; ++i) { const int idx = i * 64 + lane, row = idx >> 4, c8 = idx & 15;
                const u32x4 v = *(const LAS u32x4*)(stg + row * 128 + c8 * 8);
                *(u32x4*)(Yg + (qrow + row) * PITCH + hq * 128 + c8 * 8) = v; }
        }
    } else {
        LAS bf16_t* stg = (LAS bf16_t*)lds + wid * 2048;
#pragma unroll
        for (int r = 0; r < 16; ++r) { const int orow = crow(r, hi);
#pragma unroll
            for (int d = 0; d < 2; ++d) stg[orow * 64 + d * 32 + r32] = (bf16_t)f2bf(o[d][r]); }
        LDS_WAIT();
#pragma unroll
        for (int i = 0; i < 4; ++i) { const int idx = i * 64 + lane, row = idx >> 3, c8 = idx & 7;
            const u32x4 v = *(const LAS u32x4*)(stg + row * 64 + c8 * 8);
            *(u32x4*)(Yg + (qrow + row) * PITCH + hq * 128 + ch * 64 + c8 * 8) = v; }
    }
    FA_BAR();
#undef FA_DMA
}

constexpr int K3OFF = 0, V3OFF = 49152, NK3 = 3;
template <int MODE, bool NOMAX>
__device__ __forceinline__ void attn_unit3(LAS unsigned char* lds, const int tid_, const bf16_t* Qg, const bf16_t* Kg, const bf16_t* Vg, bf16_t* Yg, const int b, const int hq, const int u,
                                           const float lam, const float osc, const float* subln, const int pm = 0) {
    constexpr int PITCH = 512, NDB = (MODE == 0) ? 4 : 2;
    int tid = tid_; asm volatile("" : "+v"(tid));
#if PROBE_T
    const unsigned long long tu0_ = __builtin_amdgcn_s_memtime();
#endif
    const int lane = tid & 63, r32 = lane & 31, hi = lane >> 5, wid = __builtin_amdgcn_readfirstlane(tid >> 6), ch = wid >> 2, wq = wid & 3;
    const int cw = 2 * u + (wq >> 1);
    const int t0 = (MODE == 0) ? 0 : ((2 * u - 8) > 0 ? (2 * u - 8) : 0), t1 = 2 * u + 1, NT = t1 - t0 + 1;
    const int iv1 = cw - t0, iv0 = (MODE == 0) ? 0 : ((cw - 8 - t0) > 0 ? (cw - 8 - t0) : 0);
    const size_t rowbase = (size_t)b * SEQ;
    const bf16_t* Kb = Kg + rowbase * PITCH + hq * 128; const bf16_t* Vb = Vg + rowbase * PITCH + hq * 128;
    const unsigned lds0 = (unsigned)(uintptr_t)lds;
    LAS float* wsf = (LAS float*)(lds + LDS_WS2) + wid * 64;
    const bf16_t* kbase = Kb + (2 * wid) * 8;
    const bf16_t* vbase = Vb + (size_t)(16 * ((2 * wid) & 3)) * PITCH + 32 * ((2 * wid) >> 2);
    const unsigned kvo = (unsigned)lane * PITCH * 2u, vvo = (unsigned)((lane >> 2) * PITCH + (lane & 3) * 8) * 2u;
#define F3_DMAK(j) do { if ((j) < NT) { const size_t to_ = (size_t)(t0 + (j)) * 64 * PITCH; const unsigned sb_ = lds0 + K3OFF + (unsigned)((j) % NK3) * 16384u; \
        glds16s(kbase + to_, kvo, (unsigned)__builtin_amdgcn_readfirstlane(sb_ + (2 * wid) * 1024)); glds16s(kbase + to_ + 8, kvo, (unsigned)__builtin_amdgcn_readfirstlane(sb_ + (2 * wid + 1) * 1024)); } } while (0)
#define F3_DMAV(j) do { if ((j) < NT) { const size_t to_ = (size_t)(t0 + (j)) * 64 * PITCH; const unsigned sb_ = lds0 + V3OFF + (unsigned)((j) & 3) * 16384u; \
        glds16s(vbase + to_, vvo, (unsigned)__builtin_amdgcn_readfirstlane(sb_ + (2 * wid) * 1024)); glds16s(vbase + to_ + 16 * PITCH, vvo, (unsigned)__builtin_amdgcn_readfirstlane(sb_ + (2 * wid + 1) * 1024)); } } while (0)
    F3_DMAK(0); F3_DMAK(1); F3_DMAV(0); F3_DMAK(2); F3_DMAV(1);
    const size_t qrow = rowbase + (size_t)u * 128 + wq * 32;
    bf16x8 qr[4];
#pragma unroll
    for (int i = 0; i < 4; ++i) qr[i] = *(const bf16x8*)(Qg + (qrow + r32) * PITCH + hq * 128 + ch * 64 + i * 16 + hi * 8);
    f32x16 o[NDB];
#pragma unroll
    for (int d = 0; d < NDB; ++d)
#pragma unroll
        for (int r = 0; r < 16; ++r) o[d][r] = 0.f;
    float mref = -1e30f, lsum = 0.f;
    const lds_cptr kp0 = (lds_cptr)lds + K3OFF + ch * 8192 + hi * 1024 + r32 * 16;
    const lds_cptr vp0 = (lds_cptr)lds + V3OFF + ((MODE == 0) ? 0 : ch * 8192) + ((lane >> 4) & 1) * 32 + (lane & 3) * 8 + (4 * hi + ((lane & 15) >> 2)) * 64;
    const LAS float* btab = (const LAS float*)(lds + LDS_BIAS2) + ch * 640;
    f32x16 cA0, cA1, cB0, cB1; u32x4 pA[4], pB[4];
#pragma unroll
    for (int r = 0; r < 16; ++r) { cA0[r] = 0.f; cA1[r] = 0.f; cB0[r] = 0.f; cB1[r] = 0.f; }
#pragma unroll
    for (int k = 0; k < 4; ++k) { pA[k] = (u32x4){0u, 0u, 0u, 0u}; pB[k] = (u32x4){0u, 0u, 0u, 0u}; }
#define F3_SB() __builtin_amdgcn_sched_barrier(0)
#define F3_MX3(a, b, c) __builtin_fmaxf(__builtin_fmaxf((a), (b)), (c))
#define F3_QK(j, d0, d1) do { const lds_cptr kp = kp0 + ((j) % NK3) * 16384; \
        _Pragma("unroll") for (int k = 0; k < 4; ++k) { const bf16x8 ka = *(const LAS bf16x8*)(kp + k * 2048), kb = *(const LAS bf16x8*)(kp + k * 2048 + 512); \
            if (k == 0) { d0 = __builtin_amdgcn_mfma_f32_32x32x16_bf16(ka, qr[0], (f32x16){0.f, 0.f, 0.f, 0.f, 0.f, 0.f, 0.f, 0.f, 0.f, 0.f, 0.f, 0.f, 0.f, 0.f, 0.f, 0.f}, 0, 0, 0); d1 = __builtin_amdgcn_mfma_f32_32x32x16_bf16(kb, qr[0], (f32x16){0.f, 0.f, 0.f, 0.f, 0.f, 0.f, 0.f, 0.f, 0.f, 0.f, 0.f, 0.f, 0.f, 0.f, 0.f, 0.f}, 0, 0, 0); } \
            else { d0 = __builtin_amdgcn_mfma_f32_32x32x16_bf16(ka, qr[k], d0, 0, 0, 0); d1 = __builtin_amdgcn_mfma_f32_32x32x16_bf16(kb, qr[k], d1, 0, 0, 0); } } } while (0)
#define F3_BIAS(j, d0, d1) do { if (MODE == 1) { const int t = t0 + (j); const LAS float* bt = btab; const int relb = 64 * (cw - t) + 32 * (wq & 1) + r32 + 63; \
            if (cw - t >= 5) { const float c = bt[319]; _Pragma("unroll") for (int r = 0; r < 16; ++r) { d0[r] += c; d1[r] += c; } } \
            else { _Pragma("unroll") for (int r = 0; r < 16; ++r) { const int i0 = relb - crow(r, hi), i1 = i0 - 32; d0[r] += bt[i0 > 319 ? 319 : i0]; d1[r] += bt[i1 > 319 ? 319 : i1]; } } } } while (0)
#define F3_PV(j, P) do { const lds_cptr vt = vp0 + ((j) & 3) * 16384; \
        _Pragma("unroll") for (int d = 0; d < NDB; ++d) { const lds_cptr vd = vt + d * 4096; \
            o[d] = __builtin_amdgcn_mfma_f32_32x32x16_bf16(__builtin_bit_cast(bf16x8, P[0]), cat8(vtr(vd), vtr(vd + 512)), o[d], 0, 0, 0); o[d] = __builtin_amdgcn_mfma_f32_32x32x16_bf16(__builtin_bit_cast(bf16x8, P[1]), cat8(vtr(vd + 1024), vtr(vd + 1536)), o[d], 0, 0, 0); \
            o[d] = __builtin_amdgcn_mfma_f32_32x32x16_bf16(__builtin_bit_cast(bf16x8, P[2]), cat8(vtr(vd + 2048), vtr(vd + 2560)), o[d], 0, 0, 0); o[d] = __builtin_amdgcn_mfma_f32_32x32x16_bf16(__builtin_bit_cast(bf16x8, P[3]), cat8(vtr(vd + 3072), vtr(vd + 3584)), o[d], 0, 0, 0); } } while (0)
#define F3_SM(c0, c1, P) do { \
        if (NOMAX) { upd = false; } else { \
        float ma = F3_MX3(c0[0], c0[1], c1[0]), mb = F3_MX3(c0[2], c0[3], c1[1]), mc = F3_MX3(c0[4], c0[5], c1[2]), md = F3_MX3(c0[6], c0[7], c1[3]); \
        ma = F3_MX3(ma, c0[8], c0[9]); mb = F3_MX3(mb, c0[10], c0[11]); mc = F3_MX3(mc, c0[12], c0[13]); md = F3_MX3(md, c0[14], c0[15]); \
        ma = F3_MX3(ma, c1[4], c1[5]); mb = F3_MX3(mb, c1[6], c1[7]); mc = F3_MX3(mc, c1[8], c1[9]); md = F3_MX3(md, c1[10], c1[11]); \
        ma = F3_MX3(ma, c1[12], c1[13]); mb = F3_MX3(mb, c1[14], c1[15]); float rm = __builtin_fmaxf(__builtin_fmaxf(ma, mb), __builtin_fmaxf(mc, md)); rm = swapmax(rm); \
        upd = __any(rm - mref > THR); const float mnew = upd ? __builtin_fmaxf(mref, rm) : mref; fsc = fast_exp2(mref - mnew); mref = mnew; lsum *= fsc; } \
        float sa = 0.f, sb = 0.f, sc = 0.f, sd = 0.f; \
        _Pragma("unroll") for (int r = 0; r < 16; r += 4) { \
            if (NOMAX) { c0[r] = fast_exp2(c0[r]); c0[r + 1] = fast_exp2(c0[r + 1]); c0[r + 2] = fast_exp2(c0[r + 2]); c0[r + 3] = fast_exp2(c0[r + 3]); \
                         c1[r] = fast_exp2(c1[r]); c1[r + 1] = fast_exp2(c1[r + 1]); c1[r + 2] = fast_exp2(c1[r + 2]); c1[r + 3] = fast_exp2(c1[r + 3]); } \
            else { c0[r] = fast_exp2(c0[r] - mref); c0[r + 1] = fast_exp2(c0[r + 1] - mref); c0[r + 2] = fast_exp2(c0[r + 2] - mref); c0[r + 3] = fast_exp2(c0[r + 3] - mref); \
                   c1[r] = fast_exp2(c1[r] - mref); c1[r + 1] = fast_exp2(c1[r + 1] - mref); c1[r + 2] = fast_exp2(c1[r + 2] - mref); c1[r + 3] = fast_exp2(c1[r + 3] - mref); } \
            sa += c0[r] + c1[r]; sb += c0[r + 1] + c1[r + 1]; sc += c0[r + 2] + c1[r + 2]; sd += c0[r + 3] + c1[r + 3]; } \
        lsum += (sa + sb) + (sc + sd); \
        P[0] = __builtin_bit_cast(u32x4, pack_p(c0, 0)); P[1] = __builtin_bit_cast(u32x4, pack_p(c0, 8)); P[2] = __builtin_bit_cast(u32x4, pack_p(c1, 0)); P[3] = __builtin_bit_cast(u32x4, pack_p(c1, 8)); } while (0)
#define F3_RESC() do { if (!NOMAX && upd) { if (hi == 0) wsf[r32] = fsc; LDS_WAIT(); \
            _Pragma("unroll") for (int r = 0; r < 16; ++r) { const float fr = wsf[crow(r, hi)]; _Pragma("unroll") for (int d = 0; d < NDB; ++d) o[d][r] *= fr; } } } while (0)
#define F3_HEAD(i) do { if ((i) + 3 < NT) { asm volatile("s_waitcnt vmcnt(6) lgkmcnt(0)\n\ts_barrier" ::: "memory"); } else FA_WAIT_BAR(0); \
        F3_DMAK((i) + 3); F3_DMAV((i) + 2); F3_SB(); } while (0)
#if PROBE_T
    unsigned tq0 = 0, tq1 = 0, tqn = 0; unsigned long long ts0_ = 0, ts1_ = 0, ts2_ = 0;
#define F3_TS(v) do { F3_SB(); asm volatile("s_memtime %0\n\ts_waitcnt lgkmcnt(0)" : "=s"(v) :: "memory"); F3_SB(); } while (0)
#define F3_TSE(a, b) do { F3_SB(); asm volatile("s_nop 15\n\ts_nop 15" : "+v"(a), "+v"(b)); asm volatile("s_memtime %0\n\ts_waitcnt lgkmcnt(0)" : "=s"(ts2_) :: "memory"); F3_SB(); tq0 += (unsigned)(ts1_ - ts0_); tq1 += (unsigned)(ts2_ - ts1_); ++tqn; } while (0)
#else
#define F3_TS(v) do { } while (0)
#define F3_TSE(a, b) do { } while (0)
#endif
#define F3_HAND(i, C0, C1, N0, N1, PP, PW) do { \
        const lds_cptr vt_ = vp0 + (((i) - 1) & 3) * 16384; const lds_cptr kq_ = kp0 + (((i) + 1) % NK3) * 16384; \
        bf16x8 fq0, fq1, fq2, fq3, fq4; float sa_ = 0.f, sb_ = 0.f; \
        fq0 = cat8(vtr(vt_ + 0), vtr(vt_ + 512)); fq1 = cat8(vtr(vt_ + 1024), vtr(vt_ + 1536)); fq2 = cat8(vtr(vt_ + 2048), vtr(vt_ + 2560)); F3_SB(); \
        F3_TS(ts0_); if ((i) + 3 < NT) { asm volatile("s_waitcnt vmcnt(6) lgkmcnt(0)\n\ts_barrier" ::: "memory"); } else FA_WAIT_BAR(0); F3_TS(ts1_); \
        F3_DMAK((i) + 3); F3_DMAV((i) + 2); F3_SB(); \
        o[0] = __builtin_amdgcn_mfma_f32_32x32x16_bf16(__builtin_bit_cast(bf16x8, PP[0]), fq0, o[0], 0, 0, 0); fq3 = cat8(vtr(vt_ + 3072), vtr(vt_ + 3584)); C0[0] = fast_exp2(C0[0]); C0[1] = fast_exp2(C0[1]); asm volatile("" : "+v"(C0)); F3_SB(); \
        o[0] = __builtin_amdgcn_mfma_f32_32x32x16_bf16(__builtin_bit_cast(bf16x8, PP[1]), fq1, o[0], 0, 0, 0); fq0 = cat8(vtr(vt_ + 4096), vtr(vt_ + 4608)); C0[2] = fast_exp2(C0[2]); C0[3] = fast_exp2(C0[3]); asm volatile("" : "+v"(C0)); F3_SB(); \
        o[0] = __builtin_amdgcn_mfma_f32_32x32x16_bf16(__builtin_bit_cast(bf16x8, PP[2]), fq2, o[0], 0, 0, 0); fq1 = cat8(vtr(vt_ + 5120), vtr(vt_ + 5632)); C0[4] = fast_exp2(C0[4]); C0[5] = fast_exp2(C0[5]); asm volatile("" : "+v"(C0)); F3_SB(); \
        o[0] = __builtin_amdgcn_mfma_f32_32x32x16_bf16(__builtin_bit_cast(bf16x8, PP[3]), fq3, o[0], 0, 0, 0); fq2 = cat8(vtr(vt_ + 6144), vtr(vt_ + 6656)); C0[6] = fast_exp2(C0[6]); C0[7] = fast_exp2(C0[7]); asm volatile("" : "+v"(C0)); F3_SB(); \
        o[1] = __builtin_amdgcn_mfma_f32_32x32x16_bf16(__builtin_bit_cast(bf16x8, PP[0]), fq0, o[1], 0, 0, 0); fq3 = cat8(vtr(vt_ + 7168), vtr(vt_ + 7680)); C0[8] = fast_exp2(C0[8]); C0[9] = fast_exp2(C0[9]); asm volatile("" : "+v"(C0)); F3_SB(); \
        o[1] = __builtin_amdgcn_mfma_f32_32x32x16_bf16(__builtin_bit_cast(bf16x8, PP[1]), fq1, o[1], 0, 0, 0); fq0 = cat8(vtr(vt_ + 8192), vtr(vt_ + 8704)); C0[10] = fast_exp2(C0[10]); C0[11] = fast_exp2(C0[11]); asm volatile("" : "+v"(C0)); F3_SB(); \
        o[1] = __builtin_amdgcn_mfma_f32_32x32x16_bf16(__builtin_bit_cast(bf16x8, PP[2]), fq2, o[1], 0, 0, 0); fq1 = cat8(vtr(vt_ + 9216), vtr(vt_ + 9728)); C0[12] = fast_exp2(C0[12]); C0[13] = fast_exp2(C0[13]); asm volatile("" : "+v"(C0)); F3_SB(); \
        o[1] = __builtin_amdgcn_mfma_f32_32x32x16_bf16(__builtin_bit_cast(bf16x8, PP[3]), fq3, o[1], 0, 0, 0); fq2 = cat8(vtr(vt_ + 10240), vtr(vt_ + 10752)); C0[14] = fast_exp2(C0[14]); C0[15] = fast_exp2(C0[15]); asm volatile("" : "+v"(C0)); F3_SB(); \
        o[2] = __builtin_amdgcn_mfma_f32_32x32x16_bf16(__builtin_bit_cast(bf16x8, PP[0]), fq0, o[2], 0, 0, 0); fq3 = cat8(vtr(vt_ + 11264), vtr(vt_ + 11776)); C1[0] = fast_exp2(C1[0]); C1[1] = fast_exp2(C1[1]); sa_ += C0[0]; sb_ += C0[1]; asm volatile("" : "+v"(C1), "+v"(sa_), "+v"(sb_)); F3_SB(); \
        o[2] = __builtin_amdgcn_mfma_f32_32x32x16_bf16(__builtin_bit_cast(bf16x8, PP[1]), fq1, o[2], 0, 0, 0); fq0 = cat8(vtr(vt_ + 12288), vtr(vt_ + 12800)); C1[2] = fast_exp2(C1[2]); C1[3] = fast_exp2(C1[3]); sa_ += C0[2]; sb_ += C0[3]; asm volatile("" : "+v"(C1), "+v"(sa_), "+v"(sb_)); F3_SB(); \
        o[2] = __builtin_amdgcn_mfma_f32_32x32x16_bf16(__builtin_bit_cast(bf16x8, PP[2]), fq2, o[2], 0, 0, 0); fq1 = cat8(vtr(vt_ + 13312), vtr(vt_ + 13824)); C1[4] = fast_exp2(C1[4]); C1[5] = fast_exp2(C1[5]); sa_ += C0[4]; sb_ += C0[5]; asm volatile("" : "+v"(C1), "+v"(sa_), "+v"(sb_)); F3_SB(); \
        o[2] = __builtin_amdgcn_mfma_f32_32x32x16_bf16(__builtin_bit_cast(bf16x8, PP[3]), fq3, o[2], 0, 0, 0); fq2 = cat8(vtr(vt_ + 14336), vtr(vt_ + 14848)); C1[6] = fast_exp2(C1[6]); C1[7] = fast_exp2(C1[7]); sa_ += C0[6]; sb_ += C0[7]; asm volatile("" : "+v"(C1), "+v"(sa_), "+v"(sb_)); F3_SB(); \
        o[3] = __builtin_amdgcn_mfma_f32_32x32x16_bf16(__builtin_bit_cast(bf16x8, PP[0]), fq0, o[3], 0, 0, 0); fq3 = cat8(vtr(vt_ + 15360), vtr(vt_ + 15872)); C1[8] = fast_exp2(C1[8]); C1[9] = fast_exp2(C1[9]); sa_ += C0[8]; sb_ += C0[9]; asm volatile("" : "+v"(C1), "+v"(sa_), "+v"(sb_)); F3_SB(); \
        o[3] = __builtin_amdgcn_mfma_f32_32x32x16_bf16(__builtin_bit_cast(bf16x8, PP[1]), fq1, o[3], 0, 0, 0); fq0 = *(const LAS bf16x8*)(kq_ + 0); C1[10] = fast_exp2(C1[10]); C1[11] = fast_exp2(C1[11]); sa_ += C0[10]; sb_ += C0[11]; asm volatile("" : "+v"(C1), "+v"(sa_), "+v"(sb_)); F3_SB(); \
        o[3] = __builtin_amdgcn_mfma_f32_32x32x16_bf16(__builtin_bit_cast(bf16x8, PP[2]), fq2, o[3], 0, 0, 0); fq1 = *(const LAS bf16x8*)(kq_ + 512); C1[12] = fast_exp2(C1[12]); C1[13] = fast_exp2(C1[13]); sa_ += C0[12]; sb_ += C0[13]; asm volatile("" : "+v"(C1), "+v"(sa_), "+v"(sb_)); F3_SB(); \
        o[3] = __builtin_amdgcn_mfma_f32_32x32x16_bf16(__builtin_bit_cast(bf16x8, PP[3]), fq3, o[3], 0, 0, 0); fq2 = *(const LAS bf16x8*)(kq_ + 2048); C1[14] = fast_exp2(C1[14]); C1[15] = fast_exp2(C1[15]); sa_ += C0[14]; sb_ += C0[15]; asm volatile("" : "+v"(C1), "+v"(sa_), "+v"(sb_)); F3_SB(); \
        N0 = __builtin_amdgcn_mfma_f32_32x32x16_bf16(fq0, qr[0], (f32x16){0.f,0.f,0.f,0.f,0.f,0.f,0.f,0.f,0.f,0.f,0.f,0.f,0.f,0.f,0.f,0.f}, 0, 0, 0); fq3 = *(const LAS bf16x8*)(kq_ + 2560); sa_ += C1[0]; sb_ += C1[1]; PW[0][0] = cvt_pk_bf16(C0[0], C0[1]); PW[0][1] = cvt_pk_bf16(C0[2], C0[3]); asm volatile("" : "+v"(sa_), "+v"(sb_), "+v"(PW[0])); F3_SB(); \
        N1 = __builtin_amdgcn_mfma_f32_32x32x16_bf16(fq1, qr[0], (f32x16){0.f,0.f,0.f,0.f,0.f,0.f,0.f,0.f,0.f,0.f,0.f,0.f,0.f,0.f,0.f,0.f}, 0, 0, 0); fq0 = *(const LAS bf16x8*)(kq_ + 4096); sa_ += C1[2]; sb_ += C1[3]; PW[0][2] = cvt_pk_bf16(C0[4], C0[5]); PW[0][3] = cvt_pk_bf16(C0[6], C0[7]); asm volatile("" : "+v"(sa_), "+v"(sb_), "+v"(PW[0])); F3_SB(); \
        N0 = __builtin_amdgcn_mfma_f32_32x32x16_bf16(fq2, qr[1], N0, 0, 0, 0); fq1 = *(const LAS bf16x8*)(kq_ + 4608); sa_ += C1[4]; sb_ += C1[5]; PW[1][0] = cvt_pk_bf16(C0[8], C0[9]); PW[1][1] = cvt_pk_bf16(C0[10], C0[11]); asm volatile("" : "+v"(sa_), "+v"(sb_), "+v"(PW[1])); F3_SB(); \
        N1 = __builtin_amdgcn_mfma_f32_32x32x16_bf16(fq3, qr[1], N1, 0, 0, 0); fq2 = *(const LAS bf16x8*)(kq_ + 6144); sa_ += C1[6]; sb_ += C1[7]; PW[1][2] = cvt_pk_bf16(C0[12], C0[13]); PW[1][3] = cvt_pk_bf16(C0[14], C0[15]); asm volatile("" : "+v"(sa_), "+v"(sb_), "+v"(PW[1])); F3_SB(); \
        N0 = __builtin_amdgcn_mfma_f32_32x32x16_bf16(fq0, qr[2], N0, 0, 0, 0); fq3 = *(const LAS bf16x8*)(kq_ + 6656); sa_ += C1[8]; sb_ += C1[9]; PW[2][0] = cvt_pk_bf16(C1[0], C1[1]); PW[2][1] = cvt_pk_bf16(C1[2], C1[3]); asm volatile("" : "+v"(sa_), "+v"(sb_), "+v"(PW[2])); F3_SB(); \
        N1 = __builtin_amdgcn_mfma_f32_32x32x16_bf16(fq1, qr[2], N1, 0, 0, 0); sa_ += C1[10]; sb_ += C1[11]; PW[2][2] = cvt_pk_bf16(C1[4], C1[5]); PW[2][3] = cvt_pk_bf16(C1[6], C1[7]); asm volatile("" : "+v"(sa_), "+v"(sb_), "+v"(PW[2])); F3_SB(); \
        N0 = __builtin_amdgcn_mfma_f32_32x32x16_bf16(fq2, qr[3], N0, 0, 0, 0); sa_ += C1[12]; sb_ += C1[13]; PW[3][0] = cvt_pk_bf16(C1[8], C1[9]); PW[3][1] = cvt_pk_bf16(C1[10], C1[11]); asm volatile("" : "+v"(sa_), "+v"(sb_), "+v"(PW[3])); F3_SB(); \
        N1 = __builtin_amdgcn_mfma_f32_32x32x16_bf16(fq3, qr[3], N1, 0, 0, 0); sa_ += C1[14]; sb_ += C1[15]; PW[3][2] = cvt_pk_bf16(C1[12], C1[13]); PW[3][3] = cvt_pk_bf16(C1[14], C1[15]); asm volatile("" : "+v"(sa_), "+v"(sb_), "+v"(PW[3])); F3_SB(); \
        lsum += sa_ + sb_; F3_TSE(N0, N1); } while (0)
#define F3_HANDB(i, C0, C1, N0, N1, PP, PW) do { \
        const lds_cptr vt_ = vp0 + (((i) - 1) & 3) * 16384; const lds_cptr kq_ = kp0 + (((i) + 1) % NK3) * 16384; \
        const LAS float* bb_ = btab + (64 * (cw - (t0 + (i))) + 32 * (wq & 1) + r32 + 63 - 4 * hi - 59);     \
        bf16x8 fq0, fq1, fq2, fq3; float sa_ = 0.f, sb_ = 0.f, b0_, b1_, b2_, b3_; \
        fq0 = cat8(vtr(vt_ + 0), vtr(vt_ + 512)); fq1 = cat8(vtr(vt_ + 1024), vtr(vt_ + 1536)); fq2 = cat8(vtr(vt_ + 2048), vtr(vt_ + 2560)); b0_ = bb_[59]; b1_ = bb_[58]; b2_ = bb_[57]; b3_ = bb_[56]; F3_SB(); \
        if ((i) + 3 < NT) { asm volatile("s_waitcnt vmcnt(6) lgkmcnt(0)\n\ts_barrier" ::: "memory"); } else FA_WAIT_BAR(0); \
        F3_DMAK((i) + 3); F3_DMAV((i) + 2); F3_SB(); \
        o[0] = __builtin_amdgcn_mfma_f32_32x32x16_bf16(__builtin_bit_cast(bf16x8, PP[0]), fq0, o[0], 0, 0, 0); fq3 = cat8(vtr(vt_ + 3072), vtr(vt_ + 3584)); C0[0] = fast_exp2(C0[0] + b0_); C0[1] = fast_exp2(C0[1] + b1_); b0_ = bb_[51]; b1_ = bb_[50]; asm volatile("" : "+v"(C0)); F3_SB(); \
        o[0] = __builtin_amdgcn_mfma_f32_32x32x16_bf16(__builtin_bit_cast(bf16x8, PP[1]), fq1, o[0], 0, 0, 0); fq0 = cat8(vtr(vt_ + 4096), vtr(vt_ + 4608)); C0[2] = fast_exp2(C0[2] + b2_); C0[3] = fast_exp2(C0[3] + b3_); b2_ = bb_[49]; b3_ = bb_[48]; asm volatile("" : "+v"(C0)); F3_SB(); \
        o[0] = __builtin_amdgcn_mfma_f32_32x32x16_bf16(__builtin_bit_cast(bf16x8, PP[2]), fq2, o[0], 0, 0, 0); fq1 = cat8(vtr(vt_ + 5120), vtr(vt_ + 5632)); C0[4] = fast_exp2(C0[4] + b0_); C0[5] = fast_exp2(C0[5] + b1_); b0_ = bb_[43]; b1_ = bb_[42]; asm volatile("" : "+v"(C0)); F3_SB(); \
        o[0] = __builtin_amdgcn_mfma_f32_32x32x16_bf16(__builtin_bit_cast(bf16x8, PP[3]), fq3, o[0], 0, 0, 0); fq2 = cat8(vtr(vt_ + 6144), vtr(vt_ + 6656)); C0[6] = fast_exp2(C0[6] + b2_); C0[7] = fast_exp2(C0[7] + b3_); b2_ = bb_[41]; b3_ = bb_[40]; asm volatile("" : "+v"(C0)); F3_SB(); \
        o[1] = __builtin_amdgcn_mfma_f32_32x32x16_bf16(__builtin_bit_cast(bf16x8, PP[0]), fq0, o[1], 0, 0, 0); fq3 = cat8(vtr(vt_ + 7168), vtr(vt_ + 7680)); C0[8] = fast_exp2(C0[8] + b0_); C0[9] = fast_exp2(C0[9] + b1_); b0_ = bb_[35]; b1_ = bb_[34]; sa_ += C0[0]; sb_ += C0[1]; asm volatile("" : "+v"(C0), "+v"(sa_), "+v"(sb_)); F3_SB(); \
        o[1] = __builtin_amdgcn_mfma_f32_32x32x16_bf16(__builtin_bit_cast(bf16x8, PP[1]), fq1, o[1], 0, 0, 0); fq0 = *(const LAS bf16x8*)(kq_ + 0); C0[10] = fast_exp2(C0[10] + b2_); C0[11] = fast_exp2(C0[11] + b3_); b2_ = bb_[33]; b3_ = bb_[32]; sa_ += C0[2]; sb_ += C0[3]; sa_ += C0[4]; asm volatile("" : "+v"(C0), "+v"(sa_), "+v"(sb_)); F3_SB(); \
        o[1] = __builtin_amdgcn_mfma_f32_32x32x16_bf16(__builtin_bit_cast(bf16x8, PP[2]), fq2, o[1], 0, 0, 0); fq1 = *(const LAS bf16x8*)(kq_ + 512); C0[12] = fast_exp2(C0[12] + b0_); C0[13] = fast_exp2(C0[13] + b1_); b0_ = bb_[27]; b1_ = bb_[26]; sb_ += C0[5]; sa_ += C0[6]; sb_ += C0[7]; asm volatile("" : "+v"(C0), "+v"(sa_), "+v"(sb_)); F3_SB(); \
        o[1] = __builtin_amdgcn_mfma_f32_32x32x16_bf16(__builtin_bit_cast(bf16x8, PP[3]), fq3, o[1], 0, 0, 0); fq2 = *(const LAS bf16x8*)(kq_ + 2048); C0[14] = fast_exp2(C0[14] + b2_); C0[15] = fast_exp2(C0[15] + b3_); b2_ = bb_[25]; b3_ = bb_[24]; sa_ += C0[8]; sb_ += C0[9]; asm volatile("" : "+v"(C0), "+v"(sa_), "+v"(sb_)); F3_SB(); \
        N0 = __builtin_amdgcn_mfma_f32_32x32x16_bf16(fq0, qr[0], (f32x16){0.f,0.f,0.f,0.f,0.f,0.f,0.f,0.f,0.f,0.f,0.f,0.f,0.f,0.f,0.f,0.f}, 0, 0, 0); fq3 = *(const LAS bf16x8*)(kq_ + 2560); C1[0] = fast_exp2(C1[0] + b0_); C1[1] = fast_exp2(C1[1] + b1_); b0_ = bb_[19]; b1_ = bb_[18]; sa_ += C0[10]; sb_ += C0[11]; sa_ += C0[12]; PW[0][0] = cvt_pk_bf16(C0[0], C0[1]); PW[0][1] = cvt_pk_bf16(C0[2], C0[3]); asm volatile("" : "+v"(C1), "+v"(sa_), "+v"(sb_), "+v"(PW[0])); F3_SB(); \
        N1 = __builtin_amdgcn_mfma_f32_32x32x16_bf16(fq1, qr[0], (f32x16){0.f,0.f,0.f,0.f,0.f,0.f,0.f,0.f,0.f,0.f,0.f,0.f,0.f,0.f,0.f,0.f}, 0, 0, 0); fq0 = *(const LAS bf16x8*)(kq_ + 4096); C1[2] = fast_exp2(C1[2] + b2_); C1[3] = fast_exp2(C1[3] + b3_); b2_ = bb_[17]; b3_ = bb_[16]; sb_ += C0[13]; sa_ += C0[14]; sb_ += C0[15]; PW[0][2] = cvt_pk_bf16(C0[4], C0[5]); PW[0][3] = cvt_pk_bf16(C0[6], C0[7]); asm volatile("" : "+v"(C1), "+v"(sa_), "+v"(sb_), "+v"(PW[0])); F3_SB(); \
        N0 = __builtin_amdgcn_mfma_f32_32x32x16_bf16(fq2, qr[1], N0, 0, 0, 0); fq1 = *(const LAS bf16x8*)(kq_ + 4608); C1[4] = fast_exp2(C1[4] + b0_); C1[5] = fast_exp2(C1[5] + b1_); b0_ = bb_[11]; b1_ = bb_[10]; sa_ += C1[0]; sb_ += C1[1]; PW[1][0] = cvt_pk_bf16(C0[8], C0[9]); PW[1][1] = cvt_pk_bf16(C0[10], C0[11]); asm volatile("" : "+v"(C1), "+v"(sa_), "+v"(sb_), "+v"(PW[1])); F3_SB(); \
        N1 = __builtin_amdgcn_mfma_f32_32x32x16_bf16(fq3, qr[1], N1, 0, 0, 0); fq2 = *(const LAS bf16x8*)(kq_ + 6144); C1[6] = fast_exp2(C1[6] + b2_); C1[7] = fast_exp2(C1[7] + b3_); b2_ = bb_[9]; b3_ = bb_[8]; sa_ += C1[2]; sb_ += C1[3]; sa_ += C1[4]; PW[1][2] = cvt_pk_bf16(C0[12], C0[13]); PW[1][3] = cvt_pk_bf16(C0[14], C0[15]); asm volatile("" : "+v"(C1), "+v"(sa_), "+v"(sb_), "+v"(PW[1])); F3_SB(); \
        N0 = __builtin_amdgcn_mfma_f32_32x32x16_bf16(fq0, qr[2], N0, 0, 0, 0); fq3 = *(const LAS bf16x8*)(kq_ + 6656); C1[8] = fast_exp2(C1[8] + b0_); C1[9] = fast_exp2(C1[9] + b1_); b0_ = bb_[3]; b1_ = bb_[2]; sb_ += C1[5]; sa_ += C1[6]; sb_ += C1[7]; PW[2][0] = cvt_pk_bf16(C1[0], C1[1]); PW[2][1] = cvt_pk_bf16(C1[2], C1[3]); asm volatile("" : "+v"(C1), "+v"(sa_), "+v"(sb_), "+v"(PW[2])); F3_SB(); \
        N1 = __builtin_amdgcn_mfma_f32_32x32x16_bf16(fq1, qr[2], N1, 0, 0, 0); C1[10] = fast_exp2(C1[10] + b2_); C1[11] = fast_exp2(C1[11] + b3_); b2_ = bb_[1]; b3_ = bb_[0]; sa_ += C1[8]; sb_ += C1[9]; PW[2][2] = cvt_pk_bf16(C1[4], C1[5]); PW[2][3] = cvt_pk_bf16(C1[6], C1[7]); asm volatile("" : "+v"(C1), "+v"(sa_), "+v"(sb_), "+v"(PW[2])); F3_SB(); \
        N0 = __builtin_amdgcn_mfma_f32_32x32x16_bf16(fq2, qr[3], N0, 0, 0, 0); C1[12] = fast_exp2(C1[12] + b0_); C1[13] = fast_exp2(C1[13] + b1_); sa_ += C1[10]; sb_ += C1[11]; sa_ += C1[12]; PW[3][0] = cvt_pk_bf16(C1[8], C1[9]); PW[3][1] = cvt_pk_bf16(C1[10], C1[11]); asm volatile("" : "+v"(C1), "+v"(sa_), "+v"(sb_), "+v"(PW[3])); F3_SB(); \
        N1 = __builtin_amdgcn_mfma_f32_32x32x16_bf16(fq3, qr[3], N1, 0, 0, 0); C1[14] = fast_exp2(C1[14] + b2_); C1[15] = fast_exp2(C1[15] + b3_); sb_ += C1[13]; sa_ += C1[14]; sb_ += C1[15]; PW[3][2] = cvt_pk_bf16(C1[12], C1[13]); PW[3][3] = cvt_pk_bf16(C1[14], C1[15]); asm volatile("" : "+v"(C1), "+v"(sa_), "+v"(sb_), "+v"(PW[3])); F3_SB(); \
        lsum += sa_ + sb_; } while (0)
#define F3_SLOW(i, C0, C1, N0, N1, PP, PW) do { F3_HEAD(i); \
        const bool vc = ((i) >= iv0) && ((i) <= iv1), vp = ((i) - 1 >= iv0) && ((i) - 1 <= iv1), vn = ((i) + 1 >= iv0) && ((i) + 1 <= iv1) && ((i) + 1 < NT); \
        if (vp) F3_PV((i) - 1, PP); \
        F3_SB(); \
        if (vn) { F3_QK((i) + 1, N0, N1); } \
        F3_SB(); \
        if (vc) { F3_BIAS((i), C0, C1); F3_SM(C0, C1, PW); } else { upd = false; }     \
        F3_SB(); F3_RESC(); } while (0)
    bool upd = false; float fsc = 1.f;
    asm volatile("s_waitcnt vmcnt(8) lgkmcnt(0)\n\ts_barrier" ::: "memory");
    if (iv0 == 0) { F3_QK(0, cA0, cA1); }
    F3_SB();
    if (MODE == 0) {
        F3_SLOW(0, cA0, cA1, cB0, cB1, pB, pA);
        if (NOMAX && FA_HAND) {
#pragma unroll 1
            for (int i = 1; i + 3 < NT; i += 2) { F3_HAND(i, cB0, cB1, cA0, cA1, pA, pB); F3_HAND(i + 1, cA0, cA1, cB0, cB1, pB, pA); }
            if (NT >= 4) { F3_HAND(NT - 3, cB0, cB1, cA0, cA1, pA, pB); }
        } else {
#pragma unroll 1
            for (int i = 1; i + 3 < NT; i += 2) { F3_SLOW(i, cB0, cB1, cA0, cA1, pA, pB); F3_SLOW(i + 1, cA0, cA1, cB0, cB1, pB, pA); }
            if (NT >= 4) { F3_SLOW(NT - 3, cB0, cB1, cA0, cA1, pA, pB); }
        }
        if (NT >= 4) { F3_SLOW(NT - 2, cA0, cA1, cB0, cB1, pB, pA); }
        F3_SLOW(NT - 1, cB0, cB1, cA0, cA1, pA, pB);
    } else {
        F3_SLOW(0, cA0, cA1, cB0, cB1, pB, pA); F3_SLOW(1, cB0, cB1, cA0, cA1, pA, pB);
        if (NOMAX && FA_HANDB) {
#pragma unroll 1
            for (int i = 2; i + 3 < NT; i += 2) { F3_HANDB(i, cA0, cA1, cB0, cB1, pB, pA); F3_HANDB(i + 1, cB0, cB1, cA0, cA1, pA, pB); }
        } else {
#pragma unroll 1
            for (int i = 2; i + 3 < NT; i += 2) { F3_SLOW(i, cA0, cA1, cB0, cB1, pB, pA); F3_SLOW(i + 1, cB0, cB1, cA0, cA1, pA, pB); }
        }
        if (NT >= 4) { F3_SLOW(NT - 2, cA0, cA1, cB0, cB1, pB, pA); F3_SLOW(NT - 1, cB0, cB1, cA0, cA1, pA, pB); }
    }
#if PROBE_T
    if (MODE == 0 && blockIdx.x == 0 && (wid & 3) == 0 && u >= 32 && lane == 0 && tqn) { unsigned long long* pv = (unsigned long long*)((char*)Yg - WS_AQ + WS_PROBE) + (ch ? 8 : 0); pv[0] = tq0 / tqn; pv[1] = tq1 / tqn; pv[2] = tqn; }
#endif
    if (NT - 1 <= iv1) F3_PV(NT - 1, pB);
#undef F3_TS
#undef F3_TSE
#undef F3_HEAD
#undef F3_SLOW
#undef F3_HAND
#undef F3_HANDB
#undef F3_DMAK
#undef F3_DMAV
#undef F3_SB
#undef F3_MX3
#undef F3_QK
#undef F3_BIAS
#undef F3_PV
#undef F3_SM
#undef F3_RESC
    lsum = swapsum(lsum);
    if (hi == 0) wsf[32 + r32] = lsum;
    LDS_WAIT();
#pragma unroll
    for (int r = 0; r < 16; ++r) { const float il = fast_rcp(wsf[32 + crow(r, hi)]);
#pragma unroll
        for (int d = 0; d < NDB; ++d) o[d][r] *= il; }
    FA_BAR();
    if (MODE == 0) {
        LAS float* xf = (LAS float*)lds + (wid & 3) * 4096;
        if (ch == 1) {
#pragma unroll
            for (int d = 0; d < 4; ++d)
#pragma unroll
                for (int r = 0; r < 16; ++r) xf[(d * 16 + r) * 64 + lane] = o[d][r];
        }
        FA_BAR();
        if (ch == 0) {
            float ss[16];
#pragma unroll
            for (int r = 0; r < 16; ++r) ss[r] = 0.f;
#pragma unroll
            for (int d = 0; d < 4; ++d)
#pragma unroll
                for (int r = 0; r < 16; ++r) { const float y = o[d][r] - lam * xf[(d * 16 + r) * 64 + lane]; o[d][r] = y; ss[r] += y * y; }
            LAS bf16_t* stg = (LAS bf16_t*)(lds + 65536) + wid * 4096;
            float g[4];
#pragma unroll
            for (int d = 0; d < 4; ++d) g[d] = subln[32 * d + r32] * osc;
#pragma unroll
            for (int r = 0; r < 16; ++r) { const float rs = __builtin_amdgcn_rsqf(half_sum32(ss[r]) * (1.0f / 128.0f) + EPS); const int orow = crow(r, hi);
#pragma unroll
                for (int d = 0; d < 4; ++d) stg[orow * 128 + d * 32 + r32] = (bf16_t)f2bf(o[d][r] * rs * g[d]); }
            LDS_WAIT();
#pragma unroll
            for (int i = 0; i < 8; ++i) { const int idx = i * 64 + lane, row = idx >> 4, c8 = idx & 15;
                const u32x4 v = *(const LAS u32x4*)(stg + row * 128 + c8 * 8);
                *(u32x4*)(Yg + (qrow + row) * PITCH + hq * 128 + c8 * 8) = v; }
        }
    } else {
        LAS bf16_t* stg = (LAS bf16_t*)lds + wid * 2048;
#pragma unroll
        for (int r = 0; r < 16; ++r) { const int orow = crow(r, hi);
#pragma unroll
            for (int d = 0; d < 2; ++d) stg[orow * 64 + d * 32 + r32] = (bf16_t)f2bf(o[d][r]); }
        LDS_WAIT();
#pragma unroll
        for (int i = 0; i < 4; ++i) { const int idx = i * 64 + lane, row = idx >> 3, c8 = idx & 7;
            const u32x4 v = *(const LAS u32x4*)(stg + row * 64 + c8 * 8);
            *(u32x4*)(Yg + (qrow + row) * PITCH + hq * 128 + ch * 64 + c8 * 8) = v; }
    }
    FA_BAR();
#if PROBE_T
    if (MODE == 0 && blockIdx.x == 0 && wid == 0 && u >= 32 && lane == 0) { unsigned long long* pv = (unsigned long long*)((char*)Yg - WS_AQ + WS_PROBE); pv[3] = (__builtin_amdgcn_s_memtime() - tu0_) / 10; }
#endif
}

#if FA_V2 == 3
#define FA_UNIT attn_unit2
#elif FA_V2
#define FA_UNIT attn_unit2
#else
#define FA_UNIT attn_unit
#endif
__device__ __forceinline__ void attn_a_phase(LAS unsigned char* lds, const int tid, unsigned char* ws, bf16_t* yout, const int vcu, const int G, const float* lq1, const float* lk1, const float* lq2, const float* lk2,
                                             const float* subln, const float lam_init, const float* gq, const float* gk, const int pm = 0) {
    const int lane = tid & 63;
    const float lamv = expf(wave_sum(lq1[lane] * lk1[lane])) - expf(wave_sum(lq2[lane] * lk2[lane])) + lam_init;
    const float lam = __uint_as_float(__builtin_amdgcn_readfirstlane(__float_as_uint(lamv)));
    const float bound = wave_max(fabsf(gq[lane])) * wave_max(fabsf(gk[lane])) * 64.0f * C2;
    const bool nomax = __uint_as_float(__builtin_amdgcn_readfirstlane(__float_as_uint(bound))) < FA_NOMAX_BOUND_A;
    for (int v = vcu; v < 256; v += G) {
        const int bh = v >> 5, p = v & 31;
#pragma unroll 1
        for (int k = 0; k < 2; ++k) {
#if FA_V2 == 3
            if (nomax) attn_unit3<0, true>(lds, tid, (const bf16_t*)(ws + WS_AQ), (const bf16_t*)(ws + WS_AK), (const bf16_t*)(ws + WS_AV), yout, bh >> 2, bh & 3, k ? 63 - p : p, lam, 1.0f - lam_init, subln, pm);
            else       attn_unit3<0, false>(lds, tid, (const bf16_t*)(ws + WS_AQ), (const bf16_t*)(ws + WS_AK), (const bf16_t*)(ws + WS_AV), yout, bh >> 2, bh & 3, k ? 63 - p : p, lam, 1.0f - lam_init, subln, pm);
#else
            FA_UNIT<0>(lds, tid, (const bf16_t*)(ws + WS_AQ), (const bf16_t*)(ws + WS_AK), (const bf16_t*)(ws + WS_AV), yout, bh >> 2, bh & 3, k ? 63 - p : p, lam, 1.0f - lam_init, subln, pm);
#endif
        }
    }
}
__device__ __forceinline__ void attn_b_phase(LAS unsigned char* lds, const int tid, unsigned char* ws, bf16_t* yout, const int vcu, const int G, const float* relb, const float* gq, const float* gk) {
    for (int v = vcu; v < 256; v += G) {
        const int bp = v >> 5, b = bp >> 2, hp = bp & 3;
        LAS float* bt = (LAS float*)(lds + (FA_V2 ? LDS_BIAS2 : LDS_BIAS));
        for (int i = tid; i < 1280; i += 512) { const int c = i / 640, j = i - c * 640; bt[i] = relb[(2 * hp + c) * 320 + (j < 320 ? j : 319)] * LOG2E; }
        FA_BAR();
        float bm = 0.f;
        for (int i = tid & 63; i < 1280; i += 64) bm = fmaxf(bm, fabsf(bt[i]));
        const float bound = wave_max(fabsf(gq[tid & 63])) * wave_max(fabsf(gk[tid & 63])) * 64.0f * C2 + wave_max(bm);
        const bool nomax = __uint_as_float(__builtin_amdgcn_readfirstlane(__float_as_uint(bound))) < FA_NOMAX_BOUND_B;
#pragma unroll 1
        for (int k = 0; k < 2; ++k) {
#if FA_V2 == 3
            if (nomax) attn_unit3<1, true>(lds, tid, (const bf16_t*)(ws + WS_BQ), (const bf16_t*)(ws + WS_BK), (const bf16_t*)(ws + WS_BV), yout, b, hp, 2 * (v & 31) + k, 0.f, 0.f, nullptr);
            else       attn_unit3<1, false>(lds, tid, (const bf16_t*)(ws + WS_BQ), (const bf16_t*)(ws + WS_BK), (const bf16_t*)(ws + WS_BV), yout, b, hp, 2 * (v & 31) + k, 0.f, 0.f, nullptr);
#else
            FA_UNIT<1>(lds, tid, (const bf16_t*)(ws + WS_BQ), (const bf16_t*)(ws + WS_BK), (const bf16_t*)(ws + WS_BV), yout, b, hp, 2 * (v & 31) + k, 0.f, 0.f, nullptr);
#endif
        }
    }
}

__device__ __forceinline__ void ret_kv_phase(LAS unsigned char* lds, const int tid_, unsigned char* ws, const int gw, const int ngw) {
    int tid = tid_; asm volatile("" : "+v"(tid));
    const int lane = tid & 63, r32 = lane & 31, hi = lane >> 5, wid = __builtin_amdgcn_readfirstlane(tid >> 6);
    const bf16_t* CK = (const bf16_t*)(ws + WS_CK); const bf16_t* CV = (const bf16_t*)(ws + WS_CV); float* KVT = (float*)(ws + WS_R4);
    LAS unsigned char* wl = lds + wid * 16384; const unsigned wl0 = (unsigned)(uintptr_t)wl;
    const lds_cptr tp0 = (lds_cptr)wl + ((lane >> 4) & 1) * 32 + (lane & 3) * 8 + (4 * hi + ((lane & 15) >> 2)) * 64;
    for (int task = gw; task < 2048; task += ngw) {
        const int eh = task & 1, n = (task >> 1) & 127, bh = task >> 8, b = bh >> 2, h = bh & 3;
        const size_t row0 = (size_t)b * SEQ + n * 64;
#pragma unroll
        for (int p = 0; p < 8; ++p) {
            glds16(CK + (row0 + 16 * (p & 3) + (lane >> 2)) * 256 + h * 64 + 32 * (p >> 2) + (lane & 3) * 8, (unsigned)__builtin_amdgcn_readfirstlane(wl0 + p * 1024));
            glds16(CV + (row0 + 16 * (p & 3) + (lane >> 2)) * 512 + h * 128 + eh * 64 + 32 * (p >> 2) + (lane & 3) * 8, (unsigned)__builtin_amdgcn_readfirstlane(wl0 + 8192 + p * 1024));
        }
        asm volatile("s_waitcnt vmcnt(0)" ::: "memory");
#pragma unroll
        for (int eb = 0; eb < 2; ++eb)
#pragma unroll
            for (int db = 0; db < 2; ++db) {
                f32x16 acc;
#pragma unroll
                for (int r = 0; r < 16; ++r) acc[r] = 0.f;
#pragma unroll
                for (int s = 0; s < 4; ++s) {
                    const lds_cptr va = tp0 + 8192 + (eb * 4 + s) * 1024, ka = tp0 + (db * 4 + s) * 1024;
                    acc = __builtin_amdgcn_mfma_f32_32x32x16_bf16(cat8(vtr(va), vtr(va + 512)), cat8(vtr(ka), vtr(ka + 512)), acc, 0, 0, 0);
                }
                float* dst = KVT + ((size_t)(bh * 128 + n) * 128 + eh * 64 + eb * 32) * 64 + db * 32 + r32;
#pragma unroll
                for (int r = 0; r < 16; ++r) dst[(size_t)crow(r, hi) * 64] = acc[r];
            }
        LDS_WAIT(); asm volatile("" ::: "memory");
    }
}
__device__ __forceinline__ void ret_scan_phase(const int tid, unsigned char* ws, const int vcu, const int G) {
    float* KVT = (float*)(ws + WS_R4);
    for (int gt = vcu * 512 + tid; gt < 65536; gt += G * 512) {
        const int bh = gt >> 13, idx = gt & 8191, h = bh & 3;
        const float l2g = log2_gamma(h), gam = fast_exp2(l2g), g63 = fast_exp2(63.f * l2g), g64 = fast_exp2(64.f * l2g);
        float* p = KVT + (size_t)bh * 128 * 8192 + idx; float s = 0.f;
        for (int n0 = 0; n0 < 128; n0 += 32) {
            float kv[32];
#pragma unroll
            for (int j = 0; j < 32; ++j) kv[j] = p[(size_t)(n0 + j) * 8192];
#pragma unroll
            for (int j = 0; j < 32; ++j) { p[(size_t)(n0 + j) * 8192] = gam * s; s = g64 * s + g63 * kv[j]; }
        }
    }
}
__device__ __forceinline__ void ret_out_phase(LAS unsigned char* lds, const int tid_, unsigned char* ws, const int gw, const int ngw, const float* onorm) {
    int tid = tid_; asm volatile("" : "+v"(tid));
    const int lane = tid & 63, r32 = lane & 31, hi = lane >> 5, wid = __builtin_amdgcn_readfirstlane(tid >> 6);
    const bf16_t* CQ = (const bf16_t*)(ws + WS_CQ); const bf16_t* CK = (const bf16_t*)(ws + WS_CK); const bf16_t* CV = (const bf16_t*)(ws + WS_CV); bf16_t* CG = (bf16_t*)(ws + WS_CG);
    const float* KVT = (const float*)(ws + WS_R4);
    LAS unsigned char* wl = lds + wid * 16384; const unsigned wl0 = (unsigned)(uintptr_t)wl;
    const lds_cptr tp0 = (lds_cptr)wl + ((lane >> 4) & 1) * 32 + (lane & 3) * 8 + (4 * hi + ((lane & 15) >> 2)) * 64;
    for (int task = gw; task < 2048; task += ngw) {
        const int rh = task & 1, n = (task >> 1) & 127, bh = task >> 8, b = bh >> 2, h = bh & 3;
        const size_t row0 = (size_t)b * SEQ + n * 64;
        const float l2g = log2_gamma(h);
#pragma unroll
        for (int p = 0; p < 16; ++p)
            glds16(CV + (row0 + 16 * (p & 3) + (lane >> 2)) * 512 + h * 128 + 32 * (p >> 2) + (lane & 3) * 8, (unsigned)__builtin_amdgcn_readfirstlane(wl0 + p * 1024));
        bf16x8 qr[4], kf[8];
#pragma unroll
        for (int i = 0; i < 4; ++i) {
            qr[i] = *(const bf16x8*)(CQ + (row0 + 32 * rh + r32) * 256 + h * 64 + i * 16 + hi * 8);
            kf[2 * i] = *(const bf16x8*)(CK + (row0 + r32) * 256 + h * 64 + i * 16 + hi * 8);
            kf[2 * i + 1] = *(const bf16x8*)(CK + (row0 + 32 + r32) * 256 + h * 64 + i * 16 + hi * 8);
        }
        f32x16 p0, p1;
#pragma unroll
        for (int r = 0; r < 16; ++r) { p0[r] = 0.f; p1[r] = 0.f; }
#pragma unroll
        for (int i = 0; i < 4; ++i) { p0 = __builtin_amdgcn_mfma_f32_32x32x16_bf16(kf[2 * i], qr[i], p0, 0, 0, 0); p1 = __builtin_amdgcn_mfma_f32_32x32x16_bf16(kf[2 * i + 1], qr[i], p1, 0, 0, 0); }
        const int qi = 32 * rh + r32;
#pragma unroll
        for (int r = 0; r < 16; ++r) { const int key = crow(r, hi); if (key > qi) p0[r] = 0.f; if (key + 32 > qi) p1[r] = 0.f; }
        const bf16x8 pa0 = pack_p(p0, 0), pa1 = pack_p(p0, 8), pa2 = pack_p(p1, 0), pa3 = pack_p(p1, 8);
        asm volatile("s_waitcnt vmcnt(0)" ::: "memory");
        const float* st = KVT + (size_t)(bh * 128 + n) * 8192;
        f32x16 o[4];
#pragma unroll
        for (int d = 0; d < 4; ++d) {
            const lds_cptr vd = tp0 + d * 4096;
            f32x16 a;
#pragma unroll
            for (int r = 0; r < 16; ++r) a[r] = 0.f;
            a = __builtin_amdgcn_mfma_f32_32x32x16_bf16(pa0, cat8(vtr(vd), vtr(vd + 512)), a, 0, 0, 0);
            a = __builtin_amdgcn_mfma_f32_32x32x16_bf16(pa1, cat8(vtr(vd + 1024), vtr(vd + 1024 + 512)), a, 0, 0, 0);
            a = __builtin_amdgcn_mfma_f32_32x32x16_bf16(pa2, cat8(vtr(vd + 2048), vtr(vd + 2048 + 512)), a, 0, 0, 0);
            a = __builtin_amdgcn_mfma_f32_32x32x16_bf16(pa3, cat8(vtr(vd + 3072), vtr(vd + 3072 + 512)), a, 0, 0, 0);
#pragma unroll
            for (int i = 0; i < 4; ++i) {
                const f32x4 s0 = *(const f32x4*)(st + (size_t)(32 * d + r32) * 64 + i * 16 + hi * 8), s1 = *(const f32x4*)(st + (size_t)(32 * d + r32) * 64 + i * 16 + hi * 8 + 4);
                a = __builtin_amdgcn_mfma_f32_32x32x16_bf16(qr[i], __builtin_bit_cast(bf16x8, epi::pack8(s0, s1)), a, 0, 0, 0);
            }
            o[d] = a;
        }
        LDS_WAIT(); asm volatile("" ::: "memory");
        LAS float* stg = (LAS float*)wl;
        float gn[4];
#pragma unroll
        for (int d = 0; d < 4; ++d) gn[d] = onorm[h * 128 + 32 * d + r32];
#pragma unroll
        for (int r = 0; r < 16; ++r) {
            const float dec = fast_exp2((float)(32 * rh + crow(r, hi)) * l2g);
            float ss = 0.f;
#pragma unroll
            for (int d = 0; d < 4; ++d) { o[d][r] *= dec; ss += o[d][r] * o[d][r]; }
            const float rs = __builtin_amdgcn_rsqf(half_sum32(ss) * (1.0f / 128.0f) + EPS);
#pragma unroll
            for (int d = 0; d < 4; ++d) stg[crow(r, hi) * 128 + d * 32 + r32] = o[d][r] * rs * gn[d];
        }
        LDS_WAIT(); asm volatile("" ::: "memory");
#pragma unroll
        for (int i = 0; i < 8; ++i) { const int idx = i * 64 + lane, row = idx >> 4, c8 = idx & 15;
            const f32x4 y0 = *(const LAS f32x4*)(stg + row * 128 + c8 * 8), y1 = *(const LAS f32x4*)(stg + row * 128 + c8 * 8 + 4);
            bf16_t* gp = CG + (row0 + 32 * rh + row) * 512 + h * 128 + c8 * 8;
            const u32x4 gv = *(const u32x4*)gp;
            const f32x4 g0 = {bflo(gv.x), bfhi(gv.x), bflo(gv.y), bfhi(gv.y)}, g1 = {bflo(gv.z), bfhi(gv.z), bflo(gv.w), bfhi(gv.w)};
            *(u32x4*)gp = epi::pack8(y0 * g0, y1 * g1); }
        LDS_WAIT(); asm volatile("" ::: "memory");
    }
}
}
#define XB_TMO      128
#define XB_XCNT(j)  (256  + 64 * (j))
#define XB_XSUB(j)  (1280 + 64 * (j))
#define XB_XGEN(j)  (2304 + 64 * (j))
#define XB_TOP      3328
#define XB_TOPGEN   3392
#define XCD_BAR_WORDS 3456
#define XB_SPIN_CAP (1u << 18)

__device__ __forceinline__ unsigned xb_ld(unsigned* p)              { return __hip_atomic_load(p, __ATOMIC_RELAXED, __HIP_MEMORY_SCOPE_AGENT); }
__device__ __forceinline__ unsigned xb_add(unsigned* p, unsigned v) { return __hip_atomic_fetch_add(p, v, __ATOMIC_RELAXED, __HIP_MEMORY_SCOPE_AGENT); }
__device__ __forceinline__ unsigned xb_xcc_id() { return (unsigned)__builtin_amdgcn_s_getreg((3 << 11) | 20) & 0xFu; }
#define XB_SPIN(cond, bar) do { unsigned _sp = 0; while (cond) { __builtin_amdgcn_s_sleep(1); \
    if ((++_sp & 255u) == 0u) { if (xb_ld(&(bar)[XB_TMO])) break; if (_sp > XB_SPIN_CAP) { atomicAdd(&(bar)[XB_TMO], 1u); break; } } } } while (0)

struct XcdBarrier {
    unsigned* bar; unsigned x;
    volatile LAS unsigned* st;
};

__device__ __forceinline__ XcdBarrier xcd_barrier_post(unsigned* bar, volatile LAS unsigned* st) {
    XcdBarrier b; b.bar = bar; b.x = xb_xcc_id(); b.st = st;
    if (threadIdx.x == 0) (void)xb_add(&bar[XB_XCNT(b.x)], 1u);
    return b;
}
__device__ __forceinline__ void xcd_barrier_complete(unsigned* bar, unsigned x, unsigned& nloc, unsigned& nx) {
    const unsigned G = gridDim.x * gridDim.y * gridDim.z;
    unsigned sum, cnt, mine, sp = 0u;
    for (;;) {
        sum = 0u; cnt = 0u; mine = 0u;
#pragma unroll
        for (unsigned j = 0; j < 16; ++j) { const unsigned c = xb_ld(&bar[XB_XCNT(j)]); sum += c; cnt += (c > 0u) ? 1u : 0u; mine = (j == x) ? c : mine; }
        if (sum == G) break;
        __builtin_amdgcn_s_sleep(1);
        if ((++sp & 255u) == 0u) { if (xb_ld(&bar[XB_TMO])) break; if (sp > XB_SPIN_CAP) { atomicAdd(&bar[XB_TMO], 1u); break; } }
    }
    nloc = mine > 0u ? mine : 1u; nx = cnt > 0u ? cnt : 1u;
}

__device__ __forceinline__ void xcd_barrier(const XcdBarrier& b) {
    asm volatile("s_waitcnt vmcnt(0)" ::: "memory");
    __syncthreads();
    if (threadIdx.x == 0) {
        unsigned* bar = b.bar;
        __builtin_amdgcn_s_waitcnt(0);
        unsigned nloc = b.st[0], nx = b.st[1];
        if (nloc == 0u) { xcd_barrier_complete(bar, b.x, nloc, nx); b.st[0] = nloc; b.st[1] = nx; }
        const unsigned old = xb_add(&bar[XB_XSUB(b.x)], 1u);
        const unsigned gen = old / nloc;
        if (old + 1u == (gen + 1u) * nloc) {
            __builtin_amdgcn_fence(__ATOMIC_RELEASE, "agent");
            asm volatile("s_waitcnt vmcnt(0)" ::: "memory");
            const unsigned og = xb_add(&bar[XB_TOP], 1u);
            const unsigned tg = og / nx;
            if (og + 1u == (tg + 1u) * nx) xb_add(&bar[XB_TOPGEN], 1u);
            else XB_SPIN(xb_ld(&bar[XB_TOPGEN]) == tg, bar);
            __builtin_amdgcn_fence(__ATOMIC_ACQUIRE, "agent");
            xb_add(&bar[XB_XGEN(b.x)], 1u);
            asm volatile("s_waitcnt vmcnt(0)" ::: "memory");
        } else {
            XB_SPIN(xb_ld(&bar[XB_XGEN(b.x)]) == gen, bar);
            __builtin_amdgcn_fence(__ATOMIC_ACQUIRE, "agent");
            asm volatile("s_waitcnt vmcnt(0)" ::: "memory");
        }
    }
    __syncthreads();
}

constexpr int NWAVES = 8;
constexpr int RING_OFF = 0, RING_BYTES = 131072;
constexpr int LDSCTL_OFF = RING_BYTES, MISC_OFF = LDSCTL_OFF + 320;
constexpr int LDS_BYTES = 147456;
constexpr int CW_TMO = 0, CW_CODE = 1, CW_BAR = 4096;
constexpr int PH_PER_LAYER = 12 - (HIDE_CONV ? 1 : 0) - (FUSE_RET ? 2 : 0) - (FUSE_GM ? 1 : 0);
constexpr int N_PHASES = 1 + PH_PER_LAYER * DEPTH;

#define CAS __attribute__((address_space(4)))
struct Args { const GAS float* in[N_IN]; GAS float* out; GAS unsigned char* ws; double ropec[32]; float lam_init[2]; };

template <class T> __device__ __forceinline__ T* as_global(GAS T* p) { return (T*)p; }
__device__ __forceinline__ int conv_dst_row(int mode, int row_off, int n0) {
    if (mode == 0) return row_off + n0;
    if (mode == 1) return 256 * (n0 >> 7) + (n0 & 127) + row_off;
    return (n0 < NIN1) ? ((n0 & ~255) + 128 * ((n0 >> 5) & 1) + 32 * ((n0 >> 6) & 3)) : n0;
}
__device__ __forceinline__ void conv_item(const float* W, const float* gain, int K, int N, bf16_t* WT, int mode, int row_off, LAS float* scr, int item, int lane) {
    const int nblk = N / 32, kb = item / nblk, nb = item % nblk, k0 = 64 * kb, n0 = 32 * nb;
    float wv[32], gv[32];
#pragma unroll
    for (int i = 0; i < 32; ++i) { const int kk = 2 * i + (lane >> 5); wv[i] = W[(size_t)(k0 + kk) * N + n0 + (lane & 31)]; gv[i] = gain ? gain[k0 + kk] : 1.0f; }
#pragma unroll
    for (int i = 0; i < 32; ++i) { const int kk = 2 * i + (lane >> 5); scr[kk * 33 + (lane & 31)] = wv[i] * gv[i]; }
    LDS_WAIT(); asm volatile("" ::: "memory");
    const int c = lane & 7, drow = conv_dst_row(mode, row_off, n0);
#pragma unroll
    for (int j = 0; j < 4; ++j) { const int n = (lane >> 3) + 8 * j; const LAS float* s = scr + (8 * c) * 33 + n;
        u32x4 o; o.x = pk2(s[0 * 33], s[1 * 33]); o.y = pk2(s[2 * 33], s[3 * 33]); o.z = pk2(s[4 * 33], s[5 * 33]); o.w = pk2(s[6 * 33], s[7 * 33]);
        *(GAS u32x4*)(WT + (size_t)(drow + n) * K + k0 + 8 * c) = o; }
    LDS_WAIT(); asm volatile("" ::: "memory");
}
__device__ __forceinline__ void convert_layer(const CAS Args& a, unsigned char* ws, int l, int part, LAS unsigned char* lds, int gw, int ngw, int wave, int lane) {
    LAS float* scr = (LAS float*)(lds + wave * 16384);
    unsigned char* wb = ws + WS_W;
    constexpr int I_GU = (DM / 64) * (DFF / 32), I_D = (DFF / 64) * (DM / 32), I_IN = (DM / 64) * (NIN / 32), I_BR = (512 / 64) * (DM / 32), I_O = (DM / 64) * (DM / 32);
    constexpr int NITEMS = 4 * I_GU + 2 * I_D + I_IN + 3 * I_BR + I_O;
    const size_t oGU = (size_t)l * DM * DFF, oD = (size_t)l * DFF * DM, oIN = (size_t)l * DM * NIN, oBR = (size_t)l * 512 * DM, oO = (size_t)l * DM * DM;
    constexpr int P1 = 2 * I_GU + I_D, P2 = P1 + I_IN + 3 * I_BR + I_O;
    const int it_lo = (part <= 1) ? 0 : (part == 2 ? P1 : P2), it_hi = (part == 0 || part == 3) ? NITEMS : (part == 1 ? P1 : P2);
    for (int it = it_lo + gw; it < it_hi; it += ngw) {
        int r = it;
        if (r < I_GU) { conv_item(as_global(a.in[I_F1G]) + oGU, as_global(a.in[I_F1N]) + l * DM, DM, DFF, (bf16_t*)(wb + W_GU1), 1, 0, scr, r, lane); continue; } r -= I_GU;
        if (r < I_GU) { conv_item(as_global(a.in[I_F1U]) + oGU, as_global(a.in[I_F1N]) + l * DM, DM, DFF, (bf16_t*)(wb + W_GU1), 1, 128, scr, r, lane); continue; } r -= I_GU;
        if (r < I_D)  { conv_item(as_global(a.in[I_F1D]) + oD, nullptr, DFF, DM, (bf16_t*)(wb + W_D1), 0, 0, scr, r, lane); continue; } r -= I_D;
        if (r < I_IN) { conv_item(as_global(a.in[I_WIN]) + oIN, as_global(a.in[I_MIXN]) + l * DM, DM, NIN, (bf16_t*)(wb + W_IN), 2, 0, scr, r, lane); continue; } r -= I_IN;
        if (r < I_BR) { conv_item(as_global(a.in[I_WBA]) + oBR, nullptr, 512, DM, (bf16_t*)(wb + W_BR), 0, 0, scr, r, lane); continue; } r -= I_BR;
        if (r < I_BR) { conv_item(as_global(a.in[I_WBB]) + oBR, nullptr, 512, DM, (bf16_t*)(wb + W_BR), 0, DM, scr, r, lane); continue; } r -= I_BR;
        if (r < I_BR) { conv_item(as_global(a.in[I_WBC]) + oBR, nullptr, 512, DM, (bf16_t*)(wb + W_BR), 0, 2 * DM, scr, r, lane); continue; } r -= I_BR;
        if (r < I_O)  { conv_item(as_global(a.in[I_WOUT]) + oO, nullptr, DM, DM, (bf16_t*)(wb + W_OUT), 0, 0, scr, r, lane); continue; } r -= I_O;
        if (r < I_GU) { conv_item(as_global(a.in[I_F2G]) + oGU, as_global(a.in[I_F2N]) + l * DM, DM, DFF, (bf16_t*)(wb + W_GU2), 1, 0, scr, r, lane); continue; } r -= I_GU;
        if (r < I_GU) { conv_item(as_global(a.in[I_F2U]) + oGU, as_global(a.in[I_F2N]) + l * DM, DM, DFF, (bf16_t*)(wb + W_GU2), 1, 128, scr, r, lane); continue; } r -= I_GU;
        conv_item(as_global(a.in[I_F2D]) + oD, nullptr, DFF, DM, (bf16_t*)(wb + W_D2), 0, 0, scr, r, lane);
    }
}
__device__ __forceinline__ void rope_tables(const CAS Args& a, unsigned char* ws, int gtid, int ngt) {
    float* cosT = (float*)(ws + WS_COS); float* sinT = (float*)(ws + WS_SIN);
    for (int i = gtid; i < SEQ * 32; i += ngt) { const int t = i >> 5, k = i & 31;
        const double rev = (double)t * a.ropec[k]; const float fr = (float)(rev - floor(rev));
        cosT[i] = __builtin_amdgcn_cosf(fr); sinT[i] = __builtin_amdgcn_sinf(fr); }
}


constexpr int CW_CNT = 32768;
__device__ __forceinline__ void cnt_signal(gu32* ctl, int idx) {
    asm volatile("s_waitcnt vmcnt(0)" ::: "memory");
    __syncthreads();
    if (threadIdx.x == 0) {
        __builtin_amdgcn_fence(__ATOMIC_RELEASE, "agent");
        asm volatile("s_waitcnt vmcnt(0)" ::: "memory");
        (void)__hip_atomic_fetch_add((unsigned*)(ctl + CW_CNT + 64 * idx), 1u, __ATOMIC_RELAXED, __HIP_MEMORY_SCOPE_AGENT);
    }
}
__device__ __forceinline__ void cnt_wait(gu32* ctl, int idx, unsigned want) {
    if (threadIdx.x == 0) {
        unsigned sp = 0;
        while (__hip_atomic_load((unsigned*)(ctl + CW_CNT + 64 * idx), __ATOMIC_RELAXED, __HIP_MEMORY_SCOPE_AGENT) < want) {
            __builtin_amdgcn_s_sleep(2);
            if (++sp > (1u << 22)) { __hip_atomic_store((unsigned*)(ctl + CW_TMO), 1u, __ATOMIC_RELAXED, __HIP_MEMORY_SCOPE_AGENT); break; }
        }
        __builtin_amdgcn_fence(__ATOMIC_ACQUIRE, "agent");
        asm volatile("s_waitcnt vmcnt(0)" ::: "memory");
    }
    __syncthreads();
}
struct Ctx { LAS unsigned char* lds; int tid, lane, wave, vcu, G, bx, gw, ngw; unsigned char* ws; float* X; const CAS Args* ap; };
enum { K_PRO = 0, K_CONV, K_UP, K_DOWN, K_WIN, K_KV, K_SCAN, K_MIX, K_GATE, K_MERGE, K_WOUT, N_KINDS };
__host__ __device__ __forceinline__ void phase_decode(int ph, int& kind, int& l, int& ffn2) {
    if (ph == 0) { kind = K_PRO; l = 0; ffn2 = 0; return; }
    int k = (ph - 1) % PH_PER_LAYER + (HIDE_CONV ? 1 : 0); l = (ph - 1) / PH_PER_LAYER;
    if (FUSE_RET && k >= 4) k += 2;
    if (FUSE_GM && k >= 8) k += 1;
    ffn2 = (k >= 10);
    const int tab[12] = {K_CONV, K_UP, K_DOWN, K_WIN, K_KV, K_SCAN, K_MIX, K_GATE, K_MERGE, K_WOUT, K_UP, K_DOWN};
    kind = (k == 0) ? K_CONV : (k == 1 || k == 10) ? K_UP : (k == 2 || k == 11) ? K_DOWN : (k == 3) ? K_WIN : (k == 4) ? K_KV : (k == 5) ? K_SCAN : (k == 6) ? K_MIX : (k == 7) ? K_GATE : (k == 8) ? K_MERGE : K_WOUT;
    (void)tab;
}
__device__ __forceinline__ int vcu_idle(int bx) { return bx - 128; }
template <int KIND>
__device__ __forceinline__ void phase_body(const Ctx& c, const int l, const int ffn2) {
    const CAS Args& args = *c.ap; unsigned char* ws = c.ws; float* X = c.X; LAS unsigned char* lds = c.lds;
    const int tid = c.tid, lane = c.lane, wave = c.wave, vcu = c.vcu, G = c.G, bx = c.bx, gw = c.gw, ngw = c.ngw;
    bf16_t* XB = (bf16_t*)(ws + WS_XB); float* SSQ = (float*)(ws + WS_SSQ);
    const float* cosT = (const float*)(ws + WS_COS); const float* sinT = (const float*)(ws + WS_SIN);
    unsigned char* wb = ws + WS_W;
    (void)tid; (void)lane; (void)wave; (void)vcu; (void)G; (void)bx; (void)gw; (void)ngw; (void)XB; (void)SSQ; (void)cosT; (void)sinT; (void)wb; (void)X; (void)lds;
    if constexpr (KIND == K_PRO) {
#if NAIVE_WIN
        rope_tables(args, ws, (vcu * NWAVES * 64) + tid, G * NWAVES * 64);
#endif
        if (bx == 0 && tid < 4) ((unsigned*)(ws + WS_ONES))[tid] = 0x3f803f80u;
        naive::xb_ssq_pass(as_global(args.in[I_X]), XB, SSQ, gw, ngw, lane);
        convert_layer(args, ws, 0, (HIDE_CONV && G == 256) ? 1 : 0, lds, gw, ngw, wave, lane);
    } else if constexpr (KIND == K_CONV) {
        if (l > 0) convert_layer(args, ws, l, 0, lds, gw, ngw, wave, lane);
    } else if constexpr (KIND == K_UP) {
#if NAIVE_UP
        const float* xin = (l == 0 && !ffn2) ? as_global(args.in[I_X]) : X;
        naive::gemm<2, true, true, 4>(lds, tid, vcu, G, DFF, DM, xin, (ffn2 ? as_global(args.in[I_F2N]) : as_global(args.in[I_F1N])) + l * DM, nullptr, nullptr, nullptr, 0,
                                   (ffn2 ? as_global(args.in[I_F2G]) : as_global(args.in[I_F1G])) + (size_t)l * DM * DFF, (ffn2 ? as_global(args.in[I_F2U]) : as_global(args.in[I_F1U])) + (size_t)l * DM * DFF, nullptr, DFF, naive::NEpiUp{(bf16_t*)(ws + WS_HB)});
#else
        pg8::Gemm g{XB, (const bf16_t*)(wb + (ffn2 ? W_GU2 : W_GU1)), DM, 0, 0};
        pg8::StaticOrder S; S.init(M, 2 * DFF, G, bx);
        pg8::gemm_phase(lds + RING_OFF, tid, g, S, epi::EpiUp{(bf16_t*)(ws + WS_HB), (const LAS float*)(lds + epi::EPI_RSTD_OFF)}, [&]() { epi::fill_rstd_table(lds, tid, SSQ, S); });
#if HIDE_CONV
        if (G == 256 && bx >= 128) { if (l == 0 && !ffn2) convert_layer(args, ws, 0, 2, lds, (vcu_idle(bx)) * NWAVES + wave, 128 * NWAVES, wave, lane);
                                     if (l == 0 && ffn2)  convert_layer(args, ws, 1, 1, lds, (vcu_idle(bx)) * NWAVES + wave, 128 * NWAVES, wave, lane);
                                     if (l == 1 && !ffn2) convert_layer(args, ws, 1, 2, lds, (vcu_idle(bx)) * NWAVES + wave, 128 * NWAVES, wave, lane); }
#endif
#endif
    } else if constexpr (KIND == K_DOWN) {
        const float* xold = (l == 0 && !ffn2) ? as_global(args.in[I_X]) : X;
#if NAIVE_DOWN
        naive::gemm<1, true, false, 4>(lds, tid, vcu, G, DM, DFF, nullptr, nullptr, (const bf16_t*)(ws + WS_HB), nullptr, nullptr, DFF,
                                    (ffn2 ? as_global(args.in[I_F2D]) : as_global(args.in[I_F1D])) + (size_t)l * DFF * DM, nullptr, nullptr, DM, naive::NEpiRes{xold, X, XB, SSQ, 0.5f});
#else
        pg8::Gemm g{(const bf16_t*)(ws + WS_HB), (const bf16_t*)(wb + (ffn2 ? W_D2 : W_D1)), DFF, 0, 0};
        pg8::StaticOrder S; S.init(M, DM, G, bx);
        pg8::gemm_phase(lds + RING_OFF, tid, g, S, epi::EpiRes{xold, X, XB, SSQ, 0.5f});
#endif
    } else if constexpr (KIND == K_WIN) {
#if NAIVE_WIN
        naive::gemm<1, true, true, 4>(lds, tid, vcu, G, NIN1, DM, X, as_global(args.in[I_MIXN]) + l * DM, nullptr, nullptr, nullptr, 0,
                                   as_global(args.in[I_WIN]) + (size_t)l * DM * NIN, nullptr, nullptr, NIN,
                                   naive::NEpiWin{ws, cosT, sinT, as_global(args.in[I_AQN]) + l * 64, as_global(args.in[I_AKN]) + l * 64, as_global(args.in[I_BQN]) + l * 64, as_global(args.in[I_BKN]) + l * 64});
#else
        pg8::Gemm g{XB, (const bf16_t*)(wb + W_IN), DM, 0, 0};
        pg8::StaticOrder S; S.init(M, NIN1, G, bx);
        epi::fill_rstd_table(lds, tid, SSQ, S);
        { LAS float* gt = (LAS float*)(lds + epi::EPI_GAIN_OFF); LAS float* rt = (LAS float*)(lds + epi::EPI_ROPE_OFF);
          if (tid < 256) { const int kq = tid >> 6; const float* gp = (kq == 0) ? as_global(args.in[I_AQN]) : (kq == 1) ? as_global(args.in[I_AKN]) : (kq == 2) ? as_global(args.in[I_BQN]) : as_global(args.in[I_BKN]); gt[tid] = gp[l * 64 + (tid & 63)]; }
          else if (tid < 288) rt[tid - 256] = (float)args.ropec[tid - 256]; }
        __syncthreads();
        pg8::gemm_phase(lds + RING_OFF, tid, g, S, epi::EpiWin{ws, (const LAS float*)(lds + epi::EPI_RSTD_OFF), (const LAS float*)(lds + epi::EPI_GAIN_OFF), (const LAS float*)(lds + epi::EPI_ROPE_OFF)});
#if HIDE_CONV
        if (G == 256 && bx >= 128) convert_layer(args, ws, l, 3, lds, (vcu_idle(bx)) * NWAVES + wave, 128 * NWAVES, wave, lane);
#endif
#endif
    } else if constexpr (KIND == K_KV) {
#if !NAIVE_C
        fa::ret_kv_phase(lds, tid, ws, gw, ngw);
#endif
    } else if constexpr (KIND == K_SCAN) {
#if !NAIVE_C
        fa::ret_scan_phase(tid, ws, vcu, G);
#endif
    } else if constexpr (KIND == K_MIX) {
#if FUSE_RET && !NAIVE_C && !NAIVE_B && !NAIVE_A
        {
            gu32* ctl = (gu32*)(ws + WS_CTL);
            fa::ret_kv_phase(lds, tid, ws, gw, ngw);
            cnt_signal(ctl, l * 16 + (vcu >> 5));
            fa::attn_b_phase(lds, tid, ws, (bf16_t*)(ws + WS_BQ), vcu, G, as_global(args.in[I_BREL]) + l * 8 * 320, as_global(args.in[I_BQN]) + l * 64, as_global(args.in[I_BKN]) + l * 64);
            if (vcu < 128) { cnt_wait(ctl, l * 16 + (vcu >> 4), 32u); fa::ret_scan_phase(tid, ws, vcu, G); cnt_signal(ctl, l * 16 + 8 + (vcu >> 4)); }
            __syncthreads();
            fa::attn_a_phase(lds, tid, ws, (bf16_t*)(ws + WS_AQ), vcu, G, as_global(args.in[I_LQ1]) + l * 64, as_global(args.in[I_LK1]) + l * 64, as_global(args.in[I_LQ2]) + l * 64, as_global(args.in[I_LK2]) + l * 64, as_global(args.in[I_ASUB]) + l * 128, (l == 0 ? args.lam_init[0] : args.lam_init[1]), as_global(args.in[I_AQN]) + l * 64, as_global(args.in[I_AKN]) + l * 64);
            cnt_wait(ctl, l * 16 + 8 + (vcu >> 5), 16u);
            fa::ret_out_phase(lds, tid, ws, gw, ngw, as_global(args.in[I_CON]) + l * 512);
        }
#else
#if NAIVE_C
        naive::retention(ws, as_global(args.in[I_CON]) + l * 512, lds, vcu, G, tid);
#else
        fa::ret_out_phase(lds, tid, ws, gw, ngw, as_global(args.in[I_CON]) + l * 512);
#endif
        __syncthreads();
#if NAIVE_B
        naive::attn_b(ws, as_global(args.in[I_BREL]) + l * 8 * 320, lds, gw, ngw, wave, lane);
#else
#if PROBE_B
        for (int rep = 0; rep < PROBE_B; ++rep) { fa::attn_b_phase(lds, tid, ws, (bf16_t*)(ws + WS_W), vcu, G, as_global(args.in[I_BREL]) + l * 8 * 320, as_global(args.in[I_BQN]) + l * 64, as_global(args.in[I_BKN]) + l * 64); __syncthreads(); }
#endif
        fa::attn_b_phase(lds, tid, ws, (bf16_t*)(ws + WS_BQ), vcu, G, as_global(args.in[I_BREL]) + l * 8 * 320, as_global(args.in[I_BQN]) + l * 64, as_global(args.in[I_BKN]) + l * 64);
#endif
        __syncthreads();
#if NAIVE_A
        naive::attn_a(ws, as_global(args.in[I_LQ1]) + l * 64, as_global(args.in[I_LK1]) + l * 64, as_global(args.in[I_LQ2]) + l * 64, as_global(args.in[I_LK2]) + l * 64, as_global(args.in[I_ASUB]) + l * 128, (l == 0 ? args.lam_init[0] : args.lam_init[1]), lds, gw, ngw, wave, lane);
#else
#if PROBE_A
        for (int rep = 0; rep < PROBE_A; ++rep) { fa::attn_a_phase(lds, tid, ws, (bf16_t*)(ws + WS_W), vcu, G, as_global(args.in[I_LQ1]) + l * 64, as_global(args.in[I_LK1]) + l * 64, as_global(args.in[I_LQ2]) + l * 64, as_global(args.in[I_LK2]) + l * 64, as_global(args.in[I_ASUB]) + l * 128, (l == 0 ? args.lam_init[0] : args.lam_init[1]), as_global(args.in[I_AQN]) + l * 64, as_global(args.in[I_AKN]) + l * 64, PROBE_PM); __syncthreads(); }
#endif
#define MK_PROBE_STRETCH 1
        fa::attn_a_phase(lds, tid, ws, (bf16_t*)(ws + WS_AQ), vcu, G, as_global(args.in[I_LQ1]) + l * 64, as_global(args.in[I_LK1]) + l * 64, as_global(args.in[I_LQ2]) + l * 64, as_global(args.in[I_LK2]) + l * 64, as_global(args.in[I_ASUB]) + l * 128, (l == 0 ? args.lam_init[0] : args.lam_init[1]), as_global(args.in[I_AQN]) + l * 64, as_global(args.in[I_AKN]) + l * 64);
#endif
#endif
#if PROBE_T
        __syncthreads();
        if (bx == 0 && tid == 0 && l == 1) {
            const unsigned long long* pr = (const unsigned long long*)(ws + WS_PROBE);
            const unsigned long long v = pr[PROBE_SEL]; const unsigned long long t0 = __builtin_amdgcn_s_memrealtime();
            while (__builtin_amdgcn_s_memrealtime() - t0 < v * 100ull) __builtin_amdgcn_s_sleep(32);
        }
#endif
    } else if constexpr (KIND == K_GATE) {
#if NAIVE_GATE
        naive::gemm<1, true, true, 4>(lds, tid, vcu, G, NGATE, DM, X, as_global(args.in[I_MIXN]) + l * DM, nullptr, nullptr, nullptr, 0,
                                   as_global(args.in[I_WIN]) + (size_t)l * DM * NIN + NIN1, nullptr, nullptr, NIN, naive::NEpiGate{(bf16_t*)(ws + WS_GT)});
#else
#if FUSE_GM
        {
            pg8::Gemm g{XB, (const bf16_t*)(wb + W_IN) + (size_t)NIN1 * DM, DM, 0, (size_t)1024 * DM * 2};
            pg8::StaticOrder S; S.init(M, DM, G, bx);
            pg8::gemm_phase<3>(lds + RING_OFF, tid, g, S, epi::EpiGate{(bf16_t*)(ws + WS_GT), (const LAS float*)(lds + epi::EPI_RSTD_OFF)}, [&]() { epi::fill_rstd_table(lds, tid, SSQ, S); });
            asm volatile("s_waitcnt vmcnt(0)" ::: "memory"); __syncthreads();
            int tid2 = tid; asm volatile("" : "+v"(tid2));
            pg8::Gemm g2{(const bf16_t*)(ws + WS_AQ), (const bf16_t*)(wb + W_BR), 512, P16, (size_t)DM * 512 * 2};
            pg8::StaticOrder S2; S2.init(M, DM, G, bx);
            pg8::gemm_phase<3>(lds + RING_OFF, tid2, g2, S2, epi::EpiMerge{(const bf16_t*)(ws + WS_GT), (bf16_t*)(ws + WS_MG), (const unsigned*)(ws + WS_ONES)});
        }
#else
        pg8::Gemm g{XB, (const bf16_t*)(wb + W_IN) + (size_t)NIN1 * DM, DM, 0, 0};
        pg8::StaticOrder S; S.init(M, NGATE, G, bx);
        pg8::gemm_phase(lds + RING_OFF, tid, g, S, epi::EpiGate{(bf16_t*)(ws + WS_GT), (const LAS float*)(lds + epi::EPI_RSTD_OFF)}, [&]() { epi::fill_rstd_table(lds, tid, SSQ, S); });
#endif
#endif
    } else if constexpr (KIND == K_MERGE) {
#if NAIVE_MERGE
        naive::gemm<3, false, false, 2>(lds, tid, vcu, G, DM, 512, nullptr, nullptr, (const bf16_t*)(ws + WS_AQ), (const bf16_t*)(ws + WS_BQ), (const bf16_t*)(ws + WS_CG), 512,
                                     as_global(args.in[I_WBA]) + (size_t)l * 512 * DM, as_global(args.in[I_WBB]) + (size_t)l * 512 * DM, as_global(args.in[I_WBC]) + (size_t)l * 512 * DM, DM,
                                     naive::NEpiMerge{(const bf16_t*)(ws + WS_GT), (bf16_t*)(ws + WS_MG)});
#else
        static_assert(WS_BQ - WS_AQ == P16 && WS_CG - WS_BQ == P16, "y_a, y_b, y_c equally spaced");
        pg8::Gemm g{(const bf16_t*)(ws + WS_AQ), (const bf16_t*)(wb + W_BR), 512, P16, (size_t)DM * 512 * 2};
        pg8::StaticOrder S; S.init(M, DM, G, bx);
        pg8::gemm_phase<3>(lds + RING_OFF, tid, g, S, epi::EpiMerge{(const bf16_t*)(ws + WS_GT), (bf16_t*)(ws + WS_MG), (const unsigned*)(ws + WS_ONES)});
#endif
    } else if constexpr (KIND == K_WOUT) {
#if NAIVE_WOUT
        naive::gemm<1, true, false, 4>(lds, tid, vcu, G, DM, DM, nullptr, nullptr, (const bf16_t*)(ws + WS_MG), nullptr, nullptr, DM,
                                    as_global(args.in[I_WOUT]) + (size_t)l * DM * DM, nullptr, nullptr, DM, naive::NEpiRes{X, X, XB, SSQ, 1.0f});
#else
        pg8::Gemm g{(const bf16_t*)(ws + WS_MG), (const bf16_t*)(wb + W_OUT), DM, 0, 0};
        pg8::StaticOrder S; S.init(M, DM, G, bx);
        pg8::gemm_phase(lds + RING_OFF, tid, g, S, epi::EpiRes{X, X, XB, SSQ, 1.0f});
#endif
    }
}
__device__ __forceinline__ Ctx make_ctx(LAS unsigned char* lds, const int wave_s) {
    Ctx c; c.lds = lds;
    int lane_; asm volatile("v_mbcnt_lo_u32_b32 %0, -1, 0\n\tv_mbcnt_hi_u32_b32 %0, -1, %0" : "=&v"(lane_));
    int tid = wave_s * 64 + lane_; asm volatile("" : "+v"(tid));
    const CAS Args* argp = (const CAS Args*)__builtin_amdgcn_kernarg_segment_ptr(); asm volatile("" : "+s"(argp));
    c.ap = argp; c.tid = tid; c.lane = tid & 63; c.wave = __builtin_amdgcn_readfirstlane(tid >> 6);
    c.G = gridDim.x; c.bx = blockIdx.x; c.vcu = (c.G % 8 == 0) ? (c.bx % 8) * (c.G / 8) + c.bx / 8 : c.bx;
    c.gw = c.vcu * NWAVES + c.wave; c.ngw = c.G * NWAVES;
    GAS unsigned char* ws = argp->ws; asm volatile("" : "+s"(ws)); c.ws = as_global(ws);
    GAS float* X = argp->out; asm volatile("" : "+s"(X)); c.X = as_global(X);
    return c;
}
#if MK_PER_PHASE_LAUNCH
template <int KIND>
__global__ void __launch_bounds__(NWAVES * 64, 2) phase_kernel(Args args_, int l, int ffn2) {
    extern __shared__ __attribute__((aligned(16))) unsigned char lds_raw[];
    const Ctx c = make_ctx((LAS unsigned char*)lds_raw, __builtin_amdgcn_readfirstlane(threadIdx.x >> 6));
    phase_body<KIND>(c, l, ffn2);
}
#endif
#if !MK_PER_PHASE_LAUNCH
__global__ void __launch_bounds__(NWAVES * 64, 2) trunk_fwd(Args args_) {
    extern __shared__ __attribute__((aligned(16))) unsigned char lds_raw[];
    LAS unsigned char* lds = (LAS unsigned char*)lds_raw;
    volatile LAS unsigned* MISC = (volatile LAS unsigned*)(lds + MISC_OFF);
    gu32* ctl = (gu32*)(args_.ws + WS_CTL);
    for (int u = threadIdx.x; u < (LDS_BYTES - LDSCTL_OFF) / 4; u += NWAVES * 64) ((LAS unsigned*)(lds + LDSCTL_OFF))[u] = 0u;
    __syncthreads();
    XcdBarrier bar = xcd_barrier_post((unsigned*)(ctl + CW_BAR), MISC + 8);
    const int wave_s = __builtin_amdgcn_readfirstlane(threadIdx.x >> 6);
    for (int ph = 0; ph < N_PHASES; ++ph) {
        const Ctx c = make_ctx(lds, wave_s);
        int kind_, l_, ffn2_; phase_decode(ph, kind_, l_, ffn2_);
        const int kind = __builtin_amdgcn_readfirstlane(kind_), l = __builtin_amdgcn_readfirstlane(l_), ffn2 = __builtin_amdgcn_readfirstlane(ffn2_);
#if PROBE_MASK
        if ((PROBE_MASK >> kind) & 1) {
            switch (kind) {
            case K_CONV: phase_body<K_CONV>(c, l, ffn2); break;
#if PROBE_NULL
            case K_UP: { pg8::Gemm g{(const bf16_t*)(c.ws + WS_XB), (const bf16_t*)(c.ws + WS_W + (ffn2 ? W_GU2 : W_GU1)), DM, 0, 0}; pg8::StaticOrder S; S.init(M, 2 * DFF, c.G, c.bx); pg8::gemm_phase(c.lds + RING_OFF, c.tid, g, S, epi::EpiNull{}); } break;
#else
            case K_UP: phase_body<K_UP>(c, l, ffn2); break;
#endif
            case K_WIN: phase_body<K_WIN>(c, l, ffn2); break;
            case K_KV: phase_body<K_KV>(c, l, ffn2); break;
            case K_GATE: phase_body<K_GATE>(c, l, ffn2); break;
            case K_MERGE: phase_body<K_MERGE>(c, l, ffn2); break;
            default: break;
            }
            xcd_barrier(bar);
        }
#endif
#if PROBE_PH
        unsigned long long tp0 = __builtin_amdgcn_s_memrealtime();
#endif
        switch (kind) {
        case K_PRO: phase_body<K_PRO>(c, l, ffn2); break;
        case K_CONV: phase_body<K_CONV>(c, l, ffn2); break;
        case K_UP: phase_body<K_UP>(c, l, ffn2); break;
        case K_DOWN: phase_body<K_DOWN>(c, l, ffn2); break;
        case K_WIN: phase_body<K_WIN>(c, l, ffn2); break;
        case K_KV: phase_body<K_KV>(c, l, ffn2); break;
        case K_SCAN: phase_body<K_SCAN>(c, l, ffn2); break;
        case K_MIX: phase_body<K_MIX>(c, l, ffn2); break;
        case K_GATE: phase_body<K_GATE>(c, l, ffn2); break;
        case K_MERGE: phase_body<K_MERGE>(c, l, ffn2); break;
        default: phase_body<K_WOUT>(c, l, ffn2); break;
        }
#if PROBE_PH
        __syncthreads(); const unsigned long long tp1 = __builtin_amdgcn_s_memrealtime();
#endif
        if (ph + 1 < N_PHASES) xcd_barrier(bar);
#if PROBE_PH
        if (blockIdx.x == PROBE_BLK && threadIdx.x == 0) { const unsigned long long tp2 = __builtin_amdgcn_s_memrealtime(); unsigned long long* pr = (unsigned long long*)(args_.ws + WS_PROBE);
            pr[kind] += tp1 - tp0; pr[16] += tp2 - tp1; pr[17] += tp2 - tp0; pr[20 + kind] += tp2 - tp1; }
#endif
    }
#if PROBE_PH
    if (blockIdx.x == PROBE_BLK && threadIdx.x == 0) {
        const unsigned long long v = ((const unsigned long long*)(args_.ws + WS_PROBE))[PROBE_SEL] / 100; const unsigned long long t0 = __builtin_amdgcn_s_memrealtime();
        while (__builtin_amdgcn_s_memrealtime() - t0 < v * 100ull) __builtin_amdgcn_s_sleep(32);
    }
#endif
}
#endif

#if MK_PER_PHASE_LAUNCH
template <int KIND> static void launch_phase(int grid, hipStream_t stream, const Args& a, int l, int ffn2) {
    static bool attr = false;
    if (!attr) { (void)hipFuncSetAttribute((const void*)phase_kernel<KIND>, hipFuncAttributeMaxDynamicSharedMemorySize, LDS_BYTES); attr = true; }
    hipLaunchKernelGGL(phase_kernel<KIND>, dim3(grid), dim3(NWAVES * 64), LDS_BYTES, stream, a, l, ffn2);
}
#endif
extern "C" void kernel_launch(void* const* d_in, const int* in_sizes, int n_in, void* d_out, int out_size, void* d_ws, size_t ws_size, hipStream_t stream) {
    static int grid = 0;
    if (grid == 0) {
        if (n_in != N_IN || in_sizes[0] != M * DM || out_size != M * DM || ws_size < WS_END) { fprintf(stderr, "kernel_launch: unexpected shapes (n_in %d, in0 %d, out %d, ws %zu < %zu); nothing launched\n", n_in, n_in > 0 ? in_sizes[0] : -1, out_size, ws_size, (size_t)WS_END); grid = -1; return; }
        int dev = 0, cus = 0, per_cu = 0;
        if (hipGetDevice(&dev) != hipSuccess || hipDeviceGetAttribute(&cus, hipDeviceAttributeMultiprocessorCount, dev) != hipSuccess) { grid = -1; return; }
#if !MK_PER_PHASE_LAUNCH
        if (hipFuncSetAttribute((const void*)trunk_fwd, hipFuncAttributeMaxDynamicSharedMemorySize, LDS_BYTES) != hipSuccess) { fprintf(stderr, "kernel_launch: hipFuncSetAttribute failed\n"); grid = -1; return; }
        if (hipOccupancyMaxActiveBlocksPerMultiprocessor(&per_cu, (const void*)trunk_fwd, NWAVES * 64, LDS_BYTES) != hipSuccess || per_cu < 1)
            fprintf(stderr, "kernel_launch: note: occupancy query reports %d workgroups per CU\n", per_cu);
        (void)hipGetLastError();
#endif
        (void)per_cu;
        if (cus < 256) { fprintf(stderr, "kernel_launch: built for a 256-CU device (found %d CUs); nothing launched\n", cus); grid = -1; return; }
        grid = 256;
    }
    if (grid < 0) return;
    (void)hipMemsetAsync((char*)d_ws + WS_CTL, 0, (FUSE_RET || PROBE_T || PROBE_PH) ? CTL_ZERO_BYTES : 32768, stream);
    Args a{};
    for (int i = 0; i < N_IN; ++i) a.in[i] = (const GAS float*)d_in[i];
    a.out = (GAS float*)d_out; a.ws = (GAS unsigned char*)d_ws;
    for (int i = 0; i < 32; ++i) a.ropec[i] = std::pow(10000.0, -(double)i / 32.0) / (2.0 * 3.14159265358979323846);
    for (int l = 0; l < 2; ++l) a.lam_init[l] = (float)(0.8 - 0.6 * std::exp(-0.3 * (double)l));
#if MK_PER_PHASE_LAUNCH
    for (int ph = 0; ph < N_PHASES; ++ph) {
        int kind, l, ffn2; phase_decode(ph, kind, l, ffn2);
        switch (kind) {
        case K_PRO: launch_phase<K_PRO>(grid, stream, a, l, ffn2); break;
        case K_CONV: if (l > 0) launch_phase<K_CONV>(grid, stream, a, l, ffn2); break;
        case K_UP: launch_phase<K_UP>(grid, stream, a, l, ffn2); break;
        case K_DOWN: launch_phase<K_DOWN>(grid, stream, a, l, ffn2); break;
        case K_WIN: launch_phase<K_WIN>(grid, stream, a, l, ffn2); break;
#if NAIVE_C
        case K_KV: case K_SCAN: break;
#else
        case K_KV: launch_phase<K_KV>(grid, stream, a, l, ffn2); break;
        case K_SCAN: launch_phase<K_SCAN>(grid, stream, a, l, ffn2); break;
#endif
        case K_MIX: launch_phase<K_MIX>(grid, stream, a, l, ffn2); break;
        case K_GATE: launch_phase<K_GATE>(grid, stream, a, l, ffn2); break;
        case K_MERGE: launch_phase<K_MERGE>(grid, stream, a, l, ffn2); break;
        default: launch_phase<K_WOUT>(grid, stream, a, l, ffn2); break;
        }
    }
#else
    hipLaunchKernelGGL(trunk_fwd, dim3(grid), dim3(NWAVES * 64), LDS_BYTES, stream, a);
#endif
    const hipError_t le = hipPeekAtLastError();
    if (le != hipSuccess) fprintf(stderr, "kernel_launch: launch failed: %s\n", hipGetErrorName(le));
}
```

```cpp
#include <hip/hip_runtime.h>
#include <hip/hip_bf16.h>
#include <cstdio>
#include <cstdint>
#include <cmath>

#ifndef MK_PER_PHASE_LAUNCH
#define MK_PER_PHASE_LAUNCH 0
#endif
#ifndef NAIVE_GEMM
#define NAIVE_GEMM 0
#endif
#ifndef NAIVE_UP
#define NAIVE_UP NAIVE_GEMM
#endif
#ifndef NAIVE_DOWN
#define NAIVE_DOWN NAIVE_GEMM
#endif
#ifndef NAIVE_WIN
#define NAIVE_WIN NAIVE_GEMM
#endif
#ifndef NAIVE_GATE
#define NAIVE_GATE NAIVE_GEMM
#endif
#ifndef NAIVE_MERGE
#define NAIVE_MERGE NAIVE_GEMM
#endif
#ifndef NAIVE_WOUT
#define NAIVE_WOUT NAIVE_GEMM
#endif
#ifndef PROBE_MASK
#define PROBE_MASK 0
#endif
#ifndef PROBE_NULL
#define PROBE_NULL 0
#endif
#ifndef FA_V2
#define FA_V2 3
#endif
#ifndef PROBE_PM
#define PROBE_PM 0
#endif
#ifndef PROBE_T
#define PROBE_T 0
#endif
#ifndef PROBE_SEL
#define PROBE_SEL 0
#endif
#ifndef FA_WMAP
#define FA_WMAP 0
#endif
#ifndef HIDE_CONV
#define HIDE_CONV 1
#endif
#ifndef PROBE_PH
#define PROBE_PH 0
#endif
#ifndef PROBE_BLK
#define PROBE_BLK 0
#endif
#ifndef FA_HAND
#define FA_HAND 1
#endif
#ifndef FUSE_RET
#define FUSE_RET 0
#endif
#ifndef FA_HANDB
#define FA_HANDB 1
#endif
#ifndef FA_NOMAX_BOUND_A
#define FA_NOMAX_BOUND_A 100.0f
#endif
#ifndef FA_NOMAX_BOUND_B
#define FA_NOMAX_BOUND_B 100.0f
#endif
#ifndef FUSE_GM
#define FUSE_GM 1
#endif
#ifndef PROBE_A
#define PROBE_A 0
#endif
#ifndef PROBE_B
#define PROBE_B 0
#endif
#ifndef NAIVE_A
#define NAIVE_A 0
#endif
#ifndef NAIVE_B
#define NAIVE_B 0
#endif
#ifndef NAIVE_C
#define NAIVE_C 0
#endif

constexpr int BATCH = 2, SEQ = 8192, DM = 1024, DEPTH = 2, M = BATCH * SEQ;
constexpr int DFF = 2816, NIN1 = 4608, NGATE = 3072, NIN = 7680;
constexpr float EPS = 1e-6f;
constexpr float LOG2E = 1.4426950408889634f;
constexpr float C2 = 0.125f * LOG2E;

enum { I_X = 0, I_F1N, I_F1G, I_F1U, I_F1D, I_MIXN, I_WIN, I_AQN, I_AKN, I_LQ1, I_LK1, I_LQ2, I_LK2, I_ASUB, I_BQN, I_BKN, I_BREL, I_CON, I_WBA, I_WBB, I_WBC, I_WOUT, I_F2N, I_F2G, I_F2U, I_F2D, N_IN };

constexpr size_t MiB = 1u << 20;
constexpr size_t WS_CTL = 0, CTL_ZERO_BYTES = 1 * MiB;
constexpr size_t WS_PROBE = 576 * 1024;
constexpr size_t WS_ONES = 512 * 1024;
constexpr size_t WS_COS = 1 * MiB, WS_SIN = 2 * MiB;
constexpr size_t WS_SSQ = 3 * MiB;
constexpr size_t WS_W = 4 * MiB;
constexpr size_t W_GU1 = 0, W_D1 = W_GU1 + (size_t)2 * DFF * DM * 2, W_IN = W_D1 + (size_t)DM * DFF * 2, W_BR = W_IN + (size_t)NIN * DM * 2,
                 W_OUT = W_BR + (size_t)3 * DM * 512 * 2, W_GU2 = W_OUT + (size_t)DM * DM * 2, W_D2 = W_GU2 + (size_t)2 * DFF * DM * 2, W_END = W_D2 + (size_t)DM * DFF * 2;
static_assert(W_END == 53 * MiB, "weights");
constexpr size_t WS_XB = 57 * MiB;
constexpr size_t WS_R4 = 89 * MiB;
constexpr size_t WS_R3 = 121 * MiB;
constexpr size_t P16 = 16 * MiB;
constexpr size_t WS_AQ = WS_R3, WS_BQ = WS_R3 + P16, WS_CG = WS_R3 + 2 * P16;
constexpr size_t WS_AK = WS_R3 + 3 * P16, WS_AV = WS_AK + P16, WS_BK = WS_AV + P16, WS_BV = WS_BK + P16, WS_CQ = WS_BV + P16, WS_CK = WS_CQ + P16 / 2, WS_CV = WS_CK + P16 / 2;
constexpr size_t WS_GT = WS_AK;
constexpr size_t WS_HB = WS_R3;
constexpr size_t WS_MG = WS_R4;
constexpr size_t WS_END = WS_R3 + 144 * MiB;
static_assert(WS_CV + P16 == WS_END && WS_GT + (size_t)M * NGATE * 2 == WS_END && WS_HB + (size_t)M * DFF * 2 <= WS_END, "ws map");

#define GAS __attribute__((address_space(1)))
#define LAS __attribute__((address_space(3)))
typedef unsigned short bf16_t;
typedef short bf16x8 __attribute__((ext_vector_type(8)));
typedef float f32x4 __attribute__((ext_vector_type(4)));
typedef float f32x2 __attribute__((ext_vector_type(2)));
typedef float f32x16 __attribute__((ext_vector_type(16)));
typedef unsigned u32x4 __attribute__((ext_vector_type(4)));
typedef unsigned u32x2 __attribute__((ext_vector_type(2)));
typedef GAS unsigned gu32;
#define RLX_AGENT __ATOMIC_RELAXED, __HIP_MEMORY_SCOPE_AGENT
#define LDS_WAIT() asm volatile("s_waitcnt lgkmcnt(0)" ::: "memory")
#define VM_WAIT() asm volatile("s_waitcnt vmcnt(0)" ::: "memory")

__device__ __forceinline__ unsigned f2bf(float f) { unsigned u = __builtin_bit_cast(unsigned, f); return (u + 0x7fffu + ((u >> 16) & 1u)) >> 16; }
__device__ __forceinline__ unsigned pk2(float lo, float hi) { return f2bf(lo) | (f2bf(hi) << 16); }
__device__ __forceinline__ float bf2f(unsigned short b) { return __builtin_bit_cast(float, (unsigned)b << 16); }
__device__ __forceinline__ float bflo(unsigned w) { return __builtin_bit_cast(float, w << 16); }
__device__ __forceinline__ float bfhi(unsigned w) { return __builtin_bit_cast(float, w & 0xffff0000u); }
__device__ __forceinline__ unsigned cvt_pk_bf16(float lo, float hi) { unsigned r; asm volatile("v_cvt_pk_bf16_f32 %0, %1, %2" : "=v"(r) : "v"(lo), "v"(hi)); return r; }
__device__ __forceinline__ float fast_rcp(float x) { return __builtin_amdgcn_rcpf(x); }
__device__ __forceinline__ float fast_exp2(float x) { return __builtin_amdgcn_exp2f(x); }
__device__ __forceinline__ float silu_f(float x) { return x * fast_rcp(1.0f + fast_exp2(-x * LOG2E)); }
__device__ __forceinline__ float sigmoid_f(float x) { return fast_rcp(1.0f + fast_exp2(-x * LOG2E)); }
template <int O> __device__ __forceinline__ float xor_add(float v) {
    if constexpr (O == 32) { auto rr = __builtin_amdgcn_permlane32_swap(__float_as_uint(v), __float_as_uint(v), false, false); return __uint_as_float(rr[0]) + __uint_as_float(rr[1]); }
    else return v + __uint_as_float((unsigned)__builtin_amdgcn_ds_swizzle((int)__float_as_uint(v), (O << 10) | 0x1f));
}
template <int O> __device__ __forceinline__ float xor_max(float v) {
    if constexpr (O == 32) { auto rr = __builtin_amdgcn_permlane32_swap(__float_as_uint(v), __float_as_uint(v), false, false); return fmaxf(__uint_as_float(rr[0]), __uint_as_float(rr[1])); }
    else return fmaxf(v, __uint_as_float((unsigned)__builtin_amdgcn_ds_swizzle((int)__float_as_uint(v), (O << 10) | 0x1f)));
}
__device__ __forceinline__ float wave_sum(float v) { v = xor_add<1>(v); v = xor_add<2>(v); v = xor_add<4>(v); v = xor_add<8>(v); v = xor_add<16>(v); return xor_add<32>(v); }
__device__ __forceinline__ float wave_max(float v) { v = xor_max<1>(v); v = xor_max<2>(v); v = xor_max<4>(v); v = xor_max<8>(v); v = xor_max<16>(v); return xor_max<32>(v); }

namespace pg8 {
#define PG8_LAS __attribute__((address_space(3)))
constexpr int BM = 256, BK = 64, HALF = 128, HTB = HALF * BK * 2  , STAGE_BYTES = 8 * HTB, NXCD = 8, WGM = 8;

__host__ __device__ __forceinline__ int lds_byte(int r, int c) { const int st = (r >> 4) * 2 + (c >> 5), rr = r & 15, cc = c & 31, ob = rr * 64 + cc * 2; return st * 1024 + (ob ^ (((ob >> 9) & 1) << 5)); }
__host__ __device__ __forceinline__ void stage_rc(int b, int& R, int& C) { const int st = b / 1024, sb = b % 1024, swz = sb ^ (((sb >> 9) & 1) << 5); R = (st >> 1) * 16 + swz / 64; C = (st & 1) * 32 + (swz % 64) / 2; }
__host__ __device__ __forceinline__ int perm32(int rho) { const int n = rho >> 4, i = rho & 15; return 8 * (i >> 2) + 4 * n + (i & 3); }

struct Unit { int pm, pn, sub, ui; };
struct Gemm { const bf16_t* A; const bf16_t* Bt; int K; size_t subA, subB; };
__device__ __forceinline__ const char* pickA(const Gemm& g, int s) { return (const char*)g.A + (size_t)s * g.subA; }
__device__ __forceinline__ const char* pickB(const Gemm& g, int s) { return (const char*)g.Bt + (size_t)s * g.subB; }

struct StaticOrder {
    int nM, nN, nwg, G, c;
    __host__ __device__ void init(int Mr, int N, int G_, int c_) { nM = Mr / BM; nN = N / BM; nwg = nM * nN; G = G_; c = c_; }
    template <int NSUB = 1> __host__ __device__ bool next(int i, Unit& u) const {
        const int it = i / NSUB; u.sub = i - it * NSUB; u.ui = it;
        const long L = (long)it * G + c; if (L >= nwg) return false;
        int wgid = (int)L; { const int q = nwg / NXCD, r = nwg % NXCD, xcd = wgid % NXCD, off = wgid / NXCD; wgid = (xcd < r ? xcd * (q + 1) : r * (q + 1) + (xcd - r) * q) + off; }
        const int nig = WGM * nN, gid = wgid / nig, fm = gid * WGM, gsz = (nM - fm) < WGM ? (nM - fm) : WGM;
        u.pm = fm + ((wgid % nig) % gsz); u.pn = (wgid % nig) / gsz; return true;
    }
};

struct NoPre { __device__ __forceinline__ void operator()() const {} };
template <int NSUB = 1, class Epi, class Pre = NoPre>
__device__ __forceinline__ void gemm_phase(PG8_LAS unsigned char* lds, const int tid, const Gemm g, const StaticOrder& S, const Epi& E, const Pre& pre = Pre()) {
    const int wid = __builtin_amdgcn_readfirstlane(tid >> 6), lane = tid & 63, wr = wid >> 2, wc = wid & 3, fr = lane & 15, fq = lane >> 4;
    const int K = g.K, nt = K / BK;
    unsigned voffA[2], voffB[2];
#pragma unroll
    for (int i = 0; i < 2; ++i) { int R, C; stage_rc(tid * 16 + i * 8192, R, C); const int Rb = ((R & ~31) + perm32(R & 31));
        voffA[i] = (unsigned)(R * K + C) * 2u; voffB[i] = (unsigned)(Rb * K + C) * 2u; }
    const size_t kstep = (size_t)(BK * 2);
    const size_t hstep = (size_t)HALF * K * 2;
    const size_t tstep = 2 * hstep;
    const unsigned ldsw = (unsigned)wid * 1024u;
    const int aoff = lds_byte(wr * 64 + fr, fq * 8), boff = lds_byte(wc * 32 + fr, fq * 8);
#define PG8_SA(b, h) (((b) * 2 + (h)) * HTB)
#define PG8_SB(b, h) ((4 + (b) * 2 + (h)) * HTB)
#define PG8_STAGE(bufoff, gbase, voff) do { _Pragma("unroll") for (int _i = 0; _i < 2; ++_i) \
        __builtin_amdgcn_global_load_lds((const unsigned*)((const char*)(gbase) + (voff)[_i]), (PG8_LAS unsigned*)(lds + (bufoff) + ldsw + _i * 8192), 16, 0, 0); } while (0)
#define PG8_LDA(dst, b, h) do { _Pragma("unroll") for (int m = 0; m < 4; ++m) _Pragma("unroll") for (int k = 0; k < 2; ++k) dst[m][k] = *(const PG8_LAS bf16x8*)(lds + PG8_SA(b, h) + aoff + m * 2048 + k * 1024); } while (0)
#define PG8_LDB(dst, b, h) do { _Pragma("unroll") for (int n = 0; n < 2; ++n) _Pragma("unroll") for (int k = 0; k < 2; ++k) dst[n][k] = *(const PG8_LAS bf16x8*)(lds + PG8_SB(b, h) + boff + n * 2048 + k * 1024); } while (0)
#define PG8_MMA(ai, bj, At, Bt) do { __builtin_amdgcn_s_setprio(1); _Pragma("unroll") for (int m = 0; m < 4; ++m) _Pragma("unroll") for (int n = 0; n < 2; ++n) _Pragma("unroll") for (int k = 0; k < 2; ++k) \
        acc[ai][bj][m][n] = __builtin_amdgcn_mfma_f32_16x16x32_bf16(Bt[n][k], At[m][k], acc[ai][bj][m][n], 0, 0, 0); __builtin_amdgcn_s_setprio(0); } while (0)
#define PG8_WAIT_V(n) asm volatile("s_waitcnt vmcnt(" #n ")" ::: "memory")
#define PG8_WAIT_L(n) asm volatile("s_waitcnt lgkmcnt(" #n ")" ::: "memory")
#define PG8_BAR __builtin_amdgcn_s_barrier()
#define PG8_SCHED __builtin_amdgcn_sched_barrier(0)
    Unit cur, nxt; int ui = 0;
    if (!S.template next<NSUB>(0, cur)) return;
    f32x4 acc[2][2][4][2];
#pragma unroll
    for (int a = 0; a < 2; ++a)
#pragma unroll
        for (int b = 0; b < 2; ++b)
#pragma unroll
            for (int m = 0; m < 4; ++m)
#pragma unroll
                for (int n = 0; n < 2; ++n) acc[a][b][m][n] = (f32x4){0.f, 0.f, 0.f, 0.f};
    bf16x8 At[4][2], B0[2][2], B1[2][2];
    const char* cA = pickA(g, cur.sub) + (size_t)cur.pm * tstep; const char* cB = pickB(g, cur.sub) + (size_t)cur.pn * tstep;
    PG8_STAGE(PG8_SB(0, 0), cB, voffB); PG8_STAGE(PG8_SB(0, 1), cB + hstep, voffB); PG8_STAGE(PG8_SA(0, 0), cA, voffA); PG8_STAGE(PG8_SA(0, 1), cA + hstep, voffA);
    pre();
    if (wr == 1) PG8_BAR;
    PG8_WAIT_V(2); PG8_BAR;
    PG8_STAGE(PG8_SB(1, 0), cB + kstep, voffB); PG8_STAGE(PG8_SA(1, 0), cA + kstep, voffA); PG8_STAGE(PG8_SB(1, 1), cB + hstep + kstep, voffB);
    PG8_WAIT_V(6); PG8_BAR;
    for (;;) {
        const bool has_next = S.template next<NSUB>(ui + 1, nxt);
        const char* nA = has_next ? pickA(g, nxt.sub) + (size_t)nxt.pm * tstep : cA; const char* nB = has_next ? pickB(g, nxt.sub) + (size_t)nxt.pn * tstep : cB;
        for (int t = 0; t < nt; t += 2) {
            const bool last = (t == nt - 2);
            const char* a1 = cA + (size_t)(t + 1) * kstep;
            const char* a2 = last ? nA : cA + (size_t)(t + 2) * kstep; const char* b2 = last ? nB : cB + (size_t)(t + 2) * kstep;
            const char* a3 = a2 + kstep; const char* b3 = b2 + kstep;
            PG8_LDB(B0, 0, 0); PG8_LDB(B1, 0, 1); PG8_SCHED; PG8_LDA(At, 0, 0); PG8_STAGE(PG8_SA(1, 1), a1 + hstep, voffA);
            PG8_WAIT_V(8); PG8_WAIT_L(0); PG8_BAR; PG8_MMA(0, 0, At, B0); PG8_MMA(0, 1, At, B1); PG8_BAR; PG8_SCHED;
            PG8_LDA(At, 0, 1); PG8_STAGE(PG8_SB(0, 0), b2, voffB); PG8_STAGE(PG8_SB(0, 1), b2 + hstep, voffB); PG8_STAGE(PG8_SA(0, 0), a2, voffA);
            PG8_WAIT_V(8); PG8_WAIT_L(0); PG8_BAR; PG8_MMA(1, 0, At, B0); PG8_MMA(1, 1, At, B1); PG8_BAR; PG8_SCHED;
            PG8_LDB(B0, 1, 0); PG8_LDB(B1, 1, 1); PG8_SCHED; PG8_LDA(At, 1, 0); PG8_STAGE(PG8_SA(0, 1), a2 + hstep, voffA);
            PG8_WAIT_V(8); PG8_WAIT_L(0); PG8_BAR; PG8_MMA(0, 0, At, B0); PG8_MMA(0, 1, At, B1); PG8_BAR; PG8_SCHED;
            PG8_LDA(At, 1, 1); PG8_STAGE(PG8_SB(1, 0), b3, voffB); PG8_STAGE(PG8_SB(1, 1), b3 + hstep, voffB); PG8_STAGE(PG8_SA(1, 0), a3, voffA);
            PG8_WAIT_V(8); PG8_WAIT_L(0); PG8_BAR; PG8_MMA(1, 0, At, B0); PG8_MMA(1, 1, At, B1); PG8_BAR; PG8_SCHED;
        }
        if (wr == 0) PG8_BAR;
        { int l_ = tid; asm volatile("" : "+v"(l_)); const int fr_ = l_ & 15, fq_ = (l_ >> 4) & 3;
          E(acc, cur, wr, wc, fr_, fq_); }
        if (!has_next) break;
        cur = nxt; cA = nA; cB = nB; ++ui;
        if (wr == 1) PG8_BAR;
    }
    PG8_WAIT_V(0);
    PG8_BAR;
#undef PG8_SA
#undef PG8_SB
#undef PG8_STAGE
#undef PG8_LDA
#undef PG8_LDB
#undef PG8_MMA
#undef PG8_WAIT_V
#undef PG8_WAIT_L
#undef PG8_BAR
#undef PG8_SCHED
}
}

namespace epi {
using pg8::Unit;
__device__ __forceinline__ float log2_gamma_w(int h) { return __builtin_amdgcn_logf(1.0f - __builtin_amdgcn_exp2f(-5.0f - (float)h)); }
typedef f32x4 Acc[2][2][4][2];
#define ACC_ZERO(acc) do { _Pragma("unroll") for (int a_ = 0; a_ < 2; ++a_) _Pragma("unroll") for (int b_ = 0; b_ < 2; ++b_) _Pragma("unroll") for (int m_ = 0; m_ < 4; ++m_) \
    _Pragma("unroll") for (int n_ = 0; n_ < 2; ++n_) acc[a_][b_][m_][n_] = (f32x4){0.f, 0.f, 0.f, 0.f}; } while (0)

__device__ __forceinline__ float dot4(const f32x4 a) { return (a[0] * a[0] + a[1] * a[1]) + (a[2] * a[2] + a[3] * a[3]); }
__device__ __forceinline__ u32x4 pack8(const f32x4 a, const f32x4 b) { u32x4 w; w.x = cvt_pk_bf16(a[0], a[1]); w.y = cvt_pk_bf16(a[2], a[3]); w.z = cvt_pk_bf16(b[0], b[1]); w.w = cvt_pk_bf16(b[2], b[3]); return w; }
constexpr int EPI_RSTD_OFF = 132096, EPI_GAIN_OFF = EPI_RSTD_OFF + 8 * 256 * 4, EPI_ROPE_OFF = EPI_GAIN_OFF + 4 * 64 * 4, EPI_END = EPI_ROPE_OFF + 128;
__device__ __forceinline__ void fill_rstd_table(LAS unsigned char* lds0, const int tid, const float* ssq, const pg8::StaticOrder& S) {
    LAS float* tab = (LAS float*)(lds0 + EPI_RSTD_OFF);
    const int row = tid >> 1, half = tid & 1;
    f32x4 a[8], b[8]; bool ok[8];
#pragma unroll
    for (int i = 0; i < 8; ++i) {
        Unit u; ok[i] = S.next(i, u);
        const float* p = ssq + ((size_t)(ok[i] ? u.pm : 0) * 256 + row) * 16 + half * 8;
        a[i] = *(const f32x4*)p; b[i] = *(const f32x4*)(p + 4);
    }
#pragma unroll
    for (int i = 0; i < 8; ++i) {
        float s = ((a[i][0] + a[i][1]) + (a[i][2] + a[i][3])) + ((b[i][0] + b[i][1]) + (b[i][2] + b[i][3])); s = xor_add<1>(s);
        if (half == 0 && ok[i]) tab[i * 256 + row] = __builtin_amdgcn_rsqf(s * (1.0f / DM) + EPS);
    }
}
__device__ __forceinline__ float row_rstd(const LAS float* tab, int ui, int lrow) { return tab[ui * 256 + lrow]; }

struct EpiNull {
    __device__ __forceinline__ void operator()(Acc& acc, const Unit& u, int wr, int wc, int fr, int fq) const {
#pragma unroll
        for (int ai = 0; ai < 2; ++ai)
#pragma unroll
            for (int bj = 0; bj < 2; ++bj)
#pragma unroll
                for (int m = 0; m < 4; ++m) { asm volatile("" : "+v"(acc[ai][bj][m][0]), "+v"(acc[ai][bj][m][1])); }
        ACC_ZERO(acc);
    }
};
struct EpiUp {
    bf16_t* H; const LAS float* rst;
    __device__ __forceinline__ void operator()(Acc& acc, const Unit& u, int wr, int wc, int fr, int fq) const {
#pragma unroll
        for (int ai = 0; ai < 2; ++ai)
#pragma unroll
            for (int m = 0; m < 4; ++m) {
                const int lrow = ai * 128 + wr * 64 + m * 16 + fr, row = u.pm * 256 + lrow;
                const float rs = row_rstd(rst, u.ui, lrow);
                f32x4 h0, h1;
#pragma unroll
                for (int j = 0; j < 4; ++j) { h0[j] = silu_f(acc[ai][0][m][0][j] * rs) * (acc[ai][1][m][0][j] * rs); h1[j] = silu_f(acc[ai][0][m][1][j] * rs) * (acc[ai][1][m][1][j] * rs); }
                *(u32x4*)(H + (size_t)row * DFF + u.pn * 128 + wc * 32 + 8 * fq) = pack8(h0, h1);
            }
        ACC_ZERO(acc);
    }
};

struct EpiRes {
    const float* xold; float* xnew; bf16_t* xb; float* ssq; float s;
    __device__ __forceinline__ void operator()(Acc& acc, const Unit& u, int wr, int wc, int fr, int fq) const {
#pragma unroll
        for (int ai = 0; ai < 2; ++ai) {
            f32x4 ov[4][2][2];
#pragma unroll
            for (int m = 0; m < 4; ++m)
#pragma unroll
                for (int bj = 0; bj < 2; ++bj) { const size_t off = (size_t)(u.pm * 256 + ai * 128 + wr * 64 + m * 16 + fr) * DM + u.pn * 256 + bj * 128 + wc * 32 + 8 * fq;
                    ov[m][bj][0] = *(const f32x4*)(xold + off); ov[m][bj][1] = *(const f32x4*)(xold + off + 4); }
            asm volatile("" ::: "memory");
#pragma unroll
            for (int m = 0; m < 4; ++m) {
                const int row = u.pm * 256 + ai * 128 + wr * 64 + m * 16 + fr; float ss = 0.f;
#pragma unroll
                for (int bj = 0; bj < 2; ++bj) {
                    const size_t off = (size_t)row * DM + u.pn * 256 + bj * 128 + wc * 32 + 8 * fq;
                    const f32x4 v0 = ov[m][bj][0] + acc[ai][bj][m][0] * s, v1 = ov[m][bj][1] + acc[ai][bj][m][1] * s;
                    *(f32x4*)(xnew + off) = v0; *(f32x4*)(xnew + off + 4) = v1;
                    *(u32x4*)(xb + off) = pack8(v0, v1);
                    ss += dot4(v0) + dot4(v1);
                }
                ss = xor_add<16>(ss); ss = xor_add<32>(ss);
                if (fq == 0) ssq[(size_t)row * 16 + u.pn * 4 + wc] = ss;
            }
            asm volatile("" ::: "memory");
        }
        ACC_ZERO(acc);
    }
};

struct EpiGate {
    bf16_t* G; const LAS float* rst;
    __device__ __forceinline__ void operator()(Acc& acc, const Unit& u, int wr, int wc, int fr, int fq) const {
#pragma unroll
        for (int ai = 0; ai < 2; ++ai)
#pragma unroll
            for (int m = 0; m < 4; ++m) {
                const int lrow = ai * 128 + wr * 64 + m * 16 + fr, row = u.pm * 256 + lrow;
                const float rs = row_rstd(rst, u.ui, lrow);
#pragma unroll
                for (int bj = 0; bj < 2; ++bj) { f32x4 g0, g1;
#pragma unroll
                    for (int j = 0; j < 4; ++j) { g0[j] = fmaxf(sigmoid_f(acc[ai][bj][m][0][j] * rs), 9.5367431640625e-07f); g1[j] = fmaxf(sigmoid_f(acc[ai][bj][m][1][j] * rs), 9.5367431640625e-07f); }
                    *(u32x4*)(G + (size_t)row * NGATE + u.sub * 1024 + u.pn * 256 + bj * 128 + wc * 32 + 8 * fq) = pack8(g0, g1); }
            }
        ACC_ZERO(acc);
    }
};

struct EpiMerge {
    const bf16_t* G; bf16_t* MG; const unsigned* ones;
    __device__ __forceinline__ void operator()(Acc& acc, const Unit& u, int wr, int wc, int fr, int fq) const {
        const int sub = u.sub; const bool chain = sub < 2;
        const char* gb = (const char*)(G + (size_t)u.pm * 256 * NGATE + sub * 1024 + u.pn * 256);
        const char* nb = chain ? gb + 2048 : (const char*)ones; const unsigned nmask = chain ? 0xffffffffu : 0u;
        const unsigned go = (unsigned)((wr * 64 + fr) * NGATE + wc * 32 + 8 * fq) * 2u;
#pragma unroll
        for (int ai = 0; ai < 2; ++ai)
#pragma unroll
            for (int mh = 0; mh < 2; ++mh) {
                u32x4 gc[2][2], gn[2][2];
#pragma unroll
                for (int m2 = 0; m2 < 2; ++m2)
#pragma unroll
                    for (int bj = 0; bj < 2; ++bj) { const unsigned o = go + (unsigned)(((ai * 128 + (2 * mh + m2) * 16) * NGATE + bj * 128) * 2);
                        gc[m2][bj] = *(const u32x4*)(gb + o); gn[m2][bj] = *(const u32x4*)(nb + (o & nmask)); }
                asm volatile("" ::: "memory");
#pragma unroll
                for (int m2 = 0; m2 < 2; ++m2)
#pragma unroll
                    for (int bj = 0; bj < 2; ++bj) { const u32x4 c = gc[m2][bj], n = gn[m2][bj]; const int m = 2 * mh + m2;
                        const f32x4 c0 = {bflo(c.x), bfhi(c.x), bflo(c.y), bfhi(c.y)}, c1 = {bflo(c.z), bfhi(c.z), bflo(c.w), bfhi(c.w)};
                        const f32x4 n0 = {bflo(n.x), bfhi(n.x), bflo(n.y), bfhi(n.y)}, n1 = {bflo(n.z), bfhi(n.z), bflo(n.w), bfhi(n.w)};
#pragma unroll
                        for (int j = 0; j < 4; ++j) { acc[ai][bj][m][0][j] *= c0[j] * fast_rcp(n0[j]); acc[ai][bj][m][1][j] *= c1[j] * fast_rcp(n1[j]); } }
                asm volatile("" ::: "memory");
            }
        if (!chain) {
            char* mb = (char*)(MG + (size_t)u.pm * 256 * DM + u.pn * 256);
            const unsigned mo = (unsigned)((wr * 64 + fr) * DM + wc * 32 + 8 * fq) * 2u;
#pragma unroll
            for (int ai = 0; ai < 2; ++ai)
#pragma unroll
                for (int m = 0; m < 4; ++m)
#pragma unroll
                    for (int bj = 0; bj < 2; ++bj)
                        *(u32x4*)(mb + mo + (unsigned)(((ai * 128 + m * 16) * DM + bj * 128) * 2)) = pack8(acc[ai][bj][m][0], acc[ai][bj][m][1]);
            ACC_ZERO(acc);
        }
    }
};

enum { F_NORM = 1, F_ROPE = 2, F_C2 = 4, F_CKD = 8, F_SILU = 16 };
struct EpiWin {
    unsigned char* ws; const LAS float* rst; const LAS float* gtab; const LAS float* rtab;
    template <int FLAGS>
    __device__ __forceinline__ void body(Acc& acc, const Unit& u, int wr, int wc, int fr, int fq, bf16_t* out, int pitch, int colbase, int gk) const {
        f32x4 gA0 = {1.f, 1.f, 1.f, 1.f}, gA1 = gA0, gB0 = gA0, gB1 = gA0;
        if (FLAGS & F_NORM) { const LAS float* gain = gtab + gk * 64; gA0 = *(const LAS f32x4*)(gain + 8 * fq); gA1 = *(const LAS f32x4*)(gain + 8 * fq + 4); gB0 = *(const LAS f32x4*)(gain + 32 + 8 * fq); gB1 = *(const LAS f32x4*)(gain + 36 + 8 * fq); }
        f32x4 rc0 = {0.f, 0.f, 0.f, 0.f}, rc1 = rc0;
        if (FLAGS & F_ROPE) { rc0 = *(const LAS f32x4*)(rtab + 8 * fq); rc1 = *(const LAS f32x4*)(rtab + 8 * fq + 4); }
        const float l2g = (FLAGS & F_CKD) ? log2_gamma_w(wc) : 0.f;
#pragma unroll
        for (int ai = 0; ai < 2; ++ai)
#pragma unroll
            for (int m = 0; m < 4; ++m) {
                const int lrow = ai * 128 + wr * 64 + m * 16 + fr, row = u.pm * 256 + lrow, t = row & (SEQ - 1);
                const float rs = row_rstd(rst, u.ui, lrow);
                f32x4 a0 = acc[ai][0][m][0] * rs, a1 = acc[ai][0][m][1] * rs, b0 = acc[ai][1][m][0] * rs, b1 = acc[ai][1][m][1] * rs;
                if (FLAGS & F_NORM) {
                    float ss = (dot4(a0) + dot4(a1)) + (dot4(b0) + dot4(b1)); ss = xor_add<16>(ss); ss = xor_add<32>(ss);
                    const float r = __builtin_amdgcn_rsqf(ss * (1.0f / 64.0f) + EPS);
                    a0 = a0 * gA0 * r; a1 = a1 * gA1 * r; b0 = b0 * gB0 * r; b1 = b1 * gB1 * r;
                }
                if (FLAGS & F_ROPE) {
                    const float tf = (float)t; f32x4 c0, c1, s0, s1;
#pragma unroll
                    for (int j = 0; j < 4; ++j) { const float r0 = __builtin_amdgcn_fractf(tf * rc0[j]), r1 = __builtin_amdgcn_fractf(tf * rc1[j]);
                        c0[j] = __builtin_amdgcn_cosf(r0); s0[j] = __builtin_amdgcn_sinf(r0); c1[j] = __builtin_amdgcn_cosf(r1); s1[j] = __builtin_amdgcn_sinf(r1); }
                    const f32x4 na0 = a0 * c0 - b0 * s0, nb0 = b0 * c0 + a0 * s0, na1 = a1 * c1 - b1 * s1, nb1 = b1 * c1 + a1 * s1;
                    a0 = na0; b0 = nb0; a1 = na1; b1 = nb1;
                }
                if (FLAGS & (F_C2 | F_CKD)) {
                    const float sc = (FLAGS & F_C2) ? C2 : 0.125f * fast_exp2(-(float)(t & 63) * l2g);
                    a0 = a0 * sc; a1 = a1 * sc; b0 = b0 * sc; b1 = b1 * sc;
                }
                if (FLAGS & F_SILU) {
#pragma unroll
                    for (int j = 0; j < 4; ++j) { a0[j] = silu_f(a0[j]); a1[j] = silu_f(a1[j]); b0[j] = silu_f(b0[j]); b1[j] = silu_f(b1[j]); }
                }
                bf16_t* o = out + (size_t)row * pitch + colbase + 64 * wc + 8 * fq;
                *(u32x4*)o = pack8(a0, a1); *(u32x4*)(o + 32) = pack8(b0, b1);
            }
        ACC_ZERO(acc);
    }
    __device__ __forceinline__ void operator()(Acc& acc, const Unit& u, int wr, int wc, int fr, int fq) const {
        const int pn = u.pn;
        if (pn < 2)        body<F_NORM | F_ROPE | F_C2>(acc, u, wr, wc, fr, fq, (bf16_t*)(ws + WS_AQ), 512, 256 * pn, 0);
        else if (pn < 4)   body<F_NORM | F_ROPE>(acc, u, wr, wc, fr, fq, (bf16_t*)(ws + WS_AK), 512, 256 * (pn - 2), 1);
        else if (pn < 6)   body<0>(acc, u, wr, wc, fr, fq, (bf16_t*)(ws + WS_AV), 512, 256 * (pn - 4), 0);
        else if (pn < 8)   body<F_NORM | F_C2>(acc, u, wr, wc, fr, fq, (bf16_t*)(ws + WS_BQ), 512, 256 * (pn - 6), 2);
        else if (pn < 10)  body<F_NORM>(acc, u, wr, wc, fr, fq, (bf16_t*)(ws + WS_BK), 512, 256 * (pn - 8), 3);
        else if (pn < 12)  body<0>(acc, u, wr, wc, fr, fq, (bf16_t*)(ws + WS_BV), 512, 256 * (pn - 10), 0);
        else if (pn == 12) body<F_ROPE>(acc, u, wr, wc, fr, fq, (bf16_t*)(ws + WS_CQ), 256, 0, 0);
        else if (pn == 13) body<F_ROPE | F_CKD>(acc, u, wr, wc, fr, fq, (bf16_t*)(ws + WS_CK), 256, 0, 0);
        else if (pn < 16)  body<0>(acc, u, wr, wc, fr, fq, (bf16_t*)(ws + WS_CV), 512, 256 * (pn - 14), 0);
        else               body<F_SILU>(acc, u, wr, wc, fr, fq, (bf16_t*)(ws + WS_CG), 512, 256 * (pn - 16), 0);
    }
};
}

__device__ __forceinline__ float log2_gamma(int h) { return __builtin_amdgcn_logf(1.0f - __builtin_amdgcn_exp2f(-5.0f - (float)h)); }

namespace naive {
struct ANorm {
    const float* x; const float* gain; const LAS float* rs; int m0;
    __device__ __forceinline__ float get(int m, int k) const { return x[(size_t)m * DM + k] * rs[m - m0] * gain[k]; }
};
struct ABf {
    const bf16_t* a; int pitch;
    __device__ __forceinline__ float get(int m, int k) const { return bf2f(a[(size_t)m * pitch + k]); }
};
template <int NB, bool SHARED_A, bool NORM, int RT, class Epi>
__device__ __forceinline__ void gemm(LAS unsigned char* lds, const int tid, int vcu, int G, int N, int K,
                                     const float* x, const float* gain, const bf16_t* a0, const bf16_t* a1, const bf16_t* a2, int apitch,
                                     const float* w0, const float* w1, const float* w2, int ldb, const Epi& E) {
    constexpr int NA = SHARED_A ? 1 : NB;
    LAS float* As = (LAS float*)lds;
    LAS float* Bs = As + NA * 16 * 132;
    LAS float* rs = Bs + NB * 16 * 128;
    const int tx = tid & 15, ty = tid >> 4, lane = tid & 63, wave = tid >> 6;
    constexpr int TM = 32 * RT;
    const int ntn = N / 128, ntiles = (M / TM) * ntn;
    for (int tile = vcu; tile < ntiles; tile += G) {
        const int m0 = (tile / ntn) * TM, n0 = (tile % ntn) * 128;
        __syncthreads();
        if (NORM) {
            for (int r = wave * (TM / 8); r < wave * (TM / 8) + TM / 8; ++r) {
                const float* xr = x + (size_t)(m0 + r) * DM; float s = 0.f;
                for (int k = lane; k < DM; k += 64) { const float v = xr[k]; s += v * v; }
                s = wave_sum(s);
                if (lane == 0) rs[r] = 1.0f / sqrtf(s * (1.0f / DM) + EPS);
            }
            __syncthreads();
        }
        float acc[NB][RT][8];
#pragma unroll
        for (int b = 0; b < NB; ++b)
#pragma unroll
            for (int i = 0; i < RT; ++i)
#pragma unroll
                for (int j = 0; j < 8; ++j) acc[b][i][j] = 0.f;
        for (int k0 = 0; k0 < K; k0 += 16) {
            {
                const int r = tid >> 2, kq = (tid & 3) * 4;
                if (r < TM)
#pragma unroll
                for (int b = 0; b < NA; ++b)
#pragma unroll
                    for (int i = 0; i < 4; ++i) {
                        float v;
                        if (NORM) v = x[(size_t)(m0 + r) * DM + k0 + kq + i] * rs[r] * gain[k0 + kq + i];
                        else { const bf16_t* ap = (b == 0 ? a0 : (b == 1 ? a1 : a2)); v = bf2f(ap[(size_t)(m0 + r) * apitch + k0 + kq + i]); }
                        As[(b * 16 + kq + i) * 132 + r] = v;
                    }
                const int kb = tid >> 5, n4 = (tid & 31) * 4;
#pragma unroll
                for (int b = 0; b < NB; ++b) { const float* wp = (b == 0 ? w0 : (b == 1 ? w1 : w2));
                    const f32x4 v = *(const f32x4*)(wp + (size_t)(k0 + kb) * ldb + n0 + n4);
                    *(LAS f32x4*)(Bs + (b * 16 + kb) * 128 + n4) = v; }
            }
            __syncthreads();
#pragma unroll
            for (int kk = 0; kk < 16; ++kk) {
#pragma unroll
                for (int b = 0; b < NB; ++b) {
                    const int ab = SHARED_A ? 0 : b;
                    float av[RT];
#pragma unroll
                    for (int i = 0; i < RT; ++i) av[i] = As[(ab * 16 + kk) * 132 + ty * RT + i];
                    const f32x4 b0 = *(const LAS f32x4*)(Bs + (b * 16 + kk) * 128 + tx * 8), b1 = *(const LAS f32x4*)(Bs + (b * 16 + kk) * 128 + tx * 8 + 4);
#pragma unroll
                    for (int i = 0; i < RT; ++i)
#pragma unroll
                        for (int j = 0; j < 4; ++j) { acc[b][i][j] += av[i] * b0[j]; acc[b][i][4 + j] += av[i] * b1[j]; }
                }
            }
            __syncthreads();
        }
#pragma unroll
        for (int i = 0; i < RT; ++i) E(m0 + ty * RT + i, n0 + tx * 8, acc, i, tx);
    }
}

__device__ __forceinline__ void xb_ssq_pass(const float* x, bf16_t* xb, float* ssq, int gw, int ngw, int lane) {
    for (int m0 = gw * 4; m0 < M; m0 += ngw * 4) {
        f32x4 v[4][4];
#pragma unroll
        for (int r = 0; r < 4; ++r)
#pragma unroll
            for (int j = 0; j < 4; ++j) v[r][j] = ((const f32x4*)(x + (size_t)(m0 + r) * DM) + lane)[64 * j];
#pragma unroll
        for (int r = 0; r < 4; ++r) {
            float s = 0.f; u32x2* o = (u32x2*)(xb + (size_t)(m0 + r) * DM) + lane;
#pragma unroll
            for (int j = 0; j < 4; ++j) { const f32x4 w4 = v[r][j]; s += (w4[0] * w4[0] + w4[1] * w4[1]) + (w4[2] * w4[2] + w4[3] * w4[3]); u32x2 w; w.x = pk2(w4[0], w4[1]); w.y = pk2(w4[2], w4[3]); o[64 * j] = w; }
            s = wave_sum(s);
            if (lane < 16) ssq[(size_t)(m0 + r) * 16 + lane] = (lane == 0) ? s : 0.f;
        }
    }
}

struct NEpiUp { bf16_t* H;
    __device__ __forceinline__ void operator()(int m, int n, const float (&acc)[2][4][8], int i, int tx) const {
#pragma unroll
        for (int j = 0; j < 8; ++j) { const float g = acc[0][i][j], u = acc[1][i][j]; H[(size_t)m * DFF + n + j] = (bf16_t)f2bf(g / (1.0f + expf(-g)) * u); } } };
struct NEpiRes { const float* xold; float* xnew; bf16_t* xb; float* ssq; float s;
    __device__ __forceinline__ void operator()(int m, int n, const float (&acc)[1][4][8], int i, int tx) const {
        float ss = 0.f;
#pragma unroll
        for (int j = 0; j < 8; ++j) { const float v = xold[(size_t)m * DM + n + j] + s * acc[0][i][j]; xnew[(size_t)m * DM + n + j] = v; xb[(size_t)m * DM + n + j] = (bf16_t)f2bf(v); ss += v * v; }
        ss += __shfl_xor(ss, 1); ss += __shfl_xor(ss, 2); ss += __shfl_xor(ss, 4); ss += __shfl_xor(ss, 8);
        if (tx == 0) { ssq[(size_t)m * 16 + (n >> 7)] = ss; ssq[(size_t)m * 16 + 8 + (n >> 7)] = 0.f; }
    } };
struct NEpiGate { bf16_t* G;
    __device__ __forceinline__ void operator()(int m, int n, const float (&acc)[1][4][8], int i, int tx) const {
#pragma unroll
        for (int j = 0; j < 8; ++j) G[(size_t)m * NGATE + n + j] = (bf16_t)f2bf(fmaxf(1.0f / (1.0f + expf(-acc[0][i][j])), 9.5367431640625e-07f)); } };
struct NEpiMerge { const bf16_t* G; bf16_t* MG;
    __device__ __forceinline__ void operator()(int m, int n, const float (&acc)[3][2][8], int i, int tx) const {
#pragma unroll
        for (int j = 0; j < 8; ++j) { const size_t go = (size_t)m * NGATE + n + j;
            const float v = bf2f(G[go]) * acc[0][i][j] + bf2f(G[go + 1024]) * acc[1][i][j] + bf2f(G[go + 2048]) * acc[2][i][j];
            MG[(size_t)m * DM + n + j] = (bf16_t)f2bf(v); } } };
struct NEpiWin { unsigned char* ws; const float* cosT; const float* sinT; const float *aqn, *akn, *bqn, *bkn;
    __device__ __forceinline__ void operator()(int m, int n, const float (&acc)[1][4][8], int i, int tx) const {
        size_t obase; int pitch, c0, flags; const float* gain = nullptr;
        if (n < 512)       { obase = WS_AQ; pitch = 512; c0 = 0;    flags = epi::F_NORM | epi::F_ROPE | epi::F_C2; gain = aqn; }
        else if (n < 1024) { obase = WS_AK; pitch = 512; c0 = 512;  flags = epi::F_NORM | epi::F_ROPE; gain = akn; }
        else if (n < 1536) { obase = WS_AV; pitch = 512; c0 = 1024; flags = 0; }
        else if (n < 2048) { obase = WS_BQ; pitch = 512; c0 = 1536; flags = epi::F_NORM | epi::F_C2; gain = bqn; }
        else if (n < 2560) { obase = WS_BK; pitch = 512; c0 = 2048; flags = epi::F_NORM; gain = bkn; }
        else if (n < 3072) { obase = WS_BV; pitch = 512; c0 = 2560; flags = 0; }
        else if (n < 3328) { obase = WS_CQ; pitch = 256; c0 = 3072; flags = epi::F_ROPE; }
        else if (n < 3584) { obase = WS_CK; pitch = 256; c0 = 3328; flags = epi::F_ROPE | epi::F_CKD; }
        else if (n < 4096) { obase = WS_CV; pitch = 512; c0 = 3584; flags = 0; }
        else               { obase = WS_CG; pitch = 512; c0 = 4096; flags = epi::F_SILU; }
        const int t = m & (SEQ - 1), d0 = n & 63; float v[8];
#pragma unroll
        for (int j = 0; j < 8; ++j) v[j] = acc[0][i][j];
        if (flags & epi::F_NORM) { float ss = 0.f;
#pragma unroll
            for (int j = 0; j < 8; ++j) ss += v[j] * v[j];
            ss += __shfl_xor(ss, 1); ss += __shfl_xor(ss, 2); ss += __shfl_xor(ss, 4);
            const float r = 1.0f / sqrtf(ss * (1.0f / 64.0f) + EPS);
#pragma unroll
            for (int j = 0; j < 8; ++j) v[j] = v[j] * r * gain[d0 + j]; }
        if (flags & epi::F_ROPE) {
#pragma unroll
            for (int j = 0; j < 8; ++j) { const float p = __shfl_xor(v[j], 4); const int d = d0 + j, ii = d & 31; const float c = cosT[t * 32 + ii], s = sinT[t * 32 + ii];
                v[j] = (d < 32) ? (v[j] * c - p * s) : (v[j] * c + p * s); } }
        float sc = 1.0f;
        if (flags & epi::F_C2) sc = C2;
        if (flags & epi::F_CKD) sc = 0.125f * exp2f(-(float)(t & 63) * log2_gamma((n - 3328) >> 6));
        bf16_t* o = (bf16_t*)(ws + obase) + (size_t)m * pitch + (n - c0);
#pragma unroll
        for (int j = 0; j < 8; ++j) { float y = v[j] * sc; if (flags & epi::F_SILU) y = y / (1.0f + expf(-y)); o[j] = (bf16_t)f2bf(y); }
    } };

__device__ __forceinline__ void attn_a(unsigned char* ws, const float* lq1, const float* lk1, const float* lq2, const float* lk2, const float* subln, float lam_init,
                                       LAS unsigned char* lds, int gw, int ngw, int wave, int lane) {
    const bf16_t* AQ = (const bf16_t*)(ws + WS_AQ); const bf16_t* AK = (const bf16_t*)(ws + WS_AK); const bf16_t* AV = (const bf16_t*)(ws + WS_AV); bf16_t* YA = (bf16_t*)(ws + WS_AQ);
    const float lam = expf(wave_sum(lq1[lane] * lk1[lane])) - expf(wave_sum(lq2[lane] * lk2[lane])) + lam_init;
    LAS float* qs = (LAS float*)lds + wave * 128;
    for (int task = gw; task < M * 4; task += ngw) {
        const int h = task & 3, m = task >> 2, b = m >> 13, t = m & (SEQ - 1), nch = (t >> 6) + 1;
        qs[lane] = bf2f(AQ[(size_t)m * 512 + h * 128 + lane]); qs[64 + lane] = bf2f(AQ[(size_t)m * 512 + h * 128 + 64 + lane]);
        LDS_WAIT(); asm volatile("" ::: "memory");
        float mx[2] = {-1e30f, -1e30f}, l[2] = {0.f, 0.f}, o[2][2] = {{0.f, 0.f}, {0.f, 0.f}};
        for (int c = 0; c < nch; ++c) {
            const size_t krow = (size_t)(b * SEQ + c * 64 + lane);
            float s[2] = {0.f, 0.f};
            for (int cc = 0; cc < 2; ++cc) { const u32x4* kp = (const u32x4*)(AK + krow * 512 + h * 128 + cc * 64);
                for (int q = 0; q < 8; ++q) { const u32x4 w = kp[q]; const LAS float* qq = qs + cc * 64 + q * 8;
                    s[cc] += bflo(w.x) * qq[0] + bfhi(w.x) * qq[1] + bflo(w.y) * qq[2] + bfhi(w.y) * qq[3] + bflo(w.z) * qq[4] + bfhi(w.z) * qq[5] + bflo(w.w) * qq[6] + bfhi(w.w) * qq[7]; } }
            float p[2];
            for (int cc = 0; cc < 2; ++cc) { const float mn = fmaxf(mx[cc], wave_max(s[cc])), f = exp2f(mx[cc] - mn); mx[cc] = mn; p[cc] = exp2f(s[cc] - mn);
                l[cc] = l[cc] * f + wave_sum(p[cc]); o[cc][0] *= f; o[cc][1] *= f; }
            for (int j = 0; j < 64; ++j) { const float p0 = __shfl(p[0], j), p1 = __shfl(p[1], j); const size_t vrow = (size_t)(b * SEQ + c * 64 + j) * 512 + h * 128;
                const float v0 = bf2f(AV[vrow + lane]), v1 = bf2f(AV[vrow + 64 + lane]);
                o[0][0] += p0 * v0; o[0][1] += p0 * v1; o[1][0] += p1 * v0; o[1][1] += p1 * v1; }
        }
        const float y0 = o[0][0] / l[0] - lam * o[1][0] / l[1], y1 = o[0][1] / l[0] - lam * o[1][1] / l[1];
        const float r = 1.0f / sqrtf(wave_sum(y0 * y0 + y1 * y1) * (1.0f / 128.0f) + EPS) * (1.0f - lam_init);
        YA[(size_t)m * 512 + h * 128 + lane] = (bf16_t)f2bf(y0 * r * subln[lane]); YA[(size_t)m * 512 + h * 128 + 64 + lane] = (bf16_t)f2bf(y1 * r * subln[64 + lane]);
        asm volatile("" ::: "memory");
    }
}
__device__ __forceinline__ void attn_b(unsigned char* ws, const float* relb, LAS unsigned char* lds, int gw, int ngw, int wave, int lane) {
    const bf16_t* BQ = (const bf16_t*)(ws + WS_BQ); const bf16_t* BK = (const bf16_t*)(ws + WS_BK); const bf16_t* BV = (const bf16_t*)(ws + WS_BV); bf16_t* YB = (bf16_t*)(ws + WS_BQ);
    LAS float* qs = (LAS float*)lds + wave * 128;
    for (int task = gw; task < M * 8; task += ngw) {
        const int h = task & 7, m = task >> 3, b = m >> 13, t = m & (SEQ - 1), n = t >> 6;
        qs[lane] = bf2f(BQ[(size_t)m * 512 + h * 64 + lane]);
        LDS_WAIT(); asm volatile("" ::: "memory");
        float mx = -1e30f, l = 0.f, o = 0.f;
        for (int c = (n >= 8 ? n - 8 : 0); c <= n; ++c) {
            const int kpos = c * 64 + lane; const size_t krow = (size_t)(b * SEQ + kpos);
            float s = 0.f; const u32x4* kp = (const u32x4*)(BK + krow * 512 + h * 64);
            for (int q = 0; q < 8; ++q) { const u32x4 w = kp[q]; const LAS float* qq = qs + q * 8;
                s += bflo(w.x) * qq[0] + bfhi(w.x) * qq[1] + bflo(w.y) * qq[2] + bfhi(w.y) * qq[3] + bflo(w.z) * qq[4] + bfhi(w.z) * qq[5] + bflo(w.w) * qq[6] + bfhi(w.w) * qq[7]; }
            int rel = t - kpos; rel = rel < -63 ? -63 : (rel > 256 ? 256 : rel);
            s += relb[h * 320 + rel + 63] * LOG2E;
            const float mn = fmaxf(mx, wave_max(s)), f = exp2f(mx - mn); mx = mn; const float p = exp2f(s - mn);
            l = l * f + wave_sum(p); o *= f;
            for (int j = 0; j < 64; ++j) o += __shfl(p, j) * bf2f(BV[(size_t)(b * SEQ + c * 64 + j) * 512 + h * 64 + lane]);
        }
        YB[(size_t)m * 512 + h * 64 + lane] = (bf16_t)f2bf(o / l);
        asm volatile("" ::: "memory");
    }
}
__device__ __forceinline__ void retention(unsigned char* ws, const float* onorm, LAS unsigned char* lds, int vcu, int G, int tid) {
    const bf16_t* CQ = (const bf16_t*)(ws + WS_CQ); const bf16_t* CK = (const bf16_t*)(ws + WS_CK); const bf16_t* CV = (const bf16_t*)(ws + WS_CV); bf16_t* CG = (bf16_t*)(ws + WS_CG);
    LAS float* qs = (LAS float*)lds; LAS float* ks = qs + 64 * 64; LAS float* vs = ks + 64 * 64; LAS float* os = vs + 64 * 128;
    for (int bh = vcu; bh < 8; bh += G) {
        const int b = bh >> 2, h = bh & 3; const float l2g = log2_gamma(h), gam = exp2f(l2g);
        float S[64];
#pragma unroll
        for (int d = 0; d < 64; ++d) S[d] = 0.f;
        for (int n = 0; n < SEQ / 64; ++n) {
            __syncthreads();
            for (int i = tid; i < 64 * 64; i += 512) { const int r = i >> 6, d = i & 63; const size_t row = (size_t)(b * SEQ + n * 64 + r);
                qs[i] = bf2f(CQ[row * 256 + h * 64 + d]); ks[i] = bf2f(CK[row * 256 + h * 64 + d]) * exp2f((float)r * l2g); }
            for (int i = tid; i < 64 * 128; i += 512) { const int r = i >> 7, e = i & 127; vs[i] = bf2f(CV[(size_t)(b * SEQ + n * 64 + r) * 512 + h * 128 + e]); }
            __syncthreads();
            if (tid < 128) {
                for (int r = 0; r < 64; ++r) { const float v = vs[r * 128 + tid]; float o = 0.f;
#pragma unroll
                    for (int d = 0; d < 64; ++d) { S[d] = gam * S[d] + ks[r * 64 + d] * v; o += qs[r * 64 + d] * S[d]; }
                    os[r * 128 + tid] = o; }
            }
            __syncthreads();
            { const int r = tid >> 3, e0 = (tid & 7) * 16; float ss = 0.f;
#pragma unroll
              for (int j = 0; j < 16; ++j) { const float v = os[r * 128 + e0 + j]; ss += v * v; }
              ss += __shfl_xor(ss, 1); ss += __shfl_xor(ss, 2); ss += __shfl_xor(ss, 4);
              const float rr = 1.0f / sqrtf(ss * (1.0f / 128.0f) + EPS); bf16_t* g = CG + (size_t)(b * SEQ + n * 64 + r) * 512 + h * 128 + e0;
#pragma unroll
              for (int j = 0; j < 16; ++j) g[j] = (bf16_t)f2bf(bf2f(g[j]) * os[r * 128 + e0 + j] * rr * onorm[h * 128 + e0 + j]); }
        }
    }
}
}

namespace fa {
typedef short s16x4 __attribute__((ext_vector_type(4)));
typedef short v4i16_t __attribute__((ext_vector_type(4)));
typedef LAS const unsigned char* lds_cptr;
constexpr int SLOTB = 32768, NSLOT = 3, KOFF = 0, VOFF = 16384;
constexpr int LDS_WS = NSLOT * SLOTB, LDS_BIAS = LDS_WS + 2048, LDS_END = LDS_BIAS + 2560;
constexpr float THR = 8.0f;
__device__ __forceinline__ int crow(int r, int hi) { return (r & 3) + 8 * (r >> 2) + 4 * hi; }
__device__ __forceinline__ void glds16(const void* gsrc, unsigned lds_dst) { unsigned keep;
    asm volatile("s_mov_b32 %0, m0\n\ts_mov_b32 m0, %2\n\ts_nop 0\n\tglobal_load_lds_dwordx4 %1, off\n\ts_mov_b32 m0, %0" : "=&s"(keep) : "v"(gsrc), "s"(lds_dst) : "memory"); }
__device__ __forceinline__ void glds16s(const void* sbase, unsigned voff, unsigned lds_dst) { unsigned keep;
    asm volatile("s_mov_b32 %0, m0\n\ts_mov_b32 m0, %3\n\ts_nop 0\n\tglobal_load_lds_dwordx4 %1, %2\n\ts_mov_b32 m0, %0" : "=&s"(keep) : "v"(voff), "s"(sbase), "s"(lds_dst) : "memory"); }
#define FA_WAIT_BAR(N) asm volatile("s_waitcnt vmcnt(" #N ") lgkmcnt(0)\n\ts_barrier" ::: "memory")
#define FA_BAR() asm volatile("s_waitcnt lgkmcnt(0)\n\ts_barrier" ::: "memory")
__device__ __forceinline__ s16x4 vtr(lds_cptr p) { return __builtin_bit_cast(s16x4, __builtin_amdgcn_ds_read_tr16_b64_v4i16((LAS v4i16_t*)p)); }
__device__ __forceinline__ bf16x8 cat8(const s16x4 lo, const s16x4 hi) { return (bf16x8){lo[0], lo[1], lo[2], lo[3], hi[0], hi[1], hi[2], hi[3]}; }
__device__ __forceinline__ float swapmax(float m) { auto rr = __builtin_amdgcn_permlane32_swap(__float_as_uint(m), __float_as_uint(m), false, false); return fmaxf(__uint_as_float(rr[0]), __uint_as_float(rr[1])); }
__device__ __forceinline__ float swapsum(float m) { auto rr = __builtin_amdgcn_permlane32_swap(__float_as_uint(m), __float_as_uint(m), false, false); return __uint_as_float(rr[0]) + __uint_as_float(rr[1]); }
__device__ __forceinline__ bf16x8 pack_p(const f32x16& p, int base) { u32x4 w; w.x = cvt_pk_bf16(p[base], p[base + 1]); w.y = cvt_pk_bf16(p[base + 2], p[base + 3]); w.z = cvt_pk_bf16(p[base + 4], p[base + 5]); w.w = cvt_pk_bf16(p[base + 6], p[base + 7]); return __builtin_bit_cast(bf16x8, w); }
__device__ __forceinline__ float half_sum32(float v) {
    v = xor_add<1>(v); v = xor_add<2>(v); v = xor_add<4>(v); v = xor_add<8>(v); return xor_add<16>(v);
}

template <int MODE>
__device__ __forceinline__ void attn_unit(LAS unsigned char* lds, const int tid, const bf16_t* Qg, const bf16_t* Kg, const bf16_t* Vg, bf16_t* Yg, const int b, const int hq, const int u,
                                          const float lam, const float osc, const float* subln) {
    constexpr int PITCH = 512, NDB = (MODE == 0) ? 4 : 2;
    const int lane = tid & 63, r32 = lane & 31, hi = lane >> 5, wid = __builtin_amdgcn_readfirstlane(tid >> 6), ch = wid >> 2, wq = wid & 3;
    const int cw = 2 * u + (wq >> 1);
    const int t0 = (MODE == 0) ? 0 : ((2 * u - 8) > 0 ? (2 * u - 8) : 0), t1 = 2 * u + 1, NT = t1 - t0 + 1;
    const size_t rowbase = (size_t)b * SEQ;
    const bf16_t* Kb = Kg + rowbase * PITCH + hq * 128; const bf16_t* Vb = Vg + rowbase * PITCH + hq * 128;
    const unsigned lds0 = (unsigned)(uintptr_t)lds;
    LAS float* wsf = (LAS float*)(lds + LDS_WS) + wid * 64;
    const bf16_t* ksrc = Kb + (size_t)lane * PITCH + (2 * wid) * 8;
    const bf16_t* vsrc0 = Vb + (size_t)(16 * ((2 * wid) & 3) + (lane >> 2)) * PITCH + 32 * ((2 * wid) >> 2) + (lane & 3) * 8;
    const bf16_t* vsrc1 = Vb + (size_t)(16 * ((2 * wid + 1) & 3) + (lane >> 2)) * PITCH + 32 * ((2 * wid + 1) >> 2) + (lane & 3) * 8;
#define FA_DMA(t, slot) do { const size_t to_ = (size_t)(t) * 64 * PITCH; const unsigned sb_ = lds0 + (unsigned)(slot) * SLOTB; \
        glds16(ksrc + to_, (unsigned)__builtin_amdgcn_readfirstlane(sb_ + KOFF + (2 * wid) * 1024)); glds16(ksrc + to_ + 8, (unsigned)__builtin_amdgcn_readfirstlane(sb_ + KOFF + (2 * wid + 1) * 1024)); \
        glds16(vsrc0 + to_, (unsigned)__builtin_amdgcn_readfirstlane(sb_ + VOFF + (2 * wid) * 1024)); glds16(vsrc1 + to_, (unsigned)__builtin_amdgcn_readfirstlane(sb_ + VOFF + (2 * wid + 1) * 1024)); } while (0)
    FA_DMA(t0, 0);
    if (NT > 1) FA_DMA(t0 + 1, 1);
    const size_t qrow = rowbase + (size_t)u * 128 + wq * 32;
    bf16x8 qr[4];
#pragma unroll
    for (int i = 0; i < 4; ++i) qr[i] = *(const bf16x8*)(Qg + (qrow + r32) * PITCH + hq * 128 + ch * 64 + i * 16 + hi * 8);
    f32x16 o[NDB];
#pragma unroll
    for (int d = 0; d < NDB; ++d)
#pragma unroll
        for (int r = 0; r < 16; ++r) o[d][r] = 0.f;
    float mref = 0.f, lsum = 0.f; bool first = true;
    const lds_cptr kp0 = (lds_cptr)lds + KOFF + ch * 8192 + hi * 1024 + r32 * 16;
    const lds_cptr vp0 = (lds_cptr)lds + VOFF + ((MODE == 0) ? 0 : ch * 8192) + ((lane >> 4) & 1) * 32 + (lane & 3) * 8 + (4 * hi + ((lane & 15) >> 2)) * 64;
    int slot = 0;
    for (int i = 0; i < NT; ++i) {
        if (i + 1 < NT) FA_WAIT_BAR(4); else FA_WAIT_BAR(0);
        if (i + 2 < NT) { const int s2 = (slot == 0) ? 2 : slot - 1; FA_DMA(t0 + i + 2, s2); }
        const int t = t0 + i;
        const bool vis = (MODE == 0) ? (t <= cw) : (t <= cw && t + 8 >= cw);
        if (vis) {
            const lds_cptr kp = kp0 + slot * SLOTB; const lds_cptr vp = vp0 + slot * SLOTB;
            f32x16 p0, p1;
#pragma unroll
            for (int r = 0; r < 16; ++r) { p0[r] = 0.f; p1[r] = 0.f; }
#pragma unroll
            for (int k = 0; k < 4; ++k) {
                const bf16x8 ka = *(const LAS bf16x8*)(kp + k * 2048), kb = *(const LAS bf16x8*)(kp + k * 2048 + 512);
                p0 = __builtin_amdgcn_mfma_f32_32x32x16_bf16(ka, qr[k], p0, 0, 0, 0);
                p1 = __builtin_amdgcn_mfma_f32_32x32x16_bf16(kb, qr[k], p1, 0, 0, 0);
            }
            if (MODE == 1) {
                const LAS float* bt = (const LAS float*)(lds + LDS_BIAS) + ch * 320;
                const int relb = 64 * (cw - t) + 32 * (wq & 1) + r32 + 63;
                if (cw - t >= 5) { const float c = bt[319];
#pragma unroll
                    for (int r = 0; r < 16; ++r) { p0[r] += c; p1[r] += c; }
                } else {
#pragma unroll
                    for (int r = 0; r < 16; ++r) { const int i0 = relb - crow(r, hi), i1 = i0 - 32; p0[r] += bt[i0 > 319 ? 319 : i0]; p1[r] += bt[i1 > 319 ? 319 : i1]; }
                }
            }
            float rm = fmaxf(p0[0], p1[0]);
#pragma unroll
            for (int r = 1; r < 16; ++r) rm = fmaxf(rm, fmaxf(p0[r], p1[r]));
            rm = swapmax(rm);
            if (first) { mref = rm; first = false; }
            else if (__any(rm - mref > THR)) {
                const float dl = fmaxf(rm - mref, 0.f); mref += dl; const float f = fast_exp2(-dl); lsum *= f;
                if (hi == 0) wsf[r32] = f;
                LDS_WAIT();
#pragma unroll
                for (int r = 0; r < 16; ++r) { const float fr = wsf[crow(r, hi)];
#pragma unroll
                    for (int d = 0; d < NDB; ++d) o[d][r] *= fr; }
            }
            float sacc = 0.f;
#pragma unroll
            for (int r = 0; r < 16; ++r) { p0[r] = fast_exp2(p0[r] - mref); p1[r] = fast_exp2(p1[r] - mref); sacc += p0[r] + p1[r]; }
            lsum += sacc;
            const bf16x8 pa0 = pack_p(p0, 0), pa1 = pack_p(p0, 8), pa2 = pack_p(p1, 0), pa3 = pack_p(p1, 8);
#pragma unroll
            for (int d = 0; d < NDB; ++d) {
                const lds_cptr vd = vp + d * 4096;
                const bf16x8 v0 = cat8(vtr(vd), vtr(vd + 512)), v1 = cat8(vtr(vd + 1024), vtr(vd + 1024 + 512)), v2 = cat8(vtr(vd + 2048), vtr(vd + 2048 + 512)), v3 = cat8(vtr(vd + 3072), vtr(vd + 3072 + 512));
                o[d] = __builtin_amdgcn_mfma_f32_32x32x16_bf16(pa0, v0, o[d], 0, 0, 0);
                o[d] = __builtin_amdgcn_mfma_f32_32x32x16_bf16(pa1, v1, o[d], 0, 0, 0);
                o[d] = __builtin_amdgcn_mfma_f32_32x32x16_bf16(pa2, v2, o[d], 0, 0, 0);
                o[d] = __builtin_amdgcn_mfma_f32_32x32x16_bf16(pa3, v3, o[d], 0, 0, 0);
            }
        }
        slot = (slot == NSLOT - 1) ? 0 : slot + 1;
    }
    lsum = swapsum(lsum);
    if (hi == 0) wsf[32 + r32] = lsum;
    LDS_WAIT();
#pragma unroll
    for (int r = 0; r < 16; ++r) { const float il = fast_rcp(wsf[32 + crow(r, hi)]);
#pragma unroll
        for (int d = 0; d < NDB; ++d) o[d][r] *= il; }
    FA_BAR();
    if (MODE == 0) {
        LAS float* xf = (LAS float*)lds + (wid & 3) * 4096;
        if (ch == 1) {
#pragma unroll
            for (int d = 0; d < 4; ++d)
#pragma unroll
                for (int r = 0; r < 16; ++r) xf[(d * 16 + r) * 64 + lane] = o[d][r];
        }
        FA_BAR();
        if (ch == 0) {
            float ss[16];
#pragma unroll
            for (int r = 0; r < 16; ++r) ss[r] = 0.f;
#pragma unroll
            for (int d = 0; d < 4; ++d)
#pragma unroll
                for (int r = 0; r < 16; ++r) { const float y = o[d][r] - lam * xf[(d * 16 + r) * 64 + lane]; o[d][r] = y; ss[r] += y * y; }
            LAS bf16_t* stg = (LAS bf16_t*)(lds + 65536) + wid * 4096;
            float g[4];
#pragma unroll
            for (int d = 0; d < 4; ++d) g[d] = subln[32 * d + r32] * osc;
#pragma unroll
            for (int r = 0; r < 16; ++r) { const float rs = __builtin_amdgcn_rsqf(half_sum32(ss[r]) * (1.0f / 128.0f) + EPS); const int orow = crow(r, hi);
#pragma unroll
                for (int d = 0; d < 4; ++d) stg[orow * 128 + d * 32 + r32] = (bf16_t)f2bf(o[d][r] * rs * g[d]); }
            LDS_WAIT();
#pragma unroll
            for (int i = 0; i < 8; ++i) { const int idx = i * 64 + lane, row = idx >> 4, c8 = idx & 15;
                const u32x4 v = *(const LAS u32x4*)(stg + row * 128 + c8 * 8);
                *(u32x4*)(Yg + (qrow + row) * PITCH + hq * 128 + c8 * 8) = v; }
        }
    } else {
        LAS bf16_t* stg = (LAS bf16_t*)lds + wid * 2048;
#pragma unroll
        for (int r = 0; r < 16; ++r) { const int orow = crow(r, hi);
#pragma unroll
            for (int d = 0; d < 2; ++d) stg[orow * 64 + d * 32 + r32] = (bf16_t)f2bf(o[d][r]); }
        LDS_WAIT();
#pragma unroll
        for (int i = 0; i < 4; ++i) { const int idx = i * 64 + lane, row = idx >> 3, c8 = idx & 7;
            const u32x4 v = *(const LAS u32x4*)(stg + row * 64 + c8 * 8);
            *(u32x4*)(Yg + (qrow + row) * PITCH + hq * 128 + ch * 64 + c8 * 8) = v; }
    }
    FA_BAR();
#undef FA_DMA
}

constexpr int NSLOT2 = 4, LDS_WS2 = 132096, LDS_BIAS2 = LDS_WS2 + 2048;
template <int MODE>
__device__ __forceinline__ void attn_unit2(LAS unsigned char* lds, const int tid_, const bf16_t* Qg, const bf16_t* Kg, const bf16_t* Vg, bf16_t* Yg, const int b, const int hq, const int u,
                                           const float lam, const float osc, const float* subln, const int pm = 0) {
    constexpr int PITCH = 512, NDB = (MODE == 0) ? 4 : 2;
    int tid = tid_; asm volatile("" : "+v"(tid));
    const int lane = tid & 63, r32 = lane & 31, hi = lane >> 5, hwid = __builtin_amdgcn_readfirstlane(tid >> 6);
#if FA_WMAP == 1
    const int wid = (hwid >> 1) | ((hwid & 1) << 2);
#elif FA_WMAP == 2
    const int wid = (hwid & 1) | ((hwid >> 2) << 1) | (((hwid >> 1) & 1) << 2);
#else
    const int wid = hwid;
#endif
    const int ch = wid >> 2, wq = wid & 3;
    const int cw = 2 * u + (wq >> 1);
    const int t0 = (MODE == 0) ? 0 : ((2 * u - 8) > 0 ? (2 * u - 8) : 0), t1 = 2 * u + 1, NT = t1 - t0 + 1;
    const int iv1 = cw - t0, iv0 = (MODE == 0) ? 0 : ((cw - 8 - t0) > 0 ? (cw - 8 - t0) : 0);
    const size_t rowbase = (size_t)b * SEQ;
    const bf16_t* Kb = Kg + rowbase * PITCH + hq * 128; const bf16_t* Vb = Vg + rowbase * PITCH + hq * 128;
    const unsigned lds0 = (unsigned)(uintptr_t)lds;
    LAS float* wsf = (LAS float*)(lds + LDS_WS2) + wid * 64;
    const bf16_t* kbase = Kb + (2 * wid) * 8;
    const bf16_t* vbase = Vb + (size_t)(16 * ((2 * wid) & 3)) * PITCH + 32 * ((2 * wid) >> 2);
    const unsigned kvo = (unsigned)lane * PITCH * 2u, vvo = (unsigned)((lane >> 2) * PITCH + (lane & 3) * 8) * 2u;
#define FA_DMA(t, slot) do { if (pm == 1) break; const size_t to_ = (size_t)(t) * 64 * PITCH; const unsigned sb_ = lds0 + (unsigned)(slot) * SLOTB; \
        glds16s(kbase + to_, kvo, (unsigned)__builtin_amdgcn_readfirstlane(sb_ + KOFF + (2 * wid) * 1024)); glds16s(kbase + to_ + 8, kvo, (unsigned)__builtin_amdgcn_readfirstlane(sb_ + KOFF + (2 * wid + 1) * 1024)); \
        glds16s(vbase + to_, vvo, (unsigned)__builtin_amdgcn_readfirstlane(sb_ + VOFF + (2 * wid) * 1024)); glds16s(vbase + to_ + 16 * PITCH, vvo, (unsigned)__builtin_amdgcn_readfirstlane(sb_ + VOFF + (2 * wid + 1) * 1024)); } while (0)
    FA_DMA(t0, 0);
    FA_DMA(t0 + 1, 1);
    const size_t qrow = rowbase + (size_t)u * 128 + wq * 32;
    bf16x8 qr[4];
#pragma unroll
    for (int i = 0; i < 4; ++i) qr[i] = *(const bf16x8*)(Qg + (qrow + r32) * PITCH + hq * 128 + ch * 64 + i * 16 + hi * 8);
    f32x16 o[NDB];
#pragma unroll
    for (int d = 0; d < NDB; ++d)
#pragma unroll
        for (int r = 0; r < 16; ++r) o[d][r] = 0.f;
    float mref = 0.f, lsum = 0.f; bool first = true;
    const lds_cptr kp0 = (lds_cptr)lds + KOFF + ch * 8192 + hi * 1024 + r32 * 16;
    const lds_cptr vp0 = (lds_cptr)lds + VOFF + ((MODE == 0) ? 0 : ch * 8192) + ((lane >> 4) & 1) * 32 + (lane & 3) * 8 + (4 * hi + ((lane & 15) >> 2)) * 64;
    f32x16 p0, p1; bf16x8 pa0, pa1, pa2, pa3, kf[8], vf[NDB * 4];
#pragma unroll
    for (int r = 0; r < 16; ++r) { p0[r] = 0.f; p1[r] = 0.f; }
    pa0 = pa1 = pa2 = pa3 = (bf16x8){0, 0, 0, 0, 0, 0, 0, 0};
#pragma unroll
    for (int k = 0; k < NDB * 4; ++k) vf[k] = pa0;
#define FA_SB() __builtin_amdgcn_sched_barrier(0)
#define FA_KLD(i_) do { if (pm == 7) break; const lds_cptr kp = kp0 + ((i_) & 3) * SLOTB; \
        _Pragma("unroll") for (int k = 0; k < 4; ++k) { kf[2 * k] = *(const LAS bf16x8*)(kp + k * 2048); kf[2 * k + 1] = *(const LAS bf16x8*)(kp + k * 2048 + 512); } } while (0)
#define FA_QK(i_) do { \
        _Pragma("unroll") for (int r = 0; r < 16; ++r) { p0[r] = 0.f; p1[r] = 0.f; } \
        _Pragma("unroll") for (int k = 0; k < 4; ++k) { p0 = __builtin_amdgcn_mfma_f32_32x32x16_bf16(kf[2 * k], qr[k], p0, 0, 0, 0); p1 = __builtin_amdgcn_mfma_f32_32x32x16_bf16(kf[2 * k + 1], qr[k], p1, 0, 0, 0); } \
        if (MODE == 1) { const int t = t0 + (i_); const LAS float* bt = (const LAS float*)(lds + LDS_BIAS2) + ch * 320; const int relb = 64 * (cw - t) + 32 * (wq & 1) + r32 + 63; \
            if (cw - t >= 5) { const float c = bt[319]; _Pragma("unroll") for (int r = 0; r < 16; ++r) { p0[r] += c; p1[r] += c; } } \
            else { _Pragma("unroll") for (int r = 0; r < 16; ++r) { const int i0 = relb - crow(r, hi), i1 = i0 - 32; p0[r] += bt[i0 > 319 ? 319 : i0]; p1[r] += bt[i1 > 319 ? 319 : i1]; } } } } while (0)
#define FA_MX3(a, b, c) __builtin_fmaxf(__builtin_fmaxf((a), (b)), (c))
#define FA_SM() do { if (pm == 3) { asm volatile("" : "+v"(p0), "+v"(p1)); break; } \
        float ma = FA_MX3(p0[0], p0[1], p1[0]), mb = FA_MX3(p0[2], p0[3], p1[1]), mc = FA_MX3(p0[4], p0[5], p1[2]), md = FA_MX3(p0[6], p0[7], p1[3]); \
        ma = FA_MX3(ma, p0[8], p0[9]); mb = FA_MX3(mb, p0[10], p0[11]); mc = FA_MX3(mc, p0[12], p0[13]); md = FA_MX3(md, p0[14], p0[15]); \
        ma = FA_MX3(ma, p1[4], p1[5]); mb = FA_MX3(mb, p1[6], p1[7]); mc = FA_MX3(mc, p1[8], p1[9]); md = FA_MX3(md, p1[10], p1[11]); \
        ma = FA_MX3(ma, p1[12], p1[13]); mb = FA_MX3(mb, p1[14], p1[15]); float rm = __builtin_fmaxf(__builtin_fmaxf(ma, mb), __builtin_fmaxf(mc, md)); rm = swapmax(rm); \
        if (first) { mref = rm; first = false; } \
        else if (__any(rm - mref > THR)) { const float dl = fmaxf(rm - mref, 0.f); mref += dl; const float f = fast_exp2(-dl); lsum *= f; if (hi == 0) wsf[r32] = f; LDS_WAIT(); \
            _Pragma("unroll") for (int r = 0; r < 16; ++r) { const float fr = wsf[crow(r, hi)]; _Pragma("unroll") for (int d = 0; d < NDB; ++d) o[d][r] *= fr; } } \
        float sa = 0.f, sb = 0.f, sc = 0.f, sd = 0.f; \
        _Pragma("unroll") for (int r = 0; r < 16; r += 4) { p0[r] = fast_exp2(p0[r] - mref); p0[r + 1] = fast_exp2(p0[r + 1] - mref); p0[r + 2] = fast_exp2(p0[r + 2] - mref); p0[r + 3] = fast_exp2(p0[r + 3] - mref); \
            p1[r] = fast_exp2(p1[r] - mref); p1[r + 1] = fast_exp2(p1[r + 1] - mref); p1[r + 2] = fast_exp2(p1[r + 2] - mref); p1[r + 3] = fast_exp2(p1[r + 3] - mref); \
            sa += p0[r] + p1[r]; sb += p0[r + 1] + p1[r + 1]; sc += p0[r + 2] + p1[r + 2]; sd += p0[r + 3] + p1[r + 3]; } \
        lsum += (sa + sb) + (sc + sd); \
        pa0 = pack_p(p0, 0); pa1 = pack_p(p0, 8); pa2 = pack_p(p1, 0); pa3 = pack_p(p1, 8); } while (0)
#define FA_VLDALL(i_) do { if (pm == 4) break; const lds_cptr vt = vp0 + ((i_) & 3) * SLOTB; \
        _Pragma("unroll") for (int d = 0; d < NDB; ++d) _Pragma("unroll") for (int k = 0; k < 4; ++k) vf[4 * d + k] = cat8(vtr(vt + d * 4096 + k * 1024), vtr(vt + d * 4096 + k * 1024 + 512)); } while (0)
#define FA_PV() do { if (pm == 5) break; _Pragma("unroll") for (int d = 0; d < NDB; ++d) { \
        o[d] = __builtin_amdgcn_mfma_f32_32x32x16_bf16(pa0, vf[4 * d], o[d], 0, 0, 0); o[d] = __builtin_amdgcn_mfma_f32_32x32x16_bf16(pa1, vf[4 * d + 1], o[d], 0, 0, 0); \
        o[d] = __builtin_amdgcn_mfma_f32_32x32x16_bf16(pa2, vf[4 * d + 2], o[d], 0, 0, 0); o[d] = __builtin_amdgcn_mfma_f32_32x32x16_bf16(pa3, vf[4 * d + 3], o[d], 0, 0, 0); } } while (0)
#if PROBE_T
    unsigned tacc0 = 0, tacc1 = 0, tacc2 = 0, tacc3 = 0; unsigned long long s0 = 0, s1 = 0, s2 = 0, s3 = 0; const unsigned long long rt0 = __builtin_amdgcn_s_memrealtime();
#define FA_TS(v) do { FA_SB(); asm volatile("s_memtime %0\n\ts_waitcnt lgkmcnt(0)" : "=s"(v) :: "memory"); FA_SB(); } while (0)
#define FA_TSV(v, a, b) do { FA_SB(); asm volatile("s_nop 15\n\ts_nop 15" : "+v"(a), "+v"(b)); asm volatile("s_memtime %0\n\ts_waitcnt lgkmcnt(0)" : "=s"(v) :: "memory"); FA_SB(); } while (0)
#define FA_TACC() do { tacc0 += (unsigned)(s3 - s0); tacc1 += (unsigned)(s1 - s0); tacc2 += (unsigned)(s2 - s1); tacc3 += (unsigned)(s3 - s2); } while (0)
#define FA_TOUT(base) do { if (blockIdx.x == 0 && (hwid & 3) == 0 && u >= 32) { const unsigned long long rt1 = __builtin_amdgcn_s_memrealtime(); \
        unsigned long long* pv = (unsigned long long*)((char*)Yg - WS_AQ + WS_PROBE) + (base); if (lane == 0) { pv[0] = tacc0 / NT; pv[1] = tacc1 / NT; pv[2] = tacc2 / NT; pv[3] = tacc3 / NT; pv[4] = ((unsigned long long)tacc0 * 100) / (rt1 - rt0); pv[5] = NT; } } } while (0)
#else
#define FA_TS(v) do { } while (0)
#define FA_TSV(v, a, b) do { } while (0)
#define FA_TACC() do { } while (0)
#define FA_TOUT(base) do { } while (0)
#endif
    if (ch == 0) {
#pragma unroll 1
        for (int i = 0; i < NT; ++i) {
            FA_TS(s0);
            if (i + 1 < NT) FA_WAIT_BAR(4); else FA_WAIT_BAR(0);
            FA_TS(s1);
            if (i + 2 < NT) FA_DMA(t0 + i + 2, (i + 2) & 3);
            if (pm != 2) {
                const bool prev = (i - 1 >= iv0) && (i - 1 <= iv1), cur = (i >= iv0) && (i <= iv1);
                if (cur) FA_KLD(i);
                FA_SB();
                if (prev) { FA_PV(); FA_SB(); }
                if (cur) { FA_QK(i); FA_SB(); FA_TSV(s2, p0, p1); FA_VLDALL(i); FA_SB(); FA_SM(); FA_SB(); FA_TSV(s3, pa0, pa3); FA_TACC(); }
            }
        }
        FA_TOUT(0);
        if (NT - 1 <= iv1 && pm != 2) FA_PV();
    } else {
#pragma unroll 1
        for (int i = 0; i < NT; ++i) {
            FA_TS(s0);
            if (i + 1 < NT) FA_WAIT_BAR(4); else FA_WAIT_BAR(0);
            FA_TS(s1);
            if (i + 2 < NT) FA_DMA(t0 + i + 2, (i + 2) & 3);
            if (pm != 2) {
                const bool prev = (i - 1 >= iv0) && (i - 1 <= iv1), cur = (i >= iv0) && (i <= iv1);
                if (prev) { FA_VLDALL(i - 1); FA_SB(); FA_SM(); FA_SB(); FA_TSV(s2, pa0, pa3); }
                if (cur) { FA_KLD(i); FA_SB(); }
                if (prev) { FA_PV(); FA_SB(); }
                if (cur) { FA_QK(i); FA_SB(); FA_TSV(s3, p0, p1); if (prev) FA_TACC(); }
            }
        }
        FA_TOUT(8);
        if (NT - 1 <= iv1 && pm != 2) { FA_VLDALL(NT - 1); FA_SB(); FA_SM(); FA_SB(); FA_PV(); }
    }
#undef FA_VLDALL
#undef FA_MX3
#undef FA_TS
#undef FA_TSV
#undef FA_TACC
#undef FA_TOUT
#undef FA_KLD
#undef FA_SB
#undef FA_QK
#undef FA_SM
#undef FA_PV
    lsum = swapsum(lsum);
    if (hi == 0) wsf[32 + r32] = lsum;
    LDS_WAIT();
#pragma unroll
    for (int r = 0; r < 16; ++r) { const float il = fast_rcp(wsf[32 + crow(r, hi)]);
#pragma unroll
        for (int d = 0; d < NDB; ++d) o[d][r] *= il; }
    FA_BAR();
    if (MODE == 0) {
        LAS float* xf = (LAS float*)lds + (wid & 3) * 4096;
        if (ch == 1) {
#pragma unroll
            for (int d = 0; d < 4; ++d)
#pragma unroll
                for (int r = 0; r < 16; ++r) xf[(d * 16 + r) * 64 + lane] = o[d][r];
        }
        FA_BAR();
        if (ch == 0) {
            float ss[16];
#pragma unroll
            for (int r = 0; r < 16; ++r) ss[r] = 0.f;
#pragma unroll
            for (int d = 0; d < 4; ++d)
#pragma unroll
                for (int r = 0; r < 16; ++r) { const float y = o[d][r] - lam * xf[(d * 16 + r) * 64 + lane]; o[d][r] = y; ss[r] += y * y; }
            LAS bf16_t* stg = (LAS bf16_t*)(lds + 65536) + wid * 4096;
            float g[4];
#pragma unroll
            for (int d = 0; d < 4; ++d) g[d] = subln[32 * d + r32] * osc;
#pragma unroll
            for (int r = 0; r < 16; ++r) { const float rs = __builtin_amdgcn_rsqf(half_sum32(ss[r]) * (1.0f / 128.0f) + EPS); const int orow = crow(r, hi);
#pragma unroll
                for (int d = 0; d < 4; ++d) stg[orow * 128 + d * 32 + r32] = (bf16_t)f2bf(o[d][r] * rs * g[d]); }
            LDS_WAIT();
#pragma unroll
            for (int i = 0; i < 8; ++i) { const int idx = i * 64 + lane, row = idx >> 4, c8 = idx & 15;
                const u32x4 v = *(const LAS u32x4*)(stg + row * 128 + c8 * 8);
                *(u32x4*)(Yg + (qrow + row) * PITCH + hq * 128 + c8 * 8) = v; }
        }
    } else {
        LAS bf16_t* stg = (LAS bf16_t*)lds + wid * 2048;
#pragma unroll
        for (int r = 0; r < 16; ++r) { const int orow = crow(r, hi);
#pragma unroll
            for (int d = 0; d < 2; ++d) stg[orow * 64 + d * 32 + r32] = (bf16_t)f2bf(o[d][r]); }
        LDS_WAIT();
#pragma unroll
        for (int i = 0; i < 4; ++i) { const int idx = i * 64 + lane, row = idx >> 3, c8 = idx & 7;
            const u32x4 v = *(const LAS u32x4*)(stg + row * 64 + c8 * 8);
            *(u32x4*)(Yg + (qrow + row) * PITCH + hq * 128 + ch * 64 + c8 * 8) = v; }
    }
    FA_BAR();
#undef FA_DMA
}

constexpr int K3OFF = 0, V3OFF = 49152, NK3 = 3;
template <int MODE, bool NOMAX>
__device__ __forceinline__ void attn_unit3(LAS unsigned char* lds, const int tid_, const bf16_t* Qg, const bf16_t* Kg, const bf16_t* Vg, bf16_t* Yg, const int b, const int hq, const int u,
                                           const float lam, const float osc, const float* subln, const int pm = 0) {
    constexpr int PITCH = 512, NDB = (MODE == 0) ? 4 : 2;
    int tid = tid_; asm volatile("" : "+v"(tid));
#if PROBE_T
    const unsigned long long tu0_ = __builtin_amdgcn_s_memtime();
#endif
    const int lane = tid & 63, r32 = lane & 31, hi = lane >> 5, wid = __builtin_amdgcn_readfirstlane(tid >> 6), ch = wid >> 2, wq = wid & 3;
    const int cw = 2 * u + (wq >> 1);
    const int t0 = (MODE == 0) ? 0 : ((2 * u - 8) > 0 ? (2 * u - 8) : 0), t1 = 2 * u + 1, NT = t1 - t0 + 1;
    const int iv1 = cw - t0, iv0 = (MODE == 0) ? 0 : ((cw - 8 - t0) > 0 ? (cw - 8 - t0) : 0);
    const size_t rowbase = (size_t)b * SEQ;
    const bf16_t* Kb = Kg + rowbase * PITCH + hq * 128; const bf16_t* Vb = Vg + rowbase * PITCH + hq * 128;
    const unsigned lds0 = (unsigned)(uintptr_t)lds;
    LAS float* wsf = (LAS float*)(lds + LDS_WS2) + wid * 64;
    const bf16_t* kbase = Kb + (2 * wid) * 8;
    const bf16_t* vbase = Vb + (size_t)(16 * ((2 * wid) & 3)) * PITCH + 32 * ((2 * wid) >> 2);
    const unsigned kvo = (unsigned)lane * PITCH * 2u, vvo = (unsigned)((lane >> 2) * PITCH + (lane & 3) * 8) * 2u;
#define F3_DMAK(j) do { if ((j) < NT) { const size_t to_ = (size_t)(t0 + (j)) * 64 * PITCH; const unsigned sb_ = lds0 + K3OFF + (unsigned)((j) % NK3) * 16384u; \
        glds16s(kbase + to_, kvo, (unsigned)__builtin_amdgcn_readfirstlane(sb_ + (2 * wid) * 1024)); glds16s(kbase + to_ + 8, kvo, (unsigned)__builtin_amdgcn_readfirstlane(sb_ + (2 * wid + 1) * 1024)); } } while (0)
#define F3_DMAV(j) do { if ((j) < NT) { const size_t to_ = (size_t)(t0 + (j)) * 64 * PITCH; const unsigned sb_ = lds0 + V3OFF + (unsigned)((j) & 3) * 16384u; \
        glds16s(vbase + to_, vvo, (unsigned)__builtin_amdgcn_readfirstlane(sb_ + (2 * wid) * 1024)); glds16s(vbase + to_ + 16 * PITCH, vvo, (unsigned)__builtin_amdgcn_readfirstlane(sb_ + (2 * wid + 1) * 1024)); } } while (0)
#define F3_DMAK1(j, pc) do { if ((j) < NT) { const size_t to_ = (size_t)(t0 + (j)) * 64 * PITCH; const unsigned sb_ = lds0 + K3OFF + (unsigned)((j) % NK3) * 16384u; \
        glds16s(kbase + to_ + 8 * (pc), kvo, (unsigned)__builtin_amdgcn_readfirstlane(sb_ + (2 * wid + (pc)) * 1024)); } } while (0)
#define F3_DMAV1(j, pc) do { if ((j) < NT) { const size_t to_ = (size_t)(t0 + (j)) * 64 * PITCH; const unsigned sb_ = lds0 + V3OFF + (unsigned)((j) & 3) * 16384u; \
        glds16s(vbase + to_ + 16 * PITCH * (pc), vvo, (unsigned)__builtin_amdgcn_readfirstlane(sb_ + (2 * wid + (pc)) * 1024)); } } while (0)
    F3_DMAK(0); F3_DMAK(1); F3_DMAV(0); F3_DMAK(2); F3_DMAV(1);
    const size_t qrow = rowbase + (size_t)u * 128 + wq * 32;
    bf16x8 qr[4];
#pragma unroll
    for (int i = 0; i < 4; ++i) qr[i] = *(const bf16x8*)(Qg + (qrow + r32) * PITCH + hq * 128 + ch * 64 + i * 16 + hi * 8);
    f32x16 o[NDB];
#pragma unroll
    for (int d = 0; d < NDB; ++d)
#pragma unroll
        for (int r = 0; r < 16; ++r) o[d][r] = 0.f;
    float mref = -1e30f, lsum = 0.f;
    const lds_cptr kp0 = (lds_cptr)lds + K3OFF + ch * 8192 + hi * 1024 + r32 * 16;
    const lds_cptr vp0 = (lds_cptr)lds + V3OFF + ((MODE == 0) ? 0 : ch * 8192) + ((lane >> 4) & 1) * 32 + (lane & 3) * 8 + (4 * hi + ((lane & 15) >> 2)) * 64;
    const LAS float* btab = (const LAS float*)(lds + LDS_BIAS2) + ch * 640;
    f32x16 cA0, cA1, cB0, cB1; u32x4 pA[4], pB[4];
#pragma unroll
    for (int r = 0; r < 16; ++r) { cA0[r] = 0.f; cA1[r] = 0.f; cB0[r] = 0.f; cB1[r] = 0.f; }
#pragma unroll
    for (int k = 0; k < 4; ++k) { pA[k] = (u32x4){0u, 0u, 0u, 0u}; pB[k] = (u32x4){0u, 0u, 0u, 0u}; }
#define F3_SB() __builtin_amdgcn_sched_barrier(0)
#define F3_MX3(a, b, c) __builtin_fmaxf(__builtin_fmaxf((a), (b)), (c))
#define F3_QK(j, d0, d1) do { const lds_cptr kp = kp0 + ((j) % NK3) * 16384; \
        _Pragma("unroll") for (int k = 0; k < 4; ++k) { const bf16x8 ka = *(const LAS bf16x8*)(kp + k * 2048), kb = *(const LAS bf16x8*)(kp + k * 2048 + 512); \
            if (k == 0) { d0 = __builtin_amdgcn_mfma_f32_32x32x16_bf16(ka, qr[0], (f32x16){0.f, 0.f, 0.f, 0.f, 0.f, 0.f, 0.f, 0.f, 0.f, 0.f, 0.f, 0.f, 0.f, 0.f, 0.f, 0.f}, 0, 0, 0); d1 = __builtin_amdgcn_mfma_f32_32x32x16_bf16(kb, qr[0], (f32x16){0.f, 0.f, 0.f, 0.f, 0.f, 0.f, 0.f, 0.f, 0.f, 0.f, 0.f, 0.f, 0.f, 0.f, 0.f, 0.f}, 0, 0, 0); } \
            else { d0 = __builtin_amdgcn_mfma_f32_32x32x16_bf16(ka, qr[k], d0, 0, 0, 0); d1 = __builtin_amdgcn_mfma_f32_32x32x16_bf16(kb, qr[k], d1, 0, 0, 0); } } } while (0)
#define F3_BIAS(j, d0, d1) do { if (MODE == 1) { const int t = t0 + (j); const LAS float* bt = btab; const int relb = 64 * (cw - t) + 32 * (wq & 1) + r32 + 63; \
            if (cw - t >= 5) { const float c = bt[319]; _Pragma("unroll") for (int r = 0; r < 16; ++r) { d0[r] += c; d1[r] += c; } } \
            else { _Pragma("unroll") for (int r = 0; r < 16; ++r) { const int i0 = relb - crow(r, hi), i1 = i0 - 32; d0[r] += bt[i0 > 319 ? 319 : i0]; d1[r] += bt[i1 > 319 ? 319 : i1]; } } } } while (0)
#define F3_PV(j, P) do { const lds_cptr vt = vp0 + ((j) & 3) * 16384; \
        _Pragma("unroll") for (int d = 0; d < NDB; ++d) { const lds_cptr vd = vt + d * 4096; \
            o[d] = __builtin_amdgcn_mfma_f32_32x32x16_bf16(__builtin_bit_cast(bf16x8, P[0]), cat8(vtr(vd), vtr(vd + 512)), o[d], 0, 0, 0); o[d] = __builtin_amdgcn_mfma_f32_32x32x16_bf16(__builtin_bit_cast(bf16x8, P[1]), cat8(vtr(vd + 1024), vtr(vd + 1536)), o[d], 0, 0, 0); \
            o[d] = __builtin_amdgcn_mfma_f32_32x32x16_bf16(__builtin_bit_cast(bf16x8, P[2]), cat8(vtr(vd + 2048), vtr(vd + 2560)), o[d], 0, 0, 0); o[d] = __builtin_amdgcn_mfma_f32_32x32x16_bf16(__builtin_bit_cast(bf16x8, P[3]), cat8(vtr(vd + 3072), vtr(vd + 3584)), o[d], 0, 0, 0); } } while (0)
#define F3_SM(c0, c1, P) do { \
        if (NOMAX) { upd = false; } else { \
        float ma = F3_MX3(c0[0], c0[1], c1[0]), mb = F3_MX3(c0[2], c0[3], c1[1]), mc = F3_MX3(c0[4], c0[5], c1[2]), md = F3_MX3(c0[6], c0[7], c1[3]); \
        ma = F3_MX3(ma, c0[8], c0[9]); mb = F3_MX3(mb, c0[10], c0[11]); mc = F3_MX3(mc, c0[12], c0[13]); md = F3_MX3(md, c0[14], c0[15]); \
        ma = F3_MX3(ma, c1[4], c1[5]); mb = F3_MX3(mb, c1[6], c1[7]); mc = F3_MX3(mc, c1[8], c1[9]); md = F3_MX3(md, c1[10], c1[11]); \
        ma = F3_MX3(ma, c1[12], c1[13]); mb = F3_MX3(mb, c1[14], c1[15]); float rm = __builtin_fmaxf(__builtin_fmaxf(ma, mb), __builtin_fmaxf(mc, md)); rm = swapmax(rm); \
        upd = __any(rm - mref > THR); const float mnew = upd ? __builtin_fmaxf(mref, rm) : mref; fsc = fast_exp2(mref - mnew); mref = mnew; lsum *= fsc; } \
        float sa = 0.f, sb = 0.f, sc = 0.f, sd = 0.f; \
        _Pragma("unroll") for (int r = 0; r < 16; r += 4) { \
            if (NOMAX) { c0[r] = fast_exp2(c0[r]); c0[r + 1] = fast_exp2(c0[r + 1]); c0[r + 2] = fast_exp2(c0[r + 2]); c0[r + 3] = fast_exp2(c0[r + 3]); \
                         c1[r] = fast_exp2(c1[r]); c1[r + 1] = fast_exp2(c1[r + 1]); c1[r + 2] = fast_exp2(c1[r + 2]); c1[r + 3] = fast_exp2(c1[r + 3]); } \
            else { c0[r] = fast_exp2(c0[r] - mref); c0[r + 1] = fast_exp2(c0[r + 1] - mref); c0[r + 2] = fast_exp2(c0[r + 2] - mref); c0[r + 3] = fast_exp2(c0[r + 3] - mref); \
                   c1[r] = fast_exp2(c1[r] - mref); c1[r + 1] = fast_exp2(c1[r + 1] - mref); c1[r + 2] = fast_exp2(c1[r + 2] - mref); c1[r + 3] = fast_exp2(c1[r + 3] - mref); } \
            sa += c0[r] + c1[r]; sb += c0[r + 1] + c1[r + 1]; sc += c0[r + 2] + c1[r + 2]; sd += c0[r + 3] + c1[r + 3]; } \
        lsum += (sa + sb) + (sc + sd); \
        P[0] = __builtin_bit_cast(u32x4, pack_p(c0, 0)); P[1] = __builtin_bit_cast(u32x4, pack_p(c0, 8)); P[2] = __builtin_bit_cast(u32x4, pack_p(c1, 0)); P[3] = __builtin_bit_cast(u32x4, pack_p(c1, 8)); } while (0)
#define F3_RESC() do { if (!NOMAX && upd) { if (hi == 0) wsf[r32] = fsc; LDS_WAIT(); \
            _Pragma("unroll") for (int r = 0; r < 16; ++r) { const float fr = wsf[crow(r, hi)]; _Pragma("unroll") for (int d = 0; d < NDB; ++d) o[d][r] *= fr; } } } while (0)
#define F3_HEAD(i) do { if ((i) + 3 < NT) { asm volatile("s_waitcnt vmcnt(6) lgkmcnt(0)\n\ts_barrier" ::: "memory"); } else FA_WAIT_BAR(0); \
        F3_DMAK((i) + 3); F3_DMAV((i) + 2); F3_SB(); } while (0)
#if PROBE_T
    unsigned tq0 = 0, tq1 = 0, tqn = 0; unsigned long long ts0_ = 0, ts1_ = 0, ts2_ = 0;
#define F3_TS(v) do { F3_SB(); asm volatile("s_memtime %0\n\ts_waitcnt lgkmcnt(0)" : "=s"(v) :: "memory"); F3_SB(); } while (0)
#define F3_TSE(a, b) do { F3_SB(); asm volatile("s_nop 15\n\ts_nop 15" : "+v"(a), "+v"(b)); asm volatile("s_memtime %0\n\ts_waitcnt lgkmcnt(0)" : "=s"(ts2_) :: "memory"); F3_SB(); tq0 += (unsigned)(ts1_ - ts0_); tq1 += (unsigned)(ts2_ - ts1_); ++tqn; } while (0)
#else
#define F3_TS(v) do { } while (0)
#define F3_TSE(a, b) do { } while (0)
#endif
#define F3_HAND(i, C0, C1, N0, N1, PP, PW) do { \
        const lds_cptr vt_ = vp0 + (((i) - 1) & 3) * 16384; const lds_cptr kq_ = kp0 + (((i) + 1) % NK3) * 16384; \
        bf16x8 fq0, fq1, fq2, fq3, fq4; float sa_ = 0.f, sb_ = 0.f; \
        fq0 = cat8(vtr(vt_ + 0), vtr(vt_ + 512)); fq1 = cat8(vtr(vt_ + 1024), vtr(vt_ + 1536)); fq2 = cat8(vtr(vt_ + 2048), vtr(vt_ + 2560)); F3_SB(); \
        F3_TS(ts0_); if ((i) + 3 < NT) { asm volatile("s_waitcnt vmcnt(6) lgkmcnt(0)\n\ts_barrier" ::: "memory"); } else FA_WAIT_BAR(0); F3_TS(ts1_); \
        F3_SB(); \
        o[0] = __builtin_amdgcn_mfma_f32_32x32x16_bf16(__builtin_bit_cast(bf16x8, PP[0]), fq0, o[0], 0, 0, 0); fq3 = cat8(vtr(vt_ + 3072), vtr(vt_ + 3584)); F3_DMAK1((i) + 3, 0); C0[0] = fast_exp2(C0[0]); C0[1] = fast_exp2(C0[1]); asm volatile("" : "+v"(C0)); F3_SB(); \
        o[0] = __builtin_amdgcn_mfma_f32_32x32x16_bf16(__builtin_bit_cast(bf16x8, PP[1]), fq1, o[0], 0, 0, 0); fq0 = cat8(vtr(vt_ + 4096), vtr(vt_ + 4608)); F3_DMAK1((i) + 3, 1); C0[2] = fast_exp2(C0[2]); C0[3] = fast_exp2(C0[3]); asm volatile("" : "+v"(C0)); F3_SB(); \
        o[0] = __builtin_amdgcn_mfma_f32_32x32x16_bf16(__builtin_bit_cast(bf16x8, PP[2]), fq2, o[0], 0, 0, 0); fq1 = cat8(vtr(vt_ + 5120), vtr(vt_ + 5632)); F3_DMAV1((i) + 2, 0); C0[4] = fast_exp2(C0[4]); C0[5] = fast_exp2(C0[5]); asm volatile("" : "+v"(C0)); F3_SB(); \
        o[0] = __builtin_amdgcn_mfma_f32_32x32x16_bf16(__builtin_bit_cast(bf16x8, PP[3]), fq3, o[0], 0, 0, 0); fq2 = cat8(vtr(vt_ + 6144), vtr(vt_ + 6656)); F3_DMAV1((i) + 2, 1); C0[6] = fast_exp2(C0[6]); C0[7] = fast_exp2(C0[7]); asm volatile("" : "+v"(C0)); F3_SB(); \
        o[1] = __builtin_amdgcn_mfma_f32_32x32x16_bf16(__builtin_bit_cast(bf16x8, PP[0]), fq0, o[1], 0, 0, 0); fq3 = cat8(vtr(vt_ + 7168), vtr(vt_ + 7680)); C0[8] = fast_exp2(C0[8]); C0[9] = fast_exp2(C0[9]); asm volatile("" : "+v"(C0)); F3_SB(); \
        o[1] = __builtin_amdgcn_mfma_f32_32x32x16_bf16(__builtin_bit_cast(bf16x8, PP[1]), fq1, o[1], 0, 0, 0); fq0 = cat8(vtr(vt_ + 8192), vtr(vt_ + 8704)); C0[10] = fast_exp2(C0[10]); C0[11] = fast_exp2(C0[11]); asm volatile("" : "+v"(C0)); F3_SB(); \
        o[1] = __builtin_amdgcn_mfma_f32_32x32x16_bf16(__builtin_bit_cast(bf16x8, PP[2]), fq2, o[1], 0, 0, 0); fq1 = cat8(vtr(vt_ + 9216), vtr(vt_ + 9728)); C0[12] = fast_exp2(C0[12]); C0[13] = fast_exp2(C0[13]); asm volatile("" : "+v"(C0)); F3_SB(); \
        o[1] = __builtin_amdgcn_mfma_f32_32x32x16_bf16(__builtin_bit_cast(bf16x8, PP[3]), fq3, o[1], 0, 0, 0); fq2 = cat8(vtr(vt_ + 10240), vtr(vt_ + 10752)); C0[14] = fast_exp2(C0[14]); C0[15] = fast_exp2(C0[15]); asm volatile("" : "+v"(C0)); F3_SB(); \
        o[2] = __builtin_amdgcn_mfma_f32_32x32x16_bf16(__builtin_bit_cast(bf16x8, PP[0]), fq0, o[2], 0, 0, 0); fq3 = cat8(vtr(vt_ + 11264), vtr(vt_ + 11776)); C1[0] = fast_exp2(C1[0]); C1[1] = fast_exp2(C1[1]); sa_ += C0[0]; sb_ += C0[1]; asm volatile("" : "+v"(C1), "+v"(sa_), "+v"(sb_)); F3_SB(); \
        o[2] = __builtin_amdgcn_mfma_f32_32x32x16_bf16(__builtin_bit_cast(bf16x8, PP[1]), fq1, o[2], 0, 0, 0); fq0 = cat8(vtr(vt_ + 12288), vtr(vt_ + 12800)); C1[2] = fast_exp2(C1[2]); C1[3] = fast_exp2(C1[3]); sa_ += C0[2]; sb_ += C0[3]; asm volatile("" : "+v"(C1), "+v"(sa_), "+v"(sb_)); F3_SB(); \
        o[2] = __builtin_amdgcn_mfma_f32_32x32x16_bf16(__builtin_bit_cast(bf16x8, PP[2]), fq2, o[2], 0, 0, 0); fq1 = cat8(vtr(vt_ + 13312), vtr(vt_ + 13824)); C1[4] = fast_exp2(C1[4]); C1[5] = fast_exp2(C1[5]); sa_ += C0[4]; sb_ += C0[5]; asm volatile("" : "+v"(C1), "+v"(sa_), "+v"(sb_)); F3_SB(); \
        o[2] = __builtin_amdgcn_mfma_f32_32x32x16_bf16(__builtin_bit_cast(bf16x8, PP[3]), fq3, o[2], 0, 0, 0); fq2 = cat8(vtr(vt_ + 14336), vtr(vt_ + 14848)); C1[6] = fast_exp2(C1[6]); C1[7] = fast_exp2(C1[7]); sa_ += C0[6]; sb_ += C0[7]; asm volatile("" : "+v"(C1), "+v"(sa_), "+v"(sb_)); F3_SB(); \
        o[3] = __builtin_amdgcn_mfma_f32_32x32x16_bf16(__builtin_bit_cast(bf16x8, PP[0]), fq0, o[3], 0, 0, 0); fq3 = cat8(vtr(vt_ + 15360), vtr(vt_ + 15872)); C1[8] = fast_exp2(C1[8]); C1[9] = fast_exp2(C1[9]); sa_ += C0[8]; sb_ += C0[9]; asm volatile("" : "+v"(C1), "+v"(sa_), "+v"(sb_)); F3_SB(); \
        o[3] = __builtin_amdgcn_mfma_f32_32x32x16_bf16(__builtin_bit_cast(bf16x8, PP[1]), fq1, o[3], 0, 0, 0); fq0 = *(const LAS bf16x8*)(kq_ + 0); C1[10] = fast_exp2(C1[10]); C1[11] = fast_exp2(C1[11]); sa_ += C0[10]; sb_ += C0[11]; asm volatile("" : "+v"(C1), "+v"(sa_), "+v"(sb_)); F3_SB(); \
        o[3] = __builtin_amdgcn_mfma_f32_32x32x16_bf16(__builtin_bit_cast(bf16x8, PP[2]), fq2, o[3], 0, 0, 0); fq1 = *(const LAS bf16x8*)(kq_ + 512); C1[12] = fast_exp2(C1[12]); C1[13] = fast_exp2(C1[13]); sa_ += C0[12]; sb_ += C0[13]; asm volatile("" : "+v"(C1), "+v"(sa_), "+v"(sb_)); F3_SB(); \
        o[3] = __builtin_amdgcn_mfma_f32_32x32x16_bf16(__builtin_bit_cast(bf16x8, PP[3]), fq3, o[3], 0, 0, 0); fq2 = *(const LAS bf16x8*)(kq_ + 2048); C1[14] = fast_exp2(C1[14]); C1[15] = fast_exp2(C1[15]); sa_ += C0[14]; sb_ += C0[15]; asm volatile("" : "+v"(C1), "+v"(sa_), "+v"(sb_)); F3_SB(); \
        N0 = __builtin_amdgcn_mfma_f32_32x32x16_bf16(fq0, qr[0], (f32x16){0.f,0.f,0.f,0.f,0.f,0.f,0.f,0.f,0.f,0.f,0.f,0.f,0.f,0.f,0.f,0.f}, 0, 0, 0); fq3 = *(const LAS bf16x8*)(kq_ + 2560); sa_ += C1[0]; sb_ += C1[1]; PW[0][0] = cvt_pk_bf16(C0[0], C0[1]); PW[0][1] = cvt_pk_bf16(C0[2], C0[3]); asm volatile("" : "+v"(sa_), "+v"(sb_), "+v"(PW[0])); F3_SB(); \
        N1 = __builtin_amdgcn_mfma_f32_32x32x16_bf16(fq1, qr[0], (f32x16){0.f,0.f,0.f,0.f,0.f,0.f,0.f,0.f,0.f,0.f,0.f,0.f,0.f,0.f,0.f,0.f}, 0, 0, 0); fq0 = *(const LAS bf16x8*)(kq_ + 4096); sa_ += C1[2]; sb_ += C1[3]; PW[0][2] = cvt_pk_bf16(C0[4], C0[5]); PW[0][3] = cvt_pk_bf16(C0[6], C0[7]); asm volatile("" : "+v"(sa_), "+v"(sb_), "+v"(PW[0])); F3_SB(); \
        N0 = __builtin_amdgcn_mfma_f32_32x32x16_bf16(fq2, qr[1], N0, 0, 0, 0); fq1 = *(const LAS bf16x8*)(kq_ + 4608); sa_ += C1[4]; sb_ += C1[5]; PW[1][0] = cvt_pk_bf16(C0[8], C0[9]); PW[1][1] = cvt_pk_bf16(C0[10], C0[11]); asm volatile("" : "+v"(sa_), "+v"(sb_), "+v"(PW[1])); F3_SB(); \
        N1 = __builtin_amdgcn_mfma_f32_32x32x16_bf16(fq3, qr[1], N1, 0, 0, 0); fq2 = *(const LAS bf16x8*)(kq_ + 6144); sa_ += C1[6]; sb_ += C1[7]; PW[1][2] = cvt_pk_bf16(C0[12], C0[13]); PW[1][3] = cvt_pk_bf16(C0[14], C0[15]); asm volatile("" : "+v"(sa_), "+v"(sb_), "+v"(PW[1])); F3_SB(); \
        N0 = __builtin_amdgcn_mfma_f32_32x32x16_bf16(fq0, qr[2], N0, 0, 0, 0); fq3 = *(const LAS bf16x8*)(kq_ + 6656); sa_ += C1[8]; sb_ += C1[9]; PW[2][0] = cvt_pk_bf16(C1[0], C1[1]); PW[2][1] = cvt_pk_bf16(C1[2], C1[3]); asm volatile("" : "+v"(sa_), "+v"(sb_), "+v"(PW[2])); F3_SB(); \
        N1 = __builtin_amdgcn_mfma_f32_32x32x16_bf16(fq1, qr[2], N1, 0, 0, 0); sa_ += C1[10]; sb_ += C1[11]; PW[2][2] = cvt_pk_bf16(C1[4], C1[5]); PW[2][3] = cvt_pk_bf16(C1[6], C1[7]); asm volatile("" : "+v"(sa_), "+v"(sb_), "+v"(PW[2])); F3_SB(); \
        N0 = __builtin_amdgcn_mfma_f32_32x32x16_bf16(fq2, qr[3], N0, 0, 0, 0); sa_ += C1[12]; sb_ += C1[13]; PW[3][0] = cvt_pk_bf16(C1[8], C1[9]); PW[3][1] = cvt_pk_bf16(C1[10], C1[11]); asm volatile("" : "+v"(sa_), "+v"(sb_), "+v"(PW[3])); F3_SB(); \
        N1 = __builtin_amdgcn_mfma_f32_32x32x16_bf16(fq3, qr[3], N1, 0, 0, 0); sa_ += C1[14]; sb_ += C1[15]; PW[3][2] = cvt_pk_bf16(C1[12], C1[13]); PW[3][3] = cvt_pk_bf16(C1[14], C1[15]); asm volatile("" : "+v"(sa_), "+v"(sb_), "+v"(PW[3])); F3_SB(); \
        lsum += sa_ + sb_; F3_TSE(N0, N1); } while (0)
#define F3_HANDB(i, C0, C1, N0, N1, PP, PW) do { \
        const lds_cptr vt_ = vp0 + (((i) - 1) & 3) * 16384; const lds_cptr kq_ = kp0 + (((i) + 1) % NK3) * 16384; \
        const LAS float* bb_ = btab + (64 * (cw - (t0 + (i))) + 32 * (wq & 1) + r32 + 63 - 4 * hi - 59);     \
        bf16x8 fq0, fq1, fq2, fq3; float sa_ = 0.f, sb_ = 0.f, b0_, b1_, b2_, b3_; \
        fq0 = cat8(vtr(vt_ + 0), vtr(vt_ + 512)); fq1 = cat8(vtr(vt_ + 1024), vtr(vt_ + 1536)); fq2 = cat8(vtr(vt_ + 2048), vtr(vt_ + 2560)); b0_ = bb_[59]; b1_ = bb_[58]; b2_ = bb_[57]; b3_ = bb_[56]; F3_SB(); \
        if ((i) + 3 < NT) { asm volatile("s_waitcnt vmcnt(6) lgkmcnt(0)\n\ts_barrier" ::: "memory"); } else FA_WAIT_BAR(0); \
        F3_SB(); \
        o[0] = __builtin_amdgcn_mfma_f32_32x32x16_bf16(__builtin_bit_cast(bf16x8, PP[0]), fq0, o[0], 0, 0, 0); fq3 = cat8(vtr(vt_ + 3072), vtr(vt_ + 3584)); F3_DMAK1((i) + 3, 0); C0[0] = fast_exp2(C0[0] + b0_); C0[1] = fast_exp2(C0[1] + b1_); b0_ = bb_[51]; b1_ = bb_[50]; asm volatile("" : "+v"(C0)); F3_SB(); \
        o[0] = __builtin_amdgcn_mfma_f32_32x32x16_bf16(__builtin_bit_cast(bf16x8, PP[1]), fq1, o[0], 0, 0, 0); fq0 = cat8(vtr(vt_ + 4096), vtr(vt_ + 4608)); F3_DMAK1((i) + 3, 1); C0[2] = fast_exp2(C0[2] + b2_); C0[3] = fast_exp2(C0[3] + b3_); b2_ = bb_[49]; b3_ = bb_[48]; asm volatile("" : "+v"(C0)); F3_SB(); \
        o[0] = __builtin_amdgcn_mfma_f32_32x32x16_bf16(__builtin_bit_cast(bf16x8, PP[2]), fq2, o[0], 0, 0, 0); fq1 = cat8(vtr(vt_ + 5120), vtr(vt_ + 5632)); F3_DMAV1((i) + 2, 0); C0[4] = fast_exp2(C0[4] + b0_); C0[5] = fast_exp2(C0[5] + b1_); b0_ = bb_[43]; b1_ = bb_[42]; asm volatile("" : "+v"(C0)); F3_SB(); \
        o[0] = __builtin_amdgcn_mfma_f32_32x32x16_bf16(__builtin_bit_cast(bf16x8, PP[3]), fq3, o[0], 0, 0, 0); fq2 = cat8(vtr(vt_ + 6144), vtr(vt_ + 6656)); F3_DMAV1((i) + 2, 1); C0[6] = fast_exp2(C0[6] + b2_); C0[7] = fast_exp2(C0[7] + b3_); b2_ = bb_[41]; b3_ = bb_[40]; asm volatile("" : "+v"(C0)); F3_SB(); \
        o[1] = __builtin_amdgcn_mfma_f32_32x32x16_bf16(__builtin_bit_cast(bf16x8, PP[0]), fq0, o[1], 0, 0, 0); fq3 = cat8(vtr(vt_ + 7168), vtr(vt_ + 7680)); C0[8] = fast_exp2(C0[8] + b0_); C0[9] = fast_exp2(C0[9] + b1_); b0_ = bb_[35]; b1_ = bb_[34]; sa_ += C0[0]; sb_ += C0[1]; asm volatile("" : "+v"(C0), "+v"(sa_), "+v"(sb_)); F3_SB(); \
        o[1] = __builtin_amdgcn_mfma_f32_32x32x16_bf16(__builtin_bit_cast(bf16x8, PP[1]), fq1, o[1], 0, 0, 0); fq0 = *(const LAS bf16x8*)(kq_ + 0); C0[10] = fast_exp2(C0[10] + b2_); C0[11] = fast_exp2(C0[11] + b3_); b2_ = bb_[33]; b3_ = bb_[32]; sa_ += C0[2]; sb_ += C0[3]; sa_ += C0[4]; asm volatile("" : "+v"(C0), "+v"(sa_), "+v"(sb_)); F3_SB(); \
        o[1] = __builtin_amdgcn_mfma_f32_32x32x16_bf16(__builtin_bit_cast(bf16x8, PP[2]), fq2, o[1], 0, 0, 0); fq1 = *(const LAS bf16x8*)(kq_ + 512); C0[12] = fast_exp2(C0[12] + b0_); C0[13] = fast_exp2(C0[13] + b1_); b0_ = bb_[27]; b1_ = bb_[26]; sb_ += C0[5]; sa_ += C0[6]; sb_ += C0[7]; asm volatile("" : "+v"(C0), "+v"(sa_), "+v"(sb_)); F3_SB(); \
        o[1] = __builtin_amdgcn_mfma_f32_32x32x16_bf16(__builtin_bit_cast(bf16x8, PP[3]), fq3, o[1], 0, 0, 0); fq2 = *(const LAS bf16x8*)(kq_ + 2048); C0[14] = fast_exp2(C0[14] + b2_); C0[15] = fast_exp2(C0[15] + b3_); b2_ = bb_[25]; b3_ = bb_[24]; sa_ += C0[8]; sb_ += C0[9]; asm volatile("" : "+v"(C0), "+v"(sa_), "+v"(sb_)); F3_SB(); \
        N0 = __builtin_amdgcn_mfma_f32_32x32x16_bf16(fq0, qr[0], (f32x16){0.f,0.f,0.f,0.f,0.f,0.f,0.f,0.f,0.f,0.f,0.f,0.f,0.f,0.f,0.f,0.f}, 0, 0, 0); fq3 = *(const LAS bf16x8*)(kq_ + 2560); C1[0] = fast_exp2(C1[0] + b0_); C1[1] = fast_exp2(C1[1] + b1_); b0_ = bb_[19]; b1_ = bb_[18]; sa_ += C0[10]; sb_ += C0[11]; sa_ += C0[12]; PW[0][0] = cvt_pk_bf16(C0[0], C0[1]); PW[0][1] = cvt_pk_bf16(C0[2], C0[3]); asm volatile("" : "+v"(C1), "+v"(sa_), "+v"(sb_), "+v"(PW[0])); F3_SB(); \
        N1 = __builtin_amdgcn_mfma_f32_32x32x16_bf16(fq1, qr[0], (f32x16){0.f,0.f,0.f,0.f,0.f,0.f,0.f,0.f,0.f,0.f,0.f,0.f,0.f,0.f,0.f,0.f}, 0, 0, 0); fq0 = *(const LAS bf16x8*)(kq_ + 4096); C1[2] = fast_exp2(C1[2] + b2_); C1[3] = fast_exp2(C1[3] + b3_); b2_ = bb_[17]; b3_ = bb_[16]; sb_ += C0[13]; sa_ += C0[14]; sb_ += C0[15]; PW[0][2] = cvt_pk_bf16(C0[4], C0[5]); PW[0][3] = cvt_pk_bf16(C0[6], C0[7]); asm volatile("" : "+v"(C1), "+v"(sa_), "+v"(sb_), "+v"(PW[0])); F3_SB(); \
        N0 = __builtin_amdgcn_mfma_f32_32x32x16_bf16(fq2, qr[1], N0, 0, 0, 0); fq1 = *(const LAS bf16x8*)(kq_ + 4608); C1[4] = fast_exp2(C1[4] + b0_); C1[5] = fast_exp2(C1[5] + b1_); b0_ = bb_[11]; b1_ = bb_[10]; sa_ += C1[0]; sb_ += C1[1]; PW[1][0] = cvt_pk_bf16(C0[8], C0[9]); PW[1][1] = cvt_pk_bf16(C0[10], C0[11]); asm volatile("" : "+v"(C1), "+v"(sa_), "+v"(sb_), "+v"(PW[1])); F3_SB(); \
        N1 = __builtin_amdgcn_mfma_f32_32x32x16_bf16(fq3, qr[1], N1, 0, 0, 0); fq2 = *(const LAS bf16x8*)(kq_ + 6144); C1[6] = fast_exp2(C1[6] + b2_); C1[7] = fast_exp2(C1[7] + b3_); b2_ = bb_[9]; b3_ = bb_[8]; sa_ += C1[2]; sb_ += C1[3]; sa_ += C1[4]; PW[1][2] = cvt_pk_bf16(C0[12], C0[13]); PW[1][3] = cvt_pk_bf16(C0[14], C0[15]); asm volatile("" : "+v"(C1), "+v"(sa_), "+v"(sb_), "+v"(PW[1])); F3_SB(); \
        N0 = __builtin_amdgcn_mfma_f32_32x32x16_bf16(fq0, qr[2], N0, 0, 0, 0); fq3 = *(const LAS bf16x8*)(kq_ + 6656); C1[8] = fast_exp2(C1[8] + b0_); C1[9] = fast_exp2(C1[9] + b1_); b0_ = bb_[3]; b1_ = bb_[2]; sb_ += C1[5]; sa_ += C1[6]; sb_ += C1[7]; PW[2][0] = cvt_pk_bf16(C1[0], C1[1]); PW[2][1] = cvt_pk_bf16(C1[2], C1[3]); asm volatile("" : "+v"(C1), "+v"(sa_), "+v"(sb_), "+v"(PW[2])); F3_SB(); \
        N1 = __builtin_amdgcn_mfma_f32_32x32x16_bf16(fq1, qr[2], N1, 0, 0, 0); C1[10] = fast_exp2(C1[10] + b2_); C1[11] = fast_exp2(C1[11] + b3_); b2_ = bb_[1]; b3_ = bb_[0]; sa_ += C1[8]; sb_ += C1[9]; PW[2][2] = cvt_pk_bf16(C1[4], C1[5]); PW[2][3] = cvt_pk_bf16(C1[6], C1[7]); asm volatile("" : "+v"(C1), "+v"(sa_), "+v"(sb_), "+v"(PW[2])); F3_SB(); \
        N0 = __builtin_amdgcn_mfma_f32_32x32x16_bf16(fq2, qr[3], N0, 0, 0, 0); C1[12] = fast_exp2(C1[12] + b0_); C1[13] = fast_exp2(C1[13] + b1_); sa_ += C1[10]; sb_ += C1[11]; sa_ += C1[12]; PW[3][0] = cvt_pk_bf16(C1[8], C1[9]); PW[3][1] = cvt_pk_bf16(C1[10], C1[11]); asm volatile("" : "+v"(C1), "+v"(sa_), "+v"(sb_), "+v"(PW[3])); F3_SB(); \
        N1 = __builtin_amdgcn_mfma_f32_32x32x16_bf16(fq3, qr[3], N1, 0, 0, 0); C1[14] = fast_exp2(C1[14] + b2_); C1[15] = fast_exp2(C1[15] + b3_); sb_ += C1[13]; sa_ += C1[14]; sb_ += C1[15]; PW[3][2] = cvt_pk_bf16(C1[12], C1[13]); PW[3][3] = cvt_pk_bf16(C1[14], C1[15]); asm volatile("" : "+v"(C1), "+v"(sa_), "+v"(sb_), "+v"(PW[3])); F3_SB(); \
        lsum += sa_ + sb_; } while (0)
#define F3_SLOW(i, C0, C1, N0, N1, PP, PW) do { F3_HEAD(i); \
        const bool vc = ((i) >= iv0) && ((i) <= iv1), vp = ((i) - 1 >= iv0) && ((i) - 1 <= iv1), vn = ((i) + 1 >= iv0) && ((i) + 1 <= iv1) && ((i) + 1 < NT); \
        if (vp) F3_PV((i) - 1, PP); \
        F3_SB(); \
        if (vn) { F3_QK((i) + 1, N0, N1); } \
        F3_SB(); \
        if (vc) { F3_BIAS((i), C0, C1); F3_SM(C0, C1, PW); } else { upd = false; }     \
        F3_SB(); F3_RESC(); } while (0)
    bool upd = false; float fsc = 1.f;
    asm volatile("s_waitcnt vmcnt(8) lgkmcnt(0)\n\ts_barrier" ::: "memory");
    if (iv0 == 0) { F3_QK(0, cA0, cA1); }
    F3_SB();
    if (MODE == 0) {
        F3_SLOW(0, cA0, cA1, cB0, cB1, pB, pA);
        if (NOMAX && FA_HAND) {
#pragma unroll 1
            for (int i = 1; i + 3 < NT; i += 2) { F3_HAND(i, cB0, cB1, cA0, cA1, pA, pB); F3_HAND(i + 1, cA0, cA1, cB0, cB1, pB, pA); }
            if (NT >= 4) { F3_HAND(NT - 3, cB0, cB1, cA0, cA1, pA, pB); }
        } else {
#pragma unroll 1
            for (int i = 1; i + 3 < NT; i += 2) { F3_SLOW(i, cB0, cB1, cA0, cA1, pA, pB); F3_SLOW(i + 1, cA0, cA1, cB0, cB1, pB, pA); }
            if (NT >= 4) { F3_SLOW(NT - 3, cB0, cB1, cA0, cA1, pA, pB); }
        }
        if (NT >= 4) { F3_SLOW(NT - 2, cA0, cA1, cB0, cB1, pB, pA); }
        F3_SLOW(NT - 1, cB0, cB1, cA0, cA1, pA, pB);
    } else {
        F3_SLOW(0, cA0, cA1, cB0, cB1, pB, pA); F3_SLOW(1, cB0, cB1, cA0, cA1, pA, pB);
        if (NOMAX && FA_HANDB) {
#pragma unroll 1
            for (int i = 2; i + 3 < NT; i += 2) { F3_HANDB(i, cA0, cA1, cB0, cB1, pB, pA); F3_HANDB(i + 1, cB0, cB1, cA0, cA1, pA, pB); }
        } else {
#pragma unroll 1
            for (int i = 2; i + 3 < NT; i += 2) { F3_SLOW(i, cA0, cA1, cB0, cB1, pB, pA); F3_SLOW(i + 1, cB0, cB1, cA0, cA1, pA, pB); }
        }
        if (NT >= 4) { F3_SLOW(NT - 2, cA0, cA1, cB0, cB1, pB, pA); F3_SLOW(NT - 1, cB0, cB1, cA0, cA1, pA, pB); }
    }
#if PROBE_T
    if (MODE == 0 && blockIdx.x == 0 && (wid & 3) == 0 && u >= 32 && lane == 0 && tqn) { unsigned long long* pv = (unsigned long long*)((char*)Yg - WS_AQ + WS_PROBE) + (ch ? 8 : 0); pv[0] = tq0 / tqn; pv[1] = tq1 / tqn; pv[2] = tqn; }
#endif
    if (NT - 1 <= iv1) F3_PV(NT - 1, pB);
#undef F3_TS
#undef F3_TSE
#undef F3_HEAD
#undef F3_SLOW
#undef F3_HAND
#undef F3_HANDB
#undef F3_DMAK
#undef F3_DMAV
#undef F3_DMAK1
#undef F3_DMAV1
#undef F3_SB
#undef F3_MX3
#undef F3_QK
#undef F3_BIAS
#undef F3_PV
#undef F3_SM
#undef F3_RESC
    lsum = swapsum(lsum);
    if (hi == 0) wsf[32 + r32] = lsum;
    LDS_WAIT();
#pragma unroll
    for (int r = 0; r < 16; ++r) { const float il = fast_rcp(wsf[32 + crow(r, hi)]);
#pragma unroll
        for (int d = 0; d < NDB; ++d) o[d][r] *= il; }
    FA_BAR();
    if (MODE == 0) {
        LAS float* xf = (LAS float*)lds + (wid & 3) * 4096;
        if (ch == 1) {
#pragma unroll
            for (int d = 0; d < 4; ++d)
#pragma unroll
                for (int r = 0; r < 16; ++r) xf[(d * 16 + r) * 64 + lane] = o[d][r];
        }
        FA_BAR();
        if (ch == 0) {
            float ss[16];
#pragma unroll
            for (int r = 0; r < 16; ++r) ss[r] = 0.f;
#pragma unroll
            for (int d = 0; d < 4; ++d)
#pragma unroll
                for (int r = 0; r < 16; ++r) { const float y = o[d][r] - lam * xf[(d * 16 + r) * 64 + lane]; o[d][r] = y; ss[r] += y * y; }
            LAS bf16_t* stg = (LAS bf16_t*)(lds + 65536) + wid * 4096;
            float g[4];
#pragma unroll
            for (int d = 0; d < 4; ++d) g[d] = subln[32 * d + r32] * osc;
#pragma unroll
            for (int r = 0; r < 16; ++r) { const float rs = __builtin_amdgcn_rsqf(half_sum32(ss[r]) * (1.0f / 128.0f) + EPS); const int orow = crow(r, hi);
#pragma unroll
                for (int d = 0; d < 4; ++d) stg[orow * 128 + d * 32 + r32] = (bf16_t)f2bf(o[d][r] * rs * g[d]); }
            LDS_WAIT();
#pragma unroll
            for (int i = 0; i < 8; ++i) { const int idx = i * 64 + lane, row = idx >> 4, c8 = idx & 15;
                const u32x4 v = *(const LAS u32x4*)(stg + row * 128 + c8 * 8);
                *(u32x4*)(Yg + (qrow + row) * PITCH + hq * 128 + c8 * 8) = v; }
        }
    } else {
        LAS bf16_t* stg = (LAS bf16_t*)lds + wid * 2048;
#pragma unroll
        for (int r = 0; r < 16; ++r) { const int orow = crow(r, hi);
#pragma unroll
            for (int d = 0; d < 2; ++d) stg[orow * 64 + d * 32 + r32] = (bf16_t)f2bf(o[d][r]); }
        LDS_WAIT();
#pragma unroll
        for (int i = 0; i < 4; ++i) { const int idx = i * 64 + lane, row = idx >> 3, c8 = idx & 7;
            const u32x4 v = *(const LAS u32x4*)(stg + row * 64 + c8 * 8);
            *(u32x4*)(Yg + (qrow + row) * PITCH + hq * 128 + ch * 64 + c8 * 8) = v; }
    }
    FA_BAR();
#if PROBE_T
    if (MODE == 0 && blockIdx.x == 0 && wid == 0 && u >= 32 && lane == 0) { unsigned long long* pv = (unsigned long long*)((char*)Yg - WS_AQ + WS_PROBE); pv[3] = (__builtin_amdgcn_s_memtime() - tu0_) / 10; }
#endif
}

#if FA_V2 == 3
#define FA_UNIT attn_unit2
#elif FA_V2
#define FA_UNIT attn_unit2
#else
#define FA_UNIT attn_unit
#endif
__device__ __forceinline__ void attn_a_phase(LAS unsigned char* lds, const int tid, unsigned char* ws, bf16_t* yout, const int vcu, const int G, const float* lq1, const float* lk1, const float* lq2, const float* lk2,
                                             const float* subln, const float lam_init, const float* gq, const float* gk, const int pm = 0) {
    const int lane = tid & 63;
    const float lamv = expf(wave_sum(lq1[lane] * lk1[lane])) - expf(wave_sum(lq2[lane] * lk2[lane])) + lam_init;
    const float lam = __uint_as_float(__builtin_amdgcn_readfirstlane(__float_as_uint(lamv)));
    const float bound = wave_max(fabsf(gq[lane])) * wave_max(fabsf(gk[lane])) * 64.0f * C2;
    const bool nomax = __uint_as_float(__builtin_amdgcn_readfirstlane(__float_as_uint(bound))) < FA_NOMAX_BOUND_A;
    for (int v = vcu; v < 256; v += G) {
        const int bh = v >> 5, p = v & 31;
#pragma unroll 1
        for (int k = 0; k < 2; ++k) {
#if FA_V2 == 3
            if (nomax) attn_unit3<0, true>(lds, tid, (const bf16_t*)(ws + WS_AQ), (const bf16_t*)(ws + WS_AK), (const bf16_t*)(ws + WS_AV), yout, bh >> 2, bh & 3, k ? 63 - p : p, lam, 1.0f - lam_init, subln, pm);
            else       attn_unit3<0, false>(lds, tid, (const bf16_t*)(ws + WS_AQ), (const bf16_t*)(ws + WS_AK), (const bf16_t*)(ws + WS_AV), yout, bh >> 2, bh & 3, k ? 63 - p : p, lam, 1.0f - lam_init, subln, pm);
#else
            FA_UNIT<0>(lds, tid, (const bf16_t*)(ws + WS_AQ), (const bf16_t*)(ws + WS_AK), (const bf16_t*)(ws + WS_AV), yout, bh >> 2, bh & 3, k ? 63 - p : p, lam, 1.0f - lam_init, subln, pm);
#endif
        }
    }
}
__device__ __forceinline__ void attn_b_phase(LAS unsigned char* lds, const int tid, unsigned char* ws, bf16_t* yout, const int vcu, const int G, const float* relb, const float* gq, const float* gk) {
    for (int v = vcu; v < 256; v += G) {
        const int bp = v >> 5, b = bp >> 2, hp = bp & 3;
        LAS float* bt = (LAS float*)(lds + (FA_V2 ? LDS_BIAS2 : LDS_BIAS));
        for (int i = tid; i < 1280; i += 512) { const int c = i / 640, j = i - c * 640; bt[i] = relb[(2 * hp + c) * 320 + (j < 320 ? j : 319)] * LOG2E; }
        FA_BAR();
        float bm = 0.f;
        for (int i = tid & 63; i < 1280; i += 64) bm = fmaxf(bm, fabsf(bt[i]));
        const float bound = wave_max(fabsf(gq[tid & 63])) * wave_max(fabsf(gk[tid & 63])) * 64.0f * C2 + wave_max(bm);
        const bool nomax = __uint_as_float(__builtin_amdgcn_readfirstlane(__float_as_uint(bound))) < FA_NOMAX_BOUND_B;
#pragma unroll 1
        for (int k = 0; k < 2; ++k) {
#if FA_V2 == 3
            if (nomax) attn_unit3<1, true>(lds, tid, (const bf16_t*)(ws + WS_BQ), (const bf16_t*)(ws + WS_BK), (const bf16_t*)(ws + WS_BV), yout, b, hp, 2 * (v & 31) + k, 0.f, 0.f, nullptr);
            else       attn_unit3<1, false>(lds, tid, (const bf16_t*)(ws + WS_BQ), (const bf16_t*)(ws + WS_BK), (const bf16_t*)(ws + WS_BV), yout, b, hp, 2 * (v & 31) + k, 0.f, 0.f, nullptr);
#else
            FA_UNIT<1>(lds, tid, (const bf16_t*)(ws + WS_BQ), (const bf16_t*)(ws + WS_BK), (const bf16_t*)(ws + WS_BV), yout, b, hp, 2 * (v & 31) + k, 0.f, 0.f, nullptr);
#endif
        }
    }
}

__device__ __forceinline__ void ret_kv_phase(LAS unsigned char* lds, const int tid_, unsigned char* ws, const int gw, const int ngw) {
    int tid = tid_; asm volatile("" : "+v"(tid));
    const int lane = tid & 63, r32 = lane & 31, hi = lane >> 5, wid = __builtin_amdgcn_readfirstlane(tid >> 6);
    const bf16_t* CK = (const bf16_t*)(ws + WS_CK); const bf16_t* CV = (const bf16_t*)(ws + WS_CV); float* KVT = (float*)(ws + WS_R4);
    LAS unsigned char* wl = lds + wid * 16384; const unsigned wl0 = (unsigned)(uintptr_t)wl;
    const lds_cptr tp0 = (lds_cptr)wl + ((lane >> 4) & 1) * 32 + (lane & 3) * 8 + (4 * hi + ((lane & 15) >> 2)) * 64;
    for (int task = gw; task < 2048; task += ngw) {
        const int eh = task & 1, n = (task >> 1) & 127, bh = task >> 8, b = bh >> 2, h = bh & 3;
        const size_t row0 = (size_t)b * SEQ + n * 64;
#pragma unroll
        for (int p = 0; p < 8; ++p) {
            glds16(CK + (row0 + 16 * (p & 3) + (lane >> 2)) * 256 + h * 64 + 32 * (p >> 2) + (lane & 3) * 8, (unsigned)__builtin_amdgcn_readfirstlane(wl0 + p * 1024));
            glds16(CV + (row0 + 16 * (p & 3) + (lane >> 2)) * 512 + h * 128 + eh * 64 + 32 * (p >> 2) + (lane & 3) * 8, (unsigned)__builtin_amdgcn_readfirstlane(wl0 + 8192 + p * 1024));
        }
        asm volatile("s_waitcnt vmcnt(0)" ::: "memory");
#pragma unroll
        for (int eb = 0; eb < 2; ++eb)
#pragma unroll
            for (int db = 0; db < 2; ++db) {
                f32x16 acc;
#pragma unroll
                for (int r = 0; r < 16; ++r) acc[r] = 0.f;
#pragma unroll
                for (int s = 0; s < 4; ++s) {
                    const lds_cptr va = tp0 + 8192 + (eb * 4 + s) * 1024, ka = tp0 + (db * 4 + s) * 1024;
                    acc = __builtin_amdgcn_mfma_f32_32x32x16_bf16(cat8(vtr(va), vtr(va + 512)), cat8(vtr(ka), vtr(ka + 512)), acc, 0, 0, 0);
                }
                float* dst = KVT + ((size_t)(bh * 128 + n) * 128 + eh * 64 + eb * 32) * 64 + db * 32 + r32;
#pragma unroll
                for (int r = 0; r < 16; ++r) dst[(size_t)crow(r, hi) * 64] = acc[r];
            }
        LDS_WAIT(); asm volatile("" ::: "memory");
    }
}
__device__ __forceinline__ void ret_scan_phase(const int tid, unsigned char* ws, const int vcu, const int G) {
    float* KVT = (float*)(ws + WS_R4);
    for (int gt = vcu * 512 + tid; gt < 65536; gt += G * 512) {
        const int bh = gt >> 13, idx = gt & 8191, h = bh & 3;
        const float l2g = log2_gamma(h), gam = fast_exp2(l2g), g63 = fast_exp2(63.f * l2g), g64 = fast_exp2(64.f * l2g);
        float* p = KVT + (size_t)bh * 128 * 8192 + idx; float s = 0.f;
        for (int n0 = 0; n0 < 128; n0 += 32) {
            float kv[32];
#pragma unroll
            for (int j = 0; j < 32; ++j) kv[j] = p[(size_t)(n0 + j) * 8192];
#pragma unroll
            for (int j = 0; j < 32; ++j) { p[(size_t)(n0 + j) * 8192] = gam * s; s = g64 * s + g63 * kv[j]; }
        }
    }
}
__device__ __forceinline__ void ret_out_phase(LAS unsigned char* lds, const int tid_, unsigned char* ws, const int gw, const int ngw, const float* onorm) {
    int tid = tid_; asm volatile("" : "+v"(tid));
    const int lane = tid & 63, r32 = lane & 31, hi = lane >> 5, wid = __builtin_amdgcn_readfirstlane(tid >> 6);
    const bf16_t* CQ = (const bf16_t*)(ws + WS_CQ); const bf16_t* CK = (const bf16_t*)(ws + WS_CK); const bf16_t* CV = (const bf16_t*)(ws + WS_CV); bf16_t* CG = (bf16_t*)(ws + WS_CG);
    const float* KVT = (const float*)(ws + WS_R4);
    LAS unsigned char* wl = lds + wid * 16384; const unsigned wl0 = (unsigned)(uintptr_t)wl;
    const lds_cptr tp0 = (lds_cptr)wl + ((lane >> 4) & 1) * 32 + (lane & 3) * 8 + (4 * hi + ((lane & 15) >> 2)) * 64;
    for (int task = gw; task < 2048; task += ngw) {
        const int rh = task & 1, n = (task >> 1) & 127, bh = task >> 8, b = bh >> 2, h = bh & 3;
        const size_t row0 = (size_t)b * SEQ + n * 64;
        const float l2g = log2_gamma(h);
#pragma unroll
        for (int p = 0; p < 16; ++p)
            glds16(CV + (row0 + 16 * (p & 3) + (lane >> 2)) * 512 + h * 128 + 32 * (p >> 2) + (lane & 3) * 8, (unsigned)__builtin_amdgcn_readfirstlane(wl0 + p * 1024));
        bf16x8 qr[4], kf[8];
#pragma unroll
        for (int i = 0; i < 4; ++i) {
            qr[i] = *(const bf16x8*)(CQ + (row0 + 32 * rh + r32) * 256 + h * 64 + i * 16 + hi * 8);
            kf[2 * i] = *(const bf16x8*)(CK + (row0 + r32) * 256 + h * 64 + i * 16 + hi * 8);
            kf[2 * i + 1] = *(const bf16x8*)(CK + (row0 + 32 + r32) * 256 + h * 64 + i * 16 + hi * 8);
        }
        f32x16 p0, p1;
#pragma unroll
        for (int r = 0; r < 16; ++r) { p0[r] = 0.f; p1[r] = 0.f; }
#pragma unroll
        for (int i = 0; i < 4; ++i) { p0 = __builtin_amdgcn_mfma_f32_32x32x16_bf16(kf[2 * i], qr[i], p0, 0, 0, 0); p1 = __builtin_amdgcn_mfma_f32_32x32x16_bf16(kf[2 * i + 1], qr[i], p1, 0, 0, 0); }
        const int qi = 32 * rh + r32;
#pragma unroll
        for (int r = 0; r < 16; ++r) { const int key = crow(r, hi); if (key > qi) p0[r] = 0.f; if (key + 32 > qi) p1[r] = 0.f; }
        const bf16x8 pa0 = pack_p(p0, 0), pa1 = pack_p(p0, 8), pa2 = pack_p(p1, 0), pa3 = pack_p(p1, 8);
        asm volatile("s_waitcnt vmcnt(0)" ::: "memory");
        const float* st = KVT + (size_t)(bh * 128 + n) * 8192;
        f32x16 o[4];
#pragma unroll
        for (int d = 0; d < 4; ++d) {
            const lds_cptr vd = tp0 + d * 4096;
            f32x16 a;
#pragma unroll
            for (int r = 0; r < 16; ++r) a[r] = 0.f;
            a = __builtin_amdgcn_mfma_f32_32x32x16_bf16(pa0, cat8(vtr(vd), vtr(vd + 512)), a, 0, 0, 0);
            a = __builtin_amdgcn_mfma_f32_32x32x16_bf16(pa1, cat8(vtr(vd + 1024), vtr(vd + 1024 + 512)), a, 0, 0, 0);
            a = __builtin_amdgcn_mfma_f32_32x32x16_bf16(pa2, cat8(vtr(vd + 2048), vtr(vd + 2048 + 512)), a, 0, 0, 0);
            a = __builtin_amdgcn_mfma_f32_32x32x16_bf16(pa3, cat8(vtr(vd + 3072), vtr(vd + 3072 + 512)), a, 0, 0, 0);
#pragma unroll
            for (int i = 0; i < 4; ++i) {
                const f32x4 s0 = *(const f32x4*)(st + (size_t)(32 * d + r32) * 64 + i * 16 + hi * 8), s1 = *(const f32x4*)(st + (size_t)(32 * d + r32) * 64 + i * 16 + hi * 8 + 4);
                a = __builtin_amdgcn_mfma_f32_32x32x16_bf16(qr[i], __builtin_bit_cast(bf16x8, epi::pack8(s0, s1)), a, 0, 0, 0);
            }
            o[d] = a;
        }
        LDS_WAIT(); asm volatile("" ::: "memory");
        LAS float* stg = (LAS float*)wl;
        float gn[4];
#pragma unroll
        for (int d = 0; d < 4; ++d) gn[d] = onorm[h * 128 + 32 * d + r32];
#pragma unroll
        for (int r = 0; r < 16; ++r) {
            const float dec = fast_exp2((float)(32 * rh + crow(r, hi)) * l2g);
            float ss = 0.f;
#pragma unroll
            for (int d = 0; d < 4; ++d) { o[d][r] *= dec; ss += o[d][r] * o[d][r]; }
            const float rs = __builtin_amdgcn_rsqf(half_sum32(ss) * (1.0f / 128.0f) + EPS);
#pragma unroll
            for (int d = 0; d < 4; ++d) stg[crow(r, hi) * 128 + d * 32 + r32] = o[d][r] * rs * gn[d];
        }
        LDS_WAIT(); asm volatile("" ::: "memory");
#pragma unroll
        for (int i = 0; i < 8; ++i) { const int idx = i * 64 + lane, row = idx >> 4, c8 = idx & 15;
            const f32x4 y0 = *(const LAS f32x4*)(stg + row * 128 + c8 * 8), y1 = *(const LAS f32x4*)(stg + row * 128 + c8 * 8 + 4);
            bf16_t* gp = CG + (row0 + 32 * rh + row) * 512 + h * 128 + c8 * 8;
            const u32x4 gv = *(const u32x4*)gp;
            const f32x4 g0 = {bflo(gv.x), bfhi(gv.x), bflo(gv.y), bfhi(gv.y)}, g1 = {bflo(gv.z), bfhi(gv.z), bflo(gv.w), bfhi(gv.w)};
            *(u32x4*)gp = epi::pack8(y0 * g0, y1 * g1); }
        LDS_WAIT(); asm volatile("" ::: "memory");
    }
}
}
#define XB_TMO      128
#define XB_XCNT(j)  (256  + 64 * (j))
#define XB_XSUB(j)  (1280 + 64 * (j))
#define XB_XGEN(j)  (2304 + 64 * (j))
#define XB_TOP      3328
#define XB_TOPGEN   3392
#define XCD_BAR_WORDS 3456
#define XB_SPIN_CAP (1u << 18)

__device__ __forceinline__ unsigned xb_ld(unsigned* p)              { return __hip_atomic_load(p, __ATOMIC_RELAXED, __HIP_MEMORY_SCOPE_AGENT); }
__device__ __forceinline__ unsigned xb_add(unsigned* p, unsigned v) { return __hip_atomic_fetch_add(p, v, __ATOMIC_RELAXED, __HIP_MEMORY_SCOPE_AGENT); }
__device__ __forceinline__ unsigned xb_xcc_id() { return (unsigned)__builtin_amdgcn_s_getreg((3 << 11) | 20) & 0xFu; }
#define XB_SPIN(cond, bar) do { unsigned _sp = 0; while (cond) { __builtin_amdgcn_s_sleep(1); \
    if ((++_sp & 255u) == 0u) { if (xb_ld(&(bar)[XB_TMO])) break; if (_sp > XB_SPIN_CAP) { atomicAdd(&(bar)[XB_TMO], 1u); break; } } } } while (0)

struct XcdBarrier {
    unsigned* bar; unsigned x;
    volatile LAS unsigned* st;
};

__device__ __forceinline__ XcdBarrier xcd_barrier_post(unsigned* bar, volatile LAS unsigned* st) {
    XcdBarrier b; b.bar = bar; b.x = xb_xcc_id(); b.st = st;
    if (threadIdx.x == 0) (void)xb_add(&bar[XB_XCNT(b.x)], 1u);
    return b;
}
__device__ __forceinline__ void xcd_barrier_complete(unsigned* bar, unsigned x, unsigned& nloc, unsigned& nx) {
    const unsigned G = gridDim.x * gridDim.y * gridDim.z;
    unsigned sum, cnt, mine, sp = 0u;
    for (;;) {
        sum = 0u; cnt = 0u; mine = 0u;
#pragma unroll
        for (unsigned j = 0; j < 16; ++j) { const unsigned c = xb_ld(&bar[XB_XCNT(j)]); sum += c; cnt += (c > 0u) ? 1u : 0u; mine = (j == x) ? c : mine; }
        if (sum == G) break;
        __builtin_amdgcn_s_sleep(1);
        if ((++sp & 255u) == 0u) { if (xb_ld(&bar[XB_TMO])) break; if (sp > XB_SPIN_CAP) { atomicAdd(&bar[XB_TMO], 1u); break; } }
    }
    nloc = mine > 0u ? mine : 1u; nx = cnt > 0u ? cnt : 1u;
}

__device__ __forceinline__ void xcd_barrier(const XcdBarrier& b) {
    asm volatile("s_waitcnt vmcnt(0)" ::: "memory");
    __syncthreads();
    if (threadIdx.x == 0) {
        unsigned* bar = b.bar;
        __builtin_amdgcn_s_waitcnt(0);
        unsigned nloc = b.st[0], nx = b.st[1];
        if (nloc == 0u) { xcd_barrier_complete(bar, b.x, nloc, nx); b.st[0] = nloc; b.st[1] = nx; }
        const unsigned old = xb_add(&bar[XB_XSUB(b.x)], 1u);
        const unsigned gen = old / nloc;
        if (old + 1u == (gen + 1u) * nloc) {
            __builtin_amdgcn_fence(__ATOMIC_RELEASE, "agent");
            asm volatile("s_waitcnt vmcnt(0)" ::: "memory");
            const unsigned og = xb_add(&bar[XB_TOP], 1u);
            const unsigned tg = og / nx;
            if (og + 1u == (tg + 1u) * nx) xb_add(&bar[XB_TOPGEN], 1u);
            else XB_SPIN(xb_ld(&bar[XB_TOPGEN]) == tg, bar);
            __builtin_amdgcn_fence(__ATOMIC_ACQUIRE, "agent");
            xb_add(&bar[XB_XGEN(b.x)], 1u);
            asm volatile("s_waitcnt vmcnt(0)" ::: "memory");
        } else {
            XB_SPIN(xb_ld(&bar[XB_XGEN(b.x)]) == gen, bar);
            __builtin_amdgcn_fence(__ATOMIC_ACQUIRE, "agent");
            asm volatile("s_waitcnt vmcnt(0)" ::: "memory");
        }
    }
    __syncthreads();
}

constexpr int NWAVES = 8;
constexpr int RING_OFF = 0, RING_BYTES = 131072;
constexpr int LDSCTL_OFF = RING_BYTES, MISC_OFF = LDSCTL_OFF + 320;
constexpr int LDS_BYTES = 147456;
constexpr int CW_TMO = 0, CW_CODE = 1, CW_BAR = 4096;
constexpr int PH_PER_LAYER = 12 - (HIDE_CONV ? 1 : 0) - (FUSE_RET ? 2 : 0) - (FUSE_GM ? 1 : 0);
constexpr int N_PHASES = 1 + PH_PER_LAYER * DEPTH;

#define CAS __attribute__((address_space(4)))
struct Args { const GAS float* in[N_IN]; GAS float* out; GAS unsigned char* ws; double ropec[32]; float lam_init[2]; };

template <class T> __device__ __forceinline__ T* as_global(GAS T* p) { return (T*)p; }
__device__ __forceinline__ int conv_dst_row(int mode, int row_off, int n0) {
    if (mode == 0) return row_off + n0;
    if (mode == 1) return 256 * (n0 >> 7) + (n0 & 127) + row_off;
    return (n0 < NIN1) ? ((n0 & ~255) + 128 * ((n0 >> 5) & 1) + 32 * ((n0 >> 6) & 3)) : n0;
}
__device__ __forceinline__ void conv_item(const float* W, const float* gain, int K, int N, bf16_t* WT, int mode, int row_off, LAS float* scr, int item, int lane) {
    const int nblk = N / 32, kb = item / nblk, nb = item % nblk, k0 = 64 * kb, n0 = 32 * nb;
    float wv[32], gv[32];
#pragma unroll
    for (int i = 0; i < 32; ++i) { const int kk = 2 * i + (lane >> 5); wv[i] = W[(size_t)(k0 + kk) * N + n0 + (lane & 31)]; gv[i] = gain ? gain[k0 + kk] : 1.0f; }
#pragma unroll
    for (int i = 0; i < 32; ++i) { const int kk = 2 * i + (lane >> 5); scr[kk * 33 + (lane & 31)] = wv[i] * gv[i]; }
    LDS_WAIT(); asm volatile("" ::: "memory");
    const int c = lane & 7, drow = conv_dst_row(mode, row_off, n0);
#pragma unroll
    for (int j = 0; j < 4; ++j) { const int n = (lane >> 3) + 8 * j; const LAS float* s = scr + (8 * c) * 33 + n;
        u32x4 o; o.x = pk2(s[0 * 33], s[1 * 33]); o.y = pk2(s[2 * 33], s[3 * 33]); o.z = pk2(s[4 * 33], s[5 * 33]); o.w = pk2(s[6 * 33], s[7 * 33]);
        *(GAS u32x4*)(WT + (size_t)(drow + n) * K + k0 + 8 * c) = o; }
    LDS_WAIT(); asm volatile("" ::: "memory");
}
__device__ __forceinline__ void convert_layer(const CAS Args& a, unsigned char* ws, int l, int part, LAS unsigned char* lds, int gw, int ngw, int wave, int lane) {
    LAS float* scr = (LAS float*)(lds + wave * 16384);
    unsigned char* wb = ws + WS_W;
    constexpr int I_GU = (DM / 64) * (DFF / 32), I_D = (DFF / 64) * (DM / 32), I_IN = (DM / 64) * (NIN / 32), I_BR = (512 / 64) * (DM / 32), I_O = (DM / 64) * (DM / 32);
    constexpr int NITEMS = 4 * I_GU + 2 * I_D + I_IN + 3 * I_BR + I_O;
    const size_t oGU = (size_t)l * DM * DFF, oD = (size_t)l * DFF * DM, oIN = (size_t)l * DM * NIN, oBR = (size_t)l * 512 * DM, oO = (size_t)l * DM * DM;
    constexpr int P1 = 2 * I_GU + I_D, P2 = P1 + I_IN + 3 * I_BR + I_O;
    const int it_lo = (part <= 1) ? 0 : (part == 2 ? P1 : P2), it_hi = (part == 0 || part == 3) ? NITEMS : (part == 1 ? P1 : P2);
    for (int it = it_lo + gw; it < it_hi; it += ngw) {
        int r = it;
        if (r < I_GU) { conv_item(as_global(a.in[I_F1G]) + oGU, as_global(a.in[I_F1N]) + l * DM, DM, DFF, (bf16_t*)(wb + W_GU1), 1, 0, scr, r, lane); continue; } r -= I_GU;
        if (r < I_GU) { conv_item(as_global(a.in[I_F1U]) + oGU, as_global(a.in[I_F1N]) + l * DM, DM, DFF, (bf16_t*)(wb + W_GU1), 1, 128, scr, r, lane); continue; } r -= I_GU;
        if (r < I_D)  { conv_item(as_global(a.in[I_F1D]) + oD, nullptr, DFF, DM, (bf16_t*)(wb + W_D1), 0, 0, scr, r, lane); continue; } r -= I_D;
        if (r < I_IN) { conv_item(as_global(a.in[I_WIN]) + oIN, as_global(a.in[I_MIXN]) + l * DM, DM, NIN, (bf16_t*)(wb + W_IN), 2, 0, scr, r, lane); continue; } r -= I_IN;
        if (r < I_BR) { conv_item(as_global(a.in[I_WBA]) + oBR, nullptr, 512, DM, (bf16_t*)(wb + W_BR), 0, 0, scr, r, lane); continue; } r -= I_BR;
        if (r < I_BR) { conv_item(as_global(a.in[I_WBB]) + oBR, nullptr, 512, DM, (bf16_t*)(wb + W_BR), 0, DM, scr, r, lane); continue; } r -= I_BR;
        if (r < I_BR) { conv_item(as_global(a.in[I_WBC]) + oBR, nullptr, 512, DM, (bf16_t*)(wb + W_BR), 0, 2 * DM, scr, r, lane); continue; } r -= I_BR;
        if (r < I_O)  { conv_item(as_global(a.in[I_WOUT]) + oO, nullptr, DM, DM, (bf16_t*)(wb + W_OUT), 0, 0, scr, r, lane); continue; } r -= I_O;
        if (r < I_GU) { conv_item(as_global(a.in[I_F2G]) + oGU, as_global(a.in[I_F2N]) + l * DM, DM, DFF, (bf16_t*)(wb + W_GU2), 1, 0, scr, r, lane); continue; } r -= I_GU;
        if (r < I_GU) { conv_item(as_global(a.in[I_F2U]) + oGU, as_global(a.in[I_F2N]) + l * DM, DM, DFF, (bf16_t*)(wb + W_GU2), 1, 128, scr, r, lane); continue; } r -= I_GU;
        conv_item(as_global(a.in[I_F2D]) + oD, nullptr, DFF, DM, (bf16_t*)(wb + W_D2), 0, 0, scr, r, lane);
    }
}
__device__ __forceinline__ void rope_tables(const CAS Args& a, unsigned char* ws, int gtid, int ngt) {
    float* cosT = (float*)(ws + WS_COS); float* sinT = (float*)(ws + WS_SIN);
    for (int i = gtid; i < SEQ * 32; i += ngt) { const int t = i >> 5, k = i & 31;
        const double rev = (double)t * a.ropec[k]; const float fr = (float)(rev - floor(rev));
        cosT[i] = __builtin_amdgcn_cosf(fr); sinT[i] = __builtin_amdgcn_sinf(fr); }
}


constexpr int CW_CNT = 32768;
__device__ __forceinline__ void cnt_signal(gu32* ctl, int idx) {
    asm volatile("s_waitcnt vmcnt(0)" ::: "memory");
    __syncthreads();
    if (threadIdx.x == 0) {
        __builtin_amdgcn_fence(__ATOMIC_RELEASE, "agent");
        asm volatile("s_waitcnt vmcnt(0)" ::: "memory");
        (void)__hip_atomic_fetch_add((unsigned*)(ctl + CW_CNT + 64 * idx), 1u, __ATOMIC_RELAXED, __HIP_MEMORY_SCOPE_AGENT);
    }
}
__device__ __forceinline__ void cnt_wait(gu32* ctl, int idx, unsigned want) {
    if (threadIdx.x == 0) {
        unsigned sp = 0;
        while (__hip_atomic_load((unsigned*)(ctl + CW_CNT + 64 * idx), __ATOMIC_RELAXED, __HIP_MEMORY_SCOPE_AGENT) < want) {
            __builtin_amdgcn_s_sleep(2);
            if (++sp > (1u << 22)) { __hip_atomic_store((unsigned*)(ctl + CW_TMO), 1u, __ATOMIC_RELAXED, __HIP_MEMORY_SCOPE_AGENT); break; }
        }
        __builtin_amdgcn_fence(__ATOMIC_ACQUIRE, "agent");
        asm volatile("s_waitcnt vmcnt(0)" ::: "memory");
    }
    __syncthreads();
}
struct Ctx { LAS unsigned char* lds; int tid, lane, wave, vcu, G, bx, gw, ngw; unsigned char* ws; float* X; const CAS Args* ap; };
enum { K_PRO = 0, K_CONV, K_UP, K_DOWN, K_WIN, K_KV, K_SCAN, K_MIX, K_GATE, K_MERGE, K_WOUT, N_KINDS };
__host__ __device__ __forceinline__ void phase_decode(int ph, int& kind, int& l, int& ffn2) {
    if (ph == 0) { kind = K_PRO; l = 0; ffn2 = 0; return; }
    int k = (ph - 1) % PH_PER_LAYER + (HIDE_CONV ? 1 : 0); l = (ph - 1) / PH_PER_LAYER;
    if (FUSE_RET && k >= 4) k += 2;
    if (FUSE_GM && k >= 8) k += 1;
    ffn2 = (k >= 10);
    const int tab[12] = {K_CONV, K_UP, K_DOWN, K_WIN, K_KV, K_SCAN, K_MIX, K_GATE, K_MERGE, K_WOUT, K_UP, K_DOWN};
    kind = (k == 0) ? K_CONV : (k == 1 || k == 10) ? K_UP : (k == 2 || k == 11) ? K_DOWN : (k == 3) ? K_WIN : (k == 4) ? K_KV : (k == 5) ? K_SCAN : (k == 6) ? K_MIX : (k == 7) ? K_GATE : (k == 8) ? K_MERGE : K_WOUT;
    (void)tab;
}
__device__ __forceinline__ int vcu_idle(int bx) { return bx - 128; }
template <int KIND>
__device__ __forceinline__ void phase_body(const Ctx& c, const int l, const int ffn2) {
    const CAS Args& args = *c.ap; unsigned char* ws = c.ws; float* X = c.X; LAS unsigned char* lds = c.lds;
    const int tid = c.tid, lane = c.lane, wave = c.wave, vcu = c.vcu, G = c.G, bx = c.bx, gw = c.gw, ngw = c.ngw;
    bf16_t* XB = (bf16_t*)(ws + WS_XB); float* SSQ = (float*)(ws + WS_SSQ);
    const float* cosT = (const float*)(ws + WS_COS); const float* sinT = (const float*)(ws + WS_SIN);
    unsigned char* wb = ws + WS_W;
    (void)tid; (void)lane; (void)wave; (void)vcu; (void)G; (void)bx; (void)gw; (void)ngw; (void)XB; (void)SSQ; (void)cosT; (void)sinT; (void)wb; (void)X; (void)lds;
    if constexpr (KIND == K_PRO) {
#if NAIVE_WIN
        rope_tables(args, ws, (vcu * NWAVES * 64) + tid, G * NWAVES * 64);
#endif
        if (bx == 0 && tid < 4) ((unsigned*)(ws + WS_ONES))[tid] = 0x3f803f80u;
        naive::xb_ssq_pass(as_global(args.in[I_X]), XB, SSQ, gw, ngw, lane);
        convert_layer(args, ws, 0, (HIDE_CONV && G == 256) ? 1 : 0, lds, gw, ngw, wave, lane);
    } else if constexpr (KIND == K_CONV) {
        if (l > 0) convert_layer(args, ws, l, 0, lds, gw, ngw, wave, lane);
    } else if constexpr (KIND == K_UP) {
#if NAIVE_UP
        const float* xin = (l == 0 && !ffn2) ? as_global(args.in[I_X]) : X;
        naive::gemm<2, true, true, 4>(lds, tid, vcu, G, DFF, DM, xin, (ffn2 ? as_global(args.in[I_F2N]) : as_global(args.in[I_F1N])) + l * DM, nullptr, nullptr, nullptr, 0,
                                   (ffn2 ? as_global(args.in[I_F2G]) : as_global(args.in[I_F1G])) + (size_t)l * DM * DFF, (ffn2 ? as_global(args.in[I_F2U]) : as_global(args.in[I_F1U])) + (size_t)l * DM * DFF, nullptr, DFF, naive::NEpiUp{(bf16_t*)(ws + WS_HB)});
#else
        pg8::Gemm g{XB, (const bf16_t*)(wb + (ffn2 ? W_GU2 : W_GU1)), DM, 0, 0};
        pg8::StaticOrder S; S.init(M, 2 * DFF, G, bx);
        pg8::gemm_phase(lds + RING_OFF, tid, g, S, epi::EpiUp{(bf16_t*)(ws + WS_HB), (const LAS float*)(lds + epi::EPI_RSTD_OFF)}, [&]() { epi::fill_rstd_table(lds, tid, SSQ, S); });
#if HIDE_CONV
        if (G == 256 && bx >= 128) { if (l == 0 && !ffn2) convert_layer(args, ws, 0, 2, lds, (vcu_idle(bx)) * NWAVES + wave, 128 * NWAVES, wave, lane);
                                     if (l == 0 && ffn2)  convert_layer(args, ws, 1, 1, lds, (vcu_idle(bx)) * NWAVES + wave, 128 * NWAVES, wave, lane);
                                     if (l == 1 && !ffn2) convert_layer(args, ws, 1, 2, lds, (vcu_idle(bx)) * NWAVES + wave, 128 * NWAVES, wave, lane); }
#endif
#endif
    } else if constexpr (KIND == K_DOWN) {
        const float* xold = (l == 0 && !ffn2) ? as_global(args.in[I_X]) : X;
#if NAIVE_DOWN
        naive::gemm<1, true, false, 4>(lds, tid, vcu, G, DM, DFF, nullptr, nullptr, (const bf16_t*)(ws + WS_HB), nullptr, nullptr, DFF,
                                    (ffn2 ? as_global(args.in[I_F2D]) : as_global(args.in[I_F1D])) + (size_t)l * DFF * DM, nullptr, nullptr, DM, naive::NEpiRes{xold, X, XB, SSQ, 0.5f});
#else
        pg8::Gemm g{(const bf16_t*)(ws + WS_HB), (const bf16_t*)(wb + (ffn2 ? W_D2 : W_D1)), DFF, 0, 0};
        pg8::StaticOrder S; S.init(M, DM, G, bx);
        pg8::gemm_phase(lds + RING_OFF, tid, g, S, epi::EpiRes{xold, X, XB, SSQ, 0.5f});
#endif
    } else if constexpr (KIND == K_WIN) {
#if NAIVE_WIN
        naive::gemm<1, true, true, 4>(lds, tid, vcu, G, NIN1, DM, X, as_global(args.in[I_MIXN]) + l * DM, nullptr, nullptr, nullptr, 0,
                                   as_global(args.in[I_WIN]) + (size_t)l * DM * NIN, nullptr, nullptr, NIN,
                                   naive::NEpiWin{ws, cosT, sinT, as_global(args.in[I_AQN]) + l * 64, as_global(args.in[I_AKN]) + l * 64, as_global(args.in[I_BQN]) + l * 64, as_global(args.in[I_BKN]) + l * 64});
#else
        pg8::Gemm g{XB, (const bf16_t*)(wb + W_IN), DM, 0, 0};
        pg8::StaticOrder S; S.init(M, NIN1, G, bx);
        epi::fill_rstd_table(lds, tid, SSQ, S);
        { LAS float* gt = (LAS float*)(lds + epi::EPI_GAIN_OFF); LAS float* rt = (LAS float*)(lds + epi::EPI_ROPE_OFF);
          if (tid < 256) { const int kq = tid >> 6; const float* gp = (kq == 0) ? as_global(args.in[I_AQN]) : (kq == 1) ? as_global(args.in[I_AKN]) : (kq == 2) ? as_global(args.in[I_BQN]) : as_global(args.in[I_BKN]); gt[tid] = gp[l * 64 + (tid & 63)]; }
          else if (tid < 288) rt[tid - 256] = (float)args.ropec[tid - 256]; }
        __syncthreads();
        pg8::gemm_phase(lds + RING_OFF, tid, g, S, epi::EpiWin{ws, (const LAS float*)(lds + epi::EPI_RSTD_OFF), (const LAS float*)(lds + epi::EPI_GAIN_OFF), (const LAS float*)(lds + epi::EPI_ROPE_OFF)});
#if HIDE_CONV
        if (G == 256 && bx >= 128) convert_layer(args, ws, l, 3, lds, (vcu_idle(bx)) * NWAVES + wave, 128 * NWAVES, wave, lane);
#endif
#endif
    } else if constexpr (KIND == K_KV) {
#if !NAIVE_C
        fa::ret_kv_phase(lds, tid, ws, gw, ngw);
#endif
    } else if constexpr (KIND == K_SCAN) {
#if !NAIVE_C
        fa::ret_scan_phase(tid, ws, vcu, G);
#endif
    } else if constexpr (KIND == K_MIX) {
#if FUSE_RET && !NAIVE_C && !NAIVE_B && !NAIVE_A
        {
            gu32* ctl = (gu32*)(ws + WS_CTL);
            fa::ret_kv_phase(lds, tid, ws, gw, ngw);
            cnt_signal(ctl, l * 16 + (vcu >> 5));
            fa::attn_b_phase(lds, tid, ws, (bf16_t*)(ws + WS_BQ), vcu, G, as_global(args.in[I_BREL]) + l * 8 * 320, as_global(args.in[I_BQN]) + l * 64, as_global(args.in[I_BKN]) + l * 64);
            if (vcu < 128) { cnt_wait(ctl, l * 16 + (vcu >> 4), 32u); fa::ret_scan_phase(tid, ws, vcu, G); cnt_signal(ctl, l * 16 + 8 + (vcu >> 4)); }
            __syncthreads();
            fa::attn_a_phase(lds, tid, ws, (bf16_t*)(ws + WS_AQ), vcu, G, as_global(args.in[I_LQ1]) + l * 64, as_global(args.in[I_LK1]) + l * 64, as_global(args.in[I_LQ2]) + l * 64, as_global(args.in[I_LK2]) + l * 64, as_global(args.in[I_ASUB]) + l * 128, (l == 0 ? args.lam_init[0] : args.lam_init[1]), as_global(args.in[I_AQN]) + l * 64, as_global(args.in[I_AKN]) + l * 64);
            cnt_wait(ctl, l * 16 + 8 + (vcu >> 5), 16u);
            fa::ret_out_phase(lds, tid, ws, gw, ngw, as_global(args.in[I_CON]) + l * 512);
        }
#else
#if NAIVE_C
        naive::retention(ws, as_global(args.in[I_CON]) + l * 512, lds, vcu, G, tid);
#else
        fa::ret_out_phase(lds, tid, ws, gw, ngw, as_global(args.in[I_CON]) + l * 512);
#endif
        __syncthreads();
#if NAIVE_B
        naive::attn_b(ws, as_global(args.in[I_BREL]) + l * 8 * 320, lds, gw, ngw, wave, lane);
#else
#if PROBE_B
        for (int rep = 0; rep < PROBE_B; ++rep) { fa::attn_b_phase(lds, tid, ws, (bf16_t*)(ws + WS_W), vcu, G, as_global(args.in[I_BREL]) + l * 8 * 320, as_global(args.in[I_BQN]) + l * 64, as_global(args.in[I_BKN]) + l * 64); __syncthreads(); }
#endif
        fa::attn_b_phase(lds, tid, ws, (bf16_t*)(ws + WS_BQ), vcu, G, as_global(args.in[I_BREL]) + l * 8 * 320, as_global(args.in[I_BQN]) + l * 64, as_global(args.in[I_BKN]) + l * 64);
#endif
        __syncthreads();
#if NAIVE_A
        naive::attn_a(ws, as_global(args.in[I_LQ1]) + l * 64, as_global(args.in[I_LK1]) + l * 64, as_global(args.in[I_LQ2]) + l * 64, as_global(args.in[I_LK2]) + l * 64, as_global(args.in[I_ASUB]) + l * 128, (l == 0 ? args.lam_init[0] : args.lam_init[1]), lds, gw, ngw, wave, lane);
#else
#if PROBE_A
        for (int rep = 0; rep < PROBE_A; ++rep) { fa::attn_a_phase(lds, tid, ws, (bf16_t*)(ws + WS_W), vcu, G, as_global(args.in[I_LQ1]) + l * 64, as_global(args.in[I_LK1]) + l * 64, as_global(args.in[I_LQ2]) + l * 64, as_global(args.in[I_LK2]) + l * 64, as_global(args.in[I_ASUB]) + l * 128, (l == 0 ? args.lam_init[0] : args.lam_init[1]), as_global(args.in[I_AQN]) + l * 64, as_global(args.in[I_AKN]) + l * 64, PROBE_PM); __syncthreads(); }
#endif
#define MK_PROBE_STRETCH 1
        fa::attn_a_phase(lds, tid, ws, (bf16_t*)(ws + WS_AQ), vcu, G, as_global(args.in[I_LQ1]) + l * 64, as_global(args.in[I_LK1]) + l * 64, as_global(args.in[I_LQ2]) + l * 64, as_global(args.in[I_LK2]) + l * 64, as_global(args.in[I_ASUB]) + l * 128, (l == 0 ? args.lam_init[0] : args.lam_init[1]), as_global(args.in[I_AQN]) + l * 64, as_global(args.in[I_AKN]) + l * 64);
#endif
#endif
#if PROBE_T
        __syncthreads();
        if (bx == 0 && tid == 0 && l == 1) {
            const unsigned long long* pr = (const unsigned long long*)(ws + WS_PROBE);
            const unsigned long long v = pr[PROBE_SEL]; const unsigned long long t0 = __builtin_amdgcn_s_memrealtime();
            while (__builtin_amdgcn_s_memrealtime() - t0 < v * 100ull) __builtin_amdgcn_s_sleep(32);
        }
#endif
    } else if constexpr (KIND == K_GATE) {
#if NAIVE_GATE
        naive::gemm<1, true, true, 4>(lds, tid, vcu, G, NGATE, DM, X, as_global(args.in[I_MIXN]) + l * DM, nullptr, nullptr, nullptr, 0,
                                   as_global(args.in[I_WIN]) + (size_t)l * DM * NIN + NIN1, nullptr, nullptr, NIN, naive::NEpiGate{(bf16_t*)(ws + WS_GT)});
#else
#if FUSE_GM
        {
            pg8::Gemm g{XB, (const bf16_t*)(wb + W_IN) + (size_t)NIN1 * DM, DM, 0, (size_t)1024 * DM * 2};
            pg8::StaticOrder S; S.init(M, DM, G, bx);
            pg8::gemm_phase<3>(lds + RING_OFF, tid, g, S, epi::EpiGate{(bf16_t*)(ws + WS_GT), (const LAS float*)(lds + epi::EPI_RSTD_OFF)}, [&]() { epi::fill_rstd_table(lds, tid, SSQ, S); });
            asm volatile("s_waitcnt vmcnt(0)" ::: "memory"); __syncthreads();
            int tid2 = tid; asm volatile("" : "+v"(tid2));
            pg8::Gemm g2{(const bf16_t*)(ws + WS_AQ), (const bf16_t*)(wb + W_BR), 512, P16, (size_t)DM * 512 * 2};
            pg8::StaticOrder S2; S2.init(M, DM, G, bx);
            pg8::gemm_phase<3>(lds + RING_OFF, tid2, g2, S2, epi::EpiMerge{(const bf16_t*)(ws + WS_GT), (bf16_t*)(ws + WS_MG), (const unsigned*)(ws + WS_ONES)});
        }
#else
        pg8::Gemm g{XB, (const bf16_t*)(wb + W_IN) + (size_t)NIN1 * DM, DM, 0, 0};
        pg8::StaticOrder S; S.init(M, NGATE, G, bx);
        pg8::gemm_phase(lds + RING_OFF, tid, g, S, epi::EpiGate{(bf16_t*)(ws + WS_GT), (const LAS float*)(lds + epi::EPI_RSTD_OFF)}, [&]() { epi::fill_rstd_table(lds, tid, SSQ, S); });
#endif
#endif
    } else if constexpr (KIND == K_MERGE) {
#if NAIVE_MERGE
        naive::gemm<3, false, false, 2>(lds, tid, vcu, G, DM, 512, nullptr, nullptr, (const bf16_t*)(ws + WS_AQ), (const bf16_t*)(ws + WS_BQ), (const bf16_t*)(ws + WS_CG), 512,
                                     as_global(args.in[I_WBA]) + (size_t)l * 512 * DM, as_global(args.in[I_WBB]) + (size_t)l * 512 * DM, as_global(args.in[I_WBC]) + (size_t)l * 512 * DM, DM,
                                     naive::NEpiMerge{(const bf16_t*)(ws + WS_GT), (bf16_t*)(ws + WS_MG)});
#else
        static_assert(WS_BQ - WS_AQ == P16 && WS_CG - WS_BQ == P16, "y_a, y_b, y_c equally spaced");
        pg8::Gemm g{(const bf16_t*)(ws + WS_AQ), (const bf16_t*)(wb + W_BR), 512, P16, (size_t)DM * 512 * 2};
        pg8::StaticOrder S; S.init(M, DM, G, bx);
        pg8::gemm_phase<3>(lds + RING_OFF, tid, g, S, epi::EpiMerge{(const bf16_t*)(ws + WS_GT), (bf16_t*)(ws + WS_MG), (const unsigned*)(ws + WS_ONES)});
#endif
    } else if constexpr (KIND == K_WOUT) {
#if NAIVE_WOUT
        naive::gemm<1, true, false, 4>(lds, tid, vcu, G, DM, DM, nullptr, nullptr, (const bf16_t*)(ws + WS_MG), nullptr, nullptr, DM,
                                    as_global(args.in[I_WOUT]) + (size_t)l * DM * DM, nullptr, nullptr, DM, naive::NEpiRes{X, X, XB, SSQ, 1.0f});
#else
        pg8::Gemm g{(const bf16_t*)(ws + WS_MG), (const bf16_t*)(wb + W_OUT), DM, 0, 0};
        pg8::StaticOrder S; S.init(M, DM, G, bx);
        pg8::gemm_phase(lds + RING_OFF, tid, g, S, epi::EpiRes{X, X, XB, SSQ, 1.0f});
#endif
    }
}
__device__ __forceinline__ Ctx make_ctx(LAS unsigned char* lds, const int wave_s) {
    Ctx c; c.lds = lds;
    int lane_; asm volatile("v_mbcnt_lo_u32_b32 %0, -1, 0\n\tv_mbcnt_hi_u32_b32 %0, -1, %0" : "=&v"(lane_));
    int tid = wave_s * 64 + lane_; asm volatile("" : "+v"(tid));
    const CAS Args* argp = (const CAS Args*)__builtin_amdgcn_kernarg_segment_ptr(); asm volatile("" : "+s"(argp));
    c.ap = argp; c.tid = tid; c.lane = tid & 63; c.wave = __builtin_amdgcn_readfirstlane(tid >> 6);
    c.G = gridDim.x; c.bx = blockIdx.x; c.vcu = (c.G % 8 == 0) ? (c.bx % 8) * (c.G / 8) + c.bx / 8 : c.bx;
    c.gw = c.vcu * NWAVES + c.wave; c.ngw = c.G * NWAVES;
    GAS unsigned char* ws = argp->ws; asm volatile("" : "+s"(ws)); c.ws = as_global(ws);
    GAS float* X = argp->out; asm volatile("" : "+s"(X)); c.X = as_global(X);
    return c;
}
#if MK_PER_PHASE_LAUNCH
template <int KIND>
__global__ void __launch_bounds__(NWAVES * 64, 2) phase_kernel(Args args_, int l, int ffn2) {
    extern __shared__ __attribute__((aligned(16))) unsigned char lds_raw[];
    const Ctx c = make_ctx((LAS unsigned char*)lds_raw, __builtin_amdgcn_readfirstlane(threadIdx.x >> 6));
    phase_body<KIND>(c, l, ffn2);
}
#endif
#if !MK_PER_PHASE_LAUNCH
__global__ void __launch_bounds__(NWAVES * 64, 2) trunk_fwd(Args args_) {
    extern __shared__ __attribute__((aligned(16))) unsigned char lds_raw[];
    LAS unsigned char* lds = (LAS unsigned char*)lds_raw;
    volatile LAS unsigned* MISC = (volatile LAS unsigned*)(lds + MISC_OFF);
    gu32* ctl = (gu32*)(args_.ws + WS_CTL);
    for (int u = threadIdx.x; u < (LDS_BYTES - LDSCTL_OFF) / 4; u += NWAVES * 64) ((LAS unsigned*)(lds + LDSCTL_OFF))[u] = 0u;
    __syncthreads();
    XcdBarrier bar = xcd_barrier_post((unsigned*)(ctl + CW_BAR), MISC + 8);
    const int wave_s = __builtin_amdgcn_readfirstlane(threadIdx.x >> 6);
    for (int ph = 0; ph < N_PHASES; ++ph) {
        const Ctx c = make_ctx(lds, wave_s);
        int kind_, l_, ffn2_; phase_decode(ph, kind_, l_, ffn2_);
        const int kind = __builtin_amdgcn_readfirstlane(kind_), l = __builtin_amdgcn_readfirstlane(l_), ffn2 = __builtin_amdgcn_readfirstlane(ffn2_);
#if PROBE_MASK
        if ((PROBE_MASK >> kind) & 1) {
            switch (kind) {
            case K_CONV: phase_body<K_CONV>(c, l, ffn2); break;
#if PROBE_NULL
            case K_UP: { pg8::Gemm g{(const bf16_t*)(c.ws + WS_XB), (const bf16_t*)(c.ws + WS_W + (ffn2 ? W_GU2 : W_GU1)), DM, 0, 0}; pg8::StaticOrder S; S.init(M, 2 * DFF, c.G, c.bx); pg8::gemm_phase(c.lds + RING_OFF, c.tid, g, S, epi::EpiNull{}); } break;
#else
            case K_UP: phase_body<K_UP>(c, l, ffn2); break;
#endif
            case K_WIN: phase_body<K_WIN>(c, l, ffn2); break;
            case K_KV: phase_body<K_KV>(c, l, ffn2); break;
            case K_GATE: phase_body<K_GATE>(c, l, ffn2); break;
            case K_MERGE: phase_body<K_MERGE>(c, l, ffn2); break;
            default: break;
            }
            xcd_barrier(bar);
        }
#endif
#if PROBE_PH
        unsigned long long tp0 = __builtin_amdgcn_s_memrealtime();
#endif
        switch (kind) {
        case K_PRO: phase_body<K_PRO>(c, l, ffn2); break;
        case K_CONV: phase_body<K_CONV>(c, l, ffn2); break;
        case K_UP: phase_body<K_UP>(c, l, ffn2); break;
        case K_DOWN: phase_body<K_DOWN>(c, l, ffn2); break;
        case K_WIN: phase_body<K_WIN>(c, l, ffn2); break;
        case K_KV: phase_body<K_KV>(c, l, ffn2); break;
        case K_SCAN: phase_body<K_SCAN>(c, l, ffn2); break;
        case K_MIX: phase_body<K_MIX>(c, l, ffn2); break;
        case K_GATE: phase_body<K_GATE>(c, l, ffn2); break;
        case K_MERGE: phase_body<K_MERGE>(c, l, ffn2); break;
        default: phase_body<K_WOUT>(c, l, ffn2); break;
        }
#if PROBE_PH
        __syncthreads(); const unsigned long long tp1 = __builtin_amdgcn_s_memrealtime();
#endif
        if (ph + 1 < N_PHASES) xcd_barrier(bar);
#if PROBE_PH
        if (blockIdx.x == PROBE_BLK && threadIdx.x == 0) { const unsigned long long tp2 = __builtin_amdgcn_s_memrealtime(); unsigned long long* pr = (unsigned long long*)(args_.ws + WS_PROBE);
            pr[kind] += tp1 - tp0; pr[16] += tp2 - tp1; pr[17] += tp2 - tp0; pr[20 + kind] += tp2 - tp1; }
#endif
    }
#if PROBE_PH
    if (blockIdx.x == PROBE_BLK && threadIdx.x == 0) {
        const unsigned long long v = ((const unsigned long long*)(args_.ws + WS_PROBE))[PROBE_SEL] / 100; const unsigned long long t0 = __builtin_amdgcn_s_memrealtime();
        while (__builtin_amdgcn_s_memrealtime() - t0 < v * 100ull) __builtin_amdgcn_s_sleep(32);
    }
#endif
}
#endif

#if MK_PER_PHASE_LAUNCH
template <int KIND> static void launch_phase(int grid, hipStream_t stream, const Args& a, int l, int ffn2) {
    static bool attr = false;
    if (!attr) { (void)hipFuncSetAttribute((const void*)phase_kernel<KIND>, hipFuncAttributeMaxDynamicSharedMemorySize, LDS_BYTES); attr = true; }
    hipLaunchKernelGGL(phase_kernel<KIND>, dim3(grid), dim3(NWAVES * 64), LDS_BYTES, stream, a, l, ffn2);
}
#endif
extern "C" void kernel_launch(void* const* d_in, const int* in_sizes, int n_in, void* d_out, int out_size, void* d_ws, size_t ws_size, hipStream_t stream) {
    static int grid = 0;
    if (grid == 0) {
        if (n_in != N_IN || in_sizes[0] != M * DM || out_size != M * DM || ws_size < WS_END) { fprintf(stderr, "kernel_launch: unexpected shapes (n_in %d, in0 %d, out %d, ws %zu < %zu); nothing launched\n", n_in, n_in > 0 ? in_sizes[0] : -1, out_size, ws_size, (size_t)WS_END); grid = -1; return; }
        int dev = 0, cus = 0, per_cu = 0;
        if (hipGetDevice(&dev) != hipSuccess || hipDeviceGetAttribute(&cus, hipDeviceAttributeMultiprocessorCount, dev) != hipSuccess) { grid = -1; return; }
#if !MK_PER_PHASE_LAUNCH
        if (hipFuncSetAttribute((const void*)trunk_fwd, hipFuncAttributeMaxDynamicSharedMemorySize, LDS_BYTES) != hipSuccess) { fprintf(stderr, "kernel_launch: hipFuncSetAttribute failed\n"); grid = -1; return; }
        if (hipOccupancyMaxActiveBlocksPerMultiprocessor(&per_cu, (const void*)trunk_fwd, NWAVES * 64, LDS_BYTES) != hipSuccess || per_cu < 1)
            fprintf(stderr, "kernel_launch: note: occupancy query reports %d workgroups per CU\n", per_cu);
        (void)hipGetLastError();
#endif
        (void)per_cu;
        if (cus < 256) { fprintf(stderr, "kernel_launch: built for a 256-CU device (found %d CUs); nothing launched\n", cus); grid = -1; return; }
        grid = 256;
    }
    if (grid < 0) return;
    (void)hipMemsetAsync((char*)d_ws + WS_CTL, 0, (FUSE_RET || PROBE_T || PROBE_PH) ? CTL_ZERO_BYTES : 32768, stream);
    Args a{};
    for (int i = 0; i < N_IN; ++i) a.in[i] = (const GAS float*)d_in[i];
    a.out = (GAS float*)d_out; a.ws = (GAS unsigned char*)d_ws;
    for (int i = 0; i < 32; ++i) a.ropec[i] = std::pow(10000.0, -(double)i / 32.0) / (2.0 * 3.14159265358979323846);
    for (int l = 0; l < 2; ++l) a.lam_init[l] = (float)(0.8 - 0.6 * std::exp(-0.3 * (double)l));
#if MK_PER_PHASE_LAUNCH
    for (int ph = 0; ph < N_PHASES; ++ph) {
        int kind, l, ffn2; phase_decode(ph, kind, l, ffn2);
        switch (kind) {
        case K_PRO: launch_phase<K_PRO>(grid, stream, a, l, ffn2); break;
        case K_CONV: if (l > 0) launch_phase<K_CONV>(grid, stream, a, l, ffn2); break;
        case K_UP: launch_phase<K_UP>(grid, stream, a, l, ffn2); break;
        case K_DOWN: launch_phase<K_DOWN>(grid, stream, a, l, ffn2); break;
        case K_WIN: launch_phase<K_WIN>(grid, stream, a, l, ffn2); break;
#if NAIVE_C
        case K_KV: case K_SCAN: break;
#else
        case K_KV: launch_phase<K_KV>(grid, stream, a, l, ffn2); break;
        case K_SCAN: launch_phase<K_SCAN>(grid, stream, a, l, ffn2); break;
#endif
        case K_MIX: launch_phase<K_MIX>(grid, stream, a, l, ffn2); break;
        case K_GATE: launch_phase<K_GATE>(grid, stream, a, l, ffn2); break;
        case K_MERGE: launch_phase<K_MERGE>(grid, stream, a, l, ffn2); break;
        default: launch_phase<K_WOUT>(grid, stream, a, l, ffn2); break;
        }
    }
#else
    hipLaunchKernelGGL(trunk_fwd, dim3(grid), dim3(NWAVES * 64), LDS_BYTES, stream, a);
#endif
    const hipError_t le = hipPeekAtLastError();
    if (le != hipSuccess) fprintf(stderr, "kernel_launch: launch failed: %s\n", hipGetErrorName(le));
}
```

```cpp
#include <hip/hip_runtime.h>
#include <hip/hip_bf16.h>
#include <cstdio>
#include <cstdint>
#include <cmath>

#ifndef MK_PER_PHASE_LAUNCH
#define MK_PER_PHASE_LAUNCH 0
#endif
#ifndef NAIVE_GEMM
#define NAIVE_GEMM 0
#endif
#ifndef NAIVE_UP
#define NAIVE_UP NAIVE_GEMM
#endif
#ifndef NAIVE_DOWN
#define NAIVE_DOWN NAIVE_GEMM
#endif
#ifndef NAIVE_WIN
#define NAIVE_WIN NAIVE_GEMM
#endif
#ifndef NAIVE_GATE
#define NAIVE_GATE NAIVE_GEMM
#endif
#ifndef NAIVE_MERGE
#define NAIVE_MERGE NAIVE_GEMM
#endif
#ifndef NAIVE_WOUT
#define NAIVE_WOUT NAIVE_GEMM
#endif
#ifndef PROBE_MASK
#define PROBE_MASK 0
#endif
#ifndef PROBE_NULL
#define PROBE_NULL 0
#endif
#ifndef FA_V2
#define FA_V2 3
#endif
#ifndef PROBE_PM
#define PROBE_PM 0
#endif
#ifndef PROBE_T
#define PROBE_T 0
#endif
#ifndef PROBE_SEL
#define PROBE_SEL 0
#endif
#ifndef FA_WMAP
#define FA_WMAP 0
#endif
#ifndef HIDE_CONV
#define HIDE_CONV 1
#endif
#ifndef PROBE_PH
#define PROBE_PH 0
#endif
#ifndef PROBE_BLK
#define PROBE_BLK 0
#endif
#ifndef FA_HAND
#define FA_HAND 1
#endif
#ifndef FUSE_RET
#define FUSE_RET 0
#endif
#ifndef FA_HANDB
#define FA_HANDB 1
#endif
#ifndef FA_NOMAX_BOUND_A
#define FA_NOMAX_BOUND_A 100.0f
#endif
#ifndef FA_NOMAX_BOUND_B
#define FA_NOMAX_BOUND_B 100.0f
#endif
#ifndef FUSE_GM
#define FUSE_GM 1
#endif
#ifndef PROBE_A
#define PROBE_A 0
#endif
#ifndef PROBE_B
#define PROBE_B 0
#endif
#ifndef NAIVE_A
#define NAIVE_A 0
#endif
#ifndef NAIVE_B
#define NAIVE_B 0
#endif
#ifndef NAIVE_C
#define NAIVE_C 0
#endif

constexpr int BATCH = 2, SEQ = 8192, DM = 1024, DEPTH = 2, M = BATCH * SEQ;
constexpr int DFF = 2816, NIN1 = 4608, NGATE = 3072, NIN = 7680;
constexpr float EPS = 1e-6f;
constexpr float LOG2E = 1.4426950408889634f;
constexpr float C2 = 0.125f * LOG2E;

enum { I_X = 0, I_F1N, I_F1G, I_F1U, I_F1D, I_MIXN, I_WIN, I_AQN, I_AKN, I_LQ1, I_LK1, I_LQ2, I_LK2, I_ASUB, I_BQN, I_BKN, I_BREL, I_CON, I_WBA, I_WBB, I_WBC, I_WOUT, I_F2N, I_F2G, I_F2U, I_F2D, N_IN };

constexpr size_t MiB = 1u << 20;
constexpr size_t WS_CTL = 0, CTL_ZERO_BYTES = 1 * MiB;
constexpr size_t WS_PROBE = 576 * 1024;
constexpr size_t WS_ONES = 512 * 1024;
constexpr size_t WS_COS = 1 * MiB, WS_SIN = 2 * MiB;
constexpr size_t WS_SSQ = 3 * MiB;
constexpr size_t WS_W = 4 * MiB;
constexpr size_t W_GU1 = 0, W_D1 = W_GU1 + (size_t)2 * DFF * DM * 2, W_IN = W_D1 + (size_t)DM * DFF * 2, W_BR = W_IN + (size_t)NIN * DM * 2,
                 W_OUT = W_BR + (size_t)3 * DM * 512 * 2, W_GU2 = W_OUT + (size_t)DM * DM * 2, W_D2 = W_GU2 + (size_t)2 * DFF * DM * 2, W_END = W_D2 + (size_t)DM * DFF * 2;
static_assert(W_END == 53 * MiB, "weights");
constexpr size_t WS_XB = 57 * MiB;
constexpr size_t WS_R4 = 89 * MiB;
constexpr size_t WS_R3 = 121 * MiB;
constexpr size_t P16 = 16 * MiB;
constexpr size_t WS_AQ = WS_R3, WS_BQ = WS_R3 + P16, WS_CG = WS_R3 + 2 * P16;
constexpr size_t WS_AK = WS_R3 + 3 * P16, WS_AV = WS_AK + P16, WS_BK = WS_AV + P16, WS_BV = WS_BK + P16, WS_CQ = WS_BV + P16, WS_CK = WS_CQ + P16 / 2, WS_CV = WS_CK + P16 / 2;
constexpr size_t WS_GT = WS_AK;
constexpr size_t WS_HB = WS_R3;
constexpr size_t WS_MG = WS_R4;
constexpr size_t WS_END = WS_R3 + 144 * MiB;
static_assert(WS_CV + P16 == WS_END && WS_GT + (size_t)M * NGATE * 2 == WS_END && WS_HB + (size_t)M * DFF * 2 <= WS_END, "ws map");

#define GAS __attribute__((address_space(1)))
#define LAS __attribute__((address_space(3)))
typedef unsigned short bf16_t;
typedef short bf16x8 __attribute__((ext_vector_type(8)));
typedef float f32x4 __attribute__((ext_vector_type(4)));
typedef float f32x2 __attribute__((ext_vector_type(2)));
typedef float f32x16 __attribute__((ext_vector_type(16)));
typedef unsigned u32x4 __attribute__((ext_vector_type(4)));
typedef unsigned u32x2 __attribute__((ext_vector_type(2)));
typedef GAS unsigned gu32;
#define RLX_AGENT __ATOMIC_RELAXED, __HIP_MEMORY_SCOPE_AGENT
#define LDS_WAIT() asm volatile("s_waitcnt lgkmcnt(0)" ::: "memory")
#define VM_WAIT() asm volatile("s_waitcnt vmcnt(0)" ::: "memory")

__device__ __forceinline__ unsigned f2bf(float f) { unsigned u = __builtin_bit_cast(unsigned, f); return (u + 0x7fffu + ((u >> 16) & 1u)) >> 16; }
__device__ __forceinline__ unsigned pk2(float lo, float hi) { return f2bf(lo) | (f2bf(hi) << 16); }
__device__ __forceinline__ float bf2f(unsigned short b) { return __builtin_bit_cast(float, (unsigned)b << 16); }
__device__ __forceinline__ float bflo(unsigned w) { return __builtin_bit_cast(float, w << 16); }
__device__ __forceinline__ float bfhi(unsigned w) { return __builtin_bit_cast(float, w & 0xffff0000u); }
__device__ __forceinline__ unsigned cvt_pk_bf16(float lo, float hi) { unsigned r; asm volatile("v_cvt_pk_bf16_f32 %0, %1, %2" : "=v"(r) : "v"(lo), "v"(hi)); return r; }
__device__ __forceinline__ float fast_rcp(float x) { return __builtin_amdgcn_rcpf(x); }
__device__ __forceinline__ float fast_exp2(float x) { return __builtin_amdgcn_exp2f(x); }
__device__ __forceinline__ float silu_f(float x) { return x * fast_rcp(1.0f + fast_exp2(-x * LOG2E)); }
__device__ __forceinline__ float sigmoid_f(float x) { return fast_rcp(1.0f + fast_exp2(-x * LOG2E)); }
template <int O> __device__ __forceinline__ float xor_add(float v) {
    if constexpr (O == 32) { auto rr = __builtin_amdgcn_permlane32_swap(__float_as_uint(v), __float_as_uint(v), false, false); return __uint_as_float(rr[0]) + __uint_as_float(rr[1]); }
    else return v + __uint_as_float((unsigned)__builtin_amdgcn_ds_swizzle((int)__float_as_uint(v), (O << 10) | 0x1f));
}
template <int O> __device__ __forceinline__ float xor_max(float v) {
    if constexpr (O == 32) { auto rr = __builtin_amdgcn_permlane32_swap(__float_as_uint(v), __float_as_uint(v), false, false); return fmaxf(__uint_as_float(rr[0]), __uint_as_float(rr[1])); }
    else return fmaxf(v, __uint_as_float((unsigned)__builtin_amdgcn_ds_swizzle((int)__float_as_uint(v), (O << 10) | 0x1f)));
}
__device__ __forceinline__ float wave_sum(float v) { v = xor_add<1>(v); v = xor_add<2>(v); v = xor_add<4>(v); v = xor_add<8>(v); v = xor_add<16>(v); return xor_add<32>(v); }
__device__ __forceinline__ float wave_max(float v) { v = xor_max<1>(v); v = xor_max<2>(v); v = xor_max<4>(v); v = xor_max<8>(v); v = xor_max<16>(v); return xor_max<32>(v); }

namespace pg8 {
#define PG8_LAS __attribute__((address_space(3)))
constexpr int BM = 256, BK = 64, HALF = 128, HTB = HALF * BK * 2  , STAGE_BYTES = 8 * HTB, NXCD = 8, WGM = 8;

__host__ __device__ __forceinline__ int lds_byte(int r, int c) { const int st = (r >> 4) * 2 + (c >> 5), rr = r & 15, cc = c & 31, ob = rr * 64 + cc * 2; return st * 1024 + (ob ^ (((ob >> 9) & 1) << 5)); }
__host__ __device__ __forceinline__ void stage_rc(int b, int& R, int& C) { const int st = b / 1024, sb = b % 1024, swz = sb ^ (((sb >> 9) & 1) << 5); R = (st >> 1) * 16 + swz / 64; C = (st & 1) * 32 + (swz % 64) / 2; }
__host__ __device__ __forceinline__ int perm32(int rho) { const int n = rho >> 4, i = rho & 15; return 8 * (i >> 2) + 4 * n + (i & 3); }

struct Unit { int pm, pn, sub, ui; };
struct Gemm { const bf16_t* A; const bf16_t* Bt; int K; size_t subA, subB; };
__device__ __forceinline__ const char* pickA(const Gemm& g, int s) { return (const char*)g.A + (size_t)s * g.subA; }
__device__ __forceinline__ const char* pickB(const Gemm& g, int s) { return (const char*)g.Bt + (size_t)s * g.subB; }

struct StaticOrder {
    int nM, nN, nwg, G, c;
    __host__ __device__ void init(int Mr, int N, int G_, int c_) { nM = Mr / BM; nN = N / BM; nwg = nM * nN; G = G_; c = c_; }
    template <int NSUB = 1> __host__ __device__ bool next(int i, Unit& u) const {
        const int it = i / NSUB; u.sub = i - it * NSUB; u.ui = it;
        const long L = (long)it * G + c; if (L >= nwg) return false;
        int wgid = (int)L; { const int q = nwg / NXCD, r = nwg % NXCD, xcd = wgid % NXCD, off = wgid / NXCD; wgid = (xcd < r ? xcd * (q + 1) : r * (q + 1) + (xcd - r) * q) + off; }
        const int nig = WGM * nN, gid = wgid / nig, fm = gid * WGM, gsz = (nM - fm) < WGM ? (nM - fm) : WGM;
        u.pm = fm + ((wgid % nig) % gsz); u.pn = (wgid % nig) / gsz; return true;
    }
};

struct NoPre { __device__ __forceinline__ void operator()() const {} };
template <int NSUB = 1, class Epi, class Pre = NoPre>
__device__ __forceinline__ void gemm_phase(PG8_LAS unsigned char* lds, const int tid, const Gemm g, const StaticOrder& S, const Epi& E, const Pre& pre = Pre()) {
    const int wid = __builtin_amdgcn_readfirstlane(tid >> 6), lane = tid & 63, wr = wid >> 2, wc = wid & 3, fr = lane & 15, fq = lane >> 4;
    const int K = g.K, nt = K / BK;
    unsigned voffA[2], voffB[2];
#pragma unroll
    for (int i = 0; i < 2; ++i) { int R, C; stage_rc(tid * 16 + i * 8192, R, C); const int Rb = ((R & ~31) + perm32(R & 31));
        voffA[i] = (unsigned)(R * K + C) * 2u; voffB[i] = (unsigned)(Rb * K + C) * 2u; }
    const size_t kstep = (size_t)(BK * 2);
    const size_t hstep = (size_t)HALF * K * 2;
    const size_t tstep = 2 * hstep;
    const unsigned ldsw = (unsigned)wid * 1024u;
    const int aoff = lds_byte(wr * 64 + fr, fq * 8), boff = lds_byte(wc * 32 + fr, fq * 8);
#define PG8_SA(b, h) (((b) * 2 + (h)) * HTB)
#define PG8_SB(b, h) ((4 + (b) * 2 + (h)) * HTB)
#define PG8_STAGE(bufoff, gbase, voff) do { _Pragma("unroll") for (int _i = 0; _i < 2; ++_i) \
        __builtin_amdgcn_global_load_lds((const unsigned*)((const char*)(gbase) + (voff)[_i]), (PG8_LAS unsigned*)(lds + (bufoff) + ldsw + _i * 8192), 16, 0, 0); } while (0)
#define PG8_LDA(dst, b, h) do { _Pragma("unroll") for (int m = 0; m < 4; ++m) _Pragma("unroll") for (int k = 0; k < 2; ++k) dst[m][k] = *(const PG8_LAS bf16x8*)(lds + PG8_SA(b, h) + aoff + m * 2048 + k * 1024); } while (0)
#define PG8_LDB(dst, b, h) do { _Pragma("unroll") for (int n = 0; n < 2; ++n) _Pragma("unroll") for (int k = 0; k < 2; ++k) dst[n][k] = *(const PG8_LAS bf16x8*)(lds + PG8_SB(b, h) + boff + n * 2048 + k * 1024); } while (0)
#define PG8_MMA(ai, bj, At, Bt) do { __builtin_amdgcn_s_setprio(1); _Pragma("unroll") for (int m = 0; m < 4; ++m) _Pragma("unroll") for (int n = 0; n < 2; ++n) _Pragma("unroll") for (int k = 0; k < 2; ++k) \
        acc[ai][bj][m][n] = __builtin_amdgcn_mfma_f32_16x16x32_bf16(Bt[n][k], At[m][k], acc[ai][bj][m][n], 0, 0, 0); __builtin_amdgcn_s_setprio(0); } while (0)
#define PG8_WAIT_V(n) asm volatile("s_waitcnt vmcnt(" #n ")" ::: "memory")
#define PG8_WAIT_L(n) asm volatile("s_waitcnt lgkmcnt(" #n ")" ::: "memory")
#define PG8_BAR __builtin_amdgcn_s_barrier()
#define PG8_SCHED __builtin_amdgcn_sched_barrier(0)
    Unit cur, nxt; int ui = 0;
    if (!S.template next<NSUB>(0, cur)) return;
    f32x4 acc[2][2][4][2];
#pragma unroll
    for (int a = 0; a < 2; ++a)
#pragma unroll
        for (int b = 0; b < 2; ++b)
#pragma unroll
            for (int m = 0; m < 4; ++m)
#pragma unroll
                for (int n = 0; n < 2; ++n) acc[a][b][m][n] = (f32x4){0.f, 0.f, 0.f, 0.f};
    bf16x8 At[4][2], B0[2][2], B1[2][2];
    const char* cA = pickA(g, cur.sub) + (size_t)cur.pm * tstep; const char* cB = pickB(g, cur.sub) + (size_t)cur.pn * tstep;
    if constexpr (Epi::INIT) { int l_ = tid; asm volatile("" : "+v"(l_)); E.init(acc, cur, wr, wc, l_ & 15, (l_ >> 4) & 3); }
    PG8_STAGE(PG8_SB(0, 0), cB, voffB); PG8_STAGE(PG8_SB(0, 1), cB + hstep, voffB); PG8_STAGE(PG8_SA(0, 0), cA, voffA); PG8_STAGE(PG8_SA(0, 1), cA + hstep, voffA);
    pre();
    if (wr == 1) PG8_BAR;
    PG8_WAIT_V(2); PG8_BAR;
    PG8_STAGE(PG8_SB(1, 0), cB + kstep, voffB); PG8_STAGE(PG8_SA(1, 0), cA + kstep, voffA); PG8_STAGE(PG8_SB(1, 1), cB + hstep + kstep, voffB);
    PG8_WAIT_V(6); PG8_BAR;
    for (;;) {
        const bool has_next = S.template next<NSUB>(ui + 1, nxt);
        const char* nA = has_next ? pickA(g, nxt.sub) + (size_t)nxt.pm * tstep : cA; const char* nB = has_next ? pickB(g, nxt.sub) + (size_t)nxt.pn * tstep : cB;
        for (int t = 0; t < nt; t += 2) {
            const bool last = (t == nt - 2);
            const char* a1 = cA + (size_t)(t + 1) * kstep;
            const char* a2 = last ? nA : cA + (size_t)(t + 2) * kstep; const char* b2 = last ? nB : cB + (size_t)(t + 2) * kstep;
            const char* a3 = a2 + kstep; const char* b3 = b2 + kstep;
            PG8_LDB(B0, 0, 0); PG8_LDB(B1, 0, 1); PG8_SCHED; PG8_LDA(At, 0, 0); PG8_STAGE(PG8_SA(1, 1), a1 + hstep, voffA);
            PG8_WAIT_V(8); PG8_WAIT_L(0); PG8_BAR; PG8_MMA(0, 0, At, B0); PG8_MMA(0, 1, At, B1); PG8_BAR; PG8_SCHED;
            PG8_LDA(At, 0, 1); PG8_STAGE(PG8_SB(0, 0), b2, voffB); PG8_STAGE(PG8_SB(0, 1), b2 + hstep, voffB); PG8_STAGE(PG8_SA(0, 0), a2, voffA);
            PG8_WAIT_V(8); PG8_WAIT_L(0); PG8_BAR; PG8_MMA(1, 0, At, B0); PG8_MMA(1, 1, At, B1); PG8_BAR; PG8_SCHED;
            PG8_LDB(B0, 1, 0); PG8_LDB(B1, 1, 1); PG8_SCHED; PG8_LDA(At, 1, 0); PG8_STAGE(PG8_SA(0, 1), a2 + hstep, voffA);
            PG8_WAIT_V(8); PG8_WAIT_L(0); PG8_BAR; PG8_MMA(0, 0, At, B0); PG8_MMA(0, 1, At, B1); PG8_BAR; PG8_SCHED;
            PG8_LDA(At, 1, 1); PG8_STAGE(PG8_SB(1, 0), b3, voffB); PG8_STAGE(PG8_SB(1, 1), b3 + hstep, voffB); PG8_STAGE(PG8_SA(1, 0), a3, voffA);
            PG8_WAIT_V(8); PG8_WAIT_L(0); PG8_BAR; PG8_MMA(1, 0, At, B0); PG8_MMA(1, 1, At, B1); PG8_BAR; PG8_SCHED;
        }
        if (wr == 0) PG8_BAR;
        { int l_ = tid; asm volatile("" : "+v"(l_)); const int fr_ = l_ & 15, fq_ = (l_ >> 4) & 3;
          E(acc, cur, wr, wc, fr_, fq_);
          if constexpr (Epi::INIT) { if (has_next) E.init(acc, nxt, wr, wc, fr_, fq_); } }
        if (!has_next) break;
        cur = nxt; cA = nA; cB = nB; ++ui;
        if (wr == 1) PG8_BAR;
    }
    PG8_WAIT_V(0);
    PG8_BAR;
#undef PG8_SA
#undef PG8_SB
#undef PG8_STAGE
#undef PG8_LDA
#undef PG8_LDB
#undef PG8_MMA
#undef PG8_WAIT_V
#undef PG8_WAIT_L
#undef PG8_BAR
#undef PG8_SCHED
}
}

namespace epi {
using pg8::Unit;
__device__ __forceinline__ float log2_gamma_w(int h) { return __builtin_amdgcn_logf(1.0f - __builtin_amdgcn_exp2f(-5.0f - (float)h)); }
typedef f32x4 Acc[2][2][4][2];
#define ACC_ZERO(acc) do { _Pragma("unroll") for (int a_ = 0; a_ < 2; ++a_) _Pragma("unroll") for (int b_ = 0; b_ < 2; ++b_) _Pragma("unroll") for (int m_ = 0; m_ < 4; ++m_) \
    _Pragma("unroll") for (int n_ = 0; n_ < 2; ++n_) acc[a_][b_][m_][n_] = (f32x4){0.f, 0.f, 0.f, 0.f}; } while (0)

__device__ __forceinline__ float dot4(const f32x4 a) { return (a[0] * a[0] + a[1] * a[1]) + (a[2] * a[2] + a[3] * a[3]); }
__device__ __forceinline__ u32x4 pack8(const f32x4 a, const f32x4 b) { u32x4 w; w.x = cvt_pk_bf16(a[0], a[1]); w.y = cvt_pk_bf16(a[2], a[3]); w.z = cvt_pk_bf16(b[0], b[1]); w.w = cvt_pk_bf16(b[2], b[3]); return w; }
constexpr int EPI_RSTD_OFF = 132096, EPI_GAIN_OFF = EPI_RSTD_OFF + 8 * 256 * 4, EPI_ROPE_OFF = EPI_GAIN_OFF + 4 * 64 * 4, EPI_END = EPI_ROPE_OFF + 128;
__device__ __forceinline__ void fill_rstd_table(LAS unsigned char* lds0, const int tid, const float* ssq, const pg8::StaticOrder& S) {
    LAS float* tab = (LAS float*)(lds0 + EPI_RSTD_OFF);
    const int row = tid >> 1, half = tid & 1;
    f32x4 a[8], b[8]; bool ok[8];
#pragma unroll
    for (int i = 0; i < 8; ++i) {
        Unit u; ok[i] = S.next(i, u);
        const float* p = ssq + ((size_t)(ok[i] ? u.pm : 0) * 256 + row) * 16 + half * 8;
        a[i] = *(const f32x4*)p; b[i] = *(const f32x4*)(p + 4);
    }
#pragma unroll
    for (int i = 0; i < 8; ++i) {
        float s = ((a[i][0] + a[i][1]) + (a[i][2] + a[i][3])) + ((b[i][0] + b[i][1]) + (b[i][2] + b[i][3])); s = xor_add<1>(s);
        if (half == 0 && ok[i]) tab[i * 256 + row] = __builtin_amdgcn_rsqf(s * (1.0f / DM) + EPS);
    }
}
__device__ __forceinline__ float row_rstd(const LAS float* tab, int ui, int lrow) { return tab[ui * 256 + lrow]; }

struct EpiNull {
    static constexpr bool INIT = false;
    __device__ __forceinline__ void operator()(Acc& acc, const Unit& u, int wr, int wc, int fr, int fq) const {
#pragma unroll
        for (int ai = 0; ai < 2; ++ai)
#pragma unroll
            for (int bj = 0; bj < 2; ++bj)
#pragma unroll
                for (int m = 0; m < 4; ++m) { asm volatile("" : "+v"(acc[ai][bj][m][0]), "+v"(acc[ai][bj][m][1])); }
        ACC_ZERO(acc);
    }
};
struct EpiUp {
    static constexpr bool INIT = false;
    bf16_t* H; const LAS float* rst;
    __device__ __forceinline__ void operator()(Acc& acc, const Unit& u, int wr, int wc, int fr, int fq) const {
#pragma unroll
        for (int ai = 0; ai < 2; ++ai)
#pragma unroll
            for (int m = 0; m < 4; ++m) {
                const int lrow = ai * 128 + wr * 64 + m * 16 + fr, row = u.pm * 256 + lrow;
                const float rs = row_rstd(rst, u.ui, lrow);
                f32x4 h0, h1;
#pragma unroll
                for (int j = 0; j < 4; ++j) { h0[j] = silu_f(acc[ai][0][m][0][j] * rs) * (acc[ai][1][m][0][j] * rs); h1[j] = silu_f(acc[ai][0][m][1][j] * rs) * (acc[ai][1][m][1][j] * rs); }
                *(u32x4*)(H + (size_t)row * DFF + u.pn * 128 + wc * 32 + 8 * fq) = pack8(h0, h1);
            }
        ACC_ZERO(acc);
    }
};

struct EpiRes {
    static constexpr bool INIT = true;
    const float* xold; float* xnew; bf16_t* xb; float* ssq; float s;
    __device__ __forceinline__ void init(Acc& acc, const Unit& u, int wr, int wc, int fr, int fq) const {
        const float is = 1.0f / s;
#pragma unroll
        for (int ai = 0; ai < 2; ++ai)
#pragma unroll
            for (int m = 0; m < 4; ++m)
#pragma unroll
                for (int bj = 0; bj < 2; ++bj) { const size_t off = (size_t)(u.pm * 256 + ai * 128 + wr * 64 + m * 16 + fr) * DM + u.pn * 256 + bj * 128 + wc * 32 + 8 * fq;
                    acc[ai][bj][m][0] = *(const f32x4*)(xold + off) * is; acc[ai][bj][m][1] = *(const f32x4*)(xold + off + 4) * is; }
    }
    __device__ __forceinline__ void operator()(Acc& acc, const Unit& u, int wr, int wc, int fr, int fq) const {
#pragma unroll
        for (int ai = 0; ai < 2; ++ai)
#pragma unroll
            for (int m = 0; m < 4; ++m) {
                const int row = u.pm * 256 + ai * 128 + wr * 64 + m * 16 + fr; float ss = 0.f;
#pragma unroll
                for (int bj = 0; bj < 2; ++bj) {
                    const size_t off = (size_t)row * DM + u.pn * 256 + bj * 128 + wc * 32 + 8 * fq;
                    const f32x4 v0 = acc[ai][bj][m][0] * s, v1 = acc[ai][bj][m][1] * s;
                    *(f32x4*)(xnew + off) = v0; *(f32x4*)(xnew + off + 4) = v1;
                    *(u32x4*)(xb + off) = pack8(v0, v1);
                    ss += dot4(v0) + dot4(v1);
                }
                ss = xor_add<16>(ss); ss = xor_add<32>(ss);
                if (fq == 0) ssq[(size_t)row * 16 + u.pn * 4 + wc] = ss;
            }
        ACC_ZERO(acc);
    }
};

struct EpiGate {
    static constexpr bool INIT = false;
    bf16_t* G; const LAS float* rst;
    __device__ __forceinline__ void operator()(Acc& acc, const Unit& u, int wr, int wc, int fr, int fq) const {
#pragma unroll
        for (int ai = 0; ai < 2; ++ai)
#pragma unroll
            for (int m = 0; m < 4; ++m) {
                const int lrow = ai * 128 + wr * 64 + m * 16 + fr, row = u.pm * 256 + lrow;
                const float rs = row_rstd(rst, u.ui, lrow);
#pragma unroll
                for (int bj = 0; bj < 2; ++bj) { f32x4 g0, g1;
#pragma unroll
                    for (int j = 0; j < 4; ++j) { g0[j] = fmaxf(sigmoid_f(acc[ai][bj][m][0][j] * rs), 9.5367431640625e-07f); g1[j] = fmaxf(sigmoid_f(acc[ai][bj][m][1][j] * rs), 9.5367431640625e-07f); }
                    *(u32x4*)(G + (size_t)row * NGATE + u.sub * 1024 + u.pn * 256 + bj * 128 + wc * 32 + 8 * fq) = pack8(g0, g1); }
            }
        ACC_ZERO(acc);
    }
};

struct EpiMerge {
    static constexpr bool INIT = false;
    const bf16_t* G; bf16_t* MG; const unsigned* ones;
    __device__ __forceinline__ void operator()(Acc& acc, const Unit& u, int wr, int wc, int fr, int fq) const {
        const int sub = u.sub; const bool chain = sub < 2;
        const char* gb = (const char*)(G + (size_t)u.pm * 256 * NGATE + sub * 1024 + u.pn * 256);
        const char* nb = chain ? gb + 2048 : (const char*)ones; const unsigned nmask = chain ? 0xffffffffu : 0u;
        const unsigned go = (unsigned)((wr * 64 + fr) * NGATE + wc * 32 + 8 * fq) * 2u;
#pragma unroll
        for (int ai = 0; ai < 2; ++ai)
#pragma unroll
            for (int mh = 0; mh < 2; ++mh) {
                u32x4 gc[2][2], gn[2][2];
#pragma unroll
                for (int m2 = 0; m2 < 2; ++m2)
#pragma unroll
                    for (int bj = 0; bj < 2; ++bj) { const unsigned o = go + (unsigned)(((ai * 128 + (2 * mh + m2) * 16) * NGATE + bj * 128) * 2);
                        gc[m2][bj] = *(const u32x4*)(gb + o); gn[m2][bj] = *(const u32x4*)(nb + (o & nmask)); }
                asm volatile("" ::: "memory");
#pragma unroll
                for (int m2 = 0; m2 < 2; ++m2)
#pragma unroll
                    for (int bj = 0; bj < 2; ++bj) { const u32x4 c = gc[m2][bj], n = gn[m2][bj]; const int m = 2 * mh + m2;
                        const f32x4 c0 = {bflo(c.x), bfhi(c.x), bflo(c.y), bfhi(c.y)}, c1 = {bflo(c.z), bfhi(c.z), bflo(c.w), bfhi(c.w)};
                        const f32x4 n0 = {bflo(n.x), bfhi(n.x), bflo(n.y), bfhi(n.y)}, n1 = {bflo(n.z), bfhi(n.z), bflo(n.w), bfhi(n.w)};
#pragma unroll
                        for (int j = 0; j < 4; ++j) { acc[ai][bj][m][0][j] *= c0[j] * fast_rcp(n0[j]); acc[ai][bj][m][1][j] *= c1[j] * fast_rcp(n1[j]); } }
                asm volatile("" ::: "memory");
            }
        if (!chain) {
            char* mb = (char*)(MG + (size_t)u.pm * 256 * DM + u.pn * 256);
            const unsigned mo = (unsigned)((wr * 64 + fr) * DM + wc * 32 + 8 * fq) * 2u;
#pragma unroll
            for (int ai = 0; ai < 2; ++ai)
#pragma unroll
                for (int m = 0; m < 4; ++m)
#pragma unroll
                    for (int bj = 0; bj < 2; ++bj)
                        *(u32x4*)(mb + mo + (unsigned)(((ai * 128 + m * 16) * DM + bj * 128) * 2)) = pack8(acc[ai][bj][m][0], acc[ai][bj][m][1]);
            ACC_ZERO(acc);
        }
    }
};

enum { F_NORM = 1, F_ROPE = 2, F_C2 = 4, F_CKD = 8, F_SILU = 16 };
struct EpiWin {
    static constexpr bool INIT = false;
    unsigned char* ws; const LAS float* rst; const LAS float* gtab; const LAS float* rtab;
    template <int FLAGS>
    __device__ __forceinline__ void body(Acc& acc, const Unit& u, int wr, int wc, int fr, int fq, bf16_t* out, int pitch, int colbase, int gk) const {
        f32x4 gA0 = {1.f, 1.f, 1.f, 1.f}, gA1 = gA0, gB0 = gA0, gB1 = gA0;
        if (FLAGS & F_NORM) { const LAS float* gain = gtab + gk * 64; gA0 = *(const LAS f32x4*)(gain + 8 * fq); gA1 = *(const LAS f32x4*)(gain + 8 * fq + 4); gB0 = *(const LAS f32x4*)(gain + 32 + 8 * fq); gB1 = *(const LAS f32x4*)(gain + 36 + 8 * fq); }
        f32x4 rc0 = {0.f, 0.f, 0.f, 0.f}, rc1 = rc0;
        if (FLAGS & F_ROPE) { rc0 = *(const LAS f32x4*)(rtab + 8 * fq); rc1 = *(const LAS f32x4*)(rtab + 8 * fq + 4); }
        const float l2g = (FLAGS & F_CKD) ? log2_gamma_w(wc) : 0.f;
#pragma unroll
        for (int ai = 0; ai < 2; ++ai)
#pragma unroll
            for (int m = 0; m < 4; ++m) {
                const int lrow = ai * 128 + wr * 64 + m * 16 + fr, row = u.pm * 256 + lrow, t = row & (SEQ - 1);
                const float rs = row_rstd(rst, u.ui, lrow);
                f32x4 a0 = acc[ai][0][m][0] * rs, a1 = acc[ai][0][m][1] * rs, b0 = acc[ai][1][m][0] * rs, b1 = acc[ai][1][m][1] * rs;
                if (FLAGS & F_NORM) {
                    float ss = (dot4(a0) + dot4(a1)) + (dot4(b0) + dot4(b1)); ss = xor_add<16>(ss); ss = xor_add<32>(ss);
                    const float r = __builtin_amdgcn_rsqf(ss * (1.0f / 64.0f) + EPS);
                    a0 = a0 * gA0 * r; a1 = a1 * gA1 * r; b0 = b0 * gB0 * r; b1 = b1 * gB1 * r;
                }
                if (FLAGS & F_ROPE) {
                    const float tf = (float)t; f32x4 c0, c1, s0, s1;
#pragma unroll
                    for (int j = 0; j < 4; ++j) { const float r0 = __builtin_amdgcn_fractf(tf * rc0[j]), r1 = __builtin_amdgcn_fractf(tf * rc1[j]);
                        c0[j] = __builtin_amdgcn_cosf(r0); s0[j] = __builtin_amdgcn_sinf(r0); c1[j] = __builtin_amdgcn_cosf(r1); s1[j] = __builtin_amdgcn_sinf(r1); }
                    const f32x4 na0 = a0 * c0 - b0 * s0, nb0 = b0 * c0 + a0 * s0, na1 = a1 * c1 - b1 * s1, nb1 = b1 * c1 + a1 * s1;
                    a0 = na0; b0 = nb0; a1 = na1; b1 = nb1;
                }
                if (FLAGS & (F_C2 | F_CKD)) {
                    const float sc = (FLAGS & F_C2) ? C2 : 0.125f * fast_exp2(-(float)(t & 63) * l2g);
                    a0 = a0 * sc; a1 = a1 * sc; b0 = b0 * sc; b1 = b1 * sc;
                }
                if (FLAGS & F_SILU) {
#pragma unroll
                    for (int j = 0; j < 4; ++j) { a0[j] = silu_f(a0[j]); a1[j] = silu_f(a1[j]); b0[j] = silu_f(b0[j]); b1[j] = silu_f(b1[j]); }
                }
                bf16_t* o = out + (size_t)row * pitch + colbase + 64 * wc + 8 * fq;
                *(u32x4*)o = pack8(a0, a1); *(u32x4*)(o + 32) = pack8(b0, b1);
            }
        ACC_ZERO(acc);
    }
    __device__ __forceinline__ void operator()(Acc& acc, const Unit& u, int wr, int wc, int fr, int fq) const {
        const int pn = u.pn;
        if (pn < 2)        body<F_NORM | F_ROPE | F_C2>(acc, u, wr, wc, fr, fq, (bf16_t*)(ws + WS_AQ), 512, 256 * pn, 0);
        else if (pn < 4)   body<F_NORM | F_ROPE>(acc, u, wr, wc, fr, fq, (bf16_t*)(ws + WS_AK), 512, 256 * (pn - 2), 1);
        else if (pn < 6)   body<0>(acc, u, wr, wc, fr, fq, (bf16_t*)(ws + WS_AV), 512, 256 * (pn - 4), 0);
        else if (pn < 8)   body<F_NORM | F_C2>(acc, u, wr, wc, fr, fq, (bf16_t*)(ws + WS_BQ), 512, 256 * (pn - 6), 2);
        else if (pn < 10)  body<F_NORM>(acc, u, wr, wc, fr, fq, (bf16_t*)(ws + WS_BK), 512, 256 * (pn - 8), 3);
        else if (pn < 12)  body<0>(acc, u, wr, wc, fr, fq, (bf16_t*)(ws + WS_BV), 512, 256 * (pn - 10), 0);
        else if (pn == 12) body<F_ROPE>(acc, u, wr, wc, fr, fq, (bf16_t*)(ws + WS_CQ), 256, 0, 0);
        else if (pn == 13) body<F_ROPE | F_CKD>(acc, u, wr, wc, fr, fq, (bf16_t*)(ws + WS_CK), 256, 0, 0);
        else if (pn < 16)  body<0>(acc, u, wr, wc, fr, fq, (bf16_t*)(ws + WS_CV), 512, 256 * (pn - 14), 0);
        else               body<F_SILU>(acc, u, wr, wc, fr, fq, (bf16_t*)(ws + WS_CG), 512, 256 * (pn - 16), 0);
    }
};
}

__device__ __forceinline__ float log2_gamma(int h) { return __builtin_amdgcn_logf(1.0f - __builtin_amdgcn_exp2f(-5.0f - (float)h)); }

namespace naive {
struct ANorm {
    const float* x; const float* gain; const LAS float* rs; int m0;
    __device__ __forceinline__ float get(int m, int k) const { return x[(size_t)m * DM + k] * rs[m - m0] * gain[k]; }
};
struct ABf {
    const bf16_t* a; int pitch;
    __device__ __forceinline__ float get(int m, int k) const { return bf2f(a[(size_t)m * pitch + k]); }
};
template <int NB, bool SHARED_A, bool NORM, int RT, class Epi>
__device__ __forceinline__ void gemm(LAS unsigned char* lds, const int tid, int vcu, int G, int N, int K,
                                     const float* x, const float* gain, const bf16_t* a0, const bf16_t* a1, const bf16_t* a2, int apitch,
                                     const float* w0, const float* w1, const float* w2, int ldb, const Epi& E) {
    constexpr int NA = SHARED_A ? 1 : NB;
    LAS float* As = (LAS float*)lds;
    LAS float* Bs = As + NA * 16 * 132;
    LAS float* rs = Bs + NB * 16 * 128;
    const int tx = tid & 15, ty = tid >> 4, lane = tid & 63, wave = tid >> 6;
    constexpr int TM = 32 * RT;
    const int ntn = N / 128, ntiles = (M / TM) * ntn;
    for (int tile = vcu; tile < ntiles; tile += G) {
        const int m0 = (tile / ntn) * TM, n0 = (tile % ntn) * 128;
        __syncthreads();
        if (NORM) {
            for (int r = wave * (TM / 8); r < wave * (TM / 8) + TM / 8; ++r) {
                const float* xr = x + (size_t)(m0 + r) * DM; float s = 0.f;
                for (int k = lane; k < DM; k += 64) { const float v = xr[k]; s += v * v; }
                s = wave_sum(s);
                if (lane == 0) rs[r] = 1.0f / sqrtf(s * (1.0f / DM) + EPS);
            }
            __syncthreads();
        }
        float acc[NB][RT][8];
#pragma unroll
        for (int b = 0; b < NB; ++b)
#pragma unroll
            for (int i = 0; i < RT; ++i)
#pragma unroll
                for (int j = 0; j < 8; ++j) acc[b][i][j] = 0.f;
        for (int k0 = 0; k0 < K; k0 += 16) {
            {
                const int r = tid >> 2, kq = (tid & 3) * 4;
                if (r < TM)
#pragma unroll
                for (int b = 0; b < NA; ++b)
#pragma unroll
                    for (int i = 0; i < 4; ++i) {
                        float v;
                        if (NORM) v = x[(size_t)(m0 + r) * DM + k0 + kq + i] * rs[r] * gain[k0 + kq + i];
                        else { const bf16_t* ap = (b == 0 ? a0 : (b == 1 ? a1 : a2)); v = bf2f(ap[(size_t)(m0 + r) * apitch + k0 + kq + i]); }
                        As[(b * 16 + kq + i) * 132 + r] = v;
                    }
                const int kb = tid >> 5, n4 = (tid & 31) * 4;
#pragma unroll
                for (int b = 0; b < NB; ++b) { const float* wp = (b == 0 ? w0 : (b == 1 ? w1 : w2));
                    const f32x4 v = *(const f32x4*)(wp + (size_t)(k0 + kb) * ldb + n0 + n4);
                    *(LAS f32x4*)(Bs + (b * 16 + kb) * 128 + n4) = v; }
            }
            __syncthreads();
#pragma unroll
            for (int kk = 0; kk < 16; ++kk) {
#pragma unroll
                for (int b = 0; b < NB; ++b) {
                    const int ab = SHARED_A ? 0 : b;
                    float av[RT];
#pragma unroll
                    for (int i = 0; i < RT; ++i) av[i] = As[(ab * 16 + kk) * 132 + ty * RT + i];
                    const f32x4 b0 = *(const LAS f32x4*)(Bs + (b * 16 + kk) * 128 + tx * 8), b1 = *(const LAS f32x4*)(Bs + (b * 16 + kk) * 128 + tx * 8 + 4);
#pragma unroll
                    for (int i = 0; i < RT; ++i)
#pragma unroll
                        for (int j = 0; j < 4; ++j) { acc[b][i][j] += av[i] * b0[j]; acc[b][i][4 + j] += av[i] * b1[j]; }
                }
            }
            __syncthreads();
        }
#pragma unroll
        for (int i = 0; i < RT; ++i) E(m0 + ty * RT + i, n0 + tx * 8, acc, i, tx);
    }
}

__device__ __forceinline__ void xb_ssq_pass(const float* x, bf16_t* xb, float* ssq, int gw, int ngw, int lane) {
    for (int m0 = gw * 4; m0 < M; m0 += ngw * 4) {
        f32x4 v[4][4];
#pragma unroll
        for (int r = 0; r < 4; ++r)
#pragma unroll
            for (int j = 0; j < 4; ++j) v[r][j] = ((const f32x4*)(x + (size_t)(m0 + r) * DM) + lane)[64 * j];
#pragma unroll
        for (int r = 0; r < 4; ++r) {
            float s = 0.f; u32x2* o = (u32x2*)(xb + (size_t)(m0 + r) * DM) + lane;
#pragma unroll
            for (int j = 0; j < 4; ++j) { const f32x4 w4 = v[r][j]; s += (w4[0] * w4[0] + w4[1] * w4[1]) + (w4[2] * w4[2] + w4[3] * w4[3]); u32x2 w; w.x = pk2(w4[0], w4[1]); w.y = pk2(w4[2], w4[3]); o[64 * j] = w; }
            s = wave_sum(s);
            if (lane < 16) ssq[(size_t)(m0 + r) * 16 + lane] = (lane == 0) ? s : 0.f;
        }
    }
}

struct NEpiUp { bf16_t* H;
    __device__ __forceinline__ void operator()(int m, int n, const float (&acc)[2][4][8], int i, int tx) const {
#pragma unroll
        for (int j = 0; j < 8; ++j) { const float g = acc[0][i][j], u = acc[1][i][j]; H[(size_t)m * DFF + n + j] = (bf16_t)f2bf(g / (1.0f + expf(-g)) * u); } } };
struct NEpiRes { const float* xold; float* xnew; bf16_t* xb; float* ssq; float s;
    __device__ __forceinline__ void operator()(int m, int n, const float (&acc)[1][4][8], int i, int tx) const {
        float ss = 0.f;
#pragma unroll
        for (int j = 0; j < 8; ++j) { const float v = xold[(size_t)m * DM + n + j] + s * acc[0][i][j]; xnew[(size_t)m * DM + n + j] = v; xb[(size_t)m * DM + n + j] = (bf16_t)f2bf(v); ss += v * v; }
        ss += __shfl_xor(ss, 1); ss += __shfl_xor(ss, 2); ss += __shfl_xor(ss, 4); ss += __shfl_xor(ss, 8);
        if (tx == 0) { ssq[(size_t)m * 16 + (n >> 7)] = ss; ssq[(size_t)m * 16 + 8 + (n >> 7)] = 0.f; }
    } };
struct NEpiGate { bf16_t* G;
    __device__ __forceinline__ void operator()(int m, int n, const float (&acc)[1][4][8], int i, int tx) const {
#pragma unroll
        for (int j = 0; j < 8; ++j) G[(size_t)m * NGATE + n + j] = (bf16_t)f2bf(fmaxf(1.0f / (1.0f + expf(-acc[0][i][j])), 9.5367431640625e-07f)); } };
struct NEpiMerge { const bf16_t* G; bf16_t* MG;
    __device__ __forceinline__ void operator()(int m, int n, const float (&acc)[3][2][8], int i, int tx) const {
#pragma unroll
        for (int j = 0; j < 8; ++j) { const size_t go = (size_t)m * NGATE + n + j;
            const float v = bf2f(G[go]) * acc[0][i][j] + bf2f(G[go + 1024]) * acc[1][i][j] + bf2f(G[go + 2048]) * acc[2][i][j];
            MG[(size_t)m * DM + n + j] = (bf16_t)f2bf(v); } } };
struct NEpiWin { unsigned char* ws; const float* cosT; const float* sinT; const float *aqn, *akn, *bqn, *bkn;
    __device__ __forceinline__ void operator()(int m, int n, const float (&acc)[1][4][8], int i, int tx) const {
        size_t obase; int pitch, c0, flags; const float* gain = nullptr;
        if (n < 512)       { obase = WS_AQ; pitch = 512; c0 = 0;    flags = epi::F_NORM | epi::F_ROPE | epi::F_C2; gain = aqn; }
        else if (n < 1024) { obase = WS_AK; pitch = 512; c0 = 512;  flags = epi::F_NORM | epi::F_ROPE; gain = akn; }
        else if (n < 1536) { obase = WS_AV; pitch = 512; c0 = 1024; flags = 0; }
        else if (n < 2048) { obase = WS_BQ; pitch = 512; c0 = 1536; flags = epi::F_NORM | epi::F_C2; gain = bqn; }
        else if (n < 2560) { obase = WS_BK; pitch = 512; c0 = 2048; flags = epi::F_NORM; gain = bkn; }
        else if (n < 3072) { obase = WS_BV; pitch = 512; c0 = 2560; flags = 0; }
        else if (n < 3328) { obase = WS_CQ; pitch = 256; c0 = 3072; flags = epi::F_ROPE; }
        else if (n < 3584) { obase = WS_CK; pitch = 256; c0 = 3328; flags = epi::F_ROPE | epi::F_CKD; }
        else if (n < 4096) { obase = WS_CV; pitch = 512; c0 = 3584; flags = 0; }
        else               { obase = WS_CG; pitch = 512; c0 = 4096; flags = epi::F_SILU; }
        const int t = m & (SEQ - 1), d0 = n & 63; float v[8];
#pragma unroll
        for (int j = 0; j < 8; ++j) v[j] = acc[0][i][j];
        if (flags & epi::F_NORM) { float ss = 0.f;
#pragma unroll
            for (int j = 0; j < 8; ++j) ss += v[j] * v[j];
            ss += __shfl_xor(ss, 1); ss += __shfl_xor(ss, 2); ss += __shfl_xor(ss, 4);
            const float r = 1.0f / sqrtf(ss * (1.0f / 64.0f) + EPS);
#pragma unroll
            for (int j = 0; j < 8; ++j) v[j] = v[j] * r * gain[d0 + j]; }
        if (flags & epi::F_ROPE) {
#pragma unroll
            for (int j = 0; j < 8; ++j) { const float p = __shfl_xor(v[j], 4); const int d = d0 + j, ii = d & 31; const float c = cosT[t * 32 + ii], s = sinT[t * 32 + ii];
                v[j] = (d < 32) ? (v[j] * c - p * s) : (v[j] * c + p * s); } }
        float sc = 1.0f;
        if (flags & epi::F_C2) sc = C2;
        if (flags & epi::F_CKD) sc = 0.125f * exp2f(-(float)(t & 63) * log2_gamma((n - 3328) >> 6));
        bf16_t* o = (bf16_t*)(ws + obase) + (size_t)m * pitch + (n - c0);
#pragma unroll
        for (int j = 0; j < 8; ++j) { float y = v[j] * sc; if (flags & epi::F_SILU) y = y / (1.0f + expf(-y)); o[j] = (bf16_t)f2bf(y); }
    } };

__device__ __forceinline__ void attn_a(unsigned char* ws, const float* lq1, const float* lk1, const float* lq2, const float* lk2, const float* subln, float lam_init,
                                       LAS unsigned char* lds, int gw, int ngw, int wave, int lane) {
    const bf16_t* AQ = (const bf16_t*)(ws + WS_AQ); const bf16_t* AK = (const bf16_t*)(ws + WS_AK); const bf16_t* AV = (const bf16_t*)(ws + WS_AV); bf16_t* YA = (bf16_t*)(ws + WS_AQ);
    const float lam = expf(wave_sum(lq1[lane] * lk1[lane])) - expf(wave_sum(lq2[lane] * lk2[lane])) + lam_init;
    LAS float* qs = (LAS float*)lds + wave * 128;
    for (int task = gw; task < M * 4; task += ngw) {
        const int h = task & 3, m = task >> 2, b = m >> 13, t = m & (SEQ - 1), nch = (t >> 6) + 1;
        qs[lane] = bf2f(AQ[(size_t)m * 512 + h * 128 + lane]); qs[64 + lane] = bf2f(AQ[(size_t)m * 512 + h * 128 + 64 + lane]);
        LDS_WAIT(); asm volatile("" ::: "memory");
        float mx[2] = {-1e30f, -1e30f}, l[2] = {0.f, 0.f}, o[2][2] = {{0.f, 0.f}, {0.f, 0.f}};
        for (int c = 0; c < nch; ++c) {
            const size_t krow = (size_t)(b * SEQ + c * 64 + lane);
            float s[2] = {0.f, 0.f};
            for (int cc = 0; cc < 2; ++cc) { const u32x4* kp = (const u32x4*)(AK + krow * 512 + h * 128 + cc * 64);
                for (int q = 0; q < 8; ++q) { const u32x4 w = kp[q]; const LAS float* qq = qs + cc * 64 + q * 8;
                    s[cc] += bflo(w.x) * qq[0] + bfhi(w.x) * qq[1] + bflo(w.y) * qq[2] + bfhi(w.y) * qq[3] + bflo(w.z) * qq[4] + bfhi(w.z) * qq[5] + bflo(w.w) * qq[6] + bfhi(w.w) * qq[7]; } }
            float p[2];
            for (int cc = 0; cc < 2; ++cc) { const float mn = fmaxf(mx[cc], wave_max(s[cc])), f = exp2f(mx[cc] - mn); mx[cc] = mn; p[cc] = exp2f(s[cc] - mn);
                l[cc] = l[cc] * f + wave_sum(p[cc]); o[cc][0] *= f; o[cc][1] *= f; }
            for (int j = 0; j < 64; ++j) { const float p0 = __shfl(p[0], j), p1 = __shfl(p[1], j); const size_t vrow = (size_t)(b * SEQ + c * 64 + j) * 512 + h * 128;
                const float v0 = bf2f(AV[vrow + lane]), v1 = bf2f(AV[vrow + 64 + lane]);
                o[0][0] += p0 * v0; o[0][1] += p0 * v1; o[1][0] += p1 * v0; o[1][1] += p1 * v1; }
        }
        const float y0 = o[0][0] / l[0] - lam * o[1][0] / l[1], y1 = o[0][1] / l[0] - lam * o[1][1] / l[1];
        const float r = 1.0f / sqrtf(wave_sum(y0 * y0 + y1 * y1) * (1.0f / 128.0f) + EPS) * (1.0f - lam_init);
        YA[(size_t)m * 512 + h * 128 + lane] = (bf16_t)f2bf(y0 * r * subln[lane]); YA[(size_t)m * 512 + h * 128 + 64 + lane] = (bf16_t)f2bf(y1 * r * subln[64 + lane]);
        asm volatile("" ::: "memory");
    }
}
__device__ __forceinline__ void attn_b(unsigned char* ws, const float* relb, LAS unsigned char* lds, int gw, int ngw, int wave, int lane) {
    const bf16_t* BQ = (const bf16_t*)(ws + WS_BQ); const bf16_t* BK = (const bf16_t*)(ws + WS_BK); const bf16_t* BV = (const bf16_t*)(ws + WS_BV); bf16_t* YB = (bf16_t*)(ws + WS_BQ);
    LAS float* qs = (LAS float*)lds + wave * 128;
    for (int task = gw; task < M * 8; task += ngw) {
        const int h = task & 7, m = task >> 3, b = m >> 13, t = m & (SEQ - 1), n = t >> 6;
        qs[lane] = bf2f(BQ[(size_t)m * 512 + h * 64 + lane]);
        LDS_WAIT(); asm volatile("" ::: "memory");
        float mx = -1e30f, l = 0.f, o = 0.f;
        for (int c = (n >= 8 ? n - 8 : 0); c <= n; ++c) {
            const int kpos = c * 64 + lane; const size_t krow = (size_t)(b * SEQ + kpos);
            float s = 0.f; const u32x4* kp = (const u32x4*)(BK + krow * 512 + h * 64);
            for (int q = 0; q < 8; ++q) { const u32x4 w = kp[q]; const LAS float* qq = qs + q * 8;
                s += bflo(w.x) * qq[0] + bfhi(w.x) * qq[1] + bflo(w.y) * qq[2] + bfhi(w.y) * qq[3] + bflo(w.z) * qq[4] + bfhi(w.z) * qq[5] + bflo(w.w) * qq[6] + bfhi(w.w) * qq[7]; }
            int rel = t - kpos; rel = rel < -63 ? -63 : (rel > 256 ? 256 : rel);
            s += relb[h * 320 + rel + 63] * LOG2E;
            const float mn = fmaxf(mx, wave_max(s)), f = exp2f(mx - mn); mx = mn; const float p = exp2f(s - mn);
            l = l * f + wave_sum(p); o *= f;
            for (int j = 0; j < 64; ++j) o += __shfl(p, j) * bf2f(BV[(size_t)(b * SEQ + c * 64 + j) * 512 + h * 64 + lane]);
        }
        YB[(size_t)m * 512 + h * 64 + lane] = (bf16_t)f2bf(o / l);
        asm volatile("" ::: "memory");
    }
}
__device__ __forceinline__ void retention(unsigned char* ws, const float* onorm, LAS unsigned char* lds, int vcu, int G, int tid) {
    const bf16_t* CQ = (const bf16_t*)(ws + WS_CQ); const bf16_t* CK = (const bf16_t*)(ws + WS_CK); const bf16_t* CV = (const bf16_t*)(ws + WS_CV); bf16_t* CG = (bf16_t*)(ws + WS_CG);
    LAS float* qs = (LAS float*)lds; LAS float* ks = qs + 64 * 64; LAS float* vs = ks + 64 * 64; LAS float* os = vs + 64 * 128;
    for (int bh = vcu; bh < 8; bh += G) {
        const int b = bh >> 2, h = bh & 3; const float l2g = log2_gamma(h), gam = exp2f(l2g);
        float S[64];
#pragma unroll
        for (int d = 0; d < 64; ++d) S[d] = 0.f;
        for (int n = 0; n < SEQ / 64; ++n) {
            __syncthreads();
            for (int i = tid; i < 64 * 64; i += 512) { const int r = i >> 6, d = i & 63; const size_t row = (size_t)(b * SEQ + n * 64 + r);
                qs[i] = bf2f(CQ[row * 256 + h * 64 + d]); ks[i] = bf2f(CK[row * 256 + h * 64 + d]) * exp2f((float)r * l2g); }
            for (int i = tid; i < 64 * 128; i += 512) { const int r = i >> 7, e = i & 127; vs[i] = bf2f(CV[(size_t)(b * SEQ + n * 64 + r) * 512 + h * 128 + e]); }
            __syncthreads();
            if (tid < 128) {
                for (int r = 0; r < 64; ++r) { const float v = vs[r * 128 + tid]; float o = 0.f;
#pragma unroll
                    for (int d = 0; d < 64; ++d) { S[d] = gam * S[d] + ks[r * 64 + d] * v; o += qs[r * 64 + d] * S[d]; }
                    os[r * 128 + tid] = o; }
            }
            __syncthreads();
            { const int r = tid >> 3, e0 = (tid & 7) * 16; float ss = 0.f;
#pragma unroll
              for (int j = 0; j < 16; ++j) { const float v = os[r * 128 + e0 + j]; ss += v * v; }
              ss += __shfl_xor(ss, 1); ss += __shfl_xor(ss, 2); ss += __shfl_xor(ss, 4);
              const float rr = 1.0f / sqrtf(ss * (1.0f / 128.0f) + EPS); bf16_t* g = CG + (size_t)(b * SEQ + n * 64 + r) * 512 + h * 128 + e0;
#pragma unroll
              for (int j = 0; j < 16; ++j) g[j] = (bf16_t)f2bf(bf2f(g[j]) * os[r * 128 + e0 + j] * rr * onorm[h * 128 + e0 + j]); }
        }
    }
}
}

namespace fa {
typedef short s16x4 __attribute__((ext_vector_type(4)));
typedef short v4i16_t __attribute__((ext_vector_type(4)));
typedef LAS const unsigned char* lds_cptr;
constexpr int SLOTB = 32768, NSLOT = 3, KOFF = 0, VOFF = 16384;
constexpr int LDS_WS = NSLOT * SLOTB, LDS_BIAS = LDS_WS + 2048, LDS_END = LDS_BIAS + 2560;
constexpr float THR = 8.0f;
__device__ __forceinline__ int crow(int r, int hi) { return (r & 3) + 8 * (r >> 2) + 4 * hi; }
__device__ __forceinline__ void glds16(const void* gsrc, unsigned lds_dst) { unsigned keep;
    asm volatile("s_mov_b32 %0, m0\n\ts_mov_b32 m0, %2\n\ts_nop 0\n\tglobal_load_lds_dwordx4 %1, off\n\ts_mov_b32 m0, %0" : "=&s"(keep) : "v"(gsrc), "s"(lds_dst) : "memory"); }
__device__ __forceinline__ void glds16s(const void* sbase, unsigned voff, unsigned lds_dst) { unsigned keep;
    asm volatile("s_mov_b32 %0, m0\n\ts_mov_b32 m0, %3\n\ts_nop 0\n\tglobal_load_lds_dwordx4 %1, %2\n\ts_mov_b32 m0, %0" : "=&s"(keep) : "v"(voff), "s"(sbase), "s"(lds_dst) : "memory"); }
#define FA_WAIT_BAR(N) asm volatile("s_waitcnt vmcnt(" #N ") lgkmcnt(0)\n\ts_barrier" ::: "memory")
#define FA_BAR() asm volatile("s_waitcnt lgkmcnt(0)\n\ts_barrier" ::: "memory")
__device__ __forceinline__ s16x4 vtr(lds_cptr p) { return __builtin_bit_cast(s16x4, __builtin_amdgcn_ds_read_tr16_b64_v4i16((LAS v4i16_t*)p)); }
__device__ __forceinline__ bf16x8 cat8(const s16x4 lo, const s16x4 hi) { return (bf16x8){lo[0], lo[1], lo[2], lo[3], hi[0], hi[1], hi[2], hi[3]}; }
__device__ __forceinline__ float swapmax(float m) { auto rr = __builtin_amdgcn_permlane32_swap(__float_as_uint(m), __float_as_uint(m), false, false); return fmaxf(__uint_as_float(rr[0]), __uint_as_float(rr[1])); }
__device__ __forceinline__ float swapsum(float m) { auto rr = __builtin_amdgcn_permlane32_swap(__float_as_uint(m), __float_as_uint(m), false, false); return __uint_as_float(rr[0]) + __uint_as_float(rr[1]); }
__device__ __forceinline__ bf16x8 pack_p(const f32x16& p, int base) { u32x4 w; w.x = cvt_pk_bf16(p[base], p[base + 1]); w.y = cvt_pk_bf16(p[base + 2], p[base + 3]); w.z = cvt_pk_bf16(p[base + 4], p[base + 5]); w.w = cvt_pk_bf16(p[base + 6], p[base + 7]); return __builtin_bit_cast(bf16x8, w); }
__device__ __forceinline__ float half_sum32(float v) {
    v = xor_add<1>(v); v = xor_add<2>(v); v = xor_add<4>(v); v = xor_add<8>(v); return xor_add<16>(v);
}

template <int MODE>
__device__ __forceinline__ void attn_unit(LAS unsigned char* lds, const int tid, const bf16_t* Qg, const bf16_t* Kg, const bf16_t* Vg, bf16_t* Yg, const int b, const int hq, const int u,
                                          const float lam, const float osc, const float* subln) {
    constexpr int PITCH = 512, NDB = (MODE == 0) ? 4 : 2;
    const int lane = tid & 63, r32 = lane & 31, hi = lane >> 5, wid = __builtin_amdgcn_readfirstlane(tid >> 6), ch = wid >> 2, wq = wid & 3;
    const int cw = 2 * u + (wq >> 1);
    const int t0 = (MODE == 0) ? 0 : ((2 * u - 8) > 0 ? (2 * u - 8) : 0), t1 = 2 * u + 1, NT = t1 - t0 + 1;
    const size_t rowbase = (size_t)b * SEQ;
    const bf16_t* Kb = Kg + rowbase * PITCH + hq * 128; const bf16_t* Vb = Vg + rowbase * PITCH + hq * 128;
    const unsigned lds0 = (unsigned)(uintptr_t)lds;
    LAS float* wsf = (LAS float*)(lds + LDS_WS) + wid * 64;
    const bf16_t* ksrc = Kb + (size_t)lane * PITCH + (2 * wid) * 8;
    const bf16_t* vsrc0 = Vb + (size_t)(16 * ((2 * wid) & 3) + (lane >> 2)) * PITCH + 32 * ((2 * wid) >> 2) + (lane & 3) * 8;
    const bf16_t* vsrc1 = Vb + (size_t)(16 * ((2 * wid + 1) & 3) + (lane >> 2)) * PITCH + 32 * ((2 * wid + 1) >> 2) + (lane & 3) * 8;
#define FA_DMA(t, slot) do { const size_t to_ = (size_t)(t) * 64 * PITCH; const unsigned sb_ = lds0 + (unsigned)(slot) * SLOTB; \
        glds16(ksrc + to_, (unsigned)__builtin_amdgcn_readfirstlane(sb_ + KOFF + (2 * wid) * 1024)); glds16(ksrc + to_ + 8, (unsigned)__builtin_amdgcn_readfirstlane(sb_ + KOFF + (2 * wid + 1) * 1024)); \
        glds16(vsrc0 + to_, (unsigned)__builtin_amdgcn_readfirstlane(sb_ + VOFF + (2 * wid) * 1024)); glds16(vsrc1 + to_, (unsigned)__builtin_amdgcn_readfirstlane(sb_ + VOFF + (2 * wid + 1) * 1024)); } while (0)
    FA_DMA(t0, 0);
    if (NT > 1) FA_DMA(t0 + 1, 1);
    const size_t qrow = rowbase + (size_t)u * 128 + wq * 32;
    bf16x8 qr[4];
#pragma unroll
    for (int i = 0; i < 4; ++i) qr[i] = *(const bf16x8*)(Qg + (qrow + r32) * PITCH + hq * 128 + ch * 64 + i * 16 + hi * 8);
    f32x16 o[NDB];
#pragma unroll
    for (int d = 0; d < NDB; ++d)
#pragma unroll
        for (int r = 0; r < 16; ++r) o[d][r] = 0.f;
    float mref = 0.f, lsum = 0.f; bool first = true;
    const lds_cptr kp0 = (lds_cptr)lds + KOFF + ch * 8192 + hi * 1024 + r32 * 16;
    const lds_cptr vp0 = (lds_cptr)lds + VOFF + ((MODE == 0) ? 0 : ch * 8192) + ((lane >> 4) & 1) * 32 + (lane & 3) * 8 + (4 * hi + ((lane & 15) >> 2)) * 64;
    int slot = 0;
    for (int i = 0; i < NT; ++i) {
        if (i + 1 < NT) FA_WAIT_BAR(4); else FA_WAIT_BAR(0);
        if (i + 2 < NT) { const int s2 = (slot == 0) ? 2 : slot - 1; FA_DMA(t0 + i + 2, s2); }
        const int t = t0 + i;
        const bool vis = (MODE == 0) ? (t <= cw) : (t <= cw && t + 8 >= cw);
        if (vis) {
            const lds_cptr kp = kp0 + slot * SLOTB; const lds_cptr vp = vp0 + slot * SLOTB;
            f32x16 p0, p1;
#pragma unroll
            for (int r = 0; r < 16; ++r) { p0[r] = 0.f; p1[r] = 0.f; }
#pragma unroll
            for (int k = 0; k < 4; ++k) {
                const bf16x8 ka = *(const LAS bf16x8*)(kp + k * 2048), kb = *(const LAS bf16x8*)(kp + k * 2048 + 512);
                p0 = __builtin_amdgcn_mfma_f32_32x32x16_bf16(ka, qr[k], p0, 0, 0, 0);
                p1 = __builtin_amdgcn_mfma_f32_32x32x16_bf16(kb, qr[k], p1, 0, 0, 0);
            }
            if (MODE == 1) {
                const LAS float* bt = (const LAS float*)(lds + LDS_BIAS) + ch * 320;
                const int relb = 64 * (cw - t) + 32 * (wq & 1) + r32 + 63;
                if (cw - t >= 5) { const float c = bt[319];
#pragma unroll
                    for (int r = 0; r < 16; ++r) { p0[r] += c; p1[r] += c; }
                } else {
#pragma unroll
                    for (int r = 0; r < 16; ++r) { const int i0 = relb - crow(r, hi), i1 = i0 - 32; p0[r] += bt[i0 > 319 ? 319 : i0]; p1[r] += bt[i1 > 319 ? 319 : i1]; }
                }
            }
            float rm = fmaxf(p0[0], p1[0]);
#pragma unroll
            for (int r = 1; r < 16; ++r) rm = fmaxf(rm, fmaxf(p0[r], p1[r]));
            rm = swapmax(rm);
            if (first) { mref = rm; first = false; }
            else if (__any(rm - mref > THR)) {
                const float dl = fmaxf(rm - mref, 0.f); mref += dl; const float f = fast_exp2(-dl); lsum *= f;
                if (hi == 0) wsf[r32] = f;
                LDS_WAIT();
#pragma unroll
                for (int r = 0; r < 16; ++r) { const float fr = wsf[crow(r, hi)];
#pragma unroll
                    for (int d = 0; d < NDB; ++d) o[d][r] *= fr; }
            }
            float sacc = 0.f;
#pragma unroll
            for (int r = 0; r < 16; ++r) { p0[r] = fast_exp2(p0[r] - mref); p1[r] = fast_exp2(p1[r] - mref); sacc += p0[r] + p1[r]; }
            lsum += sacc;
            const bf16x8 pa0 = pack_p(p0, 0), pa1 = pack_p(p0, 8), pa2 = pack_p(p1, 0), pa3 = pack_p(p1, 8);
#pragma unroll
            for (int d = 0; d < NDB; ++d) {
                const lds_cptr vd = vp + d * 4096;
                const bf16x8 v0 = cat8(vtr(vd), vtr(vd + 512)), v1 = cat8(vtr(vd + 1024), vtr(vd + 1024 + 512)), v2 = cat8(vtr(vd + 2048), vtr(vd + 2048 + 512)), v3 = cat8(vtr(vd + 3072), vtr(vd + 3072 + 512));
                o[d] = __builtin_amdgcn_mfma_f32_32x32x16_bf16(pa0, v0, o[d], 0, 0, 0);
                o[d] = __builtin_amdgcn_mfma_f32_32x32x16_bf16(pa1, v1, o[d], 0, 0, 0);
                o[d] = __builtin_amdgcn_mfma_f32_32x32x16_bf16(pa2, v2, o[d], 0, 0, 0);
                o[d] = __builtin_amdgcn_mfma_f32_32x32x16_bf16(pa3, v3, o[d], 0, 0, 0);
            }
        }
        slot = (slot == NSLOT - 1) ? 0 : slot + 1;
    }
    lsum = swapsum(lsum);
    if (hi == 0) wsf[32 + r32] = lsum;
    LDS_WAIT();
#pragma unroll
    for (int r = 0; r < 16; ++r) { const float il = fast_rcp(wsf[32 + crow(r, hi)]);
#pragma unroll
        for (int d = 0; d < NDB; ++d) o[d][r] *= il; }
    FA_BAR();
    if (MODE == 0) {
        LAS float* xf = (LAS float*)lds + (wid & 3) * 4096;
        if (ch == 1) {
#pragma unroll
            for (int d = 0; d < 4; ++d)
#pragma unroll
                for (int r = 0; r < 16; ++r) xf[(d * 16 + r) * 64 + lane] = o[d][r];
        }
        FA_BAR();
        if (ch == 0) {
            float ss[16];
#pragma unroll
            for (int r = 0; r < 16; ++r) ss[r] = 0.f;
#pragma unroll
            for (int d = 0; d < 4; ++d)
#pragma unroll
                for (int r = 0; r < 16; ++r) { const float y = o[d][r] - lam * xf[(d * 16 + r) * 64 + lane]; o[d][r] = y; ss[r] += y * y; }
            LAS bf16_t* stg = (LAS bf16_t*)(lds + 65536) + wid * 4096;
            float g[4];
#pragma unroll
            for (int d = 0; d < 4; ++d) g[d] = subln[32 * d + r32] * osc;
#pragma unroll
            for (int r = 0; r < 16; ++r) { const float rs = __builtin_amdgcn_rsqf(half_sum32(ss[r]) * (1.0f / 128.0f) + EPS); const int orow = crow(r, hi);
#pragma unroll
                for (int d = 0; d < 4; ++d) stg[orow * 128 + d * 32 + r32] = (bf16_t)f2bf(o[d][r] * rs * g[d]); }
            LDS_WAIT();
#pragma unroll
            for (int i = 0; i < 8; ++i) { const int idx = i * 64 + lane, row = idx >> 4, c8 = idx & 15;
                const u32x4 v = *(const LAS u32x4*)(stg + row * 128 + c8 * 8);
                *(u32x4*)(Yg + (qrow + row) * PITCH + hq * 128 + c8 * 8) = v; }
        }
    } else {
        LAS bf16_t* stg = (LAS bf16_t*)lds + wid * 2048;
#pragma unroll
        for (int r = 0; r < 16; ++r) { const int orow = crow(r, hi);
#pragma unroll
            for (int d = 0; d < 2; ++d) stg[orow * 64 + d * 32 + r32] = (bf16_t)f2bf(o[d][r]); }
        LDS_WAIT();
#pragma unroll
        for (int i = 0; i < 4; ++i) { const int idx = i * 64 + lane, row = idx >> 3, c8 = idx & 7;
            const u32x4 v = *(const LAS u32x4*)(stg + row * 64 + c8 * 8);
            *(u32x4*)(Yg + (qrow + row) * PITCH + hq * 128 + ch * 64 + c8 * 8) = v; }
    }
    FA_BAR();
#undef FA_DMA
}

constexpr int NSLOT2 = 4, LDS_WS2 = 132096, LDS_BIAS2 = LDS_WS2 + 2048;
template <int MODE>
__device__ __forceinline__ void attn_unit2(LAS unsigned char* lds, const int tid_, const bf16_t* Qg, const bf16_t* Kg, const bf16_t* Vg, bf16_t* Yg, const int b, const int hq, const int u,
                                           const float lam, const float osc, const float* subln, const int pm = 0) {
    constexpr int PITCH = 512, NDB = (MODE == 0) ? 4 : 2;
    int tid = tid_; asm volatile("" : "+v"(tid));
    const int lane = tid & 63, r32 = lane & 31, hi = lane >> 5, hwid = __builtin_amdgcn_readfirstlane(tid >> 6);
#if FA_WMAP == 1
    const int wid = (hwid >> 1) | ((hwid & 1) << 2);
#elif FA_WMAP == 2
    const int wid = (hwid & 1) | ((hwid >> 2) << 1) | (((hwid >> 1) & 1) << 2);
#else
    const int wid = hwid;
#endif
    const int ch = wid >> 2, wq = wid & 3;
    const int cw = 2 * u + (wq >> 1);
    const int t0 = (MODE == 0) ? 0 : ((2 * u - 8) > 0 ? (2 * u - 8) : 0), t1 = 2 * u + 1, NT = t1 - t0 + 1;
    const int iv1 = cw - t0, iv0 = (MODE == 0) ? 0 : ((cw - 8 - t0) > 0 ? (cw - 8 - t0) : 0);
    const size_t rowbase = (size_t)b * SEQ;
    const bf16_t* Kb = Kg + rowbase * PITCH + hq * 128; const bf16_t* Vb = Vg + rowbase * PITCH + hq * 128;
    const unsigned lds0 = (unsigned)(uintptr_t)lds;
    LAS float* wsf = (LAS float*)(lds + LDS_WS2) + wid * 64;
    const bf16_t* kbase = Kb + (2 * wid) * 8;
    const bf16_t* vbase = Vb + (size_t)(16 * ((2 * wid) & 3)) * PITCH + 32 * ((2 * wid) >> 2);
    const unsigned kvo = (unsigned)lane * PITCH * 2u, vvo = (unsigned)((lane >> 2) * PITCH + (lane & 3) * 8) * 2u;
#define FA_DMA(t, slot) do { if (pm == 1) break; const size_t to_ = (size_t)(t) * 64 * PITCH; const unsigned sb_ = lds0 + (unsigned)(slot) * SLOTB; \
        glds16s(kbase + to_, kvo, (unsigned)__builtin_amdgcn_readfirstlane(sb_ + KOFF + (2 * wid) * 1024)); glds16s(kbase + to_ + 8, kvo, (unsigned)__builtin_amdgcn_readfirstlane(sb_ + KOFF + (2 * wid + 1) * 1024)); \
        glds16s(vbase + to_, vvo, (unsigned)__builtin_amdgcn_readfirstlane(sb_ + VOFF + (2 * wid) * 1024)); glds16s(vbase + to_ + 16 * PITCH, vvo, (unsigned)__builtin_amdgcn_readfirstlane(sb_ + VOFF + (2 * wid + 1) * 1024)); } while (0)
    FA_DMA(t0, 0);
    FA_DMA(t0 + 1, 1);
    const size_t qrow = rowbase + (size_t)u * 128 + wq * 32;
    bf16x8 qr[4];
#pragma unroll
    for (int i = 0; i < 4; ++i) qr[i] = *(const bf16x8*)(Qg + (qrow + r32) * PITCH + hq * 128 + ch * 64 + i * 16 + hi * 8);
    f32x16 o[NDB];
#pragma unroll
    for (int d = 0; d < NDB; ++d)
#pragma unroll
        for (int r = 0; r < 16; ++r) o[d][r] = 0.f;
    float mref = 0.f, lsum = 0.f; bool first = true;
    const lds_cptr kp0 = (lds_cptr)lds + KOFF + ch * 8192 + hi * 1024 + r32 * 16;
    const lds_cptr vp0 = (lds_cptr)lds + VOFF + ((MODE == 0) ? 0 : ch * 8192) + ((lane >> 4) & 1) * 32 + (lane & 3) * 8 + (4 * hi + ((lane & 15) >> 2)) * 64;
    f32x16 p0, p1; bf16x8 pa0, pa1, pa2, pa3, kf[8], vf[NDB * 4];
#pragma unroll
    for (int r = 0; r < 16; ++r) { p0[r] = 0.f; p1[r] = 0.f; }
    pa0 = pa1 = pa2 = pa3 = (bf16x8){0, 0, 0, 0, 0, 0, 0, 0};
#pragma unroll
    for (int k = 0; k < NDB * 4; ++k) vf[k] = pa0;
#define FA_SB() __builtin_amdgcn_sched_barrier(0)
#define FA_KLD(i_) do { if (pm == 7) break; const lds_cptr kp = kp0 + ((i_) & 3) * SLOTB; \
        _Pragma("unroll") for (int k = 0; k < 4; ++k) { kf[2 * k] = *(const LAS bf16x8*)(kp + k * 2048); kf[2 * k + 1] = *(const LAS bf16x8*)(kp + k * 2048 + 512); } } while (0)
#define FA_QK(i_) do { \
        _Pragma("unroll") for (int r = 0; r < 16; ++r) { p0[r] = 0.f; p1[r] = 0.f; } \
        _Pragma("unroll") for (int k = 0; k < 4; ++k) { p0 = __builtin_amdgcn_mfma_f32_32x32x16_bf16(kf[2 * k], qr[k], p0, 0, 0, 0); p1 = __builtin_amdgcn_mfma_f32_32x32x16_bf16(kf[2 * k + 1], qr[k], p1, 0, 0, 0); } \
        if (MODE == 1) { const int t = t0 + (i_); const LAS float* bt = (const LAS float*)(lds + LDS_BIAS2) + ch * 320; const int relb = 64 * (cw - t) + 32 * (wq & 1) + r32 + 63; \
            if (cw - t >= 5) { const float c = bt[319]; _Pragma("unroll") for (int r = 0; r < 16; ++r) { p0[r] += c; p1[r] += c; } } \
            else { _Pragma("unroll") for (int r = 0; r < 16; ++r) { const int i0 = relb - crow(r, hi), i1 = i0 - 32; p0[r] += bt[i0 > 319 ? 319 : i0]; p1[r] += bt[i1 > 319 ? 319 : i1]; } } } } while (0)
#define FA_MX3(a, b, c) __builtin_fmaxf(__builtin_fmaxf((a), (b)), (c))
#define FA_SM() do { if (pm == 3) { asm volatile("" : "+v"(p0), "+v"(p1)); break; } \
        float ma = FA_MX3(p0[0], p0[1], p1[0]), mb = FA_MX3(p0[2], p0[3], p1[1]), mc = FA_MX3(p0[4], p0[5], p1[2]), md = FA_MX3(p0[6], p0[7], p1[3]); \
        ma = FA_MX3(ma, p0[8], p0[9]); mb = FA_MX3(mb, p0[10], p0[11]); mc = FA_MX3(mc, p0[12], p0[13]); md = FA_MX3(md, p0[14], p0[15]); \
        ma = FA_MX3(ma, p1[4], p1[5]); mb = FA_MX3(mb, p1[6], p1[7]); mc = FA_MX3(mc, p1[8], p1[9]); md = FA_MX3(md, p1[10], p1[11]); \
        ma = FA_MX3(ma, p1[12], p1[13]); mb = FA_MX3(mb, p1[14], p1[15]); float rm = __builtin_fmaxf(__builtin_fmaxf(ma, mb), __builtin_fmaxf(mc, md)); rm = swapmax(rm); \
        if (first) { mref = rm; first = false; } \
        else if (__any(rm - mref > THR)) { const float dl = fmaxf(rm - mref, 0.f); mref += dl; const float f = fast_exp2(-dl); lsum *= f; if (hi == 0) wsf[r32] = f; LDS_WAIT(); \
            _Pragma("unroll") for (int r = 0; r < 16; ++r) { const float fr = wsf[crow(r, hi)]; _Pragma("unroll") for (int d = 0; d < NDB; ++d) o[d][r] *= fr; } } \
        float sa = 0.f, sb = 0.f, sc = 0.f, sd = 0.f; \
        _Pragma("unroll") for (int r = 0; r < 16; r += 4) { p0[r] = fast_exp2(p0[r] - mref); p0[r + 1] = fast_exp2(p0[r + 1] - mref); p0[r + 2] = fast_exp2(p0[r + 2] - mref); p0[r + 3] = fast_exp2(p0[r + 3] - mref); \
            p1[r] = fast_exp2(p1[r] - mref); p1[r + 1] = fast_exp2(p1[r + 1] - mref); p1[r + 2] = fast_exp2(p1[r + 2] - mref); p1[r + 3] = fast_exp2(p1[r + 3] - mref); \
            sa += p0[r] + p1[r]; sb += p0[r + 1] + p1[r + 1]; sc += p0[r + 2] + p1[r + 2]; sd += p0[r + 3] + p1[r + 3]; } \
        lsum += (sa + sb) + (sc + sd); \
        pa0 = pack_p(p0, 0); pa1 = pack_p(p0, 8); pa2 = pack_p(p1, 0); pa3 = pack_p(p1, 8); } while (0)
#define FA_VLDALL(i_) do { if (pm == 4) break; const lds_cptr vt = vp0 + ((i_) & 3) * SLOTB; \
        _Pragma("unroll") for (int d = 0; d < NDB; ++d) _Pragma("unroll") for (int k = 0; k < 4; ++k) vf[4 * d + k] = cat8(vtr(vt + d * 4096 + k * 1024), vtr(vt + d * 4096 + k * 1024 + 512)); } while (0)
#define FA_PV() do { if (pm == 5) break; _Pragma("unroll") for (int d = 0; d < NDB; ++d) { \
        o[d] = __builtin_amdgcn_mfma_f32_32x32x16_bf16(pa0, vf[4 * d], o[d], 0, 0, 0); o[d] = __builtin_amdgcn_mfma_f32_32x32x16_bf16(pa1, vf[4 * d + 1], o[d], 0, 0, 0); \
        o[d] = __builtin_amdgcn_mfma_f32_32x32x16_bf16(pa2, vf[4 * d + 2], o[d], 0, 0, 0); o[d] = __builtin_amdgcn_mfma_f32_32x32x16_bf16(pa3, vf[4 * d + 3], o[d], 0, 0, 0); } } while (0)
#if PROBE_T
    unsigned tacc0 = 0, tacc1 = 0, tacc2 = 0, tacc3 = 0; unsigned long long s0 = 0, s1 = 0, s2 = 0, s3 = 0; const unsigned long long rt0 = __builtin_amdgcn_s_memrealtime();
#define FA_TS(v) do { FA_SB(); asm volatile("s_memtime %0\n\ts_waitcnt lgkmcnt(0)" : "=s"(v) :: "memory"); FA_SB(); } while (0)
#define FA_TSV(v, a, b) do { FA_SB(); asm volatile("s_nop 15\n\ts_nop 15" : "+v"(a), "+v"(b)); asm volatile("s_memtime %0\n\ts_waitcnt lgkmcnt(0)" : "=s"(v) :: "memory"); FA_SB(); } while (0)
#define FA_TACC() do { tacc0 += (unsigned)(s3 - s0); tacc1 += (unsigned)(s1 - s0); tacc2 += (unsigned)(s2 - s1); tacc3 += (unsigned)(s3 - s2); } while (0)
#define FA_TOUT(base) do { if (blockIdx.x == 0 && (hwid & 3) == 0 && u >= 32) { const unsigned long long rt1 = __builtin_amdgcn_s_memrealtime(); \
        unsigned long long* pv = (unsigned long long*)((char*)Yg - WS_AQ + WS_PROBE) + (base); if (lane == 0) { pv[0] = tacc0 / NT; pv[1] = tacc1 / NT; pv[2] = tacc2 / NT; pv[3] = tacc3 / NT; pv[4] = ((unsigned long long)tacc0 * 100) / (rt1 - rt0); pv[5] = NT; } } } while (0)
#else
#define FA_TS(v) do { } while (0)
#define FA_TSV(v, a, b) do { } while (0)
#define FA_TACC() do { } while (0)
#define FA_TOUT(base) do { } while (0)
#endif
    if (ch == 0) {
#pragma unroll 1
        for (int i = 0; i < NT; ++i) {
            FA_TS(s0);
            if (i + 1 < NT) FA_WAIT_BAR(4); else FA_WAIT_BAR(0);
            FA_TS(s1);
            if (i + 2 < NT) FA_DMA(t0 + i + 2, (i + 2) & 3);
            if (pm != 2) {
                const bool prev = (i - 1 >= iv0) && (i - 1 <= iv1), cur = (i >= iv0) && (i <= iv1);
                if (cur) FA_KLD(i);
                FA_SB();
                if (prev) { FA_PV(); FA_SB(); }
                if (cur) { FA_QK(i); FA_SB(); FA_TSV(s2, p0, p1); FA_VLDALL(i); FA_SB(); FA_SM(); FA_SB(); FA_TSV(s3, pa0, pa3); FA_TACC(); }
            }
        }
        FA_TOUT(0);
        if (NT - 1 <= iv1 && pm != 2) FA_PV();
    } else {
#pragma unroll 1
        for (int i = 0; i < NT; ++i) {
            FA_TS(s0);
            if (i + 1 < NT) FA_WAIT_BAR(4); else FA_WAIT_BAR(0);
            FA_TS(s1);
            if (i + 2 < NT) FA_DMA(t0 + i + 2, (i + 2) & 3);
            if (pm != 2) {
                const bool prev = (i - 1 >= iv0) && (i - 1 <= iv1), cur = (i >= iv0) && (i <= iv1);
                if (prev) { FA_VLDALL(i - 1); FA_SB(); FA_SM(); FA_SB(); FA_TSV(s2, pa0, pa3); }
                if (cur) { FA_KLD(i); FA_SB(); }
                if (prev) { FA_PV(); FA_SB(); }
                if (cur) { FA_QK(i); FA_SB(); FA_TSV(s3, p0, p1); if (prev) FA_TACC(); }
            }
        }
        FA_TOUT(8);
        if (NT - 1 <= iv1 && pm != 2) { FA_VLDALL(NT - 1); FA_SB(); FA_SM(); FA_SB(); FA_PV(); }
    }
#undef FA_VLDALL
#undef FA_MX3
#undef FA_TS
#undef FA_TSV
#undef FA_TACC
#undef FA_TOUT
#undef FA_KLD
#undef FA_SB
#undef FA_QK
#undef FA_SM
#undef FA_PV
    lsum = swapsum(lsum);
    if (hi == 0) wsf[32 + r32] = lsum;
    LDS_WAIT();
#pragma unroll
    for (int r = 0; r < 16; ++r) { const float il = fast_rcp(wsf[32 + crow(r, hi)]);
#pragma unroll
        for (int d = 0; d < NDB; ++d) o[d][r] *= il; }
    FA_BAR();
    if (MODE == 0) {
        LAS float* xf = (LAS float*)lds + (wid & 3) * 4096;
        if (ch == 1) {
#pragma unroll
            for (int d = 0; d < 4; ++d)
#pragma unroll
                for (int r = 0; r < 16; ++r) xf[(d * 16 + r) * 64 + lane] = o[d][r];
        }
        FA_BAR();
        if (ch == 0) {
            float ss[16];
#pragma unroll
            for (int r = 0; r < 16; ++r) ss[r] = 0.f;
#pragma unroll
            for (int d = 0; d < 4; ++d)
#pragma unroll
                for (int r = 0; r < 16; ++r) { const float y = o[d][r] - lam * xf[(d * 16 + r) * 64 + lane]; o[d][r] = y; ss[r] += y * y; }
            LAS bf16_t* stg = (LAS bf16_t*)(lds + 65536) + wid * 4096;
            float g[4];
#pragma unroll
            for (int d = 0; d < 4; ++d) g[d] = subln[32 * d + r32] * osc;
#pragma unroll
            for (int r = 0; r < 16; ++r) { const float rs = __builtin_amdgcn_rsqf(half_sum32(ss[r]) * (1.0f / 128.0f) + EPS); const int orow = crow(r, hi);
#pragma unroll
                for (int d = 0; d < 4; ++d) stg[orow * 128 + d * 32 + r32] = (bf16_t)f2bf(o[d][r] * rs * g[d]); }
            LDS_WAIT();
#pragma unroll
            for (int i = 0; i < 8; ++i) { const int idx = i * 64 + lane, row = idx >> 4, c8 = idx & 15;
                const u32x4 v = *(const LAS u32x4*)(stg + row * 128 + c8 * 8);
                *(u32x4*)(Yg + (qrow + row) * PITCH + hq * 128 + c8 * 8) = v; }
        }
    } else {
        LAS bf16_t* stg = (LAS bf16_t*)lds + wid * 2048;
#pragma unroll
        for (int r = 0; r < 16; ++r) { const int orow = crow(r, hi);
#pragma unroll
            for (int d = 0; d < 2; ++d) stg[orow * 64 + d * 32 + r32] = (bf16_t)f2bf(o[d][r]); }
        LDS_WAIT();
#pragma unroll
        for (int i = 0; i < 4; ++i) { const int idx = i * 64 + lane, row = idx >> 3, c8 = idx & 7;
            const u32x4 v = *(const LAS u32x4*)(stg + row * 64 + c8 * 8);
            *(u32x4*)(Yg + (qrow + row) * PITCH + hq * 128 + ch * 64 + c8 * 8) = v; }
    }
    FA_BAR();
#undef FA_DMA
}

constexpr int K3OFF = 0, V3OFF = 49152, NK3 = 3;
template <int MODE, bool NOMAX>
__device__ __forceinline__ void attn_unit3(LAS unsigned char* lds, const int tid_, const bf16_t* Qg, const bf16_t* Kg, const bf16_t* Vg, bf16_t* Yg, const int b, const int hq, const int u,
                                           const float lam, const float osc, const float* subln, const int pm = 0) {
    constexpr int PITCH = 512, NDB = (MODE == 0) ? 4 : 2;
    int tid = tid_; asm volatile("" : "+v"(tid));
#if PROBE_T
    const unsigned long long tu0_ = __builtin_amdgcn_s_memtime();
#endif
    const int lane = tid & 63, r32 = lane & 31, hi = lane >> 5, wid = __builtin_amdgcn_readfirstlane(tid >> 6), ch = wid >> 2, wq = wid & 3;
    const int cw = 2 * u + (wq >> 1);
    const int t0 = (MODE == 0) ? 0 : ((2 * u - 8) > 0 ? (2 * u - 8) : 0), t1 = 2 * u + 1, NT = t1 - t0 + 1;
    const int iv1 = cw - t0, iv0 = (MODE == 0) ? 0 : ((cw - 8 - t0) > 0 ? (cw - 8 - t0) : 0);
    const size_t rowbase = (size_t)b * SEQ;
    const bf16_t* Kb = Kg + rowbase * PITCH + hq * 128; const bf16_t* Vb = Vg + rowbase * PITCH + hq * 128;
    const unsigned lds0 = (unsigned)(uintptr_t)lds;
    LAS float* wsf = (LAS float*)(lds + LDS_WS2) + wid * 64;
    const bf16_t* kbase = Kb + (2 * wid) * 8;
    const bf16_t* vbase = Vb + (size_t)(16 * ((2 * wid) & 3)) * PITCH + 32 * ((2 * wid) >> 2);
    const unsigned kvo = (unsigned)lane * PITCH * 2u, vvo = (unsigned)((lane >> 2) * PITCH + (lane & 3) * 8) * 2u;
#define F3_DMAK(j) do { if ((j) < NT) { const size_t to_ = (size_t)(t0 + (j)) * 64 * PITCH; const unsigned sb_ = lds0 + K3OFF + (unsigned)((j) % NK3) * 16384u; \
        glds16s(kbase + to_, kvo, (unsigned)__builtin_amdgcn_readfirstlane(sb_ + (2 * wid) * 1024)); glds16s(kbase + to_ + 8, kvo, (unsigned)__builtin_amdgcn_readfirstlane(sb_ + (2 * wid + 1) * 1024)); } } while (0)
#define F3_DMAV(j) do { if ((j) < NT) { const size_t to_ = (size_t)(t0 + (j)) * 64 * PITCH; const unsigned sb_ = lds0 + V3OFF + (unsigned)((j) & 3) * 16384u; \
        glds16s(vbase + to_, vvo, (unsigned)__builtin_amdgcn_readfirstlane(sb_ + (2 * wid) * 1024)); glds16s(vbase + to_ + 16 * PITCH, vvo, (unsigned)__builtin_amdgcn_readfirstlane(sb_ + (2 * wid + 1) * 1024)); } } while (0)
#define F3_DMAK1(j, pc) do { if ((j) < NT) { const size_t to_ = (size_t)(t0 + (j)) * 64 * PITCH; const unsigned sb_ = lds0 + K3OFF + (unsigned)((j) % NK3) * 16384u; \
        glds16s(kbase + to_ + 8 * (pc), kvo, (unsigned)__builtin_amdgcn_readfirstlane(sb_ + (2 * wid + (pc)) * 1024)); } } while (0)
#define F3_DMAV1(j, pc) do { if ((j) < NT) { const size_t to_ = (size_t)(t0 + (j)) * 64 * PITCH; const unsigned sb_ = lds0 + V3OFF + (unsigned)((j) & 3) * 16384u; \
        glds16s(vbase + to_ + 16 * PITCH * (pc), vvo, (unsigned)__builtin_amdgcn_readfirstlane(sb_ + (2 * wid + (pc)) * 1024)); } } while (0)
    F3_DMAK(0); F3_DMAK(1); F3_DMAV(0); F3_DMAK(2); F3_DMAV(1);
    const size_t qrow = rowbase + (size_t)u * 128 + wq * 32;
    bf16x8 qr[4];
#pragma unroll
    for (int i = 0; i < 4; ++i) qr[i] = *(const bf16x8*)(Qg + (qrow + r32) * PITCH + hq * 128 + ch * 64 + i * 16 + hi * 8);
    f32x16 o[NDB];
#pragma unroll
    for (int d = 0; d < NDB; ++d)
#pragma unroll
        for (int r = 0; r < 16; ++r) o[d][r] = 0.f;
    float mref = -1e30f, lsum = 0.f;
    const lds_cptr kp0 = (lds_cptr)lds + K3OFF + ch * 8192 + hi * 1024 + r32 * 16;
    const lds_cptr vp0 = (lds_cptr)lds + V3OFF + ((MODE == 0) ? 0 : ch * 8192) + ((lane >> 4) & 1) * 32 + (lane & 3) * 8 + (4 * hi + ((lane & 15) >> 2)) * 64;
    const LAS float* btab = (const LAS float*)(lds + LDS_BIAS2) + ch * 640;
    f32x16 cA0, cA1, cB0, cB1; u32x4 pA[4], pB[4];
#pragma unroll
    for (int r = 0; r < 16; ++r) { cA0[r] = 0.f; cA1[r] = 0.f; cB0[r] = 0.f; cB1[r] = 0.f; }
#pragma unroll
    for (int k = 0; k < 4; ++k) { pA[k] = (u32x4){0u, 0u, 0u, 0u}; pB[k] = (u32x4){0u, 0u, 0u, 0u}; }
#define F3_SB() __builtin_amdgcn_sched_barrier(0)
#define F3_MX3(a, b, c) __builtin_fmaxf(__builtin_fmaxf((a), (b)), (c))
#define F3_QK(j, d0, d1) do { const lds_cptr kp = kp0 + ((j) % NK3) * 16384; \
        _Pragma("unroll") for (int k = 0; k < 4; ++k) { const bf16x8 ka = *(const LAS bf16x8*)(kp + k * 2048), kb = *(const LAS bf16x8*)(kp + k * 2048 + 512); \
            if (k == 0) { d0 = __builtin_amdgcn_mfma_f32_32x32x16_bf16(ka, qr[0], (f32x16){0.f, 0.f, 0.f, 0.f, 0.f, 0.f, 0.f, 0.f, 0.f, 0.f, 0.f, 0.f, 0.f, 0.f, 0.f, 0.f}, 0, 0, 0); d1 = __builtin_amdgcn_mfma_f32_32x32x16_bf16(kb, qr[0], (f32x16){0.f, 0.f, 0.f, 0.f, 0.f, 0.f, 0.f, 0.f, 0.f, 0.f, 0.f, 0.f, 0.f, 0.f, 0.f, 0.f}, 0, 0, 0); } \
            else { d0 = __builtin_amdgcn_mfma_f32_32x32x16_bf16(ka, qr[k], d0, 0, 0, 0); d1 = __builtin_amdgcn_mfma_f32_32x32x16_bf16(kb, qr[k], d1, 0, 0, 0); } } } while (0)
#define F3_BIAS(j, d0, d1) do { if (MODE == 1) { const int t = t0 + (j); const LAS float* bt = btab; const int relb = 64 * (cw - t) + 32 * (wq & 1) + r32 + 63; \
            if (cw - t >= 5) { const float c = bt[319]; _Pragma("unroll") for (int r = 0; r < 16; ++r) { d0[r] += c; d1[r] += c; } } \
            else { _Pragma("unroll") for (int r = 0; r < 16; ++r) { const int i0 = relb - crow(r, hi), i1 = i0 - 32; d0[r] += bt[i0 > 319 ? 319 : i0]; d1[r] += bt[i1 > 319 ? 319 : i1]; } } } } while (0)
#define F3_PV(j, P) do { const lds_cptr vt = vp0 + ((j) & 3) * 16384; \
        _Pragma("unroll") for (int d = 0; d < NDB; ++d) { const lds_cptr vd = vt + d * 4096; \
            o[d] = __builtin_amdgcn_mfma_f32_32x32x16_bf16(__builtin_bit_cast(bf16x8, P[0]), cat8(vtr(vd), vtr(vd + 512)), o[d], 0, 0, 0); o[d] = __builtin_amdgcn_mfma_f32_32x32x16_bf16(__builtin_bit_cast(bf16x8, P[1]), cat8(vtr(vd + 1024), vtr(vd + 1536)), o[d], 0, 0, 0); \
            o[d] = __builtin_amdgcn_mfma_f32_32x32x16_bf16(__builtin_bit_cast(bf16x8, P[2]), cat8(vtr(vd + 2048), vtr(vd + 2560)), o[d], 0, 0, 0); o[d] = __builtin_amdgcn_mfma_f32_32x32x16_bf16(__builtin_bit_cast(bf16x8, P[3]), cat8(vtr(vd + 3072), vtr(vd + 3584)), o[d], 0, 0, 0); } } while (0)
#define F3_SM(c0, c1, P) do { \
        if (NOMAX) { upd = false; } else { \
        float ma = F3_MX3(c0[0], c0[1], c1[0]), mb = F3_MX3(c0[2], c0[3], c1[1]), mc = F3_MX3(c0[4], c0[5], c1[2]), md = F3_MX3(c0[6], c0[7], c1[3]); \
        ma = F3_MX3(ma, c0[8], c0[9]); mb = F3_MX3(mb, c0[10], c0[11]); mc = F3_MX3(mc, c0[12], c0[13]); md = F3_MX3(md, c0[14], c0[15]); \
        ma = F3_MX3(ma, c1[4], c1[5]); mb = F3_MX3(mb, c1[6], c1[7]); mc = F3_MX3(mc, c1[8], c1[9]); md = F3_MX3(md, c1[10], c1[11]); \
        ma = F3_MX3(ma, c1[12], c1[13]); mb = F3_MX3(mb, c1[14], c1[15]); float rm = __builtin_fmaxf(__builtin_fmaxf(ma, mb), __builtin_fmaxf(mc, md)); rm = swapmax(rm); \
        upd = __any(rm - mref > THR); const float mnew = upd ? __builtin_fmaxf(mref, rm) : mref; fsc = fast_exp2(mref - mnew); mref = mnew; lsum *= fsc; } \
        float sa = 0.f, sb = 0.f, sc = 0.f, sd = 0.f; \
        _Pragma("unroll") for (int r = 0; r < 16; r += 4) { \
            if (NOMAX) { c0[r] = fast_exp2(c0[r]); c0[r + 1] = fast_exp2(c0[r + 1]); c0[r + 2] = fast_exp2(c0[r + 2]); c0[r + 3] = fast_exp2(c0[r + 3]); \
                         c1[r] = fast_exp2(c1[r]); c1[r + 1] = fast_exp2(c1[r + 1]); c1[r + 2] = fast_exp2(c1[r + 2]); c1[r + 3] = fast_exp2(c1[r + 3]); } \
            else { c0[r] = fast_exp2(c0[r] - mref); c0[r + 1] = fast_exp2(c0[r + 1] - mref); c0[r + 2] = fast_exp2(c0[r + 2] - mref); c0[r + 3] = fast_exp2(c0[r + 3] - mref); \
                   c1[r] = fast_exp2(c1[r] - mref); c1[r + 1] = fast_exp2(c1[r + 1] - mref); c1[r + 2] = fast_exp2(c1[r + 2] - mref); c1[r + 3] = fast_exp2(c1[r + 3] - mref); } \
            sa += c0[r] + c1[r]; sb += c0[r + 1] + c1[r + 1]; sc += c0[r + 2] + c1[r + 2]; sd += c0[r + 3] + c1[r + 3]; } \
        lsum += (sa + sb) + (sc + sd); \
        P[0] = __builtin_bit_cast(u32x4, pack_p(c0, 0)); P[1] = __builtin_bit_cast(u32x4, pack_p(c0, 8)); P[2] = __builtin_bit_cast(u32x4, pack_p(c1, 0)); P[3] = __builtin_bit_cast(u32x4, pack_p(c1, 8)); } while (0)
#define F3_RESC() do { if (!NOMAX && upd) { if (hi == 0) wsf[r32] = fsc; LDS_WAIT(); \
            _Pragma("unroll") for (int r = 0; r < 16; ++r) { const float fr = wsf[crow(r, hi)]; _Pragma("unroll") for (int d = 0; d < NDB; ++d) o[d][r] *= fr; } } } while (0)
#define F3_HEAD(i) do { if ((i) + 3 < NT) { asm volatile("s_waitcnt vmcnt(6) lgkmcnt(0)\n\ts_barrier" ::: "memory"); } else FA_WAIT_BAR(0); \
        F3_DMAK((i) + 3); F3_DMAV((i) + 2); F3_SB(); } while (0)
#if PROBE_T
    unsigned tq0 = 0, tq1 = 0, tqn = 0; unsigned long long ts0_ = 0, ts1_ = 0, ts2_ = 0;
#define F3_TS(v) do { F3_SB(); asm volatile("s_memtime %0\n\ts_waitcnt lgkmcnt(0)" : "=s"(v) :: "memory"); F3_SB(); } while (0)
#define F3_TSE(a, b) do { F3_SB(); asm volatile("s_nop 15\n\ts_nop 15" : "+v"(a), "+v"(b)); asm volatile("s_memtime %0\n\ts_waitcnt lgkmcnt(0)" : "=s"(ts2_) :: "memory"); F3_SB(); tq0 += (unsigned)(ts1_ - ts0_); tq1 += (unsigned)(ts2_ - ts1_); ++tqn; } while (0)
#else
#define F3_TS(v) do { } while (0)
#define F3_TSE(a, b) do { } while (0)
#endif
#define F3_HAND(i, C0, C1, N0, N1, PP, PW) do { \
        const lds_cptr vt_ = vp0 + (((i) - 1) & 3) * 16384; const lds_cptr kq_ = kp0 + (((i) + 1) % NK3) * 16384; \
        bf16x8 fq0, fq1, fq2, fq3, fq4; float sa_ = 0.f, sb_ = 0.f; \
        fq0 = cat8(vtr(vt_ + 0), vtr(vt_ + 512)); fq1 = cat8(vtr(vt_ + 1024), vtr(vt_ + 1536)); fq2 = cat8(vtr(vt_ + 2048), vtr(vt_ + 2560)); F3_SB(); \
        F3_TS(ts0_); if ((i) + 3 < NT) { asm volatile("s_waitcnt vmcnt(6) lgkmcnt(0)\n\ts_barrier" ::: "memory"); } else FA_WAIT_BAR(0); F3_TS(ts1_); \
        F3_SB(); \
        o[0] = __builtin_amdgcn_mfma_f32_32x32x16_bf16(__builtin_bit_cast(bf16x8, PP[0]), fq0, o[0], 0, 0, 0); fq3 = cat8(vtr(vt_ + 3072), vtr(vt_ + 3584)); F3_DMAK1((i) + 3, 0); C0[0] = fast_exp2(C0[0]); C0[1] = fast_exp2(C0[1]); asm volatile("" : "+v"(C0)); F3_SB(); \
        o[0] = __builtin_amdgcn_mfma_f32_32x32x16_bf16(__builtin_bit_cast(bf16x8, PP[1]), fq1, o[0], 0, 0, 0); fq0 = cat8(vtr(vt_ + 4096), vtr(vt_ + 4608)); F3_DMAK1((i) + 3, 1); C0[2] = fast_exp2(C0[2]); C0[3] = fast_exp2(C0[3]); asm volatile("" : "+v"(C0)); F3_SB(); \
        o[0] = __builtin_amdgcn_mfma_f32_32x32x16_bf16(__builtin_bit_cast(bf16x8, PP[2]), fq2, o[0], 0, 0, 0); fq1 = cat8(vtr(vt_ + 5120), vtr(vt_ + 5632)); F3_DMAV1((i) + 2, 0); C0[4] = fast_exp2(C0[4]); C0[5] = fast_exp2(C0[5]); asm volatile("" : "+v"(C0)); F3_SB(); \
        o[0] = __builtin_amdgcn_mfma_f32_32x32x16_bf16(__builtin_bit_cast(bf16x8, PP[3]), fq3, o[0], 0, 0, 0); fq2 = cat8(vtr(vt_ + 6144), vtr(vt_ + 6656)); F3_DMAV1((i) + 2, 1); C0[6] = fast_exp2(C0[6]); C0[7] = fast_exp2(C0[7]); asm volatile("" : "+v"(C0)); F3_SB(); \
        o[1] = __builtin_amdgcn_mfma_f32_32x32x16_bf16(__builtin_bit_cast(bf16x8, PP[0]), fq0, o[1], 0, 0, 0); fq3 = cat8(vtr(vt_ + 7168), vtr(vt_ + 7680)); C0[8] = fast_exp2(C0[8]); C0[9] = fast_exp2(C0[9]); asm volatile("" : "+v"(C0)); F3_SB(); \
        o[1] = __builtin_amdgcn_mfma_f32_32x32x16_bf16(__builtin_bit_cast(bf16x8, PP[1]), fq1, o[1], 0, 0, 0); fq0 = cat8(vtr(vt_ + 8192), vtr(vt_ + 8704)); C0[10] = fast_exp2(C0[10]); C0[11] = fast_exp2(C0[11]); asm volatile("" : "+v"(C0)); F3_SB(); \
        o[1] = __builtin_amdgcn_mfma_f32_32x32x16_bf16(__builtin_bit_cast(bf16x8, PP[2]), fq2, o[1], 0, 0, 0); fq1 = cat8(vtr(vt_ + 9216), vtr(vt_ + 9728)); C0[12] = fast_exp2(C0[12]); C0[13] = fast_exp2(C0[13]); asm volatile("" : "+v"(C0)); F3_SB(); \
        o[1] = __builtin_amdgcn_mfma_f32_32x32x16_bf16(__builtin_bit_cast(bf16x8, PP[3]), fq3, o[1], 0, 0, 0); fq2 = cat8(vtr(vt_ + 10240), vtr(vt_ + 10752)); C0[14] = fast_exp2(C0[14]); C0[15] = fast_exp2(C0[15]); asm volatile("" : "+v"(C0)); F3_SB(); \
        o[2] = __builtin_amdgcn_mfma_f32_32x32x16_bf16(__builtin_bit_cast(bf16x8, PP[0]), fq0, o[2], 0, 0, 0); fq3 = cat8(vtr(vt_ + 11264), vtr(vt_ + 11776)); C1[0] = fast_exp2(C1[0]); C1[1] = fast_exp2(C1[1]); sa_ += C0[0]; sb_ += C0[1]; asm volatile("" : "+v"(C1), "+v"(sa_), "+v"(sb_)); F3_SB(); \
        o[2] = __builtin_amdgcn_mfma_f32_32x32x16_bf16(__builtin_bit_cast(bf16x8, PP[1]), fq1, o[2], 0, 0, 0); fq0 = cat8(vtr(vt_ + 12288), vtr(vt_ + 12800)); C1[2] = fast_exp2(C1[2]); C1[3] = fast_exp2(C1[3]); sa_ += C0[2]; sb_ += C0[3]; asm volatile("" : "+v"(C1), "+v"(sa_), "+v"(sb_)); F3_SB(); \
        o[2] = __builtin_amdgcn_mfma_f32_32x32x16_bf16(__builtin_bit_cast(bf16x8, PP[2]), fq2, o[2], 0, 0, 0); fq1 = cat8(vtr(vt_ + 13312), vtr(vt_ + 13824)); C1[4] = fast_exp2(C1[4]); C1[5] = fast_exp2(C1[5]); sa_ += C0[4]; sb_ += C0[5]; asm volatile("" : "+v"(C1), "+v"(sa_), "+v"(sb_)); F3_SB(); \
        o[2] = __builtin_amdgcn_mfma_f32_32x32x16_bf16(__builtin_bit_cast(bf16x8, PP[3]), fq3, o[2], 0, 0, 0); fq2 = cat8(vtr(vt_ + 14336), vtr(vt_ + 14848)); C1[6] = fast_exp2(C1[6]); C1[7] = fast_exp2(C1[7]); sa_ += C0[6]; sb_ += C0[7]; asm volatile("" : "+v"(C1), "+v"(sa_), "+v"(sb_)); F3_SB(); \
        o[3] = __builtin_amdgcn_mfma_f32_32x32x16_bf16(__builtin_bit_cast(bf16x8, PP[0]), fq0, o[3], 0, 0, 0); fq3 = cat8(vtr(vt_ + 15360), vtr(vt_ + 15872)); C1[8] = fast_exp2(C1[8]); C1[9] = fast_exp2(C1[9]); sa_ += C0[8]; sb_ += C0[9]; asm volatile("" : "+v"(C1), "+v"(sa_), "+v"(sb_)); F3_SB(); \
        o[3] = __builtin_amdgcn_mfma_f32_32x32x16_bf16(__builtin_bit_cast(bf16x8, PP[1]), fq1, o[3], 0, 0, 0); fq0 = *(const LAS bf16x8*)(kq_ + 0); C1[10] = fast_exp2(C1[10]); C1[11] = fast_exp2(C1[11]); sa_ += C0[10]; sb_ += C0[11]; asm volatile("" : "+v"(C1), "+v"(sa_), "+v"(sb_)); F3_SB(); \
        o[3] = __builtin_amdgcn_mfma_f32_32x32x16_bf16(__builtin_bit_cast(bf16x8, PP[2]), fq2, o[3], 0, 0, 0); fq1 = *(const LAS bf16x8*)(kq_ + 512); C1[12] = fast_exp2(C1[12]); C1[13] = fast_exp2(C1[13]); sa_ += C0[12]; sb_ += C0[13]; asm volatile("" : "+v"(C1), "+v"(sa_), "+v"(sb_)); F3_SB(); \
        o[3] = __builtin_amdgcn_mfma_f32_32x32x16_bf16(__builtin_bit_cast(bf16x8, PP[3]), fq3, o[3], 0, 0, 0); fq2 = *(const LAS bf16x8*)(kq_ + 2048); C1[14] = fast_exp2(C1[14]); C1[15] = fast_exp2(C1[15]); sa_ += C0[14]; sb_ += C0[15]; asm volatile("" : "+v"(C1), "+v"(sa_), "+v"(sb_)); F3_SB(); \
        N0 = __builtin_amdgcn_mfma_f32_32x32x16_bf16(fq0, qr[0], (f32x16){0.f,0.f,0.f,0.f,0.f,0.f,0.f,0.f,0.f,0.f,0.f,0.f,0.f,0.f,0.f,0.f}, 0, 0, 0); fq3 = *(const LAS bf16x8*)(kq_ + 2560); sa_ += C1[0]; sb_ += C1[1]; PW[0][0] = cvt_pk_bf16(C0[0], C0[1]); PW[0][1] = cvt_pk_bf16(C0[2], C0[3]); asm volatile("" : "+v"(sa_), "+v"(sb_), "+v"(PW[0])); F3_SB(); \
        N1 = __builtin_amdgcn_mfma_f32_32x32x16_bf16(fq1, qr[0], (f32x16){0.f,0.f,0.f,0.f,0.f,0.f,0.f,0.f,0.f,0.f,0.f,0.f,0.f,0.f,0.f,0.f}, 0, 0, 0); fq0 = *(const LAS bf16x8*)(kq_ + 4096); sa_ += C1[2]; sb_ += C1[3]; PW[0][2] = cvt_pk_bf16(C0[4], C0[5]); PW[0][3] = cvt_pk_bf16(C0[6], C0[7]); asm volatile("" : "+v"(sa_), "+v"(sb_), "+v"(PW[0])); F3_SB(); \
        N0 = __builtin_amdgcn_mfma_f32_32x32x16_bf16(fq2, qr[1], N0, 0, 0, 0); fq1 = *(const LAS bf16x8*)(kq_ + 4608); sa_ += C1[4]; sb_ += C1[5]; PW[1][0] = cvt_pk_bf16(C0[8], C0[9]); PW[1][1] = cvt_pk_bf16(C0[10], C0[11]); asm volatile("" : "+v"(sa_), "+v"(sb_), "+v"(PW[1])); F3_SB(); \
        N1 = __builtin_amdgcn_mfma_f32_32x32x16_bf16(fq3, qr[1], N1, 0, 0, 0); fq2 = *(const LAS bf16x8*)(kq_ + 6144); sa_ += C1[6]; sb_ += C1[7]; PW[1][2] = cvt_pk_bf16(C0[12], C0[13]); PW[1][3] = cvt_pk_bf16(C0[14], C0[15]); asm volatile("" : "+v"(sa_), "+v"(sb_), "+v"(PW[1])); F3_SB(); \
        N0 = __builtin_amdgcn_mfma_f32_32x32x16_bf16(fq0, qr[2], N0, 0, 0, 0); fq3 = *(const LAS bf16x8*)(kq_ + 6656); sa_ += C1[8]; sb_ += C1[9]; PW[2][0] = cvt_pk_bf16(C1[0], C1[1]); PW[2][1] = cvt_pk_bf16(C1[2], C1[3]); asm volatile("" : "+v"(sa_), "+v"(sb_), "+v"(PW[2])); F3_SB(); \
        N1 = __builtin_amdgcn_mfma_f32_32x32x16_bf16(fq1, qr[2], N1, 0, 0, 0); sa_ += C1[10]; sb_ += C1[11]; PW[2][2] = cvt_pk_bf16(C1[4], C1[5]); PW[2][3] = cvt_pk_bf16(C1[6], C1[7]); asm volatile("" : "+v"(sa_), "+v"(sb_), "+v"(PW[2])); F3_SB(); \
        N0 = __builtin_amdgcn_mfma_f32_32x32x16_bf16(fq2, qr[3], N0, 0, 0, 0); sa_ += C1[12]; sb_ += C1[13]; PW[3][0] = cvt_pk_bf16(C1[8], C1[9]); PW[3][1] = cvt_pk_bf16(C1[10], C1[11]); asm volatile("" : "+v"(sa_), "+v"(sb_), "+v"(PW[3])); F3_SB(); \
        N1 = __builtin_amdgcn_mfma_f32_32x32x16_bf16(fq3, qr[3], N1, 0, 0, 0); sa_ += C1[14]; sb_ += C1[15]; PW[3][2] = cvt_pk_bf16(C1[12], C1[13]); PW[3][3] = cvt_pk_bf16(C1[14], C1[15]); asm volatile("" : "+v"(sa_), "+v"(sb_), "+v"(PW[3])); F3_SB(); \
        lsum += sa_ + sb_; F3_TSE(N0, N1); } while (0)
#define F3_HANDB(i, C0, C1, N0, N1, PP, PW) do { \
        const lds_cptr vt_ = vp0 + (((i) - 1) & 3) * 16384; const lds_cptr kq_ = kp0 + (((i) + 1) % NK3) * 16384; \
        const LAS float* bb_ = btab + (64 * (cw - (t0 + (i))) + 32 * (wq & 1) + r32 + 63 - 4 * hi - 59);     \
        bf16x8 fq0, fq1, fq2, fq3; float sa_ = 0.f, sb_ = 0.f, b0_, b1_, b2_, b3_; \
        fq0 = cat8(vtr(vt_ + 0), vtr(vt_ + 512)); fq1 = cat8(vtr(vt_ + 1024), vtr(vt_ + 1536)); fq2 = cat8(vtr(vt_ + 2048), vtr(vt_ + 2560)); b0_ = bb_[59]; b1_ = bb_[58]; b2_ = bb_[57]; b3_ = bb_[56]; F3_SB(); \
        if ((i) + 3 < NT) { asm volatile("s_waitcnt vmcnt(6) lgkmcnt(0)\n\ts_barrier" ::: "memory"); } else FA_WAIT_BAR(0); \
        F3_SB(); \
        o[0] = __builtin_amdgcn_mfma_f32_32x32x16_bf16(__builtin_bit_cast(bf16x8, PP[0]), fq0, o[0], 0, 0, 0); fq3 = cat8(vtr(vt_ + 3072), vtr(vt_ + 3584)); F3_DMAK1((i) + 3, 0); C0[0] = fast_exp2(C0[0] + b0_); C0[1] = fast_exp2(C0[1] + b1_); b0_ = bb_[51]; b1_ = bb_[50]; asm volatile("" : "+v"(C0)); F3_SB(); \
        o[0] = __builtin_amdgcn_mfma_f32_32x32x16_bf16(__builtin_bit_cast(bf16x8, PP[1]), fq1, o[0], 0, 0, 0); fq0 = cat8(vtr(vt_ + 4096), vtr(vt_ + 4608)); F3_DMAK1((i) + 3, 1); C0[2] = fast_exp2(C0[2] + b2_); C0[3] = fast_exp2(C0[3] + b3_); b2_ = bb_[49]; b3_ = bb_[48]; asm volatile("" : "+v"(C0)); F3_SB(); \
        o[0] = __builtin_amdgcn_mfma_f32_32x32x16_bf16(__builtin_bit_cast(bf16x8, PP[2]), fq2, o[0], 0, 0, 0); fq1 = cat8(vtr(vt_ + 5120), vtr(vt_ + 5632)); F3_DMAV1((i) + 2, 0); C0[4] = fast_exp2(C0[4] + b0_); C0[5] = fast_exp2(C0[5] + b1_); b0_ = bb_[43]; b1_ = bb_[42]; asm volatile("" : "+v"(C0)); F3_SB(); \
        o[0] = __builtin_amdgcn_mfma_f32_32x32x16_bf16(__builtin_bit_cast(bf16x8, PP[3]), fq3, o[0], 0, 0, 0); fq2 = cat8(vtr(vt_ + 6144), vtr(vt_ + 6656)); F3_DMAV1((i) + 2, 1); C0[6] = fast_exp2(C0[6] + b2_); C0[7] = fast_exp2(C0[7] + b3_); b2_ = bb_[41]; b3_ = bb_[40]; asm volatile("" : "+v"(C0)); F3_SB(); \
        o[1] = __builtin_amdgcn_mfma_f32_32x32x16_bf16(__builtin_bit_cast(bf16x8, PP[0]), fq0, o[1], 0, 0, 0); fq3 = cat8(vtr(vt_ + 7168), vtr(vt_ + 7680)); C0[8] = fast_exp2(C0[8] + b0_); C0[9] = fast_exp2(C0[9] + b1_); b0_ = bb_[35]; b1_ = bb_[34]; sa_ += C0[0]; sb_ += C0[1]; asm volatile("" : "+v"(C0), "+v"(sa_), "+v"(sb_)); F3_SB(); \
        o[1] = __builtin_amdgcn_mfma_f32_32x32x16_bf16(__builtin_bit_cast(bf16x8, PP[1]), fq1, o[1], 0, 0, 0); fq0 = *(const LAS bf16x8*)(kq_ + 0); C0[10] = fast_exp2(C0[10] + b2_); C0[11] = fast_exp2(C0[11] + b3_); b2_ = bb_[33]; b3_ = bb_[32]; sa_ += C0[2]; sb_ += C0[3]; sa_ += C0[4]; asm volatile("" : "+v"(C0), "+v"(sa_), "+v"(sb_)); F3_SB(); \
        o[1] = __builtin_amdgcn_mfma_f32_32x32x16_bf16(__builtin_bit_cast(bf16x8, PP[2]), fq2, o[1], 0, 0, 0); fq1 = *(const LAS bf16x8*)(kq_ + 512); C0[12] = fast_exp2(C0[12] + b0_); C0[13] = fast_exp2(C0[13] + b1_); b0_ = bb_[27]; b1_ = bb_[26]; sb_ += C0[5]; sa_ += C0[6]; sb_ += C0[7]; asm volatile("" : "+v"(C0), "+v"(sa_), "+v"(sb_)); F3_SB(); \
        o[1] = __builtin_amdgcn_mfma_f32_32x32x16_bf16(__builtin_bit_cast(bf16x8, PP[3]), fq3, o[1], 0, 0, 0); fq2 = *(const LAS bf16x8*)(kq_ + 2048); C0[14] = fast_exp2(C0[14] + b2_); C0[15] = fast_exp2(C0[15] + b3_); b2_ = bb_[25]; b3_ = bb_[24]; sa_ += C0[8]; sb_ += C0[9]; asm volatile("" : "+v"(C0), "+v"(sa_), "+v"(sb_)); F3_SB(); \
        N0 = __builtin_amdgcn_mfma_f32_32x32x16_bf16(fq0, qr[0], (f32x16){0.f,0.f,0.f,0.f,0.f,0.f,0.f,0.f,0.f,0.f,0.f,0.f,0.f,0.f,0.f,0.f}, 0, 0, 0); fq3 = *(const LAS bf16x8*)(kq_ + 2560); C1[0] = fast_exp2(C1[0] + b0_); C1[1] = fast_exp2(C1[1] + b1_); b0_ = bb_[19]; b1_ = bb_[18]; sa_ += C0[10]; sb_ += C0[11]; sa_ += C0[12]; PW[0][0] = cvt_pk_bf16(C0[0], C0[1]); PW[0][1] = cvt_pk_bf16(C0[2], C0[3]); asm volatile("" : "+v"(C1), "+v"(sa_), "+v"(sb_), "+v"(PW[0])); F3_SB(); \
        N1 = __builtin_amdgcn_mfma_f32_32x32x16_bf16(fq1, qr[0], (f32x16){0.f,0.f,0.f,0.f,0.f,0.f,0.f,0.f,0.f,0.f,0.f,0.f,0.f,0.f,0.f,0.f}, 0, 0, 0); fq0 = *(const LAS bf16x8*)(kq_ + 4096); C1[2] = fast_exp2(C1[2] + b2_); C1[3] = fast_exp2(C1[3] + b3_); b2_ = bb_[17]; b3_ = bb_[16]; sb_ += C0[13]; sa_ += C0[14]; sb_ += C0[15]; PW[0][2] = cvt_pk_bf16(C0[4], C0[5]); PW[0][3] = cvt_pk_bf16(C0[6], C0[7]); asm volatile("" : "+v"(C1), "+v"(sa_), "+v"(sb_), "+v"(PW[0])); F3_SB(); \
        N0 = __builtin_amdgcn_mfma_f32_32x32x16_bf16(fq2, qr[1], N0, 0, 0, 0); fq1 = *(const LAS bf16x8*)(kq_ + 4608); C1[4] = fast_exp2(C1[4] + b0_); C1[5] = fast_exp2(C1[5] + b1_); b0_ = bb_[11]; b1_ = bb_[10]; sa_ += C1[0]; sb_ += C1[1]; PW[1][0] = cvt_pk_bf16(C0[8], C0[9]); PW[1][1] = cvt_pk_bf16(C0[10], C0[11]); asm volatile("" : "+v"(C1), "+v"(sa_), "+v"(sb_), "+v"(PW[1])); F3_SB(); \
        N1 = __builtin_amdgcn_mfma_f32_32x32x16_bf16(fq3, qr[1], N1, 0, 0, 0); fq2 = *(const LAS bf16x8*)(kq_ + 6144); C1[6] = fast_exp2(C1[6] + b2_); C1[7] = fast_exp2(C1[7] + b3_); b2_ = bb_[9]; b3_ = bb_[8]; sa_ += C1[2]; sb_ += C1[3]; sa_ += C1[4]; PW[1][2] = cvt_pk_bf16(C0[12], C0[13]); PW[1][3] = cvt_pk_bf16(C0[14], C0[15]); asm volatile("" : "+v"(C1), "+v"(sa_), "+v"(sb_), "+v"(PW[1])); F3_SB(); \
        N0 = __builtin_amdgcn_mfma_f32_32x32x16_bf16(fq0, qr[2], N0, 0, 0, 0); fq3 = *(const LAS bf16x8*)(kq_ + 6656); C1[8] = fast_exp2(C1[8] + b0_); C1[9] = fast_exp2(C1[9] + b1_); b0_ = bb_[3]; b1_ = bb_[2]; sb_ += C1[5]; sa_ += C1[6]; sb_ += C1[7]; PW[2][0] = cvt_pk_bf16(C1[0], C1[1]); PW[2][1] = cvt_pk_bf16(C1[2], C1[3]); asm volatile("" : "+v"(C1), "+v"(sa_), "+v"(sb_), "+v"(PW[2])); F3_SB(); \
        N1 = __builtin_amdgcn_mfma_f32_32x32x16_bf16(fq1, qr[2], N1, 0, 0, 0); C1[10] = fast_exp2(C1[10] + b2_); C1[11] = fast_exp2(C1[11] + b3_); b2_ = bb_[1]; b3_ = bb_[0]; sa_ += C1[8]; sb_ += C1[9]; PW[2][2] = cvt_pk_bf16(C1[4], C1[5]); PW[2][3] = cvt_pk_bf16(C1[6], C1[7]); asm volatile("" : "+v"(C1), "+v"(sa_), "+v"(sb_), "+v"(PW[2])); F3_SB(); \
        N0 = __builtin_amdgcn_mfma_f32_32x32x16_bf16(fq2, qr[3], N0, 0, 0, 0); C1[12] = fast_exp2(C1[12] + b0_); C1[13] = fast_exp2(C1[13] + b1_); sa_ += C1[10]; sb_ += C1[11]; sa_ += C1[12]; PW[3][0] = cvt_pk_bf16(C1[8], C1[9]); PW[3][1] = cvt_pk_bf16(C1[10], C1[11]); asm volatile("" : "+v"(C1), "+v"(sa_), "+v"(sb_), "+v"(PW[3])); F3_SB(); \
        N1 = __builtin_amdgcn_mfma_f32_32x32x16_bf16(fq3, qr[3], N1, 0, 0, 0); C1[14] = fast_exp2(C1[14] + b2_); C1[15] = fast_exp2(C1[15] + b3_); sb_ += C1[13]; sa_ += C1[14]; sb_ += C1[15]; PW[3][2] = cvt_pk_bf16(C1[12], C1[13]); PW[3][3] = cvt_pk_bf16(C1[14], C1[15]); asm volatile("" : "+v"(C1), "+v"(sa_), "+v"(sb_), "+v"(PW[3])); F3_SB(); \
        lsum += sa_ + sb_; } while (0)
#define F3_SLOW(i, C0, C1, N0, N1, PP, PW) do { F3_HEAD(i); \
        const bool vc = ((i) >= iv0) && ((i) <= iv1), vp = ((i) - 1 >= iv0) && ((i) - 1 <= iv1), vn = ((i) + 1 >= iv0) && ((i) + 1 <= iv1) && ((i) + 1 < NT); \
        if (vp) F3_PV((i) - 1, PP); \
        F3_SB(); \
        if (vn) { F3_QK((i) + 1, N0, N1); } \
        F3_SB(); \
        if (vc) { F3_BIAS((i), C0, C1); F3_SM(C0, C1, PW); } else { upd = false; }     \
        F3_SB(); F3_RESC(); } while (0)
    bool upd = false; float fsc = 1.f;
    asm volatile("s_waitcnt vmcnt(8) lgkmcnt(0)\n\ts_barrier" ::: "memory");
    if (iv0 == 0) { F3_QK(0, cA0, cA1); }
    F3_SB();
    if (MODE == 0) {
        F3_SLOW(0, cA0, cA1, cB0, cB1, pB, pA);
        if (NOMAX && FA_HAND) {
#pragma unroll 1
            for (int i = 1; i + 3 < NT; i += 2) { F3_HAND(i, cB0, cB1, cA0, cA1, pA, pB); F3_HAND(i + 1, cA0, cA1, cB0, cB1, pB, pA); }
            if (NT >= 4) { F3_HAND(NT - 3, cB0, cB1, cA0, cA1, pA, pB); }
        } else {
#pragma unroll 1
            for (int i = 1; i + 3 < NT; i += 2) { F3_SLOW(i, cB0, cB1, cA0, cA1, pA, pB); F3_SLOW(i + 1, cA0, cA1, cB0, cB1, pB, pA); }
            if (NT >= 4) { F3_SLOW(NT - 3, cB0, cB1, cA0, cA1, pA, pB); }
        }
        if (NT >= 4) { F3_SLOW(NT - 2, cA0, cA1, cB0, cB1, pB, pA); }
        F3_SLOW(NT - 1, cB0, cB1, cA0, cA1, pA, pB);
    } else {
        F3_SLOW(0, cA0, cA1, cB0, cB1, pB, pA); F3_SLOW(1, cB0, cB1, cA0, cA1, pA, pB);
        if (NOMAX && FA_HANDB) {
#pragma unroll 1
            for (int i = 2; i + 3 < NT; i += 2) { F3_HANDB(i, cA0, cA1, cB0, cB1, pB, pA); F3_HANDB(i + 1, cB0, cB1, cA0, cA1, pA, pB); }
        } else {
#pragma unroll 1
            for (int i = 2; i + 3 < NT; i += 2) { F3_SLOW(i, cA0, cA1, cB0, cB1, pB, pA); F3_SLOW(i + 1, cB0, cB1, cA0, cA1, pA, pB); }
        }
        if (NT >= 4) { F3_SLOW(NT - 2, cA0, cA1, cB0, cB1, pB, pA); F3_SLOW(NT - 1, cB0, cB1, cA0, cA1, pA, pB); }
    }
#if PROBE_T
    if (MODE == 0 && blockIdx.x == 0 && (wid & 3) == 0 && u >= 32 && lane == 0 && tqn) { unsigned long long* pv = (unsigned long long*)((char*)Yg - WS_AQ + WS_PROBE) + (ch ? 8 : 0); pv[0] = tq0 / tqn; pv[1] = tq1 / tqn; pv[2] = tqn; }
#endif
    if (NT - 1 <= iv1) F3_PV(NT - 1, pB);
#undef F3_TS
#undef F3_TSE
#undef F3_HEAD
#undef F3_SLOW
#undef F3_HAND
#undef F3_HANDB
#undef F3_DMAK
#undef F3_DMAV
#undef F3_DMAK1
#undef F3_DMAV1
#undef F3_SB
#undef F3_MX3
#undef F3_QK
#undef F3_BIAS
#undef F3_PV
#undef F3_SM
#undef F3_RESC
    lsum = swapsum(lsum);
    if (hi == 0) wsf[32 + r32] = lsum;
    LDS_WAIT();
#pragma unroll
    for (int r = 0; r < 16; ++r) { const float il = fast_rcp(wsf[32 + crow(r, hi)]);
#pragma unroll
        for (int d = 0; d < NDB; ++d) o[d][r] *= il; }
    FA_BAR();
    if (MODE == 0) {
        LAS float* xf = (LAS float*)lds + (wid & 3) * 4096;
        if (ch == 1) {
#pragma unroll
            for (int d = 0; d < 4; ++d)
#pragma unroll
                for (int r = 0; r < 16; ++r) xf[(d * 16 + r) * 64 + lane] = o[d][r];
        }
        FA_BAR();
        if (ch == 0) {
            float ss[16];
#pragma unroll
            for (int r = 0; r < 16; ++r) ss[r] = 0.f;
#pragma unroll
            for (int d = 0; d < 4; ++d)
#pragma unroll
                for (int r = 0; r < 16; ++r) { const float y = o[d][r] - lam * xf[(d * 16 + r) * 64 + lane]; o[d][r] = y; ss[r] += y * y; }
            LAS bf16_t* stg = (LAS bf16_t*)(lds + 65536) + wid * 4096;
            float g[4];
#pragma unroll
            for (int d = 0; d < 4; ++d) g[d] = subln[32 * d + r32] * osc;
#pragma unroll
            for (int r = 0; r < 16; ++r) { const float rs = __builtin_amdgcn_rsqf(half_sum32(ss[r]) * (1.0f / 128.0f) + EPS); const int orow = crow(r, hi);
#pragma unroll
                for (int d = 0; d < 4; ++d) stg[orow * 128 + d * 32 + r32] = (bf16_t)f2bf(o[d][r] * rs * g[d]); }
            LDS_WAIT();
#pragma unroll
            for (int i = 0; i < 8; ++i) { const int idx = i * 64 + lane, row = idx >> 4, c8 = idx & 15;
                const u32x4 v = *(const LAS u32x4*)(stg + row * 128 + c8 * 8);
                *(u32x4*)(Yg + (qrow + row) * PITCH + hq * 128 + c8 * 8) = v; }
        }
    } else {
        LAS bf16_t* stg = (LAS bf16_t*)lds + wid * 2048;
#pragma unroll
        for (int r = 0; r < 16; ++r) { const int orow = crow(r, hi);
#pragma unroll
            for (int d = 0; d < 2; ++d) stg[orow * 64 + d * 32 + r32] = (bf16_t)f2bf(o[d][r]); }
        LDS_WAIT();
#pragma unroll
        for (int i = 0; i < 4; ++i) { const int idx = i * 64 + lane, row = idx >> 3, c8 = idx & 7;
            const u32x4 v = *(const LAS u32x4*)(stg + row * 64 + c8 * 8);
            *(u32x4*)(Yg + (qrow + row) * PITCH + hq * 128 + ch * 64 + c8 * 8) = v; }
    }
    FA_BAR();
#if PROBE_T
    if (MODE == 0 && blockIdx.x == 0 && wid == 0 && u >= 32 && lane == 0) { unsigned long long* pv = (unsigned long long*)((char*)Yg - WS_AQ + WS_PROBE); pv[3] = (__builtin_amdgcn_s_memtime() - tu0_) / 10; }
#endif
}

#if FA_V2 == 3
#define FA_UNIT attn_unit2
#elif FA_V2
#define FA_UNIT attn_unit2
#else
#define FA_UNIT attn_unit
#endif
__device__ __forceinline__ void attn_a_phase(LAS unsigned char* lds, const int tid, unsigned char* ws, bf16_t* yout, const int vcu, const int G, const float* lq1, const float* lk1, const float* lq2, const float* lk2,
                                             const float* subln, const float lam_init, const float* gq, const float* gk, const int pm = 0) {
    const int lane = tid & 63;
    const float lamv = expf(wave_sum(lq1[lane] * lk1[lane])) - expf(wave_sum(lq2[lane] * lk2[lane])) + lam_init;
    const float lam = __uint_as_float(__builtin_amdgcn_readfirstlane(__float_as_uint(lamv)));
    const float bound = wave_max(fabsf(gq[lane])) * wave_max(fabsf(gk[lane])) * 64.0f * C2;
    const bool nomax = __uint_as_float(__builtin_amdgcn_readfirstlane(__float_as_uint(bound))) < FA_NOMAX_BOUND_A;
    for (int v = vcu; v < 256; v += G) {
        const int bh = v >> 5, p = v & 31;
#pragma unroll 1
        for (int k = 0; k < 2; ++k) {
#if FA_V2 == 3
            if (nomax) attn_unit3<0, true>(lds, tid, (const bf16_t*)(ws + WS_AQ), (const bf16_t*)(ws + WS_AK), (const bf16_t*)(ws + WS_AV), yout, bh >> 2, bh & 3, k ? 63 - p : p, lam, 1.0f - lam_init, subln, pm);
            else       attn_unit3<0, false>(lds, tid, (const bf16_t*)(ws + WS_AQ), (const bf16_t*)(ws + WS_AK), (const bf16_t*)(ws + WS_AV), yout, bh >> 2, bh & 3, k ? 63 - p : p, lam, 1.0f - lam_init, subln, pm);
#else
            FA_UNIT<0>(lds, tid, (const bf16_t*)(ws + WS_AQ), (const bf16_t*)(ws + WS_AK), (const bf16_t*)(ws + WS_AV), yout, bh >> 2, bh & 3, k ? 63 - p : p, lam, 1.0f - lam_init, subln, pm);
#endif
        }
    }
}
__device__ __forceinline__ void attn_b_phase(LAS unsigned char* lds, const int tid, unsigned char* ws, bf16_t* yout, const int vcu, const int G, const float* relb, const float* gq, const float* gk) {
    for (int v = vcu; v < 256; v += G) {
        const int bp = v >> 5, b = bp >> 2, hp = bp & 3;
        LAS float* bt = (LAS float*)(lds + (FA_V2 ? LDS_BIAS2 : LDS_BIAS));
        for (int i = tid; i < 1280; i += 512) { const int c = i / 640, j = i - c * 640; bt[i] = relb[(2 * hp + c) * 320 + (j < 320 ? j : 319)] * LOG2E; }
        FA_BAR();
        float bm = 0.f;
        for (int i = tid & 63; i < 1280; i += 64) bm = fmaxf(bm, fabsf(bt[i]));
        const float bound = wave_max(fabsf(gq[tid & 63])) * wave_max(fabsf(gk[tid & 63])) * 64.0f * C2 + wave_max(bm);
        const bool nomax = __uint_as_float(__builtin_amdgcn_readfirstlane(__float_as_uint(bound))) < FA_NOMAX_BOUND_B;
#pragma unroll 1
        for (int k = 0; k < 2; ++k) {
#if FA_V2 == 3
            if (nomax) attn_unit3<1, true>(lds, tid, (const bf16_t*)(ws + WS_BQ), (const bf16_t*)(ws + WS_BK), (const bf16_t*)(ws + WS_BV), yout, b, hp, 2 * (v & 31) + k, 0.f, 0.f, nullptr);
            else       attn_unit3<1, false>(lds, tid, (const bf16_t*)(ws + WS_BQ), (const bf16_t*)(ws + WS_BK), (const bf16_t*)(ws + WS_BV), yout, b, hp, 2 * (v & 31) + k, 0.f, 0.f, nullptr);
#else
            FA_UNIT<1>(lds, tid, (const bf16_t*)(ws + WS_BQ), (const bf16_t*)(ws + WS_BK), (const bf16_t*)(ws + WS_BV), yout, b, hp, 2 * (v & 31) + k, 0.f, 0.f, nullptr);
#endif
        }
    }
}

__device__ __forceinline__ void ret_kv_phase(LAS unsigned char* lds, const int tid_, unsigned char* ws, const int gw, const int ngw) {
    int tid = tid_; asm volatile("" : "+v"(tid));
    const int lane = tid & 63, r32 = lane & 31, hi = lane >> 5, wid = __builtin_amdgcn_readfirstlane(tid >> 6);
    const bf16_t* CK = (const bf16_t*)(ws + WS_CK); const bf16_t* CV = (const bf16_t*)(ws + WS_CV); float* KVT = (float*)(ws + WS_R4);
    LAS unsigned char* wl = lds + wid * 16384; const unsigned wl0 = (unsigned)(uintptr_t)wl;
    const lds_cptr tp0 = (lds_cptr)wl + ((lane >> 4) & 1) * 32 + (lane & 3) * 8 + (4 * hi + ((lane & 15) >> 2)) * 64;
    for (int task = gw; task < 2048; task += ngw) {
        const int eh = task & 1, n = (task >> 1) & 127, bh = task >> 8, b = bh >> 2, h = bh & 3;
        const size_t row0 = (size_t)b * SEQ + n * 64;
#pragma unroll
        for (int p = 0; p < 8; ++p) {
            glds16(CK + (row0 + 16 * (p & 3) + (lane >> 2)) * 256 + h * 64 + 32 * (p >> 2) + (lane & 3) * 8, (unsigned)__builtin_amdgcn_readfirstlane(wl0 + p * 1024));
            glds16(CV + (row0 + 16 * (p & 3) + (lane >> 2)) * 512 + h * 128 + eh * 64 + 32 * (p >> 2) + (lane & 3) * 8, (unsigned)__builtin_amdgcn_readfirstlane(wl0 + 8192 + p * 1024));
        }
        asm volatile("s_waitcnt vmcnt(0)" ::: "memory");
#pragma unroll
        for (int eb = 0; eb < 2; ++eb)
#pragma unroll
            for (int db = 0; db < 2; ++db) {
                f32x16 acc;
#pragma unroll
                for (int r = 0; r < 16; ++r) acc[r] = 0.f;
#pragma unroll
                for (int s = 0; s < 4; ++s) {
                    const lds_cptr va = tp0 + 8192 + (eb * 4 + s) * 1024, ka = tp0 + (db * 4 + s) * 1024;
                    acc = __builtin_amdgcn_mfma_f32_32x32x16_bf16(cat8(vtr(va), vtr(va + 512)), cat8(vtr(ka), vtr(ka + 512)), acc, 0, 0, 0);
                }
                float* dst = KVT + ((size_t)(bh * 128 + n) * 128 + eh * 64 + eb * 32) * 64 + db * 32 + r32;
#pragma unroll
                for (int r = 0; r < 16; ++r) dst[(size_t)crow(r, hi) * 64] = acc[r];
            }
        LDS_WAIT(); asm volatile("" ::: "memory");
    }
}
__device__ __forceinline__ void ret_scan_phase(const int tid, unsigned char* ws, const int vcu, const int G) {
    float* KVT = (float*)(ws + WS_R4);
    for (int gt = vcu * 512 + tid; gt < 65536; gt += G * 512) {
        const int bh = gt >> 13, idx = gt & 8191, h = bh & 3;
        const float l2g = log2_gamma(h), gam = fast_exp2(l2g), g63 = fast_exp2(63.f * l2g), g64 = fast_exp2(64.f * l2g);
        float* p = KVT + (size_t)bh * 128 * 8192 + idx; float s = 0.f;
        for (int n0 = 0; n0 < 128; n0 += 32) {
            float kv[32];
#pragma unroll
            for (int j = 0; j < 32; ++j) kv[j] = p[(size_t)(n0 + j) * 8192];
#pragma unroll
            for (int j = 0; j < 32; ++j) { p[(size_t)(n0 + j) * 8192] = gam * s; s = g64 * s + g63 * kv[j]; }
        }
    }
}
__device__ __forceinline__ void ret_out_phase(LAS unsigned char* lds, const int tid_, unsigned char* ws, const int gw, const int ngw, const float* onorm) {
    int tid = tid_; asm volatile("" : "+v"(tid));
    const int lane = tid & 63, r32 = lane & 31, hi = lane >> 5, wid = __builtin_amdgcn_readfirstlane(tid >> 6);
    const bf16_t* CQ = (const bf16_t*)(ws + WS_CQ); const bf16_t* CK = (const bf16_t*)(ws + WS_CK); const bf16_t* CV = (const bf16_t*)(ws + WS_CV); bf16_t* CG = (bf16_t*)(ws + WS_CG);
    const float* KVT = (const float*)(ws + WS_R4);
    LAS unsigned char* wl = lds + wid * 16384; const unsigned wl0 = (unsigned)(uintptr_t)wl;
    const lds_cptr tp0 = (lds_cptr)wl + ((lane >> 4) & 1) * 32 + (lane & 3) * 8 + (4 * hi + ((lane & 15) >> 2)) * 64;
    for (int task = gw; task < 2048; task += ngw) {
        const int rh = task & 1, n = (task >> 1) & 127, bh = task >> 8, b = bh >> 2, h = bh & 3;
        const size_t row0 = (size_t)b * SEQ + n * 64;
        const float l2g = log2_gamma(h);
#pragma unroll
        for (int p = 0; p < 16; ++p)
            glds16(CV + (row0 + 16 * (p & 3) + (lane >> 2)) * 512 + h * 128 + 32 * (p >> 2) + (lane & 3) * 8, (unsigned)__builtin_amdgcn_readfirstlane(wl0 + p * 1024));
        bf16x8 qr[4], kf[8];
#pragma unroll
        for (int i = 0; i < 4; ++i) {
            qr[i] = *(const bf16x8*)(CQ + (row0 + 32 * rh + r32) * 256 + h * 64 + i * 16 + hi * 8);
            kf[2 * i] = *(const bf16x8*)(CK + (row0 + r32) * 256 + h * 64 + i * 16 + hi * 8);
            kf[2 * i + 1] = *(const bf16x8*)(CK + (row0 + 32 + r32) * 256 + h * 64 + i * 16 + hi * 8);
        }
        f32x16 p0, p1;
#pragma unroll
        for (int r = 0; r < 16; ++r) { p0[r] = 0.f; p1[r] = 0.f; }
#pragma unroll
        for (int i = 0; i < 4; ++i) { p0 = __builtin_amdgcn_mfma_f32_32x32x16_bf16(kf[2 * i], qr[i], p0, 0, 0, 0); p1 = __builtin_amdgcn_mfma_f32_32x32x16_bf16(kf[2 * i + 1], qr[i], p1, 0, 0, 0); }
        const int qi = 32 * rh + r32;
#pragma unroll
        for (int r = 0; r < 16; ++r) { const int key = crow(r, hi); if (key > qi) p0[r] = 0.f; if (key + 32 > qi) p1[r] = 0.f; }
        const bf16x8 pa0 = pack_p(p0, 0), pa1 = pack_p(p0, 8), pa2 = pack_p(p1, 0), pa3 = pack_p(p1, 8);
        asm volatile("s_waitcnt vmcnt(0)" ::: "memory");
        const float* st = KVT + (size_t)(bh * 128 + n) * 8192;
        f32x16 o[4];
#pragma unroll
        for (int d = 0; d < 4; ++d) {
            const lds_cptr vd = tp0 + d * 4096;
            f32x16 a;
#pragma unroll
            for (int r = 0; r < 16; ++r) a[r] = 0.f;
            a = __builtin_amdgcn_mfma_f32_32x32x16_bf16(pa0, cat8(vtr(vd), vtr(vd + 512)), a, 0, 0, 0);
            a = __builtin_amdgcn_mfma_f32_32x32x16_bf16(pa1, cat8(vtr(vd + 1024), vtr(vd + 1024 + 512)), a, 0, 0, 0);
            a = __builtin_amdgcn_mfma_f32_32x32x16_bf16(pa2, cat8(vtr(vd + 2048), vtr(vd + 2048 + 512)), a, 0, 0, 0);
            a = __builtin_amdgcn_mfma_f32_32x32x16_bf16(pa3, cat8(vtr(vd + 3072), vtr(vd + 3072 + 512)), a, 0, 0, 0);
#pragma unroll
            for (int i = 0; i < 4; ++i) {
                const f32x4 s0 = *(const f32x4*)(st + (size_t)(32 * d + r32) * 64 + i * 16 + hi * 8), s1 = *(const f32x4*)(st + (size_t)(32 * d + r32) * 64 + i * 16 + hi * 8 + 4);
                a = __builtin_amdgcn_mfma_f32_32x32x16_bf16(qr[i], __builtin_bit_cast(bf16x8, epi::pack8(s0, s1)), a, 0, 0, 0);
            }
            o[d] = a;
        }
        LDS_WAIT(); asm volatile("" ::: "memory");
        LAS float* stg = (LAS float*)wl;
        float gn[4];
#pragma unroll
        for (int d = 0; d < 4; ++d) gn[d] = onorm[h * 128 + 32 * d + r32];
#pragma unroll
        for (int r = 0; r < 16; ++r) {
            const float dec = fast_exp2((float)(32 * rh + crow(r, hi)) * l2g);
            float ss = 0.f;
#pragma unroll
            for (int d = 0; d < 4; ++d) { o[d][r] *= dec; ss += o[d][r] * o[d][r]; }
            const float rs = __builtin_amdgcn_rsqf(half_sum32(ss) * (1.0f / 128.0f) + EPS);
#pragma unroll
            for (int d = 0; d < 4; ++d) stg[crow(r, hi) * 128 + d * 32 + r32] = o[d][r] * rs * gn[d];
        }
        LDS_WAIT(); asm volatile("" ::: "memory");
#pragma unroll
        for (int i = 0; i < 8; ++i) { const int idx = i * 64 + lane, row = idx >> 4, c8 = idx & 15;
            const f32x4 y0 = *(const LAS f32x4*)(stg + row * 128 + c8 * 8), y1 = *(const LAS f32x4*)(stg + row * 128 + c8 * 8 + 4);
            bf16_t* gp = CG + (row0 + 32 * rh + row) * 512 + h * 128 + c8 * 8;
            const u32x4 gv = *(const u32x4*)gp;
            const f32x4 g0 = {bflo(gv.x), bfhi(gv.x), bflo(gv.y), bfhi(gv.y)}, g1 = {bflo(gv.z), bfhi(gv.z), bflo(gv.w), bfhi(gv.w)};
            *(u32x4*)gp = epi::pack8(y0 * g0, y1 * g1); }
        LDS_WAIT(); asm volatile("" ::: "memory");
    }
}
}
#define XB_TMO      128
#define XB_XCNT(j)  (256  + 64 * (j))
#define XB_XSUB(j)  (1280 + 64 * (j))
#define XB_XGEN(j)  (2304 + 64 * (j))
#define XB_TOP      3328
#define XB_TOPGEN   3392
#define XCD_BAR_WORDS 3456
#define XB_SPIN_CAP (1u << 18)

__device__ __forceinline__ unsigned xb_ld(unsigned* p)              { return __hip_atomic_load(p, __ATOMIC_RELAXED, __HIP_MEMORY_SCOPE_AGENT); }
__device__ __forceinline__ unsigned xb_add(unsigned* p, unsigned v) { return __hip_atomic_fetch_add(p, v, __ATOMIC_RELAXED, __HIP_MEMORY_SCOPE_AGENT); }
__device__ __forceinline__ unsigned xb_xcc_id() { return (unsigned)__builtin_amdgcn_s_getreg((3 << 11) | 20) & 0xFu; }
#define XB_SPIN(cond, bar) do { unsigned _sp = 0; while (cond) { __builtin_amdgcn_s_sleep(1); \
    if ((++_sp & 255u) == 0u) { if (xb_ld(&(bar)[XB_TMO])) break; if (_sp > XB_SPIN_CAP) { atomicAdd(&(bar)[XB_TMO], 1u); break; } } } } while (0)

struct XcdBarrier {
    unsigned* bar; unsigned x;
    volatile LAS unsigned* st;
};

__device__ __forceinline__ XcdBarrier xcd_barrier_post(unsigned* bar, volatile LAS unsigned* st) {
    XcdBarrier b; b.bar = bar; b.x = xb_xcc_id(); b.st = st;
    if (threadIdx.x == 0) (void)xb_add(&bar[XB_XCNT(b.x)], 1u);
    return b;
}
__device__ __forceinline__ void xcd_barrier_complete(unsigned* bar, unsigned x, unsigned& nloc, unsigned& nx) {
    const unsigned G = gridDim.x * gridDim.y * gridDim.z;
    unsigned sum, cnt, mine, sp = 0u;
    for (;;) {
        sum = 0u; cnt = 0u; mine = 0u;
#pragma unroll
        for (unsigned j = 0; j < 16; ++j) { const unsigned c = xb_ld(&bar[XB_XCNT(j)]); sum += c; cnt += (c > 0u) ? 1u : 0u; mine = (j == x) ? c : mine; }
        if (sum == G) break;
        __builtin_amdgcn_s_sleep(1);
        if ((++sp & 255u) == 0u) { if (xb_ld(&bar[XB_TMO])) break; if (sp > XB_SPIN_CAP) { atomicAdd(&bar[XB_TMO], 1u); break; } }
    }
    nloc = mine > 0u ? mine : 1u; nx = cnt > 0u ? cnt : 1u;
}

__device__ __forceinline__ void xcd_barrier(const XcdBarrier& b) {
    asm volatile("s_waitcnt vmcnt(0)" ::: "memory");
    __syncthreads();
    if (threadIdx.x == 0) {
        unsigned* bar = b.bar;
        __builtin_amdgcn_s_waitcnt(0);
        unsigned nloc = b.st[0], nx = b.st[1];
        if (nloc == 0u) { xcd_barrier_complete(bar, b.x, nloc, nx); b.st[0] = nloc; b.st[1] = nx; }
        const unsigned old = xb_add(&bar[XB_XSUB(b.x)], 1u);
        const unsigned gen = old / nloc;
        if (old + 1u == (gen + 1u) * nloc) {
            __builtin_amdgcn_fence(__ATOMIC_RELEASE, "agent");
            asm volatile("s_waitcnt vmcnt(0)" ::: "memory");
            const unsigned og = xb_add(&bar[XB_TOP], 1u);
            const unsigned tg = og / nx;
            if (og + 1u == (tg + 1u) * nx) xb_add(&bar[XB_TOPGEN], 1u);
            else XB_SPIN(xb_ld(&bar[XB_TOPGEN]) == tg, bar);
            __builtin_amdgcn_fence(__ATOMIC_ACQUIRE, "agent");
            xb_add(&bar[XB_XGEN(b.x)], 1u);
            asm volatile("s_waitcnt vmcnt(0)" ::: "memory");
        } else {
            XB_SPIN(xb_ld(&bar[XB_XGEN(b.x)]) == gen, bar);
            __builtin_amdgcn_fence(__ATOMIC_ACQUIRE, "agent");
            asm volatile("s_waitcnt vmcnt(0)" ::: "memory");
        }
    }
    __syncthreads();
}

constexpr int NWAVES = 8;
constexpr int RING_OFF = 0, RING_BYTES = 131072;
constexpr int LDSCTL_OFF = RING_BYTES, MISC_OFF = LDSCTL_OFF + 320;
constexpr int LDS_BYTES = 147456;
constexpr int CW_TMO = 0, CW_CODE = 1, CW_BAR = 4096;
constexpr int PH_PER_LAYER = 12 - (HIDE_CONV ? 1 : 0) - (FUSE_RET ? 2 : 0) - (FUSE_GM ? 1 : 0);
constexpr int N_PHASES = 1 + PH_PER_LAYER * DEPTH;

#define CAS __attribute__((address_space(4)))
struct Args { const GAS float* in[N_IN]; GAS float* out; GAS unsigned char* ws; double ropec[32]; float lam_init[2]; };

template <class T> __device__ __forceinline__ T* as_global(GAS T* p) { return (T*)p; }
__device__ __forceinline__ int conv_dst_row(int mode, int row_off, int n0) {
    if (mode == 0) return row_off + n0;
    if (mode == 1) return 256 * (n0 >> 7) + (n0 & 127) + row_off;
    return (n0 < NIN1) ? ((n0 & ~255) + 128 * ((n0 >> 5) & 1) + 32 * ((n0 >> 6) & 3)) : n0;
}
__device__ __forceinline__ void conv_item(const float* W, const float* gain, int K, int N, bf16_t* WT, int mode, int row_off, LAS float* scr, int item, int lane) {
    const int nblk = N / 32, kb = item / nblk, nb = item % nblk, k0 = 64 * kb, n0 = 32 * nb;
    float wv[32], gv[32];
#pragma unroll
    for (int i = 0; i < 32; ++i) { const int kk = 2 * i + (lane >> 5); wv[i] = W[(size_t)(k0 + kk) * N + n0 + (lane & 31)]; gv[i] = gain ? gain[k0 + kk] : 1.0f; }
#pragma unroll
    for (int i = 0; i < 32; ++i) { const int kk = 2 * i + (lane >> 5); scr[kk * 33 + (lane & 31)] = wv[i] * gv[i]; }
    LDS_WAIT(); asm volatile("" ::: "memory");
    const int c = lane & 7, drow = conv_dst_row(mode, row_off, n0);
#pragma unroll
    for (int j = 0; j < 4; ++j) { const int n = (lane >> 3) + 8 * j; const LAS float* s = scr + (8 * c) * 33 + n;
        u32x4 o; o.x = pk2(s[0 * 33], s[1 * 33]); o.y = pk2(s[2 * 33], s[3 * 33]); o.z = pk2(s[4 * 33], s[5 * 33]); o.w = pk2(s[6 * 33], s[7 * 33]);
        *(GAS u32x4*)(WT + (size_t)(drow + n) * K + k0 + 8 * c) = o; }
    LDS_WAIT(); asm volatile("" ::: "memory");
}
__device__ __forceinline__ void convert_layer(const CAS Args& a, unsigned char* ws, int l, int part, LAS unsigned char* lds, int gw, int ngw, int wave, int lane) {
    LAS float* scr = (LAS float*)(lds + wave * 16384);
    unsigned char* wb = ws + WS_W;
    constexpr int I_GU = (DM / 64) * (DFF / 32), I_D = (DFF / 64) * (DM / 32), I_IN = (DM / 64) * (NIN / 32), I_BR = (512 / 64) * (DM / 32), I_O = (DM / 64) * (DM / 32);
    constexpr int NITEMS = 4 * I_GU + 2 * I_D + I_IN + 3 * I_BR + I_O;
    const size_t oGU = (size_t)l * DM * DFF, oD = (size_t)l * DFF * DM, oIN = (size_t)l * DM * NIN, oBR = (size_t)l * 512 * DM, oO = (size_t)l * DM * DM;
    constexpr int P1 = 2 * I_GU + I_D, P2 = P1 + I_IN + 3 * I_BR + I_O;
    const int it_lo = (part <= 1) ? 0 : (part == 2 ? P1 : P2), it_hi = (part == 0 || part == 3) ? NITEMS : (part == 1 ? P1 : P2);
    for (int it = it_lo + gw; it < it_hi; it += ngw) {
        int r = it;
        if (r < I_GU) { conv_item(as_global(a.in[I_F1G]) + oGU, as_global(a.in[I_F1N]) + l * DM, DM, DFF, (bf16_t*)(wb + W_GU1), 1, 0, scr, r, lane); continue; } r -= I_GU;
        if (r < I_GU) { conv_item(as_global(a.in[I_F1U]) + oGU, as_global(a.in[I_F1N]) + l * DM, DM, DFF, (bf16_t*)(wb + W_GU1), 1, 128, scr, r, lane); continue; } r -= I_GU;
        if (r < I_D)  { conv_item(as_global(a.in[I_F1D]) + oD, nullptr, DFF, DM, (bf16_t*)(wb + W_D1), 0, 0, scr, r, lane); continue; } r -= I_D;
        if (r < I_IN) { conv_item(as_global(a.in[I_WIN]) + oIN, as_global(a.in[I_MIXN]) + l * DM, DM, NIN, (bf16_t*)(wb + W_IN), 2, 0, scr, r, lane); continue; } r -= I_IN;
        if (r < I_BR) { conv_item(as_global(a.in[I_WBA]) + oBR, nullptr, 512, DM, (bf16_t*)(wb + W_BR), 0, 0, scr, r, lane); continue; } r -= I_BR;
        if (r < I_BR) { conv_item(as_global(a.in[I_WBB]) + oBR, nullptr, 512, DM, (bf16_t*)(wb + W_BR), 0, DM, scr, r, lane); continue; } r -= I_BR;
        if (r < I_BR) { conv_item(as_global(a.in[I_WBC]) + oBR, nullptr, 512, DM, (bf16_t*)(wb + W_BR), 0, 2 * DM, scr, r, lane); continue; } r -= I_BR;
        if (r < I_O)  { conv_item(as_global(a.in[I_WOUT]) + oO, nullptr, DM, DM, (bf16_t*)(wb + W_OUT), 0, 0, scr, r, lane); continue; } r -= I_O;
        if (r < I_GU) { conv_item(as_global(a.in[I_F2G]) + oGU, as_global(a.in[I_F2N]) + l * DM, DM, DFF, (bf16_t*)(wb + W_GU2), 1, 0, scr, r, lane); continue; } r -= I_GU;
        if (r < I_GU) { conv_item(as_global(a.in[I_F2U]) + oGU, as_global(a.in[I_F2N]) + l * DM, DM, DFF, (bf16_t*)(wb + W_GU2), 1, 128, scr, r, lane); continue; } r -= I_GU;
        conv_item(as_global(a.in[I_F2D]) + oD, nullptr, DFF, DM, (bf16_t*)(wb + W_D2), 0, 0, scr, r, lane);
    }
}
__device__ __forceinline__ void rope_tables(const CAS Args& a, unsigned char* ws, int gtid, int ngt) {
    float* cosT = (float*)(ws + WS_COS); float* sinT = (float*)(ws + WS_SIN);
    for (int i = gtid; i < SEQ * 32; i += ngt) { const int t = i >> 5, k = i & 31;
        const double rev = (double)t * a.ropec[k]; const float fr = (float)(rev - floor(rev));
        cosT[i] = __builtin_amdgcn_cosf(fr); sinT[i] = __builtin_amdgcn_sinf(fr); }
}


constexpr int CW_CNT = 32768;
__device__ __forceinline__ void cnt_signal(gu32* ctl, int idx) {
    asm volatile("s_waitcnt vmcnt(0)" ::: "memory");
    __syncthreads();
    if (threadIdx.x == 0) {
        __builtin_amdgcn_fence(__ATOMIC_RELEASE, "agent");
        asm volatile("s_waitcnt vmcnt(0)" ::: "memory");
        (void)__hip_atomic_fetch_add((unsigned*)(ctl + CW_CNT + 64 * idx), 1u, __ATOMIC_RELAXED, __HIP_MEMORY_SCOPE_AGENT);
    }
}
__device__ __forceinline__ void cnt_wait(gu32* ctl, int idx, unsigned want) {
    if (threadIdx.x == 0) {
        unsigned sp = 0;
        while (__hip_atomic_load((unsigned*)(ctl + CW_CNT + 64 * idx), __ATOMIC_RELAXED, __HIP_MEMORY_SCOPE_AGENT) < want) {
            __builtin_amdgcn_s_sleep(2);
            if (++sp > (1u << 22)) { __hip_atomic_store((unsigned*)(ctl + CW_TMO), 1u, __ATOMIC_RELAXED, __HIP_MEMORY_SCOPE_AGENT); break; }
        }
        __builtin_amdgcn_fence(__ATOMIC_ACQUIRE, "agent");
        asm volatile("s_waitcnt vmcnt(0)" ::: "memory");
    }
    __syncthreads();
}
struct Ctx { LAS unsigned char* lds; int tid, lane, wave, vcu, G, bx, gw, ngw; unsigned char* ws; float* X; const CAS Args* ap; };
enum { K_PRO = 0, K_CONV, K_UP, K_DOWN, K_WIN, K_KV, K_SCAN, K_MIX, K_GATE, K_MERGE, K_WOUT, N_KINDS };
__host__ __device__ __forceinline__ void phase_decode(int ph, int& kind, int& l, int& ffn2) {
    if (ph == 0) { kind = K_PRO; l = 0; ffn2 = 0; return; }
    int k = (ph - 1) % PH_PER_LAYER + (HIDE_CONV ? 1 : 0); l = (ph - 1) / PH_PER_LAYER;
    if (FUSE_RET && k >= 4) k += 2;
    if (FUSE_GM && k >= 8) k += 1;
    ffn2 = (k >= 10);
    const int tab[12] = {K_CONV, K_UP, K_DOWN, K_WIN, K_KV, K_SCAN, K_MIX, K_GATE, K_MERGE, K_WOUT, K_UP, K_DOWN};
    kind = (k == 0) ? K_CONV : (k == 1 || k == 10) ? K_UP : (k == 2 || k == 11) ? K_DOWN : (k == 3) ? K_WIN : (k == 4) ? K_KV : (k == 5) ? K_SCAN : (k == 6) ? K_MIX : (k == 7) ? K_GATE : (k == 8) ? K_MERGE : K_WOUT;
    (void)tab;
}
__device__ __forceinline__ int vcu_idle(int bx) { return bx - 128; }
template <int KIND>
__device__ __forceinline__ void phase_body(const Ctx& c, const int l, const int ffn2) {
    const CAS Args& args = *c.ap; unsigned char* ws = c.ws; float* X = c.X; LAS unsigned char* lds = c.lds;
    const int tid = c.tid, lane = c.lane, wave = c.wave, vcu = c.vcu, G = c.G, bx = c.bx, gw = c.gw, ngw = c.ngw;
    bf16_t* XB = (bf16_t*)(ws + WS_XB); float* SSQ = (float*)(ws + WS_SSQ);
    const float* cosT = (const float*)(ws + WS_COS); const float* sinT = (const float*)(ws + WS_SIN);
    unsigned char* wb = ws + WS_W;
    (void)tid; (void)lane; (void)wave; (void)vcu; (void)G; (void)bx; (void)gw; (void)ngw; (void)XB; (void)SSQ; (void)cosT; (void)sinT; (void)wb; (void)X; (void)lds;
    if constexpr (KIND == K_PRO) {
#if NAIVE_WIN
        rope_tables(args, ws, (vcu * NWAVES * 64) + tid, G * NWAVES * 64);
#endif
        if (bx == 0 && tid < 4) ((unsigned*)(ws + WS_ONES))[tid] = 0x3f803f80u;
        naive::xb_ssq_pass(as_global(args.in[I_X]), XB, SSQ, gw, ngw, lane);
        convert_layer(args, ws, 0, (HIDE_CONV && G == 256) ? 1 : 0, lds, gw, ngw, wave, lane);
    } else if constexpr (KIND == K_CONV) {
        if (l > 0) convert_layer(args, ws, l, 0, lds, gw, ngw, wave, lane);
    } else if constexpr (KIND == K_UP) {
#if NAIVE_UP
        const float* xin = (l == 0 && !ffn2) ? as_global(args.in[I_X]) : X;
        naive::gemm<2, true, true, 4>(lds, tid, vcu, G, DFF, DM, xin, (ffn2 ? as_global(args.in[I_F2N]) : as_global(args.in[I_F1N])) + l * DM, nullptr, nullptr, nullptr, 0,
                                   (ffn2 ? as_global(args.in[I_F2G]) : as_global(args.in[I_F1G])) + (size_t)l * DM * DFF, (ffn2 ? as_global(args.in[I_F2U]) : as_global(args.in[I_F1U])) + (size_t)l * DM * DFF, nullptr, DFF, naive::NEpiUp{(bf16_t*)(ws + WS_HB)});
#else
        pg8::Gemm g{XB, (const bf16_t*)(wb + (ffn2 ? W_GU2 : W_GU1)), DM, 0, 0};
        pg8::StaticOrder S; S.init(M, 2 * DFF, G, bx);
        pg8::gemm_phase(lds + RING_OFF, tid, g, S, epi::EpiUp{(bf16_t*)(ws + WS_HB), (const LAS float*)(lds + epi::EPI_RSTD_OFF)}, [&]() { epi::fill_rstd_table(lds, tid, SSQ, S); });
#if HIDE_CONV
        if (G == 256 && bx >= 128) { if (l == 0 && !ffn2) convert_layer(args, ws, 0, 2, lds, (vcu_idle(bx)) * NWAVES + wave, 128 * NWAVES, wave, lane);
                                     if (l == 0 && ffn2)  convert_layer(args, ws, 1, 1, lds, (vcu_idle(bx)) * NWAVES + wave, 128 * NWAVES, wave, lane);
                                     if (l == 1 && !ffn2) convert_layer(args, ws, 1, 2, lds, (vcu_idle(bx)) * NWAVES + wave, 128 * NWAVES, wave, lane); }
#endif
#endif
    } else if constexpr (KIND == K_DOWN) {
        const float* xold = (l == 0 && !ffn2) ? as_global(args.in[I_X]) : X;
#if NAIVE_DOWN
        naive::gemm<1, true, false, 4>(lds, tid, vcu, G, DM, DFF, nullptr, nullptr, (const bf16_t*)(ws + WS_HB), nullptr, nullptr, DFF,
                                    (ffn2 ? as_global(args.in[I_F2D]) : as_global(args.in[I_F1D])) + (size_t)l * DFF * DM, nullptr, nullptr, DM, naive::NEpiRes{xold, X, XB, SSQ, 0.5f});
#else
        pg8::Gemm g{(const bf16_t*)(ws + WS_HB), (const bf16_t*)(wb + (ffn2 ? W_D2 : W_D1)), DFF, 0, 0};
        pg8::StaticOrder S; S.init(M, DM, G, bx);
        pg8::gemm_phase(lds + RING_OFF, tid, g, S, epi::EpiRes{xold, X, XB, SSQ, 0.5f});
#endif
    } else if constexpr (KIND == K_WIN) {
#if NAIVE_WIN
        naive::gemm<1, true, true, 4>(lds, tid, vcu, G, NIN1, DM, X, as_global(args.in[I_MIXN]) + l * DM, nullptr, nullptr, nullptr, 0,
                                   as_global(args.in[I_WIN]) + (size_t)l * DM * NIN, nullptr, nullptr, NIN,
                                   naive::NEpiWin{ws, cosT, sinT, as_global(args.in[I_AQN]) + l * 64, as_global(args.in[I_AKN]) + l * 64, as_global(args.in[I_BQN]) + l * 64, as_global(args.in[I_BKN]) + l * 64});
#else
        pg8::Gemm g{XB, (const bf16_t*)(wb + W_IN), DM, 0, 0};
        pg8::StaticOrder S; S.init(M, NIN1, G, bx);
        epi::fill_rstd_table(lds, tid, SSQ, S);
        { LAS float* gt = (LAS float*)(lds + epi::EPI_GAIN_OFF); LAS float* rt = (LAS float*)(lds + epi::EPI_ROPE_OFF);
          if (tid < 256) { const int kq = tid >> 6; const float* gp = (kq == 0) ? as_global(args.in[I_AQN]) : (kq == 1) ? as_global(args.in[I_AKN]) : (kq == 2) ? as_global(args.in[I_BQN]) : as_global(args.in[I_BKN]); gt[tid] = gp[l * 64 + (tid & 63)]; }
          else if (tid < 288) rt[tid - 256] = (float)args.ropec[tid - 256]; }
        __syncthreads();
        pg8::gemm_phase(lds + RING_OFF, tid, g, S, epi::EpiWin{ws, (const LAS float*)(lds + epi::EPI_RSTD_OFF), (const LAS float*)(lds + epi::EPI_GAIN_OFF), (const LAS float*)(lds + epi::EPI_ROPE_OFF)});
#if HIDE_CONV
        if (G == 256 && bx >= 128) convert_layer(args, ws, l, 3, lds, (vcu_idle(bx)) * NWAVES + wave, 128 * NWAVES, wave, lane);
#endif
#endif
    } else if constexpr (KIND == K_KV) {
#if !NAIVE_C
        fa::ret_kv_phase(lds, tid, ws, gw, ngw);
#endif
    } else if constexpr (KIND == K_SCAN) {
#if !NAIVE_C
        fa::ret_scan_phase(tid, ws, vcu, G);
#endif
    } else if constexpr (KIND == K_MIX) {
#if FUSE_RET && !NAIVE_C && !NAIVE_B && !NAIVE_A
        {
            gu32* ctl = (gu32*)(ws + WS_CTL);
            fa::ret_kv_phase(lds, tid, ws, gw, ngw);
            cnt_signal(ctl, l * 16 + (vcu >> 5));
            fa::attn_b_phase(lds, tid, ws, (bf16_t*)(ws + WS_BQ), vcu, G, as_global(args.in[I_BREL]) + l * 8 * 320, as_global(args.in[I_BQN]) + l * 64, as_global(args.in[I_BKN]) + l * 64);
            if (vcu < 128) { cnt_wait(ctl, l * 16 + (vcu >> 4), 32u); fa::ret_scan_phase(tid, ws, vcu, G); cnt_signal(ctl, l * 16 + 8 + (vcu >> 4)); }
            __syncthreads();
            fa::attn_a_phase(lds, tid, ws, (bf16_t*)(ws + WS_AQ), vcu, G, as_global(args.in[I_LQ1]) + l * 64, as_global(args.in[I_LK1]) + l * 64, as_global(args.in[I_LQ2]) + l * 64, as_global(args.in[I_LK2]) + l * 64, as_global(args.in[I_ASUB]) + l * 128, (l == 0 ? args.lam_init[0] : args.lam_init[1]), as_global(args.in[I_AQN]) + l * 64, as_global(args.in[I_AKN]) + l * 64);
            cnt_wait(ctl, l * 16 + 8 + (vcu >> 5), 16u);
            fa::ret_out_phase(lds, tid, ws, gw, ngw, as_global(args.in[I_CON]) + l * 512);
        }
#else
#if NAIVE_C
        naive::retention(ws, as_global(args.in[I_CON]) + l * 512, lds, vcu, G, tid);
#else
        fa::ret_out_phase(lds, tid, ws, gw, ngw, as_global(args.in[I_CON]) + l * 512);
#endif
        __syncthreads();
#if NAIVE_B
        naive::attn_b(ws, as_global(args.in[I_BREL]) + l * 8 * 320, lds, gw, ngw, wave, lane);
#else
#if PROBE_B
        for (int rep = 0; rep < PROBE_B; ++rep) { fa::attn_b_phase(lds, tid, ws, (bf16_t*)(ws + WS_W), vcu, G, as_global(args.in[I_BREL]) + l * 8 * 320, as_global(args.in[I_BQN]) + l * 64, as_global(args.in[I_BKN]) + l * 64); __syncthreads(); }
#endif
        fa::attn_b_phase(lds, tid, ws, (bf16_t*)(ws + WS_BQ), vcu, G, as_global(args.in[I_BREL]) + l * 8 * 320, as_global(args.in[I_BQN]) + l * 64, as_global(args.in[I_BKN]) + l * 64);
#endif
        __syncthreads();
#if NAIVE_A
        naive::attn_a(ws, as_global(args.in[I_LQ1]) + l * 64, as_global(args.in[I_LK1]) + l * 64, as_global(args.in[I_LQ2]) + l * 64, as_global(args.in[I_LK2]) + l * 64, as_global(args.in[I_ASUB]) + l * 128, (l == 0 ? args.lam_init[0] : args.lam_init[1]), lds, gw, ngw, wave, lane);
#else
#if PROBE_A
        for (int rep = 0; rep < PROBE_A; ++rep) { fa::attn_a_phase(lds, tid, ws, (bf16_t*)(ws + WS_W), vcu, G, as_global(args.in[I_LQ1]) + l * 64, as_global(args.in[I_LK1]) + l * 64, as_global(args.in[I_LQ2]) + l * 64, as_global(args.in[I_LK2]) + l * 64, as_global(args.in[I_ASUB]) + l * 128, (l == 0 ? args.lam_init[0] : args.lam_init[1]), as_global(args.in[I_AQN]) + l * 64, as_global(args.in[I_AKN]) + l * 64, PROBE_PM); __syncthreads(); }
#endif
#define MK_PROBE_STRETCH 1
        fa::attn_a_phase(lds, tid, ws, (bf16_t*)(ws + WS_AQ), vcu, G, as_global(args.in[I_LQ1]) + l * 64, as_global(args.in[I_LK1]) + l * 64, as_global(args.in[I_LQ2]) + l * 64, as_global(args.in[I_LK2]) + l * 64, as_global(args.in[I_ASUB]) + l * 128, (l == 0 ? args.lam_init[0] : args.lam_init[1]), as_global(args.in[I_AQN]) + l * 64, as_global(args.in[I_AKN]) + l * 64);
#endif
#endif
#if PROBE_T
        __syncthreads();
        if (bx == 0 && tid == 0 && l == 1) {
            const unsigned long long* pr = (const unsigned long long*)(ws + WS_PROBE);
            const unsigned long long v = pr[PROBE_SEL]; const unsigned long long t0 = __builtin_amdgcn_s_memrealtime();
            while (__builtin_amdgcn_s_memrealtime() - t0 < v * 100ull) __builtin_amdgcn_s_sleep(32);
        }
#endif
    } else if constexpr (KIND == K_GATE) {
#if NAIVE_GATE
        naive::gemm<1, true, true, 4>(lds, tid, vcu, G, NGATE, DM, X, as_global(args.in[I_MIXN]) + l * DM, nullptr, nullptr, nullptr, 0,
                                   as_global(args.in[I_WIN]) + (size_t)l * DM * NIN + NIN1, nullptr, nullptr, NIN, naive::NEpiGate{(bf16_t*)(ws + WS_GT)});
#else
#if FUSE_GM
        {
            pg8::Gemm g{XB, (const bf16_t*)(wb + W_IN) + (size_t)NIN1 * DM, DM, 0, (size_t)1024 * DM * 2};
            pg8::StaticOrder S; S.init(M, DM, G, bx);
            pg8::gemm_phase<3>(lds + RING_OFF, tid, g, S, epi::EpiGate{(bf16_t*)(ws + WS_GT), (const LAS float*)(lds + epi::EPI_RSTD_OFF)}, [&]() { epi::fill_rstd_table(lds, tid, SSQ, S); });
            asm volatile("s_waitcnt vmcnt(0)" ::: "memory"); __syncthreads();
            int tid2 = tid; asm volatile("" : "+v"(tid2));
            pg8::Gemm g2{(const bf16_t*)(ws + WS_AQ), (const bf16_t*)(wb + W_BR), 512, P16, (size_t)DM * 512 * 2};
            pg8::StaticOrder S2; S2.init(M, DM, G, bx);
            pg8::gemm_phase<3>(lds + RING_OFF, tid2, g2, S2, epi::EpiMerge{(const bf16_t*)(ws + WS_GT), (bf16_t*)(ws + WS_MG), (const unsigned*)(ws + WS_ONES)});
        }
#else
        pg8::Gemm g{XB, (const bf16_t*)(wb + W_IN) + (size_t)NIN1 * DM, DM, 0, 0};
        pg8::StaticOrder S; S.init(M, NGATE, G, bx);
        pg8::gemm_phase(lds + RING_OFF, tid, g, S, epi::EpiGate{(bf16_t*)(ws + WS_GT), (const LAS float*)(lds + epi::EPI_RSTD_OFF)}, [&]() { epi::fill_rstd_table(lds, tid, SSQ, S); });
#endif
#endif
    } else if constexpr (KIND == K_MERGE) {
#if NAIVE_MERGE
        naive::gemm<3, false, false, 2>(lds, tid, vcu, G, DM, 512, nullptr, nullptr, (const bf16_t*)(ws + WS_AQ), (const bf16_t*)(ws + WS_BQ), (const bf16_t*)(ws + WS_CG), 512,
                                     as_global(args.in[I_WBA]) + (size_t)l * 512 * DM, as_global(args.in[I_WBB]) + (size_t)l * 512 * DM, as_global(args.in[I_WBC]) + (size_t)l * 512 * DM, DM,
                                     naive::NEpiMerge{(const bf16_t*)(ws + WS_GT), (bf16_t*)(ws + WS_MG)});
#else
        static_assert(WS_BQ - WS_AQ == P16 && WS_CG - WS_BQ == P16, "y_a, y_b, y_c equally spaced");
        pg8::Gemm g{(const bf16_t*)(ws + WS_AQ), (const bf16_t*)(wb + W_BR), 512, P16, (size_t)DM * 512 * 2};
        pg8::StaticOrder S; S.init(M, DM, G, bx);
        pg8::gemm_phase<3>(lds + RING_OFF, tid, g, S, epi::EpiMerge{(const bf16_t*)(ws + WS_GT), (bf16_t*)(ws + WS_MG), (const unsigned*)(ws + WS_ONES)});
#endif
    } else if constexpr (KIND == K_WOUT) {
#if NAIVE_WOUT
        naive::gemm<1, true, false, 4>(lds, tid, vcu, G, DM, DM, nullptr, nullptr, (const bf16_t*)(ws + WS_MG), nullptr, nullptr, DM,
                                    as_global(args.in[I_WOUT]) + (size_t)l * DM * DM, nullptr, nullptr, DM, naive::NEpiRes{X, X, XB, SSQ, 1.0f});
#else
        pg8::Gemm g{(const bf16_t*)(ws + WS_MG), (const bf16_t*)(wb + W_OUT), DM, 0, 0};
        pg8::StaticOrder S; S.init(M, DM, G, bx);
        pg8::gemm_phase(lds + RING_OFF, tid, g, S, epi::EpiRes{X, X, XB, SSQ, 1.0f});
#endif
    }
}
__device__ __forceinline__ Ctx make_ctx(LAS unsigned char* lds, const int wave_s) {
    Ctx c; c.lds = lds;
    int lane_; asm volatile("v_mbcnt_lo_u32_b32 %0, -1, 0\n\tv_mbcnt_hi_u32_b32 %0, -1, %0" : "=&v"(lane_));
    int tid = wave_s * 64 + lane_; asm volatile("" : "+v"(tid));
    const CAS Args* argp = (const CAS Args*)__builtin_amdgcn_kernarg_segment_ptr(); asm volatile("" : "+s"(argp));
    c.ap = argp; c.tid = tid; c.lane = tid & 63; c.wave = __builtin_amdgcn_readfirstlane(tid >> 6);
    c.G = gridDim.x; c.bx = blockIdx.x; c.vcu = (c.G % 8 == 0) ? (c.bx % 8) * (c.G / 8) + c.bx / 8 : c.bx;
    c.gw = c.vcu * NWAVES + c.wave; c.ngw = c.G * NWAVES;
    GAS unsigned char* ws = argp->ws; asm volatile("" : "+s"(ws)); c.ws = as_global(ws);
    GAS float* X = argp->out; asm volatile("" : "+s"(X)); c.X = as_global(X);
    return c;
}
#if MK_PER_PHASE_LAUNCH
template <int KIND>
__global__ void __launch_bounds__(NWAVES * 64, 2) phase_kernel(Args args_, int l, int ffn2) {
    extern __shared__ __attribute__((aligned(16))) unsigned char lds_raw[];
    const Ctx c = make_ctx((LAS unsigned char*)lds_raw, __builtin_amdgcn_readfirstlane(threadIdx.x >> 6));
    phase_body<KIND>(c, l, ffn2);
}
#endif
#if !MK_PER_PHASE_LAUNCH
__global__ void __launch_bounds__(NWAVES * 64, 2) trunk_fwd(Args args_) {
    extern __shared__ __attribute__((aligned(16))) unsigned char lds_raw[];
    LAS unsigned char* lds = (LAS unsigned char*)lds_raw;
    volatile LAS unsigned* MISC = (volatile LAS unsigned*)(lds + MISC_OFF);
    gu32* ctl = (gu32*)(args_.ws + WS_CTL);
    for (int u = threadIdx.x; u < (LDS_BYTES - LDSCTL_OFF) / 4; u += NWAVES * 64) ((LAS unsigned*)(lds + LDSCTL_OFF))[u] = 0u;
    __syncthreads();
    XcdBarrier bar = xcd_barrier_post((unsigned*)(ctl + CW_BAR), MISC + 8);
    const int wave_s = __builtin_amdgcn_readfirstlane(threadIdx.x >> 6);
    for (int ph = 0; ph < N_PHASES; ++ph) {
        const Ctx c = make_ctx(lds, wave_s);
        int kind_, l_, ffn2_; phase_decode(ph, kind_, l_, ffn2_);
        const int kind = __builtin_amdgcn_readfirstlane(kind_), l = __builtin_amdgcn_readfirstlane(l_), ffn2 = __builtin_amdgcn_readfirstlane(ffn2_);
#if PROBE_MASK
        if ((PROBE_MASK >> kind) & 1) {
            switch (kind) {
            case K_CONV: phase_body<K_CONV>(c, l, ffn2); break;
#if PROBE_NULL
            case K_UP: { pg8::Gemm g{(const bf16_t*)(c.ws + WS_XB), (const bf16_t*)(c.ws + WS_W + (ffn2 ? W_GU2 : W_GU1)), DM, 0, 0}; pg8::StaticOrder S; S.init(M, 2 * DFF, c.G, c.bx); pg8::gemm_phase(c.lds + RING_OFF, c.tid, g, S, epi::EpiNull{}); } break;
#else
            case K_UP: phase_body<K_UP>(c, l, ffn2); break;
#endif
            case K_WIN: phase_body<K_WIN>(c, l, ffn2); break;
            case K_KV: phase_body<K_KV>(c, l, ffn2); break;
            case K_GATE: phase_body<K_GATE>(c, l, ffn2); break;
            case K_MERGE: phase_body<K_MERGE>(c, l, ffn2); break;
            default: break;
            }
            xcd_barrier(bar);
        }
#endif
#if PROBE_PH
        unsigned long long tp0 = __builtin_amdgcn_s_memrealtime();
#endif
        switch (kind) {
        case K_PRO: phase_body<K_PRO>(c, l, ffn2); break;
        case K_CONV: phase_body<K_CONV>(c, l, ffn2); break;
        case K_UP: phase_body<K_UP>(c, l, ffn2); break;
        case K_DOWN: phase_body<K_DOWN>(c, l, ffn2); break;
        case K_WIN: phase_body<K_WIN>(c, l, ffn2); break;
        case K_KV: phase_body<K_KV>(c, l, ffn2); break;
        case K_SCAN: phase_body<K_SCAN>(c, l, ffn2); break;
        case K_MIX: phase_body<K_MIX>(c, l, ffn2); break;
        case K_GATE: phase_body<K_GATE>(c, l, ffn2); break;
        case K_MERGE: phase_body<K_MERGE>(c, l, ffn2); break;
        default: phase_body<K_WOUT>(c, l, ffn2); break;
        }
#if PROBE_PH
        __syncthreads(); const unsigned long long tp1 = __builtin_amdgcn_s_memrealtime();
#endif
        if (ph + 1 < N_PHASES) xcd_barrier(bar);
#if PROBE_PH
        if (blockIdx.x == PROBE_BLK && threadIdx.x == 0) { const unsigned long long tp2 = __builtin_amdgcn_s_memrealtime(); unsigned long long* pr = (unsigned long long*)(args_.ws + WS_PROBE);
            pr[kind] += tp1 - tp0; pr[16] += tp2 - tp1; pr[17] += tp2 - tp0; pr[20 + kind] += tp2 - tp1; }
#endif
    }
#if PROBE_PH
    if (blockIdx.x == PROBE_BLK && threadIdx.x == 0) {
        const unsigned long long v = ((const unsigned long long*)(args_.ws + WS_PROBE))[PROBE_SEL] / 100; const unsigned long long t0 = __builtin_amdgcn_s_memrealtime();
        while (__builtin_amdgcn_s_memrealtime() - t0 < v * 100ull) __builtin_amdgcn_s_sleep(32);
    }
#endif
}
#endif

#if MK_PER_PHASE_LAUNCH
template <int KIND> static void launch_phase(int grid, hipStream_t stream, const Args& a, int l, int ffn2) {
    static bool attr = false;
    if (!attr) { (void)hipFuncSetAttribute((const void*)phase_kernel<KIND>, hipFuncAttributeMaxDynamicSharedMemorySize, LDS_BYTES); attr = true; }
    hipLaunchKernelGGL(phase_kernel<KIND>, dim3(grid), dim3(NWAVES * 64), LDS_BYTES, stream, a, l, ffn2);
}
#endif
extern "C" void kernel_launch(void* const* d_in, const int* in_sizes, int n_in, void* d_out, int out_size, void* d_ws, size_t ws_size, hipStream_t stream) {
    static int grid = 0;
    if (grid == 0) {
        if (n_in != N_IN || in_sizes[0] != M * DM || out_size != M * DM || ws_size < WS_END) { fprintf(stderr, "kernel_launch: unexpected shapes (n_in %d, in0 %d, out %d, ws %zu < %zu); nothing launched\n", n_in, n_in > 0 ? in_sizes[0] : -1, out_size, ws_size, (size_t)WS_END); grid = -1; return; }
        int dev = 0, cus = 0, per_cu = 0;
        if (hipGetDevice(&dev) != hipSuccess || hipDeviceGetAttribute(&cus, hipDeviceAttributeMultiprocessorCount, dev) != hipSuccess) { grid = -1; return; }
#if !MK_PER_PHASE_LAUNCH
        if (hipFuncSetAttribute((const void*)trunk_fwd, hipFuncAttributeMaxDynamicSharedMemorySize, LDS_BYTES) != hipSuccess) { fprintf(stderr, "kernel_launch: hipFuncSetAttribute failed\n"); grid = -1; return; }
        if (hipOccupancyMaxActiveBlocksPerMultiprocessor(&per_cu, (const void*)trunk_fwd, NWAVES * 64, LDS_BYTES) != hipSuccess || per_cu < 1)
            fprintf(stderr, "kernel_launch: note: occupancy query reports %d workgroups per CU\n", per_cu);
        (void)hipGetLastError();
#endif
        (void)per_cu;
        if (cus < 256) { fprintf(stderr, "kernel_launch: built for a 256-CU device (found %d CUs); nothing launched\n", cus); grid = -1; return; }
        grid = 256;
    }
    if (grid < 0) return;
    (void)hipMemsetAsync((char*)d_ws + WS_CTL, 0, (FUSE_RET || PROBE_T || PROBE_PH) ? CTL_ZERO_BYTES : 32768, stream);
    Args a{};
    for (int i = 0; i < N_IN; ++i) a.in[i] = (const GAS float*)d_in[i];
    a.out = (GAS float*)d_out; a.ws = (GAS unsigned char*)d_ws;
    for (int i = 0; i < 32; ++i) a.ropec[i] = std::pow(10000.0, -(double)i / 32.0) / (2.0 * 3.14159265358979323846);
    for (int l = 0; l < 2; ++l) a.lam_init[l] = (float)(0.8 - 0.6 * std::exp(-0.3 * (double)l));
#if MK_PER_PHASE_LAUNCH
    for (int ph = 0; ph < N_PHASES; ++ph) {
        int kind, l, ffn2; phase_decode(ph, kind, l, ffn2);
        switch (kind) {
        case K_PRO: launch_phase<K_PRO>(grid, stream, a, l, ffn2); break;
        case K_CONV: if (l > 0) launch_phase<K_CONV>(grid, stream, a, l, ffn2); break;
        case K_UP: launch_phase<K_UP>(grid, stream, a, l, ffn2); break;
        case K_DOWN: launch_phase<K_DOWN>(grid, stream, a, l, ffn2); break;
        case K_WIN: launch_phase<K_WIN>(grid, stream, a, l, ffn2); break;
#if NAIVE_C
        case K_KV: case K_SCAN: break;
#else
        case K_KV: launch_phase<K_KV>(grid, stream, a, l, ffn2); break;
        case K_SCAN: launch_phase<K_SCAN>(grid, stream, a, l, ffn2); break;
#endif
        case K_MIX: launch_phase<K_MIX>(grid, stream, a, l, ffn2); break;
        case K_GATE: launch_phase<K_GATE>(grid, stream, a, l, ffn2); break;
        case K_MERGE: launch_phase<K_MERGE>(grid, stream, a, l, ffn2); break;
        default: launch_phase<K_WOUT>(grid, stream, a, l, ffn2); break;
        }
    }
#else
    hipLaunchKernelGGL(trunk_fwd, dim3(grid), dim3(NWAVES * 64), LDS_BYTES, stream, a);
#endif
    const hipError_t le = hipPeekAtLastError();
    if (le != hipSuccess) fprintf(stderr, "kernel_launch: launch failed: %s\n", hipGetErrorName(le));
}
```

```cpp
#define B_REV 1
#include <hip/hip_runtime.h>
#include <hip/hip_bf16.h>
#include <cstdio>
#include <cstdint>
#include <cmath>

#ifndef MK_PER_PHASE_LAUNCH
#define MK_PER_PHASE_LAUNCH 0
#endif
#ifndef NAIVE_GEMM
#define NAIVE_GEMM 0
#endif
#ifndef NAIVE_UP
#define NAIVE_UP NAIVE_GEMM
#endif
#ifndef NAIVE_DOWN
#define NAIVE_DOWN NAIVE_GEMM
#endif
#ifndef NAIVE_WIN
#define NAIVE_WIN NAIVE_GEMM
#endif
#ifndef NAIVE_GATE
#define NAIVE_GATE NAIVE_GEMM
#endif
#ifndef NAIVE_MERGE
#define NAIVE_MERGE NAIVE_GEMM
#endif
#ifndef NAIVE_WOUT
#define NAIVE_WOUT NAIVE_GEMM
#endif
#ifndef PROBE_MASK
#define PROBE_MASK 0
#endif
#ifndef PROBE_NULL
#define PROBE_NULL 0
#endif
#ifndef FA_V2
#define FA_V2 3
#endif
#ifndef PROBE_PM
#define PROBE_PM 0
#endif
#ifndef PROBE_T
#define PROBE_T 0
#endif
#ifndef PROBE_SEL
#define PROBE_SEL 0
#endif
#ifndef FA_WMAP
#define FA_WMAP 0
#endif
#ifndef HIDE_CONV
#define HIDE_CONV 1
#endif
#ifndef PROBE_PH
#define PROBE_PH 0
#endif
#ifndef PROBE_L
#define PROBE_L 0
#endif
#ifndef PROBE_KIND
#define PROBE_KIND 7
#endif
#ifndef B_REV
#define B_REV 0
#endif
#ifndef MIX_A_FIRST
#define MIX_A_FIRST 0
#endif
#ifndef A_LONG_FIRST
#define A_LONG_FIRST 1
#endif
#ifndef MIX_SETUP
#define MIX_SETUP 0
#endif
#ifndef SLOW_STAG
#define SLOW_STAG 0
#endif
#ifndef FA_PRIO
#define FA_PRIO 2
#endif
#ifndef DYN_RET
#define DYN_RET 0
#endif
#ifndef PROBE_LB
#define PROBE_LB 0
#endif
#ifndef LOCAL_BAR
#define LOCAL_BAR 0
#endif
#ifndef PROBE_BAR
#define PROBE_BAR 0
#endif
#ifndef PROBE_XCC
#define PROBE_XCC 0
#endif
#ifndef ST_SC1
#define ST_SC1 0
#endif
#ifndef BAR_FAST
#define BAR_FAST 2
#endif
#ifndef PROBE_KIND2
#define PROBE_KIND2 PROBE_KIND
#endif
#ifndef PROBE_XMAP
#define PROBE_XMAP 0
#endif
#ifndef SLOW_FREE
#define SLOW_FREE 0
#endif
#ifndef RET_BF16
#define RET_BF16 1
#endif
#ifndef NT_H
#define NT_H 0
#endif
#ifndef CONV_FIRST
#define CONV_FIRST 0
#endif
#ifndef PROBE_INIT
#define PROBE_INIT 0
#endif
#ifndef PROBE_BLK
#define PROBE_BLK 0
#endif
#ifndef FA_HAND
#define FA_HAND 1
#endif
#ifndef FUSE_RET
#define FUSE_RET 0
#endif
#ifndef FA_HANDB
#define FA_HANDB 1
#endif
#ifndef FA_NOMAX_BOUND_A
#define FA_NOMAX_BOUND_A 100.0f
#endif
#ifndef FA_NOMAX_BOUND_B
#define FA_NOMAX_BOUND_B 100.0f
#endif
#ifndef FUSE_GM
#define FUSE_GM 1
#endif
#ifndef PROBE_A
#define PROBE_A 0
#endif
#ifndef PROBE_B
#define PROBE_B 0
#endif
#ifndef NAIVE_A
#define NAIVE_A 0
#endif
#ifndef NAIVE_B
#define NAIVE_B 0
#endif
#ifndef NAIVE_C
#define NAIVE_C 0
#endif

constexpr int BATCH = 2, SEQ = 8192, DM = 1024, DEPTH = 2, M = BATCH * SEQ;
constexpr int DFF = 2816, NIN1 = 4608, NGATE = 3072, NIN = 7680;
constexpr float EPS = 1e-6f;
constexpr float LOG2E = 1.4426950408889634f;
constexpr float C2 = 0.125f * LOG2E;

enum { I_X = 0, I_F1N, I_F1G, I_F1U, I_F1D, I_MIXN, I_WIN, I_AQN, I_AKN, I_LQ1, I_LK1, I_LQ2, I_LK2, I_ASUB, I_BQN, I_BKN, I_BREL, I_CON, I_WBA, I_WBB, I_WBC, I_WOUT, I_F2N, I_F2G, I_F2U, I_F2D, N_IN };

constexpr size_t MiB = 1u << 20;
constexpr size_t WS_CTL = 0, CTL_ZERO_BYTES = 1 * MiB;
constexpr size_t WS_PROBE = 576 * 1024;
constexpr size_t WS_ONES = 512 * 1024;
constexpr size_t WS_COS = 1 * MiB, WS_SIN = 2 * MiB;
constexpr size_t WS_SSQ = 3 * MiB;
constexpr size_t WS_W = 4 * MiB;
constexpr size_t W_GU1 = 0, W_D1 = W_GU1 + (size_t)2 * DFF * DM * 2, W_IN = W_D1 + (size_t)DM * DFF * 2, W_BR = W_IN + (size_t)NIN * DM * 2,
                 W_OUT = W_BR + (size_t)3 * DM * 512 * 2, W_GU2 = W_OUT + (size_t)DM * DM * 2, W_D2 = W_GU2 + (size_t)2 * DFF * DM * 2, W_END = W_D2 + (size_t)DM * DFF * 2;
static_assert(W_END == 53 * MiB, "weights");
constexpr size_t WS_XB = 57 * MiB;
constexpr size_t WS_R4 = 89 * MiB;
constexpr size_t WS_R3 = 121 * MiB;
constexpr size_t P16 = 16 * MiB;
constexpr size_t WS_AQ = WS_R3, WS_BQ = WS_R3 + P16, WS_CG = WS_R3 + 2 * P16;
constexpr size_t WS_AK = WS_R3 + 3 * P16, WS_AV = WS_AK + P16, WS_BK = WS_AV + P16, WS_BV = WS_BK + P16, WS_CQ = WS_BV + P16, WS_CK = WS_CQ + P16 / 2, WS_CV = WS_CK + P16 / 2;
constexpr size_t WS_GT = WS_AK;
constexpr size_t WS_HB = WS_R3;
constexpr size_t WS_MG = WS_R4;
constexpr size_t WS_END = WS_R3 + 144 * MiB;
constexpr size_t WS_XLT = WS_R3 + 100 * MiB;
static_assert(WS_CV + P16 == WS_END && WS_GT + (size_t)M * NGATE * 2 == WS_END && WS_HB + (size_t)M * DFF * 2 <= WS_END, "ws map");

#define GAS __attribute__((address_space(1)))
#define LAS __attribute__((address_space(3)))
typedef unsigned short bf16_t;
#if RET_BF16
typedef unsigned short kvt_t;
#else
typedef float kvt_t;
#endif
typedef short bf16x8 __attribute__((ext_vector_type(8)));
typedef float f32x4 __attribute__((ext_vector_type(4)));
typedef float f32x2 __attribute__((ext_vector_type(2)));
typedef float f32x16 __attribute__((ext_vector_type(16)));
typedef unsigned u32x4 __attribute__((ext_vector_type(4)));
typedef unsigned u32x2 __attribute__((ext_vector_type(2)));
typedef GAS unsigned gu32;
#define RLX_AGENT __ATOMIC_RELAXED, __HIP_MEMORY_SCOPE_AGENT
#define LDS_WAIT() asm volatile("s_waitcnt lgkmcnt(0)" ::: "memory")
#define VM_WAIT() asm volatile("s_waitcnt vmcnt(0)" ::: "memory")

__device__ __forceinline__ unsigned f2bf(float f) { unsigned u = __builtin_bit_cast(unsigned, f); return (u + 0x7fffu + ((u >> 16) & 1u)) >> 16; }
__device__ __forceinline__ unsigned pk2(float lo, float hi) { return f2bf(lo) | (f2bf(hi) << 16); }
__device__ __forceinline__ float bf2f(unsigned short b) { return __builtin_bit_cast(float, (unsigned)b << 16); }
__device__ __forceinline__ float bflo(unsigned w) { return __builtin_bit_cast(float, w << 16); }
__device__ __forceinline__ float bfhi(unsigned w) { return __builtin_bit_cast(float, w & 0xffff0000u); }
typedef __bf16 bf16n2 __attribute__((ext_vector_type(2)));
typedef float f32n2 __attribute__((ext_vector_type(2)));
__device__ __forceinline__ unsigned cvt_pk_bf16_n(float lo, float hi) { const f32n2 v = {lo, hi}; return __builtin_bit_cast(unsigned, __builtin_convertvector(v, bf16n2)); }
__device__ __forceinline__ unsigned cvt_pk_bf16(float lo, float hi) { unsigned r; asm volatile("v_cvt_pk_bf16_f32 %0, %1, %2" : "=v"(r) : "v"(lo), "v"(hi)); return r; }
__device__ __forceinline__ float fast_rcp(float x) { return __builtin_amdgcn_rcpf(x); }
__device__ __forceinline__ float fast_exp2(float x) { return __builtin_amdgcn_exp2f(x); }
__device__ __forceinline__ float silu_f(float x) { return x * fast_rcp(1.0f + fast_exp2(-x * LOG2E)); }
__device__ __forceinline__ float sigmoid_f(float x) { return fast_rcp(1.0f + fast_exp2(-x * LOG2E)); }
template <int O> __device__ __forceinline__ float xor_add(float v) {
    if constexpr (O == 32) { auto rr = __builtin_amdgcn_permlane32_swap(__float_as_uint(v), __float_as_uint(v), false, false); return __uint_as_float(rr[0]) + __uint_as_float(rr[1]); }
    else return v + __uint_as_float((unsigned)__builtin_amdgcn_ds_swizzle((int)__float_as_uint(v), (O << 10) | 0x1f));
}
template <int O> __device__ __forceinline__ float xor_max(float v) {
    if constexpr (O == 32) { auto rr = __builtin_amdgcn_permlane32_swap(__float_as_uint(v), __float_as_uint(v), false, false); return fmaxf(__uint_as_float(rr[0]), __uint_as_float(rr[1])); }
    else return fmaxf(v, __uint_as_float((unsigned)__builtin_amdgcn_ds_swizzle((int)__float_as_uint(v), (O << 10) | 0x1f)));
}
__device__ __forceinline__ float wave_sum(float v) { v = xor_add<1>(v); v = xor_add<2>(v); v = xor_add<4>(v); v = xor_add<8>(v); v = xor_add<16>(v); return xor_add<32>(v); }
__device__ __forceinline__ float wave_max(float v) { v = xor_max<1>(v); v = xor_max<2>(v); v = xor_max<4>(v); v = xor_max<8>(v); v = xor_max<16>(v); return xor_max<32>(v); }

namespace pg8 {
#define PG8_LAS __attribute__((address_space(3)))
constexpr int BM = 256, BK = 64, HALF = 128, HTB = HALF * BK * 2  , STAGE_BYTES = 8 * HTB, NXCD = 8, WGM = 8;

__host__ __device__ __forceinline__ int lds_byte(int r, int c) { const int st = (r >> 4) * 2 + (c >> 5), rr = r & 15, cc = c & 31, ob = rr * 64 + cc * 2; return st * 1024 + (ob ^ (((ob >> 9) & 1) << 5)); }
__host__ __device__ __forceinline__ void stage_rc(int b, int& R, int& C) { const int st = b / 1024, sb = b % 1024, swz = sb ^ (((sb >> 9) & 1) << 5); R = (st >> 1) * 16 + swz / 64; C = (st & 1) * 32 + (swz % 64) / 2; }
__host__ __device__ __forceinline__ int perm32(int rho) { const int n = rho >> 4, i = rho & 15; return 8 * (i >> 2) + 4 * n + (i & 3); }

struct Unit { int pm, pn, sub, ui; };
struct Gemm { const bf16_t* A; const bf16_t* Bt; int K; size_t subA, subB; };
__device__ __forceinline__ const char* pickA(const Gemm& g, int s) { return (const char*)g.A + (size_t)s * g.subA; }
__device__ __forceinline__ const char* pickB(const Gemm& g, int s) { return (const char*)g.Bt + (size_t)s * g.subB; }

struct StaticOrder {
    int nM, nN, nwg, G, c;
    __host__ __device__ void init(int Mr, int N, int G_, int c_) { nM = Mr / BM; nN = N / BM; nwg = nM * nN; G = G_; c = c_; }
    template <int NSUB = 1> __host__ __device__ bool next(int i, Unit& u) const {
        const int it = i / NSUB; u.sub = i - it * NSUB; u.ui = it;
        const long L = (long)it * G + c; if (L >= nwg) return false;
        int wgid = (int)L; { const int q = nwg / NXCD, r = nwg % NXCD, xcd = wgid % NXCD, off = wgid / NXCD; wgid = (xcd < r ? xcd * (q + 1) : r * (q + 1) + (xcd - r) * q) + off; }
        const int nig = WGM * nN, gid = wgid / nig, fm = gid * WGM, gsz = (nM - fm) < WGM ? (nM - fm) : WGM;
        u.pm = fm + ((wgid % nig) % gsz); u.pn = (wgid % nig) / gsz; return true;
    }
};

struct NoPre { __device__ __forceinline__ void operator()() const {} };
template <int NSUB = 1, class Epi, class Pre = NoPre>
__device__ __forceinline__ void gemm_phase(PG8_LAS unsigned char* lds, const int tid, const Gemm g, const StaticOrder& S, const Epi& E, const Pre& pre = Pre()) {
    const int wid = __builtin_amdgcn_readfirstlane(tid >> 6), lane = tid & 63, wr = wid >> 2, wc = wid & 3, fr = lane & 15, fq = lane >> 4;
    const int K = g.K, nt = K / BK;
    unsigned voffA[2], voffB[2];
#pragma unroll
    for (int i = 0; i < 2; ++i) { int R, C; stage_rc(tid * 16 + i * 8192, R, C); const int Rb = ((R & ~31) + perm32(R & 31));
        voffA[i] = (unsigned)(R * K + C) * 2u; voffB[i] = (unsigned)(Rb * K + C) * 2u; }
    const size_t kstep = (size_t)(BK * 2);
    const size_t hstep = (size_t)HALF * K * 2;
    const size_t tstep = 2 * hstep;
    const unsigned ldsw = (unsigned)wid * 1024u;
    const int aoff = lds_byte(wr * 64 + fr, fq * 8), boff = lds_byte(wc * 32 + fr, fq * 8);
#define PG8_SA(b, h) (((b) * 2 + (h)) * HTB)
#define PG8_SB(b, h) ((4 + (b) * 2 + (h)) * HTB)
#define PG8_STAGE(bufoff, gbase, voff) do { _Pragma("unroll") for (int _i = 0; _i < 2; ++_i) \
        __builtin_amdgcn_global_load_lds((const unsigned*)((const char*)(gbase) + (voff)[_i]), (PG8_LAS unsigned*)(lds + (bufoff) + ldsw + _i * 8192), 16, 0, 0); } while (0)
#define PG8_LDA(dst, b, h) do { _Pragma("unroll") for (int m = 0; m < 4; ++m) _Pragma("unroll") for (int k = 0; k < 2; ++k) dst[m][k] = *(const PG8_LAS bf16x8*)(lds + PG8_SA(b, h) + aoff + m * 2048 + k * 1024); } while (0)
#define PG8_LDB(dst, b, h) do { _Pragma("unroll") for (int n = 0; n < 2; ++n) _Pragma("unroll") for (int k = 0; k < 2; ++k) dst[n][k] = *(const PG8_LAS bf16x8*)(lds + PG8_SB(b, h) + boff + n * 2048 + k * 1024); } while (0)
#define PG8_MMA(ai, bj, At, Bt) do { __builtin_amdgcn_s_setprio(1); _Pragma("unroll") for (int m = 0; m < 4; ++m) _Pragma("unroll") for (int n = 0; n < 2; ++n) _Pragma("unroll") for (int k = 0; k < 2; ++k) \
        acc[ai][bj][m][n] = __builtin_amdgcn_mfma_f32_16x16x32_bf16(Bt[n][k], At[m][k], acc[ai][bj][m][n], 0, 0, 0); __builtin_amdgcn_s_setprio(0); } while (0)
#define PG8_WAIT_V(n) asm volatile("s_waitcnt vmcnt(" #n ")" ::: "memory")
#define PG8_WAIT_L(n) asm volatile("s_waitcnt lgkmcnt(" #n ")" ::: "memory")
#define PG8_BAR __builtin_amdgcn_s_barrier()
#define PG8_SCHED __builtin_amdgcn_sched_barrier(0)
    Unit cur, nxt; int ui = 0;
    if (!S.template next<NSUB>(0, cur)) return;
    f32x4 acc[2][2][4][2];
#pragma unroll
    for (int a = 0; a < 2; ++a)
#pragma unroll
        for (int b = 0; b < 2; ++b)
#pragma unroll
            for (int m = 0; m < 4; ++m)
#pragma unroll
                for (int n = 0; n < 2; ++n) acc[a][b][m][n] = (f32x4){0.f, 0.f, 0.f, 0.f};
    bf16x8 At[4][2], B0[2][2], B1[2][2];
    const char* cA = pickA(g, cur.sub) + (size_t)cur.pm * tstep; const char* cB = pickB(g, cur.sub) + (size_t)cur.pn * tstep;
    if constexpr (Epi::INIT) { int l_ = tid; asm volatile("" : "+v"(l_)); E.init(acc, cur, wr, wc, l_ & 15, (l_ >> 4) & 3); }
#if PROBE_INIT
    if constexpr (Epi::INIT) { const unsigned long long t0_ = __builtin_amdgcn_s_memrealtime(); asm volatile("s_waitcnt vmcnt(0)" ::: "memory"); const unsigned long long t1_ = __builtin_amdgcn_s_memrealtime();
        if (blockIdx.x == PROBE_BLK && tid == 0) E.probe[54] += (t1_ - t0_) * 16 / 100; }
#endif
    PG8_STAGE(PG8_SB(0, 0), cB, voffB); PG8_STAGE(PG8_SB(0, 1), cB + hstep, voffB); PG8_STAGE(PG8_SA(0, 0), cA, voffA); PG8_STAGE(PG8_SA(0, 1), cA + hstep, voffA);
    pre();
    if (wr == 1) PG8_BAR;
    PG8_WAIT_V(2); PG8_BAR;
    PG8_STAGE(PG8_SB(1, 0), cB + kstep, voffB); PG8_STAGE(PG8_SA(1, 0), cA + kstep, voffA); PG8_STAGE(PG8_SB(1, 1), cB + hstep + kstep, voffB);
    PG8_WAIT_V(6); PG8_BAR;
    for (;;) {
        const bool has_next = S.template next<NSUB>(ui + 1, nxt);
        const char* nA = has_next ? pickA(g, nxt.sub) + (size_t)nxt.pm * tstep : cA; const char* nB = has_next ? pickB(g, nxt.sub) + (size_t)nxt.pn * tstep : cB;
        for (int t = 0; t < nt; t += 2) {
            const bool last = (t == nt - 2);
            const char* a1 = cA + (size_t)(t + 1) * kstep;
            const char* a2 = last ? nA : cA + (size_t)(t + 2) * kstep; const char* b2 = last ? nB : cB + (size_t)(t + 2) * kstep;
            const char* a3 = a2 + kstep; const char* b3 = b2 + kstep;
            PG8_LDB(B0, 0, 0); PG8_LDB(B1, 0, 1); PG8_SCHED; PG8_LDA(At, 0, 0); PG8_STAGE(PG8_SA(1, 1), a1 + hstep, voffA);
            PG8_WAIT_V(8); PG8_WAIT_L(0); PG8_BAR; PG8_MMA(0, 0, At, B0); PG8_MMA(0, 1, At, B1); PG8_BAR; PG8_SCHED;
            PG8_LDA(At, 0, 1); PG8_STAGE(PG8_SB(0, 0), b2, voffB); PG8_STAGE(PG8_SB(0, 1), b2 + hstep, voffB); PG8_STAGE(PG8_SA(0, 0), a2, voffA);
            PG8_WAIT_V(8); PG8_WAIT_L(0); PG8_BAR; PG8_MMA(1, 0, At, B0); PG8_MMA(1, 1, At, B1); PG8_BAR; PG8_SCHED;
            PG8_LDB(B0, 1, 0); PG8_LDB(B1, 1, 1); PG8_SCHED; PG8_LDA(At, 1, 0); PG8_STAGE(PG8_SA(0, 1), a2 + hstep, voffA);
            PG8_WAIT_V(8); PG8_WAIT_L(0); PG8_BAR; PG8_MMA(0, 0, At, B0); PG8_MMA(0, 1, At, B1); PG8_BAR; PG8_SCHED;
            PG8_LDA(At, 1, 1); PG8_STAGE(PG8_SB(1, 0), b3, voffB); PG8_STAGE(PG8_SB(1, 1), b3 + hstep, voffB); PG8_STAGE(PG8_SA(1, 0), a3, voffA);
            PG8_WAIT_V(8); PG8_WAIT_L(0); PG8_BAR; PG8_MMA(1, 0, At, B0); PG8_MMA(1, 1, At, B1); PG8_BAR; PG8_SCHED;
        }
        if (wr == 0) PG8_BAR;
        { int l_ = tid; asm volatile("" : "+v"(l_)); const int fr_ = l_ & 15, fq_ = (l_ >> 4) & 3;
          E(acc, cur, wr, wc, fr_, fq_);
          if constexpr (Epi::INIT) { if (has_next) E.init(acc, nxt, wr, wc, fr_, fq_); } }
        if (!has_next) break;
        cur = nxt; cA = nA; cB = nB; ++ui;
        if (wr == 1) PG8_BAR;
    }
    PG8_WAIT_V(0);
    PG8_BAR;
#undef PG8_SA
#undef PG8_SB
#undef PG8_STAGE
#undef PG8_LDA
#undef PG8_LDB
#undef PG8_MMA
#undef PG8_WAIT_V
#undef PG8_WAIT_L
#undef PG8_BAR
#undef PG8_SCHED
}
}

namespace epi {
using pg8::Unit;
__device__ __forceinline__ float log2_gamma_w(int h) { return __builtin_amdgcn_logf(1.0f - __builtin_amdgcn_exp2f(-5.0f - (float)h)); }
typedef f32x4 Acc[2][2][4][2];
#define ACC_ZERO(acc) do { _Pragma("unroll") for (int a_ = 0; a_ < 2; ++a_) _Pragma("unroll") for (int b_ = 0; b_ < 2; ++b_) _Pragma("unroll") for (int m_ = 0; m_ < 4; ++m_) \
    _Pragma("unroll") for (int n_ = 0; n_ < 2; ++n_) acc[a_][b_][m_][n_] = (f32x4){0.f, 0.f, 0.f, 0.f}; } while (0)

__device__ __forceinline__ float dot4(const f32x4 a) { return (a[0] * a[0] + a[1] * a[1]) + (a[2] * a[2] + a[3] * a[3]); }
__device__ __forceinline__ unsigned cvt_pk_bf16_t(float lo, float hi) { unsigned r; asm volatile("s_nop 1\n\tv_cvt_pk_bf16_f32 %0, %1, %2" : "=v"(r) : "v"(lo), "v"(hi)); return r; }
__device__ __forceinline__ u32x4 pack8_t(const f32x4 a, const f32x4 b) { u32x4 w; w.x = cvt_pk_bf16_t(a[0], a[1]); w.y = cvt_pk_bf16_t(a[2], a[3]); w.z = cvt_pk_bf16_t(b[0], b[1]); w.w = cvt_pk_bf16_t(b[2], b[3]); return w; }
__device__ __forceinline__ void st16(void* p, const u32x4 v) {
#if ST_SC1
    asm volatile("global_store_dwordx4 %0, %1, off sc1\n\ts_nop 1" :: "v"(p), "v"(v) : "memory");
#else
    *(u32x4*)p = v;
#endif
}
__device__ __forceinline__ unsigned pk_min_u16(unsigned a, unsigned b) { unsigned r; asm("v_pk_min_u16 %0, %1, %2" : "=v"(r) : "v"(a), "v"(b)); return r; }
__device__ __forceinline__ unsigned pk_max_u16(unsigned a, unsigned b) { unsigned r; asm("v_pk_max_u16 %0, %1, %2" : "=v"(r) : "v"(a), "v"(b)); return r; }
__device__ __forceinline__ u32x4 pack8(const f32x4 a, const f32x4 b) { u32x4 w; w.x = cvt_pk_bf16_n(a[0], a[1]); w.y = cvt_pk_bf16_n(a[2], a[3]); w.z = cvt_pk_bf16_n(b[0], b[1]); w.w = cvt_pk_bf16_n(b[2], b[3]); return w; }
constexpr int EPI_RSTD_OFF = 132096, EPI_GAIN_OFF = EPI_RSTD_OFF + 8 * 256 * 4, EPI_ROPE_OFF = EPI_GAIN_OFF + 4 * 64 * 4, EPI_END = EPI_ROPE_OFF + 128;
__device__ __forceinline__ void fill_rstd_table(LAS unsigned char* lds0, const int tid, const float* ssq, const pg8::StaticOrder& S) {
    LAS float* tab = (LAS float*)(lds0 + EPI_RSTD_OFF);
    const int row = tid >> 1, half = tid & 1;
    f32x4 a[8], b[8]; bool ok[8];
#pragma unroll
    for (int i = 0; i < 8; ++i) {
        Unit u; ok[i] = S.next(i, u);
        const float* p = ssq + ((size_t)(ok[i] ? u.pm : 0) * 256 + row) * 16 + half * 8;
        a[i] = *(const f32x4*)p; b[i] = *(const f32x4*)(p + 4);
    }
#pragma unroll
    for (int i = 0; i < 8; ++i) {
        float s = ((a[i][0] + a[i][1]) + (a[i][2] + a[i][3])) + ((b[i][0] + b[i][1]) + (b[i][2] + b[i][3])); s = xor_add<1>(s);
        if (half == 0 && ok[i]) tab[i * 256 + row] = __builtin_amdgcn_rsqf(s * (1.0f / DM) + EPS);
    }
}
__device__ __forceinline__ float row_rstd(const LAS float* tab, int ui, int lrow) { return tab[ui * 256 + lrow]; }

struct EpiNull {
    static constexpr bool INIT = false;
    __device__ __forceinline__ void operator()(Acc& acc, const Unit& u, int wr, int wc, int fr, int fq) const {
#pragma unroll
        for (int ai = 0; ai < 2; ++ai)
#pragma unroll
            for (int bj = 0; bj < 2; ++bj)
#pragma unroll
                for (int m = 0; m < 4; ++m) { asm volatile("" : "+v"(acc[ai][bj][m][0]), "+v"(acc[ai][bj][m][1])); }
        ACC_ZERO(acc);
    }
};
struct EpiUp {
    static constexpr bool INIT = false;
    bf16_t* H; const LAS float* rst;
    __device__ __forceinline__ void operator()(Acc& acc, const Unit& u, int wr, int wc, int fr, int fq) const {
#pragma unroll
        for (int ai = 0; ai < 2; ++ai)
#pragma unroll
            for (int m = 0; m < 4; ++m) {
                const int lrow = ai * 128 + wr * 64 + m * 16 + fr, row = u.pm * 256 + lrow;
                const float rs = row_rstd(rst, u.ui, lrow), k1 = -LOG2E * rs, k2 = rs * rs;
                const f32x4 a0 = acc[ai][0][m][0], a1 = acc[ai][0][m][1];
                f32x4 e0 = a0 * k1, e1 = a1 * k1;
#pragma unroll
                for (int j = 0; j < 4; ++j) { e0[j] = fast_exp2(e0[j]); e1[j] = fast_exp2(e1[j]); }
                e0 = e0 + 1.0f; e1 = e1 + 1.0f;
#pragma unroll
                for (int j = 0; j < 4; ++j) { e0[j] = fast_rcp(e0[j]); e1[j] = fast_rcp(e1[j]); }
                const f32x4 h0 = (a0 * acc[ai][1][m][0]) * (e0 * k2), h1 = (a1 * acc[ai][1][m][1]) * (e1 * k2);
#if NT_H
                __builtin_nontemporal_store(pack8(h0, h1), (u32x4*)(H + (size_t)row * DFF + u.pn * 128 + wc * 32 + 8 * fq));
#else
                st16(H + (size_t)row * DFF + u.pn * 128 + wc * 32 + 8 * fq, pack8(h0, h1));
#endif
            }
        ACC_ZERO(acc);
    }
};

struct EpiRes {
    static constexpr bool INIT = true;
    const float* xin; const bf16_t* lo_in; float* xout; bf16_t* xb; bf16_t* lo_out; float* ssq; float s;
#if PROBE_INIT
    unsigned long long* probe;
#endif
    static __device__ __forceinline__ f32x4 up_lo(unsigned a, unsigned b) { f32x4 r; r[0] = __uint_as_float(a << 16); r[1] = __uint_as_float(a & 0xffff0000u); r[2] = __uint_as_float(b << 16); r[3] = __uint_as_float(b & 0xffff0000u); return r; }
    __device__ __forceinline__ void init(Acc& acc, const Unit& u, int wr, int wc, int fr, int fq) const {
        const float is = 1.0f / s;
        if (xin) {
#pragma unroll
            for (int ai = 0; ai < 2; ++ai)
#pragma unroll
                for (int m = 0; m < 4; ++m)
#pragma unroll
                    for (int bj = 0; bj < 2; ++bj) { const size_t off = (size_t)(u.pm * 256 + ai * 128 + wr * 64 + m * 16 + fr) * DM + u.pn * 256 + bj * 128 + wc * 32 + 8 * fq;
                        acc[ai][bj][m][0] = *(const f32x4*)(xin + off) * is; acc[ai][bj][m][1] = *(const f32x4*)(xin + off + 4) * is; }
        } else {
#pragma unroll
            for (int ai = 0; ai < 2; ++ai)
#pragma unroll
                for (int m = 0; m < 4; ++m)
#pragma unroll
                    for (int bj = 0; bj < 2; ++bj) { const size_t off = (size_t)(u.pm * 256 + ai * 128 + wr * 64 + m * 16 + fr) * DM + u.pn * 256 + bj * 128 + wc * 32 + 8 * fq;
                        acc[ai][bj][m][0] = __builtin_bit_cast(f32x4, *(const u32x4*)(xb + off)); acc[ai][bj][m][1] = __builtin_bit_cast(f32x4, *(const u32x4*)(lo_in + off)); }
            __builtin_amdgcn_sched_barrier(0);
#pragma unroll
            for (int ai = 0; ai < 2; ++ai)
#pragma unroll
                for (int m = 0; m < 4; ++m)
#pragma unroll
                    for (int bj = 0; bj < 2; ++bj) { const u32x4 h = __builtin_bit_cast(u32x4, acc[ai][bj][m][0]), lw = __builtin_bit_cast(u32x4, acc[ai][bj][m][1]);
                        acc[ai][bj][m][0] = (up_lo(h.x, h.y) + up_lo(lw.x, lw.y)) * is; acc[ai][bj][m][1] = (up_lo(h.z, h.w) + up_lo(lw.z, lw.w)) * is; }
        }
    }
    __device__ __forceinline__ void operator()(Acc& acc, const Unit& u, int wr, int wc, int fr, int fq) const {
        if (xout) {
            float sf = s; asm volatile("" : "+v"(sf));
#pragma unroll
            for (int ai = 0; ai < 2; ++ai)
#pragma unroll
                for (int m = 0; m < 4; ++m)
#pragma unroll
                    for (int bj = 0; bj < 2; ++bj) { const size_t off = (size_t)(u.pm * 256 + ai * 128 + wr * 64 + m * 16 + fr) * DM + u.pn * 256 + bj * 128 + wc * 32 + 8 * fq;
                        *(f32x4*)(xout + off) = acc[ai][bj][m][0] * sf; *(f32x4*)(xout + off + 4) = acc[ai][bj][m][1] * sf; }
        } else {
            float sf = s; asm volatile("" : "+v"(sf));
#pragma unroll
            for (int ai = 0; ai < 2; ++ai)
#pragma unroll
                for (int m = 0; m < 4; ++m) {
                    const int row = u.pm * 256 + ai * 128 + wr * 64 + m * 16 + fr; float ss = 0.f;
#pragma unroll
                    for (int bj = 0; bj < 2; ++bj) {
                        const size_t off = (size_t)row * DM + u.pn * 256 + bj * 128 + wc * 32 + 8 * fq;
                        const f32x4 v0 = acc[ai][bj][m][0] * sf, v1 = acc[ai][bj][m][1] * sf;
                        const u32x4 h = pack8(v0, v1);
                        st16(xb + off, h);
                        st16(lo_out + off, pack8(v0 - up_lo(h.x, h.y), v1 - up_lo(h.z, h.w)));
                        ss += dot4(v0) + dot4(v1);
                    }
                    ss = xor_add<16>(ss); ss = xor_add<32>(ss);
                    if (fq == 0) ssq[(size_t)row * 16 + u.pn * 4 + wc] = ss;
                    __builtin_amdgcn_sched_barrier(0);
                }
        }
        ACC_ZERO(acc);
    }
};

struct EpiGate {
    static constexpr bool INIT = false;
    bf16_t* G; const LAS float* rst;
    __device__ __forceinline__ void operator()(Acc& acc, const Unit& u, int wr, int wc, int fr, int fq) const {
#pragma unroll
        for (int ai = 0; ai < 2; ++ai)
#pragma unroll
            for (int m = 0; m < 4; ++m) {
                const int lrow = ai * 128 + wr * 64 + m * 16 + fr, row = u.pm * 256 + lrow;
                const float rs = row_rstd(rst, u.ui, lrow), k1 = -LOG2E * rs;
#pragma unroll
                for (int bj = 0; bj < 2; ++bj) {
                    f32x4 g0 = acc[ai][bj][m][0] * k1, g1 = acc[ai][bj][m][1] * k1;
#pragma unroll
                    for (int j = 0; j < 4; ++j) { g0[j] = fast_exp2(g0[j]); g1[j] = fast_exp2(g1[j]); }
                    g0 = g0 + 1.0f; g1 = g1 + 1.0f;
                    u32x4 w = pack8(g0, g1);
                    w.x = pk_min_u16(w.x, 0x49804980u); w.y = pk_min_u16(w.y, 0x49804980u); w.z = pk_min_u16(w.z, 0x49804980u); w.w = pk_min_u16(w.w, 0x49804980u);
                    *(u32x4*)(G + (size_t)row * NGATE + u.sub * 1024 + u.pn * 256 + bj * 128 + wc * 32 + 8 * fq) = w; }
            }
        ACC_ZERO(acc);
    }
};

struct EpiMerge {
    static constexpr bool INIT = false;
    const bf16_t* G; bf16_t* MG; const unsigned* ones;
    __device__ __forceinline__ void operator()(Acc& acc, const Unit& u, int wr, int wc, int fr, int fq) const {
        const int sub = u.sub; const bool chain = sub < 2;
        const char* gb = (const char*)(G + (size_t)u.pm * 256 * NGATE + sub * 1024 + u.pn * 256);
        const char* nb = chain ? gb + 2048 : (const char*)ones; const unsigned nmask = chain ? 0xffffffffu : 0u;
        const unsigned go = (unsigned)((wr * 64 + fr) * NGATE + wc * 32 + 8 * fq) * 2u;
        u32x4 gcA[2][2], gnA[2][2], gcB[2][2], gnB[2][2];
#define MG_LOAD(q, GC, GN) do { _Pragma("unroll") for (int m2 = 0; m2 < 2; ++m2) _Pragma("unroll") for (int bj = 0; bj < 2; ++bj) { \
            const unsigned o = go + (unsigned)(((((q) >> 1) * 128 + (2 * ((q) & 1) + m2) * 16) * NGATE + bj * 128) * 2); \
            GC[m2][bj] = *(const u32x4*)(gb + o); GN[m2][bj] = *(const u32x4*)(nb + (o & nmask)); } asm volatile("" ::: "memory"); } while (0)
#define MG_COMP(q, GC, GN) do { _Pragma("unroll") for (int m2 = 0; m2 < 2; ++m2) _Pragma("unroll") for (int bj = 0; bj < 2; ++bj) { const u32x4 c = GC[m2][bj], n = GN[m2][bj]; const int ai = (q) >> 1, m = 2 * ((q) & 1) + m2; \
            const f32x4 c0 = {bflo(c.x), bfhi(c.x), bflo(c.y), bfhi(c.y)}, c1 = {bflo(c.z), bfhi(c.z), bflo(c.w), bfhi(c.w)}; \
            const f32x4 n0 = {bflo(n.x), bfhi(n.x), bflo(n.y), bfhi(n.y)}, n1 = {bflo(n.z), bfhi(n.z), bflo(n.w), bfhi(n.w)}; \
            _Pragma("unroll") for (int j = 0; j < 4; ++j) { acc[ai][bj][m][0][j] *= n0[j] * fast_rcp(c0[j]); acc[ai][bj][m][1][j] *= n1[j] * fast_rcp(c1[j]); } }        \
            asm volatile("" ::: "memory"); } while (0)
        MG_LOAD(0, gcA, gnA); MG_LOAD(1, gcB, gnB);
        MG_COMP(0, gcA, gnA); MG_LOAD(2, gcA, gnA);
        MG_COMP(1, gcB, gnB); MG_LOAD(3, gcB, gnB);
        MG_COMP(2, gcA, gnA); MG_COMP(3, gcB, gnB);
#undef MG_LOAD
#undef MG_COMP
        if (!chain) {
            char* mb = (char*)(MG + (size_t)u.pm * 256 * DM + u.pn * 256);
            const unsigned mo = (unsigned)((wr * 64 + fr) * DM + wc * 32 + 8 * fq) * 2u;
#pragma unroll
            for (int ai = 0; ai < 2; ++ai)
#pragma unroll
                for (int m = 0; m < 4; ++m)
#pragma unroll
                    for (int bj = 0; bj < 2; ++bj)
                        *(u32x4*)(mb + mo + (unsigned)(((ai * 128 + m * 16) * DM + bj * 128) * 2)) = pack8(acc[ai][bj][m][0], acc[ai][bj][m][1]);
            ACC_ZERO(acc);
        }
    }
};

enum { F_NORM = 1, F_ROPE = 2, F_C2 = 4, F_CKD = 8, F_SILU = 16 };
struct EpiWin {
    static constexpr bool INIT = false;
    unsigned char* ws; const LAS float* rst; const LAS float* gtab; const LAS float* rtab;
    template <int FLAGS>
    __device__ __forceinline__ void body(Acc& acc, const Unit& u, int wr, int wc, int fr, int fq, bf16_t* out, int pitch, int colbase, int gk) const {
        f32x4 gA0 = {1.f, 1.f, 1.f, 1.f}, gA1 = gA0, gB0 = gA0, gB1 = gA0;
        if (FLAGS & F_NORM) { const LAS float* gain = gtab + gk * 64; gA0 = *(const LAS f32x4*)(gain + 8 * fq); gA1 = *(const LAS f32x4*)(gain + 8 * fq + 4); gB0 = *(const LAS f32x4*)(gain + 32 + 8 * fq); gB1 = *(const LAS f32x4*)(gain + 36 + 8 * fq); }
        f32x4 rc0 = {0.f, 0.f, 0.f, 0.f}, rc1 = rc0;
        if (FLAGS & F_ROPE) { rc0 = *(const LAS f32x4*)(rtab + 8 * fq); rc1 = *(const LAS f32x4*)(rtab + 8 * fq + 4); }
        const float l2g = (FLAGS & F_CKD) ? log2_gamma_w(wc) : 0.f;
#pragma unroll
        for (int ai = 0; ai < 2; ++ai)
#pragma unroll
            for (int m = 0; m < 4; ++m) {
                const int lrow = ai * 128 + wr * 64 + m * 16 + fr, row = u.pm * 256 + lrow, t = row & (SEQ - 1);
                const float rs = row_rstd(rst, u.ui, lrow);
                f32x4 a0 = acc[ai][0][m][0] * rs, a1 = acc[ai][0][m][1] * rs, b0 = acc[ai][1][m][0] * rs, b1 = acc[ai][1][m][1] * rs;
                if (FLAGS & F_NORM) {
                    float ss = (dot4(a0) + dot4(a1)) + (dot4(b0) + dot4(b1)); ss = xor_add<16>(ss); ss = xor_add<32>(ss);
                    const float r = __builtin_amdgcn_rsqf(ss * (1.0f / 64.0f) + EPS);
                    a0 = a0 * gA0 * r; a1 = a1 * gA1 * r; b0 = b0 * gB0 * r; b1 = b1 * gB1 * r;
                }
                if (FLAGS & F_ROPE) {
                    const float tf = (float)t; f32x4 c0, c1, s0, s1;
#pragma unroll
                    for (int j = 0; j < 4; ++j) { const float r0 = __builtin_amdgcn_fractf(tf * rc0[j]), r1 = __builtin_amdgcn_fractf(tf * rc1[j]);
                        c0[j] = __builtin_amdgcn_cosf(r0); s0[j] = __builtin_amdgcn_sinf(r0); c1[j] = __builtin_amdgcn_cosf(r1); s1[j] = __builtin_amdgcn_sinf(r1); }
                    const f32x4 na0 = a0 * c0 - b0 * s0, nb0 = b0 * c0 + a0 * s0, na1 = a1 * c1 - b1 * s1, nb1 = b1 * c1 + a1 * s1;
                    a0 = na0; b0 = nb0; a1 = na1; b1 = nb1;
                }
                if (FLAGS & (F_C2 | F_CKD)) {
                    const float sc = (FLAGS & F_C2) ? C2 : 0.125f * fast_exp2(-(float)(t & 63) * l2g);
                    a0 = a0 * sc; a1 = a1 * sc; b0 = b0 * sc; b1 = b1 * sc;
                }
                if (FLAGS & F_SILU) {
#pragma unroll
                    for (int q = 0; q < 4; ++q) { f32x4& v = (q == 0) ? a0 : (q == 1) ? a1 : (q == 2) ? b0 : b1;
                        f32x4 e = v * (-LOG2E);
#pragma unroll
                        for (int j = 0; j < 4; ++j) e[j] = fast_exp2(e[j]);
                        e = e + 1.0f;
#pragma unroll
                        for (int j = 0; j < 4; ++j) e[j] = fast_rcp(e[j]);
                        v = v * e; }
                }
                bf16_t* o = out + (size_t)row * pitch + colbase + 64 * wc + 8 * fq;
                *(u32x4*)o = pack8(a0, a1); *(u32x4*)(o + 32) = pack8(b0, b1);
            }
        ACC_ZERO(acc);
    }
    __device__ __forceinline__ void operator()(Acc& acc, const Unit& u, int wr, int wc, int fr, int fq) const {
        const int pn = u.pn;
        if (pn < 2)        body<F_NORM | F_ROPE | F_C2>(acc, u, wr, wc, fr, fq, (bf16_t*)(ws + WS_AQ), 512, 256 * pn, 0);
        else if (pn < 4)   body<F_NORM | F_ROPE>(acc, u, wr, wc, fr, fq, (bf16_t*)(ws + WS_AK), 512, 256 * (pn - 2), 1);
        else if (pn < 6)   body<0>(acc, u, wr, wc, fr, fq, (bf16_t*)(ws + WS_AV), 512, 256 * (pn - 4), 0);
        else if (pn < 8)   body<F_NORM | F_C2>(acc, u, wr, wc, fr, fq, (bf16_t*)(ws + WS_BQ), 512, 256 * (pn - 6), 2);
        else if (pn < 10)  body<F_NORM>(acc, u, wr, wc, fr, fq, (bf16_t*)(ws + WS_BK), 512, 256 * (pn - 8), 3);
        else if (pn < 12)  body<0>(acc, u, wr, wc, fr, fq, (bf16_t*)(ws + WS_BV), 512, 256 * (pn - 10), 0);
        else if (pn == 12) body<F_ROPE>(acc, u, wr, wc, fr, fq, (bf16_t*)(ws + WS_CQ), 256, 0, 0);
        else if (pn == 13) body<F_ROPE | F_CKD>(acc, u, wr, wc, fr, fq, (bf16_t*)(ws + WS_CK), 256, 0, 0);
        else if (pn < 16)  body<0>(acc, u, wr, wc, fr, fq, (bf16_t*)(ws + WS_CV), 512, 256 * (pn - 14), 0);
        else               body<F_SILU>(acc, u, wr, wc, fr, fq, (bf16_t*)(ws + WS_CG), 512, 256 * (pn - 16), 0);
    }
};
}

__device__ __forceinline__ float log2_gamma(int h) { return __builtin_amdgcn_logf(1.0f - __builtin_amdgcn_exp2f(-5.0f - (float)h)); }

namespace naive {
struct ANorm {
    const float* x; const float* gain; const LAS float* rs; int m0;
    __device__ __forceinline__ float get(int m, int k) const { return x[(size_t)m * DM + k] * rs[m - m0] * gain[k]; }
};
struct ABf {
    const bf16_t* a; int pitch;
    __device__ __forceinline__ float get(int m, int k) const { return bf2f(a[(size_t)m * pitch + k]); }
};
template <int NB, bool SHARED_A, bool NORM, int RT, class Epi>
__device__ __forceinline__ void gemm(LAS unsigned char* lds, const int tid, int vcu, int G, int N, int K,
                                     const float* x, const float* gain, const bf16_t* a0, const bf16_t* a1, const bf16_t* a2, int apitch,
                                     const float* w0, const float* w1, const float* w2, int ldb, const Epi& E) {
    constexpr int NA = SHARED_A ? 1 : NB;
    LAS float* As = (LAS float*)lds;
    LAS float* Bs = As + NA * 16 * 132;
    LAS float* rs = Bs + NB * 16 * 128;
    const int tx = tid & 15, ty = tid >> 4, lane = tid & 63, wave = tid >> 6;
    constexpr int TM = 32 * RT;
    const int ntn = N / 128, ntiles = (M / TM) * ntn;
    for (int tile = vcu; tile < ntiles; tile += G) {
        const int m0 = (tile / ntn) * TM, n0 = (tile % ntn) * 128;
        __syncthreads();
        if (NORM) {
            for (int r = wave * (TM / 8); r < wave * (TM / 8) + TM / 8; ++r) {
                const float* xr = x + (size_t)(m0 + r) * DM; float s = 0.f;
                for (int k = lane; k < DM; k += 64) { const float v = xr[k]; s += v * v; }
                s = wave_sum(s);
                if (lane == 0) rs[r] = 1.0f / sqrtf(s * (1.0f / DM) + EPS);
            }
            __syncthreads();
        }
        float acc[NB][RT][8];
#pragma unroll
        for (int b = 0; b < NB; ++b)
#pragma unroll
            for (int i = 0; i < RT; ++i)
#pragma unroll
                for (int j = 0; j < 8; ++j) acc[b][i][j] = 0.f;
        for (int k0 = 0; k0 < K; k0 += 16) {
            {
                const int r = tid >> 2, kq = (tid & 3) * 4;
                if (r < TM)
#pragma unroll
                for (int b = 0; b < NA; ++b)
#pragma unroll
                    for (int i = 0; i < 4; ++i) {
                        float v;
                        if (NORM) v = x[(size_t)(m0 + r) * DM + k0 + kq + i] * rs[r] * gain[k0 + kq + i];
                        else { const bf16_t* ap = (b == 0 ? a0 : (b == 1 ? a1 : a2)); v = bf2f(ap[(size_t)(m0 + r) * apitch + k0 + kq + i]); }
                        As[(b * 16 + kq + i) * 132 + r] = v;
                    }
                const int kb = tid >> 5, n4 = (tid & 31) * 4;
#pragma unroll
                for (int b = 0; b < NB; ++b) { const float* wp = (b == 0 ? w0 : (b == 1 ? w1 : w2));
                    const f32x4 v = *(const f32x4*)(wp + (size_t)(k0 + kb) * ldb + n0 + n4);
                    *(LAS f32x4*)(Bs + (b * 16 + kb) * 128 + n4) = v; }
            }
            __syncthreads();
#pragma unroll
            for (int kk = 0; kk < 16; ++kk) {
#pragma unroll
                for (int b = 0; b < NB; ++b) {
                    const int ab = SHARED_A ? 0 : b;
                    float av[RT];
#pragma unroll
                    for (int i = 0; i < RT; ++i) av[i] = As[(ab * 16 + kk) * 132 + ty * RT + i];
                    const f32x4 b0 = *(const LAS f32x4*)(Bs + (b * 16 + kk) * 128 + tx * 8), b1 = *(const LAS f32x4*)(Bs + (b * 16 + kk) * 128 + tx * 8 + 4);
#pragma unroll
                    for (int i = 0; i < RT; ++i)
#pragma unroll
                        for (int j = 0; j < 4; ++j) { acc[b][i][j] += av[i] * b0[j]; acc[b][i][4 + j] += av[i] * b1[j]; }
                }
            }
            __syncthreads();
        }
#pragma unroll
        for (int i = 0; i < RT; ++i) E(m0 + ty * RT + i, n0 + tx * 8, acc, i, tx);
    }
}

__device__ __forceinline__ void xb_ssq_pass(const float* x, bf16_t* xb, float* ssq, int gw, int ngw, int lane) {
    for (int m0 = gw * 4; m0 < M; m0 += ngw * 4) {
        f32x4 v[4][4];
#pragma unroll
        for (int r = 0; r < 4; ++r)
#pragma unroll
            for (int j = 0; j < 4; ++j) v[r][j] = ((const f32x4*)(x + (size_t)(m0 + r) * DM) + lane)[64 * j];
#pragma unroll
        for (int r = 0; r < 4; ++r) {
            float s = 0.f; u32x2* o = (u32x2*)(xb + (size_t)(m0 + r) * DM) + lane;
#pragma unroll
            for (int j = 0; j < 4; ++j) { const f32x4 w4 = v[r][j]; s += (w4[0] * w4[0] + w4[1] * w4[1]) + (w4[2] * w4[2] + w4[3] * w4[3]); u32x2 w; w.x = pk2(w4[0], w4[1]); w.y = pk2(w4[2], w4[3]); o[64 * j] = w; }
            s = wave_sum(s);
            if (lane < 16) ssq[(size_t)(m0 + r) * 16 + lane] = (lane == 0) ? s : 0.f;
        }
    }
}

struct NEpiUp { bf16_t* H;
    __device__ __forceinline__ void operator()(int m, int n, const float (&acc)[2][4][8], int i, int tx) const {
#pragma unroll
        for (int j = 0; j < 8; ++j) { const float g = acc[0][i][j], u = acc[1][i][j]; H[(size_t)m * DFF + n + j] = (bf16_t)f2bf(g / (1.0f + expf(-g)) * u); } } };
struct NEpiRes { const float* xold; float* xnew; bf16_t* xb; float* ssq; float s;
    __device__ __forceinline__ void operator()(int m, int n, const float (&acc)[1][4][8], int i, int tx) const {
        float ss = 0.f;
#pragma unroll
        for (int j = 0; j < 8; ++j) { const float v = xold[(size_t)m * DM + n + j] + s * acc[0][i][j]; xnew[(size_t)m * DM + n + j] = v; xb[(size_t)m * DM + n + j] = (bf16_t)f2bf(v); ss += v * v; }
        ss += __shfl_xor(ss, 1); ss += __shfl_xor(ss, 2); ss += __shfl_xor(ss, 4); ss += __shfl_xor(ss, 8);
        if (tx == 0) { ssq[(size_t)m * 16 + (n >> 7)] = ss; ssq[(size_t)m * 16 + 8 + (n >> 7)] = 0.f; }
    } };
struct NEpiGate { bf16_t* G;
    __device__ __forceinline__ void operator()(int m, int n, const float (&acc)[1][4][8], int i, int tx) const {
#pragma unroll
        for (int j = 0; j < 8; ++j) G[(size_t)m * NGATE + n + j] = (bf16_t)f2bf(fmaxf(1.0f / (1.0f + expf(-acc[0][i][j])), 9.5367431640625e-07f)); } };
struct NEpiMerge { const bf16_t* G; bf16_t* MG;
    __device__ __forceinline__ void operator()(int m, int n, const float (&acc)[3][2][8], int i, int tx) const {
#pragma unroll
        for (int j = 0; j < 8; ++j) { const size_t go = (size_t)m * NGATE + n + j;
            const float v = bf2f(G[go]) * acc[0][i][j] + bf2f(G[go + 1024]) * acc[1][i][j] + bf2f(G[go + 2048]) * acc[2][i][j];
            MG[(size_t)m * DM + n + j] = (bf16_t)f2bf(v); } } };
struct NEpiWin { unsigned char* ws; const float* cosT; const float* sinT; const float *aqn, *akn, *bqn, *bkn;
    __device__ __forceinline__ void operator()(int m, int n, const float (&acc)[1][4][8], int i, int tx) const {
        size_t obase; int pitch, c0, flags; const float* gain = nullptr;
        if (n < 512)       { obase = WS_AQ; pitch = 512; c0 = 0;    flags = epi::F_NORM | epi::F_ROPE | epi::F_C2; gain = aqn; }
        else if (n < 1024) { obase = WS_AK; pitch = 512; c0 = 512;  flags = epi::F_NORM | epi::F_ROPE; gain = akn; }
        else if (n < 1536) { obase = WS_AV; pitch = 512; c0 = 1024; flags = 0; }
        else if (n < 2048) { obase = WS_BQ; pitch = 512; c0 = 1536; flags = epi::F_NORM | epi::F_C2; gain = bqn; }
        else if (n < 2560) { obase = WS_BK; pitch = 512; c0 = 2048; flags = epi::F_NORM; gain = bkn; }
        else if (n < 3072) { obase = WS_BV; pitch = 512; c0 = 2560; flags = 0; }
        else if (n < 3328) { obase = WS_CQ; pitch = 256; c0 = 3072; flags = epi::F_ROPE; }
        else if (n < 3584) { obase = WS_CK; pitch = 256; c0 = 3328; flags = epi::F_ROPE | epi::F_CKD; }
        else if (n < 4096) { obase = WS_CV; pitch = 512; c0 = 3584; flags = 0; }
        else               { obase = WS_CG; pitch = 512; c0 = 4096; flags = epi::F_SILU; }
        const int t = m & (SEQ - 1), d0 = n & 63; float v[8];
#pragma unroll
        for (int j = 0; j < 8; ++j) v[j] = acc[0][i][j];
        if (flags & epi::F_NORM) { float ss = 0.f;
#pragma unroll
            for (int j = 0; j < 8; ++j) ss += v[j] * v[j];
            ss += __shfl_xor(ss, 1); ss += __shfl_xor(ss, 2); ss += __shfl_xor(ss, 4);
            const float r = 1.0f / sqrtf(ss * (1.0f / 64.0f) + EPS);
#pragma unroll
            for (int j = 0; j < 8; ++j) v[j] = v[j] * r * gain[d0 + j]; }
        if (flags & epi::F_ROPE) {
#pragma unroll
            for (int j = 0; j < 8; ++j) { const float p = __shfl_xor(v[j], 4); const int d = d0 + j, ii = d & 31; const float c = cosT[t * 32 + ii], s = sinT[t * 32 + ii];
                v[j] = (d < 32) ? (v[j] * c - p * s) : (v[j] * c + p * s); } }
        float sc = 1.0f;
        if (flags & epi::F_C2) sc = C2;
        if (flags & epi::F_CKD) sc = 0.125f * exp2f(-(float)(t & 63) * log2_gamma((n - 3328) >> 6));
        bf16_t* o = (bf16_t*)(ws + obase) + (size_t)m * pitch + (n - c0);
#pragma unroll
        for (int j = 0; j < 8; ++j) { float y = v[j] * sc; if (flags & epi::F_SILU) y = y / (1.0f + expf(-y)); o[j] = (bf16_t)f2bf(y); }
    } };

__device__ __forceinline__ void attn_a(unsigned char* ws, const float* lq1, const float* lk1, const float* lq2, const float* lk2, const float* subln, float lam_init,
                                       LAS unsigned char* lds, int gw, int ngw, int wave, int lane) {
    const bf16_t* AQ = (const bf16_t*)(ws + WS_AQ); const bf16_t* AK = (const bf16_t*)(ws + WS_AK); const bf16_t* AV = (const bf16_t*)(ws + WS_AV); bf16_t* YA = (bf16_t*)(ws + WS_AQ);
    const float lam = expf(wave_sum(lq1[lane] * lk1[lane])) - expf(wave_sum(lq2[lane] * lk2[lane])) + lam_init;
    LAS float* qs = (LAS float*)lds + wave * 128;
    for (int task = gw; task < M * 4; task += ngw) {
        const int h = task & 3, m = task >> 2, b = m >> 13, t = m & (SEQ - 1), nch = (t >> 6) + 1;
        qs[lane] = bf2f(AQ[(size_t)m * 512 + h * 128 + lane]); qs[64 + lane] = bf2f(AQ[(size_t)m * 512 + h * 128 + 64 + lane]);
        LDS_WAIT(); asm volatile("" ::: "memory");
        float mx[2] = {-1e30f, -1e30f}, l[2] = {0.f, 0.f}, o[2][2] = {{0.f, 0.f}, {0.f, 0.f}};
        for (int c = 0; c < nch; ++c) {
            const size_t krow = (size_t)(b * SEQ + c * 64 + lane);
            float s[2] = {0.f, 0.f};
            for (int cc = 0; cc < 2; ++cc) { const u32x4* kp = (const u32x4*)(AK + krow * 512 + h * 128 + cc * 64);
                for (int q = 0; q < 8; ++q) { const u32x4 w = kp[q]; const LAS float* qq = qs + cc * 64 + q * 8;
                    s[cc] += bflo(w.x) * qq[0] + bfhi(w.x) * qq[1] + bflo(w.y) * qq[2] + bfhi(w.y) * qq[3] + bflo(w.z) * qq[4] + bfhi(w.z) * qq[5] + bflo(w.w) * qq[6] + bfhi(w.w) * qq[7]; } }
            float p[2];
            for (int cc = 0; cc < 2; ++cc) { const float mn = fmaxf(mx[cc], wave_max(s[cc])), f = exp2f(mx[cc] - mn); mx[cc] = mn; p[cc] = exp2f(s[cc] - mn);
                l[cc] = l[cc] * f + wave_sum(p[cc]); o[cc][0] *= f; o[cc][1] *= f; }
            for (int j = 0; j < 64; ++j) { const float p0 = __shfl(p[0], j), p1 = __shfl(p[1], j); const size_t vrow = (size_t)(b * SEQ + c * 64 + j) * 512 + h * 128;
                const float v0 = bf2f(AV[vrow + lane]), v1 = bf2f(AV[vrow + 64 + lane]);
                o[0][0] += p0 * v0; o[0][1] += p0 * v1; o[1][0] += p1 * v0; o[1][1] += p1 * v1; }
        }
        const float y0 = o[0][0] / l[0] - lam * o[1][0] / l[1], y1 = o[0][1] / l[0] - lam * o[1][1] / l[1];
        const float r = 1.0f / sqrtf(wave_sum(y0 * y0 + y1 * y1) * (1.0f / 128.0f) + EPS) * (1.0f - lam_init);
        YA[(size_t)m * 512 + h * 128 + lane] = (bf16_t)f2bf(y0 * r * subln[lane]); YA[(size_t)m * 512 + h * 128 + 64 + lane] = (bf16_t)f2bf(y1 * r * subln[64 + lane]);
        asm volatile("" ::: "memory");
    }
}
__device__ __forceinline__ void attn_b(unsigned char* ws, const float* relb, LAS unsigned char* lds, int gw, int ngw, int wave, int lane) {
    const bf16_t* BQ = (const bf16_t*)(ws + WS_BQ); const bf16_t* BK = (const bf16_t*)(ws + WS_BK); const bf16_t* BV = (const bf16_t*)(ws + WS_BV); bf16_t* YB = (bf16_t*)(ws + WS_BQ);
    LAS float* qs = (LAS float*)lds + wave * 128;
    for (int task = gw; task < M * 8; task += ngw) {
        const int h = task & 7, m = task >> 3, b = m >> 13, t = m & (SEQ - 1), n = t >> 6;
        qs[lane] = bf2f(BQ[(size_t)m * 512 + h * 64 + lane]);
        LDS_WAIT(); asm volatile("" ::: "memory");
        float mx = -1e30f, l = 0.f, o = 0.f;
        for (int c = (n >= 8 ? n - 8 : 0); c <= n; ++c) {
            const int kpos = c * 64 + lane; const size_t krow = (size_t)(b * SEQ + kpos);
            float s = 0.f; const u32x4* kp = (const u32x4*)(BK + krow * 512 + h * 64);
            for (int q = 0; q < 8; ++q) { const u32x4 w = kp[q]; const LAS float* qq = qs + q * 8;
                s += bflo(w.x) * qq[0] + bfhi(w.x) * qq[1] + bflo(w.y) * qq[2] + bfhi(w.y) * qq[3] + bflo(w.z) * qq[4] + bfhi(w.z) * qq[5] + bflo(w.w) * qq[6] + bfhi(w.w) * qq[7]; }
            int rel = t - kpos; rel = rel < -63 ? -63 : (rel > 256 ? 256 : rel);
            s += relb[h * 320 + rel + 63] * LOG2E;
            const float mn = fmaxf(mx, wave_max(s)), f = exp2f(mx - mn); mx = mn; const float p = exp2f(s - mn);
            l = l * f + wave_sum(p); o *= f;
            for (int j = 0; j < 64; ++j) o += __shfl(p, j) * bf2f(BV[(size_t)(b * SEQ + c * 64 + j) * 512 + h * 64 + lane]);
        }
        YB[(size_t)m * 512 + h * 64 + lane] = (bf16_t)f2bf(o / l);
        asm volatile("" ::: "memory");
    }
}
__device__ __forceinline__ void retention(unsigned char* ws, const float* onorm, LAS unsigned char* lds, int vcu, int G, int tid) {
    const bf16_t* CQ = (const bf16_t*)(ws + WS_CQ); const bf16_t* CK = (const bf16_t*)(ws + WS_CK); const bf16_t* CV = (const bf16_t*)(ws + WS_CV); bf16_t* CG = (bf16_t*)(ws + WS_CG);
    LAS float* qs = (LAS float*)lds; LAS float* ks = qs + 64 * 64; LAS float* vs = ks + 64 * 64; LAS float* os = vs + 64 * 128;
    for (int bh = vcu; bh < 8; bh += G) {
        const int b = bh >> 2, h = bh & 3; const float l2g = log2_gamma(h), gam = exp2f(l2g);
        float S[64];
#pragma unroll
        for (int d = 0; d < 64; ++d) S[d] = 0.f;
        for (int n = 0; n < SEQ / 64; ++n) {
            __syncthreads();
            for (int i = tid; i < 64 * 64; i += 512) { const int r = i >> 6, d = i & 63; const size_t row = (size_t)(b * SEQ + n * 64 + r);
                qs[i] = bf2f(CQ[row * 256 + h * 64 + d]); ks[i] = bf2f(CK[row * 256 + h * 64 + d]) * exp2f((float)r * l2g); }
            for (int i = tid; i < 64 * 128; i += 512) { const int r = i >> 7, e = i & 127; vs[i] = bf2f(CV[(size_t)(b * SEQ + n * 64 + r) * 512 + h * 128 + e]); }
            __syncthreads();
            if (tid < 128) {
                for (int r = 0; r < 64; ++r) { const float v = vs[r * 128 + tid]; float o = 0.f;
#pragma unroll
                    for (int d = 0; d < 64; ++d) { S[d] = gam * S[d] + ks[r * 64 + d] * v; o += qs[r * 64 + d] * S[d]; }
                    os[r * 128 + tid] = o; }
            }
            __syncthreads();
            { const int r = tid >> 3, e0 = (tid & 7) * 16; float ss = 0.f;
#pragma unroll
              for (int j = 0; j < 16; ++j) { const float v = os[r * 128 + e0 + j]; ss += v * v; }
              ss += __shfl_xor(ss, 1); ss += __shfl_xor(ss, 2); ss += __shfl_xor(ss, 4);
              const float rr = 1.0f / sqrtf(ss * (1.0f / 128.0f) + EPS); bf16_t* g = CG + (size_t)(b * SEQ + n * 64 + r) * 512 + h * 128 + e0;
#pragma unroll
              for (int j = 0; j < 16; ++j) g[j] = (bf16_t)f2bf(bf2f(g[j]) * os[r * 128 + e0 + j] * rr * onorm[h * 128 + e0 + j]); }
        }
    }
}
}

namespace fa {
typedef short s16x4 __attribute__((ext_vector_type(4)));
typedef short v4i16_t __attribute__((ext_vector_type(4)));
typedef LAS const unsigned char* lds_cptr;
constexpr int SLOTB = 32768, NSLOT = 3, KOFF = 0, VOFF = 16384;
constexpr int LDS_WS = NSLOT * SLOTB, LDS_BIAS = LDS_WS + 2048, LDS_END = LDS_BIAS + 2560;
constexpr float THR = 8.0f;
__device__ __forceinline__ int crow(int r, int hi) { return (r & 3) + 8 * (r >> 2) + 4 * hi; }
__device__ __forceinline__ void glds16(const void* gsrc, unsigned lds_dst) { unsigned keep;
    asm volatile("s_mov_b32 %0, m0\n\ts_mov_b32 m0, %2\n\ts_nop 0\n\tglobal_load_lds_dwordx4 %1, off\n\ts_mov_b32 m0, %0" : "=&s"(keep) : "v"(gsrc), "s"(lds_dst) : "memory"); }
__device__ __forceinline__ void glds16s(const void* sbase, unsigned voff, unsigned lds_dst) { unsigned keep;
    asm volatile("s_mov_b32 %0, m0\n\ts_mov_b32 m0, %3\n\ts_nop 0\n\tglobal_load_lds_dwordx4 %1, %2\n\ts_mov_b32 m0, %0" : "=&s"(keep) : "v"(voff), "s"(sbase), "s"(lds_dst) : "memory"); }
#define FA_WAIT_BAR(N) asm volatile("s_waitcnt vmcnt(" #N ") lgkmcnt(0)\n\ts_barrier" ::: "memory")
#define FA_BAR() asm volatile("s_waitcnt lgkmcnt(0)\n\ts_barrier" ::: "memory")
__device__ __forceinline__ s16x4 vtr(lds_cptr p) { return __builtin_bit_cast(s16x4, __builtin_amdgcn_ds_read_tr16_b64_v4i16((LAS v4i16_t*)p)); }
__device__ __forceinline__ bf16x8 cat8(const s16x4 lo, const s16x4 hi) { return (bf16x8){lo[0], lo[1], lo[2], lo[3], hi[0], hi[1], hi[2], hi[3]}; }
__device__ __forceinline__ float swapmax(float m) { auto rr = __builtin_amdgcn_permlane32_swap(__float_as_uint(m), __float_as_uint(m), false, false); return fmaxf(__uint_as_float(rr[0]), __uint_as_float(rr[1])); }
__device__ __forceinline__ float swapsum(float m) { auto rr = __builtin_amdgcn_permlane32_swap(__float_as_uint(m), __float_as_uint(m), false, false); return __uint_as_float(rr[0]) + __uint_as_float(rr[1]); }
__device__ __forceinline__ bf16x8 pack_p(const f32x16& p, int base) { u32x4 w; w.x = cvt_pk_bf16_n(p[base], p[base + 1]); w.y = cvt_pk_bf16_n(p[base + 2], p[base + 3]); w.z = cvt_pk_bf16_n(p[base + 4], p[base + 5]); w.w = cvt_pk_bf16_n(p[base + 6], p[base + 7]); return __builtin_bit_cast(bf16x8, w); }
__device__ __forceinline__ float half_sum32(float v) {
    v = xor_add<1>(v); v = xor_add<2>(v); v = xor_add<4>(v); v = xor_add<8>(v); return xor_add<16>(v);
}

template <int MODE>
__device__ __forceinline__ void attn_unit(LAS unsigned char* lds, const int tid, const bf16_t* Qg, const bf16_t* Kg, const bf16_t* Vg, bf16_t* Yg, const int b, const int hq, const int u,
                                          const float lam, const float osc, const float* subln) {
    constexpr int PITCH = 512, NDB = (MODE == 0) ? 4 : 2;
    const int lane = tid & 63, r32 = lane & 31, hi = lane >> 5, wid = __builtin_amdgcn_readfirstlane(tid >> 6), ch = wid >> 2, wq = wid & 3;
    const int cw = 2 * u + (wq >> 1);
    const int t0 = (MODE == 0) ? 0 : ((2 * u - 8) > 0 ? (2 * u - 8) : 0), t1 = 2 * u + 1, NT = t1 - t0 + 1;
    const size_t rowbase = (size_t)b * SEQ;
    const bf16_t* Kb = Kg + rowbase * PITCH + hq * 128; const bf16_t* Vb = Vg + rowbase * PITCH + hq * 128;
    const unsigned lds0 = (unsigned)(uintptr_t)lds;
    LAS float* wsf = (LAS float*)(lds + LDS_WS) + wid * 64;
    const bf16_t* ksrc = Kb + (size_t)lane * PITCH + (2 * wid) * 8;
    const bf16_t* vsrc0 = Vb + (size_t)(16 * ((2 * wid) & 3) + (lane >> 2)) * PITCH + 32 * ((2 * wid) >> 2) + (lane & 3) * 8;
    const bf16_t* vsrc1 = Vb + (size_t)(16 * ((2 * wid + 1) & 3) + (lane >> 2)) * PITCH + 32 * ((2 * wid + 1) >> 2) + (lane & 3) * 8;
#define FA_DMA(t, slot) do { const size_t to_ = (size_t)(t) * 64 * PITCH; const unsigned sb_ = lds0 + (unsigned)(slot) * SLOTB; \
        glds16(ksrc + to_, (unsigned)__builtin_amdgcn_readfirstlane(sb_ + KOFF + (2 * wid) * 1024)); glds16(ksrc + to_ + 8, (unsigned)__builtin_amdgcn_readfirstlane(sb_ + KOFF + (2 * wid + 1) * 1024)); \
        glds16(vsrc0 + to_, (unsigned)__builtin_amdgcn_readfirstlane(sb_ + VOFF + (2 * wid) * 1024)); glds16(vsrc1 + to_, (unsigned)__builtin_amdgcn_readfirstlane(sb_ + VOFF + (2 * wid + 1) * 1024)); } while (0)
    FA_DMA(t0, 0);
    if (NT > 1) FA_DMA(t0 + 1, 1);
    const size_t qrow = rowbase + (size_t)u * 128 + wq * 32;
    bf16x8 qr[4];
#pragma unroll
    for (int i = 0; i < 4; ++i) qr[i] = *(const bf16x8*)(Qg + (qrow + r32) * PITCH + hq * 128 + ch * 64 + i * 16 + hi * 8);
    f32x16 o[NDB];
#pragma unroll
    for (int d = 0; d < NDB; ++d)
#pragma unroll
        for (int r = 0; r < 16; ++r) o[d][r] = 0.f;
    float mref = 0.f, lsum = 0.f; bool first = true;
    const lds_cptr kp0 = (lds_cptr)lds + KOFF + ch * 8192 + hi * 1024 + r32 * 16;
    const lds_cptr vp0 = (lds_cptr)lds + VOFF + ((MODE == 0) ? 0 : ch * 8192) + ((lane >> 4) & 1) * 32 + (lane & 3) * 8 + (4 * hi + ((lane & 15) >> 2)) * 64;
    int slot = 0;
    for (int i = 0; i < NT; ++i) {
        if (i + 1 < NT) FA_WAIT_BAR(4); else FA_WAIT_BAR(0);
        if (i + 2 < NT) { const int s2 = (slot == 0) ? 2 : slot - 1; FA_DMA(t0 + i + 2, s2); }
        const int t = t0 + i;
        const bool vis = (MODE == 0) ? (t <= cw) : (t <= cw && t + 8 >= cw);
        if (vis) {
            const lds_cptr kp = kp0 + slot * SLOTB; const lds_cptr vp = vp0 + slot * SLOTB;
            f32x16 p0, p1;
#pragma unroll
            for (int r = 0; r < 16; ++r) { p0[r] = 0.f; p1[r] = 0.f; }
#pragma unroll
            for (int k = 0; k < 4; ++k) {
                const bf16x8 ka = *(const LAS bf16x8*)(kp + k * 2048), kb = *(const LAS bf16x8*)(kp + k * 2048 + 512);
                p0 = __builtin_amdgcn_mfma_f32_32x32x16_bf16(ka, qr[k], p0, 0, 0, 0);
                p1 = __builtin_amdgcn_mfma_f32_32x32x16_bf16(kb, qr[k], p1, 0, 0, 0);
            }
            if (MODE == 1) {
                const LAS float* bt = (const LAS float*)(lds + LDS_BIAS) + ch * 320;
                const int relb = 64 * (cw - t) + 32 * (wq & 1) + r32 + 63;
                if (cw - t >= 5) { const float c = bt[319];
#pragma unroll
                    for (int r = 0; r < 16; ++r) { p0[r] += c; p1[r] += c; }
                } else {
#pragma unroll
                    for (int r = 0; r < 16; ++r) { const int i0 = relb - crow(r, hi), i1 = i0 - 32; p0[r] += bt[i0 > 319 ? 319 : i0]; p1[r] += bt[i1 > 319 ? 319 : i1]; }
                }
            }
            float rm = fmaxf(p0[0], p1[0]);
#pragma unroll
            for (int r = 1; r < 16; ++r) rm = fmaxf(rm, fmaxf(p0[r], p1[r]));
            rm = swapmax(rm);
            if (first) { mref = rm; first = false; }
            else if (__any(rm - mref > THR)) {
                const float dl = fmaxf(rm - mref, 0.f); mref += dl; const float f = fast_exp2(-dl); lsum *= f;
                if (hi == 0) wsf[r32] = f;
                LDS_WAIT();
#pragma unroll
                for (int r = 0; r < 16; ++r) { const float fr = wsf[crow(r, hi)];
#pragma unroll
                    for (int d = 0; d < NDB; ++d) o[d][r] *= fr; }
            }
            float sacc = 0.f;
#pragma unroll
            for (int r = 0; r < 16; ++r) { p0[r] = fast_exp2(p0[r] - mref); p1[r] = fast_exp2(p1[r] - mref); sacc += p0[r] + p1[r]; }
            lsum += sacc;
            const bf16x8 pa0 = pack_p(p0, 0), pa1 = pack_p(p0, 8), pa2 = pack_p(p1, 0), pa3 = pack_p(p1, 8);
#pragma unroll
            for (int d = 0; d < NDB; ++d) {
                const lds_cptr vd = vp + d * 4096;
                const bf16x8 v0 = cat8(vtr(vd), vtr(vd + 512)), v1 = cat8(vtr(vd + 1024), vtr(vd + 1024 + 512)), v2 = cat8(vtr(vd + 2048), vtr(vd + 2048 + 512)), v3 = cat8(vtr(vd + 3072), vtr(vd + 3072 + 512));
                o[d] = __builtin_amdgcn_mfma_f32_32x32x16_bf16(pa0, v0, o[d], 0, 0, 0);
                o[d] = __builtin_amdgcn_mfma_f32_32x32x16_bf16(pa1, v1, o[d], 0, 0, 0);
                o[d] = __builtin_amdgcn_mfma_f32_32x32x16_bf16(pa2, v2, o[d], 0, 0, 0);
                o[d] = __builtin_amdgcn_mfma_f32_32x32x16_bf16(pa3, v3, o[d], 0, 0, 0);
            }
        }
        slot = (slot == NSLOT - 1) ? 0 : slot + 1;
    }
    lsum = swapsum(lsum);
    if (hi == 0) wsf[32 + r32] = lsum;
    LDS_WAIT();
#pragma unroll
    for (int r = 0; r < 16; ++r) { const float il = fast_rcp(wsf[32 + crow(r, hi)]);
#pragma unroll
        for (int d = 0; d < NDB; ++d) o[d][r] *= il; }
    FA_BAR();
    if (MODE == 0) {
        LAS float* xf = (LAS float*)lds + (wid & 3) * 4096;
        if (ch == 1) {
#pragma unroll
            for (int d = 0; d < 4; ++d)
#pragma unroll
                for (int r = 0; r < 16; ++r) xf[(d * 16 + r) * 64 + lane] = o[d][r];
        }
        FA_BAR();
        if (ch == 0) {
            float ss[16];
#pragma unroll
            for (int r = 0; r < 16; ++r) ss[r] = 0.f;
#pragma unroll
            for (int d = 0; d < 4; ++d)
#pragma unroll
                for (int r = 0; r < 16; ++r) { const float y = o[d][r] - lam * xf[(d * 16 + r) * 64 + lane]; o[d][r] = y; ss[r] += y * y; }
            LAS bf16_t* stg = (LAS bf16_t*)(lds + 65536) + wid * 4096;
            float g[4];
#pragma unroll
            for (int d = 0; d < 4; ++d) g[d] = subln[32 * d + r32] * osc;
#pragma unroll
            for (int r = 0; r < 16; ++r) { const float rs = __builtin_amdgcn_rsqf(half_sum32(ss[r]) * (1.0f / 128.0f) + EPS); const int orow = crow(r, hi);
#pragma unroll
                for (int d = 0; d < 4; ++d) stg[orow * 128 + d * 32 + r32] = (bf16_t)f2bf(o[d][r] * rs * g[d]); }
            LDS_WAIT();
#pragma unroll
            for (int i = 0; i < 8; ++i) { const int idx = i * 64 + lane, row = idx >> 4, c8 = idx & 15;
                const u32x4 v = *(const LAS u32x4*)(stg + row * 128 + c8 * 8);
                *(u32x4*)(Yg + (qrow + row) * PITCH + hq * 128 + c8 * 8) = v; }
        }
    } else {
        LAS bf16_t* stg = (LAS bf16_t*)lds + wid * 2048;
#pragma unroll
        for (int r = 0; r < 16; ++r) { const int orow = crow(r, hi);
#pragma unroll
            for (int d = 0; d < 2; ++d) stg[orow * 64 + d * 32 + r32] = (bf16_t)f2bf(o[d][r]); }
        LDS_WAIT();
#pragma unroll
        for (int i = 0; i < 4; ++i) { const int idx = i * 64 + lane, row = idx >> 3, c8 = idx & 7;
            const u32x4 v = *(const LAS u32x4*)(stg + row * 64 + c8 * 8);
            *(u32x4*)(Yg + (qrow + row) * PITCH + hq * 128 + ch * 64 + c8 * 8) = v; }
    }
    FA_BAR();
#undef FA_DMA
}

constexpr int NSLOT2 = 4, LDS_WS2 = 132096, LDS_BIAS2 = LDS_WS2 + 2048;
template <int MODE>
__device__ __forceinline__ void attn_unit2(LAS unsigned char* lds, const int tid_, const bf16_t* Qg, const bf16_t* Kg, const bf16_t* Vg, bf16_t* Yg, const int b, const int hq, const int u,
                                           const float lam, const float osc, const float* subln, const int pm = 0) {
    constexpr int PITCH = 512, NDB = (MODE == 0) ? 4 : 2;
    int tid = tid_; asm volatile("" : "+v"(tid));
    const int lane = tid & 63, r32 = lane & 31, hi = lane >> 5, hwid = __builtin_amdgcn_readfirstlane(tid >> 6);
#if FA_WMAP == 1
    const int wid = (hwid >> 1) | ((hwid & 1) << 2);
#elif FA_WMAP == 2
    const int wid = (hwid & 1) | ((hwid >> 2) << 1) | (((hwid >> 1) & 1) << 2);
#else
    const int wid = hwid;
#endif
    const int ch = wid >> 2, wq = wid & 3;
    const int cw = 2 * u + (wq >> 1);
    const int t0 = (MODE == 0) ? 0 : ((2 * u - 8) > 0 ? (2 * u - 8) : 0), t1 = 2 * u + 1, NT = t1 - t0 + 1;
    const int iv1 = cw - t0, iv0 = (MODE == 0) ? 0 : ((cw - 8 - t0) > 0 ? (cw - 8 - t0) : 0);
    const size_t rowbase = (size_t)b * SEQ;
    const bf16_t* Kb = Kg + rowbase * PITCH + hq * 128; const bf16_t* Vb = Vg + rowbase * PITCH + hq * 128;
    const unsigned lds0 = (unsigned)(uintptr_t)lds;
    LAS float* wsf = (LAS float*)(lds + LDS_WS2) + wid * 64;
    const bf16_t* kbase = Kb + (2 * wid) * 8;
    const bf16_t* vbase = Vb + (size_t)(16 * ((2 * wid) & 3)) * PITCH + 32 * ((2 * wid) >> 2);
    const unsigned kvo = (unsigned)lane * PITCH * 2u, vvo = (unsigned)((lane >> 2) * PITCH + (lane & 3) * 8) * 2u;
#define FA_DMA(t, slot) do { if (pm == 1) break; const size_t to_ = (size_t)(t) * 64 * PITCH; const unsigned sb_ = lds0 + (unsigned)(slot) * SLOTB; \
        glds16s(kbase + to_, kvo, (unsigned)__builtin_amdgcn_readfirstlane(sb_ + KOFF + (2 * wid) * 1024)); glds16s(kbase + to_ + 8, kvo, (unsigned)__builtin_amdgcn_readfirstlane(sb_ + KOFF + (2 * wid + 1) * 1024)); \
        glds16s(vbase + to_, vvo, (unsigned)__builtin_amdgcn_readfirstlane(sb_ + VOFF + (2 * wid) * 1024)); glds16s(vbase + to_ + 16 * PITCH, vvo, (unsigned)__builtin_amdgcn_readfirstlane(sb_ + VOFF + (2 * wid + 1) * 1024)); } while (0)
    FA_DMA(t0, 0);
    FA_DMA(t0 + 1, 1);
    const size_t qrow = rowbase + (size_t)u * 128 + wq * 32;
    bf16x8 qr[4];
#pragma unroll
    for (int i = 0; i < 4; ++i) qr[i] = *(const bf16x8*)(Qg + (qrow + r32) * PITCH + hq * 128 + ch * 64 + i * 16 + hi * 8);
    f32x16 o[NDB];
#pragma unroll
    for (int d = 0; d < NDB; ++d)
#pragma unroll
        for (int r = 0; r < 16; ++r) o[d][r] = 0.f;
    float mref = 0.f, lsum = 0.f; bool first = true;
    const lds_cptr kp0 = (lds_cptr)lds + KOFF + ch * 8192 + hi * 1024 + r32 * 16;
    const lds_cptr vp0 = (lds_cptr)lds + VOFF + ((MODE == 0) ? 0 : ch * 8192) + ((lane >> 4) & 1) * 32 + (lane & 3) * 8 + (4 * hi + ((lane & 15) >> 2)) * 64;
    f32x16 p0, p1; bf16x8 pa0, pa1, pa2, pa3, kf[8], vf[NDB * 4];
#pragma unroll
    for (int r = 0; r < 16; ++r) { p0[r] = 0.f; p1[r] = 0.f; }
    pa0 = pa1 = pa2 = pa3 = (bf16x8){0, 0, 0, 0, 0, 0, 0, 0};
#pragma unroll
    for (int k = 0; k < NDB * 4; ++k) vf[k] = pa0;
#define FA_SB() __builtin_amdgcn_sched_barrier(0)
#define FA_KLD(i_) do { if (pm == 7) break; const lds_cptr kp = kp0 + ((i_) & 3) * SLOTB; \
        _Pragma("unroll") for (int k = 0; k < 4; ++k) { kf[2 * k] = *(const LAS bf16x8*)(kp + k * 2048); kf[2 * k + 1] = *(const LAS bf16x8*)(kp + k * 2048 + 512); } } while (0)
#define FA_QK(i_) do { \
        _Pragma("unroll") for (int r = 0; r < 16; ++r) { p0[r] = 0.f; p1[r] = 0.f; } \
        _Pragma("unroll") for (int k = 0; k < 4; ++k) { p0 = __builtin_amdgcn_mfma_f32_32x32x16_bf16(kf[2 * k], qr[k], p0, 0, 0, 0); p1 = __builtin_amdgcn_mfma_f32_32x32x16_bf16(kf[2 * k + 1], qr[k], p1, 0, 0, 0); } \
        if (MODE == 1) { const int t = t0 + (i_); const LAS float* bt = (const LAS float*)(lds + LDS_BIAS2) + ch * 320; const int relb = 64 * (cw - t) + 32 * (wq & 1) + r32 + 63; \
            if (cw - t >= 5) { const float c = bt[319]; _Pragma("unroll") for (int r = 0; r < 16; ++r) { p0[r] += c; p1[r] += c; } } \
            else { _Pragma("unroll") for (int r = 0; r < 16; ++r) { const int i0 = relb - crow(r, hi), i1 = i0 - 32; p0[r] += bt[i0 > 319 ? 319 : i0]; p1[r] += bt[i1 > 319 ? 319 : i1]; } } } } while (0)
#define FA_MX3(a, b, c) __builtin_fmaxf(__builtin_fmaxf((a), (b)), (c))
#define FA_SM() do { if (pm == 3) { asm volatile("" : "+v"(p0), "+v"(p1)); break; } \
        float ma = FA_MX3(p0[0], p0[1], p1[0]), mb = FA_MX3(p0[2], p0[3], p1[1]), mc = FA_MX3(p0[4], p0[5], p1[2]), md = FA_MX3(p0[6], p0[7], p1[3]); \
        ma = FA_MX3(ma, p0[8], p0[9]); mb = FA_MX3(mb, p0[10], p0[11]); mc = FA_MX3(mc, p0[12], p0[13]); md = FA_MX3(md, p0[14], p0[15]); \
        ma = FA_MX3(ma, p1[4], p1[5]); mb = FA_MX3(mb, p1[6], p1[7]); mc = FA_MX3(mc, p1[8], p1[9]); md = FA_MX3(md, p1[10], p1[11]); \
        ma = FA_MX3(ma, p1[12], p1[13]); mb = FA_MX3(mb, p1[14], p1[15]); float rm = __builtin_fmaxf(__builtin_fmaxf(ma, mb), __builtin_fmaxf(mc, md)); rm = swapmax(rm); \
        if (first) { mref = rm; first = false; } \
        else if (__any(rm - mref > THR)) { const float dl = fmaxf(rm - mref, 0.f); mref += dl; const float f = fast_exp2(-dl); lsum *= f; if (hi == 0) wsf[r32] = f; LDS_WAIT(); \
            _Pragma("unroll") for (int r = 0; r < 16; ++r) { const float fr = wsf[crow(r, hi)]; _Pragma("unroll") for (int d = 0; d < NDB; ++d) o[d][r] *= fr; } } \
        float sa = 0.f, sb = 0.f, sc = 0.f, sd = 0.f; \
        _Pragma("unroll") for (int r = 0; r < 16; r += 4) { p0[r] = fast_exp2(p0[r] - mref); p0[r + 1] = fast_exp2(p0[r + 1] - mref); p0[r + 2] = fast_exp2(p0[r + 2] - mref); p0[r + 3] = fast_exp2(p0[r + 3] - mref); \
            p1[r] = fast_exp2(p1[r] - mref); p1[r + 1] = fast_exp2(p1[r + 1] - mref); p1[r + 2] = fast_exp2(p1[r + 2] - mref); p1[r + 3] = fast_exp2(p1[r + 3] - mref); \
            sa += p0[r] + p1[r]; sb += p0[r + 1] + p1[r + 1]; sc += p0[r + 2] + p1[r + 2]; sd += p0[r + 3] + p1[r + 3]; } \
        lsum += (sa + sb) + (sc + sd); \
        pa0 = pack_p(p0, 0); pa1 = pack_p(p0, 8); pa2 = pack_p(p1, 0); pa3 = pack_p(p1, 8); } while (0)
#define FA_VLDALL(i_) do { if (pm == 4) break; const lds_cptr vt = vp0 + ((i_) & 3) * SLOTB; \
        _Pragma("unroll") for (int d = 0; d < NDB; ++d) _Pragma("unroll") for (int k = 0; k < 4; ++k) vf[4 * d + k] = cat8(vtr(vt + d * 4096 + k * 1024), vtr(vt + d * 4096 + k * 1024 + 512)); } while (0)
#define FA_PV() do { if (pm == 5) break; _Pragma("unroll") for (int d = 0; d < NDB; ++d) { \
        o[d] = __builtin_amdgcn_mfma_f32_32x32x16_bf16(pa0, vf[4 * d], o[d], 0, 0, 0); o[d] = __builtin_amdgcn_mfma_f32_32x32x16_bf16(pa1, vf[4 * d + 1], o[d], 0, 0, 0); \
        o[d] = __builtin_amdgcn_mfma_f32_32x32x16_bf16(pa2, vf[4 * d + 2], o[d], 0, 0, 0); o[d] = __builtin_amdgcn_mfma_f32_32x32x16_bf16(pa3, vf[4 * d + 3], o[d], 0, 0, 0); } } while (0)
#if PROBE_T
    unsigned tacc0 = 0, tacc1 = 0, tacc2 = 0, tacc3 = 0; unsigned long long s0 = 0, s1 = 0, s2 = 0, s3 = 0; const unsigned long long rt0 = __builtin_amdgcn_s_memrealtime();
#define FA_TS(v) do { FA_SB(); asm volatile("s_memtime %0\n\ts_waitcnt lgkmcnt(0)" : "=s"(v) :: "memory"); FA_SB(); } while (0)
#define FA_TSV(v, a, b) do { FA_SB(); asm volatile("s_nop 15\n\ts_nop 15" : "+v"(a), "+v"(b)); asm volatile("s_memtime %0\n\ts_waitcnt lgkmcnt(0)" : "=s"(v) :: "memory"); FA_SB(); } while (0)
#define FA_TACC() do { tacc0 += (unsigned)(s3 - s0); tacc1 += (unsigned)(s1 - s0); tacc2 += (unsigned)(s2 - s1); tacc3 += (unsigned)(s3 - s2); } while (0)
#define FA_TOUT(base) do { if (blockIdx.x == 0 && (hwid & 3) == 0 && u >= 32) { const unsigned long long rt1 = __builtin_amdgcn_s_memrealtime(); \
        unsigned long long* pv = (unsigned long long*)((char*)Yg - WS_AQ + WS_PROBE) + (base); if (lane == 0) { pv[0] = tacc0 / NT; pv[1] = tacc1 / NT; pv[2] = tacc2 / NT; pv[3] = tacc3 / NT; pv[4] = ((unsigned long long)tacc0 * 100) / (rt1 - rt0); pv[5] = NT; } } } while (0)
#else
#define FA_TS(v) do { } while (0)
#define FA_TSV(v, a, b) do { } while (0)
#define FA_TACC() do { } while (0)
#define FA_TOUT(base) do { } while (0)
#endif
    if (ch == 0) {
#pragma unroll 1
        for (int i = 0; i < NT; ++i) {
            FA_TS(s0);
            if (i + 1 < NT) FA_WAIT_BAR(4); else FA_WAIT_BAR(0);
            FA_TS(s1);
            if (i + 2 < NT) FA_DMA(t0 + i + 2, (i + 2) & 3);
            if (pm != 2) {
                const bool prev = (i - 1 >= iv0) && (i - 1 <= iv1), cur = (i >= iv0) && (i <= iv1);
                if (cur) FA_KLD(i);
                FA_SB();
                if (prev) { FA_PV(); FA_SB(); }
                if (cur) { FA_QK(i); FA_SB(); FA_TSV(s2, p0, p1); FA_VLDALL(i); FA_SB(); FA_SM(); FA_SB(); FA_TSV(s3, pa0, pa3); FA_TACC(); }
            }
        }
        FA_TOUT(0);
        if (NT - 1 <= iv1 && pm != 2) FA_PV();
    } else {
#pragma unroll 1
        for (int i = 0; i < NT; ++i) {
            FA_TS(s0);
            if (i + 1 < NT) FA_WAIT_BAR(4); else FA_WAIT_BAR(0);
            FA_TS(s1);
            if (i + 2 < NT) FA_DMA(t0 + i + 2, (i + 2) & 3);
            if (pm != 2) {
                const bool prev = (i - 1 >= iv0) && (i - 1 <= iv1), cur = (i >= iv0) && (i <= iv1);
                if (prev) { FA_VLDALL(i - 1); FA_SB(); FA_SM(); FA_SB(); FA_TSV(s2, pa0, pa3); }
                if (cur) { FA_KLD(i); FA_SB(); }
                if (prev) { FA_PV(); FA_SB(); }
                if (cur) { FA_QK(i); FA_SB(); FA_TSV(s3, p0, p1); if (prev) FA_TACC(); }
            }
        }
        FA_TOUT(8);
        if (NT - 1 <= iv1 && pm != 2) { FA_VLDALL(NT - 1); FA_SB(); FA_SM(); FA_SB(); FA_PV(); }
    }
#undef FA_VLDALL
#undef FA_MX3
#undef FA_TS
#undef FA_TSV
#undef FA_TACC
#undef FA_TOUT
#undef FA_KLD
#undef FA_SB
#undef FA_QK
#undef FA_SM
#undef FA_PV
    lsum = swapsum(lsum);
    if (hi == 0) wsf[32 + r32] = lsum;
    LDS_WAIT();
#pragma unroll
    for (int r = 0; r < 16; ++r) { const float il = fast_rcp(wsf[32 + crow(r, hi)]);
#pragma unroll
        for (int d = 0; d < NDB; ++d) o[d][r] *= il; }
    FA_BAR();
    if (MODE == 0) {
        LAS float* xf = (LAS float*)lds + (wid & 3) * 4096;
        if (ch == 1) {
#pragma unroll
            for (int d = 0; d < 4; ++d)
#pragma unroll
                for (int r = 0; r < 16; ++r) xf[(d * 16 + r) * 64 + lane] = o[d][r];
        }
        FA_BAR();
        if (ch == 0) {
            float ss[16];
#pragma unroll
            for (int r = 0; r < 16; ++r) ss[r] = 0.f;
#pragma unroll
            for (int d = 0; d < 4; ++d)
#pragma unroll
                for (int r = 0; r < 16; ++r) { const float y = o[d][r] - lam * xf[(d * 16 + r) * 64 + lane]; o[d][r] = y; ss[r] += y * y; }
            LAS bf16_t* stg = (LAS bf16_t*)(lds + 65536) + wid * 4096;
            float g[4];
#pragma unroll
            for (int d = 0; d < 4; ++d) g[d] = subln[32 * d + r32] * osc;
#pragma unroll
            for (int r = 0; r < 16; ++r) { const float rs = __builtin_amdgcn_rsqf(half_sum32(ss[r]) * (1.0f / 128.0f) + EPS); const int orow = crow(r, hi);
#pragma unroll
                for (int d = 0; d < 4; ++d) stg[orow * 128 + d * 32 + r32] = (bf16_t)f2bf(o[d][r] * rs * g[d]); }
            LDS_WAIT();
#pragma unroll
            for (int i = 0; i < 8; ++i) { const int idx = i * 64 + lane, row = idx >> 4, c8 = idx & 15;
                const u32x4 v = *(const LAS u32x4*)(stg + row * 128 + c8 * 8);
                *(u32x4*)(Yg + (qrow + row) * PITCH + hq * 128 + c8 * 8) = v; }
        }
    } else {
        LAS bf16_t* stg = (LAS bf16_t*)lds + wid * 2048;
#pragma unroll
        for (int r = 0; r < 16; ++r) { const int orow = crow(r, hi);
#pragma unroll
            for (int d = 0; d < 2; ++d) stg[orow * 64 + d * 32 + r32] = (bf16_t)f2bf(o[d][r]); }
        LDS_WAIT();
#pragma unroll
        for (int i = 0; i < 4; ++i) { const int idx = i * 64 + lane, row = idx >> 3, c8 = idx & 7;
            const u32x4 v = *(const LAS u32x4*)(stg + row * 64 + c8 * 8);
            *(u32x4*)(Yg + (qrow + row) * PITCH + hq * 128 + ch * 64 + c8 * 8) = v; }
    }
    FA_BAR();
#undef FA_DMA
}

constexpr int K3OFF = 0, V3OFF = 49152, NK3 = 3;
template <int MODE, bool NOMAX>
__device__ __forceinline__ void attn_unit3(LAS unsigned char* lds, const int tid_, const bf16_t* Qg, const bf16_t* Kg, const bf16_t* Vg, bf16_t* Yg, const int b, const int hq, const int u,
                                           const float lam, const float osc, const float* subln, const int pm = 0) {
    constexpr int PITCH = 512, NDB = (MODE == 0) ? 4 : 2;
    int tid = tid_; asm volatile("" : "+v"(tid));
#if PROBE_T
    const unsigned long long tu0_ = __builtin_amdgcn_s_memtime();
#endif
    const int lane = tid & 63, r32 = lane & 31, hi = lane >> 5, wid = __builtin_amdgcn_readfirstlane(tid >> 6), ch = wid >> 2, wq = wid & 3;
    const int cw = 2 * u + (wq >> 1);
#if FA_PRIO
    if (ch == 0) __builtin_amdgcn_s_setprio(FA_PRIO); else __builtin_amdgcn_s_setprio(0);
#endif
    const int t0 = (MODE == 0) ? 0 : ((2 * u - 8) > 0 ? (2 * u - 8) : 0), t1 = 2 * u + 1, NT = t1 - t0 + 1;
    const int iv1 = cw - t0, iv0 = (MODE == 0) ? 0 : ((cw - 8 - t0) > 0 ? (cw - 8 - t0) : 0);
    const size_t rowbase = (size_t)b * SEQ;
    const bf16_t* Kb = Kg + rowbase * PITCH + hq * 128; const bf16_t* Vb = Vg + rowbase * PITCH + hq * 128;
    const unsigned lds0 = (unsigned)(uintptr_t)lds;
    LAS float* wsf = (LAS float*)(lds + LDS_WS2) + wid * 64;
    const bf16_t* kbase = Kb + (2 * wid) * 8;
    const bf16_t* vbase = Vb + (size_t)(16 * ((2 * wid) & 3)) * PITCH + 32 * ((2 * wid) >> 2);
    const unsigned kvo = (unsigned)lane * PITCH * 2u, vvo = (unsigned)((lane >> 2) * PITCH + (lane & 3) * 8) * 2u;
#define F3_DMAK(j) do { if ((j) < NT) { const size_t to_ = (size_t)(t0 + (j)) * 64 * PITCH; const unsigned sb_ = lds0 + K3OFF + (unsigned)((j) % NK3) * 16384u; \
        glds16s(kbase + to_, kvo, (unsigned)__builtin_amdgcn_readfirstlane(sb_ + (2 * wid) * 1024)); glds16s(kbase + to_ + 8, kvo, (unsigned)__builtin_amdgcn_readfirstlane(sb_ + (2 * wid + 1) * 1024)); } } while (0)
#define F3_DMAV(j) do { if ((j) < NT) { const size_t to_ = (size_t)(t0 + (j)) * 64 * PITCH; const unsigned sb_ = lds0 + V3OFF + (unsigned)((j) & 3) * 16384u; \
        glds16s(vbase + to_, vvo, (unsigned)__builtin_amdgcn_readfirstlane(sb_ + (2 * wid) * 1024)); glds16s(vbase + to_ + 16 * PITCH, vvo, (unsigned)__builtin_amdgcn_readfirstlane(sb_ + (2 * wid + 1) * 1024)); } } while (0)
#define F3_DMAK1(j, pc) do { if ((j) < NT) { const size_t to_ = (size_t)(t0 + (j)) * 64 * PITCH; const unsigned sb_ = lds0 + K3OFF + (unsigned)((j) % NK3) * 16384u; \
        glds16s(kbase + to_ + 8 * (pc), kvo, (unsigned)__builtin_amdgcn_readfirstlane(sb_ + (2 * wid + (pc)) * 1024)); } } while (0)
#define F3_DMAV1(j, pc) do { if ((j) < NT) { const size_t to_ = (size_t)(t0 + (j)) * 64 * PITCH; const unsigned sb_ = lds0 + V3OFF + (unsigned)((j) & 3) * 16384u; \
        glds16s(vbase + to_ + 16 * PITCH * (pc), vvo, (unsigned)__builtin_amdgcn_readfirstlane(sb_ + (2 * wid + (pc)) * 1024)); } } while (0)
    F3_DMAK(0); F3_DMAK(1); F3_DMAV(0); F3_DMAK(2); F3_DMAV(1);
    const size_t qrow = rowbase + (size_t)u * 128 + wq * 32;
    bf16x8 qr[4];
#pragma unroll
    for (int i = 0; i < 4; ++i) qr[i] = *(const bf16x8*)(Qg + (qrow + r32) * PITCH + hq * 128 + ch * 64 + i * 16 + hi * 8);
    f32x16 o[NDB];
#pragma unroll
    for (int d = 0; d < NDB; ++d)
#pragma unroll
        for (int r = 0; r < 16; ++r) o[d][r] = 0.f;
    float mref = -1e30f, lsum = 0.f;
    const lds_cptr kp0 = (lds_cptr)lds + K3OFF + ch * 8192 + hi * 1024 + r32 * 16;
    const lds_cptr vp0 = (lds_cptr)lds + V3OFF + ((MODE == 0) ? 0 : ch * 8192) + ((lane >> 4) & 1) * 32 + (lane & 3) * 8 + (4 * hi + ((lane & 15) >> 2)) * 64;
    const LAS float* btab = (const LAS float*)(lds + LDS_BIAS2) + ch * 640;
    f32x16 cA0, cA1, cB0, cB1; u32x4 pA[4], pB[4];
#pragma unroll
    for (int r = 0; r < 16; ++r) { cA0[r] = 0.f; cA1[r] = 0.f; cB0[r] = 0.f; cB1[r] = 0.f; }
#pragma unroll
    for (int k = 0; k < 4; ++k) { pA[k] = (u32x4){0u, 0u, 0u, 0u}; pB[k] = (u32x4){0u, 0u, 0u, 0u}; }
#define F3_SB() __builtin_amdgcn_sched_barrier(0)
#define F3_MX3(a, b, c) __builtin_fmaxf(__builtin_fmaxf((a), (b)), (c))
#define F3_QK(j, d0, d1) do { const lds_cptr kp = kp0 + ((j) % NK3) * 16384; \
        _Pragma("unroll") for (int k = 0; k < 4; ++k) { const bf16x8 ka = *(const LAS bf16x8*)(kp + k * 2048), kb = *(const LAS bf16x8*)(kp + k * 2048 + 512); \
            if (k == 0) { d0 = __builtin_amdgcn_mfma_f32_32x32x16_bf16(ka, qr[0], (f32x16){0.f, 0.f, 0.f, 0.f, 0.f, 0.f, 0.f, 0.f, 0.f, 0.f, 0.f, 0.f, 0.f, 0.f, 0.f, 0.f}, 0, 0, 0); d1 = __builtin_amdgcn_mfma_f32_32x32x16_bf16(kb, qr[0], (f32x16){0.f, 0.f, 0.f, 0.f, 0.f, 0.f, 0.f, 0.f, 0.f, 0.f, 0.f, 0.f, 0.f, 0.f, 0.f, 0.f}, 0, 0, 0); } \
            else { d0 = __builtin_amdgcn_mfma_f32_32x32x16_bf16(ka, qr[k], d0, 0, 0, 0); d1 = __builtin_amdgcn_mfma_f32_32x32x16_bf16(kb, qr[k], d1, 0, 0, 0); } } } while (0)
#define F3_BIAS(j, d0, d1) do { if (MODE == 1) { const int t = t0 + (j); const LAS float* bt = btab; const int relb = 64 * (cw - t) + 32 * (wq & 1) + r32 + 63; \
            if (cw - t >= 5) { const float c = bt[319]; _Pragma("unroll") for (int r = 0; r < 16; ++r) { d0[r] += c; d1[r] += c; } } \
            else { _Pragma("unroll") for (int r = 0; r < 16; ++r) { const int i0 = relb - crow(r, hi), i1 = i0 - 32; d0[r] += bt[i0 > 319 ? 319 : i0]; d1[r] += bt[i1 > 319 ? 319 : i1]; } } } } while (0)
#define F3_PV(j, P) do { const lds_cptr vt = vp0 + ((j) & 3) * 16384; \
        _Pragma("unroll") for (int d = 0; d < NDB; ++d) { const lds_cptr vd = vt + d * 4096; \
            o[d] = __builtin_amdgcn_mfma_f32_32x32x16_bf16(__builtin_bit_cast(bf16x8, P[0]), cat8(vtr(vd), vtr(vd + 512)), o[d], 0, 0, 0); o[d] = __builtin_amdgcn_mfma_f32_32x32x16_bf16(__builtin_bit_cast(bf16x8, P[1]), cat8(vtr(vd + 1024), vtr(vd + 1536)), o[d], 0, 0, 0); \
            o[d] = __builtin_amdgcn_mfma_f32_32x32x16_bf16(__builtin_bit_cast(bf16x8, P[2]), cat8(vtr(vd + 2048), vtr(vd + 2560)), o[d], 0, 0, 0); o[d] = __builtin_amdgcn_mfma_f32_32x32x16_bf16(__builtin_bit_cast(bf16x8, P[3]), cat8(vtr(vd + 3072), vtr(vd + 3584)), o[d], 0, 0, 0); } } while (0)
#define F3_SM(c0, c1, P) do { \
        if (NOMAX) { upd = false; } else { \
        float ma = F3_MX3(c0[0], c0[1], c1[0]), mb = F3_MX3(c0[2], c0[3], c1[1]), mc = F3_MX3(c0[4], c0[5], c1[2]), md = F3_MX3(c0[6], c0[7], c1[3]); \
        ma = F3_MX3(ma, c0[8], c0[9]); mb = F3_MX3(mb, c0[10], c0[11]); mc = F3_MX3(mc, c0[12], c0[13]); md = F3_MX3(md, c0[14], c0[15]); \
        ma = F3_MX3(ma, c1[4], c1[5]); mb = F3_MX3(mb, c1[6], c1[7]); mc = F3_MX3(mc, c1[8], c1[9]); md = F3_MX3(md, c1[10], c1[11]); \
        ma = F3_MX3(ma, c1[12], c1[13]); mb = F3_MX3(mb, c1[14], c1[15]); float rm = __builtin_fmaxf(__builtin_fmaxf(ma, mb), __builtin_fmaxf(mc, md)); rm = swapmax(rm); \
        upd = __any(rm - mref > THR); const float mnew = upd ? __builtin_fmaxf(mref, rm) : mref; fsc = fast_exp2(mref - mnew); mref = mnew; lsum *= fsc; } \
        float sa = 0.f, sb = 0.f, sc = 0.f, sd = 0.f; \
        _Pragma("unroll") for (int r = 0; r < 16; r += 4) { \
            if (NOMAX) { c0[r] = fast_exp2(c0[r]); c0[r + 1] = fast_exp2(c0[r + 1]); c0[r + 2] = fast_exp2(c0[r + 2]); c0[r + 3] = fast_exp2(c0[r + 3]); \
                         c1[r] = fast_exp2(c1[r]); c1[r + 1] = fast_exp2(c1[r + 1]); c1[r + 2] = fast_exp2(c1[r + 2]); c1[r + 3] = fast_exp2(c1[r + 3]); } \
            else { c0[r] = fast_exp2(c0[r] - mref); c0[r + 1] = fast_exp2(c0[r + 1] - mref); c0[r + 2] = fast_exp2(c0[r + 2] - mref); c0[r + 3] = fast_exp2(c0[r + 3] - mref); \
                   c1[r] = fast_exp2(c1[r] - mref); c1[r + 1] = fast_exp2(c1[r + 1] - mref); c1[r + 2] = fast_exp2(c1[r + 2] - mref); c1[r + 3] = fast_exp2(c1[r + 3] - mref); } \
            sa += c0[r] + c1[r]; sb += c0[r + 1] + c1[r + 1]; sc += c0[r + 2] + c1[r + 2]; sd += c0[r + 3] + c1[r + 3]; } \
        lsum += (sa + sb) + (sc + sd); \
        P[0] = __builtin_bit_cast(u32x4, pack_p(c0, 0)); P[1] = __builtin_bit_cast(u32x4, pack_p(c0, 8)); P[2] = __builtin_bit_cast(u32x4, pack_p(c1, 0)); P[3] = __builtin_bit_cast(u32x4, pack_p(c1, 8)); } while (0)
#define F3_RESC() do { if (!NOMAX && upd) { if (hi == 0) wsf[r32] = fsc; LDS_WAIT(); \
            _Pragma("unroll") for (int r = 0; r < 16; ++r) { const float fr = wsf[crow(r, hi)]; _Pragma("unroll") for (int d = 0; d < NDB; ++d) o[d][r] *= fr; } } } while (0)
#define F3_HEAD(i) do { if ((i) + 3 < NT) { asm volatile("s_waitcnt vmcnt(6) lgkmcnt(0)\n\ts_barrier" ::: "memory"); } else FA_WAIT_BAR(0); \
        F3_DMAK((i) + 3); F3_DMAV((i) + 2); F3_SB(); } while (0)
#if PROBE_T
    unsigned tq0 = 0, tq1 = 0, tqn = 0; unsigned long long ts0_ = 0, ts1_ = 0, ts2_ = 0;
#define F3_TS(v) do { F3_SB(); asm volatile("s_memtime %0\n\ts_waitcnt lgkmcnt(0)" : "=s"(v) :: "memory"); F3_SB(); } while (0)
#define F3_TSE(a, b) do { F3_SB(); asm volatile("s_nop 15\n\ts_nop 15" : "+v"(a), "+v"(b)); asm volatile("s_memtime %0\n\ts_waitcnt lgkmcnt(0)" : "=s"(ts2_) :: "memory"); F3_SB(); tq0 += (unsigned)(ts1_ - ts0_); tq1 += (unsigned)(ts2_ - ts1_); ++tqn; } while (0)
#else
#define F3_TS(v) do { } while (0)
#define F3_TSE(a, b) do { } while (0)
#endif
#define F3_HAND(i, C0, C1, N0, N1, PP, PW) do { \
        const lds_cptr vt_ = vp0 + (((i) - 1) & 3) * 16384; const lds_cptr kq_ = kp0 + (((i) + 1) % NK3) * 16384; \
        bf16x8 fq0, fq1, fq2, fq3, fq4; float sa_ = 0.f, sb_ = 0.f; \
        fq0 = cat8(vtr(vt_ + 0), vtr(vt_ + 512)); fq1 = cat8(vtr(vt_ + 1024), vtr(vt_ + 1536)); fq2 = cat8(vtr(vt_ + 2048), vtr(vt_ + 2560)); F3_SB(); \
        F3_TS(ts0_); if ((i) + 3 < NT) { asm volatile("s_waitcnt vmcnt(6) lgkmcnt(0)\n\ts_barrier" ::: "memory"); } else FA_WAIT_BAR(0); F3_TS(ts1_); \
        F3_SB(); \
        o[0] = __builtin_amdgcn_mfma_f32_32x32x16_bf16(__builtin_bit_cast(bf16x8, PP[0]), fq0, o[0], 0, 0, 0); fq3 = cat8(vtr(vt_ + 3072), vtr(vt_ + 3584)); F3_DMAK1((i) + 3, 0); C0[0] = fast_exp2(C0[0]); C0[1] = fast_exp2(C0[1]); asm volatile("" : "+v"(C0)); F3_SB(); \
        o[0] = __builtin_amdgcn_mfma_f32_32x32x16_bf16(__builtin_bit_cast(bf16x8, PP[1]), fq1, o[0], 0, 0, 0); fq0 = cat8(vtr(vt_ + 4096), vtr(vt_ + 4608)); F3_DMAK1((i) + 3, 1); C0[2] = fast_exp2(C0[2]); C0[3] = fast_exp2(C0[3]); asm volatile("" : "+v"(C0)); F3_SB(); \
        o[0] = __builtin_amdgcn_mfma_f32_32x32x16_bf16(__builtin_bit_cast(bf16x8, PP[2]), fq2, o[0], 0, 0, 0); fq1 = cat8(vtr(vt_ + 5120), vtr(vt_ + 5632)); F3_DMAV1((i) + 2, 0); C0[4] = fast_exp2(C0[4]); C0[5] = fast_exp2(C0[5]); asm volatile("" : "+v"(C0)); F3_SB(); \
        o[0] = __builtin_amdgcn_mfma_f32_32x32x16_bf16(__builtin_bit_cast(bf16x8, PP[3]), fq3, o[0], 0, 0, 0); fq2 = cat8(vtr(vt_ + 6144), vtr(vt_ + 6656)); F3_DMAV1((i) + 2, 1); C0[6] = fast_exp2(C0[6]); C0[7] = fast_exp2(C0[7]); asm volatile("" : "+v"(C0)); F3_SB(); \
        o[1] = __builtin_amdgcn_mfma_f32_32x32x16_bf16(__builtin_bit_cast(bf16x8, PP[0]), fq0, o[1], 0, 0, 0); fq3 = cat8(vtr(vt_ + 7168), vtr(vt_ + 7680)); C0[8] = fast_exp2(C0[8]); C0[9] = fast_exp2(C0[9]); asm volatile("" : "+v"(C0)); F3_SB(); \
        o[1] = __builtin_amdgcn_mfma_f32_32x32x16_bf16(__builtin_bit_cast(bf16x8, PP[1]), fq1, o[1], 0, 0, 0); fq0 = cat8(vtr(vt_ + 8192), vtr(vt_ + 8704)); C0[10] = fast_exp2(C0[10]); C0[11] = fast_exp2(C0[11]); asm volatile("" : "+v"(C0)); F3_SB(); \
        o[1] = __builtin_amdgcn_mfma_f32_32x32x16_bf16(__builtin_bit_cast(bf16x8, PP[2]), fq2, o[1], 0, 0, 0); fq1 = cat8(vtr(vt_ + 9216), vtr(vt_ + 9728)); C0[12] = fast_exp2(C0[12]); C0[13] = fast_exp2(C0[13]); asm volatile("" : "+v"(C0)); F3_SB(); \
        o[1] = __builtin_amdgcn_mfma_f32_32x32x16_bf16(__builtin_bit_cast(bf16x8, PP[3]), fq3, o[1], 0, 0, 0); fq2 = cat8(vtr(vt_ + 10240), vtr(vt_ + 10752)); C0[14] = fast_exp2(C0[14]); C0[15] = fast_exp2(C0[15]); asm volatile("" : "+v"(C0)); F3_SB(); \
        o[2] = __builtin_amdgcn_mfma_f32_32x32x16_bf16(__builtin_bit_cast(bf16x8, PP[0]), fq0, o[2], 0, 0, 0); fq3 = cat8(vtr(vt_ + 11264), vtr(vt_ + 11776)); C1[0] = fast_exp2(C1[0]); C1[1] = fast_exp2(C1[1]); sa_ += C0[0]; sb_ += C0[1]; asm volatile("" : "+v"(C1), "+v"(sa_), "+v"(sb_)); F3_SB(); \
        o[2] = __builtin_amdgcn_mfma_f32_32x32x16_bf16(__builtin_bit_cast(bf16x8, PP[1]), fq1, o[2], 0, 0, 0); fq0 = cat8(vtr(vt_ + 12288), vtr(vt_ + 12800)); C1[2] = fast_exp2(C1[2]); C1[3] = fast_exp2(C1[3]); sa_ += C0[2]; sb_ += C0[3]; asm volatile("" : "+v"(C1), "+v"(sa_), "+v"(sb_)); F3_SB(); \
        o[2] = __builtin_amdgcn_mfma_f32_32x32x16_bf16(__builtin_bit_cast(bf16x8, PP[2]), fq2, o[2], 0, 0, 0); fq1 = cat8(vtr(vt_ + 13312), vtr(vt_ + 13824)); C1[4] = fast_exp2(C1[4]); C1[5] = fast_exp2(C1[5]); sa_ += C0[4]; sb_ += C0[5]; asm volatile("" : "+v"(C1), "+v"(sa_), "+v"(sb_)); F3_SB(); \
        o[2] = __builtin_amdgcn_mfma_f32_32x32x16_bf16(__builtin_bit_cast(bf16x8, PP[3]), fq3, o[2], 0, 0, 0); fq2 = cat8(vtr(vt_ + 14336), vtr(vt_ + 14848)); C1[6] = fast_exp2(C1[6]); C1[7] = fast_exp2(C1[7]); sa_ += C0[6]; sb_ += C0[7]; asm volatile("" : "+v"(C1), "+v"(sa_), "+v"(sb_)); F3_SB(); \
        o[3] = __builtin_amdgcn_mfma_f32_32x32x16_bf16(__builtin_bit_cast(bf16x8, PP[0]), fq0, o[3], 0, 0, 0); fq3 = cat8(vtr(vt_ + 15360), vtr(vt_ + 15872)); C1[8] = fast_exp2(C1[8]); C1[9] = fast_exp2(C1[9]); sa_ += C0[8]; sb_ += C0[9]; asm volatile("" : "+v"(C1), "+v"(sa_), "+v"(sb_)); F3_SB(); \
        o[3] = __builtin_amdgcn_mfma_f32_32x32x16_bf16(__builtin_bit_cast(bf16x8, PP[1]), fq1, o[3], 0, 0, 0); fq0 = *(const LAS bf16x8*)(kq_ + 0); C1[10] = fast_exp2(C1[10]); C1[11] = fast_exp2(C1[11]); sa_ += C0[10]; sb_ += C0[11]; asm volatile("" : "+v"(C1), "+v"(sa_), "+v"(sb_)); F3_SB(); \
        o[3] = __builtin_amdgcn_mfma_f32_32x32x16_bf16(__builtin_bit_cast(bf16x8, PP[2]), fq2, o[3], 0, 0, 0); fq1 = *(const LAS bf16x8*)(kq_ + 512); C1[12] = fast_exp2(C1[12]); C1[13] = fast_exp2(C1[13]); sa_ += C0[12]; sb_ += C0[13]; asm volatile("" : "+v"(C1), "+v"(sa_), "+v"(sb_)); F3_SB(); \
        o[3] = __builtin_amdgcn_mfma_f32_32x32x16_bf16(__builtin_bit_cast(bf16x8, PP[3]), fq3, o[3], 0, 0, 0); fq2 = *(const LAS bf16x8*)(kq_ + 2048); C1[14] = fast_exp2(C1[14]); C1[15] = fast_exp2(C1[15]); sa_ += C0[14]; sb_ += C0[15]; asm volatile("" : "+v"(C1), "+v"(sa_), "+v"(sb_)); F3_SB(); \
        N0 = __builtin_amdgcn_mfma_f32_32x32x16_bf16(fq0, qr[0], (f32x16){0.f,0.f,0.f,0.f,0.f,0.f,0.f,0.f,0.f,0.f,0.f,0.f,0.f,0.f,0.f,0.f}, 0, 0, 0); fq3 = *(const LAS bf16x8*)(kq_ + 2560); sa_ += C1[0]; sb_ += C1[1]; PW[0][0] = cvt_pk_bf16(C0[0], C0[1]); PW[0][1] = cvt_pk_bf16(C0[2], C0[3]); asm volatile("" : "+v"(sa_), "+v"(sb_), "+v"(PW[0])); F3_SB(); \
        N1 = __builtin_amdgcn_mfma_f32_32x32x16_bf16(fq1, qr[0], (f32x16){0.f,0.f,0.f,0.f,0.f,0.f,0.f,0.f,0.f,0.f,0.f,0.f,0.f,0.f,0.f,0.f}, 0, 0, 0); fq0 = *(const LAS bf16x8*)(kq_ + 4096); sa_ += C1[2]; sb_ += C1[3]; PW[0][2] = cvt_pk_bf16(C0[4], C0[5]); PW[0][3] = cvt_pk_bf16(C0[6], C0[7]); asm volatile("" : "+v"(sa_), "+v"(sb_), "+v"(PW[0])); F3_SB(); \
        N0 = __builtin_amdgcn_mfma_f32_32x32x16_bf16(fq2, qr[1], N0, 0, 0, 0); fq1 = *(const LAS bf16x8*)(kq_ + 4608); sa_ += C1[4]; sb_ += C1[5]; PW[1][0] = cvt_pk_bf16(C0[8], C0[9]); PW[1][1] = cvt_pk_bf16(C0[10], C0[11]); asm volatile("" : "+v"(sa_), "+v"(sb_), "+v"(PW[1])); F3_SB(); \
        N1 = __builtin_amdgcn_mfma_f32_32x32x16_bf16(fq3, qr[1], N1, 0, 0, 0); fq2 = *(const LAS bf16x8*)(kq_ + 6144); sa_ += C1[6]; sb_ += C1[7]; PW[1][2] = cvt_pk_bf16(C0[12], C0[13]); PW[1][3] = cvt_pk_bf16(C0[14], C0[15]); asm volatile("" : "+v"(sa_), "+v"(sb_), "+v"(PW[1])); F3_SB(); \
        N0 = __builtin_amdgcn_mfma_f32_32x32x16_bf16(fq0, qr[2], N0, 0, 0, 0); fq3 = *(const LAS bf16x8*)(kq_ + 6656); sa_ += C1[8]; sb_ += C1[9]; PW[2][0] = cvt_pk_bf16(C1[0], C1[1]); PW[2][1] = cvt_pk_bf16(C1[2], C1[3]); asm volatile("" : "+v"(sa_), "+v"(sb_), "+v"(PW[2])); F3_SB(); \
        N1 = __builtin_amdgcn_mfma_f32_32x32x16_bf16(fq1, qr[2], N1, 0, 0, 0); sa_ += C1[10]; sb_ += C1[11]; PW[2][2] = cvt_pk_bf16(C1[4], C1[5]); PW[2][3] = cvt_pk_bf16(C1[6], C1[7]); asm volatile("" : "+v"(sa_), "+v"(sb_), "+v"(PW[2])); F3_SB(); \
        N0 = __builtin_amdgcn_mfma_f32_32x32x16_bf16(fq2, qr[3], N0, 0, 0, 0); sa_ += C1[12]; sb_ += C1[13]; PW[3][0] = cvt_pk_bf16(C1[8], C1[9]); PW[3][1] = cvt_pk_bf16(C1[10], C1[11]); asm volatile("" : "+v"(sa_), "+v"(sb_), "+v"(PW[3])); F3_SB(); \
        N1 = __builtin_amdgcn_mfma_f32_32x32x16_bf16(fq3, qr[3], N1, 0, 0, 0); sa_ += C1[14]; sb_ += C1[15]; PW[3][2] = cvt_pk_bf16(C1[12], C1[13]); PW[3][3] = cvt_pk_bf16(C1[14], C1[15]); asm volatile("" : "+v"(sa_), "+v"(sb_), "+v"(PW[3])); F3_SB(); \
        lsum += sa_ + sb_; F3_TSE(N0, N1); } while (0)
#define F3_HANDB(i, C0, C1, N0, N1, PP, PW) do { \
        const lds_cptr vt_ = vp0 + (((i) - 1) & 3) * 16384; const lds_cptr kq_ = kp0 + (((i) + 1) % NK3) * 16384; \
        const LAS float* bb_ = btab + (64 * (cw - (t0 + (i))) + 32 * (wq & 1) + r32 + 63 - 4 * hi - 59);     \
        bf16x8 fq0, fq1, fq2, fq3; float sa_ = 0.f, sb_ = 0.f, b0_, b1_, b2_, b3_; \
        fq0 = cat8(vtr(vt_ + 0), vtr(vt_ + 512)); fq1 = cat8(vtr(vt_ + 1024), vtr(vt_ + 1536)); fq2 = cat8(vtr(vt_ + 2048), vtr(vt_ + 2560)); b0_ = bb_[59]; b1_ = bb_[58]; b2_ = bb_[57]; b3_ = bb_[56]; F3_SB(); \
        if ((i) + 3 < NT) { asm volatile("s_waitcnt vmcnt(6) lgkmcnt(0)\n\ts_barrier" ::: "memory"); } else FA_WAIT_BAR(0); \
        F3_SB(); \
        o[0] = __builtin_amdgcn_mfma_f32_32x32x16_bf16(__builtin_bit_cast(bf16x8, PP[0]), fq0, o[0], 0, 0, 0); fq3 = cat8(vtr(vt_ + 3072), vtr(vt_ + 3584)); F3_DMAK1((i) + 3, 0); C0[0] = fast_exp2(C0[0] + b0_); C0[1] = fast_exp2(C0[1] + b1_); b0_ = bb_[51]; b1_ = bb_[50]; asm volatile("" : "+v"(C0)); F3_SB(); \
        o[0] = __builtin_amdgcn_mfma_f32_32x32x16_bf16(__builtin_bit_cast(bf16x8, PP[1]), fq1, o[0], 0, 0, 0); fq0 = cat8(vtr(vt_ + 4096), vtr(vt_ + 4608)); F3_DMAK1((i) + 3, 1); C0[2] = fast_exp2(C0[2] + b2_); C0[3] = fast_exp2(C0[3] + b3_); b2_ = bb_[49]; b3_ = bb_[48]; asm volatile("" : "+v"(C0)); F3_SB(); \
        o[0] = __builtin_amdgcn_mfma_f32_32x32x16_bf16(__builtin_bit_cast(bf16x8, PP[2]), fq2, o[0], 0, 0, 0); fq1 = cat8(vtr(vt_ + 5120), vtr(vt_ + 5632)); F3_DMAV1((i) + 2, 0); C0[4] = fast_exp2(C0[4] + b0_); C0[5] = fast_exp2(C0[5] + b1_); b0_ = bb_[43]; b1_ = bb_[42]; asm volatile("" : "+v"(C0)); F3_SB(); \
        o[0] = __builtin_amdgcn_mfma_f32_32x32x16_bf16(__builtin_bit_cast(bf16x8, PP[3]), fq3, o[0], 0, 0, 0); fq2 = cat8(vtr(vt_ + 6144), vtr(vt_ + 6656)); F3_DMAV1((i) + 2, 1); C0[6] = fast_exp2(C0[6] + b2_); C0[7] = fast_exp2(C0[7] + b3_); b2_ = bb_[41]; b3_ = bb_[40]; asm volatile("" : "+v"(C0)); F3_SB(); \
        o[1] = __builtin_amdgcn_mfma_f32_32x32x16_bf16(__builtin_bit_cast(bf16x8, PP[0]), fq0, o[1], 0, 0, 0); fq3 = cat8(vtr(vt_ + 7168), vtr(vt_ + 7680)); C0[8] = fast_exp2(C0[8] + b0_); C0[9] = fast_exp2(C0[9] + b1_); b0_ = bb_[35]; b1_ = bb_[34]; sa_ += C0[0]; sb_ += C0[1]; asm volatile("" : "+v"(C0), "+v"(sa_), "+v"(sb_)); F3_SB(); \
        o[1] = __builtin_amdgcn_mfma_f32_32x32x16_bf16(__builtin_bit_cast(bf16x8, PP[1]), fq1, o[1], 0, 0, 0); fq0 = *(const LAS bf16x8*)(kq_ + 0); C0[10] = fast_exp2(C0[10] + b2_); C0[11] = fast_exp2(C0[11] + b3_); b2_ = bb_[33]; b3_ = bb_[32]; sa_ += C0[2]; sb_ += C0[3]; sa_ += C0[4]; asm volatile("" : "+v"(C0), "+v"(sa_), "+v"(sb_)); F3_SB(); \
        o[1] = __builtin_amdgcn_mfma_f32_32x32x16_bf16(__builtin_bit_cast(bf16x8, PP[2]), fq2, o[1], 0, 0, 0); fq1 = *(const LAS bf16x8*)(kq_ + 512); C0[12] = fast_exp2(C0[12] + b0_); C0[13] = fast_exp2(C0[13] + b1_); b0_ = bb_[27]; b1_ = bb_[26]; sb_ += C0[5]; sa_ += C0[6]; sb_ += C0[7]; asm volatile("" : "+v"(C0), "+v"(sa_), "+v"(sb_)); F3_SB(); \
        o[1] = __builtin_amdgcn_mfma_f32_32x32x16_bf16(__builtin_bit_cast(bf16x8, PP[3]), fq3, o[1], 0, 0, 0); fq2 = *(const LAS bf16x8*)(kq_ + 2048); C0[14] = fast_exp2(C0[14] + b2_); C0[15] = fast_exp2(C0[15] + b3_); b2_ = bb_[25]; b3_ = bb_[24]; sa_ += C0[8]; sb_ += C0[9]; asm volatile("" : "+v"(C0), "+v"(sa_), "+v"(sb_)); F3_SB(); \
        N0 = __builtin_amdgcn_mfma_f32_32x32x16_bf16(fq0, qr[0], (f32x16){0.f,0.f,0.f,0.f,0.f,0.f,0.f,0.f,0.f,0.f,0.f,0.f,0.f,0.f,0.f,0.f}, 0, 0, 0); fq3 = *(const LAS bf16x8*)(kq_ + 2560); C1[0] = fast_exp2(C1[0] + b0_); C1[1] = fast_exp2(C1[1] + b1_); b0_ = bb_[19]; b1_ = bb_[18]; sa_ += C0[10]; sb_ += C0[11]; sa_ += C0[12]; PW[0][0] = cvt_pk_bf16(C0[0], C0[1]); PW[0][1] = cvt_pk_bf16(C0[2], C0[3]); asm volatile("" : "+v"(C1), "+v"(sa_), "+v"(sb_), "+v"(PW[0])); F3_SB(); \
        N1 = __builtin_amdgcn_mfma_f32_32x32x16_bf16(fq1, qr[0], (f32x16){0.f,0.f,0.f,0.f,0.f,0.f,0.f,0.f,0.f,0.f,0.f,0.f,0.f,0.f,0.f,0.f}, 0, 0, 0); fq0 = *(const LAS bf16x8*)(kq_ + 4096); C1[2] = fast_exp2(C1[2] + b2_); C1[3] = fast_exp2(C1[3] + b3_); b2_ = bb_[17]; b3_ = bb_[16]; sb_ += C0[13]; sa_ += C0[14]; sb_ += C0[15]; PW[0][2] = cvt_pk_bf16(C0[4], C0[5]); PW[0][3] = cvt_pk_bf16(C0[6], C0[7]); asm volatile("" : "+v"(C1), "+v"(sa_), "+v"(sb_), "+v"(PW[0])); F3_SB(); \
        N0 = __builtin_amdgcn_mfma_f32_32x32x16_bf16(fq2, qr[1], N0, 0, 0, 0); fq1 = *(const LAS bf16x8*)(kq_ + 4608); C1[4] = fast_exp2(C1[4] + b0_); C1[5] = fast_exp2(C1[5] + b1_); b0_ = bb_[11]; b1_ = bb_[10]; sa_ += C1[0]; sb_ += C1[1]; PW[1][0] = cvt_pk_bf16(C0[8], C0[9]); PW[1][1] = cvt_pk_bf16(C0[10], C0[11]); asm volatile("" : "+v"(C1), "+v"(sa_), "+v"(sb_), "+v"(PW[1])); F3_SB(); \
        N1 = __builtin_amdgcn_mfma_f32_32x32x16_bf16(fq3, qr[1], N1, 0, 0, 0); fq2 = *(const LAS bf16x8*)(kq_ + 6144); C1[6] = fast_exp2(C1[6] + b2_); C1[7] = fast_exp2(C1[7] + b3_); b2_ = bb_[9]; b3_ = bb_[8]; sa_ += C1[2]; sb_ += C1[3]; sa_ += C1[4]; PW[1][2] = cvt_pk_bf16(C0[12], C0[13]); PW[1][3] = cvt_pk_bf16(C0[14], C0[15]); asm volatile("" : "+v"(C1), "+v"(sa_), "+v"(sb_), "+v"(PW[1])); F3_SB(); \
        N0 = __builtin_amdgcn_mfma_f32_32x32x16_bf16(fq0, qr[2], N0, 0, 0, 0); fq3 = *(const LAS bf16x8*)(kq_ + 6656); C1[8] = fast_exp2(C1[8] + b0_); C1[9] = fast_exp2(C1[9] + b1_); b0_ = bb_[3]; b1_ = bb_[2]; sb_ += C1[5]; sa_ += C1[6]; sb_ += C1[7]; PW[2][0] = cvt_pk_bf16(C1[0], C1[1]); PW[2][1] = cvt_pk_bf16(C1[2], C1[3]); asm volatile("" : "+v"(C1), "+v"(sa_), "+v"(sb_), "+v"(PW[2])); F3_SB(); \
        N1 = __builtin_amdgcn_mfma_f32_32x32x16_bf16(fq1, qr[2], N1, 0, 0, 0); C1[10] = fast_exp2(C1[10] + b2_); C1[11] = fast_exp2(C1[11] + b3_); b2_ = bb_[1]; b3_ = bb_[0]; sa_ += C1[8]; sb_ += C1[9]; PW[2][2] = cvt_pk_bf16(C1[4], C1[5]); PW[2][3] = cvt_pk_bf16(C1[6], C1[7]); asm volatile("" : "+v"(C1), "+v"(sa_), "+v"(sb_), "+v"(PW[2])); F3_SB(); \
        N0 = __builtin_amdgcn_mfma_f32_32x32x16_bf16(fq2, qr[3], N0, 0, 0, 0); C1[12] = fast_exp2(C1[12] + b0_); C1[13] = fast_exp2(C1[13] + b1_); sa_ += C1[10]; sb_ += C1[11]; sa_ += C1[12]; PW[3][0] = cvt_pk_bf16(C1[8], C1[9]); PW[3][1] = cvt_pk_bf16(C1[10], C1[11]); asm volatile("" : "+v"(C1), "+v"(sa_), "+v"(sb_), "+v"(PW[3])); F3_SB(); \
        N1 = __builtin_amdgcn_mfma_f32_32x32x16_bf16(fq3, qr[3], N1, 0, 0, 0); C1[14] = fast_exp2(C1[14] + b2_); C1[15] = fast_exp2(C1[15] + b3_); sb_ += C1[13]; sa_ += C1[14]; sb_ += C1[15]; PW[3][2] = cvt_pk_bf16(C1[12], C1[13]); PW[3][3] = cvt_pk_bf16(C1[14], C1[15]); asm volatile("" : "+v"(C1), "+v"(sa_), "+v"(sb_), "+v"(PW[3])); F3_SB(); \
        lsum += sa_ + sb_; } while (0)
#if SLOW_FREE
#define F3_SLOW_SB() do { } while (0)
#else
#define F3_SLOW_SB() F3_SB()
#endif
#define F3_SLOW(i, C0, C1, N0, N1, PP, PW) do { F3_HEAD(i); \
        const bool vc = ((i) >= iv0) && ((i) <= iv1), vp = ((i) - 1 >= iv0) && ((i) - 1 <= iv1), vn = ((i) + 1 >= iv0) && ((i) + 1 <= iv1) && ((i) + 1 < NT); \
        if (!SLOW_STAG || ch == 0) { \
        if (vp) F3_PV((i) - 1, PP); \
        F3_SLOW_SB(); \
        if (vn) { F3_QK((i) + 1, N0, N1); } \
        F3_SLOW_SB(); \
        if (vc) { F3_BIAS((i), C0, C1); F3_SM(C0, C1, PW); } else { upd = false; }     \
        } else {     \
        if (vc) { F3_BIAS((i), C0, C1); F3_SM(C0, C1, PW); } else { upd = false; } \
        F3_SLOW_SB(); \
        if (vp) F3_PV((i) - 1, PP); \
        F3_SLOW_SB(); \
        if (vn) { F3_QK((i) + 1, N0, N1); } \
        } \
        F3_SB(); F3_RESC(); } while (0)
    bool upd = false; float fsc = 1.f;
    asm volatile("s_waitcnt vmcnt(8) lgkmcnt(0)\n\ts_barrier" ::: "memory");
    if (iv0 == 0) { F3_QK(0, cA0, cA1); }
    F3_SB();
    if (MODE == 0) {
        F3_SLOW(0, cA0, cA1, cB0, cB1, pB, pA);
        if (NOMAX && FA_HAND) {
#pragma unroll 1
            for (int i = 1; i + 3 < NT; i += 2) { F3_HAND(i, cB0, cB1, cA0, cA1, pA, pB); F3_HAND(i + 1, cA0, cA1, cB0, cB1, pB, pA); }
            if (NT >= 4) { F3_HAND(NT - 3, cB0, cB1, cA0, cA1, pA, pB); }
        } else {
#pragma unroll 1
            for (int i = 1; i + 3 < NT; i += 2) { F3_SLOW(i, cB0, cB1, cA0, cA1, pA, pB); F3_SLOW(i + 1, cA0, cA1, cB0, cB1, pB, pA); }
            if (NT >= 4) { F3_SLOW(NT - 3, cB0, cB1, cA0, cA1, pA, pB); }
        }
        if (NT >= 4) { F3_SLOW(NT - 2, cA0, cA1, cB0, cB1, pB, pA); }
        F3_SLOW(NT - 1, cB0, cB1, cA0, cA1, pA, pB);
    } else {
        F3_SLOW(0, cA0, cA1, cB0, cB1, pB, pA); F3_SLOW(1, cB0, cB1, cA0, cA1, pA, pB);
        if (NOMAX && FA_HANDB) {
#pragma unroll 1
            for (int i = 2; i + 3 < NT; i += 2) { F3_HANDB(i, cA0, cA1, cB0, cB1, pB, pA); F3_HANDB(i + 1, cB0, cB1, cA0, cA1, pA, pB); }
        } else {
#pragma unroll 1
            for (int i = 2; i + 3 < NT; i += 2) { F3_SLOW(i, cA0, cA1, cB0, cB1, pB, pA); F3_SLOW(i + 1, cB0, cB1, cA0, cA1, pA, pB); }
        }
        if (NT >= 4) { F3_SLOW(NT - 2, cA0, cA1, cB0, cB1, pB, pA); F3_SLOW(NT - 1, cB0, cB1, cA0, cA1, pA, pB); }
    }
#if PROBE_T
    if (MODE == 0 && blockIdx.x == 0 && (wid & 3) == 0 && u >= 32 && lane == 0 && tqn) { unsigned long long* pv = (unsigned long long*)((char*)Yg - WS_AQ + WS_PROBE) + (ch ? 8 : 0); pv[0] = tq0 / tqn; pv[1] = tq1 / tqn; pv[2] = tqn; }
#endif
    if (NT - 1 <= iv1) F3_PV(NT - 1, pB);
#undef F3_TS
#undef F3_TSE
#undef F3_HEAD
#undef F3_SLOW
#undef F3_HAND
#undef F3_HANDB
#undef F3_DMAK
#undef F3_DMAV
#undef F3_DMAK1
#undef F3_DMAV1
#undef F3_SB
#undef F3_MX3
#undef F3_QK
#undef F3_BIAS
#undef F3_PV
#undef F3_SM
#undef F3_RESC
#if FA_PRIO
    __builtin_amdgcn_s_setprio(0);
#endif
    lsum = swapsum(lsum);
    if (hi == 0) wsf[32 + r32] = lsum;
    LDS_WAIT();
#pragma unroll
    for (int r = 0; r < 16; ++r) { const float il = fast_rcp(wsf[32 + crow(r, hi)]);
#pragma unroll
        for (int d = 0; d < NDB; ++d) o[d][r] *= il; }
    FA_BAR();
    if (MODE == 0) {
        LAS float* xf = (LAS float*)lds + (wid & 3) * 4096;
        if (ch == 1) {
#pragma unroll
            for (int d = 0; d < 4; ++d)
#pragma unroll
                for (int r = 0; r < 16; ++r) xf[(d * 16 + r) * 64 + lane] = o[d][r];
        }
        FA_BAR();
        if (ch == 0) {
            float ss[16];
#pragma unroll
            for (int r = 0; r < 16; ++r) ss[r] = 0.f;
#pragma unroll
            for (int d = 0; d < 4; ++d)
#pragma unroll
                for (int r = 0; r < 16; ++r) { const float y = o[d][r] - lam * xf[(d * 16 + r) * 64 + lane]; o[d][r] = y; ss[r] += y * y; }
            LAS bf16_t* stg = (LAS bf16_t*)(lds + 65536) + wid * 4096;
            float g[4];
#pragma unroll
            for (int d = 0; d < 4; ++d) g[d] = subln[32 * d + r32] * osc;
#pragma unroll
            for (int r = 0; r < 16; ++r) { const float rs = __builtin_amdgcn_rsqf(half_sum32(ss[r]) * (1.0f / 128.0f) + EPS); const int orow = crow(r, hi);
#pragma unroll
                for (int d = 0; d < 4; ++d) stg[orow * 128 + d * 32 + r32] = (bf16_t)f2bf(o[d][r] * rs * g[d]); }
            LDS_WAIT();
#pragma unroll
            for (int i = 0; i < 8; ++i) { const int idx = i * 64 + lane, row = idx >> 4, c8 = idx & 15;
                const u32x4 v = *(const LAS u32x4*)(stg + row * 128 + c8 * 8);
                *(u32x4*)(Yg + (qrow + row) * PITCH + hq * 128 + c8 * 8) = v; }
        }
    } else {
        LAS bf16_t* stg = (LAS bf16_t*)lds + wid * 2048;
#pragma unroll
        for (int r = 0; r < 16; ++r) { const int orow = crow(r, hi);
#pragma unroll
            for (int d = 0; d < 2; ++d) stg[orow * 64 + d * 32 + r32] = (bf16_t)f2bf(o[d][r]); }
        LDS_WAIT();
#pragma unroll
        for (int i = 0; i < 4; ++i) { const int idx = i * 64 + lane, row = idx >> 3, c8 = idx & 7;
            const u32x4 v = *(const LAS u32x4*)(stg + row * 64 + c8 * 8);
            *(u32x4*)(Yg + (qrow + row) * PITCH + hq * 128 + ch * 64 + c8 * 8) = v; }
    }
    FA_BAR();
#if PROBE_T
    if (MODE == 0 && blockIdx.x == 0 && wid == 0 && u >= 32 && lane == 0) { unsigned long long* pv = (unsigned long long*)((char*)Yg - WS_AQ + WS_PROBE); pv[3] = (__builtin_amdgcn_s_memtime() - tu0_) / 10; }
#endif
}

#if FA_V2 == 3
#define FA_UNIT attn_unit2
#elif FA_V2
#define FA_UNIT attn_unit2
#else
#define FA_UNIT attn_unit
#endif
__device__ __forceinline__ void attn_a_phase(LAS unsigned char* lds, const int tid, unsigned char* ws, bf16_t* yout, const int vcu, const int G, const float* lq1, const float* lk1, const float* lq2, const float* lk2,
                                             const float* subln, const float lam_init, const float* gq, const float* gk, const int pm = 0, const LAS float* mixc = nullptr) {
    const int lane = tid & 63;
    const float lamv = mixc ? mixc[0] : expf(wave_sum(lq1[lane] * lk1[lane])) - expf(wave_sum(lq2[lane] * lk2[lane])) + lam_init;
    const float lam = __uint_as_float(__builtin_amdgcn_readfirstlane(__float_as_uint(lamv)));
    const float bound = mixc ? mixc[1] : wave_max(fabsf(gq[lane])) * wave_max(fabsf(gk[lane])) * 64.0f * C2;
    const bool nomax = __uint_as_float(__builtin_amdgcn_readfirstlane(__float_as_uint(bound))) < FA_NOMAX_BOUND_A;
    for (int v = vcu; v < 256; v += G) {
        const int bh = v >> 5, p = v & 31;
#pragma unroll 1
        for (int k = 0; k < 2; ++k) {
#if FA_V2 == 3
            if (nomax) attn_unit3<0, true>(lds, tid, (const bf16_t*)(ws + WS_AQ), (const bf16_t*)(ws + WS_AK), (const bf16_t*)(ws + WS_AV), yout, bh >> 2, bh & 3, (k ^ A_LONG_FIRST) ? 63 - p : p, lam, 1.0f - lam_init, subln, pm);
            else       attn_unit3<0, false>(lds, tid, (const bf16_t*)(ws + WS_AQ), (const bf16_t*)(ws + WS_AK), (const bf16_t*)(ws + WS_AV), yout, bh >> 2, bh & 3, (k ^ A_LONG_FIRST) ? 63 - p : p, lam, 1.0f - lam_init, subln, pm);
#else
            FA_UNIT<0>(lds, tid, (const bf16_t*)(ws + WS_AQ), (const bf16_t*)(ws + WS_AK), (const bf16_t*)(ws + WS_AV), yout, bh >> 2, bh & 3, (k ^ A_LONG_FIRST) ? 63 - p : p, lam, 1.0f - lam_init, subln, pm);
#endif
        }
    }
}
constexpr int LDS_MIXC = LDS_BIAS2 + 5120;
__device__ __forceinline__ void mix_setup(LAS unsigned char* lds, const int tid, const int vcu, const float* relb, const float* gqa, const float* gka, const float* gqb, const float* gkb,
                                          const float* lq1, const float* lk1, const float* lq2, const float* lk2, const float lam_init) {
    const int hp = (vcu >> 5) & 3, lane = tid & 63;
    LAS float* bt = (LAS float*)(lds + LDS_BIAS2);
    for (int i = tid; i < 1280; i += 512) { const int c = i / 640, j = i - c * 640; bt[i] = relb[(2 * hp + c) * 320 + (j < 320 ? j : 319)] * LOG2E; }
    if (tid < 64) {
        const float lamv = expf(wave_sum(lq1[lane] * lk1[lane])) - expf(wave_sum(lq2[lane] * lk2[lane])) + lam_init;
        const float ba = wave_max(fabsf(gqa[lane])) * wave_max(fabsf(gka[lane])) * 64.0f * C2, bb = wave_max(fabsf(gqb[lane])) * wave_max(fabsf(gkb[lane])) * 64.0f * C2;
        LAS float* mc = (LAS float*)(lds + LDS_MIXC);
        if (lane == 0) { mc[0] = lamv; mc[1] = ba; mc[2] = bb; }
    }
}
__device__ __forceinline__ void attn_b_phase(LAS unsigned char* lds, const int tid, unsigned char* ws, bf16_t* yout, const int vcu, const int G, const float* relb, const float* gq, const float* gk, const LAS float* mixc = nullptr) {
    for (int v = vcu; v < 256; v += G) {
        const int bp = v >> 5, b = bp >> 2, hp = bp & 3;
        LAS float* bt = (LAS float*)(lds + (FA_V2 ? LDS_BIAS2 : LDS_BIAS));
        if (!mixc) { for (int i = tid; i < 1280; i += 512) { const int c = i / 640, j = i - c * 640; bt[i] = relb[(2 * hp + c) * 320 + (j < 320 ? j : 319)] * LOG2E; } }
        FA_BAR();
        float bm = 0.f;
        for (int i = tid & 63; i < 1280; i += 64) bm = fmaxf(bm, fabsf(bt[i]));
        const float bound = (mixc ? mixc[2] : wave_max(fabsf(gq[tid & 63])) * wave_max(fabsf(gk[tid & 63])) * 64.0f * C2) + wave_max(bm);
        const bool nomax = __uint_as_float(__builtin_amdgcn_readfirstlane(__float_as_uint(bound))) < FA_NOMAX_BOUND_B;
#pragma unroll 1
        for (int k = 0; k < 2; ++k) {
#if FA_V2 == 3
            if (nomax) attn_unit3<1, true>(lds, tid, (const bf16_t*)(ws + WS_BQ), (const bf16_t*)(ws + WS_BK), (const bf16_t*)(ws + WS_BV), yout, b, hp, 2 * (v & 31) + (k ^ B_REV), 0.f, 0.f, nullptr);
            else       attn_unit3<1, false>(lds, tid, (const bf16_t*)(ws + WS_BQ), (const bf16_t*)(ws + WS_BK), (const bf16_t*)(ws + WS_BV), yout, b, hp, 2 * (v & 31) + (k ^ B_REV), 0.f, 0.f, nullptr);
#else
            FA_UNIT<1>(lds, tid, (const bf16_t*)(ws + WS_BQ), (const bf16_t*)(ws + WS_BK), (const bf16_t*)(ws + WS_BV), yout, b, hp, 2 * (v & 31) + (k ^ B_REV), 0.f, 0.f, nullptr);
#endif
        }
    }
}

__device__ __forceinline__ void ret_kv_phase(LAS unsigned char* lds, const int tid_, unsigned char* ws, const int gw, const int ngw) {
    int tid = tid_; asm volatile("" : "+v"(tid));
    const int lane = tid & 63, r32 = lane & 31, hi = lane >> 5, wid = __builtin_amdgcn_readfirstlane(tid >> 6);
    const bf16_t* CK = (const bf16_t*)(ws + WS_CK); const bf16_t* CV = (const bf16_t*)(ws + WS_CV); kvt_t* KVT = (kvt_t*)(ws + WS_R4);
    LAS unsigned char* wl = lds + wid * 16384; const unsigned wl0 = (unsigned)(uintptr_t)wl;
    const lds_cptr tp0 = (lds_cptr)wl + ((lane >> 4) & 1) * 32 + (lane & 3) * 8 + (4 * hi + ((lane & 15) >> 2)) * 64;
    for (int task = gw; task < 2048; task += ngw) {
        const int eh = task & 1, n = (task >> 1) & 127, bh = task >> 8, b = bh >> 2, h = bh & 3;
        const size_t row0 = (size_t)b * SEQ + n * 64;
#pragma unroll
        for (int p = 0; p < 8; ++p) {
            glds16(CK + (row0 + 16 * (p & 3) + (lane >> 2)) * 256 + h * 64 + 32 * (p >> 2) + (lane & 3) * 8, (unsigned)__builtin_amdgcn_readfirstlane(wl0 + p * 1024));
            glds16(CV + (row0 + 16 * (p & 3) + (lane >> 2)) * 512 + h * 128 + eh * 64 + 32 * (p >> 2) + (lane & 3) * 8, (unsigned)__builtin_amdgcn_readfirstlane(wl0 + 8192 + p * 1024));
        }
        asm volatile("s_waitcnt vmcnt(0)" ::: "memory");
#pragma unroll
        for (int eb = 0; eb < 2; ++eb)
#pragma unroll
            for (int db = 0; db < 2; ++db) {
                f32x16 acc;
#pragma unroll
                for (int r = 0; r < 16; ++r) acc[r] = 0.f;
#pragma unroll
                for (int s = 0; s < 4; ++s) {
                    const lds_cptr va = tp0 + 8192 + (eb * 4 + s) * 1024, ka = tp0 + (db * 4 + s) * 1024;
                    acc = __builtin_amdgcn_mfma_f32_32x32x16_bf16(cat8(vtr(va), vtr(va + 512)), cat8(vtr(ka), vtr(ka + 512)), acc, 0, 0, 0);
                }
                kvt_t* dst = KVT + ((size_t)(bh * 128 + n) * 128 + eh * 64 + eb * 32) * 64 + db * 32 + r32;
#if RET_BF16
#pragma unroll
                for (int r = 0; r < 16; r += 2) { const unsigned w = cvt_pk_bf16_n(acc[r], acc[r + 1]); dst[(size_t)crow(r, hi) * 64] = (bf16_t)(w & 0xffffu); dst[(size_t)crow(r + 1, hi) * 64] = (bf16_t)(w >> 16); }
#else
#pragma unroll
                for (int r = 0; r < 16; ++r) dst[(size_t)crow(r, hi) * 64] = acc[r];
#endif
            }
        LDS_WAIT(); asm volatile("" ::: "memory");
    }
}
__device__ __forceinline__ void ret_scan_phase(const int tid, unsigned char* ws, const int vcu, const int G) {
    kvt_t* KVT = (kvt_t*)(ws + WS_R4);
    for (int gt = vcu * 512 + tid; gt < 65536; gt += G * 512) {
        const int bh = gt >> 13, idx = gt & 8191, h = bh & 3;
        const float l2g = log2_gamma(h), gam = fast_exp2(l2g), g63 = fast_exp2(63.f * l2g), g64 = fast_exp2(64.f * l2g);
        kvt_t* p = KVT + (size_t)bh * 128 * 8192 + idx; float s = 0.f;
#if RET_BF16
        {
            unsigned kvA[32], kvB[32];
#define SC_LOAD(KV, n0) do { _Pragma("unroll") for (int j = 0; j < 32; ++j) KV[j] = p[(size_t)((n0) + j) * 8192]; asm volatile("" ::: "memory"); } while (0)
#define SC_STEP(KV, n0) do { _Pragma("unroll") for (int j = 0; j < 32; ++j) { const float gs = gam * s; p[(size_t)((n0) + j) * 8192] = (bf16_t)(cvt_pk_bf16_n(gs, gs) & 0xffffu); s = g64 * s + g63 * __builtin_bit_cast(float, KV[j] << 16); } asm volatile("" ::: "memory"); } while (0)
            SC_LOAD(kvA, 0); SC_LOAD(kvB, 32);
            SC_STEP(kvA, 0); SC_LOAD(kvA, 64);
            SC_STEP(kvB, 32); SC_LOAD(kvB, 96);
            SC_STEP(kvA, 64); SC_STEP(kvB, 96);
#undef SC_LOAD
#undef SC_STEP
        }
#else
        for (int n0 = 0; n0 < 128; n0 += 32) {
            float kv[32];
#pragma unroll
            for (int j = 0; j < 32; ++j) kv[j] = p[(size_t)(n0 + j) * 8192];
#pragma unroll
            for (int j = 0; j < 32; ++j) { p[(size_t)(n0 + j) * 8192] = gam * s; s = g64 * s + g63 * kv[j]; }
        }
#endif
    }
}
__device__ __forceinline__ void ret_out_phase(LAS unsigned char* lds, const int tid_, unsigned char* ws, const int gw, const int ngw, const float* onorm, unsigned* claim = nullptr) {
    int tid = tid_; asm volatile("" : "+v"(tid));
    const int lane = tid & 63, r32 = lane & 31, hi = lane >> 5, wid = __builtin_amdgcn_readfirstlane(tid >> 6);
    const bf16_t* CQ = (const bf16_t*)(ws + WS_CQ); const bf16_t* CK = (const bf16_t*)(ws + WS_CK); const bf16_t* CV = (const bf16_t*)(ws + WS_CV); bf16_t* CG = (bf16_t*)(ws + WS_CG);
    const kvt_t* KVT = (const kvt_t*)(ws + WS_R4);
    LAS unsigned char* wl = lds + wid * 16384; const unsigned wl0 = (unsigned)(uintptr_t)wl;
    const lds_cptr tp0 = (lds_cptr)wl + ((lane >> 4) & 1) * 32 + (lane & 3) * 8 + (4 * hi + ((lane & 15) >> 2)) * 64;
    for (int task = claim ? 0 : gw, first_ = 1; ; task += ngw, first_ = 0) {
        if (claim) { unsigned t_ = 0u; if (lane == 0) t_ = __hip_atomic_fetch_add(claim, 1u, __ATOMIC_RELAXED, __HIP_MEMORY_SCOPE_AGENT); task = (int)__builtin_amdgcn_readfirstlane(t_); }
        (void)first_;
        if (task >= 2048) break;
        const int rh = task & 1, n = (task >> 1) & 127, bh = task >> 8, b = bh >> 2, h = bh & 3;
        const size_t row0 = (size_t)b * SEQ + n * 64;
        const float l2g = log2_gamma(h);
#pragma unroll
        for (int p = 0; p < 16; ++p)
            glds16(CV + (row0 + 16 * (p & 3) + (lane >> 2)) * 512 + h * 128 + 32 * (p >> 2) + (lane & 3) * 8, (unsigned)__builtin_amdgcn_readfirstlane(wl0 + p * 1024));
        bf16x8 qr[4], kf[8];
#pragma unroll
        for (int i = 0; i < 4; ++i) {
            qr[i] = *(const bf16x8*)(CQ + (row0 + 32 * rh + r32) * 256 + h * 64 + i * 16 + hi * 8);
            kf[2 * i] = *(const bf16x8*)(CK + (row0 + r32) * 256 + h * 64 + i * 16 + hi * 8);
            kf[2 * i + 1] = *(const bf16x8*)(CK + (row0 + 32 + r32) * 256 + h * 64 + i * 16 + hi * 8);
        }
#if RET_BF16
        const kvt_t* st = KVT + (size_t)(bh * 128 + n) * 8192;
        bf16x8 sf[4][4];
#pragma unroll
        for (int d = 0; d < 4; ++d)
#pragma unroll
            for (int i = 0; i < 4; ++i) sf[d][i] = *(const bf16x8*)(st + (size_t)(32 * d + r32) * 64 + i * 16 + hi * 8);
#endif
        f32x16 p0, p1;
#pragma unroll
        for (int r = 0; r < 16; ++r) { p0[r] = 0.f; p1[r] = 0.f; }
#pragma unroll
        for (int i = 0; i < 4; ++i) { p0 = __builtin_amdgcn_mfma_f32_32x32x16_bf16(kf[2 * i], qr[i], p0, 0, 0, 0); p1 = __builtin_amdgcn_mfma_f32_32x32x16_bf16(kf[2 * i + 1], qr[i], p1, 0, 0, 0); }
        const int qi = 32 * rh + r32;
#pragma unroll
        for (int r = 0; r < 16; ++r) { const int key = crow(r, hi); if (key > qi) p0[r] = 0.f; if (key + 32 > qi) p1[r] = 0.f; }
        const bf16x8 pa0 = pack_p(p0, 0), pa1 = pack_p(p0, 8), pa2 = pack_p(p1, 0), pa3 = pack_p(p1, 8);
        asm volatile("s_waitcnt vmcnt(0)" ::: "memory");
#if !RET_BF16
        const float* st = KVT + (size_t)(bh * 128 + n) * 8192;
#endif
        f32x16 o[4];
#pragma unroll
        for (int d = 0; d < 4; ++d) {
            const lds_cptr vd = tp0 + d * 4096;
            f32x16 a;
#pragma unroll
            for (int r = 0; r < 16; ++r) a[r] = 0.f;
            a = __builtin_amdgcn_mfma_f32_32x32x16_bf16(pa0, cat8(vtr(vd), vtr(vd + 512)), a, 0, 0, 0);
            a = __builtin_amdgcn_mfma_f32_32x32x16_bf16(pa1, cat8(vtr(vd + 1024), vtr(vd + 1024 + 512)), a, 0, 0, 0);
            a = __builtin_amdgcn_mfma_f32_32x32x16_bf16(pa2, cat8(vtr(vd + 2048), vtr(vd + 2048 + 512)), a, 0, 0, 0);
            a = __builtin_amdgcn_mfma_f32_32x32x16_bf16(pa3, cat8(vtr(vd + 3072), vtr(vd + 3072 + 512)), a, 0, 0, 0);
#pragma unroll
            for (int i = 0; i < 4; ++i) {
#if RET_BF16
                a = __builtin_amdgcn_mfma_f32_32x32x16_bf16(qr[i], sf[d][i], a, 0, 0, 0); continue;
#endif
                const f32x4 s0 = *(const f32x4*)(st + (size_t)(32 * d + r32) * 64 + i * 16 + hi * 8), s1 = *(const f32x4*)(st + (size_t)(32 * d + r32) * 64 + i * 16 + hi * 8 + 4);
                a = __builtin_amdgcn_mfma_f32_32x32x16_bf16(qr[i], __builtin_bit_cast(bf16x8, epi::pack8(s0, s1)), a, 0, 0, 0);
            }
            o[d] = a;
        }
        LDS_WAIT(); asm volatile("" ::: "memory");
        LAS float* stg = (LAS float*)wl;
        float gn[4];
#pragma unroll
        for (int d = 0; d < 4; ++d) gn[d] = onorm[h * 128 + 32 * d + r32];
#pragma unroll
        for (int r = 0; r < 16; ++r) {
            const float dec = fast_exp2((float)(32 * rh + crow(r, hi)) * l2g);
            float ss = 0.f;
#pragma unroll
            for (int d = 0; d < 4; ++d) { o[d][r] *= dec; ss += o[d][r] * o[d][r]; }
            const float rs = __builtin_amdgcn_rsqf(half_sum32(ss) * (1.0f / 128.0f) + EPS);
#pragma unroll
            for (int d = 0; d < 4; ++d) stg[crow(r, hi) * 128 + d * 32 + r32] = o[d][r] * rs * gn[d];
        }
        LDS_WAIT(); asm volatile("" ::: "memory");
#pragma unroll
        for (int i = 0; i < 8; ++i) { const int idx = i * 64 + lane, row = idx >> 4, c8 = idx & 15;
            const f32x4 y0 = *(const LAS f32x4*)(stg + row * 128 + c8 * 8), y1 = *(const LAS f32x4*)(stg + row * 128 + c8 * 8 + 4);
            bf16_t* gp = CG + (row0 + 32 * rh + row) * 512 + h * 128 + c8 * 8;
            const u32x4 gv = *(const u32x4*)gp;
            const f32x4 g0 = {bflo(gv.x), bfhi(gv.x), bflo(gv.y), bfhi(gv.y)}, g1 = {bflo(gv.z), bfhi(gv.z), bflo(gv.w), bfhi(gv.w)};
            *(u32x4*)gp = epi::pack8(y0 * g0, y1 * g1); }
        LDS_WAIT(); asm volatile("" ::: "memory");
    }
}
}
#define XB_TMO      128
#define XB_XCNT(j)  (256  + 64 * (j))
#define XB_XSUB(j)  (1280 + 64 * (j))
#define XB_XGEN(j)  (2304 + 64 * (j))
#define XB_TOP      3328
#define XB_TOPGEN   3392
#define XCD_BAR_WORDS 3456
#define XB_GMASK(j) (3456 + 8 * (j))
#define XB_LSUB(j)  (3520 + 64 * (j))
#define XB_SPIN_CAP (1u << 18)

__device__ __forceinline__ unsigned xb_ld(unsigned* p)              { return __hip_atomic_load(p, __ATOMIC_RELAXED, __HIP_MEMORY_SCOPE_AGENT); }
__device__ __forceinline__ unsigned xb_add(unsigned* p, unsigned v) { return __hip_atomic_fetch_add(p, v, __ATOMIC_RELAXED, __HIP_MEMORY_SCOPE_AGENT); }
__device__ __forceinline__ unsigned xb_xcc_id() { return (unsigned)__builtin_amdgcn_s_getreg((3 << 11) | 20) & 0xFu; }
#define XB_SPIN(cond, bar) do { unsigned _sp = 0; while (cond) { __builtin_amdgcn_s_sleep(1); \
    if ((++_sp & 255u) == 0u) { if (xb_ld(&(bar)[XB_TMO])) break; if (_sp > XB_SPIN_CAP) { atomicAdd(&(bar)[XB_TMO], 1u); break; } } } } while (0)

struct XcdBarrier {
    unsigned* bar; unsigned x;
    volatile LAS unsigned* st;
};

__device__ __forceinline__ XcdBarrier xcd_barrier_post(unsigned* bar, volatile LAS unsigned* st) {
    XcdBarrier b; b.bar = bar; b.x = xb_xcc_id(); b.st = st;
    if (threadIdx.x == 0) {
#if LOCAL_BAR
        (void)__hip_atomic_fetch_or(&bar[XB_GMASK(blockIdx.x & 7u)], 1u << b.x, __ATOMIC_RELAXED, __HIP_MEMORY_SCOPE_AGENT);
        __builtin_amdgcn_fence(__ATOMIC_RELEASE, "agent");
#endif
        (void)xb_add(&bar[XB_XCNT(b.x)], 1u);
    }
    return b;
}
__device__ __forceinline__ void xcd_barrier_complete(unsigned* bar, unsigned x, unsigned& nloc, unsigned& nx) {
    const unsigned G = gridDim.x * gridDim.y * gridDim.z;
    unsigned sum, cnt, mine, sp = 0u;
    for (;;) {
        sum = 0u; cnt = 0u; mine = 0u;
#pragma unroll
        for (unsigned j = 0; j < 16; ++j) { const unsigned c = xb_ld(&bar[XB_XCNT(j)]); sum += c; cnt += (c > 0u) ? 1u : 0u; mine = (j == x) ? c : mine; }
        if (sum == G) break;
        __builtin_amdgcn_s_sleep(1);
        if ((++sp & 255u) == 0u) { if (xb_ld(&bar[XB_TMO])) break; if (sp > XB_SPIN_CAP) { atomicAdd(&bar[XB_TMO], 1u); break; } }
    }
    nloc = mine > 0u ? mine : 1u; nx = cnt > 0u ? cnt : 1u;
}

__device__ __forceinline__ void xcd_barrier(const XcdBarrier& b, const bool local = false) {
    asm volatile("s_waitcnt vmcnt(0)" ::: "memory");
    __syncthreads();
#if LOCAL_BAR
    if (threadIdx.x == 0 && local && b.st[2] == 1u) {
        unsigned* bar = b.bar; const unsigned g = blockIdx.x & 7u;
        const unsigned old = xb_add(&bar[XB_LSUB(g)], 1u);
        const unsigned target = (old / 32u + 1u) * 32u;
        XB_SPIN(xb_ld(&bar[XB_LSUB(g)]) < target, bar);
        __builtin_amdgcn_fence(__ATOMIC_ACQUIRE, "workgroup");
    } else
#endif
    if (threadIdx.x == 0) {
        unsigned* bar = b.bar; unsigned bx_ = b.x; asm volatile("" : "+s"(bx_));
        __builtin_amdgcn_s_waitcnt(0);
        unsigned nloc = b.st[0], nx = b.st[1];
        if (nloc == 0u) { xcd_barrier_complete(bar, bx_, nloc, nx); b.st[0] = nloc; b.st[1] = nx;
#if LOCAL_BAR
            { bool one = (nx == 8u && gridDim.x == 256u);
#pragma unroll
              for (unsigned j = 0; j < 8u; ++j) one = one && (__builtin_popcount(xb_ld(&bar[XB_GMASK(j)])) == 1);
              b.st[2] = one ? 1u : 2u; }
#endif
        }
#if BAR_FAST == 1 || BAR_FAST == 3
        __builtin_amdgcn_fence(__ATOMIC_RELEASE, "agent");
        asm volatile("s_waitcnt vmcnt(0)" ::: "memory");
#endif
        const unsigned old = xb_add(&bar[XB_XSUB(bx_)], 1u);
        const unsigned gen = old / nloc;
#if BAR_FAST >= 4
        if (old == gen * nloc && nloc > 1u) {
            __builtin_amdgcn_fence(__ATOMIC_RELEASE, "agent");
            asm volatile("s_waitcnt vmcnt(0)" ::: "memory");
        }
#endif
        if (old + 1u == (gen + 1u) * nloc) {
#if PROBE_BAR
            const unsigned long long pb0 = __builtin_amdgcn_s_memrealtime();
#endif
            __builtin_amdgcn_fence(__ATOMIC_RELEASE, "agent");
            asm volatile("s_waitcnt vmcnt(0)" ::: "memory");
#if PROBE_BAR
            const unsigned long long pb1 = __builtin_amdgcn_s_memrealtime();
#endif
            const unsigned og = xb_add(&bar[XB_TOP], 1u);
            const unsigned tg = og / nx;
#if PROBE_BAR
            const unsigned long long pb2 = __builtin_amdgcn_s_memrealtime() + (og & 0u);
#endif
#if BAR_FAST >= 5
            const bool lastx = (og + 1u == (tg + 1u) * nx);
            if (lastx) xb_add(&bar[XB_TOPGEN], 1u);
            __builtin_amdgcn_fence(__ATOMIC_ACQUIRE, "agent");
            asm volatile("s_waitcnt vmcnt(0)" ::: "memory");
            if (!lastx) XB_SPIN(xb_ld(&bar[XB_TOPGEN]) == tg, bar);
#else
            if (og + 1u == (tg + 1u) * nx) xb_add(&bar[XB_TOPGEN], 1u);
            else XB_SPIN(xb_ld(&bar[XB_TOPGEN]) == tg, bar);
#endif
#if PROBE_BAR
            const unsigned long long pb3 = __builtin_amdgcn_s_memrealtime();
#endif
#if BAR_FAST < 5
            __builtin_amdgcn_fence(__ATOMIC_ACQUIRE, "agent");
#else
            __builtin_amdgcn_fence(__ATOMIC_ACQUIRE, "workgroup");
#endif
#if PROBE_BAR
            asm volatile("s_waitcnt vmcnt(0)" ::: "memory");
            if (bx_ == PROBE_XCC) { const unsigned long long pb4 = __builtin_amdgcn_s_memrealtime(); unsigned long long* pr = (unsigned long long*)((char*)bar - WS_CTL - 16384 + WS_PROBE);
                pr[600] += (pb1 - pb0) * 4 / 100 * 4; pr[601] += (pb2 - pb1) * 4 / 100 * 4; pr[602] += (pb3 - pb2) * 4 / 100 * 4; pr[603] += (pb4 - pb3) * 4 / 100 * 4; }
#endif
#if BAR_FAST < 2
            xb_add(&bar[XB_XGEN(bx_)], 1u);
#endif
            asm volatile("s_waitcnt vmcnt(0)" ::: "memory");
        } else {
#if BAR_FAST >= 5
            __builtin_amdgcn_fence(__ATOMIC_ACQUIRE, "agent");
            asm volatile("s_waitcnt vmcnt(0)" ::: "memory");
#endif
#if BAR_FAST >= 2
            XB_SPIN(xb_ld(&bar[XB_TOPGEN]) == gen, bar);
#else
            XB_SPIN(xb_ld(&bar[XB_XGEN(bx_)]) == gen, bar);
#endif
#if BAR_FAST >= 5
            __builtin_amdgcn_fence(__ATOMIC_ACQUIRE, "workgroup");
#else
            __builtin_amdgcn_fence(__ATOMIC_ACQUIRE, "agent");
#endif
            asm volatile("s_waitcnt vmcnt(0)" ::: "memory");
        }
    }
    __syncthreads();
}


constexpr int NWAVES = 8;
constexpr int RING_OFF = 0, RING_BYTES = 131072;
constexpr int LDSCTL_OFF = RING_BYTES, MISC_OFF = LDSCTL_OFF + 320;
constexpr int LDS_BYTES = 147456;
constexpr int CW_TMO = 0, CW_CODE = 1, CW_BAR = 4096;
constexpr int PH_PER_LAYER = 12 - (HIDE_CONV ? 1 : 0) - (FUSE_RET ? 2 : 0) - (FUSE_GM ? 1 : 0);
constexpr int N_PHASES = 1 + PH_PER_LAYER * DEPTH;

#define CAS __attribute__((address_space(4)))
struct Args { const GAS float* in[N_IN]; GAS float* out; GAS unsigned char* ws; double ropec[32]; float lam_init[2]; };

template <class T> __device__ __forceinline__ T* as_global(GAS T* p) { return (T*)p; }
__device__ __forceinline__ int conv_dst_row(int mode, int row_off, int n0) {
    if (mode == 0) return row_off + n0;
    if (mode == 1) return 256 * (n0 >> 7) + (n0 & 127) + row_off;
    return (n0 < NIN1) ? ((n0 & ~255) + 128 * ((n0 >> 5) & 1) + 32 * ((n0 >> 6) & 3)) : n0;
}
__device__ __forceinline__ void conv_item(const float* W, const float* gain, int K, int N, bf16_t* WT, int mode, int row_off, LAS float* scr, int item, int lane) {
    const int nblk = N / 32, kb = item / nblk, nb = item % nblk, k0 = 64 * kb, n0 = 32 * nb;
    float wv[32], gv[32];
#pragma unroll
    for (int i = 0; i < 32; ++i) { const int kk = 2 * i + (lane >> 5); wv[i] = W[(size_t)(k0 + kk) * N + n0 + (lane & 31)]; gv[i] = gain ? gain[k0 + kk] : 1.0f; }
#pragma unroll
    for (int i = 0; i < 32; ++i) { const int kk = 2 * i + (lane >> 5); scr[kk * 33 + (lane & 31)] = wv[i] * gv[i]; }
    LDS_WAIT(); asm volatile("" ::: "memory");
    const int c = lane & 7, drow = conv_dst_row(mode, row_off, n0);
#pragma unroll
    for (int j = 0; j < 4; ++j) { const int n = (lane >> 3) + 8 * j; const LAS float* s = scr + (8 * c) * 33 + n;
        u32x4 o; o.x = pk2(s[0 * 33], s[1 * 33]); o.y = pk2(s[2 * 33], s[3 * 33]); o.z = pk2(s[4 * 33], s[5 * 33]); o.w = pk2(s[6 * 33], s[7 * 33]);
        *(GAS u32x4*)(WT + (size_t)(drow + n) * K + k0 + 8 * c) = o; }
    LDS_WAIT(); asm volatile("" ::: "memory");
}
__device__ __forceinline__ void convert_layer(const CAS Args& a, unsigned char* ws, int l, int part, LAS unsigned char* lds, int gw, int ngw, int wave, int lane) {
    LAS float* scr = (LAS float*)(lds + wave * 16384);
    unsigned char* wb = ws + WS_W;
    constexpr int I_GU = (DM / 64) * (DFF / 32), I_D = (DFF / 64) * (DM / 32), I_IN = (DM / 64) * (NIN / 32), I_BR = (512 / 64) * (DM / 32), I_O = (DM / 64) * (DM / 32);
    constexpr int NITEMS = 4 * I_GU + 2 * I_D + I_IN + 3 * I_BR + I_O;
    const size_t oGU = (size_t)l * DM * DFF, oD = (size_t)l * DFF * DM, oIN = (size_t)l * DM * NIN, oBR = (size_t)l * 512 * DM, oO = (size_t)l * DM * DM;
    constexpr int P1 = 2 * I_GU + I_D, P2 = P1 + I_IN + 3 * I_BR + I_O;
    const int it_lo = (part <= 1) ? 0 : (part == 2 ? P1 : P2), it_hi = (part == 0 || part == 3) ? NITEMS : (part == 1 ? P1 : P2);
    for (int it = it_lo + gw; it < it_hi; it += ngw) {
        int r = it;
        if (r < I_GU) { conv_item(as_global(a.in[I_F1G]) + oGU, as_global(a.in[I_F1N]) + l * DM, DM, DFF, (bf16_t*)(wb + W_GU1), 1, 0, scr, r, lane); continue; } r -= I_GU;
        if (r < I_GU) { conv_item(as_global(a.in[I_F1U]) + oGU, as_global(a.in[I_F1N]) + l * DM, DM, DFF, (bf16_t*)(wb + W_GU1), 1, 128, scr, r, lane); continue; } r -= I_GU;
        if (r < I_D)  { conv_item(as_global(a.in[I_F1D]) + oD, nullptr, DFF, DM, (bf16_t*)(wb + W_D1), 0, 0, scr, r, lane); continue; } r -= I_D;
        if (r < I_IN) { conv_item(as_global(a.in[I_WIN]) + oIN, as_global(a.in[I_MIXN]) + l * DM, DM, NIN, (bf16_t*)(wb + W_IN), 2, 0, scr, r, lane); continue; } r -= I_IN;
        if (r < I_BR) { conv_item(as_global(a.in[I_WBA]) + oBR, nullptr, 512, DM, (bf16_t*)(wb + W_BR), 0, 0, scr, r, lane); continue; } r -= I_BR;
        if (r < I_BR) { conv_item(as_global(a.in[I_WBB]) + oBR, nullptr, 512, DM, (bf16_t*)(wb + W_BR), 0, DM, scr, r, lane); continue; } r -= I_BR;
        if (r < I_BR) { conv_item(as_global(a.in[I_WBC]) + oBR, nullptr, 512, DM, (bf16_t*)(wb + W_BR), 0, 2 * DM, scr, r, lane); continue; } r -= I_BR;
        if (r < I_O)  { conv_item(as_global(a.in[I_WOUT]) + oO, nullptr, DM, DM, (bf16_t*)(wb + W_OUT), 0, 0, scr, r, lane); continue; } r -= I_O;
        if (r < I_GU) { conv_item(as_global(a.in[I_F2G]) + oGU, as_global(a.in[I_F2N]) + l * DM, DM, DFF, (bf16_t*)(wb + W_GU2), 1, 0, scr, r, lane); continue; } r -= I_GU;
        if (r < I_GU) { conv_item(as_global(a.in[I_F2U]) + oGU, as_global(a.in[I_F2N]) + l * DM, DM, DFF, (bf16_t*)(wb + W_GU2), 1, 128, scr, r, lane); continue; } r -= I_GU;
        conv_item(as_global(a.in[I_F2D]) + oD, nullptr, DFF, DM, (bf16_t*)(wb + W_D2), 0, 0, scr, r, lane);
    }
}
__device__ __forceinline__ void rope_tables(const CAS Args& a, unsigned char* ws, int gtid, int ngt) {
    float* cosT = (float*)(ws + WS_COS); float* sinT = (float*)(ws + WS_SIN);
    for (int i = gtid; i < SEQ * 32; i += ngt) { const int t = i >> 5, k = i & 31;
        const double rev = (double)t * a.ropec[k]; const float fr = (float)(rev - floor(rev));
        cosT[i] = __builtin_amdgcn_cosf(fr); sinT[i] = __builtin_amdgcn_sinf(fr); }
}


constexpr int CW_CNT = 32768;
__device__ __forceinline__ void cnt_signal(gu32* ctl, int idx) {
    asm volatile("s_waitcnt vmcnt(0)" ::: "memory");
    __syncthreads();
    if (threadIdx.x == 0) {
        __builtin_amdgcn_fence(__ATOMIC_RELEASE, "agent");
        asm volatile("s_waitcnt vmcnt(0)" ::: "memory");
        (void)__hip_atomic_fetch_add((unsigned*)(ctl + CW_CNT + 64 * idx), 1u, __ATOMIC_RELAXED, __HIP_MEMORY_SCOPE_AGENT);
    }
}
__device__ __forceinline__ void cnt_wait(gu32* ctl, int idx, unsigned want) {
    if (threadIdx.x == 0) {
        unsigned sp = 0;
        while (__hip_atomic_load((unsigned*)(ctl + CW_CNT + 64 * idx), __ATOMIC_RELAXED, __HIP_MEMORY_SCOPE_AGENT) < want) {
            __builtin_amdgcn_s_sleep(2);
            if (++sp > (1u << 22)) { __hip_atomic_store((unsigned*)(ctl + CW_TMO), 1u, __ATOMIC_RELAXED, __HIP_MEMORY_SCOPE_AGENT); break; }
        }
        __builtin_amdgcn_fence(__ATOMIC_ACQUIRE, "agent");
        asm volatile("s_waitcnt vmcnt(0)" ::: "memory");
    }
    __syncthreads();
}
struct Ctx { LAS unsigned char* lds; int tid, lane, wave, vcu, G, bx, gw, ngw; unsigned char* ws; float* X; const CAS Args* ap; };
enum { K_PRO = 0, K_CONV, K_UP, K_DOWN, K_WIN, K_KV, K_SCAN, K_MIX, K_GATE, K_MERGE, K_WOUT, N_KINDS };
__host__ __device__ __forceinline__ void phase_decode(int ph, int& kind, int& l, int& ffn2) {
    if (ph == 0) { kind = K_PRO; l = 0; ffn2 = 0; return; }
    int k = (ph - 1) % PH_PER_LAYER + (HIDE_CONV ? 1 : 0); l = (ph - 1) / PH_PER_LAYER;
    if (FUSE_RET && k >= 4) k += 2;
    if (FUSE_GM && k >= 8) k += 1;
    ffn2 = (k >= 10);
    const int tab[12] = {K_CONV, K_UP, K_DOWN, K_WIN, K_KV, K_SCAN, K_MIX, K_GATE, K_MERGE, K_WOUT, K_UP, K_DOWN};
    kind = (k == 0) ? K_CONV : (k == 1 || k == 10) ? K_UP : (k == 2 || k == 11) ? K_DOWN : (k == 3) ? K_WIN : (k == 4) ? K_KV : (k == 5) ? K_SCAN : (k == 6) ? K_MIX : (k == 7) ? K_GATE : (k == 8) ? K_MERGE : K_WOUT;
    (void)tab;
}
__device__ __forceinline__ int vcu_idle(int bx) { return bx - 128; }
template <int KIND>
__device__ __forceinline__ void phase_body(const Ctx& c, const int l, const int ffn2) {
    const CAS Args& args = *c.ap; unsigned char* ws = c.ws; float* X = c.X; LAS unsigned char* lds = c.lds;
    const int tid = c.tid, lane = c.lane, wave = c.wave, vcu = c.vcu, G = c.G, bx = c.bx, gw = c.gw, ngw = c.ngw;
    bf16_t* XB = (bf16_t*)(ws + WS_XB); float* SSQ = (float*)(ws + WS_SSQ);
    bf16_t* XLO = (bf16_t*)X; bf16_t* XLT = (bf16_t*)(ws + WS_XLT);
    const float* cosT = (const float*)(ws + WS_COS); const float* sinT = (const float*)(ws + WS_SIN);
    unsigned char* wb = ws + WS_W;
    (void)tid; (void)lane; (void)wave; (void)vcu; (void)G; (void)bx; (void)gw; (void)ngw; (void)XB; (void)SSQ; (void)XLO; (void)XLT; (void)cosT; (void)sinT; (void)wb; (void)X; (void)lds;
    if constexpr (KIND == K_PRO) {
#if NAIVE_WIN
        rope_tables(args, ws, (vcu * NWAVES * 64) + tid, G * NWAVES * 64);
#endif
        if (bx == 0 && tid < 4) ((unsigned*)(ws + WS_ONES))[tid] = 0x3f803f80u;
        naive::xb_ssq_pass(as_global(args.in[I_X]), XB, SSQ, gw, ngw, lane);
        convert_layer(args, ws, 0, (HIDE_CONV && G == 256) ? 1 : 0, lds, gw, ngw, wave, lane);
    } else if constexpr (KIND == K_CONV) {
        if (l > 0) convert_layer(args, ws, l, 0, lds, gw, ngw, wave, lane);
    } else if constexpr (KIND == K_UP) {
#if NAIVE_UP
        const float* xin = (l == 0 && !ffn2) ? as_global(args.in[I_X]) : X;
        naive::gemm<2, true, true, 4>(lds, tid, vcu, G, DFF, DM, xin, (ffn2 ? as_global(args.in[I_F2N]) : as_global(args.in[I_F1N])) + l * DM, nullptr, nullptr, nullptr, 0,
                                   (ffn2 ? as_global(args.in[I_F2G]) : as_global(args.in[I_F1G])) + (size_t)l * DM * DFF, (ffn2 ? as_global(args.in[I_F2U]) : as_global(args.in[I_F1U])) + (size_t)l * DM * DFF, nullptr, DFF, naive::NEpiUp{(bf16_t*)(ws + WS_HB)});
#else
        pg8::Gemm g{XB, (const bf16_t*)(wb + (ffn2 ? W_GU2 : W_GU1)), DM, 0, 0};
        pg8::StaticOrder S; S.init(M, 2 * DFF, G, bx);
#if !(HIDE_CONV && CONV_FIRST)
        pg8::gemm_phase(lds + RING_OFF, tid, g, S, epi::EpiUp{(bf16_t*)(ws + WS_HB), (const LAS float*)(lds + epi::EPI_RSTD_OFF)}, [&]() { epi::fill_rstd_table(lds, tid, SSQ, S); });
#endif
#if HIDE_CONV
        if (G == 256 && bx >= 128) { if (l == 0 && !ffn2) convert_layer(args, ws, 0, 2, lds, (vcu_idle(bx)) * NWAVES + wave, 128 * NWAVES, wave, lane);
                                     if (l == 0 && ffn2)  convert_layer(args, ws, 1, 1, lds, (vcu_idle(bx)) * NWAVES + wave, 128 * NWAVES, wave, lane);
                                     if (l == 1 && !ffn2) convert_layer(args, ws, 1, 2, lds, (vcu_idle(bx)) * NWAVES + wave, 128 * NWAVES, wave, lane); }
#if CONV_FIRST
        __syncthreads();
        pg8::gemm_phase(lds + RING_OFF, tid, g, S, epi::EpiUp{(bf16_t*)(ws + WS_HB), (const LAS float*)(lds + epi::EPI_RSTD_OFF)}, [&]() { epi::fill_rstd_table(lds, tid, SSQ, S); });
#endif
#endif
#endif
    } else if constexpr (KIND == K_DOWN) {
        const float* xold = (l == 0 && !ffn2) ? as_global(args.in[I_X]) : X;
#if NAIVE_DOWN
        naive::gemm<1, true, false, 4>(lds, tid, vcu, G, DM, DFF, nullptr, nullptr, (const bf16_t*)(ws + WS_HB), nullptr, nullptr, DFF,
                                    (ffn2 ? as_global(args.in[I_F2D]) : as_global(args.in[I_F1D])) + (size_t)l * DFF * DM, nullptr, nullptr, DM, naive::NEpiRes{xold, X, XB, SSQ, 0.5f});
#else
        pg8::Gemm g{(const bf16_t*)(ws + WS_HB), (const bf16_t*)(wb + (ffn2 ? W_D2 : W_D1)), DFF, 0, 0};
        pg8::StaticOrder S; S.init(M, DM, G, bx);
        pg8::gemm_phase(lds + RING_OFF, tid, g, S, epi::EpiRes{(l == 0 && !ffn2) ? xold : nullptr, (l == DEPTH - 1 && ffn2) ? XLT : XLO, (l == DEPTH - 1 && ffn2) ? X : nullptr, XB, XLO, SSQ, 0.5f
#if PROBE_INIT
            , (unsigned long long*)(ws + WS_PROBE)
#endif
            });
#endif
    } else if constexpr (KIND == K_WIN) {
#if NAIVE_WIN
        naive::gemm<1, true, true, 4>(lds, tid, vcu, G, NIN1, DM, X, as_global(args.in[I_MIXN]) + l * DM, nullptr, nullptr, nullptr, 0,
                                   as_global(args.in[I_WIN]) + (size_t)l * DM * NIN, nullptr, nullptr, NIN,
                                   naive::NEpiWin{ws, cosT, sinT, as_global(args.in[I_AQN]) + l * 64, as_global(args.in[I_AKN]) + l * 64, as_global(args.in[I_BQN]) + l * 64, as_global(args.in[I_BKN]) + l * 64});
#else
        pg8::Gemm g{XB, (const bf16_t*)(wb + W_IN), DM, 0, 0};
        pg8::StaticOrder S; S.init(M, NIN1, G, bx);
#if HIDE_CONV && CONV_FIRST
        if (G == 256 && bx >= 128) convert_layer(args, ws, l, 3, lds, (vcu_idle(bx)) * NWAVES + wave, 128 * NWAVES, wave, lane);
        __syncthreads();
#endif
        pg8::gemm_phase(lds + RING_OFF, tid, g, S, epi::EpiWin{ws, (const LAS float*)(lds + epi::EPI_RSTD_OFF), (const LAS float*)(lds + epi::EPI_GAIN_OFF), (const LAS float*)(lds + epi::EPI_ROPE_OFF)}, [&]() {
            epi::fill_rstd_table(lds, tid, SSQ, S);
            LAS float* gt = (LAS float*)(lds + epi::EPI_GAIN_OFF); LAS float* rt = (LAS float*)(lds + epi::EPI_ROPE_OFF);
            if (tid < 256) { const int kq = tid >> 6; const float* gp = (kq == 0) ? as_global(args.in[I_AQN]) : (kq == 1) ? as_global(args.in[I_AKN]) : (kq == 2) ? as_global(args.in[I_BQN]) : as_global(args.in[I_BKN]); gt[tid] = gp[l * 64 + (tid & 63)]; }
            else if (tid < 288) rt[tid - 256] = (float)args.ropec[tid - 256]; });
#if HIDE_CONV && !CONV_FIRST
        if (G == 256 && bx >= 128) convert_layer(args, ws, l, 3, lds, (vcu_idle(bx)) * NWAVES + wave, 128 * NWAVES, wave, lane);
#endif
#endif
    } else if constexpr (KIND == K_KV) {
#if !NAIVE_C
        fa::ret_kv_phase(lds, tid, ws, gw, ngw);
#endif
    } else if constexpr (KIND == K_SCAN) {
#if !NAIVE_C
        fa::ret_scan_phase(tid, ws, vcu, G);
#endif
    } else if constexpr (KIND == K_MIX) {
#if PROBE_XMAP
        const int vcu_keep = vcu; (void)vcu_keep;
#define vcu ((((7 - (vcu_keep >> 5)) & 7) << 5) | (vcu_keep & 31))
#define gw (vcu * NWAVES + wave)
#endif
#if FUSE_RET && !NAIVE_C && !NAIVE_B && !NAIVE_A
        {
            gu32* ctl = (gu32*)(ws + WS_CTL);
            fa::ret_kv_phase(lds, tid, ws, gw, ngw);
            cnt_signal(ctl, l * 16 + (vcu >> 5));
            fa::attn_b_phase(lds, tid, ws, (bf16_t*)(ws + WS_BQ), vcu, G, as_global(args.in[I_BREL]) + l * 8 * 320, as_global(args.in[I_BQN]) + l * 64, as_global(args.in[I_BKN]) + l * 64);
            if (vcu < 128) { cnt_wait(ctl, l * 16 + (vcu >> 4), 32u); fa::ret_scan_phase(tid, ws, vcu, G); cnt_signal(ctl, l * 16 + 8 + (vcu >> 4)); }
            __syncthreads();
            fa::attn_a_phase(lds, tid, ws, (bf16_t*)(ws + WS_AQ), vcu, G, as_global(args.in[I_LQ1]) + l * 64, as_global(args.in[I_LK1]) + l * 64, as_global(args.in[I_LQ2]) + l * 64, as_global(args.in[I_LK2]) + l * 64, as_global(args.in[I_ASUB]) + l * 128, (l == 0 ? args.lam_init[0] : args.lam_init[1]), as_global(args.in[I_AQN]) + l * 64, as_global(args.in[I_AKN]) + l * 64);
            cnt_wait(ctl, l * 16 + 8 + (vcu >> 5), 16u);
            fa::ret_out_phase(lds, tid, ws, gw, ngw, as_global(args.in[I_CON]) + l * 512);
        }
#else
#if NAIVE_C
        naive::retention(ws, as_global(args.in[I_CON]) + l * 512, lds, vcu, G, tid);
#else
#if PROBE_PH == 3
        const unsigned long long tm0 = __builtin_amdgcn_s_memrealtime();
#endif
#if MIX_SETUP
        const LAS float* mixc = (G == 256) ? (const LAS float*)(lds + fa::LDS_MIXC) : nullptr;
        if (mixc) fa::mix_setup(lds, tid, vcu, as_global(args.in[I_BREL]) + l * 8 * 320, as_global(args.in[I_AQN]) + l * 64, as_global(args.in[I_AKN]) + l * 64, as_global(args.in[I_BQN]) + l * 64, as_global(args.in[I_BKN]) + l * 64,
                                  as_global(args.in[I_LQ1]) + l * 64, as_global(args.in[I_LK1]) + l * 64, as_global(args.in[I_LQ2]) + l * 64, as_global(args.in[I_LK2]) + l * 64, (l == 0 ? args.lam_init[0] : args.lam_init[1]));
#else
        const LAS float* mixc = nullptr;
#endif
#if !DYN_RET
        fa::ret_out_phase(lds, tid, ws, gw, ngw, as_global(args.in[I_CON]) + l * 512);
#endif
#endif
        __syncthreads();
#if PROBE_PH == 3
        const unsigned long long tm1 = __builtin_amdgcn_s_memrealtime();
#endif
#if NAIVE_B
        naive::attn_b(ws, as_global(args.in[I_BREL]) + l * 8 * 320, lds, gw, ngw, wave, lane);
#else
#if PROBE_B
        for (int rep = 0; rep < PROBE_B; ++rep) { fa::attn_b_phase(lds, tid, ws, (bf16_t*)(ws + WS_W), vcu, G, as_global(args.in[I_BREL]) + l * 8 * 320, as_global(args.in[I_BQN]) + l * 64, as_global(args.in[I_BKN]) + l * 64); __syncthreads(); }
#endif
#if !MIX_A_FIRST
        fa::attn_b_phase(lds, tid, ws, (bf16_t*)(ws + WS_BQ), vcu, G, as_global(args.in[I_BREL]) + l * 8 * 320, as_global(args.in[I_BQN]) + l * 64, as_global(args.in[I_BKN]) + l * 64, mixc);
#endif
#endif
        __syncthreads();
#if PROBE_PH == 3
        if (bx == PROBE_BLK && tid == 0 && l == PROBE_L) { const unsigned long long tm2 = __builtin_amdgcn_s_memrealtime(); unsigned long long* pr = (unsigned long long*)(ws + WS_PROBE); pr[57] = (tm1 - tm0) * 16 / 100; pr[58] = (tm2 - tm1) * 16 / 100; }
#endif
#if NAIVE_A
        naive::attn_a(ws, as_global(args.in[I_LQ1]) + l * 64, as_global(args.in[I_LK1]) + l * 64, as_global(args.in[I_LQ2]) + l * 64, as_global(args.in[I_LK2]) + l * 64, as_global(args.in[I_ASUB]) + l * 128, (l == 0 ? args.lam_init[0] : args.lam_init[1]), lds, gw, ngw, wave, lane);
#else
#if PROBE_A
        for (int rep = 0; rep < PROBE_A; ++rep) { fa::attn_a_phase(lds, tid, ws, (bf16_t*)(ws + WS_W), vcu, G, as_global(args.in[I_LQ1]) + l * 64, as_global(args.in[I_LK1]) + l * 64, as_global(args.in[I_LQ2]) + l * 64, as_global(args.in[I_LK2]) + l * 64, as_global(args.in[I_ASUB]) + l * 128, (l == 0 ? args.lam_init[0] : args.lam_init[1]), as_global(args.in[I_AQN]) + l * 64, as_global(args.in[I_AKN]) + l * 64, PROBE_PM); __syncthreads(); }
#endif
#define MK_PROBE_STRETCH 1
        fa::attn_a_phase(lds, tid, ws, (bf16_t*)(ws + WS_AQ), vcu, G, as_global(args.in[I_LQ1]) + l * 64, as_global(args.in[I_LK1]) + l * 64, as_global(args.in[I_LQ2]) + l * 64, as_global(args.in[I_LK2]) + l * 64, as_global(args.in[I_ASUB]) + l * 128, (l == 0 ? args.lam_init[0] : args.lam_init[1]), as_global(args.in[I_AQN]) + l * 64, as_global(args.in[I_AKN]) + l * 64, 0, mixc);
#if MIX_A_FIRST && !NAIVE_B
        __syncthreads();
        fa::attn_b_phase(lds, tid, ws, (bf16_t*)(ws + WS_BQ), vcu, G, as_global(args.in[I_BREL]) + l * 8 * 320, as_global(args.in[I_BQN]) + l * 64, as_global(args.in[I_BKN]) + l * 64, mixc);
#endif
#endif
#if DYN_RET && !NAIVE_C
        __syncthreads();
        fa::ret_out_phase(lds, tid, ws, gw, ngw, as_global(args.in[I_CON]) + l * 512, (unsigned*)(ws + WS_CTL) + 1024 + 64 * l);
#endif
#endif
#if PROBE_T
        __syncthreads();
        if (bx == 0 && tid == 0 && l == 1) {
            const unsigned long long* pr = (const unsigned long long*)(ws + WS_PROBE);
            const unsigned long long v = pr[PROBE_SEL]; const unsigned long long t0 = __builtin_amdgcn_s_memrealtime();
            while (__builtin_amdgcn_s_memrealtime() - t0 < v * 100ull) __builtin_amdgcn_s_sleep(32);
        }
#endif
#if PROBE_XMAP
#undef vcu
#undef gw
#endif
    } else if constexpr (KIND == K_GATE) {
#if NAIVE_GATE
        naive::gemm<1, true, true, 4>(lds, tid, vcu, G, NGATE, DM, X, as_global(args.in[I_MIXN]) + l * DM, nullptr, nullptr, nullptr, 0,
                                   as_global(args.in[I_WIN]) + (size_t)l * DM * NIN + NIN1, nullptr, nullptr, NIN, naive::NEpiGate{(bf16_t*)(ws + WS_GT)});
#else
#if FUSE_GM
        {
            pg8::Gemm g{XB, (const bf16_t*)(wb + W_IN) + (size_t)NIN1 * DM, DM, 0, (size_t)1024 * DM * 2};
            pg8::StaticOrder S; S.init(M, DM, G, bx);
            pg8::gemm_phase<3>(lds + RING_OFF, tid, g, S, epi::EpiGate{(bf16_t*)(ws + WS_GT), (const LAS float*)(lds + epi::EPI_RSTD_OFF)}, [&]() { epi::fill_rstd_table(lds, tid, SSQ, S); });
            asm volatile("s_waitcnt vmcnt(0)" ::: "memory"); __syncthreads();
            int tid2 = tid; asm volatile("" : "+v"(tid2));
            pg8::Gemm g2{(const bf16_t*)(ws + WS_AQ), (const bf16_t*)(wb + W_BR), 512, P16, (size_t)DM * 512 * 2};
            pg8::StaticOrder S2; S2.init(M, DM, G, bx);
            pg8::gemm_phase<3>(lds + RING_OFF, tid2, g2, S2, epi::EpiMerge{(const bf16_t*)(ws + WS_GT), (bf16_t*)(ws + WS_MG), (const unsigned*)(ws + WS_ONES)});
        }
#else
        pg8::Gemm g{XB, (const bf16_t*)(wb + W_IN) + (size_t)NIN1 * DM, DM, 0, 0};
        pg8::StaticOrder S; S.init(M, NGATE, G, bx);
        pg8::gemm_phase(lds + RING_OFF, tid, g, S, epi::EpiGate{(bf16_t*)(ws + WS_GT), (const LAS float*)(lds + epi::EPI_RSTD_OFF)}, [&]() { epi::fill_rstd_table(lds, tid, SSQ, S); });
#endif
#endif
    } else if constexpr (KIND == K_MERGE) {
#if NAIVE_MERGE
        naive::gemm<3, false, false, 2>(lds, tid, vcu, G, DM, 512, nullptr, nullptr, (const bf16_t*)(ws + WS_AQ), (const bf16_t*)(ws + WS_BQ), (const bf16_t*)(ws + WS_CG), 512,
                                     as_global(args.in[I_WBA]) + (size_t)l * 512 * DM, as_global(args.in[I_WBB]) + (size_t)l * 512 * DM, as_global(args.in[I_WBC]) + (size_t)l * 512 * DM, DM,
                                     naive::NEpiMerge{(const bf16_t*)(ws + WS_GT), (bf16_t*)(ws + WS_MG)});
#else
        static_assert(WS_BQ - WS_AQ == P16 && WS_CG - WS_BQ == P16, "y_a, y_b, y_c equally spaced");
        pg8::Gemm g{(const bf16_t*)(ws + WS_AQ), (const bf16_t*)(wb + W_BR), 512, P16, (size_t)DM * 512 * 2};
        pg8::StaticOrder S; S.init(M, DM, G, bx);
        pg8::gemm_phase<3>(lds + RING_OFF, tid, g, S, epi::EpiMerge{(const bf16_t*)(ws + WS_GT), (bf16_t*)(ws + WS_MG), (const unsigned*)(ws + WS_ONES)});
#endif
    } else if constexpr (KIND == K_WOUT) {
#if NAIVE_WOUT
        naive::gemm<1, true, false, 4>(lds, tid, vcu, G, DM, DM, nullptr, nullptr, (const bf16_t*)(ws + WS_MG), nullptr, nullptr, DM,
                                    as_global(args.in[I_WOUT]) + (size_t)l * DM * DM, nullptr, nullptr, DM, naive::NEpiRes{X, X, XB, SSQ, 1.0f});
#else
        pg8::Gemm g{(const bf16_t*)(ws + WS_MG), (const bf16_t*)(wb + W_OUT), DM, 0, 0};
        pg8::StaticOrder S; S.init(M, DM, G, bx);
        pg8::gemm_phase(lds + RING_OFF, tid, g, S, epi::EpiRes{nullptr, XLO, nullptr, XB, (l == DEPTH - 1) ? XLT : XLO, SSQ, 1.0f
#if PROBE_INIT
            , (unsigned long long*)(ws + WS_PROBE)
#endif
            });
#endif
    }
}
__device__ __forceinline__ Ctx make_ctx(LAS unsigned char* lds, const int wave_s) {
    Ctx c; c.lds = lds;
    int lane_; asm volatile("v_mbcnt_lo_u32_b32 %0, -1, 0\n\tv_mbcnt_hi_u32_b32 %0, -1, %0" : "=&v"(lane_));
    int tid = wave_s * 64 + lane_; asm volatile("" : "+v"(tid));
    const CAS Args* argp = (const CAS Args*)__builtin_amdgcn_kernarg_segment_ptr(); asm volatile("" : "+s"(argp));
    c.ap = argp; c.tid = tid; c.lane = tid & 63; c.wave = __builtin_amdgcn_readfirstlane(tid >> 6);
    c.G = gridDim.x; c.bx = blockIdx.x; c.vcu = (c.G % 8 == 0) ? (c.bx % 8) * (c.G / 8) + c.bx / 8 : c.bx;
    c.gw = c.vcu * NWAVES + c.wave; c.ngw = c.G * NWAVES;
    GAS unsigned char* ws = argp->ws; asm volatile("" : "+s"(ws)); c.ws = as_global(ws);
    GAS float* X = argp->out; asm volatile("" : "+s"(X)); c.X = as_global(X);
    return c;
}
#if MK_PER_PHASE_LAUNCH
template <int KIND>
__global__ void __launch_bounds__(NWAVES * 64, 2) phase_kernel(Args args_, int l, int ffn2) {
    extern __shared__ __attribute__((aligned(16))) unsigned char lds_raw[];
    const Ctx c = make_ctx((LAS unsigned char*)lds_raw, __builtin_amdgcn_readfirstlane(threadIdx.x >> 6));
    phase_body<KIND>(c, l, ffn2);
}
#endif
#if !MK_PER_PHASE_LAUNCH
__global__ void __launch_bounds__(NWAVES * 64, 2) trunk_fwd(Args args_) {
    extern __shared__ __attribute__((aligned(16))) unsigned char lds_raw[];
    LAS unsigned char* lds = (LAS unsigned char*)lds_raw;
    volatile LAS unsigned* MISC = (volatile LAS unsigned*)(lds + MISC_OFF);
    gu32* ctl = (gu32*)(args_.ws + WS_CTL);
    for (int u = threadIdx.x; u < (LDS_BYTES - LDSCTL_OFF) / 4; u += NWAVES * 64) ((LAS unsigned*)(lds + LDSCTL_OFF))[u] = 0u;
    __syncthreads();
    XcdBarrier bar = xcd_barrier_post((unsigned*)(ctl + CW_BAR), MISC + 8);
    const int wave_s = __builtin_amdgcn_readfirstlane(threadIdx.x >> 6);
    for (int ph = 0; ph < N_PHASES; ++ph) {
        const Ctx c = make_ctx(lds, wave_s);
        int kind_, l_, ffn2_; phase_decode(ph, kind_, l_, ffn2_);
        const int kind = __builtin_amdgcn_readfirstlane(kind_), l = __builtin_amdgcn_readfirstlane(l_), ffn2 = __builtin_amdgcn_readfirstlane(ffn2_);
#if PROBE_MASK
        if ((PROBE_MASK >> kind) & 1) {
            switch (kind) {
            case K_CONV: phase_body<K_CONV>(c, l, ffn2); break;
#if PROBE_NULL
            case K_UP: { pg8::Gemm g{(const bf16_t*)(c.ws + WS_XB), (const bf16_t*)(c.ws + WS_W + (ffn2 ? W_GU2 : W_GU1)), DM, 0, 0}; pg8::StaticOrder S; S.init(M, 2 * DFF, c.G, c.bx); pg8::gemm_phase(c.lds + RING_OFF, c.tid, g, S, epi::EpiNull{}); } break;
#else
            case K_UP: phase_body<K_UP>(c, l, ffn2); break;
#endif
            case K_WIN: phase_body<K_WIN>(c, l, ffn2); break;
            case K_KV: phase_body<K_KV>(c, l, ffn2); break;
            case K_GATE: phase_body<K_GATE>(c, l, ffn2); break;
            case K_MERGE: phase_body<K_MERGE>(c, l, ffn2); break;
            default: break;
            }
            xcd_barrier(bar);
        }
#endif
#if PROBE_PH
        unsigned long long tp0 = __builtin_amdgcn_s_memrealtime();
        const unsigned long long tc0 = __builtin_amdgcn_s_memtime();
#endif
        switch (kind) {
        case K_PRO: phase_body<K_PRO>(c, l, ffn2); break;
        case K_CONV: phase_body<K_CONV>(c, l, ffn2); break;
        case K_UP: phase_body<K_UP>(c, l, ffn2); break;
        case K_DOWN: phase_body<K_DOWN>(c, l, ffn2); break;
        case K_WIN: phase_body<K_WIN>(c, l, ffn2); break;
        case K_KV: phase_body<K_KV>(c, l, ffn2); break;
        case K_SCAN: phase_body<K_SCAN>(c, l, ffn2); break;
        case K_MIX: phase_body<K_MIX>(c, l, ffn2); break;
        case K_GATE: phase_body<K_GATE>(c, l, ffn2); break;
        case K_MERGE: phase_body<K_MERGE>(c, l, ffn2); break;
        default: phase_body<K_WOUT>(c, l, ffn2); break;
        }
#if PROBE_PH
        __syncthreads(); const unsigned long long tp1 = __builtin_amdgcn_s_memrealtime();
        if (blockIdx.x == PROBE_BLK && threadIdx.x == 0 && l == PROBE_L && kind == PROBE_KIND) { const unsigned long long tc1 = __builtin_amdgcn_s_memtime();
            ((unsigned long long*)(args_.ws + WS_PROBE))[52] = (tc1 - tc0) * 40ull / (tp1 - tp0); ((unsigned long long*)(args_.ws + WS_PROBE))[53] = (tp1 - tp0) * 16 / 100; }
#endif
        { int k2_, l2_, f2_; phase_decode(ph, k2_, l2_, f2_);
          if (ph + 1 < N_PHASES) xcd_barrier(bar, LOCAL_BAR && __builtin_amdgcn_readfirstlane(k2_) == K_UP); }
#if PROBE_PH
        if (blockIdx.x == PROBE_BLK && threadIdx.x == 0) { const unsigned long long tp2 = __builtin_amdgcn_s_memrealtime(); unsigned long long* pr = (unsigned long long*)(args_.ws + WS_PROBE);
            pr[kind] += tp1 - tp0; pr[16] += tp2 - tp1; pr[17] += tp2 - tp0; pr[20 + kind] += tp2 - tp1; }
#if PROBE_PH == 3
        if (blockIdx.x == PROBE_BLK && threadIdx.x == 0 && l == PROBE_L && kind == PROBE_KIND) ((unsigned long long*)(args_.ws + WS_PROBE))[56] = tp0;
        if (threadIdx.x == 0 && l == PROBE_L && kind == PROBE_KIND2) __hip_atomic_store((unsigned long long*)(args_.ws + WS_PROBE) + 64 + 256 + blockIdx.x, tp0, __ATOMIC_RELAXED, __HIP_MEMORY_SCOPE_AGENT);
        if (threadIdx.x == 0 && l == PROBE_L && kind == PROBE_KIND) __hip_atomic_store((unsigned long long*)(args_.ws + WS_PROBE) + 64 + blockIdx.x, tp1, __ATOMIC_RELAXED, __HIP_MEMORY_SCOPE_AGENT);
#endif
#if PROBE_PH == 2
        if (threadIdx.x == 0 && l == 0) { const unsigned long long tp2 = __builtin_amdgcn_s_memrealtime();
            (void)__hip_atomic_fetch_add((unsigned long long*)(args_.ws + WS_PROBE) + 40 + kind, (tp2 - tp1) / 256, __ATOMIC_RELAXED, __HIP_MEMORY_SCOPE_AGENT); }
#endif
#endif
    }
#if PROBE_LB
    if (blockIdx.x == 0 && threadIdx.x == 0 && MISC[10] == 1u) { const unsigned long long t0 = __builtin_amdgcn_s_memrealtime(); while (__builtin_amdgcn_s_memrealtime() - t0 < 20000ull) __builtin_amdgcn_s_sleep(32); }
#endif
#if PROBE_PH == 3
    if (blockIdx.x == PROBE_BLK && threadIdx.x == 0) {
        unsigned long long* pr = (unsigned long long*)(args_.ws + WS_PROBE);
        unsigned long long gmax = 0, w_in = 0, w_x = 0, mmin = ~0ull, mmax = 0;
        for (int x = 0; x < 8; ++x) { unsigned long long xm = 0, xs = 0;
            for (int j = 0; j < 32; ++j) { const unsigned long long t = __hip_atomic_load(pr + 64 + x + 8 * j, __ATOMIC_RELAXED, __HIP_MEMORY_SCOPE_AGENT); xm = t > xm ? t : xm; xs += t; }
            pr[32 + x] = xm; pr[40 + x] = xs / 32; gmax = xm > gmax ? xm : gmax; mmin = xs / 32 < mmin ? xs / 32 : mmin; mmax = xs / 32 > mmax ? xs / 32 : mmax; w_in += 32 * xm - xs; }
        for (int x = 0; x < 8; ++x) w_x += 32 * (gmax - pr[32 + x]);
        pr[0] = w_in / 256; pr[1] = w_x / 256; pr[2] = mmax - mmin; { unsigned long long smin = ~0ull, smax = 0, s7 = 0, s4 = 0; for (int x = 0; x < 8; ++x) { unsigned long long ss = 0; for (int j = 0; j < 32; ++j) ss += __hip_atomic_load(pr + 64 + 256 + x + 8 * j, __ATOMIC_RELAXED, __HIP_MEMORY_SCOPE_AGENT); ss /= 32; smin = ss < smin ? ss : smin; smax = ss > smax ? ss : smax; if (x == 7) s7 = ss; if (x == 4) s4 = ss; }
          { unsigned long long sall = 0, s1st = ~0ull; for (int j = 0; j < 256; ++j) { const unsigned long long t = __hip_atomic_load(pr + 64 + 256 + j, __ATOMIC_RELAXED, __HIP_MEMORY_SCOPE_AGENT); sall += t; s1st = t < s1st ? t : s1st; }
            pr[36] = (sall / 256 + 10000 - gmax) * 16 / 100; pr[37] = (s1st + 10000 - gmax) * 16 / 100; pr[38] = (smax + 10000 - gmax) * 16 / 100; }
          pr[62] = (smax - smin) * 16 / 100; pr[63] = (s7 + 10000 - s4) * 16 / 100; }
        pr[55] = (gmax - pr[56]) * 16 / 100; { unsigned long long sm = 0; for (int x = 0; x < 8; ++x) sm += pr[40 + x]; pr[59] = (sm / 8 - pr[56]) * 16 / 100; pr[60] = (mmin - pr[56]) * 16 / 100; pr[61] = (mmax - pr[56]) * 16 / 100; }
        { int am = 0, an = 0; for (int x = 0; x < 8; ++x) { if (pr[40 + x] == mmax) am = x; if (pr[40 + x] == mmin) an = x; } pr[3] = (unsigned long long)am * 250ull; pr[4] = (unsigned long long)an * 250ull; }
    }
#endif
#if PROBE_PH
    if (blockIdx.x == PROBE_BLK && threadIdx.x == 0) {
        const unsigned long long v = ((const unsigned long long*)(args_.ws + WS_PROBE))[PROBE_SEL] / (PROBE_PH >= 2 ? 4 : 100); const unsigned long long t0 = __builtin_amdgcn_s_memrealtime();
        while (__builtin_amdgcn_s_memrealtime() - t0 < v * 100ull) __builtin_amdgcn_s_sleep(32);
    }
#endif
}
#endif

#if MK_PER_PHASE_LAUNCH
template <int KIND> static void launch_phase(int grid, hipStream_t stream, const Args& a, int l, int ffn2) {
    static bool attr = false;
    if (!attr) { (void)hipFuncSetAttribute((const void*)phase_kernel<KIND>, hipFuncAttributeMaxDynamicSharedMemorySize, LDS_BYTES); attr = true; }
    hipLaunchKernelGGL(phase_kernel<KIND>, dim3(grid), dim3(NWAVES * 64), LDS_BYTES, stream, a, l, ffn2);
}
#endif
extern "C" void kernel_launch(void* const* d_in, const int* in_sizes, int n_in, void* d_out, int out_size, void* d_ws, size_t ws_size, hipStream_t stream) {
    static int grid = 0;
    if (grid == 0) {
        if (n_in != N_IN || in_sizes[0] != M * DM || out_size != M * DM || ws_size < WS_END) { fprintf(stderr, "kernel_launch: unexpected shapes (n_in %d, in0 %d, out %d, ws %zu < %zu); nothing launched\n", n_in, n_in > 0 ? in_sizes[0] : -1, out_size, ws_size, (size_t)WS_END); grid = -1; return; }
        int dev = 0, cus = 0, per_cu = 0;
        if (hipGetDevice(&dev) != hipSuccess || hipDeviceGetAttribute(&cus, hipDeviceAttributeMultiprocessorCount, dev) != hipSuccess) { grid = -1; return; }
#if !MK_PER_PHASE_LAUNCH
        if (hipFuncSetAttribute((const void*)trunk_fwd, hipFuncAttributeMaxDynamicSharedMemorySize, LDS_BYTES) != hipSuccess) { fprintf(stderr, "kernel_launch: hipFuncSetAttribute failed\n"); grid = -1; return; }
        if (hipOccupancyMaxActiveBlocksPerMultiprocessor(&per_cu, (const void*)trunk_fwd, NWAVES * 64, LDS_BYTES) != hipSuccess || per_cu < 1)
            fprintf(stderr, "kernel_launch: note: occupancy query reports %d workgroups per CU\n", per_cu);
        (void)hipGetLastError();
#endif
        (void)per_cu;
        if (cus < 256) { fprintf(stderr, "kernel_launch: built for a 256-CU device (found %d CUs); nothing launched\n", cus); grid = -1; return; }
        grid = 256;
    }
    if (grid < 0) return;
    (void)hipMemsetAsync((char*)d_ws + WS_CTL, 0, (FUSE_RET || PROBE_T || PROBE_PH) ? CTL_ZERO_BYTES : 32768, stream);
    Args a{};
    for (int i = 0; i < N_IN; ++i) a.in[i] = (const GAS float*)d_in[i];
    a.out = (GAS float*)d_out; a.ws = (GAS unsigned char*)d_ws;
    for (int i = 0; i < 32; ++i) a.ropec[i] = std::pow(10000.0, -(double)i / 32.0) / (2.0 * 3.14159265358979323846);
    for (int l = 0; l < 2; ++l) a.lam_init[l] = (float)(0.8 - 0.6 * std::exp(-0.3 * (double)l));
#if MK_PER_PHASE_LAUNCH
    for (int ph = 0; ph < N_PHASES; ++ph) {
        int kind, l, ffn2; phase_decode(ph, kind, l, ffn2);
        switch (kind) {
        case K_PRO: launch_phase<K_PRO>(grid, stream, a, l, ffn2); break;
        case K_CONV: if (l > 0) launch_phase<K_CONV>(grid, stream, a, l, ffn2); break;
        case K_UP: launch_phase<K_UP>(grid, stream, a, l, ffn2); break;
        case K_DOWN: launch_phase<K_DOWN>(grid, stream, a, l, ffn2); break;
        case K_WIN: launch_phase<K_WIN>(grid, stream, a, l, ffn2); break;
#if NAIVE_C
        case K_KV: case K_SCAN: break;
#else
        case K_KV: launch_phase<K_KV>(grid, stream, a, l, ffn2); break;
        case K_SCAN: launch_phase<K_SCAN>(grid, stream, a, l, ffn2); break;
#endif
        case K_MIX: launch_phase<K_MIX>(grid, stream, a, l, ffn2); break;
        case K_GATE: launch_phase<K_GATE>(grid, stream, a, l, ffn2); break;
        case K_MERGE: launch_phase<K_MERGE>(grid, stream, a, l, ffn2); break;
        default: launch_phase<K_WOUT>(grid, stream, a, l, ffn2); break;
        }
    }
#else
    hipLaunchKernelGGL(trunk_fwd, dim3(grid), dim3(NWAVES * 64), LDS_BYTES, stream, a);
#endif
    const hipError_t le = hipPeekAtLastError();
    if (le != hipSuccess) fprintf(stderr, "kernel_launch: launch failed: %s\n", hipGetErrorName(le));
}
```
